# Optimizing an MI355X kernel written in HIP

```python
import math
import jax
import jax.numpy as jnp
from jax import lax
import numpy as np

D_MODEL = 1024
BATCH = 4
SEQ = 4096
DEPTH = 4

HY_WIDTH = D_MODEL // 4
HY_GROUPS = 4
ATT_WIDTH = D_MODEL // 2
ATT_HEADS = 4
ATT_HEAD_DIM = ATT_WIDTH // (2 * ATT_HEADS)
POOL_WINDOWS = (2, 4, 8, 16)
POOL_WIDTH = D_MODEL - HY_WIDTH - ATT_WIDTH
POOL_GROUP = POOL_WIDTH // len(POOL_WINDOWS)
IN_WIDTH = 3 * HY_WIDTH + 3 * ATT_WIDTH + POOL_WIDTH
ROPE_THETA = 500000.0
ROPE_DIM = ATT_HEAD_DIM // 4
Q_BLOCK = 128
HY_EMB = 33
HY_BANDS = (HY_EMB - 1) // 2
HY_FILTER_HIDDEN = 64
HY_DECAY_TARGET = 1e-2
HY_FAST_DECAY = 0.3
HY_SLOW_DECAY = 1.5
HY_SHIFT = 0.0
N_GROUPS = 4
EXPERTS_PER_GROUP = 4
N_EXPERTS = N_GROUPS * EXPERTS_PER_GROUP
TOP_K_IN_GROUP = 2
D_EXPERT = 256
PLE_DIM = 256
LN_EPS = 1e-5
RMS_EPS = 1e-5
DN_ALPHA = (2 * DEPTH) ** 0.25
DN_BETA = (8 * DEPTH) ** -0.25

kernel_name = 'hybrid_hyena_diffattn_pool_hmoe_encoder'


def layer_norm(x, g, b):
    xf = x.astype(jnp.float32)
    mu = jnp.mean(xf, axis=-1, keepdims=True)
    var = jnp.mean(jnp.square(xf - mu), axis=-1, keepdims=True)
    y = (xf - mu) * lax.rsqrt(var + LN_EPS) * g.astype(jnp.float32) + b.astype(jnp.float32)
    return y.astype(x.dtype)


def rms_norm(x, g):
    xf = x.astype(jnp.float32)
    y = xf * lax.rsqrt(jnp.mean(jnp.square(xf), axis=-1, keepdims=True) + RMS_EPS) * g.astype(jnp.float32)
    return y.astype(x.dtype)


def rope_tables(seq_len):
    pos = jnp.arange(seq_len, dtype=jnp.float32)
    inv_freq = jnp.power(ROPE_THETA, -jnp.arange(0, ROPE_DIM, 2, dtype=jnp.float32) / ROPE_DIM)
    ang = pos[:, None] * inv_freq[None, :]
    ang = jnp.concatenate([ang, ang], axis=-1)
    return jnp.cos(ang), jnp.sin(ang)


def apply_partial_rope(x, cos, sin):
    xf = x.astype(jnp.float32)
    xr, xp = xf[..., :ROPE_DIM], xf[..., ROPE_DIM:]
    half = ROPE_DIM // 2
    rot = jnp.concatenate([-xr[..., half:], xr[..., :half]], axis=-1)
    c = cos[None, :, None, None, :]
    s = sin[None, :, None, None, :]
    return jnp.concatenate([xr * c + rot * s, xp], axis=-1).astype(x.dtype)


def short_conv_centred(u, w, b):
    up = jnp.pad(u, ((0, 0), (1, 1), (0, 0)))
    return up[:, :-2] * w[0] + up[:, 1:-1] * w[1] + up[:, 2:] * w[2] + b


def hyena_filters(seq_len, fw1, fb1, freq1, fw2, fb2, freq2, fw3):
    f32 = jnp.float32
    t = jnp.linspace(0.0, 1.0, seq_len, dtype=f32)[:, None]
    wpos = 2.0 * math.pi * jnp.arange(seq_len, dtype=f32)[:, None] / seq_len
    bands = jnp.linspace(1e-4, HY_BANDS - 1, HY_BANDS, dtype=f32)[None, :]
    z = jnp.concatenate([t, jnp.cos(wpos * bands), -jnp.sin(wpos * bands)], axis=-1)
    hdn = jnp.sin(freq1.astype(f32) * (z @ fw1.astype(f32) + fb1.astype(f32)))
    hdn = jnp.sin(freq2.astype(f32) * (hdn @ fw2.astype(f32) + fb2.astype(f32)))
    filt = hdn @ fw3.astype(f32)
    max_decay = math.log(HY_DECAY_TARGET) / HY_FAST_DECAY
    min_decay = math.log(HY_DECAY_TARGET) / HY_SLOW_DECAY
    deltas = jnp.linspace(min_decay, max_decay, HY_WIDTH, dtype=f32)[None, :]
    window = jnp.exp(-t * jnp.abs(deltas)) + HY_SHIFT
    h_fwd = filt[:, :HY_WIDTH] * window
    h_bwd = filt[:, HY_WIDTH:] * window
    k = jnp.concatenate([h_fwd, jnp.zeros((1, HY_WIDTH), f32), h_bwd[:0:-1]], axis=0)
    return k * lax.rsqrt(jnp.sum(jnp.square(k), axis=0, keepdims=True) + 1e-6)


def hyena_mixer(u, conv_w, conv_b, fw1, fb1, freq1, fw2, fb2, freq2, fw3, bias_d):
    B, L, _ = u.shape
    uc = short_conv_centred(u, conv_w, conv_b)
    x0, x1, v = jnp.split(uc, 3, axis=-1)
    v = (v * x1).astype(jnp.float32)
    k = hyena_filters(L, fw1, fb1, freq1, fw2, fb2, freq2, fw3)
    vf = jnp.fft.rfft(v, n=2 * L, axis=1)
    kf = jnp.fft.rfft(k, axis=0)
    y = jnp.fft.irfft(vf * kf[None], n=2 * L, axis=1)[:, :L]
    y = y + v * bias_d.astype(jnp.float32)
    return (y * x0.astype(jnp.float32)).astype(u.dtype)


def diff_attention(q, k, v, lq1, lk1, lq2, lk2, subln_g, lam_init, cos, sin):
    B, S, _ = q.shape
    q = q.reshape(B, S, ATT_HEADS, 2, ATT_HEAD_DIM)
    k = k.reshape(B, S, ATT_HEADS, 2, ATT_HEAD_DIM)
    v = v.reshape(B, S, ATT_HEADS, 2 * ATT_HEAD_DIM)
    q = apply_partial_rope(q, cos, sin) * (ATT_HEAD_DIM ** -0.5)
    k = apply_partial_rope(k, cos, sin)
    f32 = jnp.float32
    lam = (jnp.exp(jnp.sum(lq1.astype(f32) * lk1.astype(f32)))
           - jnp.exp(jnp.sum(lq2.astype(f32) * lk2.astype(f32))) + lam_init)
    nb = S // Q_BLOCK
    qb = q.reshape(B, nb, Q_BLOCK, ATT_HEADS, 2, ATT_HEAD_DIM).transpose(1, 0, 2, 3, 4, 5)

    def one_block(qblk):
        s = jnp.einsum('bqhcd,bkhcd->bhcqk', qblk, k, preferred_element_type=f32)
        pr = jax.nn.softmax(s, axis=-1)
        a = pr[:, :, 0] - lam * pr[:, :, 1]
        return jnp.einsum('bhqk,bkhe->bqhe', a.astype(v.dtype), v)

    o = lax.map(one_block, qb)
    o = o.transpose(1, 0, 2, 3, 4).reshape(B, S, ATT_HEADS, 2 * ATT_HEAD_DIM)
    o = rms_norm(o, subln_g) * (1.0 - lam_init)
    return o.reshape(B, S, ATT_HEADS * 2 * ATT_HEAD_DIM)


def pool_mixer(u, w, b, scale):
    B, S, _ = u.shape
    G = len(POOL_WINDOWS)
    f32 = jnp.float32
    uf = u.astype(f32).reshape(B, S, G, POOL_GROUP)
    csum = jnp.concatenate([jnp.zeros((B, 1, G, POOL_GROUP), f32), jnp.cumsum(uf, axis=1)], axis=1)
    pos = jnp.arange(S)
    pooled = []
    for g, win in enumerate(POOL_WINDOWS):
        lo = jnp.clip(pos - win // 2, 0, S - 1)
        hi = jnp.clip(pos + win // 2 - 1, 0, S - 1)
        cg = csum[:, :, g]
        cnt = (hi - lo + 1).astype(f32)[None, :, None]
        pooled.append((cg[:, hi + 1] - cg[:, lo]) / cnt)
    y = jnp.stack(pooled, axis=2) - uf
    y = jnp.einsum('bsgc,gcd->bsgd', y, w.astype(f32)) + b.astype(f32)
    return (y.reshape(B, S, POOL_WIDTH) * scale.astype(f32)).astype(u.dtype)


def hier_moe(h, wgc, bgc, wgf, bgf, w1, w3, w2):
    B, S, D = h.shape
    f32 = jnp.float32
    t = h.reshape(B * S, D)
    T = t.shape[0]
    pg = jax.nn.softmax(jnp.dot(t, wgc, preferred_element_type=f32) + bgc.astype(f32), axis=-1)
    gw, gi = lax.top_k(pg, 1)
    fl = (jnp.dot(t, wgf, preferred_element_type=f32) + bgf.astype(f32)).reshape(T, N_GROUPS, EXPERTS_PER_GROUP)
    idx = jnp.broadcast_to(gi[:, :, None], (T, 1, EXPERTS_PER_GROUP))
    fs = jnp.take_along_axis(fl, idx, axis=1)[:, 0]
    tv, ti = lax.top_k(jax.nn.softmax(fs, axis=-1), TOP_K_IN_GROUP)
    tv = tv / jnp.sum(tv, axis=-1, keepdims=True)
    eid = gi * EXPERTS_PER_GROUP + ti
    wts = gw * tv
    gates = jnp.sum(jax.nn.one_hot(eid, N_EXPERTS, dtype=f32) * wts[..., None], axis=1)
    a = jnp.einsum('td,edf->tef', t, w1)
    c = jnp.einsum('td,edf->tef', t, w3)
    act = jax.nn.silu(a) * c * gates[:, :, None].astype(t.dtype)
    y = jnp.einsum('tef,efd->td', act, w2)
    return y.reshape(B, S, D)


def setup_inputs(seed: int = 0) -> dict:
    key = jax.random.key(seed)
    ks = iter(jax.random.split(key, 48))
    f32 = jnp.float32

    def nrm(shape, scale):
        return scale * jax.random.normal(next(ks), shape, f32)

    def gain(shape):
        return 1.0 + 0.05 * jax.random.normal(next(ks), shape, f32)

    L = DEPTH
    return {
        'x': nrm((BATCH, SEQ, D_MODEL), 1.0),
        'p': nrm((DEPTH, BATCH, SEQ, PLE_DIM), 1.0),
        'ln0_g': gain((D_MODEL,)),
        'ln0_b': nrm((D_MODEL,), 0.02),
        'w_in': nrm((L, D_MODEL, IN_WIDTH), D_MODEL ** -0.5),
        'hy_conv_w': nrm((L, 3, 3 * HY_WIDTH), 3 ** -0.5),
        'hy_conv_b': nrm((L, 3 * HY_WIDTH), 0.02),
        'hy_fw1': nrm((L, HY_EMB, HY_FILTER_HIDDEN), HY_EMB ** -0.5),
        'hy_fb1': nrm((L, HY_FILTER_HIDDEN), 0.02),
        'hy_freq1': gain((L, HY_FILTER_HIDDEN)),
        'hy_fw2': nrm((L, HY_FILTER_HIDDEN, HY_FILTER_HIDDEN), HY_FILTER_HIDDEN ** -0.5),
        'hy_fb2': nrm((L, HY_FILTER_HIDDEN), 0.02),
        'hy_freq2': gain((L, HY_FILTER_HIDDEN)),
        'hy_fw3': nrm((L, HY_FILTER_HIDDEN, 2 * HY_WIDTH), HY_FILTER_HIDDEN ** -0.5),
        'hy_bias': nrm((L, HY_WIDTH), 1.0),
        'att_lq1': nrm((L, ATT_HEAD_DIM), 0.1),
        'att_lk1': nrm((L, ATT_HEAD_DIM), 0.1),
        'att_lq2': nrm((L, ATT_HEAD_DIM), 0.1),
        'att_lk2': nrm((L, ATT_HEAD_DIM), 0.1),
        'att_subln_g': gain((L, 2 * ATT_HEAD_DIM)),
        'pool_w': nrm((L, len(POOL_WINDOWS), POOL_GROUP, POOL_GROUP), POOL_GROUP ** -0.5),
        'pool_b': nrm((L, len(POOL_WINDOWS), POOL_GROUP), 0.02),
        'pool_scale': gain((L, POOL_WIDTH)),
        'w_out': nrm((L, D_MODEL, D_MODEL), DN_BETA * D_MODEL ** -0.5),
        'ln1_g': gain((L, D_MODEL)),
        'ln1_b': nrm((L, D_MODEL), 0.02),
        'moe_wgc': nrm((L, D_MODEL, N_GROUPS), D_MODEL ** -0.5),
        'moe_bgc': nrm((L, N_GROUPS), 0.01),
        'moe_wgf': nrm((L, D_MODEL, N_EXPERTS), D_MODEL ** -0.5),
        'moe_bgf': nrm((L, N_EXPERTS), 0.01),
        'moe_w1': nrm((L, N_EXPERTS, D_MODEL, D_EXPERT), D_MODEL ** -0.5),
        'moe_w3': nrm((L, N_EXPERTS, D_MODEL, D_EXPERT), D_MODEL ** -0.5),
        'moe_w2': nrm((L, N_EXPERTS, D_EXPERT, D_MODEL), DN_BETA * D_EXPERT ** -0.5),
        'ple_wg': nrm((L, D_MODEL, D_MODEL), D_MODEL ** -0.5),
        'ple_bg': nrm((L, D_MODEL), 0.02),
        'ple_wp': nrm((L, PLE_DIM, D_MODEL), DN_BETA * PLE_DIM ** -0.5),
        'ln2_g': gain((L, D_MODEL)),
        'ln2_b': nrm((L, D_MODEL), 0.02),
    }


def reference(x, p, ln0_g, ln0_b, w_in, hy_conv_w, hy_conv_b, hy_fw1, hy_fb1, hy_freq1,
              hy_fw2, hy_fb2, hy_freq2, hy_fw3, hy_bias, att_lq1, att_lk1, att_lq2, att_lk2,
              att_subln_g, pool_w, pool_b, pool_scale, w_out, ln1_g, ln1_b, moe_wgc, moe_bgc,
              moe_wgf, moe_bgf, moe_w1, moe_w3, moe_w2, ple_wg, ple_bg, ple_wp, ln2_g, ln2_b):
    S = x.shape[1]
    h = layer_norm(x, ln0_g, ln0_b)
    cos, sin = rope_tables(S)
    o_q = 3 * HY_WIDTH
    o_k = o_q + ATT_WIDTH
    o_v = o_k + ATT_WIDTH
    o_p = o_v + ATT_WIDTH
    for i in range(DEPTH):
        lam_init = 0.8 - 0.6 * math.exp(-0.3 * i)
        u = h @ w_in[i]
        y_hy = hyena_mixer(u[..., :o_q], hy_conv_w[i], hy_conv_b[i], hy_fw1[i], hy_fb1[i],
                           hy_freq1[i], hy_fw2[i], hy_fb2[i], hy_freq2[i], hy_fw3[i], hy_bias[i])
        y_att = diff_attention(u[..., o_q:o_k], u[..., o_k:o_v], u[..., o_v:o_p],
                               att_lq1[i], att_lk1[i], att_lq2[i], att_lk2[i], att_subln_g[i],
                               lam_init, cos, sin)
        y_pool = pool_mixer(u[..., o_p:], pool_w[i], pool_b[i], pool_scale[i])
        mix = jnp.concatenate([y_hy, y_att, y_pool], axis=-1) @ w_out[i]
        h = layer_norm(DN_ALPHA * h + mix, ln1_g[i], ln1_b[i])
        y_moe = hier_moe(h, moe_wgc[i], moe_bgc[i], moe_wgf[i], moe_bgf[i],
                         moe_w1[i], moe_w3[i], moe_w2[i])
        y_ple = jax.nn.sigmoid(h @ ple_wg[i] + ple_bg[i]) * (p[i] @ ple_wp[i])
        h = layer_norm(DN_ALPHA * h + y_moe + y_ple, ln2_g[i], ln2_b[i])
    return h
```

```cpp
#include <hip/hip_runtime.h>
#include <stdint.h>
#include <math.h>

namespace nv {
constexpr int D = 1024, NB = 4, S = 4096, M = NB * S, DEPTH = 4;
constexpr int HYW = 256, NH = 4, DH = 64, DV = 128, INW = 2560;
constexpr int OQ = 768, OKK = 1280, OV = 1792, OP = 2304;
constexpr float DN_ALPHA = 1.681792830507429f;
constexpr size_t MB = 1u << 20;
constexpr size_t W_H = 0, W_H1 = 64 * MB, W_U = 128 * MB, W_MIX = 288 * MB, W_VV = 352 * MB, W_PD = 368 * MB, W_MISC = 384 * MB;

__device__ __forceinline__ float wsum(float v) {
#pragma unroll
    for (int o = 32; o > 0; o >>= 1) v += __shfl_xor(v, o);
    return v;
}

__global__ __launch_bounds__(256) void ln_kernel(const float* in0, float a, const float* in1, const float* in2, const float* g, const float* b, float* out) {
    const int row = blockIdx.x * 4 + (threadIdx.x >> 6), lane = threadIdx.x & 63;
    const size_t base = (size_t)row * D;
    float4 v[4]; float s = 0.f;
#pragma unroll
    for (int j = 0; j < 4; ++j) {
        const int c = (lane + 64 * j) * 4;
        float4 x = *(const float4*)(in0 + base + c);
        x.x *= a; x.y *= a; x.z *= a; x.w *= a;
        if (in1) { const float4 y = *(const float4*)(in1 + base + c); x.x += y.x; x.y += y.y; x.z += y.z; x.w += y.w; }
        if (in2) { const float4 y = *(const float4*)(in2 + base + c); x.x += y.x; x.y += y.y; x.z += y.z; x.w += y.w; }
        v[j] = x; s += (x.x + x.y) + (x.z + x.w);
    }
    const float mean = wsum(s) * (1.f / D);
    float q = 0.f;
#pragma unroll
    for (int j = 0; j < 4; ++j) { v[j].x -= mean; v[j].y -= mean; v[j].z -= mean; v[j].w -= mean; q += (v[j].x * v[j].x + v[j].y * v[j].y) + (v[j].z * v[j].z + v[j].w * v[j].w); }
    const float rstd = 1.0f / sqrtf(wsum(q) * (1.f / D) + 1e-5f);
#pragma unroll
    for (int j = 0; j < 4; ++j) {
        const int c = (lane + 64 * j) * 4;
        const float4 gg = *(const float4*)(g + c), bb = *(const float4*)(b + c);
        float4 o; o.x = v[j].x * rstd * gg.x + bb.x; o.y = v[j].y * rstd * gg.y + bb.y; o.z = v[j].z * rstd * gg.z + bb.z; o.w = v[j].w * rstd * gg.w + bb.w;
        *(float4*)(out + base + c) = o;
    }
}

template <int MODE>
__global__ __launch_bounds__(256) void gemm_f32(const float* A, int lda, const float* W, int ldw, float* C, int ldc, int K, const float* R, float alpha, const float* bias) {
    __shared__ float As[16][68];
    __shared__ float Ws[16][68];
    const int tx = threadIdx.x & 15, ty = threadIdx.x >> 4;
    const int m0 = blockIdx.y * 64, n0 = blockIdx.x * 64;
    float acc[4][4];
#pragma unroll
    for (int i = 0; i < 4; ++i)
#pragma unroll
        for (int j = 0; j < 4; ++j) acc[i][j] = 0.f;
    for (int k0 = 0; k0 < K; k0 += 16) {
        { const int r = threadIdx.x >> 2, kq = (threadIdx.x & 3) * 4; const float4 v = *(const float4*)(A + (size_t)(m0 + r) * lda + k0 + kq);
          As[kq + 0][r] = v.x; As[kq + 1][r] = v.y; As[kq + 2][r] = v.z; As[kq + 3][r] = v.w; }
        { const int k = threadIdx.x >> 4, n4 = (threadIdx.x & 15) * 4; *(float4*)&Ws[k][n4] = *(const float4*)(W + (size_t)(k0 + k) * ldw + n0 + n4); }
        __syncthreads();
#pragma unroll
        for (int k = 0; k < 16; ++k) {
            const float4 a = *(const float4*)&As[k][ty * 4], b = *(const float4*)&Ws[k][tx * 4];
            acc[0][0] += a.x * b.x; acc[0][1] += a.x * b.y; acc[0][2] += a.x * b.z; acc[0][3] += a.x * b.w;
            acc[1][0] += a.y * b.x; acc[1][1] += a.y * b.y; acc[1][2] += a.y * b.z; acc[1][3] += a.y * b.w;
            acc[2][0] += a.z * b.x; acc[2][1] += a.z * b.y; acc[2][2] += a.z * b.z; acc[2][3] += a.z * b.w;
            acc[3][0] += a.w * b.x; acc[3][1] += a.w * b.y; acc[3][2] += a.w * b.z; acc[3][3] += a.w * b.w;
        }
        __syncthreads();
    }
#pragma unroll
    for (int i = 0; i < 4; ++i) {
        const size_t row = (size_t)(m0 + ty * 4 + i); const int col = n0 + tx * 4;
        float4 o; o.x = acc[i][0]; o.y = acc[i][1]; o.z = acc[i][2]; o.w = acc[i][3];
        if (MODE == 1) { const float4 r = *(const float4*)(R + row * ldc + col); o.x += alpha * r.x; o.y += alpha * r.y; o.z += alpha * r.z; o.w += alpha * r.w; }
        if (MODE == 2) { const float4 bb = *(const float4*)(bias + col); const float4 y = *(const float4*)(C + row * ldc + col);
            o.x = y.x / (1.f + expf(-(o.x + bb.x))); o.y = y.y / (1.f + expf(-(o.y + bb.y))); o.z = y.z / (1.f + expf(-(o.z + bb.z))); o.w = y.w / (1.f + expf(-(o.w + bb.w))); }
        *(float4*)(C + row * ldc + col) = o;
    }
}

__global__ __launch_bounds__(256) void rope_kernel(float* u) {
    const int idx = blockIdx.x * 256 + threadIdx.x;
    const int j = idx & 7, hc = (idx >> 3) & 7, qk = (idx >> 6) & 1, tok = idx >> 7;
    const int pos = tok % S;
    const float inv = powf(500000.0f, -(float)(2 * j) / 16.0f);
    const float ang = (float)pos * inv;
    const float c = cosf(ang), s = sinf(ang);
    float* p = u + (size_t)tok * INW + (qk ? OKK : OQ) + hc * 64 + j;
    const float x0 = p[0], x1 = p[8];
    p[0] = x0 * c - x1 * s; p[8] = x1 * c + x0 * s;
}

__global__ __launch_bounds__(64) void attn_naive(const float* u, float* attO) {
    __shared__ float Ks[64][64];
    __shared__ float Vs[64][128];
    const int qb = blockIdx.x, hc = blockIdx.y, b = blockIdx.z, h = hc >> 1, c = hc & 1;
    const int tid = threadIdx.x;
    const size_t tok = (size_t)b * S + qb * 64 + tid;
    float q[64], o[128];
#pragma unroll
    for (int d = 0; d < 64; d += 4) { const float4 v = *(const float4*)(u + tok * INW + OQ + h * 128 + c * 64 + d); q[d] = v.x * 0.125f; q[d + 1] = v.y * 0.125f; q[d + 2] = v.z * 0.125f; q[d + 3] = v.w * 0.125f; }
#pragma unroll
    for (int e = 0; e < 128; ++e) o[e] = 0.f;
    float m = -INFINITY, l = 0.f;
    for (int kt = 0; kt < S / 64; ++kt) {
        __syncthreads();
        for (int i = tid; i < 64 * 16; i += 64) { const int r = i >> 4, c4 = (i & 15) * 4; *(float4*)&Ks[r][c4] = *(const float4*)(u + ((size_t)b * S + kt * 64 + r) * INW + OKK + h * 128 + c * 64 + c4); }
        for (int i = tid; i < 64 * 32; i += 64) { const int r = i >> 5, c4 = (i & 31) * 4; *(float4*)&Vs[r][c4] = *(const float4*)(u + ((size_t)b * S + kt * 64 + r) * INW + OV + h * 128 + c4); }
        __syncthreads();
        for (int j = 0; j < 64; ++j) {
            float s = 0.f;
#pragma unroll
            for (int d = 0; d < 64; d += 4) { const float4 kv = *(const float4*)&Ks[j][d]; s += q[d] * kv.x + q[d + 1] * kv.y + q[d + 2] * kv.z + q[d + 3] * kv.w; }
            if (s > m) { const float f = expf(m - s); l *= f;
#pragma unroll
                for (int e = 0; e < 128; ++e) o[e] *= f;
                m = s; }
            const float p = expf(s - m); l += p;
#pragma unroll
            for (int e = 0; e < 128; e += 4) { const float4 vv = *(const float4*)&Vs[j][e]; o[e] += p * vv.x; o[e + 1] += p * vv.y; o[e + 2] += p * vv.z; o[e + 3] += p * vv.w; }
        }
    }
    const float il = 1.f / l;
    float* op = attO + (tok * 8 + hc) * 128;
#pragma unroll
    for (int e = 0; e < 128; e += 4) { float4 v; v.x = o[e] * il; v.y = o[e + 1] * il; v.z = o[e + 2] * il; v.w = o[e + 3] * il; *(float4*)(op + e) = v; }
}

__global__ __launch_bounds__(256) void attn_combine(const float* attO, const float* lq1, const float* lk1, const float* lq2, const float* lk2, const float* g, float lam_init, float* mix) {
    const int w = blockIdx.x * 4 + (threadIdx.x >> 6), lane = threadIdx.x & 63;
    const int tok = w >> 2, h = w & 3;
    const float lam = expf(wsum(lq1[lane] * lk1[lane])) - expf(wsum(lq2[lane] * lk2[lane])) + lam_init;
    const float* o1 = attO + ((size_t)tok * 8 + h * 2) * 128; const float* o2 = o1 + 128;
    const float a0 = o1[lane] - lam * o2[lane], a1 = o1[lane + 64] - lam * o2[lane + 64];
    const float ms = wsum(a0 * a0 + a1 * a1) * (1.f / 128.f);
    const float r = 1.0f / sqrtf(ms + 1e-5f) * (1.f - lam_init);
    float* mp = mix + (size_t)tok * D + 256 + h * 128;
    mp[lane] = a0 * r * g[lane]; mp[lane + 64] = a1 * r * g[lane + 64];
}

__global__ __launch_bounds__(64) void hy_filter(const float* fw1, const float* fb1, const float* fr1, const float* fw2, const float* fb2, const float* fr2, const float* fw3, float* hf, float* hb) {
    __shared__ float z[33]; __shared__ float h1[64]; __shared__ float h2[64];
    const int p = blockIdx.x, j = threadIdx.x;
    const float t = (float)p / (float)(S - 1);
    if (j == 0) z[0] = t;
    if (j < 16) { const float wpos = 2.0f * 3.14159265358979323846f * (float)p / (float)S; const float band = 1e-4f + (float)j * ((15.0f - 1e-4f) / 15.0f);
        z[1 + j] = cosf(wpos * band); z[17 + j] = -sinf(wpos * band); }
    __syncthreads();
    float a = fb1[j];
    for (int i = 0; i < 33; ++i) a += z[i] * fw1[i * 64 + j];
    h1[j] = sinf(fr1[j] * a);
    __syncthreads();
    a = fb2[j];
    for (int i = 0; i < 64; ++i) a += h1[i] * fw2[i * 64 + j];
    h2[j] = sinf(fr2[j] * a);
    __syncthreads();
    const float mind = logf(1e-2f) / 1.5f, maxd = logf(1e-2f) / 0.3f;
    for (int q = 0; q < 8; ++q) {
        const int col = j + 64 * q; float f = 0.f;
        for (int i = 0; i < 64; ++i) f += h2[i] * fw3[i * 512 + col];
        const int ch = col & 255;
        const float delta = mind + (float)ch * ((maxd - mind) / 255.0f);
        const float win = expf(-t * fabsf(delta));
        if (col < 256) hf[(size_t)p * 256 + ch] = f * win; else hb[(size_t)p * 256 + ch] = f * win;
    }
}
__global__ __launch_bounds__(256) void hy_norm(const float* hf, const float* hb, float* nrm) {
    __shared__ float red[4];
    const int c = blockIdx.x; float s = 0.f;
    for (int p = threadIdx.x; p < S; p += 256) { const float a = hf[(size_t)p * 256 + c]; s += a * a; if (p >= 1) { const float b = hb[(size_t)p * 256 + c]; s += b * b; } }
    s = wsum(s);
    if ((threadIdx.x & 63) == 0) red[threadIdx.x >> 6] = s;
    __syncthreads();
    if (threadIdx.x == 0) nrm[c] = 1.0f / sqrtf(red[0] + red[1] + red[2] + red[3] + 1e-6f);
}
__device__ __forceinline__ float conv3(const float* u, int tok, int pos, int ch, const float* cw, const float* cb) {
    const float xm = pos > 0 ? u[(size_t)(tok - 1) * INW + ch] : 0.f, x0 = u[(size_t)tok * INW + ch], xp = pos < S - 1 ? u[(size_t)(tok + 1) * INW + ch] : 0.f;
    return xm * cw[ch] + x0 * cw[768 + ch] + xp * cw[1536 + ch] + cb[ch];
}
__global__ __launch_bounds__(256) void hy_vv(const float* u, const float* cw, const float* cb, float* vv) {
    const int tok = blockIdx.x, c = threadIdx.x, pos = tok % S;
    vv[(size_t)tok * 256 + c] = conv3(u, tok, pos, 512 + c, cw, cb) * conv3(u, tok, pos, 256 + c, cw, cb);
}
__global__ __launch_bounds__(256) void hy_conv(const float* u, const float* cw, const float* cb, const float* vv, const float* hf, const float* hb, const float* nrm, const float* bias_d, float* mix) {
    const int tok = blockIdx.x, c = threadIdx.x, t = tok % S, b = tok / S;
    const float* vb = vv + (size_t)b * S * 256 + c;
    float acc = 0.f;
    for (int s = 0; s <= t; ++s) acc += hf[(size_t)(t - s) * 256 + c] * vb[(size_t)s * 256];
    for (int s = t + 1; s < S; ++s) acc += hb[(size_t)(s - t) * 256 + c] * vb[(size_t)s * 256];
    const float y = acc * nrm[c] + vb[(size_t)t * 256] * bias_d[c];
    mix[(size_t)tok * D + c] = y * conv3(u, tok, t, c, cw, cb);
}
__global__ __launch_bounds__(256) void pool_diff(const float* u, float* pd) {
    const int tok = blockIdx.x, col = threadIdx.x, g = col >> 6, pos = tok % S;
    const int win = 2 << g;
    int lo = pos - win / 2, hi = pos + win / 2 - 1;
    lo = lo < 0 ? 0 : (lo > S - 1 ? S - 1 : lo); hi = hi < 0 ? 0 : (hi > S - 1 ? S - 1 : hi);
    float s = 0.f;
    for (int r = lo; r <= hi; ++r) s += u[(size_t)(tok - pos + r) * INW + OP + col];
    pd[(size_t)tok * 256 + col] = s / (float)(hi - lo + 1) - u[(size_t)tok * INW + OP + col];
}
__global__ __launch_bounds__(256) void pool_mm(const float* pd, const float* w, const float* pb, const float* sc, float* mix) {
    __shared__ float x[256];
    const int tok = blockIdx.x, col = threadIdx.x, g = col >> 6, d = col & 63;
    x[col] = pd[(size_t)tok * 256 + col];
    __syncthreads();
    float a = pb[col];
    for (int c = 0; c < 64; ++c) a += x[g * 64 + c] * w[(g * 64 + c) * 64 + d];
    mix[(size_t)tok * D + 768 + col] = a * sc[col];
}
__global__ __launch_bounds__(256) void router(const float* h1, const float* wgc, const float* bgc, const float* wgf, const float* bgf, int* eid, float* wts) {
    const int tok = blockIdx.x * 4 + (threadIdx.x >> 6), lane = threadIdx.x & 63;
    float lg[20];
#pragma unroll
    for (int j = 0; j < 20; ++j) lg[j] = 0.f;
    for (int i = 0; i < 16; ++i) {
        const int k = lane + 64 * i; const float x = h1[(size_t)tok * D + k];
#pragma unroll
        for (int j = 0; j < 4; ++j) lg[j] += x * wgc[k * 4 + j];
#pragma unroll
        for (int j = 0; j < 16; ++j) lg[4 + j] += x * wgf[k * 16 + j];
    }
#pragma unroll
    for (int j = 0; j < 20; ++j) lg[j] = wsum(lg[j]);
    if (lane == 0) {
        float pg[4], mx = -INFINITY, sum = 0.f;
#pragma unroll
        for (int j = 0; j < 4; ++j) { pg[j] = lg[j] + bgc[j]; mx = fmaxf(mx, pg[j]); }
#pragma unroll
        for (int j = 0; j < 4; ++j) { pg[j] = expf(pg[j] - mx); sum += pg[j]; }
        int gi = 0; float gw = pg[0];
#pragma unroll
        for (int j = 1; j < 4; ++j) if (pg[j] > gw) { gw = pg[j]; gi = j; }
        gw /= sum;
        float fs[4]; mx = -INFINITY; sum = 0.f;
#pragma unroll
        for (int j = 0; j < 4; ++j) { float v = 0.f;
#pragma unroll
            for (int g = 0; g < 4; ++g) if (g == gi) v = lg[4 + g * 4 + j] + bgf[g * 4 + j];
            fs[j] = v; mx = fmaxf(mx, v); }
#pragma unroll
        for (int j = 0; j < 4; ++j) { fs[j] = expf(fs[j] - mx); sum += fs[j]; }
        int t0 = 0; float v0 = fs[0];
#pragma unroll
        for (int j = 1; j < 4; ++j) if (fs[j] > v0) { v0 = fs[j]; t0 = j; }
        int t1 = -1; float v1 = -1.f;
#pragma unroll
        for (int j = 0; j < 4; ++j) if (j != t0 && fs[j] > v1) { v1 = fs[j]; t1 = j; }
        const float tsum = v0 + v1;
        eid[tok * 2] = gi * 4 + t0; eid[tok * 2 + 1] = gi * 4 + t1;
        wts[tok * 2] = gw * (v0 / tsum); wts[tok * 2 + 1] = gw * (v1 / tsum);
    }
}
__global__ __launch_bounds__(256) void moe_naive(const float* h1, const int* eid, const float* wts, const float* w1, const float* w3, const float* w2, float* ymoe) {
    __shared__ float t[D]; __shared__ float act[256];
    const int tok = blockIdx.x, f = threadIdx.x;
    for (int i = f; i < D; i += 256) t[i] = h1[(size_t)tok * D + i];
    float y[4] = {0.f, 0.f, 0.f, 0.f};
    for (int sl = 0; sl < 2; ++sl) {
        const int e = eid[tok * 2 + sl]; const float gate = wts[tok * 2 + sl];
        __syncthreads();
        const float* p1 = w1 + (size_t)e * D * 256 + f; const float* p3 = w3 + (size_t)e * D * 256 + f;
        float a = 0.f, c = 0.f;
        for (int d = 0; d < D; ++d) { a += t[d] * p1[(size_t)d * 256]; c += t[d] * p3[(size_t)d * 256]; }
        act[f] = a / (1.f + expf(-a)) * c * gate;
        __syncthreads();
        const float* p2 = w2 + (size_t)e * 256 * D + f;
        for (int k = 0; k < 256; ++k) { const float av = act[k];
#pragma unroll
            for (int q = 0; q < 4; ++q) y[q] += av * p2[(size_t)k * D + 256 * q]; }
    }
#pragma unroll
    for (int q = 0; q < 4; ++q) ymoe[(size_t)tok * D + f + 256 * q] = y[q];
}
}

extern "C" void kernel_launch(void* const* d_in, const int* in_sizes, int n_in, void* d_out, int out_size, void* d_ws, size_t ws_size, hipStream_t stream) {
    using namespace nv;
    (void)in_sizes; (void)n_in; (void)out_size; (void)ws_size;
    auto in = [&](int i) { return (const float*)d_in[i]; };
    char* ws = (char*)d_ws;
    float* h = (float*)(ws + W_H); float* h1 = (float*)(ws + W_H1); float* u = (float*)(ws + W_U); float* mix = (float*)(ws + W_MIX);
    float* vv = (float*)(ws + W_VV); float* pd = (float*)(ws + W_PD);
    float* hf = (float*)(ws + W_MISC); float* hb = hf + S * 256; float* nrm = hb + S * 256; int* eid = (int*)(nrm + 256); float* wts = (float*)(eid + 2 * M);
    float* attO = h1; float* pre = h1; float* yp = u; float* ymoe = (float*)(ws + W_U + 64 * MB);
    ln_kernel<<<M / 4, 256, 0, stream>>>(in(0), 1.f, nullptr, nullptr, in(2), in(3), h);
    for (int l = 0; l < DEPTH; ++l) {
        const float lam_init = 0.8f - 0.6f * expf(-0.3f * (float)l);
        gemm_f32<0><<<dim3(INW / 64, M / 64), 256, 0, stream>>>(h, D, in(4) + (size_t)l * D * INW, INW, u, INW, D, nullptr, 0.f, nullptr);
        hy_filter<<<S, 64, 0, stream>>>(in(7) + l * 33 * 64, in(8) + l * 64, in(9) + l * 64, in(10) + l * 64 * 64, in(11) + l * 64, in(12) + l * 64, in(13) + l * 64 * 512, hf, hb);
        hy_norm<<<256, 256, 0, stream>>>(hf, hb, nrm);
        hy_vv<<<M, 256, 0, stream>>>(u, in(5) + l * 3 * 768, in(6) + l * 768, vv);
        hy_conv<<<M, 256, 0, stream>>>(u, in(5) + l * 3 * 768, in(6) + l * 768, vv, hf, hb, nrm, in(14) + l * 256, mix);
        pool_diff<<<M, 256, 0, stream>>>(u, pd);
        pool_mm<<<M, 256, 0, stream>>>(pd, in(20) + l * 4 * 64 * 64, in(21) + l * 256, in(22) + l * 256, mix);
        rope_kernel<<<M * 128 / 256, 256, 0, stream>>>(u);
        attn_naive<<<dim3(S / 64, 8, NB), 64, 0, stream>>>(u, attO);
        attn_combine<<<M, 256, 0, stream>>>(attO, in(15) + l * 64, in(16) + l * 64, in(17) + l * 64, in(18) + l * 64, in(19) + l * 128, lam_init, mix);
        gemm_f32<1><<<dim3(D / 64, M / 64), 256, 0, stream>>>(mix, D, in(23) + (size_t)l * D * D, D, pre, D, D, h, DN_ALPHA, nullptr);
        ln_kernel<<<M / 4, 256, 0, stream>>>(pre, 1.f, nullptr, nullptr, in(24) + l * D, in(25) + l * D, h1);
        router<<<M / 4, 256, 0, stream>>>(h1, in(26) + l * D * 4, in(27) + l * 4, in(28) + l * D * 16, in(29) + l * 16, eid, wts);
        moe_naive<<<M, 256, 0, stream>>>(h1, eid, wts, in(30) + (size_t)l * 16 * D * 256, in(31) + (size_t)l * 16 * D * 256, in(32) + (size_t)l * 16 * 256 * D, ymoe);
        gemm_f32<0><<<dim3(D / 64, M / 64), 256, 0, stream>>>(in(1) + (size_t)l * M * 256, 256, in(35) + (size_t)l * 256 * D, D, yp, D, 256, nullptr, 0.f, nullptr);
        gemm_f32<2><<<dim3(D / 64, M / 64), 256, 0, stream>>>(h1, D, in(33) + (size_t)l * D * D, D, yp, D, D, nullptr, 0.f, in(34) + l * D);
        ln_kernel<<<M / 4, 256, 0, stream>>>(h1, DN_ALPHA, ymoe, yp, in(36) + l * D, in(37) + l * D, l == DEPTH - 1 ? (float*)d_out : h);
    }
}
```

```cpp
#include <hip/hip_runtime.h>
#include <stdint.h>
#include <math.h>
namespace pg8 {
#define PG8_LAS __attribute__((address_space(3)))
typedef unsigned short bf16_t;
typedef short bf16x8 __attribute__((ext_vector_type(8)));
typedef float f32x4 __attribute__((ext_vector_type(4)));
typedef unsigned u32x4 __attribute__((ext_vector_type(4)));
constexpr int BM = 256, BK = 64, HALF = 128, HTB = HALF * BK * 2  , STAGE_BYTES = 8 * HTB;

__host__ __device__ __forceinline__ int lds_byte(int r, int c) { const int st = (r >> 4) * 2 + (c >> 5), rr = r & 15, cc = c & 31, ob = rr * 64 + cc * 2; return st * 1024 + (ob ^ (((ob >> 9) & 1) << 5)); }
__host__ __device__ __forceinline__ void stage_rc(int b, int& R, int& C) { const int st = b / 1024, sb = b % 1024, swz = sb ^ (((sb >> 9) & 1) << 5); R = (st >> 1) * 16 + swz / 64; C = (st & 1) * 32 + (swz % 64) / 2; }
__host__ __device__ __forceinline__ int perm32(int rho) { const int n = rho >> 4, i = rho & 15; return 8 * (i >> 2) + 4 * n + (i & 3); }

struct Unit { const char* A; const char* B; int kind, pm, pn, aux; };

__device__ __forceinline__ unsigned cvt_pk_bf16(float lo, float hi) { unsigned r; asm volatile("v_cvt_pk_bf16_f32 %0, %1, %2" : "=v"(r) : "v"(lo), "v"(hi)); return r; }

template <class Epi, class Sched, bool GATHER = false>
__device__ __forceinline__ void gemm_phase(PG8_LAS unsigned char* lds, const int K_, const Sched& S, const Epi& E) {
    int K = K_; asm volatile("" : "+s"(K));
    int tid_ = threadIdx.x; asm volatile("" : "+v"(tid_));
    const int tid = tid_, wid = __builtin_amdgcn_readfirstlane(tid >> 6), lane = tid & 63, wr = wid >> 2, wc = wid & 3, fr = lane & 15, fq = lane >> 4;
    const int nt = K / BK;
    unsigned voffA[2][2], voffN[2][2] = {{0u, 0u}, {0u, 0u}}, voffB[2]; int RA[2], CA[2];
#pragma unroll
    for (int i = 0; i < 2; ++i) { int R, C; stage_rc(tid * 16 + i * 8192, R, C); const int Rb = Epi::PERM ? ((R & ~31) + perm32(R & 31)) : R; RA[i] = R; CA[i] = C;
        voffA[0][i] = (unsigned)(R * K + C) * 2u; voffA[1][i] = (unsigned)((R + HALF) * K + C) * 2u; voffB[i] = (unsigned)(Rb * K + C) * 2u; }
    const size_t kstep = (size_t)(BK * 2);
    const size_t hstep = (size_t)HALF * K * 2;
    const unsigned ldsw = (unsigned)wid * 1024u;
    const int aoff = lds_byte(wr * 64 + fr, fq * 8), boff = lds_byte(wc * 32 + fr, fq * 8);
#define PG8_SA(b, h) (((b) * 2 + (h)) * HTB)
#define PG8_SB(b, h) ((4 + (b) * 2 + (h)) * HTB)
#define PG8_STAGE(bufoff, gbase, voff) do { _Pragma("unroll") for (int _i = 0; _i < 2; ++_i) \
        __builtin_amdgcn_global_load_lds((const unsigned*)((const char*)(gbase) + (voff)[_i]), (PG8_LAS unsigned*)(lds + (bufoff) + ldsw + _i * 8192), 16, 0, 0); } while (0)
#define PG8_LDA(dst, b, h) do { _Pragma("unroll") for (int m = 0; m < 4; ++m) _Pragma("unroll") for (int k = 0; k < 2; ++k) dst[m][k] = *(const PG8_LAS bf16x8*)(lds + PG8_SA(b, h) + aoff + m * 2048 + k * 1024); } while (0)
#define PG8_LDB(dst, b, h) do { _Pragma("unroll") for (int n = 0; n < 2; ++n) _Pragma("unroll") for (int k = 0; k < 2; ++k) dst[n][k] = *(const PG8_LAS bf16x8*)(lds + PG8_SB(b, h) + boff + n * 2048 + k * 1024); } while (0)
#define PG8_MMA(ai, bj, At, Bt) do { __builtin_amdgcn_s_setprio(1); _Pragma("unroll") for (int m = 0; m < 4; ++m) _Pragma("unroll") for (int n = 0; n < 2; ++n) _Pragma("unroll") for (int k = 0; k < 2; ++k) \
        acc[ai][bj][m][n] = __builtin_amdgcn_mfma_f32_16x16x32_bf16(Bt[n][k], At[m][k], acc[ai][bj][m][n], 0, 0, 0); __builtin_amdgcn_s_setprio(0); } while (0)
#define PG8_WAIT_V(n) asm volatile("s_waitcnt vmcnt(" #n ")" ::: "memory")
#define PG8_WAIT_L(n) asm volatile("s_waitcnt lgkmcnt(" #n ")" ::: "memory")
#define PG8_BAR __builtin_amdgcn_s_barrier()
#define PG8_SCHED __builtin_amdgcn_sched_barrier(0)
    Unit cur, nxt; int ui = 0;
    if (!S.next(0, cur)) return;
    if constexpr (GATHER) {
#pragma unroll
        for (int h = 0; h < 2; ++h)
#pragma unroll
            for (int i = 0; i < 2; ++i) voffA[h][i] = (unsigned)(S.arow(cur, h * HALF + RA[i]) * K + CA[i]) * 2u;
    }
    f32x4 acc[2][2][4][2];
#pragma unroll
    for (int a = 0; a < 2; ++a)
#pragma unroll
        for (int b = 0; b < 2; ++b)
#pragma unroll
            for (int m = 0; m < 4; ++m)
#pragma unroll
                for (int n = 0; n < 2; ++n) acc[a][b][m][n] = (f32x4){0.f, 0.f, 0.f, 0.f};
    bf16x8 At[4][2], B0[2][2], B1[2][2];
    const char* cA = cur.A; const char* cB = cur.B;
    PG8_STAGE(PG8_SB(0, 0), cB, voffB); PG8_STAGE(PG8_SB(0, 1), cB + hstep, voffB); PG8_STAGE(PG8_SA(0, 0), cA, voffA[0]); PG8_STAGE(PG8_SA(0, 1), cA, voffA[1]);
    if (wr == 1) PG8_BAR;
    PG8_WAIT_V(2); PG8_BAR;
    PG8_STAGE(PG8_SB(1, 0), cB + kstep, voffB); PG8_STAGE(PG8_SA(1, 0), cA + kstep, voffA[0]); PG8_STAGE(PG8_SB(1, 1), cB + hstep + kstep, voffB);
    PG8_WAIT_V(6); PG8_BAR;
    for (;;) {
        const bool has_next = S.next(ui + 1, nxt);
        const char* nA = has_next ? nxt.A : cA; const char* nB = has_next ? nxt.B : cB;
        if constexpr (GATHER) {
#pragma unroll
            for (int h = 0; h < 2; ++h)
#pragma unroll
                for (int i = 0; i < 2; ++i) voffN[h][i] = has_next ? (unsigned)(S.arow(nxt, h * HALF + RA[i]) * K + CA[i]) * 2u : voffA[h][i];
        }
#pragma unroll 1
        for (int t = 0; t < nt; t += 2) {
            const bool last = (t == nt - 2);
            const char* a1 = cA + (size_t)(t + 1) * kstep;
            const char* a2 = last ? nA : cA + (size_t)(t + 2) * kstep; const char* b2 = last ? nB : cB + (size_t)(t + 2) * kstep;
            const char* a3 = a2 + kstep; const char* b3 = b2 + kstep;
            PG8_LDB(B0, 0, 0); PG8_LDB(B1, 0, 1); PG8_SCHED; PG8_LDA(At, 0, 0); PG8_STAGE(PG8_SA(1, 1), a1, voffA[1]);
            if constexpr (GATHER) { if (last) {
#pragma unroll
                for (int h = 0; h < 2; ++h)
#pragma unroll
                    for (int i = 0; i < 2; ++i) voffA[h][i] = voffN[h][i]; } }
            PG8_WAIT_V(8); PG8_WAIT_L(0); PG8_BAR; PG8_MMA(0, 0, At, B0); PG8_MMA(0, 1, At, B1); PG8_BAR; PG8_SCHED;
            PG8_LDA(At, 0, 1); PG8_STAGE(PG8_SB(0, 0), b2, voffB); PG8_STAGE(PG8_SB(0, 1), b2 + hstep, voffB); PG8_STAGE(PG8_SA(0, 0), a2, voffA[0]);
            PG8_WAIT_V(8); PG8_WAIT_L(0); PG8_BAR; PG8_MMA(1, 0, At, B0); PG8_MMA(1, 1, At, B1); PG8_BAR; PG8_SCHED;
            PG8_LDB(B0, 1, 0); PG8_LDB(B1, 1, 1); PG8_SCHED; PG8_LDA(At, 1, 0); PG8_STAGE(PG8_SA(0, 1), a2, voffA[1]);
            PG8_WAIT_V(8); PG8_WAIT_L(0); PG8_BAR; PG8_MMA(0, 0, At, B0); PG8_MMA(0, 1, At, B1); PG8_BAR; PG8_SCHED;
            PG8_LDA(At, 1, 1); PG8_STAGE(PG8_SB(1, 0), b3, voffB); PG8_STAGE(PG8_SB(1, 1), b3 + hstep, voffB); PG8_STAGE(PG8_SA(1, 0), a3, voffA[0]);
            PG8_WAIT_V(8); PG8_WAIT_L(0); PG8_BAR; PG8_MMA(1, 0, At, B0); PG8_MMA(1, 1, At, B1); PG8_BAR; PG8_SCHED;
        }
        if (wr == 0) PG8_BAR;
        { Unit ce = cur; ce.pm = __builtin_amdgcn_readfirstlane(cur.pm); ce.pn = __builtin_amdgcn_readfirstlane(cur.pn); ce.kind = __builtin_amdgcn_readfirstlane(cur.kind); ce.aux = __builtin_amdgcn_readfirstlane(cur.aux); int fr_ = fr, fq_ = fq;
          asm volatile("" : "+s"(ce.pm), "+s"(ce.pn), "+s"(ce.kind), "+s"(ce.aux), "+v"(fr_), "+v"(fq_));
          E(acc, ce, wr, wc, fr_, fq_); }
        if (!has_next) break;
#pragma unroll
        for (int a = 0; a < 2; ++a)
#pragma unroll
            for (int b = 0; b < 2; ++b)
#pragma unroll
                for (int m = 0; m < 4; ++m)
#pragma unroll
                    for (int n = 0; n < 2; ++n) acc[a][b][m][n] = (f32x4){0.f, 0.f, 0.f, 0.f};
        cur = nxt; cA = nA; cB = nB; ++ui;
        if (wr == 1) PG8_BAR;
    }
    PG8_WAIT_V(0);
    PG8_BAR;
#undef PG8_SA
#undef PG8_SB
#undef PG8_STAGE
#undef PG8_LDA
#undef PG8_LDB
#undef PG8_MMA
#undef PG8_WAIT_V
#undef PG8_WAIT_L
#undef PG8_BAR
#undef PG8_SCHED
}
}
constexpr int D = 1024, NB = 4, S = 4096, M = NB * S, DEPTH = 4, INW = 2560;
constexpr float DN_ALPHA = 1.681792830507429f;
constexpr float QSCALE = 0.125f * 1.4426950408889634f;
constexpr int NWAVES = 8;
constexpr size_t MiB = 1u << 20;
constexpr size_t TILEB = (size_t)256 * D * 2;
constexpr size_t WS_CTL = 0, CTL_ZERO_BYTES = 1 * MiB;
constexpr size_t WS_CS = 1 * MiB;
constexpr size_t WS_WIN = 2 * MiB, WIN_LAYER = 5 * MiB;
constexpr size_t WS_X = 22 * MiB;
constexpr size_t WS_XB = 86 * MiB;
constexpr size_t WS_QKP = 118 * MiB;
constexpr size_t WS_UVT = 158 * MiB;
constexpr size_t WS_MIXB = 198 * MiB;
constexpr size_t WS_STASH = WS_XB;
constexpr size_t WS_WOUT = 383 * MiB, WOUT_LAYER = 2 * MiB;
constexpr size_t WS_TOKIDX = 391 * MiB, WS_GATE = 392 * MiB;
constexpr size_t WS_YMOE = WS_QKP;
constexpr size_t WS_YP = WS_MIXB;
constexpr size_t WS_ACT = 230 * MiB;
constexpr size_t WS_PB = 248 * MiB;
constexpr size_t WS_W13 = 351 * MiB, WS_W2 = 367 * MiB, WS_WG = 375 * MiB, WS_WP = 377 * MiB;
constexpr size_t WS_KF = 262 * MiB, WS_PS = 278 * MiB, WS_HT = 280 * MiB;
constexpr int CW_BAR = 4096, CW_CNT = 8192;

#define GAS __attribute__((address_space(1)))
#define LAS __attribute__((address_space(3)))
typedef unsigned short bf16;
typedef unsigned v4u __attribute__((ext_vector_type(4)));
typedef float f32x4 __attribute__((ext_vector_type(4)));
typedef short bf16x8 __attribute__((ext_vector_type(8)));
typedef GAS unsigned gu32;
typedef GAS unsigned long long gu64;
#define RLX_AGENT __ATOMIC_RELAXED, __HIP_MEMORY_SCOPE_AGENT
#define LDS_WAIT() asm volatile("s_waitcnt lgkmcnt(0)" ::: "memory")
#define VM_WAIT() asm volatile("s_waitcnt vmcnt(0)" ::: "memory")
__device__ __forceinline__ unsigned long long rt() { return __builtin_amdgcn_s_memrealtime(); }
__device__ __forceinline__ unsigned f2bf(float f) { unsigned u = __builtin_bit_cast(unsigned, f); return (u + 0x7fffu + ((u >> 16) & 1u)) >> 16; }
__device__ __forceinline__ unsigned pk2(float lo, float hi) { return f2bf(lo) | (f2bf(hi) << 16); }

#define XB_TMO      128
#define XB_XCNT(j)  (256  + 64 * (j))
#define XB_XSUB(j)  (1280 + 64 * (j))
#define XB_XGEN(j)  (2304 + 64 * (j))
#define XB_TOP      3328
#define XB_TOPGEN   3392
#define XCD_BAR_WORDS 3456
#define XB_SPIN_CAP (1u << 18)

__device__ __forceinline__ unsigned xb_ld(unsigned* p)              { return __hip_atomic_load(p, __ATOMIC_RELAXED, __HIP_MEMORY_SCOPE_AGENT); }
__device__ __forceinline__ unsigned xb_add(unsigned* p, unsigned v) { return __hip_atomic_fetch_add(p, v, __ATOMIC_RELAXED, __HIP_MEMORY_SCOPE_AGENT); }
__device__ __forceinline__ unsigned xb_xcc_id() { return (unsigned)__builtin_amdgcn_s_getreg((3 << 11) | 20) & 0xFu; }
#define XB_SPIN(cond, bar) do { unsigned _sp = 0; while (cond) { __builtin_amdgcn_s_sleep(1); \
    if ((++_sp & 255u) == 0u) { if (xb_ld(&(bar)[XB_TMO])) break; if (_sp > XB_SPIN_CAP) { atomicAdd(&(bar)[XB_TMO], 1u); break; } } } } while (0)

struct XcdBarrier {
    unsigned* bar; unsigned x;
    volatile LAS unsigned* st;
};

__device__ __forceinline__ XcdBarrier xcd_barrier_post(unsigned* bar, volatile LAS unsigned* st) {
    XcdBarrier b; b.bar = bar; b.x = xb_xcc_id(); b.st = st;
    if (threadIdx.x == 0) (void)xb_add(&bar[XB_XCNT(b.x)], 1u);
    return b;
}
__device__ __forceinline__ void xcd_barrier_complete(unsigned* bar, unsigned x, unsigned& nloc, unsigned& nx) {
    const unsigned G = gridDim.x * gridDim.y * gridDim.z;
    unsigned sum, cnt, mine, sp = 0u;
    for (;;) {
        sum = 0u; cnt = 0u; mine = 0u;
#pragma unroll
        for (unsigned j = 0; j < 16; ++j) { const unsigned c = xb_ld(&bar[XB_XCNT(j)]); sum += c; cnt += (c > 0u) ? 1u : 0u; mine = (j == x) ? c : mine; }
        if (sum == G) break;
        __builtin_amdgcn_s_sleep(1);
        if ((++sp & 255u) == 0u) { if (xb_ld(&bar[XB_TMO])) break; if (sp > XB_SPIN_CAP) { atomicAdd(&bar[XB_TMO], 1u); break; } }
    }
    nloc = mine > 0u ? mine : 1u; nx = cnt > 0u ? cnt : 1u;
}

__device__ __forceinline__ void xcd_barrier(const XcdBarrier& b) {
    asm volatile("s_waitcnt vmcnt(0)" ::: "memory");
    __syncthreads();
    if (threadIdx.x == 0) {
        unsigned* bar = b.bar;
        __builtin_amdgcn_s_waitcnt(0);
        unsigned nloc = b.st[0], nx = b.st[1];
        if (nloc == 0u) { xcd_barrier_complete(bar, b.x, nloc, nx); b.st[0] = nloc; b.st[1] = nx; }
        const unsigned old = xb_add(&bar[XB_XSUB(b.x)], 1u);
        const unsigned gen = old / nloc;
        if (old + 1u == (gen + 1u) * nloc) {
            __builtin_amdgcn_fence(__ATOMIC_RELEASE, "agent");
            asm volatile("s_waitcnt vmcnt(0)" ::: "memory");
            const unsigned og = xb_add(&bar[XB_TOP], 1u);
            const unsigned tg = og / nx;
            if (og + 1u == (tg + 1u) * nx) xb_add(&bar[XB_TOPGEN], 1u);
            else XB_SPIN(xb_ld(&bar[XB_TOPGEN]) == tg, bar);
            __builtin_amdgcn_fence(__ATOMIC_ACQUIRE, "agent");
            xb_add(&bar[XB_XGEN(b.x)], 1u);
            asm volatile("s_waitcnt vmcnt(0)" ::: "memory");
        } else {
            XB_SPIN(xb_ld(&bar[XB_XGEN(b.x)]) == gen, bar);
            __builtin_amdgcn_fence(__ATOMIC_ACQUIRE, "agent");
            asm volatile("s_waitcnt vmcnt(0)" ::: "memory");
        }
    }
    __syncthreads();
}
__device__ __forceinline__ float bf2f(unsigned short b) { return __uint_as_float((unsigned)b << 16); }
__device__ __forceinline__ float wave_sum(float v) {
#pragma unroll
    for (int o = 1; o < 64; o <<= 1) v += __shfl_xor(v, o);
    return v;
}
__device__ __forceinline__ void p0_transpose_block(const float* W, int K, int N, int k0, int n0, bf16* WT, int mode, LAS float* scr, int lane) {
#pragma unroll 4
    for (int i = 0; i < 32; ++i) { const int kk = 2 * i + (lane >> 5); scr[kk * 33 + (lane & 31)] = W[(size_t)(k0 + kk) * N + n0 + (lane & 31)]; }
    LDS_WAIT(); asm volatile("" ::: "memory");
    const int c = lane & 7;
#pragma unroll 1
    for (int j = 0; j < 4; ++j) { const int n = (lane >> 3) + 8 * j; const LAS float* s = scr + (8 * c) * 33 + n;
        v4u o; o.x = pk2(s[0 * 33], s[1 * 33]); o.y = pk2(s[2 * 33], s[3 * 33]); o.z = pk2(s[4 * 33], s[5 * 33]); o.w = pk2(s[6 * 33], s[7 * 33]);
        const int f = n0 + n; const size_t drow = mode == 0 ? (size_t)n : (size_t)(8 * (f >> 2) + (f & 3) + (mode == 2 ? 4 : 0));
        *(GAS v4u*)(WT + drow * K + k0 + 8 * c) = o; }
    LDS_WAIT(); asm volatile("" ::: "memory");
}
__device__ __forceinline__ void ln_row(const float* x0, float a, const bf16* y1, const bf16* y2, const bf16* y3, const float* g, const float* b, float* of, bf16* ob, int lane) {
    f32x4 v[4]; float s = 0.f;
#pragma unroll
    for (int j = 0; j < 4; ++j) { const int c = 4 * lane + 256 * j; v[j] = *(const GAS f32x4*)(x0 + c) * a;
        if (y1) { const unsigned long long w = *(const GAS unsigned long long*)(y1 + c); v[j] += (f32x4){bf2f((bf16)w), bf2f((bf16)(w >> 16)), bf2f((bf16)(w >> 32)), bf2f((bf16)(w >> 48))}; }
        if (y2) { const unsigned long long w = *(const GAS unsigned long long*)(y2 + c); v[j] += (f32x4){bf2f((bf16)w), bf2f((bf16)(w >> 16)), bf2f((bf16)(w >> 32)), bf2f((bf16)(w >> 48))}; }
        if (y3) { const unsigned long long w = *(const GAS unsigned long long*)(y3 + c); v[j] += (f32x4){bf2f((bf16)w), bf2f((bf16)(w >> 16)), bf2f((bf16)(w >> 32)), bf2f((bf16)(w >> 48))}; }
        s += (v[j].x + v[j].y) + (v[j].z + v[j].w); }
    const float mean = wave_sum(s) * (1.f / D); float s2 = 0.f;
#pragma unroll
    for (int j = 0; j < 4; ++j) { v[j] = v[j] - mean; s2 += (v[j].x * v[j].x + v[j].y * v[j].y) + (v[j].z * v[j].z + v[j].w * v[j].w); }
    const float rstd = 1.f / sqrtf(wave_sum(s2) * (1.f / D) + 1e-5f);
#pragma unroll
    for (int j = 0; j < 4; ++j) { const int c = 4 * lane + 256 * j; const f32x4 o = v[j] * rstd * *(const GAS f32x4*)(g + c) + *(const GAS f32x4*)(b + c);
        if (of) *(GAS f32x4*)(of + c) = o;
        if (ob) *(GAS unsigned long long*)(ob + c) = (unsigned long long)pk2(o.x, o.y) | ((unsigned long long)pk2(o.z, o.w) << 32); }
}

struct SchedIn {
    int vcu, G; const char* xb; const char* wsw; const char* wnm;
    __device__ __forceinline__ bool next(int i, pg8::Unit& u) const {
        const int L = i * G + vcu; if (L >= 640) return false;
        const int t = L / 10, j = L % 10;
        if (j < 5) { u.kind = 0; u.pm = t; u.pn = j; u.A = xb + (size_t)t * TILEB; u.B = wnm + (size_t)j * TILEB; }
        else { u.kind = 1; u.pm = j - 5; u.pn = t; u.A = wsw + (size_t)(j - 5) * TILEB; u.B = xb + (size_t)t * TILEB; }
        u.aux = 0; return true;
    }
};
struct EpiIn {
    static constexpr bool PERM = true;
    bf16* qkp; bf16* uvt; const float* cs;
    __device__ __forceinline__ void operator()(const pg8::f32x4 (&acc)[2][2][4][2], const pg8::Unit& u, int wr, int wc, int fr, int fq) const {
        bf16* base = u.kind == 0 ? qkp : uvt; const int ldc = u.kind == 0 ? 1280 : M;
        const int row0 = u.pm * 256 + wr * 64 + fr, col0 = u.pn * 256 + wc * 32 + 8 * fq;
        const bool rope = (u.kind == 0) && (u.pn < 4) && ((wc & 1) == 0);
        const float sc = (u.kind == 0 && u.pn < 2) ? QSCALE : 1.f;
        const float sgn = fq == 0 ? -1.f : 1.f;
        const bool vperm = (u.kind == 1) && (u.pm >= 3);
#pragma unroll
        for (int ai = 0; ai < 2; ++ai)
#pragma unroll
            for (int m = 0; m < 4; ++m) { const int row = row0 + ai * 128 + m * 16; bf16* rowp = base + (size_t)row * ldc + col0;
                f32x4 cv0 = {1.f, 1.f, 1.f, 1.f}, cv1 = cv0, sv0 = {0.f, 0.f, 0.f, 0.f}, sv1 = sv0;
                if (rope && fq < 2) { const float* t = cs + (size_t)(row & (S - 1)) * 16; cv0 = *(const f32x4*)t; cv1 = *(const f32x4*)(t + 4); sv0 = *(const f32x4*)(t + 8) * sgn; sv1 = *(const f32x4*)(t + 12) * sgn; }
#pragma unroll
                for (int bj = 0; bj < 2; ++bj) { f32x4 v0 = acc[ai][bj][m][0], v1 = acc[ai][bj][m][1];
                    if (rope) { f32x4 p0, p1;
#pragma unroll
                        for (int e = 0; e < 4; ++e) { p0[e] = __shfl_xor(v0[e], 16); p1[e] = __shfl_xor(v1[e], 16); }
                        v0 = v0 * cv0 + p0 * sv0; v1 = v1 * cv1 + p1 * sv1; }
                    v0 = v0 * sc; v1 = v1 * sc;
                    pg8::u32x4 w; w.x = pg8::cvt_pk_bf16(v0[0], v0[1]); w.y = pg8::cvt_pk_bf16(v0[2], v0[3]); w.z = pg8::cvt_pk_bf16(v1[0], v1[1]); w.w = pg8::cvt_pk_bf16(v1[2], v1[3]);
                    if (vperm) {
                        bf16* gp = rowp + bj * 128 - (fq & 1) * 8;
                        typedef unsigned u32x2 __attribute__((ext_vector_type(2)));
                        *(u32x2*)(gp + ((fq & 1) ? 4 : 0)) = (u32x2){w.x, w.y}; *(u32x2*)(gp + ((fq & 1) ? 12 : 8)) = (u32x2){w.z, w.w};
                    } else *(pg8::u32x4*)(rowp + bj * 128) = w; } }
    }
};

struct SchedOut {
    int vcu, G; const char* a; const char* w;
    __device__ __forceinline__ bool next(int i, pg8::Unit& u) const {
        const int L = i * G + vcu; if (L >= 256) return false;
        u.kind = 0; u.pm = L >> 2; u.pn = L & 3; u.aux = 0; u.A = a + (size_t)u.pm * TILEB; u.B = w + (size_t)u.pn * TILEB; return true;
    }
};
struct EpiRes {
    static constexpr bool PERM = false;
    float* X;
    __device__ __forceinline__ void operator()(const pg8::f32x4 (&acc)[2][2][4][2], const pg8::Unit& u, int wr, int wc, int fr, int fq) const {
        const int row0 = u.pm * 256 + wr * 64 + fr, col0 = u.pn * 256 + wc * 32 + 4 * fq;
#pragma unroll
        for (int ai = 0; ai < 2; ++ai)
#pragma unroll
            for (int m = 0; m < 4; ++m) { float* rowp = X + (size_t)(row0 + ai * 128 + m * 16) * D + col0;
#pragma unroll
                for (int bj = 0; bj < 2; ++bj)
#pragma unroll
                    for (int n = 0; n < 2; ++n) { pg8::f32x4* p = (pg8::f32x4*)(rowp + bj * 128 + n * 16); *p = *p * DN_ALPHA + acc[ai][bj][m][n]; } }
    }
};
__device__ __forceinline__ void ln1_router_row(float* xrow, bf16* xbrow, const float* g, const float* b, const float* wgc, const float* bgc, const float* wgf, const float* bgf,
                                               int tok, int* eid, float* wts, unsigned* cnt, int* tokidx, float* gate, int lane) {
    f32x4 v[4]; float s = 0.f;
#pragma unroll
    for (int j = 0; j < 4; ++j) { v[j] = *(const GAS f32x4*)(xrow + 4 * lane + 256 * j); s += (v[j].x + v[j].y) + (v[j].z + v[j].w); }
    const float mean = wave_sum(s) * (1.f / D); float s2 = 0.f;
#pragma unroll
    for (int j = 0; j < 4; ++j) { v[j] = v[j] - mean; s2 += (v[j].x * v[j].x + v[j].y * v[j].y) + (v[j].z * v[j].z + v[j].w * v[j].w); }
    const float rstd = 1.f / sqrtf(wave_sum(s2) * (1.f / D) + 1e-5f);
    float lg[20];
#pragma unroll
    for (int i = 0; i < 20; ++i) lg[i] = 0.f;
#pragma unroll
    for (int j = 0; j < 4; ++j) { const int c = 4 * lane + 256 * j; const f32x4 o = v[j] * rstd * *(const GAS f32x4*)(g + c) + *(const GAS f32x4*)(b + c);
        *(GAS f32x4*)(xrow + c) = o;
        *(GAS unsigned long long*)(xbrow + c) = (unsigned long long)pk2(o.x, o.y) | ((unsigned long long)pk2(o.z, o.w) << 32);
#pragma unroll
        for (int e = 0; e < 4; ++e) { const float x = o[e]; const f32x4 wc4 = *(const GAS f32x4*)(wgc + (size_t)(c + e) * 4);
            lg[0] += x * wc4.x; lg[1] += x * wc4.y; lg[2] += x * wc4.z; lg[3] += x * wc4.w;
#pragma unroll
            for (int q = 0; q < 4; ++q) { const f32x4 w4 = *(const GAS f32x4*)(wgf + (size_t)(c + e) * 16 + q * 4); lg[4 + 4 * q] += x * w4.x; lg[5 + 4 * q] += x * w4.y; lg[6 + 4 * q] += x * w4.z; lg[7 + 4 * q] += x * w4.w; } } }
#pragma unroll
    for (int i = 0; i < 20; ++i) lg[i] = wave_sum(lg[i]);
    if (lane == 0) {
        float pg[4], mx = -INFINITY, sum = 0.f;
#pragma unroll
        for (int j = 0; j < 4; ++j) { pg[j] = lg[j] + bgc[j]; mx = fmaxf(mx, pg[j]); }
#pragma unroll
        for (int j = 0; j < 4; ++j) { pg[j] = expf(pg[j] - mx); sum += pg[j]; }
        int gi = 0; float gw = pg[0];
#pragma unroll
        for (int j = 1; j < 4; ++j) if (pg[j] > gw) { gw = pg[j]; gi = j; }
        gw /= sum;
        float fs[4]; mx = -INFINITY;
#pragma unroll
        for (int j = 0; j < 4; ++j) { float t = 0.f;
#pragma unroll
            for (int q = 0; q < 4; ++q) if (q == gi) t = lg[4 + q * 4 + j] + bgf[q * 4 + j];
            fs[j] = t; mx = fmaxf(mx, t); }
#pragma unroll
        for (int j = 0; j < 4; ++j) fs[j] = expf(fs[j] - mx);
        int t0 = 0; float v0 = fs[0];
#pragma unroll
        for (int j = 1; j < 4; ++j) if (fs[j] > v0) { v0 = fs[j]; t0 = j; }
        int t1 = -1; float v1 = -1.f;
#pragma unroll
        for (int j = 0; j < 4; ++j) if (j != t0 && fs[j] > v1) { v1 = fs[j]; t1 = j; }
        const float ts = v0 + v1; const int e0 = gi * 4 + t0, e1 = gi * 4 + t1; const float g0 = gw * (v0 / ts), g1 = gw * (v1 / ts);
        if (eid) { eid[tok * 2] = e0; eid[tok * 2 + 1] = e1; wts[tok * 2] = g0; wts[tok * 2 + 1] = g1; }
        const unsigned r0 = __hip_atomic_fetch_add(cnt + e0, 1u, __ATOMIC_RELAXED, __HIP_MEMORY_SCOPE_AGENT), r1 = __hip_atomic_fetch_add(cnt + e1, 1u, __ATOMIC_RELAXED, __HIP_MEMORY_SCOPE_AGENT);
        tokidx[e0 * M + r0] = tok * 2; gate[e0 * M + r0] = g0; tokidx[e1 * M + r1] = tok * 2 + 1; gate[e1 * M + r1] = g1;
    }
}

struct MoeTab { LAS const int* p;
    __device__ __forceinline__ int cnt(int e) const { return __builtin_amdgcn_readfirstlane(p[e]); }
    __device__ __forceinline__ int pre(int e) const { return __builtin_amdgcn_readfirstlane(p[16 + e]); } };
__device__ __forceinline__ void moe_tab_build(LAS int* p, const gu32* cnt) {
    if (threadIdx.x == 0) { int acc = 0;
        for (int e = 0; e < 16; ++e) { const int c = (int)__hip_atomic_load(cnt + e, RLX_AGENT); p[e] = c; p[16 + e] = acc; acc += (c + 255) >> 8; }
        p[32] = acc; }
    __syncthreads();
}
template <int NPN> struct SchedMoe {
    int vcu, G; MoeTab T; const char* a; const char* w; size_t wexp  ; const int* tokidx; size_t atile  ;
    __device__ __forceinline__ bool next(int i, pg8::Unit& u) const {
        const int L = i * G + vcu; if (L >= T.pre(16) * NPN) return false;
        const int tile = L / NPN; u.pn = L % NPN; int e = 0;
#pragma unroll 1
        for (int q = 1; q < 16; ++q) if (tile >= T.pre(q)) e = q;
        u.aux = e; u.pm = tile - T.pre(e); u.kind = tile;
        u.A = a + (size_t)tile * atile; u.B = w + (size_t)e * wexp + (size_t)u.pn * 256 * (wexp / (NPN * 256)); return true;
    }
    __device__ __forceinline__ int arow(const pg8::Unit& u, int r) const {
        const int rank = u.pm * 256 + r; const int c = T.cnt(u.aux);
        return rank < c ? (tokidx[(size_t)u.aux * M + rank] >> 1) : 0;
    }
};
struct EpiMoe1 {
    static constexpr bool PERM = true;
    bf16* act; const float* gate; MoeTab T;
    __device__ __forceinline__ void operator()(const pg8::f32x4 (&acc)[2][2][4][2], const pg8::Unit& u, int wr, int wc, int fr, int fq) const {
        const int cnt = T.cnt(u.aux);
#pragma unroll
        for (int ai = 0; ai < 2; ++ai)
#pragma unroll
            for (int m = 0; m < 4; ++m) { const int r = ai * 128 + wr * 64 + m * 16 + fr, rank = u.pm * 256 + r;
                const float gt = rank < cnt ? gate[(size_t)u.aux * M + rank] : 0.f;
                bf16* rowp = act + ((size_t)u.kind * 256 + r) * 256 + u.pn * 128 + wc * 16 + 4 * fq;
#pragma unroll
                for (int bj = 0; bj < 2; ++bj) { const pg8::f32x4 av = acc[ai][bj][m][0], cv = acc[ai][bj][m][1]; float y[4];
#pragma unroll
                    for (int e = 0; e < 4; ++e) y[e] = av[e] / (1.f + __expf(-av[e])) * cv[e] * gt;
                    *(unsigned long long*)(rowp + bj * 64) = (unsigned long long)pg8::cvt_pk_bf16(y[0], y[1]) | ((unsigned long long)pg8::cvt_pk_bf16(y[2], y[3]) << 32); } }
    }
};
struct EpiMoe2 {
    static constexpr bool PERM = true;
    bf16* ymoe; const int* tokidx; MoeTab T;
    __device__ __forceinline__ void operator()(const pg8::f32x4 (&acc)[2][2][4][2], const pg8::Unit& u, int wr, int wc, int fr, int fq) const {
        const int cnt = T.cnt(u.aux);
#pragma unroll
        for (int ai = 0; ai < 2; ++ai)
#pragma unroll
            for (int m = 0; m < 4; ++m) { const int r = ai * 128 + wr * 64 + m * 16 + fr, rank = u.pm * 256 + r;
                if (rank < cnt) { bf16* rowp = ymoe + (size_t)tokidx[(size_t)u.aux * M + rank] * D + u.pn * 256 + wc * 32 + 8 * fq;
#pragma unroll
                    for (int bj = 0; bj < 2; ++bj) { const pg8::f32x4 v0 = acc[ai][bj][m][0], v1 = acc[ai][bj][m][1];
                        pg8::u32x4 w; w.x = pg8::cvt_pk_bf16(v0[0], v0[1]); w.y = pg8::cvt_pk_bf16(v0[2], v0[3]); w.z = pg8::cvt_pk_bf16(v1[0], v1[1]); w.w = pg8::cvt_pk_bf16(v1[2], v1[3]);
                        *(pg8::u32x4*)(rowp + bj * 128) = w; } } }
    }
};
struct SchedSq {
    int vcu, G; const char* a; const char* w; size_t astep, wstep;
    __device__ __forceinline__ bool next(int i, pg8::Unit& u) const {
        const int L = i * G + vcu; if (L >= 256) return false;
        u.kind = 0; u.pm = L >> 2; u.pn = L & 3; u.aux = 0; u.A = a + (size_t)u.pm * astep; u.B = w + (size_t)u.pn * wstep; return true;
    }
};
template <int GATED> struct EpiPle {
    static constexpr bool PERM = true;
    bf16* yp; const float* bg;
    __device__ __forceinline__ void operator()(const pg8::f32x4 (&acc)[2][2][4][2], const pg8::Unit& u, int wr, int wc, int fr, int fq) const {
        const int row0 = u.pm * 256 + wr * 64 + fr, col0 = u.pn * 256 + wc * 32 + 8 * fq;
#pragma unroll
        for (int ai = 0; ai < 2; ++ai)
#pragma unroll
            for (int m = 0; m < 4; ++m) { bf16* rowp = yp + (size_t)(row0 + ai * 128 + m * 16) * D + col0;
#pragma unroll
                for (int bj = 0; bj < 2; ++bj) { pg8::f32x4 v0 = acc[ai][bj][m][0], v1 = acc[ai][bj][m][1];
                    if (GATED) { const pg8::f32x4 b0 = *(const pg8::f32x4*)(bg + col0 + bj * 128), b1 = *(const pg8::f32x4*)(bg + col0 + bj * 128 + 4); const pg8::u32x4 y = *(const pg8::u32x4*)(rowp + bj * 128);
                        const float yf[8] = {bf2f((bf16)y.x), bf2f((bf16)(y.x >> 16)), bf2f((bf16)y.y), bf2f((bf16)(y.y >> 16)), bf2f((bf16)y.z), bf2f((bf16)(y.z >> 16)), bf2f((bf16)y.w), bf2f((bf16)(y.w >> 16))};
#pragma unroll
                        for (int e = 0; e < 4; ++e) { v0[e] = yf[e] / (1.f + __expf(-(v0[e] + b0[e]))); v1[e] = yf[4 + e] / (1.f + __expf(-(v1[e] + b1[e]))); } }
                    pg8::u32x4 w; w.x = pg8::cvt_pk_bf16(v0[0], v0[1]); w.y = pg8::cvt_pk_bf16(v0[2], v0[3]); w.z = pg8::cvt_pk_bf16(v1[0], v1[1]); w.w = pg8::cvt_pk_bf16(v1[2], v1[3]);
                    *(pg8::u32x4*)(rowp + bj * 128) = w; } }
    }
};
namespace att {
typedef float f32x16 __attribute__((ext_vector_type(16)));
constexpr int KSLOT = 8192, VSLOT = 16384, LDS_K = 0, LDS_V = 2 * KSLOT, ATT_LDS = 2 * KSLOT + 2 * VSLOT;
__device__ __forceinline__ bf16x8 pack8(const f32x16& p, int b) {
    v4u w; w.x = pg8::cvt_pk_bf16(p[b], p[b + 1]); w.y = pg8::cvt_pk_bf16(p[b + 2], p[b + 3]); w.z = pg8::cvt_pk_bf16(p[b + 4], p[b + 5]); w.w = pg8::cvt_pk_bf16(p[b + 6], p[b + 7]);
    return __builtin_bit_cast(bf16x8, w);
}
__device__ __forceinline__ void tile(LAS const unsigned char* ks, LAS const unsigned char* vs, const bf16x8 (&qf)[4], f32x16 (&o)[4], float& m, float& l, int r32, int hi) {
    f32x16 p0, p1;
#pragma unroll
    for (int r = 0; r < 16; ++r) { p0[r] = 0.f; p1[r] = 0.f; }
    LAS const unsigned char* kb = ks + hi * 1024 + r32 * 16;
#pragma unroll
    for (int kk = 0; kk < 4; ++kk) {
        const bf16x8 a0 = *(LAS const bf16x8*)(kb + kk * 2048), a1 = *(LAS const bf16x8*)(kb + kk * 2048 + 512);
        p0 = __builtin_amdgcn_mfma_f32_32x32x16_bf16(a0, qf[kk], p0, 0, 0, 0);
        p1 = __builtin_amdgcn_mfma_f32_32x32x16_bf16(a1, qf[kk], p1, 0, 0, 0);
    }
    __builtin_amdgcn_sched_barrier(0);
    float mx = fmaxf(p0[0], p1[0]);
#pragma unroll
    for (int r = 1; r < 16; ++r) mx = fmaxf(mx, fmaxf(p0[r], p1[r]));
    mx = fmaxf(mx, __shfl_xor(mx, 32));
    const float mn = fmaxf(m, mx);
    const float alpha = __builtin_amdgcn_exp2f(m - mn);
    m = mn;
    float ps = 0.f;
#pragma unroll
    for (int r = 0; r < 16; ++r) { p0[r] = __builtin_amdgcn_exp2f(p0[r] - mn); p1[r] = __builtin_amdgcn_exp2f(p1[r] - mn); ps += p0[r] + p1[r]; }
    l = l * alpha + ps;
#pragma unroll
    for (int db = 0; db < 4; ++db)
#pragma unroll
        for (int r = 0; r < 16; ++r) o[db][r] *= alpha;
    __builtin_amdgcn_sched_barrier(0);
    bf16x8 pf[4]; pf[0] = pack8(p0, 0); pf[1] = pack8(p0, 8); pf[2] = pack8(p1, 0); pf[3] = pack8(p1, 8);
    LAS const unsigned char* vb = vs + hi * 2048 + r32 * 16;
#pragma unroll
    for (int db = 0; db < 4; ++db) {
        bf16x8 va[4];
#pragma unroll
        for (int s = 0; s < 4; ++s) va[s] = *(LAS const bf16x8*)(vb + s * 4096 + db * 512);
#pragma unroll
        for (int s = 0; s < 4; ++s) o[db] = __builtin_amdgcn_mfma_f32_32x32x16_bf16(va[s], pf[s], o[db], 0, 0, 0);
        __builtin_amdgcn_sched_barrier(0);
    }
}
__device__ __forceinline__ void unit(LAS unsigned char* lds, int b, int h, int qb, const bf16* QKP, const bf16* UVT, float lam, float lam_init, const float* subg, bf16* MIXB, float* stash, int wave, int lane) {
    asm volatile("" : "+v"(lane));
    const int r32 = lane & 31, hi = lane >> 5;
    const size_t tok0 = (size_t)b * S;
    const size_t qtok = tok0 + qb * 256 + wave * 32 + r32;
#pragma unroll 1
    for (int c = 0; c < 2; ++c) {
        bf16x8 qf[4];
#pragma unroll
        for (int kk = 0; kk < 4; ++kk) qf[kk] = *(const GAS bf16x8*)(QKP + qtok * 1280 + h * 128 + c * 64 + kk * 16 + hi * 8);
        f32x16 o[4];
#pragma unroll
        for (int db = 0; db < 4; ++db)
#pragma unroll
            for (int r = 0; r < 16; ++r) o[db][r] = 0.f;
        float m = -INFINITY, l = 0.f;
        const bf16* ksrc = QKP + (tok0 + lane) * 1280 + 512 + h * 128 + c * 64 + wave * 8;
        const bf16* vsrc = UVT + (size_t)(768 + h * 128 + lane) * M + tok0 + wave * 8;
#define ATT_DMA(t, slot) do { \
            __builtin_amdgcn_global_load_lds((const unsigned*)(ksrc + (size_t)(t) * 64 * 1280), (LAS unsigned*)(lds + LDS_K + (slot) * KSLOT + wave * 1024), 16, 0, 0); \
            __builtin_amdgcn_global_load_lds((const unsigned*)(vsrc + (size_t)(t) * 64), (LAS unsigned*)(lds + LDS_V + (slot) * VSLOT + wave * 2048), 16, 0, 0); \
            __builtin_amdgcn_global_load_lds((const unsigned*)(vsrc + (size_t)64 * M + (size_t)(t) * 64), (LAS unsigned*)(lds + LDS_V + (slot) * VSLOT + wave * 2048 + 1024), 16, 0, 0); } while (0)
        asm volatile("s_waitcnt vmcnt(0) lgkmcnt(0)" ::: "memory"); __builtin_amdgcn_s_barrier();
        ATT_DMA(0, 0);
#pragma unroll 1
        for (int t = 0; t < S / 64; t += 2) {
            asm volatile("s_waitcnt vmcnt(0) lgkmcnt(0)" ::: "memory"); __builtin_amdgcn_s_barrier();
            ATT_DMA(t + 1, 1);
            tile(lds + LDS_K, lds + LDS_V, qf, o, m, l, r32, hi);
            asm volatile("s_waitcnt vmcnt(0) lgkmcnt(0)" ::: "memory"); __builtin_amdgcn_s_barrier();
            if (t + 2 < S / 64) ATT_DMA(t + 2, 0);
            tile(lds + LDS_K + KSLOT, lds + LDS_V + VSLOT, qf, o, m, l, r32, hi);
        }
#undef ATT_DMA
        const float lt = l + __shfl_xor(l, 32);
        if (c == 0) {
            const float i1 = 1.f / lt;
#pragma unroll
            for (int db = 0; db < 4; ++db)
#pragma unroll
                for (int g4 = 0; g4 < 4; ++g4) *(GAS f32x4*)(stash + ((db * 4 + g4) * 64 + lane) * 4) = (f32x4){o[db][4 * g4] * i1, o[db][4 * g4 + 1] * i1, o[db][4 * g4 + 2] * i1, o[db][4 * g4 + 3] * i1};
        } else {
            const float i2 = lam / lt;
            float ss = 0.f;
#pragma unroll
            for (int db = 0; db < 4; ++db)
#pragma unroll
                for (int g4 = 0; g4 < 4; ++g4) { const f32x4 s1 = *(const GAS f32x4*)(stash + ((db * 4 + g4) * 64 + lane) * 4);
#pragma unroll
                    for (int i = 0; i < 4; ++i) { const float v = s1[i] - o[db][4 * g4 + i] * i2; o[db][4 * g4 + i] = v; ss += v * v; } }
            ss += __shfl_xor(ss, 32);
            const float rs = (1.f - lam_init) / sqrtf(ss * (1.f / 128.f) + 1e-5f);
            bf16* orow = MIXB + qtok * D + 256 + h * 128;
#pragma unroll
            for (int db = 0; db < 4; ++db)
#pragma unroll
                for (int g4 = 0; g4 < 4; ++g4) { const int e = 32 * db + 8 * g4 + 4 * hi; const f32x4 gg = *(const GAS f32x4*)(subg + e);
                    const unsigned long long w = (unsigned long long)pg8::cvt_pk_bf16(o[db][4 * g4] * rs * gg.x, o[db][4 * g4 + 1] * rs * gg.y) | ((unsigned long long)pg8::cvt_pk_bf16(o[db][4 * g4 + 2] * rs * gg.z, o[db][4 * g4 + 3] * rs * gg.w) << 32);
                    *(GAS unsigned long long*)(orow + e) = w; }
        }
    }
}
}
namespace hy {
typedef float f32x16 __attribute__((ext_vector_type(16)));
constexpr int CPY = 16456;
constexpr int LDS_F = 0, LDS_VV = 4 * CPY, LDS_END = LDS_VV + 32768;
static_assert(LDS_VV % 16 == 0 && LDS_END <= 131072, "hyena LDS map");

__device__ __forceinline__ void filter_item(LAS unsigned char* lds, int pb, const float* fw1, const float* fb1, const float* fr1, const float* fw2, const float* fb2, const float* fr2,
                                            const float* fw3, bf16* KF, float* PS, int wave, int lane) {
    LAS bf16* tile = (LAS bf16*)lds;
    LAS float* za = (LAS float*)(lds + 65536) + wave * 512;
    LAS float* zb = (LAS float*)(lds + 81920) + wave * 512;
    LAS float* sqs = (LAS float*)(lds + 98304);
    const int p0 = pb * 64 + wave * 8;
    if (lane < 33) {
#pragma unroll 1
        for (int pi = 0; pi < 8; ++pi) { const int p = p0 + pi; float z;
            if (lane == 0) z = (float)p / (float)(S - 1);
            else { const int bi = (lane - 1) & 15; const float band = 1e-4f + (float)bi * ((15.0f - 1e-4f) / 15.0f), wpos = 2.0f * 3.14159265358979323846f * (float)p / (float)S;
                   z = lane <= 16 ? cosf(wpos * band) : -sinf(wpos * band); }
            za[pi * 64 + lane] = z; }
    }
    LDS_WAIT(); asm volatile("" ::: "memory");
    float acc8[8];
    { const float b1 = fb1[lane];
#pragma unroll
      for (int pi = 0; pi < 8; ++pi) acc8[pi] = b1;
#pragma unroll 1
      for (int i = 0; i < 33; ++i) { const float w = fw1[i * 64 + lane];
#pragma unroll
          for (int pi = 0; pi < 8; ++pi) acc8[pi] += za[pi * 64 + i] * w; }
      const float f1 = fr1[lane];
#pragma unroll
      for (int pi = 0; pi < 8; ++pi) zb[pi * 64 + lane] = sinf(f1 * acc8[pi]); }
    LDS_WAIT(); asm volatile("" ::: "memory");
    { const float b2 = fb2[lane];
#pragma unroll
      for (int pi = 0; pi < 8; ++pi) acc8[pi] = b2;
#pragma unroll 1
      for (int i = 0; i < 64; ++i) { const float w = fw2[i * 64 + lane];
#pragma unroll
          for (int pi = 0; pi < 8; ++pi) acc8[pi] += zb[pi * 64 + i] * w; }
      const float f2 = fr2[lane];
      LDS_WAIT(); asm volatile("" ::: "memory");
#pragma unroll
      for (int pi = 0; pi < 8; ++pi) za[pi * 64 + lane] = sinf(f2 * acc8[pi]); }
    LDS_WAIT(); asm volatile("" ::: "memory");
    const float mind = logf(1e-2f) / 1.5f, maxd = logf(1e-2f) / 0.3f;
#pragma unroll 1
    for (int qh = 0; qh < 2; ++qh) {
        float ac[8][4];
#pragma unroll
        for (int pi = 0; pi < 8; ++pi)
#pragma unroll
            for (int q = 0; q < 4; ++q) ac[pi][q] = 0.f;
#pragma unroll 1
        for (int i = 0; i < 64; ++i) { float w[4];
#pragma unroll
            for (int q = 0; q < 4; ++q) w[q] = fw3[i * 512 + lane + 64 * (qh * 4 + q)];
#pragma unroll
            for (int pi = 0; pi < 8; ++pi) { const float hv = za[pi * 64 + i];
#pragma unroll
                for (int q = 0; q < 4; ++q) ac[pi][q] += hv * w[q]; } }
#pragma unroll
        for (int q = 0; q < 4; ++q) { const int col = lane + 64 * (qh * 4 + q), ch = col & 255; const float delta = fabsf(mind + (float)ch * ((maxd - mind) / 255.0f)); float sq = 0.f;
#pragma unroll
            for (int pi = 0; pi < 8; ++pi) { const int p = p0 + pi; const float val = ac[pi][q] * expf(-((float)p / (float)(S - 1)) * delta);
                if (!(col >= 256 && p == 0)) sq += val * val;
                tile[col * 64 + wave * 8 + pi] = (bf16)f2bf(val); }
            sqs[wave * 512 + col] = sq; }
    }
    LDS_WAIT(); __syncthreads();
    { const int p = pb * 64 + lane;
#pragma unroll 1
      for (int cc = 0; cc < 64; ++cc) { const int col = wave * 64 + cc; const bf16 v = tile[col * 64 + lane];
          if (col < 256) KF[(size_t)col * 8192 + 4095 - p] = v; else if (p != 0) KF[(size_t)(col - 256) * 8192 + 4095 + p] = v; } }
    { const int t = threadIdx.x; float s = 0.f;
#pragma unroll
      for (int w = 0; w < 8; ++w) s += sqs[w * 512 + t];
      PS[(size_t)pb * 512 + t] = s;
      if (pb == 0 && t < 256) KF[(size_t)t * 8192 + 8191] = 0; }
    LDS_WAIT(); __syncthreads();
}

__device__ __forceinline__ float conv1(float um, float u0, float up, float w0, float w1, float w2, float cb) { return um * w0 + u0 * w1 + up * w2 + cb; }

__device__ __forceinline__ void unit(LAS unsigned char* lds, int c, const bf16* KF, const float* PS, const bf16* UVT, const float* cw, const float* cb, const float* bias_d, bf16* HT, int wave, int lane) {
    const int tid = wave * 64 + lane;
    { const bf16* src = KF + (size_t)c * 8192;
#pragma unroll
      for (int i = 0; i < 2; ++i) { const int ch = tid + 512 * i; *(LAS v4u*)(lds + LDS_F + ch * 16) = *(const GAS v4u*)(src + ch * 8); } }
    { const float w0v = cw[512 + c], w1v = cw[768 + 512 + c], w2v = cw[1536 + 512 + c], cbv = cb[512 + c], w0x = cw[256 + c], w1x = cw[768 + 256 + c], w2x = cw[1536 + 256 + c], cbx = cb[256 + c];
      const bf16* rv = UVT + (size_t)(512 + c) * M; const bf16* rx = UVT + (size_t)(256 + c) * M;
#pragma unroll 1
      for (int i = 0; i < 4; ++i) { const int q = tid + 512 * i, b = q >> 9, sc = q & 511, s0 = sc * 8; const size_t g0 = (size_t)b * S + s0;
          const v4u av = *(const GAS v4u*)(rv + g0), ax = *(const GAS v4u*)(rx + g0);
          float uv[10], ux[10];
          uv[0] = s0 > 0 ? bf2f(rv[g0 - 1]) : 0.f; ux[0] = s0 > 0 ? bf2f(rx[g0 - 1]) : 0.f; uv[9] = s0 + 8 < S ? bf2f(rv[g0 + 8]) : 0.f; ux[9] = s0 + 8 < S ? bf2f(rx[g0 + 8]) : 0.f;
#pragma unroll
          for (int e = 0; e < 4; ++e) { uv[1 + 2 * e] = bf2f((bf16)av[e]); uv[2 + 2 * e] = bf2f((bf16)(av[e] >> 16)); ux[1 + 2 * e] = bf2f((bf16)ax[e]); ux[2 + 2 * e] = bf2f((bf16)(ax[e] >> 16)); }
          float o[8];
#pragma unroll
          for (int e = 0; e < 8; ++e) o[e] = conv1(uv[e], uv[e + 1], uv[e + 2], w0v, w1v, w2v, cbv) * conv1(ux[e], ux[e + 1], ux[e + 2], w0x, w1x, w2x, cbx);
          v4u w; w.x = pk2(o[0], o[1]); w.y = pk2(o[2], o[3]); w.z = pk2(o[4], o[5]); w.w = pk2(o[6], o[7]);
          *(LAS v4u*)(lds + LDS_VV + (((sc & 7) * 64 + (sc >> 3)) * 4 + b) * 16) = w; } }
    LDS_WAIT(); __syncthreads();
    {
#pragma unroll 1
      for (int i = 0; i < 4; ++i) { const int y = tid + 512 * i;
          const unsigned long long w0 = *(LAS const unsigned long long*)(lds + LDS_F + y * 8), w1 = *(LAS const unsigned long long*)(lds + LDS_F + y * 8 + 8);
#pragma unroll
          for (int p = 1; p < 4; ++p) *(LAS unsigned long long*)(lds + LDS_F + p * CPY + y * 8) = (w0 >> (16 * p)) | (w1 << (64 - 16 * p)); } }
    const float nrm = 1.0f / sqrtf(wave_sum(PS[(size_t)lane * 512 + c] + PS[(size_t)lane * 512 + 256 + c]) + 1e-6f);
    LDS_WAIT(); __syncthreads();
    const int r32 = lane & 31, hi = lane >> 5, gp = wave & 3, half = wave >> 2, iloc = r32 >> 2, b = r32 & 3;
    f32x16 acc[2][2];
#pragma unroll
    for (int rho = 0; rho < 2; ++rho)
#pragma unroll
        for (int gg = 0; gg < 2; ++gg)
#pragma unroll
            for (int r = 0; r < 16; ++r) acc[rho][gg][r] = 0.f;
    const int dlo = 16 * gp - 63 + (half ? 40 : 0), dn = half ? 39 : 40;
    int pa = LDS_F + (3 - (r32 & 3)) * CPY + (4092 - 4 * (r32 >> 2) + 8 * hi) * 2 - 64 - 128 * dlo;
    int jb = 16 * gp + iloc - dlo;
    const int pbase = LDS_VV + hi * 4096 + b * 16;
#pragma unroll 1
    for (int dd = 0; dd < dn; ++dd) {
        const int j0 = jb, j1 = jb + 8; const bool v0 = (unsigned)j0 < 64u, v1 = (unsigned)j1 < 64u;
        LAS const unsigned char* ap = lds + pa; LAS const unsigned char* bp0 = lds + pbase + (v0 ? j0 : 0) * 64; LAS const unsigned char* bp1 = lds + pbase + (v1 ? j1 : 0) * 64;
#pragma unroll
        for (int k = 0; k < 4; ++k) {
            typedef unsigned long long u64;
            const u64 a00 = *(LAS const u64*)(ap + 64 + 32 * k), a01 = *(LAS const u64*)(ap + 64 + 32 * k + 8), a10 = *(LAS const u64*)(ap + 32 * k), a11 = *(LAS const u64*)(ap + 32 * k + 8);
            v4u b0 = *(LAS const v4u*)(bp0 + k * 8192), b1 = *(LAS const v4u*)(bp1 + k * 8192);
            if (!v0) b0 = (v4u){0u, 0u, 0u, 0u};
            if (!v1) b1 = (v4u){0u, 0u, 0u, 0u};
            const bf16x8 fa0 = __builtin_bit_cast(bf16x8, (v4u){(unsigned)a00, (unsigned)(a00 >> 32), (unsigned)a01, (unsigned)(a01 >> 32)});
            const bf16x8 fa1 = __builtin_bit_cast(bf16x8, (v4u){(unsigned)a10, (unsigned)(a10 >> 32), (unsigned)a11, (unsigned)(a11 >> 32)});
            const bf16x8 fb0 = __builtin_bit_cast(bf16x8, b0), fb1 = __builtin_bit_cast(bf16x8, b1);
            acc[0][0] = __builtin_amdgcn_mfma_f32_32x32x16_bf16(fa0, fb0, acc[0][0], 0, 0, 0);
            acc[0][1] = __builtin_amdgcn_mfma_f32_32x32x16_bf16(fa0, fb1, acc[0][1], 0, 0, 0);
            acc[1][0] = __builtin_amdgcn_mfma_f32_32x32x16_bf16(fa1, fb0, acc[1][0], 0, 0, 0);
            acc[1][1] = __builtin_amdgcn_mfma_f32_32x32x16_bf16(fa1, fb1, acc[1][1], 0, 0, 0);
        }
        pa -= 128; jb -= 1;
    }
    LDS_WAIT(); __syncthreads();
    { LAS float* xw = (LAS float*)(lds + LDS_F) + (gp * 2 + (half ? 0 : 1)) * 2048 + lane;
#pragma unroll
      for (int gg = 0; gg < 2; ++gg)
#pragma unroll
          for (int r = 0; r < 16; ++r) xw[(gg * 16 + r) * 64] = half ? acc[0][gg][r] : acc[1][gg][r]; }
    LDS_WAIT(); __syncthreads();
    f32x16 fin[2];
    { LAS const float* xr = (LAS const float*)(lds + LDS_F) + (gp * 2 + (half ? 1 : 0)) * 2048 + lane;
#pragma unroll
      for (int gg = 0; gg < 2; ++gg)
#pragma unroll
          for (int r = 0; r < 16; ++r) fin[gg][r] = (half ? acc[1][gg][r] : acc[0][gg][r]) + xr[(gg * 16 + r) * 64]; }
    { const float bd = bias_d[c], w0 = cw[c], w1 = cw[768 + c], w2 = cw[1536 + c], cb0 = cb[c]; const bf16* r0p = UVT + (size_t)c * M; bf16* hrow = HT + (size_t)c * M;
#pragma unroll
      for (int gg = 0; gg < 2; ++gg)
#pragma unroll
          for (int g4 = 0; g4 < 4; ++g4) { const int i = 16 * gp + 8 * gg + iloc, rr = 32 * half + 8 * g4 + 4 * hi, t0 = 64 * i + rr; const size_t tok = (size_t)b * S + t0;
              const unsigned long long vw = *(LAS const unsigned long long*)(lds + LDS_VV + (((rr >> 3) * 64 + i) * 4 + b) * 16 + (rr & 7) * 2);
              const unsigned long long uw = *(const GAS unsigned long long*)(r0p + tok);
              float u[6]; u[0] = t0 > 0 ? bf2f(r0p[tok - 1]) : 0.f; u[5] = t0 + 4 < S ? bf2f(r0p[tok + 4]) : 0.f;
              u[1] = bf2f((bf16)uw); u[2] = bf2f((bf16)(uw >> 16)); u[3] = bf2f((bf16)(uw >> 32)); u[4] = bf2f((bf16)(uw >> 48));
              float o[4];
#pragma unroll
              for (int e = 0; e < 4; ++e) { const float vv = bf2f((bf16)(vw >> (16 * e))); o[e] = (nrm * fin[gg][4 * g4 + e] + vv * bd) * conv1(u[e], u[e + 1], u[e + 2], w0, w1, w2, cb0); }
              *(GAS unsigned long long*)(hrow + tok) = (unsigned long long)pk2(o[0], o[1]) | ((unsigned long long)pk2(o[2], o[3]) << 32); } }
    LDS_WAIT(); __syncthreads();
}
__device__ __forceinline__ void transpose_slab(LAS unsigned char* lds, int slab, const bf16* HT, bf16* MIXB, int wave, int lane) {
    const int tid = wave * 64 + lane; LAS bf16* tile = (LAS bf16*)lds;
#pragma unroll 1
    for (int i = 0; i < 4; ++i) { const int q = tid + 512 * i, c = q >> 3, tc = q & 7; const v4u w = *(const GAS v4u*)(HT + (size_t)c * M + (size_t)slab * 64 + tc * 8);
#pragma unroll
        for (int e = 0; e < 4; ++e) { tile[(tc * 8 + 2 * e) * 264 + c] = (bf16)w[e]; tile[(tc * 8 + 2 * e + 1) * 264 + c] = (bf16)(w[e] >> 16); } }
    LDS_WAIT(); __syncthreads();
#pragma unroll 1
    for (int i = 0; i < 4; ++i) { const int q = tid + 512 * i, tk = q >> 5, cc = q & 31;
        *(GAS v4u*)(MIXB + ((size_t)slab * 64 + tk) * D + cc * 8) = *(LAS const v4u*)(lds + (tk * 264 + cc * 8) * 2); }
    LDS_WAIT(); __syncthreads();
}
}
#ifndef EN_HY
#define EN_HY 1
#endif
#ifndef EN_HYT
#define EN_HYT 1
#endif
#ifndef EN_PRO
#define EN_PRO 1
#endif
#ifndef EN_IN
#define EN_IN 1
#endif
#ifndef EN_ATT
#define EN_ATT 1
#endif
#ifndef EN_POOL
#define EN_POOL 1
#endif
#ifndef EN_OUT
#define EN_OUT 1
#endif
#ifndef EN_LN1
#define EN_LN1 1
#endif
#ifndef EN_WCV
#define EN_WCV 1
#endif
#ifndef EN_MOE1
#define EN_MOE1 1
#endif
#ifndef EN_MOE2
#define EN_MOE2 1
#endif
#ifndef EN_LN2
#define EN_LN2 1
#endif
constexpr int RING_BYTES = 131072;
constexpr int LDSCTL_OFF = RING_BYTES, MISC_OFF = LDSCTL_OFF + 320, MOETAB_OFF = LDSCTL_OFF + 1024;
constexpr int LDS_BYTES = 147456;

struct Args { const float* in[38]; float* out; unsigned char* ws; int* eid; float* wts; int ph_lo, ph_hi, l_lo, l_hi, single, pad; };
enum { PH_PRO = 0, PH_IN = 1, PH_ATT = 2, PH_POOL = 3, PH_OUT = 4, PH_LN1 = 5, PH_WCV = 6, PH_MOE1 = 7, PH_MOE2 = 8, PH_LN2 = 9, PH_HY = 10, PH_HYT = 11, PH_END = 12 };

__global__ void __launch_bounds__(NWAVES * 64, 2) mk_fwd(Args a) {
    extern __shared__ __attribute__((aligned(16))) unsigned char lds_raw[];
    LAS unsigned char* lds = (LAS unsigned char*)lds_raw;
    volatile LAS unsigned* MISC = (volatile LAS unsigned*)(lds + MISC_OFF);
    const int tid = threadIdx.x, lane0 = tid & 63, wave = __builtin_amdgcn_readfirstlane(tid >> 6);
    const int G = gridDim.x, bx = blockIdx.x, vcu = (G % 8 == 0) ? (bx % 8) * (G / 8) + bx / 8 : bx;
    gu32* ctl0 = (gu32*)(a.ws + WS_CTL);
    for (int u = tid; u < (LDS_BYTES - LDSCTL_OFF) / 4; u += NWAVES * 64) ((LAS unsigned*)(lds + LDSCTL_OFF))[u] = 0u;
    __syncthreads();
    XcdBarrier bar; bar.bar = (unsigned*)(ctl0 + CW_BAR); bar.x = 0; bar.st = nullptr;
    if (!a.single) bar = xcd_barrier_post((unsigned*)(ctl0 + CW_BAR), MISC + 8);
#define IN(k) (a.ph_lo <= (k) && (k) < a.ph_hi)
#define SEAM() do { if (!a.single) xcd_barrier(bar); } while (0)
    const int gw = vcu * NWAVES + wave, NGW = G * NWAVES;
#define PHASE_PTRS() int lane = lane0; asm volatile("" : "+v"(lane)); unsigned char* ws = a.ws; gu32* ctl = (gu32*)(ws + WS_CTL); (void)ctl; \
    float* X = (float*)(ws + WS_X); bf16* XB = (bf16*)(ws + WS_XB); bf16* QKP = (bf16*)(ws + WS_QKP); bf16* UVT = (bf16*)(ws + WS_UVT); float* CS = (float*)(ws + WS_CS); bf16* MIXB = (bf16*)(ws + WS_MIXB); \
    (void)X; (void)XB; (void)QKP; (void)UVT; (void)CS; (void)MIXB
#define INP(k) (a.in[k])

    if (EN_PRO && IN(PH_PRO)) {
            PHASE_PTRS();
        LAS float* scr = (LAS float*)(lds + wave * 16384);
        for (int it = gw; it < DEPTH * (16 * 72 + 16 * 32); it += NGW) {
            const int l = it / 1664, r = it % 1664; const float* src; int N, k0, n0; bf16* dst;
            if (r < 1152) { const int kb = r / 72, nb = r % 72; n0 = nb * 32; k0 = kb * 64; N = INW; src = INP(4) + (size_t)l * D * INW;
                bf16* wsw = (bf16*)(ws + WS_WIN + (size_t)l * WIN_LAYER); bf16* wnm = wsw + 1280 * 1024;
                dst = n0 < 768 ? wsw + (size_t)n0 * D : (n0 < 1792 ? wnm + (size_t)(n0 - 768) * D : wsw + (size_t)(768 + n0 - 1792) * D); }
            else { const int q = r - 1152, kb = q >> 5, nb = q & 31; n0 = nb * 32; k0 = kb * 64; N = D; src = INP(23) + (size_t)l * D * D; dst = (bf16*)(ws + WS_WOUT + (size_t)l * WOUT_LAYER) + (size_t)n0 * D; }
            p0_transpose_block(src, D, N, k0, n0, dst, 0, scr, lane);
        }
        for (int it = gw; it < DEPTH * 4 * 16 * 2; it += NGW) {
            const int l = it >> 7, g = (it >> 5) & 3, dh = (it >> 4) & 1, k = (it & 15) * 64 + lane;
            const float* wrow = INP(4) + (size_t)l * D * INW + (size_t)k * INW + 2304 + g * 64;
            const float* pw = INP(20) + (size_t)(l * 4 + g) * 64 * 64 + dh * 32;
            float acc[32];
#pragma unroll
            for (int d = 0; d < 32; ++d) acc[d] = 0.f;
#pragma unroll 1
            for (int c = 0; c < 64; ++c) { const float x = wrow[c];
#pragma unroll
                for (int d = 0; d < 32; ++d) acc[d] += x * pw[c * 64 + d]; }
            bf16* dst = (bf16*)(ws + WS_WIN + (size_t)l * WIN_LAYER) + (size_t)(1280 + 1024 + g * 64 + dh * 32) * D + k;
#pragma unroll
            for (int d = 0; d < 32; ++d) dst[(size_t)d * D] = (bf16)f2bf(acc[d]);
        }
        int ln2 = lane; asm volatile("" : "+v"(ln2));
        for (int i = gw * 64 + ln2; i < S * 8; i += NGW * 64) { const int pos = i >> 3, j = i & 7; const float ang = (float)pos * powf(500000.0f, -(float)(2 * j) / 16.0f);
            CS[pos * 16 + j] = cosf(ang); CS[pos * 16 + 8 + j] = sinf(ang); }
        for (int m = gw; m < M; m += NGW) ln_row(INP(0) + (size_t)m * D, 1.f, nullptr, nullptr, nullptr, INP(2), INP(3), X + (size_t)m * D, XB + (size_t)m * D, lane);
        LDS_WAIT(); __syncthreads();
        for (int it = vcu; it < DEPTH * 64; it += G) { const int fl = it >> 6, pb = it & 63;
            hy::filter_item(lds, pb, INP(7) + fl * 33 * 64, INP(8) + fl * 64, INP(9) + fl * 64, INP(10) + fl * 64 * 64, INP(11) + fl * 64, INP(12) + fl * 64, INP(13) + fl * 64 * 512,
                            (bf16*)(ws + WS_KF) + (size_t)fl * 256 * 8192, (float*)(ws + WS_PS) + (size_t)fl * 64 * 512, wave, lane); }
        SEAM();
    }
    for (int l = a.l_lo; l < a.l_hi; ++l) {
        if (EN_IN && IN(PH_IN)) {
            PHASE_PTRS();
            const char* wsw = (const char*)(ws + WS_WIN + (size_t)l * WIN_LAYER);
            SchedIn Sc{vcu, G, (const char*)XB, wsw, wsw + (size_t)1280 * 1024 * 2};
            EpiIn E{QKP, UVT, CS};
            pg8::gemm_phase<EpiIn, SchedIn>(lds, D, Sc, E);
            SEAM();
        }
        if (EN_HY && IN(PH_HY)) {
            PHASE_PTRS();
            for (int c = vcu; c < 256; c += G)
                hy::unit(lds, c, (const bf16*)(ws + WS_KF) + (size_t)l * 256 * 8192, (const float*)(ws + WS_PS) + (size_t)l * 64 * 512, UVT, INP(5) + l * 3 * 768, INP(6) + l * 768, INP(14) + l * 256, (bf16*)(ws + WS_HT), wave, lane);
            SEAM();
        }
        if (EN_HYT && IN(PH_HYT)) {
            PHASE_PTRS();
            for (int s = vcu; s < 256; s += G) hy::transpose_slab(lds, s, (const bf16*)(ws + WS_HT), MIXB, wave, lane);
            SEAM();
        }
        if (EN_ATT && IN(PH_ATT)) {
            PHASE_PTRS();
            const float lam_init = 0.8f - 0.6f * expf(-0.3f * (float)l);
            int ln = lane; asm volatile("" : "+v"(ln));
            const float lam = expf(wave_sum(INP(15)[l * 64 + ln] * INP(16)[l * 64 + ln])) - expf(wave_sum(INP(17)[l * 64 + ln] * INP(18)[l * 64 + ln])) + lam_init;
            for (int u = vcu; u < 256; u += G) att::unit(lds, (u >> 4) >> 2, (u >> 4) & 3, u & 15, QKP, UVT, lam, lam_init, INP(19) + l * 128, MIXB, (float*)(ws + WS_STASH) + ((size_t)u * 8 + wave) * 4096, wave, lane);
            SEAM();
        }
        if (EN_POOL && IN(PH_POOL)) {
            PHASE_PTRS();
            int ln = lane; asm volatile("" : "+v"(ln));
            const int cc = (ln & 31) * 8, gq = cc >> 6, hw = 1 << gq;
            const float* pb = INP(21) + l * 256 + cc; const float* psc = INP(22) + l * 256 + cc;
            for (int it = gw; it < M / 2; it += NGW) {
                const int tok = it * 2 + (ln >> 5), pos = tok & (S - 1);
                int lo = pos - hw, hi2 = pos + hw - 1; lo = lo < 0 ? 0 : lo; hi2 = hi2 > S - 1 ? S - 1 : hi2;
                float sacc[8];
#pragma unroll
                for (int e = 0; e < 8; ++e) sacc[e] = 0.f;
                const bf16* zp = QKP + (size_t)(tok - pos) * 1280 + 1024 + cc;
                for (int r = lo; r <= hi2; ++r) { const v4u w = *(const GAS v4u*)(zp + (size_t)r * 1280);
                    sacc[0] += bf2f((bf16)w.x); sacc[1] += bf2f((bf16)(w.x >> 16)); sacc[2] += bf2f((bf16)w.y); sacc[3] += bf2f((bf16)(w.y >> 16));
                    sacc[4] += bf2f((bf16)w.z); sacc[5] += bf2f((bf16)(w.z >> 16)); sacc[6] += bf2f((bf16)w.w); sacc[7] += bf2f((bf16)(w.w >> 16)); }
                const float inv = 1.f / (float)(hi2 - lo + 1);
                const v4u w = *(const GAS v4u*)(zp + (size_t)pos * 1280);
                float z[8] = {bf2f((bf16)w.x), bf2f((bf16)(w.x >> 16)), bf2f((bf16)w.y), bf2f((bf16)(w.y >> 16)), bf2f((bf16)w.z), bf2f((bf16)(w.z >> 16)), bf2f((bf16)w.w), bf2f((bf16)(w.w >> 16))};
                float y[8];
#pragma unroll
                for (int e = 0; e < 8; ++e) y[e] = (sacc[e] * inv - z[e] + pb[e]) * psc[e];
                v4u o; o.x = pk2(y[0], y[1]); o.y = pk2(y[2], y[3]); o.z = pk2(y[4], y[5]); o.w = pk2(y[6], y[7]);
                *(GAS v4u*)(MIXB + (size_t)tok * D + 768 + cc) = o;
            }
            SEAM();
        }
        if (EN_OUT && IN(PH_OUT)) {
            PHASE_PTRS();
            SchedOut Sc{vcu, G, (const char*)MIXB, (const char*)(ws + WS_WOUT + (size_t)l * WOUT_LAYER)};
            EpiRes E{X};
            pg8::gemm_phase<EpiRes, SchedOut>(lds, D, Sc, E);
            SEAM();
        }
        if (EN_LN1 && IN(PH_LN1)) {
            PHASE_PTRS();
            int ln = lane; asm volatile("" : "+v"(ln));
            for (int m = gw; m < M; m += NGW)
                ln1_router_row(X + (size_t)m * D, XB + (size_t)m * D, INP(24) + l * D, INP(25) + l * D, INP(26) + (size_t)l * D * 4, INP(27) + l * 4, INP(28) + (size_t)l * D * 16, INP(29) + l * 16,
                               m, a.eid, a.wts, (unsigned*)(ctl + CW_CNT + l * 16), (int*)(ws + WS_TOKIDX), (float*)(ws + WS_GATE), ln);
            SEAM();
        }
        if (EN_WCV && IN(PH_WCV)) {
            PHASE_PTRS();
            LAS float* scr = (LAS float*)(lds + wave * 16384);
            bf16* W13 = (bf16*)(ws + WS_W13); bf16* W2 = (bf16*)(ws + WS_W2); bf16* WG = (bf16*)(ws + WS_WG); bf16* WP = (bf16*)(ws + WS_WP);
            for (int it = gw; it < 6784; it += NGW) {
                const float* src; int K, N, k0, n0, mode = 0; bf16* dst;
                if (it < 4096) { const int which = it >> 11, r = it & 2047, e = r >> 7, kb = (r >> 3) & 15, nb = r & 7;
                    src = INP(which ? 31 : 30) + ((size_t)l * 16 + e) * D * 256; K = D; N = 256; k0 = kb * 64; n0 = nb * 32; mode = 1 + which; dst = W13 + (size_t)e * 512 * D;
                } else if (it < 6144) { const int r = it - 4096, e = r >> 7, kb = (r >> 5) & 3, nb = r & 31;
                    src = INP(32) + ((size_t)l * 16 + e) * 256 * D; K = 256; N = D; k0 = kb * 64; n0 = nb * 32; dst = W2 + (size_t)e * D * 256 + (size_t)n0 * 256;
                } else if (it < 6656) { const int r = it - 6144, kb = r >> 5, nb = r & 31;
                    src = INP(33) + (size_t)l * D * D; K = D; N = D; k0 = kb * 64; n0 = nb * 32; dst = WG + (size_t)n0 * D;
                } else { const int r = it - 6656, kb = r >> 5, nb = r & 31;
                    src = INP(35) + (size_t)l * 256 * D; K = 256; N = D; k0 = kb * 64; n0 = nb * 32; dst = WP + (size_t)n0 * 256; }
                p0_transpose_block(src, K, N, k0, n0, dst, mode, scr, lane);
            }
            int ln = lane; asm volatile("" : "+v"(ln));
            const float* ps = INP(1) + (size_t)l * M * 256; bf16* PB = (bf16*)(ws + WS_PB);
            for (size_t i = ((size_t)gw * 64 + ln) * 8; i < (size_t)M * 256; i += (size_t)NGW * 64 * 8) { const f32x4 x0 = *(const GAS f32x4*)(ps + i), x1 = *(const GAS f32x4*)(ps + i + 4);
                v4u o; o.x = pk2(x0.x, x0.y); o.y = pk2(x0.z, x0.w); o.z = pk2(x1.x, x1.y); o.w = pk2(x1.z, x1.w); *(GAS v4u*)(PB + i) = o; }
            SEAM();
        }
        if (EN_MOE1 && IN(PH_MOE1)) {
            PHASE_PTRS();
            moe_tab_build((LAS int*)(lds + MOETAB_OFF), ctl + CW_CNT + l * 16); const MoeTab T{(LAS const int*)(lds + MOETAB_OFF)};
            { SchedMoe<2> Sc{vcu, G, T, (const char*)XB, (const char*)(ws + WS_W13), (size_t)512 * D * 2, (const int*)(ws + WS_TOKIDX), 0};
              EpiMoe1 E{(bf16*)(ws + WS_ACT), (const float*)(ws + WS_GATE), T};
              pg8::gemm_phase<EpiMoe1, SchedMoe<2>, true>(lds, D, Sc, E); }
            { SchedSq Sc{vcu, G, (const char*)(ws + WS_PB), (const char*)(ws + WS_WP), (size_t)256 * 256 * 2, (size_t)256 * 256 * 2};
              EpiPle<0> E{(bf16*)(ws + WS_YP), nullptr};
              pg8::gemm_phase<EpiPle<0>, SchedSq>(lds, 256, Sc, E); }
            { SchedSq Sc{vcu, G, (const char*)XB, (const char*)(ws + WS_WG), TILEB, TILEB};
              EpiPle<1> E{(bf16*)(ws + WS_YP), INP(34) + l * D};
              pg8::gemm_phase<EpiPle<1>, SchedSq>(lds, D, Sc, E); }
            SEAM();
        }
        if (EN_MOE2 && IN(PH_MOE2)) {
            PHASE_PTRS();
            moe_tab_build((LAS int*)(lds + MOETAB_OFF), ctl + CW_CNT + l * 16); const MoeTab T{(LAS const int*)(lds + MOETAB_OFF)};
            SchedMoe<4> Sc{vcu, G, T, (const char*)(ws + WS_ACT), (const char*)(ws + WS_W2), (size_t)D * 256 * 2, (const int*)(ws + WS_TOKIDX), (size_t)256 * 256 * 2};
            EpiMoe2 E{(bf16*)(ws + WS_YMOE), (const int*)(ws + WS_TOKIDX), T};
            pg8::gemm_phase<EpiMoe2, SchedMoe<4>>(lds, 256, Sc, E);
            SEAM();
        }
        if (EN_LN2 && IN(PH_LN2)) {
            PHASE_PTRS();
            int ln = lane; asm volatile("" : "+v"(ln));
            const bf16* YM = (const bf16*)(ws + WS_YMOE); const bf16* YP = (const bf16*)(ws + WS_YP);
            const bool lastl = (l == DEPTH - 1);
            for (int m = gw; m < M; m += NGW)
                ln_row(X + (size_t)m * D, DN_ALPHA, YM + (size_t)(2 * m) * D, YM + (size_t)(2 * m + 1) * D, YP + (size_t)m * D, INP(36) + l * D, INP(37) + l * D,
                       lastl ? a.out + (size_t)m * D : X + (size_t)m * D, lastl ? nullptr : XB + (size_t)m * D, ln);
            SEAM();
        }
    }
#undef IN
#undef SEAM
}
static void mk_launch(const Args& base, int ph, int l, int grid, hipStream_t stream) {
    Args a = base; a.ph_lo = ph; a.ph_hi = ph + 1; a.l_lo = l; a.l_hi = l + 1; a.single = 1;
    hipLaunchKernelGGL(mk_fwd, dim3(grid), dim3(NWAVES * 64), LDS_BYTES, stream, a);
}
extern "C" void kernel_launch(void* const* d_in, const int* in_sizes, int n_in, void* d_out, int out_size, void* d_ws, size_t ws_size, hipStream_t stream) {
    (void)in_sizes; (void)n_in; (void)out_size; (void)ws_size;
    static int grid = 0;
    if (grid == 0) {
        int dev = 0, cus = 0;
        if (hipGetDevice(&dev) != hipSuccess || hipDeviceGetAttribute(&cus, hipDeviceAttributeMultiprocessorCount, dev) != hipSuccess) { grid = -1; return; }
        if (hipFuncSetAttribute((const void*)mk_fwd, hipFuncAttributeMaxDynamicSharedMemorySize, LDS_BYTES) != hipSuccess) { grid = -1; return; }
        (void)hipGetLastError();
        grid = cus;
    }
    if (grid < 0) return;
    (void)hipMemsetAsync((char*)d_ws + WS_CTL, 0, CTL_ZERO_BYTES, stream);
    Args base{};
    for (int i = 0; i < 38; ++i) base.in[i] = (const float*)d_in[i];
    base.out = (float*)d_out; base.ws = (unsigned char*)d_ws;
    base.eid = nullptr; base.wts = nullptr;
#if defined(MK_PER_PHASE)
    mk_launch(base, PH_PRO, 0, grid, stream);
    for (int l = 0; l < DEPTH; ++l) for (int ph : {PH_IN, PH_HY, PH_HYT, PH_ATT, PH_POOL, PH_OUT, PH_LN1, PH_WCV, PH_MOE1, PH_MOE2, PH_LN2}) mk_launch(base, ph, l, grid, stream);
#else
    Args a = base; a.ph_lo = 0; a.ph_hi = PH_END; a.l_lo = 0; a.l_hi = DEPTH; a.single = 0;
    hipLaunchKernelGGL(mk_fwd, dim3(grid), dim3(NWAVES * 64), LDS_BYTES, stream, a);
#endif
}
```

```cpp
#include <hip/hip_runtime.h>
#include <stdint.h>
#include <math.h>
namespace pg8 {
#define PG8_LAS __attribute__((address_space(3)))
typedef unsigned short bf16_t;
typedef short bf16x8 __attribute__((ext_vector_type(8)));
typedef float f32x4 __attribute__((ext_vector_type(4)));
typedef unsigned u32x4 __attribute__((ext_vector_type(4)));
constexpr int BM = 256, BK = 64, HALF = 128, HTB = HALF * BK * 2  , STAGE_BYTES = 8 * HTB;

__host__ __device__ __forceinline__ int lds_byte(int r, int c) { const int st = (r >> 4) * 2 + (c >> 5), rr = r & 15, cc = c & 31, ob = rr * 64 + cc * 2; return st * 1024 + (ob ^ (((ob >> 9) & 1) << 5)); }
__host__ __device__ __forceinline__ void stage_rc(int b, int& R, int& C) { const int st = b / 1024, sb = b % 1024, swz = sb ^ (((sb >> 9) & 1) << 5); R = (st >> 1) * 16 + swz / 64; C = (st & 1) * 32 + (swz % 64) / 2; }
__host__ __device__ __forceinline__ int perm32(int rho) { const int n = rho >> 4, i = rho & 15; return 8 * (i >> 2) + 4 * n + (i & 3); }

struct Unit { const char* A; const char* B; int kind, pm, pn, aux; };

__device__ __forceinline__ unsigned cvt_pk_bf16(float lo, float hi) { unsigned r; asm volatile("v_cvt_pk_bf16_f32 %0, %1, %2" : "=v"(r) : "v"(lo), "v"(hi)); return r; }

template <class Epi, class Sched, bool GATHER = false>
__device__ __forceinline__ void gemm_phase(PG8_LAS unsigned char* lds, const int K_, const Sched& S, const Epi& E) {
    int K = K_; asm volatile("" : "+s"(K));
    int tid_ = threadIdx.x; asm volatile("" : "+v"(tid_));
    const int tid = tid_, wid = __builtin_amdgcn_readfirstlane(tid >> 6), lane = tid & 63, wr = wid >> 2, wc = wid & 3, fr = lane & 15, fq = lane >> 4;
    const int nt = K / BK;
    unsigned voffA[2][2], voffN[2][2] = {{0u, 0u}, {0u, 0u}}, voffB[2]; int RA[2], CA[2];
#pragma unroll
    for (int i = 0; i < 2; ++i) { int R, C; stage_rc(tid * 16 + i * 8192, R, C); const int Rb = Epi::PERM ? ((R & ~31) + perm32(R & 31)) : R; RA[i] = R; CA[i] = C;
        voffA[0][i] = (unsigned)(R * K + C) * 2u; voffA[1][i] = (unsigned)((R + HALF) * K + C) * 2u; voffB[i] = (unsigned)(Rb * K + C) * 2u; }
    const size_t kstep = (size_t)(BK * 2);
    const size_t hstep = (size_t)HALF * K * 2;
    const unsigned ldsw = (unsigned)wid * 1024u;
    const int aoff = lds_byte(wr * 64 + fr, fq * 8), boff = lds_byte(wc * 32 + fr, fq * 8);
#define PG8_SA(b, h) (((b) * 2 + (h)) * HTB)
#define PG8_SB(b, h) ((4 + (b) * 2 + (h)) * HTB)
#define PG8_STAGE(bufoff, gbase, voff) do { _Pragma("unroll") for (int _i = 0; _i < 2; ++_i) \
        __builtin_amdgcn_global_load_lds((const unsigned*)((const char*)(gbase) + (voff)[_i]), (PG8_LAS unsigned*)(lds + (bufoff) + ldsw + _i * 8192), 16, 0, 0); } while (0)
#define PG8_LDA(dst, b, h) do { _Pragma("unroll") for (int m = 0; m < 4; ++m) _Pragma("unroll") for (int k = 0; k < 2; ++k) dst[m][k] = *(const PG8_LAS bf16x8*)(lds + PG8_SA(b, h) + aoff + m * 2048 + k * 1024); } while (0)
#define PG8_LDB(dst, b, h) do { _Pragma("unroll") for (int n = 0; n < 2; ++n) _Pragma("unroll") for (int k = 0; k < 2; ++k) dst[n][k] = *(const PG8_LAS bf16x8*)(lds + PG8_SB(b, h) + boff + n * 2048 + k * 1024); } while (0)
#define PG8_MMA(ai, bj, At, Bt) do { __builtin_amdgcn_s_setprio(1); _Pragma("unroll") for (int m = 0; m < 4; ++m) _Pragma("unroll") for (int n = 0; n < 2; ++n) _Pragma("unroll") for (int k = 0; k < 2; ++k) \
        acc[ai][bj][m][n] = __builtin_amdgcn_mfma_f32_16x16x32_bf16(Bt[n][k], At[m][k], acc[ai][bj][m][n], 0, 0, 0); __builtin_amdgcn_s_setprio(0); } while (0)
#define PG8_WAIT_V(n) asm volatile("s_waitcnt vmcnt(" #n ")" ::: "memory")
#define PG8_WAIT_L(n) asm volatile("s_waitcnt lgkmcnt(" #n ")" ::: "memory")
#define PG8_BAR __builtin_amdgcn_s_barrier()
#define PG8_SCHED __builtin_amdgcn_sched_barrier(0)
    Unit cur, nxt; int ui = 0;
    if (!S.next(0, cur)) return;
    if constexpr (GATHER) {
#pragma unroll
        for (int h = 0; h < 2; ++h)
#pragma unroll
            for (int i = 0; i < 2; ++i) voffA[h][i] = (unsigned)(S.arow(cur, h * HALF + RA[i]) * K + CA[i]) * 2u;
    }
    f32x4 acc[2][2][4][2];
#pragma unroll
    for (int a = 0; a < 2; ++a)
#pragma unroll
        for (int b = 0; b < 2; ++b)
#pragma unroll
            for (int m = 0; m < 4; ++m)
#pragma unroll
                for (int n = 0; n < 2; ++n) acc[a][b][m][n] = (f32x4){0.f, 0.f, 0.f, 0.f};
    bf16x8 At[4][2], B0[2][2], B1[2][2];
    const char* cA = cur.A; const char* cB = cur.B;
    PG8_STAGE(PG8_SB(0, 0), cB, voffB); PG8_STAGE(PG8_SB(0, 1), cB + hstep, voffB); PG8_STAGE(PG8_SA(0, 0), cA, voffA[0]); PG8_STAGE(PG8_SA(0, 1), cA, voffA[1]);
    if (wr == 1) PG8_BAR;
    PG8_WAIT_V(2); PG8_BAR;
    PG8_STAGE(PG8_SB(1, 0), cB + kstep, voffB); PG8_STAGE(PG8_SA(1, 0), cA + kstep, voffA[0]); PG8_STAGE(PG8_SB(1, 1), cB + hstep + kstep, voffB);
    PG8_WAIT_V(6); PG8_BAR;
    for (;;) {
        const bool has_next = S.next(ui + 1, nxt);
        const char* nA = has_next ? nxt.A : cA; const char* nB = has_next ? nxt.B : cB;
        if constexpr (GATHER) {
#pragma unroll
            for (int h = 0; h < 2; ++h)
#pragma unroll
                for (int i = 0; i < 2; ++i) voffN[h][i] = has_next ? (unsigned)(S.arow(nxt, h * HALF + RA[i]) * K + CA[i]) * 2u : voffA[h][i];
        }
#pragma unroll 1
        for (int t = 0; t < nt; t += 2) {
            const bool last = (t == nt - 2);
            const char* a1 = cA + (size_t)(t + 1) * kstep;
            const char* a2 = last ? nA : cA + (size_t)(t + 2) * kstep; const char* b2 = last ? nB : cB + (size_t)(t + 2) * kstep;
            const char* a3 = a2 + kstep; const char* b3 = b2 + kstep;
            PG8_LDB(B0, 0, 0); PG8_LDB(B1, 0, 1); PG8_SCHED; PG8_LDA(At, 0, 0); PG8_STAGE(PG8_SA(1, 1), a1, voffA[1]);
            if constexpr (GATHER) { if (last) {
#pragma unroll
                for (int h = 0; h < 2; ++h)
#pragma unroll
                    for (int i = 0; i < 2; ++i) voffA[h][i] = voffN[h][i]; } }
            PG8_WAIT_V(8); PG8_WAIT_L(0); PG8_BAR; PG8_MMA(0, 0, At, B0); PG8_MMA(0, 1, At, B1); PG8_BAR; PG8_SCHED;
            PG8_LDA(At, 0, 1); PG8_STAGE(PG8_SB(0, 0), b2, voffB); PG8_STAGE(PG8_SB(0, 1), b2 + hstep, voffB); PG8_STAGE(PG8_SA(0, 0), a2, voffA[0]);
            PG8_WAIT_V(8); PG8_WAIT_L(0); PG8_BAR; PG8_MMA(1, 0, At, B0); PG8_MMA(1, 1, At, B1); PG8_BAR; PG8_SCHED;
            PG8_LDB(B0, 1, 0); PG8_LDB(B1, 1, 1); PG8_SCHED; PG8_LDA(At, 1, 0); PG8_STAGE(PG8_SA(0, 1), a2, voffA[1]);
            PG8_WAIT_V(8); PG8_WAIT_L(0); PG8_BAR; PG8_MMA(0, 0, At, B0); PG8_MMA(0, 1, At, B1); PG8_BAR; PG8_SCHED;
            PG8_LDA(At, 1, 1); PG8_STAGE(PG8_SB(1, 0), b3, voffB); PG8_STAGE(PG8_SB(1, 1), b3 + hstep, voffB); PG8_STAGE(PG8_SA(1, 0), a3, voffA[0]);
            PG8_WAIT_V(8); PG8_WAIT_L(0); PG8_BAR; PG8_MMA(1, 0, At, B0); PG8_MMA(1, 1, At, B1); PG8_BAR; PG8_SCHED;
        }
        if (wr == 0) PG8_BAR;
        { Unit ce = cur; ce.pm = __builtin_amdgcn_readfirstlane(cur.pm); ce.pn = __builtin_amdgcn_readfirstlane(cur.pn); ce.kind = __builtin_amdgcn_readfirstlane(cur.kind); ce.aux = __builtin_amdgcn_readfirstlane(cur.aux); int fr_ = fr, fq_ = fq;
          asm volatile("" : "+s"(ce.pm), "+s"(ce.pn), "+s"(ce.kind), "+s"(ce.aux), "+v"(fr_), "+v"(fq_));
          E(acc, ce, wr, wc, fr_, fq_); }
        if (!has_next) break;
#pragma unroll
        for (int a = 0; a < 2; ++a)
#pragma unroll
            for (int b = 0; b < 2; ++b)
#pragma unroll
                for (int m = 0; m < 4; ++m)
#pragma unroll
                    for (int n = 0; n < 2; ++n) acc[a][b][m][n] = (f32x4){0.f, 0.f, 0.f, 0.f};
        cur = nxt; cA = nA; cB = nB; ++ui;
        if (wr == 1) PG8_BAR;
    }
    PG8_WAIT_V(0);
    PG8_BAR;
#undef PG8_SA
#undef PG8_SB
#undef PG8_STAGE
#undef PG8_LDA
#undef PG8_LDB
#undef PG8_MMA
#undef PG8_WAIT_V
#undef PG8_WAIT_L
#undef PG8_BAR
#undef PG8_SCHED
}
}
constexpr int D = 1024, NB = 4, S = 4096, M = NB * S, DEPTH = 4, INW = 2560;
constexpr float DN_ALPHA = 1.681792830507429f;
constexpr float QSCALE = 0.125f * 1.4426950408889634f;
constexpr int NWAVES = 8;
constexpr size_t MiB = 1u << 20;
constexpr size_t TILEB = (size_t)256 * D * 2;
constexpr size_t WS_CTL = 0, CTL_ZERO_BYTES = 1 * MiB;
constexpr size_t WS_CS = 1 * MiB;
constexpr size_t WS_WIN = 2 * MiB, WIN_LAYER = 5 * MiB;
constexpr size_t WS_X = 22 * MiB;
constexpr size_t WS_XB = 86 * MiB;
constexpr size_t WS_QKP = 118 * MiB;
constexpr size_t WS_UVT = 158 * MiB;
constexpr size_t WS_MIXB = 198 * MiB;
constexpr size_t WS_STASH = WS_XB;
constexpr size_t WS_WOUT = 383 * MiB, WOUT_LAYER = 2 * MiB;
constexpr size_t WS_TOKIDX = 391 * MiB, WS_GATE = 392 * MiB;
constexpr size_t WS_YMOE = WS_QKP;
constexpr size_t WS_YP = WS_MIXB;
constexpr size_t WS_ACT = 230 * MiB;
constexpr size_t WS_PB = 248 * MiB;
constexpr size_t WS_W13 = 351 * MiB, WS_W2 = 367 * MiB, WS_WG = 375 * MiB, WS_WP = 377 * MiB;
constexpr size_t WS_KF = 262 * MiB, WS_PS = 278 * MiB, WS_HT = 280 * MiB;
constexpr int CW_BAR = 4096, CW_CNT = 8192;

#define GAS __attribute__((address_space(1)))
#define LAS __attribute__((address_space(3)))
typedef unsigned short bf16;
typedef unsigned v4u __attribute__((ext_vector_type(4)));
typedef float f32x4 __attribute__((ext_vector_type(4)));
typedef short bf16x8 __attribute__((ext_vector_type(8)));
typedef GAS unsigned gu32;
typedef GAS unsigned long long gu64;
#define RLX_AGENT __ATOMIC_RELAXED, __HIP_MEMORY_SCOPE_AGENT
#define LDS_WAIT() asm volatile("s_waitcnt lgkmcnt(0)" ::: "memory")
#define VM_WAIT() asm volatile("s_waitcnt vmcnt(0)" ::: "memory")
__device__ __forceinline__ unsigned long long rt() { return __builtin_amdgcn_s_memrealtime(); }
__device__ __forceinline__ unsigned f2bf(float f) { unsigned u = __builtin_bit_cast(unsigned, f); return (u + 0x7fffu + ((u >> 16) & 1u)) >> 16; }
__device__ __forceinline__ unsigned pk2(float lo, float hi) { return f2bf(lo) | (f2bf(hi) << 16); }

#define XB_TMO      128
#define XB_XCNT(j)  (256  + 64 * (j))
#define XB_XSUB(j)  (1280 + 64 * (j))
#define XB_XGEN(j)  (2304 + 64 * (j))
#define XB_TOP      3328
#define XB_TOPGEN   3392
#define XCD_BAR_WORDS 3456
#define XB_SPIN_CAP (1u << 18)

__device__ __forceinline__ unsigned xb_ld(unsigned* p)              { return __hip_atomic_load(p, __ATOMIC_RELAXED, __HIP_MEMORY_SCOPE_AGENT); }
__device__ __forceinline__ unsigned xb_add(unsigned* p, unsigned v) { return __hip_atomic_fetch_add(p, v, __ATOMIC_RELAXED, __HIP_MEMORY_SCOPE_AGENT); }
__device__ __forceinline__ unsigned xb_xcc_id() { return (unsigned)__builtin_amdgcn_s_getreg((3 << 11) | 20) & 0xFu; }
#define XB_SPIN(cond, bar) do { unsigned _sp = 0; while (cond) { __builtin_amdgcn_s_sleep(1); \
    if ((++_sp & 255u) == 0u) { if (xb_ld(&(bar)[XB_TMO])) break; if (_sp > XB_SPIN_CAP) { atomicAdd(&(bar)[XB_TMO], 1u); break; } } } } while (0)

struct XcdBarrier {
    unsigned* bar; unsigned x;
    volatile LAS unsigned* st;
};

__device__ __forceinline__ XcdBarrier xcd_barrier_post(unsigned* bar, volatile LAS unsigned* st) {
    XcdBarrier b; b.bar = bar; b.x = xb_xcc_id(); b.st = st;
    if (threadIdx.x == 0) (void)xb_add(&bar[XB_XCNT(b.x)], 1u);
    return b;
}
__device__ __forceinline__ void xcd_barrier_complete(unsigned* bar, unsigned x, unsigned& nloc, unsigned& nx) {
    const unsigned G = gridDim.x * gridDim.y * gridDim.z;
    unsigned sum, cnt, mine, sp = 0u;
    for (;;) {
        sum = 0u; cnt = 0u; mine = 0u;
#pragma unroll
        for (unsigned j = 0; j < 16; ++j) { const unsigned c = xb_ld(&bar[XB_XCNT(j)]); sum += c; cnt += (c > 0u) ? 1u : 0u; mine = (j == x) ? c : mine; }
        if (sum == G) break;
        __builtin_amdgcn_s_sleep(1);
        if ((++sp & 255u) == 0u) { if (xb_ld(&bar[XB_TMO])) break; if (sp > XB_SPIN_CAP) { atomicAdd(&bar[XB_TMO], 1u); break; } }
    }
    nloc = mine > 0u ? mine : 1u; nx = cnt > 0u ? cnt : 1u;
}

__device__ __forceinline__ void xcd_barrier(const XcdBarrier& b) {
    asm volatile("s_waitcnt vmcnt(0)" ::: "memory");
    __syncthreads();
    if (threadIdx.x == 0) {
        unsigned* bar = b.bar; unsigned bx_ = b.x; asm volatile("" : "+s"(bx_));
        __builtin_amdgcn_s_waitcnt(0);
        unsigned nloc = b.st[0], nx = b.st[1];
        if (nloc == 0u) { xcd_barrier_complete(bar, bx_, nloc, nx); b.st[0] = nloc; b.st[1] = nx; }
        const unsigned old = xb_add(&bar[XB_XSUB(bx_)], 1u);
        const unsigned gen = old / nloc;
        if (old + 1u == (gen + 1u) * nloc) {
            __builtin_amdgcn_fence(__ATOMIC_RELEASE, "agent");
            asm volatile("s_waitcnt vmcnt(0)" ::: "memory");
            const unsigned og = xb_add(&bar[XB_TOP], 1u);
            const unsigned tg = og / nx;
            if (og + 1u == (tg + 1u) * nx) xb_add(&bar[XB_TOPGEN], 1u);
            else XB_SPIN(xb_ld(&bar[XB_TOPGEN]) == tg, bar);
            __builtin_amdgcn_fence(__ATOMIC_ACQUIRE, "agent");
            xb_add(&bar[XB_XGEN(bx_)], 1u);
            asm volatile("s_waitcnt vmcnt(0)" ::: "memory");
        } else {
            XB_SPIN(xb_ld(&bar[XB_XGEN(bx_)]) == gen, bar);
            __builtin_amdgcn_fence(__ATOMIC_ACQUIRE, "agent");
            asm volatile("s_waitcnt vmcnt(0)" ::: "memory");
        }
    }
    __syncthreads();
}
__device__ __forceinline__ float bf2f(unsigned short b) { return __uint_as_float((unsigned)b << 16); }
__device__ __forceinline__ float wave_sum(float v) {
#pragma unroll
    for (int o = 1; o < 64; o <<= 1) v += __shfl_xor(v, o);
    return v;
}
__device__ __forceinline__ void p0_transpose_block(const float* W, int K, int N, int k0, int n0, bf16* WT, int mode, LAS float* scr, int lane) {
#pragma unroll 4
    for (int i = 0; i < 32; ++i) { const int kk = 2 * i + (lane >> 5); scr[kk * 33 + (lane & 31)] = W[(size_t)(k0 + kk) * N + n0 + (lane & 31)]; }
    LDS_WAIT(); asm volatile("" ::: "memory");
    const int c = lane & 7;
#pragma unroll 1
    for (int j = 0; j < 4; ++j) { const int n = (lane >> 3) + 8 * j; const LAS float* s = scr + (8 * c) * 33 + n;
        v4u o; o.x = pk2(s[0 * 33], s[1 * 33]); o.y = pk2(s[2 * 33], s[3 * 33]); o.z = pk2(s[4 * 33], s[5 * 33]); o.w = pk2(s[6 * 33], s[7 * 33]);
        const int f = n0 + n; const size_t drow = mode == 0 ? (size_t)n : (size_t)(8 * (f >> 2) + (f & 3) + (mode == 2 ? 4 : 0));
        *(GAS v4u*)(WT + drow * K + k0 + 8 * c) = o; }
    LDS_WAIT(); asm volatile("" ::: "memory");
}
__device__ __forceinline__ void ln_row(const float* x0, float a, const bf16* y1, const bf16* y2, const bf16* y3, const float* g, const float* b, float* of, bf16* ob, int lane) {
    f32x4 v[4]; float s = 0.f;
#pragma unroll
    for (int j = 0; j < 4; ++j) { const int c = 4 * lane + 256 * j; v[j] = *(const GAS f32x4*)(x0 + c) * a;
        if (y1) { const unsigned long long w = *(const GAS unsigned long long*)(y1 + c); v[j] += (f32x4){bf2f((bf16)w), bf2f((bf16)(w >> 16)), bf2f((bf16)(w >> 32)), bf2f((bf16)(w >> 48))}; }
        if (y2) { const unsigned long long w = *(const GAS unsigned long long*)(y2 + c); v[j] += (f32x4){bf2f((bf16)w), bf2f((bf16)(w >> 16)), bf2f((bf16)(w >> 32)), bf2f((bf16)(w >> 48))}; }
        if (y3) { const unsigned long long w = *(const GAS unsigned long long*)(y3 + c); v[j] += (f32x4){bf2f((bf16)w), bf2f((bf16)(w >> 16)), bf2f((bf16)(w >> 32)), bf2f((bf16)(w >> 48))}; }
        s += (v[j].x + v[j].y) + (v[j].z + v[j].w); }
    const float mean = wave_sum(s) * (1.f / D); float s2 = 0.f;
#pragma unroll
    for (int j = 0; j < 4; ++j) { v[j] = v[j] - mean; s2 += (v[j].x * v[j].x + v[j].y * v[j].y) + (v[j].z * v[j].z + v[j].w * v[j].w); }
    const float rstd = 1.f / sqrtf(wave_sum(s2) * (1.f / D) + 1e-5f);
#pragma unroll
    for (int j = 0; j < 4; ++j) { const int c = 4 * lane + 256 * j; const f32x4 o = v[j] * rstd * *(const GAS f32x4*)(g + c) + *(const GAS f32x4*)(b + c);
        if (of) *(GAS f32x4*)(of + c) = o;
        if (ob) *(GAS unsigned long long*)(ob + c) = (unsigned long long)pk2(o.x, o.y) | ((unsigned long long)pk2(o.z, o.w) << 32); }
}

struct SchedIn {
    int vcu, G; const char* xb; const char* wsw; const char* wnm;
    __device__ __forceinline__ bool next(int i, pg8::Unit& u) const {
        const int L = i * G + vcu; if (L >= 640) return false;
        const int t = L / 10, j = L % 10;
        const int sw = __builtin_amdgcn_readfirstlane((unsigned)(j + 27) >> 5);
        const int jj = j - 5 * sw; const char* tp = xb + (size_t)t * TILEB; const char* wp = (sw ? wsw : wnm) + (size_t)jj * TILEB;
        u.kind = sw; u.pm = sw ? jj : t; u.pn = sw ? t : jj; u.A = sw ? wp : tp; u.B = sw ? tp : wp;
        u.aux = 0; return true;
    }
};
struct EpiIn {
    static constexpr bool PERM = true;
    bf16* qkp; bf16* uvt; const float* cs;
    __device__ __forceinline__ void operator()(const pg8::f32x4 (&acc)[2][2][4][2], const pg8::Unit& u, int wr, int wc, int fr, int fq) const {
        bf16* base = u.kind == 0 ? qkp : uvt; const int ldc = u.kind == 0 ? 1280 : M;
        const int row0 = u.pm * 256 + wr * 64 + fr, col0 = u.pn * 256 + wc * 32 + 8 * fq;
        const bool rope = (u.kind == 0) && (u.pn < 4) && ((wc & 1) == 0);
        const float sc = (u.kind == 0 && u.pn < 2) ? QSCALE : 1.f;
        const float sgn = fq == 0 ? -1.f : 1.f;
        const bool vperm = (u.kind == 1) && (u.pm >= 3);
#pragma unroll
        for (int ai = 0; ai < 2; ++ai)
#pragma unroll
            for (int m = 0; m < 4; ++m) { const int row = row0 + ai * 128 + m * 16; bf16* rowp = base + (size_t)row * ldc + col0;
                f32x4 cv0 = {1.f, 1.f, 1.f, 1.f}, cv1 = cv0, sv0 = {0.f, 0.f, 0.f, 0.f}, sv1 = sv0;
                if (rope && fq < 2) { const float* t = cs + (size_t)(row & (S - 1)) * 16; cv0 = *(const f32x4*)t; cv1 = *(const f32x4*)(t + 4); sv0 = *(const f32x4*)(t + 8) * sgn; sv1 = *(const f32x4*)(t + 12) * sgn; }
#pragma unroll
                for (int bj = 0; bj < 2; ++bj) { f32x4 v0 = acc[ai][bj][m][0], v1 = acc[ai][bj][m][1];
                    if (rope) { f32x4 p0, p1;
#pragma unroll
                        for (int e = 0; e < 4; ++e) { p0[e] = __shfl_xor(v0[e], 16); p1[e] = __shfl_xor(v1[e], 16); }
                        v0 = v0 * cv0 + p0 * sv0; v1 = v1 * cv1 + p1 * sv1; }
                    v0 = v0 * sc; v1 = v1 * sc;
                    pg8::u32x4 w; w.x = pg8::cvt_pk_bf16(v0[0], v0[1]); w.y = pg8::cvt_pk_bf16(v0[2], v0[3]); w.z = pg8::cvt_pk_bf16(v1[0], v1[1]); w.w = pg8::cvt_pk_bf16(v1[2], v1[3]);
                    if (vperm) {
                        bf16* gp = rowp + bj * 128 - (fq & 1) * 8;
                        typedef unsigned u32x2 __attribute__((ext_vector_type(2)));
                        *(u32x2*)(gp + ((fq & 1) ? 4 : 0)) = (u32x2){w.x, w.y}; *(u32x2*)(gp + ((fq & 1) ? 12 : 8)) = (u32x2){w.z, w.w};
                    } else *(pg8::u32x4*)(rowp + bj * 128) = w; } }
    }
};

struct SchedOut {
    int vcu, G; const char* a; const char* w;
    __device__ __forceinline__ bool next(int i, pg8::Unit& u) const {
        const int L = i * G + vcu; if (L >= 256) return false;
        u.kind = 0; u.pm = L >> 2; u.pn = L & 3; u.aux = 0; u.A = a + (size_t)u.pm * TILEB; u.B = w + (size_t)u.pn * TILEB; return true;
    }
};
struct EpiRes {
    static constexpr bool PERM = false;
    float* X;
    __device__ __forceinline__ void operator()(const pg8::f32x4 (&acc)[2][2][4][2], const pg8::Unit& u, int wr, int wc, int fr, int fq) const {
        const int row0 = u.pm * 256 + wr * 64 + fr, col0 = u.pn * 256 + wc * 32 + 4 * fq;
#pragma unroll
        for (int ai = 0; ai < 2; ++ai)
#pragma unroll
            for (int m = 0; m < 4; ++m) { float* rowp = X + (size_t)(row0 + ai * 128 + m * 16) * D + col0;
#pragma unroll
                for (int bj = 0; bj < 2; ++bj)
#pragma unroll
                    for (int n = 0; n < 2; ++n) { pg8::f32x4* p = (pg8::f32x4*)(rowp + bj * 128 + n * 16); *p = *p * DN_ALPHA + acc[ai][bj][m][n]; } }
    }
};
struct RouteLds { unsigned lcnt[16]; unsigned gbase[16]; int e0[64], e1[64]; unsigned r0[64], r1[64]; float g0[64], g1[64]; };
__device__ __forceinline__ void ln1_router_chunk(LAS RouteLds* R, int row0, float* X, bf16* XB, const float* g, const float* b, const float* wgc, const float* bgc, const float* wgf, const float* bgf,
                                                 int* eid, float* wts, gu32* cnt, int* tokidx, float* gate, int wave, int lane) {
    const int tidl = wave * 64 + lane;
    if (tidl < 16) R->lcnt[tidl] = 0u;
    LDS_WAIT(); __syncthreads();
#pragma unroll 1
    for (int pass = 0; pass < 2; ++pass) {
        const int rl0 = wave * 8 + pass * 4;
        f32x4 o[4][4];
#pragma unroll
        for (int r = 0; r < 4; ++r) { float* xrow = X + (size_t)(row0 + rl0 + r) * D; float s = 0.f;
#pragma unroll
            for (int j = 0; j < 4; ++j) { o[r][j] = *(const GAS f32x4*)(xrow + 4 * lane + 256 * j); s += (o[r][j].x + o[r][j].y) + (o[r][j].z + o[r][j].w); }
            const float mean = wave_sum(s) * (1.f / D); float s2 = 0.f;
#pragma unroll
            for (int j = 0; j < 4; ++j) { o[r][j] = o[r][j] - mean; s2 += (o[r][j].x * o[r][j].x + o[r][j].y * o[r][j].y) + (o[r][j].z * o[r][j].z + o[r][j].w * o[r][j].w); }
            const float rstd = 1.f / sqrtf(wave_sum(s2) * (1.f / D) + 1e-5f);
            bf16* xbrow = XB + (size_t)(row0 + rl0 + r) * D;
#pragma unroll
            for (int j = 0; j < 4; ++j) { const int c = 4 * lane + 256 * j; o[r][j] = o[r][j] * rstd * *(const GAS f32x4*)(g + c) + *(const GAS f32x4*)(b + c);
                *(GAS f32x4*)(xrow + c) = o[r][j];
                *(GAS unsigned long long*)(xbrow + c) = (unsigned long long)pk2(o[r][j].x, o[r][j].y) | ((unsigned long long)pk2(o[r][j].z, o[r][j].w) << 32); } }
        float lg[4][20];
#pragma unroll
        for (int r = 0; r < 4; ++r)
#pragma unroll
            for (int i = 0; i < 20; ++i) lg[r][i] = 0.f;
#pragma unroll
        for (int j = 0; j < 4; ++j)
#pragma unroll
            for (int e = 0; e < 4; ++e) { const int k = 4 * lane + 256 * j + e; const f32x4 wc4 = *(const GAS f32x4*)(wgc + (size_t)k * 4);
                f32x4 wf[4];
#pragma unroll
                for (int q = 0; q < 4; ++q) wf[q] = *(const GAS f32x4*)(wgf + (size_t)k * 16 + q * 4);
#pragma unroll
                for (int r = 0; r < 4; ++r) { const float x = o[r][j][e];
                    lg[r][0] += x * wc4.x; lg[r][1] += x * wc4.y; lg[r][2] += x * wc4.z; lg[r][3] += x * wc4.w;
#pragma unroll
                    for (int q = 0; q < 4; ++q) { lg[r][4 + 4 * q] += x * wf[q].x; lg[r][5 + 4 * q] += x * wf[q].y; lg[r][6 + 4 * q] += x * wf[q].z; lg[r][7 + 4 * q] += x * wf[q].w; } } }
        float my[20];
#pragma unroll
        for (int i = 0; i < 20; ++i) { my[i] = 0.f;
#pragma unroll
            for (int r = 0; r < 4; ++r) { const float t = wave_sum(lg[r][i]); if (lane == r) my[i] = t; } }
        if (lane < 4) {
            const int rl = rl0 + lane, tok = row0 + rl;
            float pg[4], mx = -INFINITY, sum = 0.f;
#pragma unroll
            for (int j = 0; j < 4; ++j) { pg[j] = my[j] + bgc[j]; mx = fmaxf(mx, pg[j]); }
#pragma unroll
            for (int j = 0; j < 4; ++j) { pg[j] = expf(pg[j] - mx); sum += pg[j]; }
            int gi = 0; float gw = pg[0];
#pragma unroll
            for (int j = 1; j < 4; ++j) if (pg[j] > gw) { gw = pg[j]; gi = j; }
            gw /= sum;
            float fs[4]; mx = -INFINITY;
#pragma unroll
            for (int j = 0; j < 4; ++j) { float t = 0.f;
#pragma unroll
                for (int q = 0; q < 4; ++q) if (q == gi) t = my[4 + q * 4 + j] + bgf[q * 4 + j];
                fs[j] = t; mx = fmaxf(mx, t); }
#pragma unroll
            for (int j = 0; j < 4; ++j) fs[j] = expf(fs[j] - mx);
            int t0 = 0; float v0 = fs[0];
#pragma unroll
            for (int j = 1; j < 4; ++j) if (fs[j] > v0) { v0 = fs[j]; t0 = j; }
            int t1 = -1; float v1 = -1.f;
#pragma unroll
            for (int j = 0; j < 4; ++j) if (j != t0 && fs[j] > v1) { v1 = fs[j]; t1 = j; }
            const float ts = v0 + v1; const int e0 = gi * 4 + t0, e1 = gi * 4 + t1; const float g0 = gw * (v0 / ts), g1 = gw * (v1 / ts);
            if (eid) { eid[tok * 2] = e0; eid[tok * 2 + 1] = e1; wts[tok * 2] = g0; wts[tok * 2 + 1] = g1; }
            R->e0[rl] = e0; R->e1[rl] = e1; R->g0[rl] = g0; R->g1[rl] = g1;
            R->r0[rl] = __hip_atomic_fetch_add(&R->lcnt[e0], 1u, __ATOMIC_RELAXED, __HIP_MEMORY_SCOPE_WORKGROUP);
            R->r1[rl] = __hip_atomic_fetch_add(&R->lcnt[e1], 1u, __ATOMIC_RELAXED, __HIP_MEMORY_SCOPE_WORKGROUP);
        }
    }
    LDS_WAIT(); __syncthreads();
    if (tidl < 16) { const unsigned n = R->lcnt[tidl]; R->gbase[tidl] = n ? __hip_atomic_fetch_add(cnt + tidl, n, RLX_AGENT) : 0u; }
    LDS_WAIT(); __syncthreads();
    if (tidl < 64) { const int rl = tidl, tok = row0 + rl; const int e0 = R->e0[rl], e1 = R->e1[rl]; const unsigned p0 = R->gbase[e0] + R->r0[rl], p1 = R->gbase[e1] + R->r1[rl];
        tokidx[(size_t)e0 * M + p0] = tok * 2; gate[(size_t)e0 * M + p0] = R->g0[rl]; tokidx[(size_t)e1 * M + p1] = tok * 2 + 1; gate[(size_t)e1 * M + p1] = R->g1[rl]; }
    LDS_WAIT(); __syncthreads();
}

struct MoeTab { LAS const int* p;
    __device__ __forceinline__ int cnt(int e) const { return __builtin_amdgcn_readfirstlane(p[e]); }
    __device__ __forceinline__ int pre(int e) const { return __builtin_amdgcn_readfirstlane(p[16 + e]); } };
__device__ __forceinline__ void moe_tab_build(LAS int* p, const gu32* cnt) {
    if (threadIdx.x == 0) { int acc = 0;
        for (int e = 0; e < 16; ++e) { const int c = (int)__hip_atomic_load(cnt + e, RLX_AGENT); p[e] = c; p[16 + e] = acc; acc += (c + 255) >> 8; }
        p[32] = acc; }
    __syncthreads();
}
template <int NPN> struct SchedMoe {
    int vcu, G; MoeTab T; const char* a; const char* w; size_t wexp  ; const int* tokidx; size_t atile  ;
    __device__ __forceinline__ bool next(int i, pg8::Unit& u) const {
        const int L = i * G + vcu; if (L >= T.pre(16) * NPN) return false;
        const int tile = L / NPN; u.pn = L % NPN; int e = 0;
#pragma unroll 1
        for (int q = 1; q < 16; ++q) if (tile >= T.pre(q)) e = q;
        u.aux = e; u.pm = tile - T.pre(e); u.kind = tile;
        u.A = a + (size_t)tile * atile; u.B = w + (size_t)e * wexp + (size_t)u.pn * 256 * (wexp / (NPN * 256)); return true;
    }
    __device__ __forceinline__ int arow(const pg8::Unit& u, int r) const {
        const int rank = u.pm * 256 + r; const int c = T.cnt(u.aux);
        return rank < c ? (tokidx[(size_t)u.aux * M + rank] >> 1) : 0;
    }
};
struct EpiMoe1 {
    static constexpr bool PERM = true;
    bf16* act; const float* gate; MoeTab T;
    __device__ __forceinline__ void operator()(const pg8::f32x4 (&acc)[2][2][4][2], const pg8::Unit& u, int wr, int wc, int fr, int fq) const {
        const int cnt = T.cnt(u.aux);
#pragma unroll
        for (int ai = 0; ai < 2; ++ai)
#pragma unroll
            for (int m = 0; m < 4; ++m) { const int r = ai * 128 + wr * 64 + m * 16 + fr, rank = u.pm * 256 + r;
                const float gt = rank < cnt ? gate[(size_t)u.aux * M + rank] : 0.f;
                bf16* rowp = act + ((size_t)u.kind * 256 + r) * 256 + u.pn * 128 + wc * 16 + 4 * fq;
#pragma unroll
                for (int bj = 0; bj < 2; ++bj) { const pg8::f32x4 av = acc[ai][bj][m][0], cv = acc[ai][bj][m][1]; float y[4];
#pragma unroll
                    for (int e = 0; e < 4; ++e) y[e] = av[e] / (1.f + __expf(-av[e])) * cv[e] * gt;
                    *(unsigned long long*)(rowp + bj * 64) = (unsigned long long)pg8::cvt_pk_bf16(y[0], y[1]) | ((unsigned long long)pg8::cvt_pk_bf16(y[2], y[3]) << 32); } }
    }
};
struct EpiMoe2 {
    static constexpr bool PERM = true;
    bf16* ymoe; const int* tokidx; MoeTab T;
    __device__ __forceinline__ void operator()(const pg8::f32x4 (&acc)[2][2][4][2], const pg8::Unit& u, int wr, int wc, int fr, int fq) const {
        const int cnt = T.cnt(u.aux);
#pragma unroll
        for (int ai = 0; ai < 2; ++ai)
#pragma unroll
            for (int m = 0; m < 4; ++m) { const int r = ai * 128 + wr * 64 + m * 16 + fr, rank = u.pm * 256 + r;
                if (rank < cnt) { bf16* rowp = ymoe + (size_t)tokidx[(size_t)u.aux * M + rank] * D + u.pn * 256 + wc * 32 + 8 * fq;
#pragma unroll
                    for (int bj = 0; bj < 2; ++bj) { const pg8::f32x4 v0 = acc[ai][bj][m][0], v1 = acc[ai][bj][m][1];
                        pg8::u32x4 w; w.x = pg8::cvt_pk_bf16(v0[0], v0[1]); w.y = pg8::cvt_pk_bf16(v0[2], v0[3]); w.z = pg8::cvt_pk_bf16(v1[0], v1[1]); w.w = pg8::cvt_pk_bf16(v1[2], v1[3]);
                        *(pg8::u32x4*)(rowp + bj * 128) = w; } } }
    }
};
struct SchedSq {
    int vcu, G; const char* a; const char* w; size_t astep, wstep;
    __device__ __forceinline__ bool next(int i, pg8::Unit& u) const {
        const int L = i * G + vcu; if (L >= 256) return false;
        u.kind = 0; u.pm = L >> 2; u.pn = L & 3; u.aux = 0; u.A = a + (size_t)u.pm * astep; u.B = w + (size_t)u.pn * wstep; return true;
    }
};
template <int GATED> struct EpiPle {
    static constexpr bool PERM = true;
    bf16* yp; const float* bg;
    __device__ __forceinline__ void operator()(const pg8::f32x4 (&acc)[2][2][4][2], const pg8::Unit& u, int wr, int wc, int fr, int fq) const {
        const int row0 = u.pm * 256 + wr * 64 + fr, col0 = u.pn * 256 + wc * 32 + 8 * fq;
#pragma unroll
        for (int ai = 0; ai < 2; ++ai)
#pragma unroll
            for (int m = 0; m < 4; ++m) { bf16* rowp = yp + (size_t)(row0 + ai * 128 + m * 16) * D + col0;
#pragma unroll
                for (int bj = 0; bj < 2; ++bj) { pg8::f32x4 v0 = acc[ai][bj][m][0], v1 = acc[ai][bj][m][1];
                    if (GATED) { const pg8::f32x4 b0 = *(const pg8::f32x4*)(bg + col0 + bj * 128), b1 = *(const pg8::f32x4*)(bg + col0 + bj * 128 + 4); const pg8::u32x4 y = *(const pg8::u32x4*)(rowp + bj * 128);
                        const float yf[8] = {bf2f((bf16)y.x), bf2f((bf16)(y.x >> 16)), bf2f((bf16)y.y), bf2f((bf16)(y.y >> 16)), bf2f((bf16)y.z), bf2f((bf16)(y.z >> 16)), bf2f((bf16)y.w), bf2f((bf16)(y.w >> 16))};
#pragma unroll
                        for (int e = 0; e < 4; ++e) { v0[e] = yf[e] / (1.f + __expf(-(v0[e] + b0[e]))); v1[e] = yf[4 + e] / (1.f + __expf(-(v1[e] + b1[e]))); } }
                    pg8::u32x4 w; w.x = pg8::cvt_pk_bf16(v0[0], v0[1]); w.y = pg8::cvt_pk_bf16(v0[2], v0[3]); w.z = pg8::cvt_pk_bf16(v1[0], v1[1]); w.w = pg8::cvt_pk_bf16(v1[2], v1[3]);
                    *(pg8::u32x4*)(rowp + bj * 128) = w; } }
    }
};
namespace att {
typedef float f32x16 __attribute__((ext_vector_type(16)));
constexpr int KSLOT = 8192, VSLOT = 16384, LDS_K = 0, LDS_V = 2 * KSLOT, ATT_LDS = 2 * KSLOT + 2 * VSLOT;
__device__ __forceinline__ bf16x8 pack8(const f32x16& p, int b) {
    v4u w; w.x = pg8::cvt_pk_bf16(p[b], p[b + 1]); w.y = pg8::cvt_pk_bf16(p[b + 2], p[b + 3]); w.z = pg8::cvt_pk_bf16(p[b + 4], p[b + 5]); w.w = pg8::cvt_pk_bf16(p[b + 6], p[b + 7]);
    return __builtin_bit_cast(bf16x8, w);
}
__device__ __forceinline__ void tile(LAS const unsigned char* ks, LAS const unsigned char* vs, const bf16x8 (&qf)[4], f32x16 (&o)[4], float& m, float& l, int r32, int hi) {
    f32x16 p0, p1;
#pragma unroll
    for (int r = 0; r < 16; ++r) { p0[r] = 0.f; p1[r] = 0.f; }
    LAS const unsigned char* kb = ks + hi * 1024 + r32 * 16;
#pragma unroll
    for (int kk = 0; kk < 4; ++kk) {
        const bf16x8 a0 = *(LAS const bf16x8*)(kb + kk * 2048), a1 = *(LAS const bf16x8*)(kb + kk * 2048 + 512);
        p0 = __builtin_amdgcn_mfma_f32_32x32x16_bf16(a0, qf[kk], p0, 0, 0, 0);
        p1 = __builtin_amdgcn_mfma_f32_32x32x16_bf16(a1, qf[kk], p1, 0, 0, 0);
    }
    __builtin_amdgcn_sched_barrier(0);
    float mx = fmaxf(p0[0], p1[0]);
#pragma unroll
    for (int r = 1; r < 16; ++r) mx = fmaxf(mx, fmaxf(p0[r], p1[r]));
    mx = fmaxf(mx, __shfl_xor(mx, 32));
    const float mn = fmaxf(m, mx);
    const float alpha = __builtin_amdgcn_exp2f(m - mn);
    m = mn;
    float ps = 0.f;
#pragma unroll
    for (int r = 0; r < 16; ++r) { p0[r] = __builtin_amdgcn_exp2f(p0[r] - mn); p1[r] = __builtin_amdgcn_exp2f(p1[r] - mn); ps += p0[r] + p1[r]; }
    l = l * alpha + ps;
#pragma unroll
    for (int db = 0; db < 4; ++db)
#pragma unroll
        for (int r = 0; r < 16; ++r) o[db][r] *= alpha;
    __builtin_amdgcn_sched_barrier(0);
    bf16x8 pf[4]; pf[0] = pack8(p0, 0); pf[1] = pack8(p0, 8); pf[2] = pack8(p1, 0); pf[3] = pack8(p1, 8);
    LAS const unsigned char* vb = vs + hi * 2048 + r32 * 16;
#pragma unroll
    for (int db = 0; db < 4; ++db) {
        bf16x8 va[4];
#pragma unroll
        for (int s = 0; s < 4; ++s) va[s] = *(LAS const bf16x8*)(vb + s * 4096 + db * 512);
#pragma unroll
        for (int s = 0; s < 4; ++s) o[db] = __builtin_amdgcn_mfma_f32_32x32x16_bf16(va[s], pf[s], o[db], 0, 0, 0);
        __builtin_amdgcn_sched_barrier(0);
    }
}
__device__ __forceinline__ void unit(LAS unsigned char* lds, int b, int h, int qb, const bf16* QKP, const bf16* UVT, float lam, float lam_init, const float* subg, bf16* MIXB, float* stash, int wave, int lane) {
    asm volatile("" : "+v"(lane));
    const int r32 = lane & 31, hi = lane >> 5;
    const size_t tok0 = (size_t)b * S;
    const size_t qtok = tok0 + qb * 256 + wave * 32 + r32;
#pragma unroll 1
    for (int c = 0; c < 2; ++c) {
        bf16x8 qf[4];
#pragma unroll
        for (int kk = 0; kk < 4; ++kk) qf[kk] = *(const GAS bf16x8*)(QKP + qtok * 1280 + h * 128 + c * 64 + kk * 16 + hi * 8);
        f32x16 o[4];
#pragma unroll
        for (int db = 0; db < 4; ++db)
#pragma unroll
            for (int r = 0; r < 16; ++r) o[db][r] = 0.f;
        float m = -INFINITY, l = 0.f;
        const bf16* ksrc = QKP + (tok0 + lane) * 1280 + 512 + h * 128 + c * 64 + wave * 8;
        const bf16* vsrc = UVT + (size_t)(768 + h * 128 + lane) * M + tok0 + wave * 8;
#define ATT_DMA(t, slot) do { \
            __builtin_amdgcn_global_load_lds((const unsigned*)(ksrc + (size_t)(t) * 64 * 1280), (LAS unsigned*)(lds + LDS_K + (slot) * KSLOT + wave * 1024), 16, 0, 0); \
            __builtin_amdgcn_global_load_lds((const unsigned*)(vsrc + (size_t)(t) * 64), (LAS unsigned*)(lds + LDS_V + (slot) * VSLOT + wave * 2048), 16, 0, 0); \
            __builtin_amdgcn_global_load_lds((const unsigned*)(vsrc + (size_t)64 * M + (size_t)(t) * 64), (LAS unsigned*)(lds + LDS_V + (slot) * VSLOT + wave * 2048 + 1024), 16, 0, 0); } while (0)
        asm volatile("s_waitcnt vmcnt(0) lgkmcnt(0)" ::: "memory"); __builtin_amdgcn_s_barrier();
        ATT_DMA(0, 0);
#pragma unroll 1
        for (int t = 0; t < S / 64; t += 2) {
            asm volatile("s_waitcnt vmcnt(0) lgkmcnt(0)" ::: "memory"); __builtin_amdgcn_s_barrier();
            ATT_DMA(t + 1, 1);
            tile(lds + LDS_K, lds + LDS_V, qf, o, m, l, r32, hi);
            asm volatile("s_waitcnt vmcnt(0) lgkmcnt(0)" ::: "memory"); __builtin_amdgcn_s_barrier();
            if (t + 2 < S / 64) ATT_DMA(t + 2, 0);
            tile(lds + LDS_K + KSLOT, lds + LDS_V + VSLOT, qf, o, m, l, r32, hi);
        }
#undef ATT_DMA
        const float lt = l + __shfl_xor(l, 32);
        if (c == 0) {
            const float i1 = 1.f / lt;
#pragma unroll
            for (int db = 0; db < 4; ++db)
#pragma unroll
                for (int g4 = 0; g4 < 4; ++g4) *(GAS f32x4*)(stash + ((db * 4 + g4) * 64 + lane) * 4) = (f32x4){o[db][4 * g4] * i1, o[db][4 * g4 + 1] * i1, o[db][4 * g4 + 2] * i1, o[db][4 * g4 + 3] * i1};
        } else {
            const float i2 = lam / lt;
            float ss = 0.f;
#pragma unroll
            for (int db = 0; db < 4; ++db)
#pragma unroll
                for (int g4 = 0; g4 < 4; ++g4) { const f32x4 s1 = *(const GAS f32x4*)(stash + ((db * 4 + g4) * 64 + lane) * 4);
#pragma unroll
                    for (int i = 0; i < 4; ++i) { const float v = s1[i] - o[db][4 * g4 + i] * i2; o[db][4 * g4 + i] = v; ss += v * v; } }
            ss += __shfl_xor(ss, 32);
            const float rs = (1.f - lam_init) / sqrtf(ss * (1.f / 128.f) + 1e-5f);
            bf16* orow = MIXB + qtok * D + 256 + h * 128;
#pragma unroll
            for (int db = 0; db < 4; ++db)
#pragma unroll
                for (int g4 = 0; g4 < 4; ++g4) { const int e = 32 * db + 8 * g4 + 4 * hi; const f32x4 gg = *(const GAS f32x4*)(subg + e);
                    const unsigned long long w = (unsigned long long)pg8::cvt_pk_bf16(o[db][4 * g4] * rs * gg.x, o[db][4 * g4 + 1] * rs * gg.y) | ((unsigned long long)pg8::cvt_pk_bf16(o[db][4 * g4 + 2] * rs * gg.z, o[db][4 * g4 + 3] * rs * gg.w) << 32);
                    *(GAS unsigned long long*)(orow + e) = w; }
        }
    }
}
}
namespace hy {
typedef float f32x16 __attribute__((ext_vector_type(16)));
constexpr int CPY = 16456;
constexpr int LDS_F = 0, LDS_VV = 4 * CPY, LDS_END = LDS_VV + 32768;
static_assert(LDS_VV % 16 == 0 && LDS_END <= 131072, "hyena LDS map");

__device__ __forceinline__ void filter_item(LAS unsigned char* lds, int pb, const float* fw1, const float* fb1, const float* fr1, const float* fw2, const float* fb2, const float* fr2,
                                            const float* fw3, bf16* KF, float* PS, int wave, int lane) {
    LAS bf16* tile = (LAS bf16*)lds;
    LAS float* za = (LAS float*)(lds + 65536) + wave * 512;
    LAS float* zb = (LAS float*)(lds + 81920) + wave * 512;
    LAS float* sqs = (LAS float*)(lds + 98304);
    const int p0 = pb * 64 + wave * 8;
    if (lane < 33) {
#pragma unroll 1
        for (int pi = 0; pi < 8; ++pi) { const int p = p0 + pi; float z;
            if (lane == 0) z = (float)p / (float)(S - 1);
            else { const int bi = (lane - 1) & 15; const float band = 1e-4f + (float)bi * ((15.0f - 1e-4f) / 15.0f), wpos = 2.0f * 3.14159265358979323846f * (float)p / (float)S;
                   z = lane <= 16 ? cosf(wpos * band) : -sinf(wpos * band); }
            za[pi * 64 + lane] = z; }
    }
    LDS_WAIT(); asm volatile("" ::: "memory");
    float acc8[8];
    { const float b1 = fb1[lane];
#pragma unroll
      for (int pi = 0; pi < 8; ++pi) acc8[pi] = b1;
#pragma unroll 1
      for (int i = 0; i < 33; ++i) { const float w = fw1[i * 64 + lane];
#pragma unroll
          for (int pi = 0; pi < 8; ++pi) acc8[pi] += za[pi * 64 + i] * w; }
      const float f1 = fr1[lane];
#pragma unroll
      for (int pi = 0; pi < 8; ++pi) zb[pi * 64 + lane] = sinf(f1 * acc8[pi]); }
    LDS_WAIT(); asm volatile("" ::: "memory");
    { const float b2 = fb2[lane];
#pragma unroll
      for (int pi = 0; pi < 8; ++pi) acc8[pi] = b2;
#pragma unroll 1
      for (int i = 0; i < 64; ++i) { const float w = fw2[i * 64 + lane];
#pragma unroll
          for (int pi = 0; pi < 8; ++pi) acc8[pi] += zb[pi * 64 + i] * w; }
      const float f2 = fr2[lane];
      LDS_WAIT(); asm volatile("" ::: "memory");
#pragma unroll
      for (int pi = 0; pi < 8; ++pi) za[pi * 64 + lane] = sinf(f2 * acc8[pi]); }
    LDS_WAIT(); asm volatile("" ::: "memory");
    const float mind = logf(1e-2f) / 1.5f, maxd = logf(1e-2f) / 0.3f;
#pragma unroll 1
    for (int qh = 0; qh < 2; ++qh) {
        float ac[8][4];
#pragma unroll
        for (int pi = 0; pi < 8; ++pi)
#pragma unroll
            for (int q = 0; q < 4; ++q) ac[pi][q] = 0.f;
#pragma unroll 1
        for (int i = 0; i < 64; ++i) { float w[4];
#pragma unroll
            for (int q = 0; q < 4; ++q) w[q] = fw3[i * 512 + lane + 64 * (qh * 4 + q)];
#pragma unroll
            for (int pi = 0; pi < 8; ++pi) { const float hv = za[pi * 64 + i];
#pragma unroll
                for (int q = 0; q < 4; ++q) ac[pi][q] += hv * w[q]; } }
#pragma unroll
        for (int q = 0; q < 4; ++q) { const int col = lane + 64 * (qh * 4 + q), ch = col & 255; const float delta = fabsf(mind + (float)ch * ((maxd - mind) / 255.0f)); float sq = 0.f;
#pragma unroll
            for (int pi = 0; pi < 8; ++pi) { const int p = p0 + pi; const float val = ac[pi][q] * expf(-((float)p / (float)(S - 1)) * delta);
                if (!(col >= 256 && p == 0)) sq += val * val;
                tile[col * 64 + wave * 8 + pi] = (bf16)f2bf(val); }
            sqs[wave * 512 + col] = sq; }
    }
    LDS_WAIT(); __syncthreads();
    { const int p = pb * 64 + lane;
#pragma unroll 1
      for (int cc = 0; cc < 64; ++cc) { const int col = wave * 64 + cc; const bf16 v = tile[col * 64 + lane];
          if (col < 256) KF[(size_t)col * 8192 + 4095 - p] = v; else if (p != 0) KF[(size_t)(col - 256) * 8192 + 4095 + p] = v; } }
    { const int t = threadIdx.x; float s = 0.f;
#pragma unroll
      for (int w = 0; w < 8; ++w) s += sqs[w * 512 + t];
      PS[(size_t)pb * 512 + t] = s;
      if (pb == 0 && t < 256) KF[(size_t)t * 8192 + 8191] = 0; }
    LDS_WAIT(); __syncthreads();
}

__device__ __forceinline__ float conv1(float um, float u0, float up, float w0, float w1, float w2, float cb) { return um * w0 + u0 * w1 + up * w2 + cb; }

__device__ __forceinline__ void unit(LAS unsigned char* lds, int c, const bf16* KF, const float* PS, const bf16* UVT, const float* cw, const float* cb, const float* bias_d, bf16* HT, int wave, int lane) {
    const int tid = wave * 64 + lane;
    { const bf16* src = KF + (size_t)c * 8192;
#pragma unroll
      for (int i = 0; i < 2; ++i) { const int ch = tid + 512 * i; *(LAS v4u*)(lds + LDS_F + ch * 16) = *(const GAS v4u*)(src + ch * 8); } }
    { const float w0v = cw[512 + c], w1v = cw[768 + 512 + c], w2v = cw[1536 + 512 + c], cbv = cb[512 + c], w0x = cw[256 + c], w1x = cw[768 + 256 + c], w2x = cw[1536 + 256 + c], cbx = cb[256 + c];
      const bf16* rv = UVT + (size_t)(512 + c) * M; const bf16* rx = UVT + (size_t)(256 + c) * M;
#pragma unroll 1
      for (int i = 0; i < 4; ++i) { const int q = tid + 512 * i, b = q >> 9, sc = q & 511, s0 = sc * 8; const size_t g0 = (size_t)b * S + s0;
          const v4u av = *(const GAS v4u*)(rv + g0), ax = *(const GAS v4u*)(rx + g0);
          float uv[10], ux[10];
          uv[0] = s0 > 0 ? bf2f(rv[g0 - 1]) : 0.f; ux[0] = s0 > 0 ? bf2f(rx[g0 - 1]) : 0.f; uv[9] = s0 + 8 < S ? bf2f(rv[g0 + 8]) : 0.f; ux[9] = s0 + 8 < S ? bf2f(rx[g0 + 8]) : 0.f;
#pragma unroll
          for (int e = 0; e < 4; ++e) { uv[1 + 2 * e] = bf2f((bf16)av[e]); uv[2 + 2 * e] = bf2f((bf16)(av[e] >> 16)); ux[1 + 2 * e] = bf2f((bf16)ax[e]); ux[2 + 2 * e] = bf2f((bf16)(ax[e] >> 16)); }
          float o[8];
#pragma unroll
          for (int e = 0; e < 8; ++e) o[e] = conv1(uv[e], uv[e + 1], uv[e + 2], w0v, w1v, w2v, cbv) * conv1(ux[e], ux[e + 1], ux[e + 2], w0x, w1x, w2x, cbx);
          v4u w; w.x = pk2(o[0], o[1]); w.y = pk2(o[2], o[3]); w.z = pk2(o[4], o[5]); w.w = pk2(o[6], o[7]);
          *(LAS v4u*)(lds + LDS_VV + (((sc & 7) * 64 + (sc >> 3)) * 4 + b) * 16) = w; } }
    LDS_WAIT(); __syncthreads();
    {
#pragma unroll 1
      for (int i = 0; i < 4; ++i) { const int y = tid + 512 * i;
          const unsigned long long w0 = *(LAS const unsigned long long*)(lds + LDS_F + y * 8), w1 = *(LAS const unsigned long long*)(lds + LDS_F + y * 8 + 8);
#pragma unroll
          for (int p = 1; p < 4; ++p) *(LAS unsigned long long*)(lds + LDS_F + p * CPY + y * 8) = (w0 >> (16 * p)) | (w1 << (64 - 16 * p)); } }
    const float nrm = 1.0f / sqrtf(wave_sum(PS[(size_t)lane * 512 + c] + PS[(size_t)lane * 512 + 256 + c]) + 1e-6f);
    LDS_WAIT(); __syncthreads();
    const int r32 = lane & 31, hi = lane >> 5, gp = wave & 3, half = wave >> 2, iloc = r32 >> 2, b = r32 & 3;
    f32x16 acc[2][2];
#pragma unroll
    for (int rho = 0; rho < 2; ++rho)
#pragma unroll
        for (int gg = 0; gg < 2; ++gg)
#pragma unroll
            for (int r = 0; r < 16; ++r) acc[rho][gg][r] = 0.f;
    const int dlo = 16 * gp - 63 + (half ? 40 : 0), dn = half ? 39 : 40;
    int pa = LDS_F + (3 - (r32 & 3)) * CPY + (4092 - 4 * (r32 >> 2) + 8 * hi) * 2 - 64 - 128 * dlo;
    int jb = 16 * gp + iloc - dlo;
    const int pbase = LDS_VV + hi * 4096 + b * 16;
#pragma unroll 1
    for (int dd = 0; dd < dn; ++dd) {
        const int j0 = jb, j1 = jb + 8; const bool v0 = (unsigned)j0 < 64u, v1 = (unsigned)j1 < 64u;
        LAS const unsigned char* ap = lds + pa; LAS const unsigned char* bp0 = lds + pbase + (v0 ? j0 : 0) * 64; LAS const unsigned char* bp1 = lds + pbase + (v1 ? j1 : 0) * 64;
#pragma unroll
        for (int k = 0; k < 4; ++k) {
            typedef unsigned long long u64;
            const u64 a00 = *(LAS const u64*)(ap + 64 + 32 * k), a01 = *(LAS const u64*)(ap + 64 + 32 * k + 8), a10 = *(LAS const u64*)(ap + 32 * k), a11 = *(LAS const u64*)(ap + 32 * k + 8);
            v4u b0 = *(LAS const v4u*)(bp0 + k * 8192), b1 = *(LAS const v4u*)(bp1 + k * 8192);
            if (!v0) b0 = (v4u){0u, 0u, 0u, 0u};
            if (!v1) b1 = (v4u){0u, 0u, 0u, 0u};
            const bf16x8 fa0 = __builtin_bit_cast(bf16x8, (v4u){(unsigned)a00, (unsigned)(a00 >> 32), (unsigned)a01, (unsigned)(a01 >> 32)});
            const bf16x8 fa1 = __builtin_bit_cast(bf16x8, (v4u){(unsigned)a10, (unsigned)(a10 >> 32), (unsigned)a11, (unsigned)(a11 >> 32)});
            const bf16x8 fb0 = __builtin_bit_cast(bf16x8, b0), fb1 = __builtin_bit_cast(bf16x8, b1);
            acc[0][0] = __builtin_amdgcn_mfma_f32_32x32x16_bf16(fa0, fb0, acc[0][0], 0, 0, 0);
            acc[0][1] = __builtin_amdgcn_mfma_f32_32x32x16_bf16(fa0, fb1, acc[0][1], 0, 0, 0);
            acc[1][0] = __builtin_amdgcn_mfma_f32_32x32x16_bf16(fa1, fb0, acc[1][0], 0, 0, 0);
            acc[1][1] = __builtin_amdgcn_mfma_f32_32x32x16_bf16(fa1, fb1, acc[1][1], 0, 0, 0);
        }
        pa -= 128; jb -= 1;
    }
    LDS_WAIT(); __syncthreads();
    { LAS float* xw = (LAS float*)(lds + LDS_F) + (gp * 2 + (half ? 0 : 1)) * 2048 + lane;
#pragma unroll
      for (int gg = 0; gg < 2; ++gg)
#pragma unroll
          for (int r = 0; r < 16; ++r) xw[(gg * 16 + r) * 64] = half ? acc[0][gg][r] : acc[1][gg][r]; }
    LDS_WAIT(); __syncthreads();
    f32x16 fin[2];
    { LAS const float* xr = (LAS const float*)(lds + LDS_F) + (gp * 2 + (half ? 1 : 0)) * 2048 + lane;
#pragma unroll
      for (int gg = 0; gg < 2; ++gg)
#pragma unroll
          for (int r = 0; r < 16; ++r) fin[gg][r] = (half ? acc[1][gg][r] : acc[0][gg][r]) + xr[(gg * 16 + r) * 64]; }
    { const float bd = bias_d[c], w0 = cw[c], w1 = cw[768 + c], w2 = cw[1536 + c], cb0 = cb[c]; const bf16* r0p = UVT + (size_t)c * M; bf16* hrow = HT + (size_t)c * M;
#pragma unroll
      for (int gg = 0; gg < 2; ++gg)
#pragma unroll
          for (int g4 = 0; g4 < 4; ++g4) { const int i = 16 * gp + 8 * gg + iloc, rr = 32 * half + 8 * g4 + 4 * hi, t0 = 64 * i + rr; const size_t tok = (size_t)b * S + t0;
              const unsigned long long vw = *(LAS const unsigned long long*)(lds + LDS_VV + (((rr >> 3) * 64 + i) * 4 + b) * 16 + (rr & 7) * 2);
              const unsigned long long uw = *(const GAS unsigned long long*)(r0p + tok);
              float u[6]; u[0] = t0 > 0 ? bf2f(r0p[tok - 1]) : 0.f; u[5] = t0 + 4 < S ? bf2f(r0p[tok + 4]) : 0.f;
              u[1] = bf2f((bf16)uw); u[2] = bf2f((bf16)(uw >> 16)); u[3] = bf2f((bf16)(uw >> 32)); u[4] = bf2f((bf16)(uw >> 48));
              float o[4];
#pragma unroll
              for (int e = 0; e < 4; ++e) { const float vv = bf2f((bf16)(vw >> (16 * e))); o[e] = (nrm * fin[gg][4 * g4 + e] + vv * bd) * conv1(u[e], u[e + 1], u[e + 2], w0, w1, w2, cb0); }
              *(GAS unsigned long long*)(hrow + tok) = (unsigned long long)pk2(o[0], o[1]) | ((unsigned long long)pk2(o[2], o[3]) << 32); } }
    LDS_WAIT(); __syncthreads();
}
__device__ __forceinline__ void transpose_slab(LAS unsigned char* lds, int slab, const bf16* HT, bf16* MIXB, int wave, int lane) {
    const int tid = wave * 64 + lane; LAS bf16* tile = (LAS bf16*)lds;
#pragma unroll 1
    for (int i = 0; i < 4; ++i) { const int q = tid + 512 * i, c = q >> 3, tc = q & 7; const v4u w = *(const GAS v4u*)(HT + (size_t)c * M + (size_t)slab * 64 + tc * 8);
#pragma unroll
        for (int e = 0; e < 4; ++e) { tile[(tc * 8 + 2 * e) * 264 + c] = (bf16)w[e]; tile[(tc * 8 + 2 * e + 1) * 264 + c] = (bf16)(w[e] >> 16); } }
    LDS_WAIT(); __syncthreads();
#pragma unroll 1
    for (int i = 0; i < 4; ++i) { const int q = tid + 512 * i, tk = q >> 5, cc = q & 31;
        *(GAS v4u*)(MIXB + ((size_t)slab * 64 + tk) * D + cc * 8) = *(LAS const v4u*)(lds + (tk * 264 + cc * 8) * 2); }
    LDS_WAIT(); __syncthreads();
}
}
#ifndef DUP_IN
#define DUP_IN 1
#endif
#ifndef DUP_HY
#define DUP_HY 1
#endif
#ifndef DUP_HYT
#define DUP_HYT 1
#endif
#ifndef DUP_ATT
#define DUP_ATT 1
#endif
#ifndef DUP_POOL
#define DUP_POOL 1
#endif
#ifndef DUP_WCV
#define DUP_WCV 1
#endif
#ifndef DUP_MOE1
#define DUP_MOE1 1
#endif
#ifndef DUP_MOE2
#define DUP_MOE2 1
#endif
#ifndef EN_HY
#define EN_HY 1
#endif
#ifndef EN_HYT
#define EN_HYT 1
#endif
#ifndef EN_PRO
#define EN_PRO 1
#endif
#ifndef EN_IN
#define EN_IN 1
#endif
#ifndef EN_ATT
#define EN_ATT 1
#endif
#ifndef EN_POOL
#define EN_POOL 1
#endif
#ifndef EN_OUT
#define EN_OUT 1
#endif
#ifndef EN_LN1
#define EN_LN1 1
#endif
#ifndef EN_WCV
#define EN_WCV 1
#endif
#ifndef EN_MOE1
#define EN_MOE1 1
#endif
#ifndef EN_MOE2
#define EN_MOE2 1
#endif
#ifndef EN_LN2
#define EN_LN2 1
#endif
constexpr int RING_BYTES = 131072;
constexpr int LDSCTL_OFF = RING_BYTES, MISC_OFF = LDSCTL_OFF + 320, MOETAB_OFF = LDSCTL_OFF + 1024, ROUTE_OFF = LDSCTL_OFF + 2048;
constexpr int LDS_BYTES = 147456;

struct Args { const float* in[38]; float* out; unsigned char* ws; int* eid; float* wts; int ph_lo, ph_hi, l_lo, l_hi, single, pad; };
enum { PH_PRO = 0, PH_IN = 1, PH_ATT = 2, PH_POOL = 3, PH_OUT = 4, PH_LN1 = 5, PH_WCV = 6, PH_MOE1 = 7, PH_MOE2 = 8, PH_LN2 = 9, PH_HY = 10, PH_HYT = 11, PH_END = 12 };

__global__ void __launch_bounds__(NWAVES * 64, 2) mk_fwd(Args a) {
    extern __shared__ __attribute__((aligned(16))) unsigned char lds_raw[];
    LAS unsigned char* lds = (LAS unsigned char*)lds_raw;
    volatile LAS unsigned* MISC = (volatile LAS unsigned*)(lds + MISC_OFF);
    const int tid = threadIdx.x;
    const int G = gridDim.x, bx = blockIdx.x, vcu = (G % 8 == 0) ? (bx % 8) * (G / 8) + bx / 8 : bx;
    gu32* ctl0 = (gu32*)(a.ws + WS_CTL);
    for (int u = tid; u < (LDS_BYTES - LDSCTL_OFF) / 4; u += NWAVES * 64) ((LAS unsigned*)(lds + LDSCTL_OFF))[u] = 0u;
    __syncthreads();
    XcdBarrier bar; bar.bar = (unsigned*)(ctl0 + CW_BAR); bar.x = 0; bar.st = nullptr;
#if defined(MK_PER_PHASE)
    if (!a.single)
#endif
    bar = xcd_barrier_post((unsigned*)(ctl0 + CW_BAR), MISC + 8);
#if defined(MK_PER_PHASE)
#define IN(k) (a.ph_lo <= (k) && (k) < a.ph_hi)
#define SEAM() do { if (!a.single) xcd_barrier(bar); } while (0)
#else
#define IN(k) 1
#define SEAM() xcd_barrier(bar)
#endif
    const int NGW = G * NWAVES;
#define PHASE_PTRS() int tidp_ = threadIdx.x; asm volatile("" : "+v"(tidp_)); const int lane = tidp_ & 63, wave = __builtin_amdgcn_readfirstlane(tidp_ >> 6); (void)wave; const int gw = vcu * NWAVES + wave; (void)gw; unsigned char* ws = a.ws; gu32* ctl = (gu32*)(ws + WS_CTL); (void)ctl; \
    float* X = (float*)(ws + WS_X); bf16* XB = (bf16*)(ws + WS_XB); bf16* QKP = (bf16*)(ws + WS_QKP); bf16* UVT = (bf16*)(ws + WS_UVT); float* CS = (float*)(ws + WS_CS); bf16* MIXB = (bf16*)(ws + WS_MIXB); \
    (void)X; (void)XB; (void)QKP; (void)UVT; (void)CS; (void)MIXB
#define INP(k) (a.in[k])

    if (EN_PRO && IN(PH_PRO)) {
            PHASE_PTRS();
        LAS float* scr = (LAS float*)(lds + wave * 16384);
        for (int it = gw; it < DEPTH * (16 * 72 + 16 * 32); it += NGW) {
            const int l = it / 1664, r = it % 1664; const float* src; int N, k0, n0; bf16* dst;
            if (r < 1152) { const int kb = r / 72, nb = r % 72; n0 = nb * 32; k0 = kb * 64; N = INW; src = INP(4) + (size_t)l * D * INW;
                bf16* wsw = (bf16*)(ws + WS_WIN + (size_t)l * WIN_LAYER); bf16* wnm = wsw + 1280 * 1024;
                dst = n0 < 768 ? wsw + (size_t)n0 * D : (n0 < 1792 ? wnm + (size_t)(n0 - 768) * D : wsw + (size_t)(768 + n0 - 1792) * D); }
            else { const int q = r - 1152, kb = q >> 5, nb = q & 31; n0 = nb * 32; k0 = kb * 64; N = D; src = INP(23) + (size_t)l * D * D; dst = (bf16*)(ws + WS_WOUT + (size_t)l * WOUT_LAYER) + (size_t)n0 * D; }
            p0_transpose_block(src, D, N, k0, n0, dst, 0, scr, lane);
        }
        for (int it = gw; it < DEPTH * 4 * 16 * 2; it += NGW) {
            const int l = it >> 7, g = (it >> 5) & 3, dh = (it >> 4) & 1, k = (it & 15) * 64 + lane;
            const float* wrow = INP(4) + (size_t)l * D * INW + (size_t)k * INW + 2304 + g * 64;
            const float* pw = INP(20) + (size_t)(l * 4 + g) * 64 * 64 + dh * 32;
            float acc[32];
#pragma unroll
            for (int d = 0; d < 32; ++d) acc[d] = 0.f;
#pragma unroll 1
            for (int c = 0; c < 64; ++c) { const float x = wrow[c];
#pragma unroll
                for (int d = 0; d < 32; ++d) acc[d] += x * pw[c * 64 + d]; }
            bf16* dst = (bf16*)(ws + WS_WIN + (size_t)l * WIN_LAYER) + (size_t)(1280 + 1024 + g * 64 + dh * 32) * D + k;
#pragma unroll
            for (int d = 0; d < 32; ++d) dst[(size_t)d * D] = (bf16)f2bf(acc[d]);
        }
        int ln2 = lane; asm volatile("" : "+v"(ln2));
        for (int i = gw * 64 + ln2; i < S * 8; i += NGW * 64) { const int pos = i >> 3, j = i & 7; const float ang = (float)pos * powf(500000.0f, -(float)(2 * j) / 16.0f);
            CS[pos * 16 + j] = cosf(ang); CS[pos * 16 + 8 + j] = sinf(ang); }
        for (int m = gw; m < M; m += NGW) ln_row(INP(0) + (size_t)m * D, 1.f, nullptr, nullptr, nullptr, INP(2), INP(3), X + (size_t)m * D, XB + (size_t)m * D, lane);
        LDS_WAIT(); __syncthreads();
        for (int it = vcu; it < DEPTH * 64; it += G) { const int fl = it >> 6, pb = it & 63;
            hy::filter_item(lds, pb, INP(7) + fl * 33 * 64, INP(8) + fl * 64, INP(9) + fl * 64, INP(10) + fl * 64 * 64, INP(11) + fl * 64, INP(12) + fl * 64, INP(13) + fl * 64 * 512,
                            (bf16*)(ws + WS_KF) + (size_t)fl * 256 * 8192, (float*)(ws + WS_PS) + (size_t)fl * 64 * 512, wave, lane); }
        SEAM();
    }
#if defined(MK_PER_PHASE)
    for (int l = a.l_lo; l < a.l_hi; ++l) {
#else
#pragma unroll 1
    for (int l = 0; l < DEPTH; ++l) {
#endif
        if (EN_IN && IN(PH_IN)) for (int rep_ = 0; rep_ < DUP_IN; ++rep_) {
            PHASE_PTRS();
            const char* wsw = (const char*)(ws + WS_WIN + (size_t)l * WIN_LAYER);
            SchedIn Sc{vcu, G, (const char*)XB, wsw, wsw + (size_t)1280 * 1024 * 2};
            EpiIn E{QKP, UVT, CS};
            pg8::gemm_phase<EpiIn, SchedIn>(lds, D, Sc, E);
            SEAM();
        }
        if (EN_HY && IN(PH_HY)) for (int rep_ = 0; rep_ < DUP_HY; ++rep_) {
            PHASE_PTRS();
            for (int c = vcu; c < 256; c += G)
                hy::unit(lds, c, (const bf16*)(ws + WS_KF) + (size_t)l * 256 * 8192, (const float*)(ws + WS_PS) + (size_t)l * 64 * 512, UVT, INP(5) + l * 3 * 768, INP(6) + l * 768, INP(14) + l * 256, (bf16*)(ws + WS_HT), wave, lane);
            SEAM();
        }
        if (EN_HYT && IN(PH_HYT)) for (int rep_ = 0; rep_ < DUP_HYT; ++rep_) {
            PHASE_PTRS();
            for (int s = vcu; s < 256; s += G) hy::transpose_slab(lds, s, (const bf16*)(ws + WS_HT), MIXB, wave, lane);
            SEAM();
        }
        if (EN_ATT && IN(PH_ATT)) for (int rep_ = 0; rep_ < DUP_ATT; ++rep_) {
            PHASE_PTRS();
            const float lam_init = 0.8f - 0.6f * expf(-0.3f * (float)l);
            int ln = lane; asm volatile("" : "+v"(ln));
            const float lam = expf(wave_sum(INP(15)[l * 64 + ln] * INP(16)[l * 64 + ln])) - expf(wave_sum(INP(17)[l * 64 + ln] * INP(18)[l * 64 + ln])) + lam_init;
            for (int u = vcu; u < 256; u += G) att::unit(lds, (u >> 4) >> 2, (u >> 4) & 3, u & 15, QKP, UVT, lam, lam_init, INP(19) + l * 128, MIXB, (float*)(ws + WS_STASH) + ((size_t)u * 8 + wave) * 4096, wave, lane);
            SEAM();
        }
        if (EN_POOL && IN(PH_POOL)) for (int rep_ = 0; rep_ < DUP_POOL; ++rep_) {
            PHASE_PTRS();
            int ln = lane; asm volatile("" : "+v"(ln));
            const int cc = (ln & 31) * 8, gq = cc >> 6, hw = 1 << gq;
            const float* pb = INP(21) + l * 256 + cc; const float* psc = INP(22) + l * 256 + cc;
            for (int it = gw; it < M / 2; it += NGW) {
                const int tok = it * 2 + (ln >> 5), pos = tok & (S - 1);
                int lo = pos - hw, hi2 = pos + hw - 1; lo = lo < 0 ? 0 : lo; hi2 = hi2 > S - 1 ? S - 1 : hi2;
                float sacc[8];
#pragma unroll
                for (int e = 0; e < 8; ++e) sacc[e] = 0.f;
                const bf16* zp = QKP + (size_t)(tok - pos) * 1280 + 1024 + cc;
                for (int r = lo; r <= hi2; ++r) { const v4u w = *(const GAS v4u*)(zp + (size_t)r * 1280);
                    sacc[0] += bf2f((bf16)w.x); sacc[1] += bf2f((bf16)(w.x >> 16)); sacc[2] += bf2f((bf16)w.y); sacc[3] += bf2f((bf16)(w.y >> 16));
                    sacc[4] += bf2f((bf16)w.z); sacc[5] += bf2f((bf16)(w.z >> 16)); sacc[6] += bf2f((bf16)w.w); sacc[7] += bf2f((bf16)(w.w >> 16)); }
                const float inv = 1.f / (float)(hi2 - lo + 1);
                const v4u w = *(const GAS v4u*)(zp + (size_t)pos * 1280);
                float z[8] = {bf2f((bf16)w.x), bf2f((bf16)(w.x >> 16)), bf2f((bf16)w.y), bf2f((bf16)(w.y >> 16)), bf2f((bf16)w.z), bf2f((bf16)(w.z >> 16)), bf2f((bf16)w.w), bf2f((bf16)(w.w >> 16))};
                float y[8];
#pragma unroll
                for (int e = 0; e < 8; ++e) y[e] = (sacc[e] * inv - z[e] + pb[e]) * psc[e];
                v4u o; o.x = pk2(y[0], y[1]); o.y = pk2(y[2], y[3]); o.z = pk2(y[4], y[5]); o.w = pk2(y[6], y[7]);
                *(GAS v4u*)(MIXB + (size_t)tok * D + 768 + cc) = o;
            }
            SEAM();
        }
        if (EN_OUT && IN(PH_OUT)) {
            PHASE_PTRS();
            SchedOut Sc{vcu, G, (const char*)MIXB, (const char*)(ws + WS_WOUT + (size_t)l * WOUT_LAYER)};
            EpiRes E{X};
            pg8::gemm_phase<EpiRes, SchedOut>(lds, D, Sc, E);
            SEAM();
        }
        if (EN_LN1 && IN(PH_LN1)) {
            PHASE_PTRS();
            int ln = lane; asm volatile("" : "+v"(ln));
            for (int ch = vcu; ch < M / 64; ch += G)
                ln1_router_chunk((LAS RouteLds*)(lds + ROUTE_OFF), ch * 64, X, XB, INP(24) + l * D, INP(25) + l * D, INP(26) + (size_t)l * D * 4, INP(27) + l * 4, INP(28) + (size_t)l * D * 16, INP(29) + l * 16,
                                 a.eid, a.wts, ctl + CW_CNT + l * 16, (int*)(ws + WS_TOKIDX), (float*)(ws + WS_GATE), wave, lane);
            SEAM();
        }
        if (EN_WCV && IN(PH_WCV)) for (int rep_ = 0; rep_ < DUP_WCV; ++rep_) {
            PHASE_PTRS();
            LAS float* scr = (LAS float*)(lds + wave * 16384);
            bf16* W13 = (bf16*)(ws + WS_W13); bf16* W2 = (bf16*)(ws + WS_W2); bf16* WG = (bf16*)(ws + WS_WG); bf16* WP = (bf16*)(ws + WS_WP);
            for (int it = gw; it < 6784; it += NGW) {
                const float* src; int K, N, k0, n0, mode = 0; bf16* dst;
                if (it < 4096) { const int which = it >> 11, r = it & 2047, e = r >> 7, kb = (r >> 3) & 15, nb = r & 7;
                    src = INP(which ? 31 : 30) + ((size_t)l * 16 + e) * D * 256; K = D; N = 256; k0 = kb * 64; n0 = nb * 32; mode = 1 + which; dst = W13 + (size_t)e * 512 * D;
                } else if (it < 6144) { const int r = it - 4096, e = r >> 7, kb = (r >> 5) & 3, nb = r & 31;
                    src = INP(32) + ((size_t)l * 16 + e) * 256 * D; K = 256; N = D; k0 = kb * 64; n0 = nb * 32; dst = W2 + (size_t)e * D * 256 + (size_t)n0 * 256;
                } else if (it < 6656) { const int r = it - 6144, kb = r >> 5, nb = r & 31;
                    src = INP(33) + (size_t)l * D * D; K = D; N = D; k0 = kb * 64; n0 = nb * 32; dst = WG + (size_t)n0 * D;
                } else { const int r = it - 6656, kb = r >> 5, nb = r & 31;
                    src = INP(35) + (size_t)l * 256 * D; K = 256; N = D; k0 = kb * 64; n0 = nb * 32; dst = WP + (size_t)n0 * 256; }
                p0_transpose_block(src, K, N, k0, n0, dst, mode, scr, lane);
            }
            int ln = lane; asm volatile("" : "+v"(ln));
            const float* ps = INP(1) + (size_t)l * M * 256; bf16* PB = (bf16*)(ws + WS_PB);
            for (size_t i = ((size_t)gw * 64 + ln) * 8; i < (size_t)M * 256; i += (size_t)NGW * 64 * 8) { const f32x4 x0 = *(const GAS f32x4*)(ps + i), x1 = *(const GAS f32x4*)(ps + i + 4);
                v4u o; o.x = pk2(x0.x, x0.y); o.y = pk2(x0.z, x0.w); o.z = pk2(x1.x, x1.y); o.w = pk2(x1.z, x1.w); *(GAS v4u*)(PB + i) = o; }
            SEAM();
        }
        if (EN_MOE1 && IN(PH_MOE1)) for (int rep_ = 0; rep_ < DUP_MOE1; ++rep_) {
            PHASE_PTRS();
            moe_tab_build((LAS int*)(lds + MOETAB_OFF), ctl + CW_CNT + l * 16); const MoeTab T{(LAS const int*)(lds + MOETAB_OFF)};
            { SchedMoe<2> Sc{vcu, G, T, (const char*)XB, (const char*)(ws + WS_W13), (size_t)512 * D * 2, (const int*)(ws + WS_TOKIDX), 0};
              EpiMoe1 E{(bf16*)(ws + WS_ACT), (const float*)(ws + WS_GATE), T};
              pg8::gemm_phase<EpiMoe1, SchedMoe<2>, true>(lds, D, Sc, E); }
            { SchedSq Sc{vcu, G, (const char*)(ws + WS_PB), (const char*)(ws + WS_WP), (size_t)256 * 256 * 2, (size_t)256 * 256 * 2};
              EpiPle<0> E{(bf16*)(ws + WS_YP), nullptr};
              pg8::gemm_phase<EpiPle<0>, SchedSq>(lds, 256, Sc, E); }
            { SchedSq Sc{vcu, G, (const char*)XB, (const char*)(ws + WS_WG), TILEB, TILEB};
              EpiPle<1> E{(bf16*)(ws + WS_YP), INP(34) + l * D};
              pg8::gemm_phase<EpiPle<1>, SchedSq>(lds, D, Sc, E); }
            SEAM();
        }
        if (EN_MOE2 && IN(PH_MOE2)) for (int rep_ = 0; rep_ < DUP_MOE2; ++rep_) {
            PHASE_PTRS();
            moe_tab_build((LAS int*)(lds + MOETAB_OFF), ctl + CW_CNT + l * 16); const MoeTab T{(LAS const int*)(lds + MOETAB_OFF)};
            SchedMoe<4> Sc{vcu, G, T, (const char*)(ws + WS_ACT), (const char*)(ws + WS_W2), (size_t)D * 256 * 2, (const int*)(ws + WS_TOKIDX), (size_t)256 * 256 * 2};
            EpiMoe2 E{(bf16*)(ws + WS_YMOE), (const int*)(ws + WS_TOKIDX), T};
            pg8::gemm_phase<EpiMoe2, SchedMoe<4>>(lds, 256, Sc, E);
            SEAM();
        }
        if (EN_LN2 && IN(PH_LN2)) {
            PHASE_PTRS();
            int ln = lane; asm volatile("" : "+v"(ln));
            const bf16* YM = (const bf16*)(ws + WS_YMOE); const bf16* YP = (const bf16*)(ws + WS_YP);
            const bool lastl = (l == DEPTH - 1);
            for (int m = gw; m < M; m += NGW)
                ln_row(X + (size_t)m * D, DN_ALPHA, YM + (size_t)(2 * m) * D, YM + (size_t)(2 * m + 1) * D, YP + (size_t)m * D, INP(36) + l * D, INP(37) + l * D,
                       lastl ? a.out + (size_t)m * D : X + (size_t)m * D, lastl ? nullptr : XB + (size_t)m * D, ln);
            SEAM();
        }
    }
#undef IN
#undef SEAM
}
static void mk_launch(const Args& base, int ph, int l, int grid, hipStream_t stream) {
    Args a = base; a.ph_lo = ph; a.ph_hi = ph + 1; a.l_lo = l; a.l_hi = l + 1; a.single = 1;
    hipLaunchKernelGGL(mk_fwd, dim3(grid), dim3(NWAVES * 64), LDS_BYTES, stream, a);
}
extern "C" void kernel_launch(void* const* d_in, const int* in_sizes, int n_in, void* d_out, int out_size, void* d_ws, size_t ws_size, hipStream_t stream) {
    (void)in_sizes; (void)n_in; (void)out_size; (void)ws_size;
    static int grid = 0;
    if (grid == 0) {
        int dev = 0, cus = 0;
        if (hipGetDevice(&dev) != hipSuccess || hipDeviceGetAttribute(&cus, hipDeviceAttributeMultiprocessorCount, dev) != hipSuccess) { grid = -1; return; }
        if (hipFuncSetAttribute((const void*)mk_fwd, hipFuncAttributeMaxDynamicSharedMemorySize, LDS_BYTES) != hipSuccess) { grid = -1; return; }
        (void)hipGetLastError();
        grid = cus;
    }
    if (grid < 0) return;
    (void)hipMemsetAsync((char*)d_ws + WS_CTL, 0, CTL_ZERO_BYTES, stream);
    Args base{};
    for (int i = 0; i < 38; ++i) base.in[i] = (const float*)d_in[i];
    base.out = (float*)d_out; base.ws = (unsigned char*)d_ws;
    base.eid = nullptr; base.wts = nullptr;
#if defined(MK_PER_PHASE)
    mk_launch(base, PH_PRO, 0, grid, stream);
    for (int l = 0; l < DEPTH; ++l) for (int ph : {PH_IN, PH_HY, PH_HYT, PH_ATT, PH_POOL, PH_OUT, PH_LN1, PH_WCV, PH_MOE1, PH_MOE2, PH_LN2}) mk_launch(base, ph, l, grid, stream);
#else
    Args a = base; a.ph_lo = 0; a.ph_hi = PH_END; a.l_lo = 0; a.l_hi = DEPTH; a.single = 0;
    hipLaunchKernelGGL(mk_fwd, dim3(grid), dim3(NWAVES * 64), LDS_BYTES, stream, a);
#endif
}
```

```cpp
#include <hip/hip_runtime.h>
#include <stdint.h>
#include <math.h>
namespace pg8 {
#define PG8_LAS __attribute__((address_space(3)))
typedef unsigned short bf16_t;
typedef short bf16x8 __attribute__((ext_vector_type(8)));
typedef float f32x4 __attribute__((ext_vector_type(4)));
typedef unsigned u32x4 __attribute__((ext_vector_type(4)));
constexpr int BM = 256, BK = 64, HALF = 128, HTB = HALF * BK * 2  , STAGE_BYTES = 8 * HTB;

__host__ __device__ __forceinline__ int lds_byte(int r, int c) { const int st = (r >> 4) * 2 + (c >> 5), rr = r & 15, cc = c & 31, ob = rr * 64 + cc * 2; return st * 1024 + (ob ^ (((ob >> 9) & 1) << 5)); }
__host__ __device__ __forceinline__ void stage_rc(int b, int& R, int& C) { const int st = b / 1024, sb = b % 1024, swz = sb ^ (((sb >> 9) & 1) << 5); R = (st >> 1) * 16 + swz / 64; C = (st & 1) * 32 + (swz % 64) / 2; }
__host__ __device__ __forceinline__ int perm32(int rho) { const int n = rho >> 4, i = rho & 15; return 8 * (i >> 2) + 4 * n + (i & 3); }

struct Unit { const char* A; const char* B; int kind, pm, pn, aux; };

__device__ __forceinline__ unsigned cvt_pk_bf16(float lo, float hi) { unsigned r; asm volatile("v_cvt_pk_bf16_f32 %0, %1, %2" : "=v"(r) : "v"(lo), "v"(hi)); return r; }

template <class Epi, class Sched, bool GATHER = false>
__device__ __forceinline__ void gemm_phase(PG8_LAS unsigned char* lds, const int K_, const Sched& S, const Epi& E, const int wave_) {
    int K = K_; asm volatile("" : "+s"(K));
    int tid_; asm volatile("v_mbcnt_lo_u32_b32 %0, -1, 0\n\tv_mbcnt_hi_u32_b32 %0, -1, %0" : "=v"(tid_)); tid_ += wave_ * 64;
    const int tid = tid_, wid = __builtin_amdgcn_readfirstlane(tid >> 6), lane = tid & 63, wr = wid >> 2, wc = wid & 3, fr = lane & 15, fq = lane >> 4;
    const int nt = K / BK;
    unsigned voffA[2][2], voffN[2][2] = {{0u, 0u}, {0u, 0u}}, voffB[2]; int RA[2], CA[2];
#pragma unroll
    for (int i = 0; i < 2; ++i) { int R, C; stage_rc(tid * 16 + i * 8192, R, C); const int Rb = Epi::PERM ? ((R & ~31) + perm32(R & 31)) : R; RA[i] = R; CA[i] = C;
        voffA[0][i] = (unsigned)(R * K + C) * 2u; voffA[1][i] = (unsigned)((R + HALF) * K + C) * 2u; voffB[i] = (unsigned)(Rb * K + C) * 2u; }
    const size_t kstep = (size_t)(BK * 2);
    const size_t hstep = (size_t)HALF * K * 2;
    const unsigned ldsw = (unsigned)wid * 1024u;
    const int aoff = lds_byte(wr * 64 + fr, fq * 8), boff = lds_byte(wc * 32 + fr, fq * 8);
#define PG8_SA(b, h) (((b) * 2 + (h)) * HTB)
#define PG8_SB(b, h) ((4 + (b) * 2 + (h)) * HTB)
#define PG8_STAGE(bufoff, gbase, voff) do { _Pragma("unroll") for (int _i = 0; _i < 2; ++_i) \
        __builtin_amdgcn_global_load_lds((const unsigned*)((const char*)(gbase) + (voff)[_i]), (PG8_LAS unsigned*)(lds + (bufoff) + ldsw + _i * 8192), 16, 0, 0); } while (0)
#define PG8_LDA(dst, b, h) do { _Pragma("unroll") for (int m = 0; m < 4; ++m) _Pragma("unroll") for (int k = 0; k < 2; ++k) dst[m][k] = *(const PG8_LAS bf16x8*)(lds + PG8_SA(b, h) + aoff + m * 2048 + k * 1024); } while (0)
#define PG8_LDB(dst, b, h) do { _Pragma("unroll") for (int n = 0; n < 2; ++n) _Pragma("unroll") for (int k = 0; k < 2; ++k) dst[n][k] = *(const PG8_LAS bf16x8*)(lds + PG8_SB(b, h) + boff + n * 2048 + k * 1024); } while (0)
#define PG8_MMA(ai, bj, At, Bt) do { __builtin_amdgcn_s_setprio(1); _Pragma("unroll") for (int m = 0; m < 4; ++m) _Pragma("unroll") for (int n = 0; n < 2; ++n) _Pragma("unroll") for (int k = 0; k < 2; ++k) \
        acc[ai][bj][m][n] = __builtin_amdgcn_mfma_f32_16x16x32_bf16(Bt[n][k], At[m][k], acc[ai][bj][m][n], 0, 0, 0); __builtin_amdgcn_s_setprio(0); } while (0)
#define PG8_WAIT_V(n) asm volatile("s_waitcnt vmcnt(" #n ")" ::: "memory")
#define PG8_WAIT_L(n) asm volatile("s_waitcnt lgkmcnt(" #n ")" ::: "memory")
#define PG8_BAR __builtin_amdgcn_s_barrier()
#define PG8_SCHED __builtin_amdgcn_sched_barrier(0)
    Unit cur, nxt; int ui = 0;
    if (!S.next(0, cur)) return;
    if constexpr (GATHER) {
#pragma unroll
        for (int h = 0; h < 2; ++h)
#pragma unroll
            for (int i = 0; i < 2; ++i) voffA[h][i] = (unsigned)(S.arow(cur, h * HALF + RA[i]) * K + CA[i]) * 2u;
    }
    f32x4 acc[2][2][4][2];
#pragma unroll
    for (int a = 0; a < 2; ++a)
#pragma unroll
        for (int b = 0; b < 2; ++b)
#pragma unroll
            for (int m = 0; m < 4; ++m)
#pragma unroll
                for (int n = 0; n < 2; ++n) acc[a][b][m][n] = (f32x4){0.f, 0.f, 0.f, 0.f};
    bf16x8 At[4][2], B0[2][2], B1[2][2];
    const char* cA = cur.A; const char* cB = cur.B;
    PG8_STAGE(PG8_SB(0, 0), cB, voffB); PG8_STAGE(PG8_SB(0, 1), cB + hstep, voffB); PG8_STAGE(PG8_SA(0, 0), cA, voffA[0]); PG8_STAGE(PG8_SA(0, 1), cA, voffA[1]);
    if (wr == 1) PG8_BAR;
    PG8_WAIT_V(2); PG8_BAR;
    PG8_STAGE(PG8_SB(1, 0), cB + kstep, voffB); PG8_STAGE(PG8_SA(1, 0), cA + kstep, voffA[0]); PG8_STAGE(PG8_SB(1, 1), cB + hstep + kstep, voffB);
    PG8_WAIT_V(6); PG8_BAR;
    for (;;) {
        const bool has_next = S.next(ui + 1, nxt);
        const char* nA = has_next ? nxt.A : cA; const char* nB = has_next ? nxt.B : cB;
        if constexpr (GATHER) {
#pragma unroll
            for (int h = 0; h < 2; ++h)
#pragma unroll
                for (int i = 0; i < 2; ++i) voffN[h][i] = has_next ? (unsigned)(S.arow(nxt, h * HALF + RA[i]) * K + CA[i]) * 2u : voffA[h][i];
        }
#pragma unroll 1
        for (int t = 0; t < nt; t += 2) {
            const bool last = (t == nt - 2);
            const char* a1 = cA + (size_t)(t + 1) * kstep;
            const char* a2 = last ? nA : cA + (size_t)(t + 2) * kstep; const char* b2 = last ? nB : cB + (size_t)(t + 2) * kstep;
            const char* a3 = a2 + kstep; const char* b3 = b2 + kstep;
            PG8_LDB(B0, 0, 0); PG8_LDB(B1, 0, 1); PG8_SCHED; PG8_LDA(At, 0, 0); PG8_STAGE(PG8_SA(1, 1), a1, voffA[1]);
            if constexpr (GATHER) { if (last) {
#pragma unroll
                for (int h = 0; h < 2; ++h)
#pragma unroll
                    for (int i = 0; i < 2; ++i) voffA[h][i] = voffN[h][i]; } }
            PG8_WAIT_V(8); PG8_WAIT_L(0); PG8_BAR; PG8_MMA(0, 0, At, B0); PG8_MMA(0, 1, At, B1); PG8_BAR; PG8_SCHED;
            PG8_LDA(At, 0, 1); PG8_STAGE(PG8_SB(0, 0), b2, voffB); PG8_STAGE(PG8_SB(0, 1), b2 + hstep, voffB); PG8_STAGE(PG8_SA(0, 0), a2, voffA[0]);
            PG8_WAIT_V(8); PG8_WAIT_L(0); PG8_BAR; PG8_MMA(1, 0, At, B0); PG8_MMA(1, 1, At, B1); PG8_BAR; PG8_SCHED;
            PG8_LDB(B0, 1, 0); PG8_LDB(B1, 1, 1); PG8_SCHED; PG8_LDA(At, 1, 0); PG8_STAGE(PG8_SA(0, 1), a2, voffA[1]);
            PG8_WAIT_V(8); PG8_WAIT_L(0); PG8_BAR; PG8_MMA(0, 0, At, B0); PG8_MMA(0, 1, At, B1); PG8_BAR; PG8_SCHED;
            PG8_LDA(At, 1, 1); PG8_STAGE(PG8_SB(1, 0), b3, voffB); PG8_STAGE(PG8_SB(1, 1), b3 + hstep, voffB); PG8_STAGE(PG8_SA(1, 0), a3, voffA[0]);
            PG8_WAIT_V(8); PG8_WAIT_L(0); PG8_BAR; PG8_MMA(1, 0, At, B0); PG8_MMA(1, 1, At, B1); PG8_BAR; PG8_SCHED;
        }
        if (wr == 0) PG8_BAR;
        { Unit ce = cur; ce.pm = __builtin_amdgcn_readfirstlane(cur.pm); ce.pn = __builtin_amdgcn_readfirstlane(cur.pn); ce.kind = __builtin_amdgcn_readfirstlane(cur.kind); ce.aux = __builtin_amdgcn_readfirstlane(cur.aux); int fr_ = fr, fq_ = fq;
          asm volatile("" : "+s"(ce.pm), "+s"(ce.pn), "+s"(ce.kind), "+s"(ce.aux), "+v"(fr_), "+v"(fq_));
          E(acc, ce, wr, wc, fr_, fq_); }
        if (!has_next) break;
#pragma unroll
        for (int a = 0; a < 2; ++a)
#pragma unroll
            for (int b = 0; b < 2; ++b)
#pragma unroll
                for (int m = 0; m < 4; ++m)
#pragma unroll
                    for (int n = 0; n < 2; ++n) acc[a][b][m][n] = (f32x4){0.f, 0.f, 0.f, 0.f};
        cur = nxt; cA = nA; cB = nB; ++ui;
        if (wr == 1) PG8_BAR;
    }
    PG8_WAIT_V(0);
    PG8_BAR;
#undef PG8_SA
#undef PG8_SB
#undef PG8_STAGE
#undef PG8_LDA
#undef PG8_LDB
#undef PG8_MMA
#undef PG8_WAIT_V
#undef PG8_WAIT_L
#undef PG8_BAR
#undef PG8_SCHED
}
}
constexpr int D = 1024, NB = 4, S = 4096, M = NB * S, DEPTH = 4, INW = 2560;
constexpr float DN_ALPHA = 1.681792830507429f;
constexpr float QSCALE = 0.125f * 1.4426950408889634f;
constexpr int NWAVES = 8;
constexpr size_t MiB = 1u << 20;
constexpr size_t TILEB = (size_t)256 * D * 2;
constexpr size_t WS_CTL = 0, CTL_ZERO_BYTES = 1 * MiB;
constexpr size_t WS_CS = 1 * MiB;
constexpr size_t WS_WIN = 2 * MiB, WIN_LAYER = 5 * MiB;
constexpr size_t WS_XB = 22 * MiB;
constexpr size_t WS_QKP = 118 * MiB;
constexpr size_t WS_UVT = 158 * MiB;
constexpr size_t WS_MIXB = 198 * MiB;
constexpr size_t WS_STASH = 54 * MiB;
constexpr size_t WS_WOUT = 383 * MiB, WOUT_LAYER = 2 * MiB;
constexpr size_t WS_TOKIDX = 391 * MiB, WS_GATE = 392 * MiB;
constexpr size_t WS_YMOE = WS_QKP;
constexpr size_t WS_YP = 86 * MiB;
constexpr size_t WS_ACT = 230 * MiB;
constexpr size_t WS_PB = 248 * MiB;
constexpr size_t WS_W13 = 351 * MiB, WS_W2 = 367 * MiB, WS_WG = 375 * MiB, WS_WP = 377 * MiB;
constexpr size_t WS_KF = 262 * MiB, WS_PS = 278 * MiB, WS_HT = 280 * MiB;
constexpr int CW_BAR = 4096, CW_CNT = 8192;

#define GAS __attribute__((address_space(1)))
#define LAS __attribute__((address_space(3)))
typedef unsigned short bf16;
typedef unsigned v4u __attribute__((ext_vector_type(4)));
typedef float f32x4 __attribute__((ext_vector_type(4)));
typedef short bf16x8 __attribute__((ext_vector_type(8)));
typedef GAS unsigned gu32;
typedef GAS unsigned long long gu64;
#define RLX_AGENT __ATOMIC_RELAXED, __HIP_MEMORY_SCOPE_AGENT
#define LDS_WAIT() asm volatile("s_waitcnt lgkmcnt(0)" ::: "memory")
#define VM_WAIT() asm volatile("s_waitcnt vmcnt(0)" ::: "memory")
__device__ __forceinline__ unsigned long long rt() { return __builtin_amdgcn_s_memrealtime(); }
__device__ __forceinline__ unsigned f2bf(float f) { unsigned u = __builtin_bit_cast(unsigned, f); return (u + 0x7fffu + ((u >> 16) & 1u)) >> 16; }
__device__ __forceinline__ unsigned pk2(float lo, float hi) { return f2bf(lo) | (f2bf(hi) << 16); }

#define XB_TMO      128
#define XB_XCNT(j)  (256  + 64 * (j))
#define XB_XSUB(j)  (1280 + 64 * (j))
#define XB_XGEN(j)  (2304 + 64 * (j))
#define XB_TOP      3328
#define XB_TOPGEN   3392
#define XCD_BAR_WORDS 3456
#define XB_SPIN_CAP (1u << 18)

__device__ __forceinline__ unsigned xb_ld(unsigned* p)              { return __hip_atomic_load(p, __ATOMIC_RELAXED, __HIP_MEMORY_SCOPE_AGENT); }
__device__ __forceinline__ unsigned xb_add(unsigned* p, unsigned v) { return __hip_atomic_fetch_add(p, v, __ATOMIC_RELAXED, __HIP_MEMORY_SCOPE_AGENT); }
__device__ __forceinline__ unsigned xb_xcc_id() { return (unsigned)__builtin_amdgcn_s_getreg((3 << 11) | 20) & 0xFu; }
#define XB_SPIN(cond, bar) do { unsigned _sp = 0; while (cond) { __builtin_amdgcn_s_sleep(1); \
    if ((++_sp & 255u) == 0u) { if (xb_ld(&(bar)[XB_TMO])) break; if (_sp > XB_SPIN_CAP) { atomicAdd(&(bar)[XB_TMO], 1u); break; } } } } while (0)

struct XcdBarrier {
    unsigned* bar; unsigned x;
    volatile LAS unsigned* st;
};

__device__ __forceinline__ unsigned mk_lane_id() { unsigned x; asm volatile("v_mbcnt_lo_u32_b32 %0, -1, 0\n\tv_mbcnt_hi_u32_b32 %0, -1, %0" : "=v"(x)); return x; }
__device__ __forceinline__ XcdBarrier xcd_barrier_post(unsigned* bar, volatile LAS unsigned* st, int wave) {
    XcdBarrier b; b.bar = bar; b.x = xb_xcc_id(); b.st = st;
    if (wave == 0 && mk_lane_id() == 0u) (void)xb_add(&bar[XB_XCNT(b.x)], 1u);
    return b;
}
__device__ __forceinline__ void xcd_barrier_complete(unsigned* bar, unsigned x, unsigned& nloc, unsigned& nx) {
    const unsigned G = gridDim.x * gridDim.y * gridDim.z;
    unsigned sum, cnt, mine, sp = 0u;
    for (;;) {
        sum = 0u; cnt = 0u; mine = 0u;
#pragma unroll
        for (unsigned j = 0; j < 16; ++j) { const unsigned c = xb_ld(&bar[XB_XCNT(j)]); sum += c; cnt += (c > 0u) ? 1u : 0u; mine = (j == x) ? c : mine; }
        if (sum == G) break;
        __builtin_amdgcn_s_sleep(1);
        if ((++sp & 255u) == 0u) { if (xb_ld(&bar[XB_TMO])) break; if (sp > XB_SPIN_CAP) { atomicAdd(&bar[XB_TMO], 1u); break; } }
    }
    nloc = mine > 0u ? mine : 1u; nx = cnt > 0u ? cnt : 1u;
}

__device__ __forceinline__ void xcd_barrier(const XcdBarrier& b, int wave) {
    asm volatile("" : "+s"(wave));
    const bool t0_ = (wave == 0) && (mk_lane_id() == 0u);
    asm volatile("s_waitcnt vmcnt(0)" ::: "memory");
    __syncthreads();
    if (t0_) {
        unsigned* bar = b.bar; unsigned bx_ = b.x; asm volatile("" : "+s"(bx_));
        __builtin_amdgcn_s_waitcnt(0);
        unsigned nloc = b.st[0], nx = b.st[1];
        if (nloc == 0u) { xcd_barrier_complete(bar, bx_, nloc, nx); b.st[0] = nloc; b.st[1] = nx; }
        const unsigned old = xb_add(&bar[XB_XSUB(bx_)], 1u);
        const unsigned gen = old / nloc;
        if (old + 1u == (gen + 1u) * nloc) {
            __builtin_amdgcn_fence(__ATOMIC_RELEASE, "agent");
            asm volatile("s_waitcnt vmcnt(0)" ::: "memory");
            const unsigned og = xb_add(&bar[XB_TOP], 1u);
            const unsigned tg = og / nx;
            if (og + 1u == (tg + 1u) * nx) xb_add(&bar[XB_TOPGEN], 1u);
            else XB_SPIN(xb_ld(&bar[XB_TOPGEN]) == tg, bar);
            __builtin_amdgcn_fence(__ATOMIC_ACQUIRE, "agent");
            xb_add(&bar[XB_XGEN(bx_)], 1u);
            asm volatile("s_waitcnt vmcnt(0)" ::: "memory");
        } else {
            XB_SPIN(xb_ld(&bar[XB_XGEN(bx_)]) == gen, bar);
            __builtin_amdgcn_fence(__ATOMIC_ACQUIRE, "agent");
            asm volatile("s_waitcnt vmcnt(0)" ::: "memory");
        }
    }
    __syncthreads();
}
__device__ __forceinline__ float bf2f(unsigned short b) { return __uint_as_float((unsigned)b << 16); }
__device__ __forceinline__ float wave_sum(float v) {
#pragma unroll
    for (int o = 1; o < 64; o <<= 1) v += __shfl_xor(v, o);
    return v;
}
__device__ __forceinline__ void p0_transpose_block(const float* W, int K, int N, int k0, int n0, bf16* WT, int mode, LAS float* scr, int lane) {
#pragma unroll 4
    for (int i = 0; i < 32; ++i) { const int kk = 2 * i + (lane >> 5); scr[kk * 33 + (lane & 31)] = W[(size_t)(k0 + kk) * N + n0 + (lane & 31)]; }
    LDS_WAIT(); asm volatile("" ::: "memory");
    const int c = lane & 7;
#pragma unroll 1
    for (int j = 0; j < 4; ++j) { const int n = (lane >> 3) + 8 * j; const LAS float* s = scr + (8 * c) * 33 + n;
        v4u o; o.x = pk2(s[0 * 33], s[1 * 33]); o.y = pk2(s[2 * 33], s[3 * 33]); o.z = pk2(s[4 * 33], s[5 * 33]); o.w = pk2(s[6 * 33], s[7 * 33]);
        const int f = n0 + n; const size_t drow = mode == 0 ? (size_t)n : (size_t)(8 * (f >> 2) + (f & 3) + (mode == 2 ? 4 : 0));
        *(GAS v4u*)(WT + drow * K + k0 + 8 * c) = o; }
    LDS_WAIT(); asm volatile("" ::: "memory");
}
template <class TX> __device__ __forceinline__ void ln_row(const TX* x0, float a, const bf16* y1, const bf16* y2, const bf16* y3, const float* g, const float* b, float* of, bf16* ob, int lane) {
    f32x4 v[4]; float s = 0.f;
#pragma unroll
    for (int j = 0; j < 4; ++j) { const int c = 4 * lane + 256 * j;
        if constexpr (sizeof(TX) == 4) v[j] = *(const GAS f32x4*)(x0 + c) * a;
        else { const unsigned long long w = *(const GAS unsigned long long*)(x0 + c); v[j] = (f32x4){bf2f((bf16)w), bf2f((bf16)(w >> 16)), bf2f((bf16)(w >> 32)), bf2f((bf16)(w >> 48))} * a; }
        if (y1) { const unsigned long long w = *(const GAS unsigned long long*)(y1 + c); v[j] += (f32x4){bf2f((bf16)w), bf2f((bf16)(w >> 16)), bf2f((bf16)(w >> 32)), bf2f((bf16)(w >> 48))}; }
        if (y2) { const unsigned long long w = *(const GAS unsigned long long*)(y2 + c); v[j] += (f32x4){bf2f((bf16)w), bf2f((bf16)(w >> 16)), bf2f((bf16)(w >> 32)), bf2f((bf16)(w >> 48))}; }
        if (y3) { const unsigned long long w = *(const GAS unsigned long long*)(y3 + c); v[j] += (f32x4){bf2f((bf16)w), bf2f((bf16)(w >> 16)), bf2f((bf16)(w >> 32)), bf2f((bf16)(w >> 48))}; }
        s += (v[j].x + v[j].y) + (v[j].z + v[j].w); }
    const float mean = wave_sum(s) * (1.f / D); float s2 = 0.f;
#pragma unroll
    for (int j = 0; j < 4; ++j) { v[j] = v[j] - mean; s2 += (v[j].x * v[j].x + v[j].y * v[j].y) + (v[j].z * v[j].z + v[j].w * v[j].w); }
    const float rstd = 1.f / sqrtf(wave_sum(s2) * (1.f / D) + 1e-5f);
#pragma unroll
    for (int j = 0; j < 4; ++j) { const int c = 4 * lane + 256 * j; const f32x4 o = v[j] * rstd * *(const GAS f32x4*)(g + c) + *(const GAS f32x4*)(b + c);
        if (of) *(GAS f32x4*)(of + c) = o;
        if (ob) *(GAS unsigned long long*)(ob + c) = (unsigned long long)pk2(o.x, o.y) | ((unsigned long long)pk2(o.z, o.w) << 32); }
}

struct SchedIn {
    int vcu, G; const char* xb; const char* wsw; const char* wnm;
    __device__ __forceinline__ bool next(int i, pg8::Unit& u) const {
        const int L = i * G + vcu; if (L >= 640) return false;
        const int t = L / 10, j = L % 10;
        const int sw = __builtin_amdgcn_readfirstlane((unsigned)(j + 27) >> 5);
        const int jj = j - 5 * sw; const char* tp = xb + (size_t)t * TILEB; const char* wp = (sw ? wsw : wnm) + (size_t)jj * TILEB;
        u.kind = sw; u.pm = sw ? jj : t; u.pn = sw ? t : jj; u.A = sw ? wp : tp; u.B = sw ? tp : wp;
        u.aux = 0; return true;
    }
};
struct EpiIn {
    static constexpr bool PERM = true;
    bf16* qkp; bf16* uvt; const float* cs;
    __device__ __forceinline__ void operator()(const pg8::f32x4 (&acc)[2][2][4][2], const pg8::Unit& u, int wr, int wc, int fr, int fq) const {
        bf16* base = u.kind == 0 ? qkp : uvt; const int ldc = u.kind == 0 ? 1280 : M;
        const int row0 = u.pm * 256 + wr * 64 + fr, col0 = u.pn * 256 + wc * 32 + 8 * fq;
        const bool rope = (u.kind == 0) && (u.pn < 4) && ((wc & 1) == 0);
        const float sc = (u.kind == 0 && u.pn < 2) ? QSCALE : 1.f;
        const float sgn = fq == 0 ? -1.f : 1.f;
        const bool vperm = (u.kind == 1) && (u.pm >= 3);
#pragma unroll
        for (int ai = 0; ai < 2; ++ai)
#pragma unroll
            for (int m = 0; m < 4; ++m) { const int row = row0 + ai * 128 + m * 16; bf16* rowp = base + (size_t)row * ldc + col0;
                f32x4 cv0 = {1.f, 1.f, 1.f, 1.f}, cv1 = cv0, sv0 = {0.f, 0.f, 0.f, 0.f}, sv1 = sv0;
                if (rope && fq < 2) { const float* t = cs + (size_t)(row & (S - 1)) * 16; cv0 = *(const f32x4*)t; cv1 = *(const f32x4*)(t + 4); sv0 = *(const f32x4*)(t + 8) * sgn; sv1 = *(const f32x4*)(t + 12) * sgn; }
#pragma unroll
                for (int bj = 0; bj < 2; ++bj) { f32x4 v0 = acc[ai][bj][m][0], v1 = acc[ai][bj][m][1];
                    if (rope) { f32x4 p0, p1;
#pragma unroll
                        for (int e = 0; e < 4; ++e) { p0[e] = __shfl_xor(v0[e], 16); p1[e] = __shfl_xor(v1[e], 16); }
                        v0 = v0 * cv0 + p0 * sv0; v1 = v1 * cv1 + p1 * sv1; }
                    v0 = v0 * sc; v1 = v1 * sc;
                    pg8::u32x4 w; w.x = pg8::cvt_pk_bf16(v0[0], v0[1]); w.y = pg8::cvt_pk_bf16(v0[2], v0[3]); w.z = pg8::cvt_pk_bf16(v1[0], v1[1]); w.w = pg8::cvt_pk_bf16(v1[2], v1[3]);
                    if (vperm) {
                        bf16* gp = rowp + bj * 128 - (fq & 1) * 8;
                        typedef unsigned u32x2 __attribute__((ext_vector_type(2)));
                        *(u32x2*)(gp + ((fq & 1) ? 4 : 0)) = (u32x2){w.x, w.y}; *(u32x2*)(gp + ((fq & 1) ? 12 : 8)) = (u32x2){w.z, w.w};
                    } else *(pg8::u32x4*)(rowp + bj * 128) = w; } }
    }
};

struct SchedOut {
    int vcu, G; const char* a; const char* w;
    __device__ __forceinline__ bool next(int i, pg8::Unit& u) const {
        const int L = i * G + vcu; if (L >= 256) return false;
        u.kind = 0; u.pm = L >> 2; u.pn = L & 3; u.aux = 0; u.A = a + (size_t)u.pm * TILEB; u.B = w + (size_t)u.pn * TILEB; return true;
    }
};
struct EpiRes {
    static constexpr bool PERM = true;
    bf16* XB;
    __device__ __forceinline__ void operator()(const pg8::f32x4 (&acc)[2][2][4][2], const pg8::Unit& u, int wr, int wc, int fr, int fq) const {
        const int row0 = u.pm * 256 + wr * 64 + fr, col0 = u.pn * 256 + wc * 32 + 8 * fq;
#pragma unroll
        for (int ai = 0; ai < 2; ++ai)
#pragma unroll
            for (int m = 0; m < 4; ++m) { bf16* rowp = XB + (size_t)(row0 + ai * 128 + m * 16) * D + col0;
#pragma unroll
                for (int bj = 0; bj < 2; ++bj) { pg8::u32x4* p = (pg8::u32x4*)(rowp + bj * 128); const pg8::u32x4 x = *p; const pg8::f32x4 v0 = acc[ai][bj][m][0], v1 = acc[ai][bj][m][1];
                    pg8::u32x4 w; w.x = pg8::cvt_pk_bf16(bf2f((bf16)x.x) * DN_ALPHA + v0[0], bf2f((bf16)(x.x >> 16)) * DN_ALPHA + v0[1]); w.y = pg8::cvt_pk_bf16(bf2f((bf16)x.y) * DN_ALPHA + v0[2], bf2f((bf16)(x.y >> 16)) * DN_ALPHA + v0[3]);
                    w.z = pg8::cvt_pk_bf16(bf2f((bf16)x.z) * DN_ALPHA + v1[0], bf2f((bf16)(x.z >> 16)) * DN_ALPHA + v1[1]); w.w = pg8::cvt_pk_bf16(bf2f((bf16)x.w) * DN_ALPHA + v1[2], bf2f((bf16)(x.w >> 16)) * DN_ALPHA + v1[3]);
                    *p = w; } }
    }
};
struct RouteLds { unsigned lcnt[16]; unsigned gbase[16]; int e0[64], e1[64]; unsigned r0[64], r1[64]; float g0[64], g1[64]; };
__device__ __forceinline__ void ln1_router_chunk(LAS RouteLds* R, int row0, bf16* XB, const float* g, const float* b, const float* wgc, const float* bgc, const float* wgf, const float* bgf,
                                                 int* eid, float* wts, gu32* cnt, int* tokidx, float* gate, int wave, int lane) {
    const int tidl = wave * 64 + lane;
    if (tidl < 16) R->lcnt[tidl] = 0u;
    LDS_WAIT(); __syncthreads();
#pragma unroll 1
    for (int pass = 0; pass < 2; ++pass) {
        const int rl0 = wave * 8 + pass * 4;
        f32x4 o[4][4];
#pragma unroll
        for (int r = 0; r < 4; ++r) { bf16* xbrow = XB + (size_t)(row0 + rl0 + r) * D; float s = 0.f;
#pragma unroll
            for (int j = 0; j < 4; ++j) { const unsigned long long w = *(const GAS unsigned long long*)(xbrow + 4 * lane + 256 * j);
                o[r][j] = (f32x4){bf2f((bf16)w), bf2f((bf16)(w >> 16)), bf2f((bf16)(w >> 32)), bf2f((bf16)(w >> 48))}; s += (o[r][j].x + o[r][j].y) + (o[r][j].z + o[r][j].w); }
            const float mean = wave_sum(s) * (1.f / D); float s2 = 0.f;
#pragma unroll
            for (int j = 0; j < 4; ++j) { o[r][j] = o[r][j] - mean; s2 += (o[r][j].x * o[r][j].x + o[r][j].y * o[r][j].y) + (o[r][j].z * o[r][j].z + o[r][j].w * o[r][j].w); }
            const float rstd = 1.f / sqrtf(wave_sum(s2) * (1.f / D) + 1e-5f);
#pragma unroll
            for (int j = 0; j < 4; ++j) { const int c = 4 * lane + 256 * j; o[r][j] = o[r][j] * rstd * *(const GAS f32x4*)(g + c) + *(const GAS f32x4*)(b + c);
                *(GAS unsigned long long*)(xbrow + c) = (unsigned long long)pk2(o[r][j].x, o[r][j].y) | ((unsigned long long)pk2(o[r][j].z, o[r][j].w) << 32); } }
        float lg[4][20];
#pragma unroll
        for (int r = 0; r < 4; ++r)
#pragma unroll
            for (int i = 0; i < 20; ++i) lg[r][i] = 0.f;
#pragma unroll
        for (int j = 0; j < 4; ++j)
#pragma unroll
            for (int e = 0; e < 4; ++e) { const int k = 4 * lane + 256 * j + e; const f32x4 wc4 = *(const GAS f32x4*)(wgc + (size_t)k * 4);
                f32x4 wf[4];
#pragma unroll
                for (int q = 0; q < 4; ++q) wf[q] = *(const GAS f32x4*)(wgf + (size_t)k * 16 + q * 4);
#pragma unroll
                for (int r = 0; r < 4; ++r) { const float x = o[r][j][e];
                    lg[r][0] += x * wc4.x; lg[r][1] += x * wc4.y; lg[r][2] += x * wc4.z; lg[r][3] += x * wc4.w;
#pragma unroll
                    for (int q = 0; q < 4; ++q) { lg[r][4 + 4 * q] += x * wf[q].x; lg[r][5 + 4 * q] += x * wf[q].y; lg[r][6 + 4 * q] += x * wf[q].z; lg[r][7 + 4 * q] += x * wf[q].w; } } }
        float my[20];
#pragma unroll
        for (int i = 0; i < 20; ++i) { my[i] = 0.f;
#pragma unroll
            for (int r = 0; r < 4; ++r) { const float t = wave_sum(lg[r][i]); if (lane == r) my[i] = t; } }
        if (lane < 4) {
            const int rl = rl0 + lane, tok = row0 + rl;
            float pg[4], mx = -INFINITY, sum = 0.f;
#pragma unroll
            for (int j = 0; j < 4; ++j) { pg[j] = my[j] + bgc[j]; mx = fmaxf(mx, pg[j]); }
#pragma unroll
            for (int j = 0; j < 4; ++j) { pg[j] = expf(pg[j] - mx); sum += pg[j]; }
            int gi = 0; float gw = pg[0];
#pragma unroll
            for (int j = 1; j < 4; ++j) if (pg[j] > gw) { gw = pg[j]; gi = j; }
            gw /= sum;
            float fs[4]; mx = -INFINITY;
#pragma unroll
            for (int j = 0; j < 4; ++j) { float t = 0.f;
#pragma unroll
                for (int q = 0; q < 4; ++q) if (q == gi) t = my[4 + q * 4 + j] + bgf[q * 4 + j];
                fs[j] = t; mx = fmaxf(mx, t); }
#pragma unroll
            for (int j = 0; j < 4; ++j) fs[j] = expf(fs[j] - mx);
            int t0 = 0; float v0 = fs[0];
#pragma unroll
            for (int j = 1; j < 4; ++j) if (fs[j] > v0) { v0 = fs[j]; t0 = j; }
            int t1 = -1; float v1 = -1.f;
#pragma unroll
            for (int j = 0; j < 4; ++j) if (j != t0 && fs[j] > v1) { v1 = fs[j]; t1 = j; }
            const float ts = v0 + v1; const int e0 = gi * 4 + t0, e1 = gi * 4 + t1; const float g0 = gw * (v0 / ts), g1 = gw * (v1 / ts);
            if (eid) { eid[tok * 2] = e0; eid[tok * 2 + 1] = e1; wts[tok * 2] = g0; wts[tok * 2 + 1] = g1; }
            R->e0[rl] = e0; R->e1[rl] = e1; R->g0[rl] = g0; R->g1[rl] = g1;
            R->r0[rl] = __hip_atomic_fetch_add(&R->lcnt[e0], 1u, __ATOMIC_RELAXED, __HIP_MEMORY_SCOPE_WORKGROUP);
            R->r1[rl] = __hip_atomic_fetch_add(&R->lcnt[e1], 1u, __ATOMIC_RELAXED, __HIP_MEMORY_SCOPE_WORKGROUP);
        }
    }
    LDS_WAIT(); __syncthreads();
    if (tidl < 16) { const unsigned n = R->lcnt[tidl]; R->gbase[tidl] = n ? __hip_atomic_fetch_add(cnt + tidl, n, RLX_AGENT) : 0u; }
    LDS_WAIT(); __syncthreads();
    if (tidl < 64) { const int rl = tidl, tok = row0 + rl; const int e0 = R->e0[rl], e1 = R->e1[rl]; const unsigned p0 = R->gbase[e0] + R->r0[rl], p1 = R->gbase[e1] + R->r1[rl];
        tokidx[(size_t)e0 * M + p0] = tok * 2; gate[(size_t)e0 * M + p0] = R->g0[rl]; tokidx[(size_t)e1 * M + p1] = tok * 2 + 1; gate[(size_t)e1 * M + p1] = R->g1[rl]; }
    LDS_WAIT(); __syncthreads();
}

struct MoeTab { LAS const int* p;
    __device__ __forceinline__ int cnt(int e) const { return __builtin_amdgcn_readfirstlane(p[e]); }
    __device__ __forceinline__ int pre(int e) const { return __builtin_amdgcn_readfirstlane(p[16 + e]); } };
__device__ __forceinline__ void moe_tab_build(LAS int* p, const gu32* cnt, bool t0) {
    if (t0) { int acc = 0;
        for (int e = 0; e < 16; ++e) { const int c = (int)__hip_atomic_load(cnt + e, RLX_AGENT); p[e] = c; p[16 + e] = acc; acc += (c + 255) >> 8; }
        p[32] = acc; }
    __syncthreads();
}
template <int NPN> struct SchedMoe {
    int vcu, G; MoeTab T; const char* a; const char* w; size_t wexp  ; const int* tokidx; size_t atile  ;
    __device__ __forceinline__ bool next(int i, pg8::Unit& u) const {
        const int L = i * G + vcu; if (L >= T.pre(16) * NPN) return false;
        const int tile = L / NPN; u.pn = L % NPN; int e = 0;
#pragma unroll 1
        for (int q = 1; q < 16; ++q) if (tile >= T.pre(q)) e = q;
        u.aux = e; u.pm = tile - T.pre(e); u.kind = tile;
        u.A = a + (size_t)tile * atile; u.B = w + (size_t)e * wexp + (size_t)u.pn * 256 * (wexp / (NPN * 256)); return true;
    }
    __device__ __forceinline__ int arow(const pg8::Unit& u, int r) const {
        const int rank = u.pm * 256 + r; const int c = T.cnt(u.aux);
        return rank < c ? (tokidx[(size_t)u.aux * M + rank] >> 1) : 0;
    }
};
struct EpiMoe1 {
    static constexpr bool PERM = true;
    bf16* act; const float* gate; MoeTab T;
    __device__ __forceinline__ void operator()(const pg8::f32x4 (&acc)[2][2][4][2], const pg8::Unit& u, int wr, int wc, int fr, int fq) const {
        const int cnt = T.cnt(u.aux);
#pragma unroll
        for (int ai = 0; ai < 2; ++ai)
#pragma unroll
            for (int m = 0; m < 4; ++m) { const int r = ai * 128 + wr * 64 + m * 16 + fr, rank = u.pm * 256 + r;
                const float gt = rank < cnt ? gate[(size_t)u.aux * M + rank] : 0.f;
                bf16* rowp = act + ((size_t)u.kind * 256 + r) * 256 + u.pn * 128 + wc * 16 + 4 * fq;
#pragma unroll
                for (int bj = 0; bj < 2; ++bj) { const pg8::f32x4 av = acc[ai][bj][m][0], cv = acc[ai][bj][m][1]; float y[4];
#pragma unroll
                    for (int e = 0; e < 4; ++e) y[e] = av[e] / (1.f + __expf(-av[e])) * cv[e] * gt;
                    *(unsigned long long*)(rowp + bj * 64) = (unsigned long long)pg8::cvt_pk_bf16(y[0], y[1]) | ((unsigned long long)pg8::cvt_pk_bf16(y[2], y[3]) << 32); } }
    }
};
struct EpiMoe2 {
    static constexpr bool PERM = true;
    bf16* ymoe; const int* tokidx; MoeTab T;
    __device__ __forceinline__ void operator()(const pg8::f32x4 (&acc)[2][2][4][2], const pg8::Unit& u, int wr, int wc, int fr, int fq) const {
        const int cnt = T.cnt(u.aux);
#pragma unroll
        for (int ai = 0; ai < 2; ++ai)
#pragma unroll
            for (int m = 0; m < 4; ++m) { const int r = ai * 128 + wr * 64 + m * 16 + fr, rank = u.pm * 256 + r;
                if (rank < cnt) { bf16* rowp = ymoe + (size_t)tokidx[(size_t)u.aux * M + rank] * D + u.pn * 256 + wc * 32 + 8 * fq;
#pragma unroll
                    for (int bj = 0; bj < 2; ++bj) { const pg8::f32x4 v0 = acc[ai][bj][m][0], v1 = acc[ai][bj][m][1];
                        pg8::u32x4 w; w.x = pg8::cvt_pk_bf16(v0[0], v0[1]); w.y = pg8::cvt_pk_bf16(v0[2], v0[3]); w.z = pg8::cvt_pk_bf16(v1[0], v1[1]); w.w = pg8::cvt_pk_bf16(v1[2], v1[3]);
                        *(pg8::u32x4*)(rowp + bj * 128) = w; } } }
    }
};
struct SchedSq {
    int vcu, G; const char* a; const char* w; size_t astep, wstep;
    __device__ __forceinline__ bool next(int i, pg8::Unit& u) const {
        const int L = i * G + vcu; if (L >= 256) return false;
        u.kind = 0; u.pm = L >> 2; u.pn = L & 3; u.aux = 0; u.A = a + (size_t)u.pm * astep; u.B = w + (size_t)u.pn * wstep; return true;
    }
};
template <int GATED> struct EpiPle {
    static constexpr bool PERM = true;
    bf16* yp; const float* bg;
    __device__ __forceinline__ void operator()(const pg8::f32x4 (&acc)[2][2][4][2], const pg8::Unit& u, int wr, int wc, int fr, int fq) const {
        const int row0 = u.pm * 256 + wr * 64 + fr, col0 = u.pn * 256 + wc * 32 + 8 * fq;
#pragma unroll
        for (int ai = 0; ai < 2; ++ai)
#pragma unroll
            for (int m = 0; m < 4; ++m) { bf16* rowp = yp + (size_t)(row0 + ai * 128 + m * 16) * D + col0;
#pragma unroll
                for (int bj = 0; bj < 2; ++bj) { pg8::f32x4 v0 = acc[ai][bj][m][0], v1 = acc[ai][bj][m][1];
                    if (GATED) { const pg8::f32x4 b0 = *(const pg8::f32x4*)(bg + col0 + bj * 128), b1 = *(const pg8::f32x4*)(bg + col0 + bj * 128 + 4); const pg8::u32x4 y = *(const pg8::u32x4*)(rowp + bj * 128);
                        const float yf[8] = {bf2f((bf16)y.x), bf2f((bf16)(y.x >> 16)), bf2f((bf16)y.y), bf2f((bf16)(y.y >> 16)), bf2f((bf16)y.z), bf2f((bf16)(y.z >> 16)), bf2f((bf16)y.w), bf2f((bf16)(y.w >> 16))};
#pragma unroll
                        for (int e = 0; e < 4; ++e) { v0[e] = yf[e] / (1.f + __expf(-(v0[e] + b0[e]))); v1[e] = yf[4 + e] / (1.f + __expf(-(v1[e] + b1[e]))); } }
                    pg8::u32x4 w; w.x = pg8::cvt_pk_bf16(v0[0], v0[1]); w.y = pg8::cvt_pk_bf16(v0[2], v0[3]); w.z = pg8::cvt_pk_bf16(v1[0], v1[1]); w.w = pg8::cvt_pk_bf16(v1[2], v1[3]);
                    *(pg8::u32x4*)(rowp + bj * 128) = w; } }
    }
};
namespace att {
typedef float f32x16 __attribute__((ext_vector_type(16)));
constexpr int KSLOT = 8192, VSLOT = 16384, LDS_K = 0, LDS_V = 2 * KSLOT, ATT_LDS = 2 * KSLOT + 2 * VSLOT;
__device__ __forceinline__ bf16x8 pack8(const f32x16& p, int b) {
    v4u w; w.x = pg8::cvt_pk_bf16(p[b], p[b + 1]); w.y = pg8::cvt_pk_bf16(p[b + 2], p[b + 3]); w.z = pg8::cvt_pk_bf16(p[b + 4], p[b + 5]); w.w = pg8::cvt_pk_bf16(p[b + 6], p[b + 7]);
    return __builtin_bit_cast(bf16x8, w);
}
constexpr float THR2 = 8.f;
__device__ __forceinline__ void qkt(f32x16& p0, f32x16& p1, LAS const unsigned char* ks, const bf16x8 (&qf)[4], int r32, int hi) {
#pragma unroll
    for (int r = 0; r < 16; ++r) { p0[r] = 0.f; p1[r] = 0.f; }
    LAS const unsigned char* kb = ks + hi * 1024 + r32 * 16;
#pragma unroll
    for (int kk = 0; kk < 4; ++kk) {
        const bf16x8 a0 = *(LAS const bf16x8*)(kb + kk * 2048), a1 = *(LAS const bf16x8*)(kb + kk * 2048 + 512);
        p0 = __builtin_amdgcn_mfma_f32_32x32x16_bf16(a0, qf[kk], p0, 0, 0, 0);
        p1 = __builtin_amdgcn_mfma_f32_32x32x16_bf16(a1, qf[kk], p1, 0, 0, 0);
    }
}
__device__ __forceinline__ void partialSM(f32x16& p0, f32x16& p1, float& m, float& alpha) {
    float pmax = fmaxf(p0[0], p1[0]);
#pragma unroll
    for (int r = 1; r < 16; ++r) pmax = fmaxf(pmax, fmaxf(p0[r], p1[r]));
    pmax = fmaxf(pmax, __shfl_xor(pmax, 32));
    if (__builtin_expect(__all(pmax - m <= THR2), 1)) alpha = 1.f;
    else { const float mn = fmaxf(m, pmax); alpha = __builtin_amdgcn_exp2f(m - mn); m = mn; }
    const float mm = m;
#pragma unroll
    for (int r = 0; r < 16; ++r) { p0[r] = __builtin_amdgcn_exp2f(p0[r] - mm); p1[r] -= mm; }
}
__device__ __forceinline__ void finishSM(f32x16& p0, f32x16& p1, float alpha, float& l, bf16x8 (&pf)[4]) {
    float ps = 0.f;
#pragma unroll
    for (int r = 0; r < 16; ++r) { p1[r] = __builtin_amdgcn_exp2f(p1[r]); ps += p0[r] + p1[r]; }
    l = l * alpha + ps;
    pf[0] = pack8(p0, 0); pf[1] = pack8(p0, 8); pf[2] = pack8(p1, 0); pf[3] = pack8(p1, 8);
}
__device__ __forceinline__ void pv(f32x16 (&o)[4], LAS const unsigned char* vs, const bf16x8 (&pf)[4], int r32, int hi) {
    LAS const unsigned char* vb = vs + hi * 2048 + r32 * 16;
#pragma unroll
    for (int db = 0; db < 4; ++db) {
        bf16x8 va[4];
#pragma unroll
        for (int s = 0; s < 4; ++s) va[s] = *(LAS const bf16x8*)(vb + s * 4096 + db * 512);
#pragma unroll
        for (int s = 0; s < 4; ++s) o[db] = __builtin_amdgcn_mfma_f32_32x32x16_bf16(va[s], pf[s], o[db], 0, 0, 0);
        __builtin_amdgcn_sched_group_barrier(0x100, 4, 0); __builtin_amdgcn_sched_group_barrier(0x8, 4, 0);
    }
}
__device__ __forceinline__ void resc(f32x16 (&o)[4], float alpha) {
    if (__any(alpha < 1.f)) {
#pragma unroll
        for (int db = 0; db < 4; ++db)
#pragma unroll
            for (int r = 0; r < 16; ++r) o[db][r] *= alpha;
    }
}
__device__ __forceinline__ void unit(LAS unsigned char* lds, int b, int h, int qb, const bf16* QKP, const bf16* UVT, float lam, float lam_init, const float* subg, bf16* MIXB, float* stash, int wave, int lane) {
    asm volatile("" : "+v"(lane));
    const int r32 = lane & 31, hi = lane >> 5;
    const size_t tok0 = (size_t)b * S;
    const size_t qtok = tok0 + qb * 256 + wave * 32 + r32;
    constexpr int NT = S / 64;
#pragma unroll 1
    for (int c = 0; c < 2; ++c) {
        bf16x8 qf[4];
#pragma unroll
        for (int kk = 0; kk < 4; ++kk) qf[kk] = *(const GAS bf16x8*)(QKP + qtok * 1280 + h * 128 + c * 64 + kk * 16 + hi * 8);
        f32x16 o[4];
#pragma unroll
        for (int db = 0; db < 4; ++db)
#pragma unroll
            for (int r = 0; r < 16; ++r) o[db][r] = 0.f;
        float m = -INFINITY, l = 0.f, alA, alB;
        f32x16 pA0, pA1, pB0, pB1; bf16x8 pf[4];
        const char* kub = (const char*)(QKP + tok0 * 1280 + 512 + h * 128 + c * 64 + wave * 8);
        const char* vub = (const char*)(UVT + (size_t)(768 + h * 128) * M + tok0 + wave * 8);
        const unsigned kvo = (unsigned)lane * 2560u, vvo = (unsigned)lane * (unsigned)(M * 2);
#define ATT_DMA_K(t) __builtin_amdgcn_global_load_lds((const unsigned*)(kub + (size_t)(t) * (64 * 2560) + kvo), (LAS unsigned*)(lds + LDS_K + ((t) & 1) * KSLOT + wave * 1024), 16, 0, 0)
#define ATT_DMA_V(t) do { \
            __builtin_amdgcn_global_load_lds((const unsigned*)(vub + (size_t)(t) * 128 + vvo), (LAS unsigned*)(lds + LDS_V + ((t) & 1) * VSLOT + wave * 2048), 16, 0, 0); \
            __builtin_amdgcn_global_load_lds((const unsigned*)(vub + (size_t)64 * M * 2 + (size_t)(t) * 128 + vvo), (LAS unsigned*)(lds + LDS_V + ((t) & 1) * VSLOT + wave * 2048 + 1024), 16, 0, 0); } while (0)
#define SB() __builtin_amdgcn_sched_barrier(0)
#define ATT_SYNC() do { asm volatile("s_waitcnt vmcnt(0) lgkmcnt(0)" ::: "memory"); __builtin_amdgcn_s_barrier(); asm volatile("" ::: "memory"); } while (0)
        ATT_SYNC();
        ATT_DMA_K(0); ATT_DMA_V(0);
        ATT_SYNC();
        ATT_DMA_K(1);
        qkt(pA0, pA1, lds + LDS_K, qf, r32, hi); partialSM(pA0, pA1, m, alA);
#pragma unroll 1
        for (int j = 1; j < NT - 1; j += 2) {
            ATT_SYNC(); ATT_DMA_K(j + 1); ATT_DMA_V(j);
            SB(); qkt(pB0, pB1, lds + LDS_K + KSLOT, qf, r32, hi); finishSM(pA0, pA1, alA, l, pf); SB();
            pv(o, lds + LDS_V, pf, r32, hi); partialSM(pB0, pB1, m, alB); SB(); resc(o, alB);
            ATT_SYNC(); ATT_DMA_K(j + 2); ATT_DMA_V(j + 1);
            SB(); qkt(pA0, pA1, lds + LDS_K, qf, r32, hi); finishSM(pB0, pB1, alB, l, pf); SB();
            pv(o, lds + LDS_V + VSLOT, pf, r32, hi); partialSM(pA0, pA1, m, alA); SB(); resc(o, alA);
        }
        ATT_SYNC(); ATT_DMA_V(NT - 1);
        SB(); qkt(pB0, pB1, lds + LDS_K + KSLOT, qf, r32, hi); finishSM(pA0, pA1, alA, l, pf); SB();
        pv(o, lds + LDS_V, pf, r32, hi); partialSM(pB0, pB1, m, alB); SB(); resc(o, alB);
        ATT_SYNC();
        finishSM(pB0, pB1, alB, l, pf); pv(o, lds + LDS_V + VSLOT, pf, r32, hi);
#undef ATT_DMA_K
#undef ATT_DMA_V
#undef ATT_SYNC
#undef SB
        const float lt = l + __shfl_xor(l, 32);
        int lane_e = lane; asm volatile("" : "+v"(lane_e));
        const int hi_e = lane_e >> 5; const size_t qtok_e = tok0 + qb * 256 + wave * 32 + (lane_e & 31);
        if (c == 0) {
            const float i1 = 1.f / lt;
#pragma unroll
            for (int db = 0; db < 4; ++db)
#pragma unroll
                for (int g4 = 0; g4 < 4; ++g4) *(GAS f32x4*)(stash + ((db * 4 + g4) * 64 + lane_e) * 4) = (f32x4){o[db][4 * g4] * i1, o[db][4 * g4 + 1] * i1, o[db][4 * g4 + 2] * i1, o[db][4 * g4 + 3] * i1};
        } else {
            const float i2 = lam / lt;
            float ss = 0.f;
#pragma unroll
            for (int db = 0; db < 4; ++db)
#pragma unroll
                for (int g4 = 0; g4 < 4; ++g4) { const f32x4 s1 = *(const GAS f32x4*)(stash + ((db * 4 + g4) * 64 + lane_e) * 4);
#pragma unroll
                    for (int i = 0; i < 4; ++i) { const float v = s1[i] - o[db][4 * g4 + i] * i2; o[db][4 * g4 + i] = v; ss += v * v; } }
            ss += __shfl_xor(ss, 32);
            const float rs = (1.f - lam_init) / sqrtf(ss * (1.f / 128.f) + 1e-5f);
            bf16* orow = MIXB + qtok_e * D + 256 + h * 128;
#pragma unroll
            for (int db = 0; db < 4; ++db)
#pragma unroll
                for (int g4 = 0; g4 < 4; ++g4) { const int e = 32 * db + 8 * g4 + 4 * hi_e; const f32x4 gg = *(const GAS f32x4*)(subg + e);
                    const unsigned long long w = (unsigned long long)pg8::cvt_pk_bf16(o[db][4 * g4] * rs * gg.x, o[db][4 * g4 + 1] * rs * gg.y) | ((unsigned long long)pg8::cvt_pk_bf16(o[db][4 * g4 + 2] * rs * gg.z, o[db][4 * g4 + 3] * rs * gg.w) << 32);
                    *(GAS unsigned long long*)(orow + e) = w; }
        }
    }
}
}
namespace hy {
typedef float f32x16 __attribute__((ext_vector_type(16)));
constexpr int CPY = 16456;
constexpr int LDS_F = 0, LDS_VV = 4 * CPY, LDS_END = LDS_VV + 32768;
static_assert(LDS_VV % 16 == 0 && LDS_END <= 131072, "hyena LDS map");

__device__ __forceinline__ void filter_item(LAS unsigned char* lds, int pb, const float* fw1, const float* fb1, const float* fr1, const float* fw2, const float* fb2, const float* fr2,
                                            const float* fw3, bf16* KF, float* PS, int wave, int lane) {
    LAS bf16* tile = (LAS bf16*)lds;
    LAS float* za = (LAS float*)(lds + 65536) + wave * 512;
    LAS float* zb = (LAS float*)(lds + 81920) + wave * 512;
    LAS float* sqs = (LAS float*)(lds + 98304);
    const int p0 = pb * 64 + wave * 8;
    if (lane < 33) {
#pragma unroll 1
        for (int pi = 0; pi < 8; ++pi) { const int p = p0 + pi; float z;
            if (lane == 0) z = (float)p / (float)(S - 1);
            else { const int bi = (lane - 1) & 15; const float band = 1e-4f + (float)bi * ((15.0f - 1e-4f) / 15.0f), wpos = 2.0f * 3.14159265358979323846f * (float)p / (float)S;
                   z = lane <= 16 ? cosf(wpos * band) : -sinf(wpos * band); }
            za[pi * 64 + lane] = z; }
    }
    LDS_WAIT(); asm volatile("" ::: "memory");
    float acc8[8];
    { const float b1 = fb1[lane];
#pragma unroll
      for (int pi = 0; pi < 8; ++pi) acc8[pi] = b1;
#pragma unroll 1
      for (int i = 0; i < 33; ++i) { const float w = fw1[i * 64 + lane];
#pragma unroll
          for (int pi = 0; pi < 8; ++pi) acc8[pi] += za[pi * 64 + i] * w; }
      const float f1 = fr1[lane];
#pragma unroll
      for (int pi = 0; pi < 8; ++pi) zb[pi * 64 + lane] = sinf(f1 * acc8[pi]); }
    LDS_WAIT(); asm volatile("" ::: "memory");
    { const float b2 = fb2[lane];
#pragma unroll
      for (int pi = 0; pi < 8; ++pi) acc8[pi] = b2;
#pragma unroll 1
      for (int i = 0; i < 64; ++i) { const float w = fw2[i * 64 + lane];
#pragma unroll
          for (int pi = 0; pi < 8; ++pi) acc8[pi] += zb[pi * 64 + i] * w; }
      const float f2 = fr2[lane];
      LDS_WAIT(); asm volatile("" ::: "memory");
#pragma unroll
      for (int pi = 0; pi < 8; ++pi) za[pi * 64 + lane] = sinf(f2 * acc8[pi]); }
    LDS_WAIT(); asm volatile("" ::: "memory");
    const float mind = logf(1e-2f) / 1.5f, maxd = logf(1e-2f) / 0.3f;
#pragma unroll 1
    for (int qh = 0; qh < 2; ++qh) {
        float ac[8][4];
#pragma unroll
        for (int pi = 0; pi < 8; ++pi)
#pragma unroll
            for (int q = 0; q < 4; ++q) ac[pi][q] = 0.f;
#pragma unroll 1
        for (int i = 0; i < 64; ++i) { float w[4];
#pragma unroll
            for (int q = 0; q < 4; ++q) w[q] = fw3[i * 512 + lane + 64 * (qh * 4 + q)];
#pragma unroll
            for (int pi = 0; pi < 8; ++pi) { const float hv = za[pi * 64 + i];
#pragma unroll
                for (int q = 0; q < 4; ++q) ac[pi][q] += hv * w[q]; } }
#pragma unroll
        for (int q = 0; q < 4; ++q) { const int col = lane + 64 * (qh * 4 + q), ch = col & 255; const float delta = fabsf(mind + (float)ch * ((maxd - mind) / 255.0f)); float sq = 0.f;
#pragma unroll
            for (int pi = 0; pi < 8; ++pi) { const int p = p0 + pi; const float val = ac[pi][q] * expf(-((float)p / (float)(S - 1)) * delta);
                if (!(col >= 256 && p == 0)) sq += val * val;
                tile[col * 64 + wave * 8 + pi] = (bf16)f2bf(val); }
            sqs[wave * 512 + col] = sq; }
    }
    LDS_WAIT(); __syncthreads();
    { const int p = pb * 64 + lane;
#pragma unroll 1
      for (int cc = 0; cc < 64; ++cc) { const int col = wave * 64 + cc; const bf16 v = tile[col * 64 + lane];
          if (col < 256) KF[(size_t)col * 8192 + 4095 - p] = v; else if (p != 0) KF[(size_t)(col - 256) * 8192 + 4095 + p] = v; } }
    { const int t = wave * 64 + lane; float s = 0.f;
#pragma unroll
      for (int w = 0; w < 8; ++w) s += sqs[w * 512 + t];
      PS[(size_t)pb * 512 + t] = s;
      if (pb == 0 && t < 256) KF[(size_t)t * 8192 + 8191] = 0; }
    LDS_WAIT(); __syncthreads();
}

__device__ __forceinline__ float conv1(float um, float u0, float up, float w0, float w1, float w2, float cb) { return um * w0 + u0 * w1 + up * w2 + cb; }

__device__ __forceinline__ void unit(LAS unsigned char* lds, int c, const bf16* KF, const float* PS, const bf16* UVT, const float* cw, const float* cb, const float* bias_d, bf16* HT, int wave, int lane) {
    asm volatile("" : "+s"(wave), "+v"(lane));
    const int tid = wave * 64 + lane;
    { const bf16* src = KF + (size_t)c * 8192;
#pragma unroll
      for (int i = 0; i < 2; ++i) { const int ch = tid + 512 * i; *(LAS v4u*)(lds + LDS_F + ch * 16) = *(const GAS v4u*)(src + ch * 8); } }
    { const float w0v = cw[512 + c], w1v = cw[768 + 512 + c], w2v = cw[1536 + 512 + c], cbv = cb[512 + c], w0x = cw[256 + c], w1x = cw[768 + 256 + c], w2x = cw[1536 + 256 + c], cbx = cb[256 + c];
      const bf16* rv = UVT + (size_t)(512 + c) * M; const bf16* rx = UVT + (size_t)(256 + c) * M;
#pragma unroll 1
      for (int i = 0; i < 4; ++i) { const int q = tid + 512 * i, b = q >> 9, sc = q & 511, s0 = sc * 8; const size_t g0 = (size_t)b * S + s0;
          const v4u av = *(const GAS v4u*)(rv + g0), ax = *(const GAS v4u*)(rx + g0);
          float uv[10], ux[10];
          uv[0] = s0 > 0 ? bf2f(rv[g0 - 1]) : 0.f; ux[0] = s0 > 0 ? bf2f(rx[g0 - 1]) : 0.f; uv[9] = s0 + 8 < S ? bf2f(rv[g0 + 8]) : 0.f; ux[9] = s0 + 8 < S ? bf2f(rx[g0 + 8]) : 0.f;
#pragma unroll
          for (int e = 0; e < 4; ++e) { uv[1 + 2 * e] = bf2f((bf16)av[e]); uv[2 + 2 * e] = bf2f((bf16)(av[e] >> 16)); ux[1 + 2 * e] = bf2f((bf16)ax[e]); ux[2 + 2 * e] = bf2f((bf16)(ax[e] >> 16)); }
          float o[8];
#pragma unroll
          for (int e = 0; e < 8; ++e) o[e] = conv1(uv[e], uv[e + 1], uv[e + 2], w0v, w1v, w2v, cbv) * conv1(ux[e], ux[e + 1], ux[e + 2], w0x, w1x, w2x, cbx);
          v4u w; w.x = pk2(o[0], o[1]); w.y = pk2(o[2], o[3]); w.z = pk2(o[4], o[5]); w.w = pk2(o[6], o[7]);
          *(LAS v4u*)(lds + LDS_VV + (((sc & 7) * 64 + (sc >> 3)) * 4 + b) * 16) = w; } }
    LDS_WAIT(); __syncthreads();
    {
#pragma unroll 1
      for (int i = 0; i < 4; ++i) { const int y = tid + 512 * i;
          const unsigned long long w0 = *(LAS const unsigned long long*)(lds + LDS_F + y * 8), w1 = *(LAS const unsigned long long*)(lds + LDS_F + y * 8 + 8);
#pragma unroll
          for (int p = 1; p < 4; ++p) *(LAS unsigned long long*)(lds + LDS_F + p * CPY + y * 8) = (w0 >> (16 * p)) | (w1 << (64 - 16 * p)); } }
    const float nrm = 1.0f / sqrtf(wave_sum(PS[(size_t)lane * 512 + c] + PS[(size_t)lane * 512 + 256 + c]) + 1e-6f);
    LDS_WAIT(); __syncthreads();
    const int r32 = lane & 31, hi = lane >> 5, gp = wave & 3, half = wave >> 2, iloc = r32 >> 2, b = r32 & 3;
    f32x16 acc[2][2];
#pragma unroll
    for (int rho = 0; rho < 2; ++rho)
#pragma unroll
        for (int gg = 0; gg < 2; ++gg)
#pragma unroll
            for (int r = 0; r < 16; ++r) acc[rho][gg][r] = 0.f;
    const int dlo = 16 * gp - 63 + (half ? 40 : 0), dn = half ? 39 : 40;
    int pa = LDS_F + (3 - (r32 & 3)) * CPY + (4092 - 4 * (r32 >> 2) + 8 * hi) * 2 - 64 - 128 * dlo;
    int jb = 16 * gp + iloc - dlo;
    const int pbase = LDS_VV + hi * 4096 + b * 16;
#pragma unroll 1
    for (int dd = 0; dd < dn; ++dd) {
        const int j0 = jb, j1 = jb + 8; const bool v0 = (unsigned)j0 < 64u, v1 = (unsigned)j1 < 64u;
        LAS const unsigned char* ap = lds + pa; LAS const unsigned char* bp0 = lds + pbase + (v0 ? j0 : 0) * 64; LAS const unsigned char* bp1 = lds + pbase + (v1 ? j1 : 0) * 64;
#pragma unroll
        for (int k = 0; k < 4; ++k) {
            typedef unsigned long long u64;
            const u64 a00 = *(LAS const u64*)(ap + 64 + 32 * k), a01 = *(LAS const u64*)(ap + 64 + 32 * k + 8), a10 = *(LAS const u64*)(ap + 32 * k), a11 = *(LAS const u64*)(ap + 32 * k + 8);
            v4u b0 = *(LAS const v4u*)(bp0 + k * 8192), b1 = *(LAS const v4u*)(bp1 + k * 8192);
            if (!v0) b0 = (v4u){0u, 0u, 0u, 0u};
            if (!v1) b1 = (v4u){0u, 0u, 0u, 0u};
            const bf16x8 fa0 = __builtin_bit_cast(bf16x8, (v4u){(unsigned)a00, (unsigned)(a00 >> 32), (unsigned)a01, (unsigned)(a01 >> 32)});
            const bf16x8 fa1 = __builtin_bit_cast(bf16x8, (v4u){(unsigned)a10, (unsigned)(a10 >> 32), (unsigned)a11, (unsigned)(a11 >> 32)});
            const bf16x8 fb0 = __builtin_bit_cast(bf16x8, b0), fb1 = __builtin_bit_cast(bf16x8, b1);
            acc[0][0] = __builtin_amdgcn_mfma_f32_32x32x16_bf16(fa0, fb0, acc[0][0], 0, 0, 0);
            acc[0][1] = __builtin_amdgcn_mfma_f32_32x32x16_bf16(fa0, fb1, acc[0][1], 0, 0, 0);
            acc[1][0] = __builtin_amdgcn_mfma_f32_32x32x16_bf16(fa1, fb0, acc[1][0], 0, 0, 0);
            acc[1][1] = __builtin_amdgcn_mfma_f32_32x32x16_bf16(fa1, fb1, acc[1][1], 0, 0, 0);
        }
        pa -= 128; jb -= 1;
    }
    LDS_WAIT(); __syncthreads();
    { LAS float* xw = (LAS float*)(lds + LDS_F) + (gp * 2 + (half ? 0 : 1)) * 2048 + lane;
#pragma unroll
      for (int gg = 0; gg < 2; ++gg)
#pragma unroll
          for (int r = 0; r < 16; ++r) xw[(gg * 16 + r) * 64] = half ? acc[0][gg][r] : acc[1][gg][r]; }
    LDS_WAIT(); __syncthreads();
    f32x16 fin[2];
    { LAS const float* xr = (LAS const float*)(lds + LDS_F) + (gp * 2 + (half ? 1 : 0)) * 2048 + lane;
#pragma unroll
      for (int gg = 0; gg < 2; ++gg)
#pragma unroll
          for (int r = 0; r < 16; ++r) fin[gg][r] = (half ? acc[1][gg][r] : acc[0][gg][r]) + xr[(gg * 16 + r) * 64]; }
    { const float bd = bias_d[c], w0 = cw[c], w1 = cw[768 + c], w2 = cw[1536 + c], cb0 = cb[c]; const bf16* r0p = UVT + (size_t)c * M; bf16* hrow = HT + (size_t)c * M;
#pragma unroll
      for (int gg = 0; gg < 2; ++gg)
#pragma unroll
          for (int g4 = 0; g4 < 4; ++g4) { const int i = 16 * gp + 8 * gg + iloc, rr = 32 * half + 8 * g4 + 4 * hi, t0 = 64 * i + rr; const size_t tok = (size_t)b * S + t0;
              const unsigned long long vw = *(LAS const unsigned long long*)(lds + LDS_VV + (((rr >> 3) * 64 + i) * 4 + b) * 16 + (rr & 7) * 2);
              const unsigned long long uw = *(const GAS unsigned long long*)(r0p + tok);
              float u[6]; u[0] = t0 > 0 ? bf2f(r0p[tok - 1]) : 0.f; u[5] = t0 + 4 < S ? bf2f(r0p[tok + 4]) : 0.f;
              u[1] = bf2f((bf16)uw); u[2] = bf2f((bf16)(uw >> 16)); u[3] = bf2f((bf16)(uw >> 32)); u[4] = bf2f((bf16)(uw >> 48));
              float o[4];
#pragma unroll
              for (int e = 0; e < 4; ++e) { const float vv = bf2f((bf16)(vw >> (16 * e))); o[e] = (nrm * fin[gg][4 * g4 + e] + vv * bd) * conv1(u[e], u[e + 1], u[e + 2], w0, w1, w2, cb0); }
              *(GAS unsigned long long*)(hrow + tok) = (unsigned long long)pk2(o[0], o[1]) | ((unsigned long long)pk2(o[2], o[3]) << 32); } }
    LDS_WAIT(); __syncthreads();
}
__device__ __forceinline__ void transpose_slab(LAS unsigned char* lds, int slab, const bf16* HT, bf16* MIXB, int wave, int lane) {
    const int tid = wave * 64 + lane; LAS bf16* tile = (LAS bf16*)lds;
#pragma unroll 1
    for (int i = 0; i < 4; ++i) { const int q = tid + 512 * i, c = q >> 3, tc = q & 7; const v4u w = *(const GAS v4u*)(HT + (size_t)c * M + (size_t)slab * 64 + tc * 8);
#pragma unroll
        for (int e = 0; e < 4; ++e) { tile[(tc * 8 + 2 * e) * 264 + c] = (bf16)w[e]; tile[(tc * 8 + 2 * e + 1) * 264 + c] = (bf16)(w[e] >> 16); } }
    LDS_WAIT(); __syncthreads();
#pragma unroll 1
    for (int i = 0; i < 4; ++i) { const int q = tid + 512 * i, tk = q >> 5, cc = q & 31;
        *(GAS v4u*)(MIXB + ((size_t)slab * 64 + tk) * D + cc * 8) = *(LAS const v4u*)(lds + (tk * 264 + cc * 8) * 2); }
    LDS_WAIT(); __syncthreads();
}
}
#ifndef DUP_PRO
#define DUP_PRO 1
#endif
#ifndef DUP_IN
#define DUP_IN 1
#endif
#ifndef DUP_HY
#define DUP_HY 1
#endif
#ifndef DUP_HYT
#define DUP_HYT 1
#endif
#ifndef DUP_ATT
#define DUP_ATT 1
#endif
#ifndef DUP_POOL
#define DUP_POOL 1
#endif
#ifndef DUP_WCV
#define DUP_WCV 1
#endif
#ifndef DUP_MOE1
#define DUP_MOE1 1
#endif
#ifndef DUP_MOE2
#define DUP_MOE2 1
#endif
#ifndef EN_HY
#define EN_HY 1
#endif
#ifndef EN_HYT
#define EN_HYT 1
#endif
#ifndef EN_PRO
#define EN_PRO 1
#endif
#ifndef EN_IN
#define EN_IN 1
#endif
#ifndef EN_ATT
#define EN_ATT 1
#endif
#ifndef EN_POOL
#define EN_POOL 1
#endif
#ifndef EN_OUT
#define EN_OUT 1
#endif
#ifndef EN_LN1
#define EN_LN1 1
#endif
#ifndef EN_WCV
#define EN_WCV 1
#endif
#ifndef EN_MOE1
#define EN_MOE1 1
#endif
#ifndef EN_MOE2
#define EN_MOE2 1
#endif
#ifndef EN_LN2
#define EN_LN2 1
#endif
constexpr int RING_BYTES = 131072;
constexpr int LDSCTL_OFF = RING_BYTES, MISC_OFF = LDSCTL_OFF + 320, MOETAB_OFF = LDSCTL_OFF + 1024, ROUTE_OFF = LDSCTL_OFF + 2048;
constexpr int LDS_BYTES = 147456;

struct Args { const float* in[38]; float* out; unsigned char* ws; int* eid; float* wts; int ph_lo, ph_hi, l_lo, l_hi, single, pad; };
enum { PH_PRO = 0, PH_IN = 1, PH_ATT = 2, PH_POOL = 3, PH_OUT = 4, PH_LN1 = 5, PH_WCV = 6, PH_MOE1 = 7, PH_MOE2 = 8, PH_LN2 = 9, PH_HY = 10, PH_HYT = 11, PH_END = 12 };

__global__ void __launch_bounds__(NWAVES * 64, 2) mk_fwd(Args a) {
    extern __shared__ __attribute__((aligned(16))) unsigned char lds_raw[];
    LAS unsigned char* lds = (LAS unsigned char*)lds_raw;
    volatile LAS unsigned* MISC = (volatile LAS unsigned*)(lds + MISC_OFF);
    const int wave_s = __builtin_amdgcn_readfirstlane((int)threadIdx.x >> 6);
    const int G = gridDim.x, bx = blockIdx.x, vcu0 = (G % 8 == 0) ? (bx % 8) * (G / 8) + bx / 8 : bx;
    gu32* ctl0 = (gu32*)(a.ws + WS_CTL);
    for (int u = wave_s * 64 + (int)mk_lane_id(); u < (LDS_BYTES - LDSCTL_OFF) / 4; u += NWAVES * 64) ((LAS unsigned*)(lds + LDSCTL_OFF))[u] = 0u;
    __syncthreads();
    XcdBarrier bar; bar.bar = (unsigned*)(ctl0 + CW_BAR); bar.x = 0; bar.st = nullptr;
#if defined(MK_PER_PHASE)
    if (!a.single)
#endif
    bar = xcd_barrier_post((unsigned*)(ctl0 + CW_BAR), MISC + 8, wave_s);
#if defined(MK_PER_PHASE)
#define IN(k) (a.ph_lo <= (k) && (k) < a.ph_hi)
#define SEAM() do { if (!a.single) xcd_barrier(bar, wave_s); } while (0)
#else
#define IN(k) 1
#define SEAM() xcd_barrier(bar, wave_s)
#endif
    const int NGW = G * NWAVES;
#define PHASE_PTRS() int lane_ = (int)mk_lane_id(); asm volatile("" : "+v"(lane_)); const int lane = lane_, wave = wave_s; int vcu = vcu0; asm volatile("" : "+s"(vcu)); (void)wave; const int gw = vcu * NWAVES + wave; (void)gw; unsigned char* ws = a.ws; gu32* ctl = (gu32*)(ws + WS_CTL); (void)ctl; \
    bf16* XB = (bf16*)(ws + WS_XB); bf16* QKP = (bf16*)(ws + WS_QKP); bf16* UVT = (bf16*)(ws + WS_UVT); float* CS = (float*)(ws + WS_CS); bf16* MIXB = (bf16*)(ws + WS_MIXB); \
    (void)XB; (void)QKP; (void)UVT; (void)CS; (void)MIXB
#define INP(k) (a.in[k])

    if (EN_PRO && IN(PH_PRO)) {
            PHASE_PTRS();
        LAS float* scr = (LAS float*)(lds + wave * 16384);
        for (int it = gw; it < DEPTH * (16 * 72 + 16 * 32); it += NGW) {
            const int l = it / 1664, r = it % 1664; const float* src; int N, k0, n0; bf16* dst;
            if (r < 1152) { const int kb = r / 72, nb = r % 72; n0 = nb * 32; k0 = kb * 64; N = INW; src = INP(4) + (size_t)l * D * INW;
                bf16* wsw = (bf16*)(ws + WS_WIN + (size_t)l * WIN_LAYER); bf16* wnm = wsw + 1280 * 1024;
                dst = n0 < 768 ? wsw + (size_t)n0 * D : (n0 < 1792 ? wnm + (size_t)(n0 - 768) * D : wsw + (size_t)(768 + n0 - 1792) * D); }
            else { const int q = r - 1152, kb = q >> 5, nb = q & 31; n0 = nb * 32; k0 = kb * 64; N = D; src = INP(23) + (size_t)l * D * D; dst = (bf16*)(ws + WS_WOUT + (size_t)l * WOUT_LAYER) + (size_t)n0 * D; }
            p0_transpose_block(src, D, N, k0, n0, dst, 0, scr, lane);
        }
        for (int it = gw; it < DEPTH * 4 * 16 * 2; it += NGW) {
            const int l = it >> 7, g = (it >> 5) & 3, dh = (it >> 4) & 1, k = (it & 15) * 64 + lane;
            const float* wrow = INP(4) + (size_t)l * D * INW + (size_t)k * INW + 2304 + g * 64;
            const float* pw = INP(20) + (size_t)(l * 4 + g) * 64 * 64 + dh * 32;
            float acc[32];
#pragma unroll
            for (int d = 0; d < 32; ++d) acc[d] = 0.f;
#pragma unroll 1
            for (int c = 0; c < 64; ++c) { const float x = wrow[c];
#pragma unroll
                for (int d = 0; d < 32; ++d) acc[d] += x * pw[c * 64 + d]; }
            bf16* dst = (bf16*)(ws + WS_WIN + (size_t)l * WIN_LAYER) + (size_t)(1280 + 1024 + g * 64 + dh * 32) * D + k;
#pragma unroll
            for (int d = 0; d < 32; ++d) dst[(size_t)d * D] = (bf16)f2bf(acc[d]);
        }
        int ln2 = lane; asm volatile("" : "+v"(ln2));
        for (int i = gw * 64 + ln2; i < S * 8; i += NGW * 64) { const int pos = i >> 3, j = i & 7; const float ang = (float)pos * powf(500000.0f, -(float)(2 * j) / 16.0f);
            CS[pos * 16 + j] = cosf(ang); CS[pos * 16 + 8 + j] = sinf(ang); }
        for (int m = gw; m < M; m += NGW) ln_row(INP(0) + (size_t)m * D, 1.f, nullptr, nullptr, nullptr, INP(2), INP(3), nullptr, XB + (size_t)m * D, lane);
        LDS_WAIT(); __syncthreads();
        for (int it = vcu; it < DEPTH * 64; it += G) { const int fl = it >> 6, pb = it & 63;
            hy::filter_item(lds, pb, INP(7) + fl * 33 * 64, INP(8) + fl * 64, INP(9) + fl * 64, INP(10) + fl * 64 * 64, INP(11) + fl * 64, INP(12) + fl * 64, INP(13) + fl * 64 * 512,
                            (bf16*)(ws + WS_KF) + (size_t)fl * 256 * 8192, (float*)(ws + WS_PS) + (size_t)fl * 64 * 512, wave, lane); }
        SEAM();
    }
#if defined(MK_PER_PHASE)
    for (int l = a.l_lo; l < a.l_hi; ++l) {
#else
#pragma unroll 1
    for (int l = 0; l < DEPTH; ++l) {
#endif
        if (EN_IN && IN(PH_IN)) {
            PHASE_PTRS();
            const char* wsw = (const char*)(ws + WS_WIN + (size_t)l * WIN_LAYER);
            SchedIn Sc{vcu, G, (const char*)XB, wsw, wsw + (size_t)1280 * 1024 * 2};
            EpiIn E{QKP, UVT, CS};
            pg8::gemm_phase<EpiIn, SchedIn>(lds, D, Sc, E, wave);
            SEAM();
        }
        if (EN_HY && IN(PH_HY)) {
            PHASE_PTRS();
            for (int c = vcu; c < 256; c += G)
                hy::unit(lds, c, (const bf16*)(ws + WS_KF) + (size_t)l * 256 * 8192, (const float*)(ws + WS_PS) + (size_t)l * 64 * 512, UVT, INP(5) + l * 3 * 768, INP(6) + l * 768, INP(14) + l * 256, (bf16*)(ws + WS_HT), wave, lane);
        }
        if (EN_POOL && IN(PH_POOL)) {
            PHASE_PTRS();
            int ln = lane; asm volatile("" : "+v"(ln));
            const int cc = (ln & 31) * 8, gq = cc >> 6, hw = 1 << gq;
            const float* pb = INP(21) + l * 256 + cc; const float* psc = INP(22) + l * 256 + cc;
            for (int it = gw; it < M / 2; it += NGW) {
                const int tok = it * 2 + (ln >> 5), pos = tok & (S - 1);
                int lo = pos - hw, hi2 = pos + hw - 1; lo = lo < 0 ? 0 : lo; hi2 = hi2 > S - 1 ? S - 1 : hi2;
                float sacc[8];
#pragma unroll
                for (int e = 0; e < 8; ++e) sacc[e] = 0.f;
                const bf16* zp = QKP + (size_t)(tok - pos) * 1280 + 1024 + cc;
                for (int r = lo; r <= hi2; ++r) { const v4u w = *(const GAS v4u*)(zp + (size_t)r * 1280);
                    sacc[0] += bf2f((bf16)w.x); sacc[1] += bf2f((bf16)(w.x >> 16)); sacc[2] += bf2f((bf16)w.y); sacc[3] += bf2f((bf16)(w.y >> 16));
                    sacc[4] += bf2f((bf16)w.z); sacc[5] += bf2f((bf16)(w.z >> 16)); sacc[6] += bf2f((bf16)w.w); sacc[7] += bf2f((bf16)(w.w >> 16)); }
                const float inv = 1.f / (float)(hi2 - lo + 1);
                const v4u w = *(const GAS v4u*)(zp + (size_t)pos * 1280);
                float z[8] = {bf2f((bf16)w.x), bf2f((bf16)(w.x >> 16)), bf2f((bf16)w.y), bf2f((bf16)(w.y >> 16)), bf2f((bf16)w.z), bf2f((bf16)(w.z >> 16)), bf2f((bf16)w.w), bf2f((bf16)(w.w >> 16))};
                float y[8];
#pragma unroll
                for (int e = 0; e < 8; ++e) y[e] = (sacc[e] * inv - z[e] + pb[e]) * psc[e];
                v4u o; o.x = pk2(y[0], y[1]); o.y = pk2(y[2], y[3]); o.z = pk2(y[4], y[5]); o.w = pk2(y[6], y[7]);
                *(GAS v4u*)(MIXB + (size_t)tok * D + 768 + cc) = o;
            }
        }
        if (EN_WCV && IN(PH_WCV)) {
            PHASE_PTRS();
            LAS float* scr = (LAS float*)(lds + wave * 16384);
            bf16* W13 = (bf16*)(ws + WS_W13); bf16* W2 = (bf16*)(ws + WS_W2); bf16* WG = (bf16*)(ws + WS_WG); bf16* WP = (bf16*)(ws + WS_WP);
            for (int it = gw; it < 6784; it += NGW) {
                const float* src; int K, N, k0, n0, mode = 0; bf16* dst;
                if (it < 4096) { const int which = it >> 11, r = it & 2047, e = r >> 7, kb = (r >> 3) & 15, nb = r & 7;
                    src = INP(which ? 31 : 30) + ((size_t)l * 16 + e) * D * 256; K = D; N = 256; k0 = kb * 64; n0 = nb * 32; mode = 1 + which; dst = W13 + (size_t)e * 512 * D;
                } else if (it < 6144) { const int r = it - 4096, e = r >> 7, kb = (r >> 5) & 3, nb = r & 31;
                    src = INP(32) + ((size_t)l * 16 + e) * 256 * D; K = 256; N = D; k0 = kb * 64; n0 = nb * 32; dst = W2 + (size_t)e * D * 256 + (size_t)n0 * 256;
                } else if (it < 6656) { const int r = it - 6144, kb = r >> 5, nb = r & 31;
                    src = INP(33) + (size_t)l * D * D; K = D; N = D; k0 = kb * 64; n0 = nb * 32; dst = WG + (size_t)n0 * D;
                } else { const int r = it - 6656, kb = r >> 5, nb = r & 31;
                    src = INP(35) + (size_t)l * 256 * D; K = 256; N = D; k0 = kb * 64; n0 = nb * 32; dst = WP + (size_t)n0 * 256; }
                p0_transpose_block(src, K, N, k0, n0, dst, mode, scr, lane);
            }
            int ln = lane; asm volatile("" : "+v"(ln));
            const float* ps = INP(1) + (size_t)l * M * 256; bf16* PB = (bf16*)(ws + WS_PB);
            for (size_t i = ((size_t)gw * 64 + ln) * 8; i < (size_t)M * 256; i += (size_t)NGW * 64 * 8) { const f32x4 x0 = *(const GAS f32x4*)(ps + i), x1 = *(const GAS f32x4*)(ps + i + 4);
                v4u o; o.x = pk2(x0.x, x0.y); o.y = pk2(x0.z, x0.w); o.z = pk2(x1.x, x1.y); o.w = pk2(x1.z, x1.w); *(GAS v4u*)(PB + i) = o; }
            SEAM();
        }
        if (EN_HYT && IN(PH_HYT)) {
            PHASE_PTRS();
            for (int s = vcu; s < 256; s += G) hy::transpose_slab(lds, s, (const bf16*)(ws + WS_HT), MIXB, wave, lane);
        }
        if (EN_ATT && IN(PH_ATT)) {
            PHASE_PTRS();
            const float lam_init = 0.8f - 0.6f * expf(-0.3f * (float)l);
            int ln = lane; asm volatile("" : "+v"(ln));
            const float lam = expf(wave_sum(INP(15)[l * 64 + ln] * INP(16)[l * 64 + ln])) - expf(wave_sum(INP(17)[l * 64 + ln] * INP(18)[l * 64 + ln])) + lam_init;
            for (int u = vcu; u < 256; u += G) att::unit(lds, (u >> 4) >> 2, (u >> 4) & 3, u & 15, QKP, UVT, lam, lam_init, INP(19) + l * 128, MIXB, (float*)(ws + WS_STASH) + ((size_t)u * 8 + wave) * 4096, wave, lane);
            SEAM();
        }
        if (EN_OUT && IN(PH_OUT)) {
            PHASE_PTRS();
            SchedOut Sc{vcu, G, (const char*)MIXB, (const char*)(ws + WS_WOUT + (size_t)l * WOUT_LAYER)};
            EpiRes E{XB};
            pg8::gemm_phase<EpiRes, SchedOut>(lds, D, Sc, E, wave);
            SEAM();
        }
        if (EN_LN1 && IN(PH_LN1)) {
            PHASE_PTRS();
            int ln = lane; asm volatile("" : "+v"(ln));
            for (int ch = vcu; ch < M / 64; ch += G)
                ln1_router_chunk((LAS RouteLds*)(lds + ROUTE_OFF), ch * 64, XB, INP(24) + l * D, INP(25) + l * D, INP(26) + (size_t)l * D * 4, INP(27) + l * 4, INP(28) + (size_t)l * D * 16, INP(29) + l * 16,
                                 a.eid, a.wts, ctl + CW_CNT + l * 16, (int*)(ws + WS_TOKIDX), (float*)(ws + WS_GATE), wave, lane);
            SEAM();
        }
        if (EN_MOE1 && IN(PH_MOE1)) {
            PHASE_PTRS();
            moe_tab_build((LAS int*)(lds + MOETAB_OFF), ctl + CW_CNT + l * 16, wave == 0 && lane == 0); const MoeTab T{(LAS const int*)(lds + MOETAB_OFF)};
            { SchedMoe<2> Sc{vcu, G, T, (const char*)XB, (const char*)(ws + WS_W13), (size_t)512 * D * 2, (const int*)(ws + WS_TOKIDX), 0};
              EpiMoe1 E{(bf16*)(ws + WS_ACT), (const float*)(ws + WS_GATE), T};
              pg8::gemm_phase<EpiMoe1, SchedMoe<2>, true>(lds, D, Sc, E, wave); }
            { SchedSq Sc{vcu, G, (const char*)(ws + WS_PB), (const char*)(ws + WS_WP), (size_t)256 * 256 * 2, (size_t)256 * 256 * 2};
              EpiPle<0> E{(bf16*)(ws + WS_YP), nullptr};
              pg8::gemm_phase<EpiPle<0>, SchedSq>(lds, 256, Sc, E, wave); }
            { SchedSq Sc{vcu, G, (const char*)XB, (const char*)(ws + WS_WG), TILEB, TILEB};
              EpiPle<1> E{(bf16*)(ws + WS_YP), INP(34) + l * D};
              pg8::gemm_phase<EpiPle<1>, SchedSq>(lds, D, Sc, E, wave); }
            SEAM();
        }
        if (EN_MOE2 && IN(PH_MOE2)) {
            PHASE_PTRS();
            moe_tab_build((LAS int*)(lds + MOETAB_OFF), ctl + CW_CNT + l * 16, wave == 0 && lane == 0); const MoeTab T{(LAS const int*)(lds + MOETAB_OFF)};
            SchedMoe<4> Sc{vcu, G, T, (const char*)(ws + WS_ACT), (const char*)(ws + WS_W2), (size_t)D * 256 * 2, (const int*)(ws + WS_TOKIDX), (size_t)256 * 256 * 2};
            EpiMoe2 E{(bf16*)(ws + WS_YMOE), (const int*)(ws + WS_TOKIDX), T};
            pg8::gemm_phase<EpiMoe2, SchedMoe<4>>(lds, 256, Sc, E, wave);
            SEAM();
        }
        if (EN_LN2 && IN(PH_LN2)) {
            PHASE_PTRS();
            int ln = lane; asm volatile("" : "+v"(ln));
            const bf16* YM = (const bf16*)(ws + WS_YMOE); const bf16* YP = (const bf16*)(ws + WS_YP);
            const bool lastl = (l == DEPTH - 1);
            for (int m = gw; m < M; m += NGW)
                ln_row(XB + (size_t)m * D, DN_ALPHA, YM + (size_t)(2 * m) * D, YM + (size_t)(2 * m + 1) * D, YP + (size_t)m * D, INP(36) + l * D, INP(37) + l * D,
                       lastl ? a.out + (size_t)m * D : (float*)nullptr, lastl ? nullptr : XB + (size_t)m * D, ln);
            SEAM();
        }
    }
#undef IN
#undef SEAM
}
static void mk_launch(const Args& base, int ph, int l, int grid, hipStream_t stream) {
    Args a = base; a.ph_lo = ph; a.ph_hi = ph + 1; a.l_lo = l; a.l_hi = l + 1; a.single = 1;
    hipLaunchKernelGGL(mk_fwd, dim3(grid), dim3(NWAVES * 64), LDS_BYTES, stream, a);
}
extern "C" void kernel_launch(void* const* d_in, const int* in_sizes, int n_in, void* d_out, int out_size, void* d_ws, size_t ws_size, hipStream_t stream) {
    (void)in_sizes; (void)n_in; (void)out_size; (void)ws_size;
    static int grid = 0;
    if (grid == 0) {
        int dev = 0, cus = 0;
        if (hipGetDevice(&dev) != hipSuccess || hipDeviceGetAttribute(&cus, hipDeviceAttributeMultiprocessorCount, dev) != hipSuccess) { grid = -1; return; }
        if (hipFuncSetAttribute((const void*)mk_fwd, hipFuncAttributeMaxDynamicSharedMemorySize, LDS_BYTES) != hipSuccess) { grid = -1; return; }
        (void)hipGetLastError();
        grid = cus;
    }
    if (grid < 0) return;
    (void)hipMemsetAsync((char*)d_ws + WS_CTL, 0, CTL_ZERO_BYTES, stream);
    Args base{};
    for (int i = 0; i < 38; ++i) base.in[i] = (const float*)d_in[i];
    base.out = (float*)d_out; base.ws = (unsigned char*)d_ws;
    base.eid = nullptr; base.wts = nullptr;
#if defined(MK_PER_PHASE)
    mk_launch(base, PH_PRO, 0, grid, stream);
    for (int l = 0; l < DEPTH; ++l) for (int ph : {PH_IN, PH_HY, PH_HYT, PH_ATT, PH_POOL, PH_OUT, PH_LN1, PH_WCV, PH_MOE1, PH_MOE2, PH_LN2}) mk_launch(base, ph, l, grid, stream);
#else
    Args a = base; a.ph_lo = 0; a.ph_hi = PH_END; a.l_lo = 0; a.l_hi = DEPTH; a.single = 0;
    hipLaunchKernelGGL(mk_fwd, dim3(grid), dim3(NWAVES * 64), LDS_BYTES, stream, a);
#endif
}
```

```cpp
#include <hip/hip_runtime.h>
#include <stdint.h>
#include <math.h>
namespace pg8 {
#define PG8_LAS __attribute__((address_space(3)))
typedef unsigned short bf16_t;
typedef short bf16x8 __attribute__((ext_vector_type(8)));
typedef float f32x4 __attribute__((ext_vector_type(4)));
typedef unsigned u32x4 __attribute__((ext_vector_type(4)));
constexpr int BM = 256, BK = 64, HALF = 128, HTB = HALF * BK * 2  , STAGE_BYTES = 8 * HTB;

__host__ __device__ __forceinline__ int lds_byte(int r, int c) { const int st = (r >> 4) * 2 + (c >> 5), rr = r & 15, cc = c & 31, ob = rr * 64 + cc * 2; return st * 1024 + (ob ^ (((ob >> 9) & 1) << 5)); }
__host__ __device__ __forceinline__ void stage_rc(int b, int& R, int& C) { const int st = b / 1024, sb = b % 1024, swz = sb ^ (((sb >> 9) & 1) << 5); R = (st >> 1) * 16 + swz / 64; C = (st & 1) * 32 + (swz % 64) / 2; }
__host__ __device__ __forceinline__ int perm32(int rho) { const int n = rho >> 4, i = rho & 15; return 8 * (i >> 2) + 4 * n + (i & 3); }

struct Unit { const char* A; const char* B; int kind, pm, pn, aux; };

__device__ __forceinline__ unsigned cvt_pk_bf16(float lo, float hi) { unsigned r; asm volatile("v_cvt_pk_bf16_f32 %0, %1, %2" : "=v"(r) : "v"(lo), "v"(hi)); return r; }

template <class Epi, class Sched, bool GATHER = false>
__device__ __forceinline__ void gemm_phase(PG8_LAS unsigned char* lds, const int K_, const Sched& S, const Epi& E, const int wave_) {
    int K = K_; asm volatile("" : "+s"(K));
    int tid_; asm volatile("v_mbcnt_lo_u32_b32 %0, -1, 0\n\tv_mbcnt_hi_u32_b32 %0, -1, %0" : "=v"(tid_)); tid_ += wave_ * 64;
    const int tid = tid_, wid = __builtin_amdgcn_readfirstlane(tid >> 6), lane = tid & 63, wr = wid >> 2, wc = wid & 3, fr = lane & 15, fq = lane >> 4;
    const int nt = K / BK;
    unsigned voffA[2][2], voffN[2][2] = {{0u, 0u}, {0u, 0u}}, voffB[2]; int RA[2], CA[2];
#pragma unroll
    for (int i = 0; i < 2; ++i) { int R, C; stage_rc(tid * 16 + i * 8192, R, C); const int Rb = Epi::PERM ? ((R & ~31) + perm32(R & 31)) : R; RA[i] = R; CA[i] = C;
        voffA[0][i] = (unsigned)(R * K + C) * 2u; voffA[1][i] = (unsigned)((R + HALF) * K + C) * 2u; voffB[i] = (unsigned)(Rb * K + C) * 2u; }
    const size_t kstep = (size_t)(BK * 2);
    const size_t hstep = (size_t)HALF * K * 2;
    const unsigned ldsw = (unsigned)wid * 1024u;
    const int aoff = lds_byte(wr * 64 + fr, fq * 8), boff = lds_byte(wc * 32 + fr, fq * 8);
#define PG8_SA(b, h) (((b) * 2 + (h)) * HTB)
#define PG8_SB(b, h) ((4 + (b) * 2 + (h)) * HTB)
#define PG8_STAGE(bufoff, gbase, voff) do { _Pragma("unroll") for (int _i = 0; _i < 2; ++_i) \
        __builtin_amdgcn_global_load_lds((const unsigned*)((const char*)(gbase) + (voff)[_i]), (PG8_LAS unsigned*)(lds + (bufoff) + ldsw + _i * 8192), 16, 0, 0); } while (0)
#define PG8_LDA(dst, b, h) do { _Pragma("unroll") for (int m = 0; m < 4; ++m) _Pragma("unroll") for (int k = 0; k < 2; ++k) dst[m][k] = *(const PG8_LAS bf16x8*)(lds + PG8_SA(b, h) + aoff + m * 2048 + k * 1024); } while (0)
#define PG8_LDB(dst, b, h) do { _Pragma("unroll") for (int n = 0; n < 2; ++n) _Pragma("unroll") for (int k = 0; k < 2; ++k) dst[n][k] = *(const PG8_LAS bf16x8*)(lds + PG8_SB(b, h) + boff + n * 2048 + k * 1024); } while (0)
#define PG8_MMA(ai, bj, At, Bt) do { __builtin_amdgcn_s_setprio(1); _Pragma("unroll") for (int m = 0; m < 4; ++m) _Pragma("unroll") for (int n = 0; n < 2; ++n) _Pragma("unroll") for (int k = 0; k < 2; ++k) \
        acc[ai][bj][m][n] = __builtin_amdgcn_mfma_f32_16x16x32_bf16(Bt[n][k], At[m][k], acc[ai][bj][m][n], 0, 0, 0); __builtin_amdgcn_s_setprio(0); } while (0)
#define PG8_WAIT_V(n) asm volatile("s_waitcnt vmcnt(" #n ")" ::: "memory")
#define PG8_WAIT_L(n) asm volatile("s_waitcnt lgkmcnt(" #n ")" ::: "memory")
#define PG8_BAR __builtin_amdgcn_s_barrier()
#define PG8_SCHED __builtin_amdgcn_sched_barrier(0)
    Unit cur, nxt; int ui = 0;
    if (!S.next(0, cur)) return;
    if constexpr (GATHER) {
#pragma unroll
        for (int h = 0; h < 2; ++h)
#pragma unroll
            for (int i = 0; i < 2; ++i) voffA[h][i] = (unsigned)(S.arow(cur, h * HALF + RA[i]) * K + CA[i]) * 2u;
    }
    f32x4 acc[2][2][4][2];
#pragma unroll
    for (int a = 0; a < 2; ++a)
#pragma unroll
        for (int b = 0; b < 2; ++b)
#pragma unroll
            for (int m = 0; m < 4; ++m)
#pragma unroll
                for (int n = 0; n < 2; ++n) acc[a][b][m][n] = (f32x4){0.f, 0.f, 0.f, 0.f};
    bf16x8 At[4][2], B0[2][2], B1[2][2];
    const char* cA = cur.A; const char* cB = cur.B;
    PG8_STAGE(PG8_SB(0, 0), cB, voffB); PG8_STAGE(PG8_SB(0, 1), cB + hstep, voffB); PG8_STAGE(PG8_SA(0, 0), cA, voffA[0]); PG8_STAGE(PG8_SA(0, 1), cA, voffA[1]);
    if (wr == 1) PG8_BAR;
    PG8_WAIT_V(2); PG8_BAR;
    PG8_STAGE(PG8_SB(1, 0), cB + kstep, voffB); PG8_STAGE(PG8_SA(1, 0), cA + kstep, voffA[0]); PG8_STAGE(PG8_SB(1, 1), cB + hstep + kstep, voffB);
    PG8_WAIT_V(6); PG8_BAR;
    for (;;) {
        const bool has_next = S.next(ui + 1, nxt);
        const char* nA = has_next ? nxt.A : cA; const char* nB = has_next ? nxt.B : cB;
        if constexpr (GATHER) {
#pragma unroll
            for (int h = 0; h < 2; ++h)
#pragma unroll
                for (int i = 0; i < 2; ++i) voffN[h][i] = has_next ? (unsigned)(S.arow(nxt, h * HALF + RA[i]) * K + CA[i]) * 2u : voffA[h][i];
        }
#pragma unroll 1
        for (int t = 0; t < nt; t += 2) {
            const bool last = (t == nt - 2);
            const char* a1 = cA + (size_t)(t + 1) * kstep;
            const char* a2 = last ? nA : cA + (size_t)(t + 2) * kstep; const char* b2 = last ? nB : cB + (size_t)(t + 2) * kstep;
            const char* a3 = a2 + kstep; const char* b3 = b2 + kstep;
            PG8_LDB(B0, 0, 0); PG8_LDB(B1, 0, 1); PG8_SCHED; PG8_LDA(At, 0, 0); PG8_STAGE(PG8_SA(1, 1), a1, voffA[1]);
            if constexpr (GATHER) { if (last) {
#pragma unroll
                for (int h = 0; h < 2; ++h)
#pragma unroll
                    for (int i = 0; i < 2; ++i) voffA[h][i] = voffN[h][i]; } }
            PG8_WAIT_V(8); PG8_WAIT_L(0); PG8_BAR; PG8_MMA(0, 0, At, B0); PG8_MMA(0, 1, At, B1); PG8_BAR; PG8_SCHED;
            PG8_LDA(At, 0, 1); PG8_STAGE(PG8_SB(0, 0), b2, voffB); PG8_STAGE(PG8_SB(0, 1), b2 + hstep, voffB); PG8_STAGE(PG8_SA(0, 0), a2, voffA[0]);
            PG8_WAIT_V(8); PG8_WAIT_L(0); PG8_BAR; PG8_MMA(1, 0, At, B0); PG8_MMA(1, 1, At, B1); PG8_BAR; PG8_SCHED;
            PG8_LDB(B0, 1, 0); PG8_LDB(B1, 1, 1); PG8_SCHED; PG8_LDA(At, 1, 0); PG8_STAGE(PG8_SA(0, 1), a2, voffA[1]);
            PG8_WAIT_V(8); PG8_WAIT_L(0); PG8_BAR; PG8_MMA(0, 0, At, B0); PG8_MMA(0, 1, At, B1); PG8_BAR; PG8_SCHED;
            PG8_LDA(At, 1, 1); PG8_STAGE(PG8_SB(1, 0), b3, voffB); PG8_STAGE(PG8_SB(1, 1), b3 + hstep, voffB); PG8_STAGE(PG8_SA(1, 0), a3, voffA[0]);
            PG8_WAIT_V(8); PG8_WAIT_L(0); PG8_BAR; PG8_MMA(1, 0, At, B0); PG8_MMA(1, 1, At, B1); PG8_BAR; PG8_SCHED;
        }
        if (wr == 0) PG8_BAR;
        { Unit ce = cur; ce.pm = __builtin_amdgcn_readfirstlane(cur.pm); ce.pn = __builtin_amdgcn_readfirstlane(cur.pn); ce.kind = __builtin_amdgcn_readfirstlane(cur.kind); ce.aux = __builtin_amdgcn_readfirstlane(cur.aux); int fr_ = fr, fq_ = fq;
          asm volatile("" : "+s"(ce.pm), "+s"(ce.pn), "+s"(ce.kind), "+s"(ce.aux), "+v"(fr_), "+v"(fq_));
          E(acc, ce, wr, wc, fr_, fq_); }
        if (!has_next) break;
#pragma unroll
        for (int a = 0; a < 2; ++a)
#pragma unroll
            for (int b = 0; b < 2; ++b)
#pragma unroll
                for (int m = 0; m < 4; ++m)
#pragma unroll
                    for (int n = 0; n < 2; ++n) acc[a][b][m][n] = (f32x4){0.f, 0.f, 0.f, 0.f};
        cur = nxt; cA = nA; cB = nB; ++ui;
        if (wr == 1) PG8_BAR;
    }
    PG8_WAIT_V(0);
    PG8_BAR;
#undef PG8_SA
#undef PG8_SB
#undef PG8_STAGE
#undef PG8_LDA
#undef PG8_LDB
#undef PG8_MMA
#undef PG8_WAIT_V
#undef PG8_WAIT_L
#undef PG8_BAR
#undef PG8_SCHED
}
}
constexpr int D = 1024, NB = 4, S = 4096, M = NB * S, DEPTH = 4, INW = 2560;
constexpr float DN_ALPHA = 1.681792830507429f;
constexpr float QSCALE = 0.125f * 1.4426950408889634f;
constexpr int NWAVES = 8;
constexpr size_t MiB = 1u << 20;
constexpr size_t TILEB = (size_t)256 * D * 2;
constexpr size_t WS_CTL = 0, CTL_ZERO_BYTES = 1 * MiB;
constexpr size_t WS_CS = 1 * MiB;
constexpr size_t WS_WIN = 2 * MiB, WIN_LAYER = 5 * MiB;
constexpr size_t WS_XB = 22 * MiB;
constexpr size_t WS_QKP = 118 * MiB;
constexpr size_t WS_UVT = 158 * MiB;
constexpr size_t WS_MIXB = 198 * MiB;
constexpr size_t WS_STASH = 54 * MiB;
constexpr size_t WS_WOUT = 383 * MiB, WOUT_LAYER = 2 * MiB;
constexpr size_t WS_TOKIDX = 391 * MiB, WS_GATE = 392 * MiB;
constexpr size_t WS_YMOE = WS_QKP;
constexpr size_t WS_YP = 86 * MiB;
constexpr size_t WS_ACT = 230 * MiB;
constexpr size_t WS_WBUF = 288 * MiB, WBUF_STRIDE = 35 * MiB, WB_W13 = 0, WB_W2 = 16 * MiB, WB_WG = 24 * MiB, WB_WP = 26 * MiB, WB_PB = 27 * MiB;
constexpr size_t WS_KF = 262 * MiB, WS_PS = 278 * MiB, WS_HT = 280 * MiB;
constexpr size_t WS_WR = 256 * MiB;
constexpr int CW_BAR = 4096, CW_CNT = 8192, CNT_STRIDE = 64;

#define GAS __attribute__((address_space(1)))
#define LAS __attribute__((address_space(3)))
typedef unsigned short bf16;
typedef unsigned v4u __attribute__((ext_vector_type(4)));
typedef float f32x4 __attribute__((ext_vector_type(4)));
typedef short bf16x8 __attribute__((ext_vector_type(8)));
typedef GAS unsigned gu32;
typedef GAS unsigned long long gu64;
#define RLX_AGENT __ATOMIC_RELAXED, __HIP_MEMORY_SCOPE_AGENT
#define LDS_WAIT() asm volatile("s_waitcnt lgkmcnt(0)" ::: "memory")
#define VM_WAIT() asm volatile("s_waitcnt vmcnt(0)" ::: "memory")
__device__ __forceinline__ unsigned long long rt() { return __builtin_amdgcn_s_memrealtime(); }
__device__ __forceinline__ unsigned f2bf(float f) { unsigned u = __builtin_bit_cast(unsigned, f); return (u + 0x7fffu + ((u >> 16) & 1u)) >> 16; }
__device__ __forceinline__ unsigned pk2(float lo, float hi) { return f2bf(lo) | (f2bf(hi) << 16); }

#define XB_TMO      128
#define XB_XCNT(j)  (256  + 64 * (j))
#define XB_XSUB(j)  (1280 + 64 * (j))
#define XB_XGEN(j)  (2304 + 64 * (j))
#define XB_TOP      3328
#define XB_TOPGEN   3392
#define XCD_BAR_WORDS 3456
#define XB_SPIN_CAP (1u << 18)

__device__ __forceinline__ unsigned xb_ld(unsigned* p)              { return __hip_atomic_load(p, __ATOMIC_RELAXED, __HIP_MEMORY_SCOPE_AGENT); }
__device__ __forceinline__ unsigned xb_add(unsigned* p, unsigned v) { return __hip_atomic_fetch_add(p, v, __ATOMIC_RELAXED, __HIP_MEMORY_SCOPE_AGENT); }
__device__ __forceinline__ unsigned xb_xcc_id() { return (unsigned)__builtin_amdgcn_s_getreg((3 << 11) | 20) & 0xFu; }
#define XB_SPIN(cond, bar) do { unsigned _sp = 0; while (cond) { __builtin_amdgcn_s_sleep(1); \
    if ((++_sp & 255u) == 0u) { if (xb_ld(&(bar)[XB_TMO])) break; if (_sp > XB_SPIN_CAP) { atomicAdd(&(bar)[XB_TMO], 1u); break; } } } } while (0)

struct XcdBarrier {
    unsigned* bar; unsigned x;
    volatile LAS unsigned* st;
};

__device__ __forceinline__ unsigned mk_lane_id() { unsigned x; asm volatile("v_mbcnt_lo_u32_b32 %0, -1, 0\n\tv_mbcnt_hi_u32_b32 %0, -1, %0" : "=v"(x)); return x; }
__device__ __forceinline__ XcdBarrier xcd_barrier_post(unsigned* bar, volatile LAS unsigned* st, int wave) {
    XcdBarrier b; b.bar = bar; b.x = xb_xcc_id(); b.st = st;
    if (wave == 0 && mk_lane_id() == 0u) (void)xb_add(&bar[XB_XCNT(b.x)], 1u);
    return b;
}
__device__ __forceinline__ void xcd_barrier_complete(unsigned* bar, unsigned x, unsigned& nloc, unsigned& nx) {
    const unsigned G = gridDim.x * gridDim.y * gridDim.z;
    unsigned sum, cnt, mine, sp = 0u;
    for (;;) {
        sum = 0u; cnt = 0u; mine = 0u;
#pragma unroll
        for (unsigned j = 0; j < 16; ++j) { const unsigned c = xb_ld(&bar[XB_XCNT(j)]); sum += c; cnt += (c > 0u) ? 1u : 0u; mine = (j == x) ? c : mine; }
        if (sum == G) break;
        __builtin_amdgcn_s_sleep(1);
        if ((++sp & 255u) == 0u) { if (xb_ld(&bar[XB_TMO])) break; if (sp > XB_SPIN_CAP) { atomicAdd(&bar[XB_TMO], 1u); break; } }
    }
    nloc = mine > 0u ? mine : 1u; nx = cnt > 0u ? cnt : 1u;
}

__device__ __forceinline__ void xcd_barrier(const XcdBarrier& b, int wave) {
    asm volatile("" : "+s"(wave));
    const bool t0_ = (wave == 0) && (mk_lane_id() == 0u);
    asm volatile("s_waitcnt vmcnt(0)" ::: "memory");
    __syncthreads();
    if (t0_) {
        unsigned* bar = b.bar; unsigned bx_ = b.x; asm volatile("" : "+s"(bx_));
        __builtin_amdgcn_s_waitcnt(0);
        unsigned nloc = b.st[0], nx = b.st[1];
        if (nloc == 0u) { xcd_barrier_complete(bar, bx_, nloc, nx); b.st[0] = nloc; b.st[1] = nx; }
        const unsigned old = xb_add(&bar[XB_XSUB(bx_)], 1u);
        const unsigned gen = old / nloc;
        if (old + 1u == (gen + 1u) * nloc) {
            __builtin_amdgcn_fence(__ATOMIC_RELEASE, "agent");
            asm volatile("s_waitcnt vmcnt(0)" ::: "memory");
            const unsigned og = xb_add(&bar[XB_TOP], 1u);
            const unsigned tg = og / nx;
            if (og + 1u == (tg + 1u) * nx) xb_add(&bar[XB_TOPGEN], 1u);
            else XB_SPIN(xb_ld(&bar[XB_TOPGEN]) == tg, bar);
            __builtin_amdgcn_fence(__ATOMIC_ACQUIRE, "agent");
            xb_add(&bar[XB_XGEN(bx_)], 1u);
            asm volatile("s_waitcnt vmcnt(0)" ::: "memory");
        } else {
            XB_SPIN(xb_ld(&bar[XB_XGEN(bx_)]) == gen, bar);
            __builtin_amdgcn_fence(__ATOMIC_ACQUIRE, "agent");
            asm volatile("s_waitcnt vmcnt(0)" ::: "memory");
        }
    }
    __syncthreads();
}
__device__ __forceinline__ float bf2f(unsigned short b) { return __uint_as_float((unsigned)b << 16); }
__device__ __forceinline__ float wave_sum(float v) {
#pragma unroll
    for (int o = 1; o < 64; o <<= 1) v += __shfl_xor(v, o);
    return v;
}
__device__ __forceinline__ void p0_transpose_block(const float* W, int K, int N, int k0, int n0, bf16* WT, int mode, LAS float* scr, int lane) {
#pragma unroll 4
    for (int i = 0; i < 32; ++i) { const int kk = 2 * i + (lane >> 5); scr[kk * 33 + (lane & 31)] = W[(size_t)(k0 + kk) * N + n0 + (lane & 31)]; }
    LDS_WAIT(); asm volatile("" ::: "memory");
    const int c = lane & 7;
#pragma unroll 1
    for (int j = 0; j < 4; ++j) { const int n = (lane >> 3) + 8 * j; const LAS float* s = scr + (8 * c) * 33 + n;
        v4u o; o.x = pk2(s[0 * 33], s[1 * 33]); o.y = pk2(s[2 * 33], s[3 * 33]); o.z = pk2(s[4 * 33], s[5 * 33]); o.w = pk2(s[6 * 33], s[7 * 33]);
        const int f = n0 + n; const size_t drow = mode == 0 ? (size_t)n : (size_t)(8 * (f >> 2) + (f & 3) + (mode == 2 ? 4 : 0));
        *(GAS v4u*)(WT + drow * K + k0 + 8 * c) = o; }
    LDS_WAIT(); asm volatile("" ::: "memory");
}
template <class TX> __device__ __forceinline__ void ln_row(const TX* x0, float a, const bf16* y1, const bf16* y2, const bf16* y3, const float* g, const float* b, float* of, bf16* ob, int lane) {
    f32x4 v[4]; float s = 0.f;
#pragma unroll
    for (int j = 0; j < 4; ++j) { const int c = 4 * lane + 256 * j;
        if constexpr (sizeof(TX) == 4) v[j] = *(const GAS f32x4*)(x0 + c) * a;
        else { const unsigned long long w = *(const GAS unsigned long long*)(x0 + c); v[j] = (f32x4){bf2f((bf16)w), bf2f((bf16)(w >> 16)), bf2f((bf16)(w >> 32)), bf2f((bf16)(w >> 48))} * a; }
        if (y1) { const unsigned long long w = *(const GAS unsigned long long*)(y1 + c); v[j] += (f32x4){bf2f((bf16)w), bf2f((bf16)(w >> 16)), bf2f((bf16)(w >> 32)), bf2f((bf16)(w >> 48))}; }
        if (y2) { const unsigned long long w = *(const GAS unsigned long long*)(y2 + c); v[j] += (f32x4){bf2f((bf16)w), bf2f((bf16)(w >> 16)), bf2f((bf16)(w >> 32)), bf2f((bf16)(w >> 48))}; }
        if (y3) { const unsigned long long w = *(const GAS unsigned long long*)(y3 + c); v[j] += (f32x4){bf2f((bf16)w), bf2f((bf16)(w >> 16)), bf2f((bf16)(w >> 32)), bf2f((bf16)(w >> 48))}; }
        s += (v[j].x + v[j].y) + (v[j].z + v[j].w); }
    const float mean = wave_sum(s) * (1.f / D); float s2 = 0.f;
#pragma unroll
    for (int j = 0; j < 4; ++j) { v[j] = v[j] - mean; s2 += (v[j].x * v[j].x + v[j].y * v[j].y) + (v[j].z * v[j].z + v[j].w * v[j].w); }
    const float rstd = 1.f / sqrtf(wave_sum(s2) * (1.f / D) + 1e-5f);
#pragma unroll
    for (int j = 0; j < 4; ++j) { const int c = 4 * lane + 256 * j; const f32x4 o = v[j] * rstd * *(const GAS f32x4*)(g + c) + *(const GAS f32x4*)(b + c);
        if (of) *(GAS f32x4*)(of + c) = o;
        if (ob) *(GAS unsigned long long*)(ob + c) = (unsigned long long)pk2(o.x, o.y) | ((unsigned long long)pk2(o.z, o.w) << 32); }
}

struct SchedIn {
    int vcu, G; const char* xb; const char* wsw; const char* wnm;
    __device__ __forceinline__ bool next(int i, pg8::Unit& u) const {
        const int L = i * G + vcu; if (L >= 640) return false;
        const int t = L / 10, j = L % 10;
        const int sw = __builtin_amdgcn_readfirstlane((unsigned)(j + 27) >> 5);
        const int jj = j - 5 * sw; const char* tp = xb + (size_t)t * TILEB; const char* wp = (sw ? wsw : wnm) + (size_t)jj * TILEB;
        u.kind = sw; u.pm = sw ? jj : t; u.pn = sw ? t : jj; u.A = sw ? wp : tp; u.B = sw ? tp : wp;
        u.aux = 0; return true;
    }
};
struct EpiIn {
    static constexpr bool PERM = true;
    bf16* qkp; bf16* uvt; const float* cs;
    __device__ __forceinline__ void operator()(const pg8::f32x4 (&acc)[2][2][4][2], const pg8::Unit& u, int wr, int wc, int fr, int fq) const {
        bf16* base = u.kind == 0 ? qkp : uvt; const int ldc = u.kind == 0 ? 1280 : M;
        const int row0 = u.pm * 256 + wr * 64 + fr, col0 = u.pn * 256 + wc * 32 + 8 * fq;
        const bool rope = (u.kind == 0) && (u.pn < 4) && ((wc & 1) == 0);
        const float sc = (u.kind == 0 && u.pn < 2) ? QSCALE : 1.f;
        const float sgn = fq == 0 ? -1.f : 1.f;
        const bool vperm = (u.kind == 1) && (u.pm >= 3);
#pragma unroll
        for (int ai = 0; ai < 2; ++ai)
#pragma unroll
            for (int m = 0; m < 4; ++m) { const int row = row0 + ai * 128 + m * 16; bf16* rowp = base + (size_t)row * ldc + col0;
                f32x4 cv0 = {1.f, 1.f, 1.f, 1.f}, cv1 = cv0, sv0 = {0.f, 0.f, 0.f, 0.f}, sv1 = sv0;
                if (rope && fq < 2) { const float* t = cs + (size_t)(row & (S - 1)) * 16; cv0 = *(const f32x4*)t; cv1 = *(const f32x4*)(t + 4); sv0 = *(const f32x4*)(t + 8) * sgn; sv1 = *(const f32x4*)(t + 12) * sgn; }
#pragma unroll
                for (int bj = 0; bj < 2; ++bj) { f32x4 v0 = acc[ai][bj][m][0], v1 = acc[ai][bj][m][1];
                    if (rope) { f32x4 p0, p1;
#pragma unroll
                        for (int e = 0; e < 4; ++e) { p0[e] = __shfl_xor(v0[e], 16); p1[e] = __shfl_xor(v1[e], 16); }
                        v0 = v0 * cv0 + p0 * sv0; v1 = v1 * cv1 + p1 * sv1; }
                    v0 = v0 * sc; v1 = v1 * sc;
                    pg8::u32x4 w; w.x = pg8::cvt_pk_bf16(v0[0], v0[1]); w.y = pg8::cvt_pk_bf16(v0[2], v0[3]); w.z = pg8::cvt_pk_bf16(v1[0], v1[1]); w.w = pg8::cvt_pk_bf16(v1[2], v1[3]);
                    if (vperm) {
                        bf16* gp = rowp + bj * 128 - (fq & 1) * 8;
                        typedef unsigned u32x2 __attribute__((ext_vector_type(2)));
                        *(u32x2*)(gp + ((fq & 1) ? 4 : 0)) = (u32x2){w.x, w.y}; *(u32x2*)(gp + ((fq & 1) ? 12 : 8)) = (u32x2){w.z, w.w};
                    } else *(pg8::u32x4*)(rowp + bj * 128) = w; } }
    }
};

struct SchedOut {
    int vcu, G; const char* a; const char* w;
    __device__ __forceinline__ bool next(int i, pg8::Unit& u) const {
        const int L = i * G + vcu; if (L >= 256) return false;
        u.kind = 0; u.pm = L >> 2; u.pn = L & 3; u.aux = 0; u.A = a + (size_t)u.pm * TILEB; u.B = w + (size_t)u.pn * TILEB; return true;
    }
};
struct EpiRes {
    static constexpr bool PERM = true;
    bf16* XB;
    __device__ __forceinline__ void operator()(const pg8::f32x4 (&acc)[2][2][4][2], const pg8::Unit& u, int wr, int wc, int fr, int fq) const {
        const int row0 = u.pm * 256 + wr * 64 + fr, col0 = u.pn * 256 + wc * 32 + 8 * fq;
#pragma unroll
        for (int ai = 0; ai < 2; ++ai)
#pragma unroll
            for (int m = 0; m < 4; ++m) { bf16* rowp = XB + (size_t)(row0 + ai * 128 + m * 16) * D + col0;
#pragma unroll
                for (int bj = 0; bj < 2; ++bj) { pg8::u32x4* p = (pg8::u32x4*)(rowp + bj * 128); const pg8::u32x4 x = *p; const pg8::f32x4 v0 = acc[ai][bj][m][0], v1 = acc[ai][bj][m][1];
                    pg8::u32x4 w; w.x = pg8::cvt_pk_bf16(bf2f((bf16)x.x) * DN_ALPHA + v0[0], bf2f((bf16)(x.x >> 16)) * DN_ALPHA + v0[1]); w.y = pg8::cvt_pk_bf16(bf2f((bf16)x.y) * DN_ALPHA + v0[2], bf2f((bf16)(x.y >> 16)) * DN_ALPHA + v0[3]);
                    w.z = pg8::cvt_pk_bf16(bf2f((bf16)x.z) * DN_ALPHA + v1[0], bf2f((bf16)(x.z >> 16)) * DN_ALPHA + v1[1]); w.w = pg8::cvt_pk_bf16(bf2f((bf16)x.w) * DN_ALPHA + v1[2], bf2f((bf16)(x.w >> 16)) * DN_ALPHA + v1[3]);
                    *p = w; } }
    }
};
struct RouteLds { unsigned lcnt[16]; unsigned gbase[16]; int e0[64], e1[64]; unsigned r0[64], r1[64]; float g0[64], g1[64]; };
constexpr int RT_PITCH = 2052;
__device__ __forceinline__ void ln1_router_chunk(LAS RouteLds* R, LAS unsigned char* tile, int row0, bf16* XB, const float* g, const float* b, const float* wgc, const float* bgc, const float* wgf, const float* bgf,
                                                 gu32* cnt, int* tokidx, float* gate, int wave, int lane) {
    const int tidl = wave * 64 + lane;
    if (tidl < 16) R->lcnt[tidl] = 0u;
#pragma unroll 2
    for (int r = 0; r < 8; ++r) { const int rl = wave * 8 + r; bf16* xbrow = XB + (size_t)(row0 + rl) * D; f32x4 v[4]; float s = 0.f;
#pragma unroll
        for (int j = 0; j < 4; ++j) { const unsigned long long w = *(const GAS unsigned long long*)(xbrow + 4 * lane + 256 * j);
            v[j] = (f32x4){bf2f((bf16)w), bf2f((bf16)(w >> 16)), bf2f((bf16)(w >> 32)), bf2f((bf16)(w >> 48))}; s += (v[j].x + v[j].y) + (v[j].z + v[j].w); }
        const float mean = wave_sum(s) * (1.f / D); float s2 = 0.f;
#pragma unroll
        for (int j = 0; j < 4; ++j) { v[j] = v[j] - mean; s2 += (v[j].x * v[j].x + v[j].y * v[j].y) + (v[j].z * v[j].z + v[j].w * v[j].w); }
        const float rstd = 1.f / sqrtf(wave_sum(s2) * (1.f / D) + 1e-5f);
#pragma unroll
        for (int j = 0; j < 4; ++j) { const int c = 4 * lane + 256 * j; const f32x4 o = v[j] * rstd * *(const GAS f32x4*)(g + c) + *(const GAS f32x4*)(b + c);
            const unsigned w0 = pk2(o.x, o.y), w1 = pk2(o.z, o.w);
            *(GAS unsigned long long*)(xbrow + c) = (unsigned long long)w0 | ((unsigned long long)w1 << 32);
            LAS unsigned* tp = (LAS unsigned*)(tile + rl * RT_PITCH + c * 2); tp[0] = w0; tp[1] = w1; } }
    LDS_WAIT(); __syncthreads();
    float acc[20];
#pragma unroll
    for (int i = 0; i < 20; ++i) acc[i] = 0.f;
    { LAS const unsigned* xr = (LAS const unsigned*)(tile + lane * RT_PITCH) + wave * 64;
      const float* wc = wgc + (size_t)wave * 128 * 4; const float* wf = wgf + (size_t)wave * 128 * 16;
#pragma unroll 2
      for (int kk = 0; kk < 64; ++kk) { const unsigned w = xr[kk]; const float x0 = __uint_as_float(w << 16), x1 = __uint_as_float(w & 0xffff0000u);
#pragma unroll
          for (int i = 0; i < 4; ++i) acc[i] += x0 * wc[(2 * kk) * 4 + i] + x1 * wc[(2 * kk + 1) * 4 + i];
#pragma unroll
          for (int i = 0; i < 16; ++i) acc[4 + i] += x0 * wf[(2 * kk) * 16 + i] + x1 * wf[(2 * kk + 1) * 16 + i]; } }
    LDS_WAIT(); __syncthreads();
    { LAS float* P = (LAS float*)tile + wave * (20 * 64) + lane;
#pragma unroll
      for (int i = 0; i < 20; ++i) P[i * 64] = acc[i]; }
    LDS_WAIT(); __syncthreads();
    if (wave == 0) {
        float my[20];
#pragma unroll
        for (int i = 0; i < 20; ++i) { float t = 0.f;
#pragma unroll
            for (int w = 0; w < 8; ++w) t += ((LAS const float*)tile)[w * (20 * 64) + i * 64 + lane];
            my[i] = t; }
        const int rl = lane;
        float pg[4], mx = -INFINITY, sum = 0.f;
#pragma unroll
        for (int j = 0; j < 4; ++j) { pg[j] = my[j] + bgc[j]; mx = fmaxf(mx, pg[j]); }
#pragma unroll
        for (int j = 0; j < 4; ++j) { pg[j] = expf(pg[j] - mx); sum += pg[j]; }
        int gi = 0; float gw = pg[0];
#pragma unroll
        for (int j = 1; j < 4; ++j) if (pg[j] > gw) { gw = pg[j]; gi = j; }
        gw /= sum;
        float fs[4]; mx = -INFINITY;
#pragma unroll
        for (int j = 0; j < 4; ++j) { float t = 0.f;
#pragma unroll
            for (int q = 0; q < 4; ++q) if (q == gi) t = my[4 + q * 4 + j] + bgf[q * 4 + j];
            fs[j] = t; mx = fmaxf(mx, t); }
#pragma unroll
        for (int j = 0; j < 4; ++j) fs[j] = expf(fs[j] - mx);
        int t0 = 0; float v0 = fs[0];
#pragma unroll
        for (int j = 1; j < 4; ++j) if (fs[j] > v0) { v0 = fs[j]; t0 = j; }
        int t1 = -1; float v1 = -1.f;
#pragma unroll
        for (int j = 0; j < 4; ++j) if (j != t0 && fs[j] > v1) { v1 = fs[j]; t1 = j; }
        const float ts = v0 + v1; const int e0 = gi * 4 + t0, e1 = gi * 4 + t1;
        R->e0[rl] = e0; R->e1[rl] = e1; R->g0[rl] = gw * (v0 / ts); R->g1[rl] = gw * (v1 / ts);
        R->r0[rl] = __hip_atomic_fetch_add(&R->lcnt[e0], 1u, __ATOMIC_RELAXED, __HIP_MEMORY_SCOPE_WORKGROUP);
        R->r1[rl] = __hip_atomic_fetch_add(&R->lcnt[e1], 1u, __ATOMIC_RELAXED, __HIP_MEMORY_SCOPE_WORKGROUP);
    }
    LDS_WAIT(); __syncthreads();
    if (tidl < 16) { const unsigned n = R->lcnt[tidl]; R->gbase[tidl] = n ? __hip_atomic_fetch_add(cnt + tidl * CNT_STRIDE, n, RLX_AGENT) : 0u; }
    LDS_WAIT(); __syncthreads();
    if (tidl < 64) { const int rl = tidl, tok = row0 + rl; const int e0 = R->e0[rl], e1 = R->e1[rl]; const unsigned p0 = R->gbase[e0] + R->r0[rl], p1 = R->gbase[e1] + R->r1[rl];
        tokidx[(size_t)e0 * M + p0] = tok * 2; gate[(size_t)e0 * M + p0] = R->g0[rl]; tokidx[(size_t)e1 * M + p1] = tok * 2 + 1; gate[(size_t)e1 * M + p1] = R->g1[rl]; }
    LDS_WAIT(); __syncthreads();
}

struct MoeTab { LAS const int* p;
    __device__ __forceinline__ int cnt(int e) const { return __builtin_amdgcn_readfirstlane(p[e]); }
    __device__ __forceinline__ int pre(int e) const { return __builtin_amdgcn_readfirstlane(p[16 + e]); } };
__device__ __forceinline__ void moe_tab_build(LAS int* p, const gu32* cnt, bool t0) {
    if (t0) { int acc = 0;
        for (int e = 0; e < 16; ++e) { const int c = (int)__hip_atomic_load(cnt + e * CNT_STRIDE, RLX_AGENT); p[e] = c; p[16 + e] = acc; acc += (c + 255) >> 8; }
        p[32] = acc; }
    __syncthreads();
}
template <int NPN> struct SchedMoe {
    int vcu, G; MoeTab T; const char* a; const char* w; size_t wexp  ; const int* tokidx; size_t atile  ;
    __device__ __forceinline__ bool next(int i, pg8::Unit& u) const {
        const int L = i * G + vcu; if (L >= T.pre(16) * NPN) return false;
        const int tile = L / NPN; u.pn = L % NPN; int e = 0;
#pragma unroll 1
        for (int q = 1; q < 16; ++q) if (tile >= T.pre(q)) e = q;
        u.aux = e; u.pm = tile - T.pre(e); u.kind = tile;
        u.A = a + (size_t)tile * atile; u.B = w + (size_t)e * wexp + (size_t)u.pn * 256 * (wexp / (NPN * 256)); return true;
    }
    __device__ __forceinline__ int arow(const pg8::Unit& u, int r) const {
        const int rank = u.pm * 256 + r; const int c = T.cnt(u.aux);
        return rank < c ? (tokidx[(size_t)u.aux * M + rank] >> 1) : 0;
    }
};
struct EpiMoe1 {
    static constexpr bool PERM = true;
    bf16* act; const float* gate; MoeTab T;
    __device__ __forceinline__ void operator()(const pg8::f32x4 (&acc)[2][2][4][2], const pg8::Unit& u, int wr, int wc, int fr, int fq) const {
        const int cnt = T.cnt(u.aux);
#pragma unroll
        for (int ai = 0; ai < 2; ++ai)
#pragma unroll
            for (int m = 0; m < 4; ++m) { const int r = ai * 128 + wr * 64 + m * 16 + fr, rank = u.pm * 256 + r;
                const float gt = rank < cnt ? gate[(size_t)u.aux * M + rank] : 0.f;
                bf16* rowp = act + ((size_t)u.kind * 256 + r) * 256 + u.pn * 128 + wc * 16 + 4 * fq;
#pragma unroll
                for (int bj = 0; bj < 2; ++bj) { const pg8::f32x4 av = acc[ai][bj][m][0], cv = acc[ai][bj][m][1]; float y[4];
#pragma unroll
                    for (int e = 0; e < 4; ++e) y[e] = av[e] / (1.f + __expf(-av[e])) * cv[e] * gt;
                    *(unsigned long long*)(rowp + bj * 64) = (unsigned long long)pg8::cvt_pk_bf16(y[0], y[1]) | ((unsigned long long)pg8::cvt_pk_bf16(y[2], y[3]) << 32); } }
    }
};
struct EpiMoe2 {
    static constexpr bool PERM = true;
    bf16* ymoe; const int* tokidx; MoeTab T;
    __device__ __forceinline__ void operator()(const pg8::f32x4 (&acc)[2][2][4][2], const pg8::Unit& u, int wr, int wc, int fr, int fq) const {
        const int cnt = T.cnt(u.aux);
#pragma unroll
        for (int ai = 0; ai < 2; ++ai)
#pragma unroll
            for (int m = 0; m < 4; ++m) { const int r = ai * 128 + wr * 64 + m * 16 + fr, rank = u.pm * 256 + r;
                if (rank < cnt) { bf16* rowp = ymoe + (size_t)tokidx[(size_t)u.aux * M + rank] * D + u.pn * 256 + wc * 32 + 8 * fq;
#pragma unroll
                    for (int bj = 0; bj < 2; ++bj) { const pg8::f32x4 v0 = acc[ai][bj][m][0], v1 = acc[ai][bj][m][1];
                        pg8::u32x4 w; w.x = pg8::cvt_pk_bf16(v0[0], v0[1]); w.y = pg8::cvt_pk_bf16(v0[2], v0[3]); w.z = pg8::cvt_pk_bf16(v1[0], v1[1]); w.w = pg8::cvt_pk_bf16(v1[2], v1[3]);
                        *(pg8::u32x4*)(rowp + bj * 128) = w; } } }
    }
};
struct SchedSq {
    int vcu, G; const char* a; const char* w; size_t astep, wstep;
    __device__ __forceinline__ bool next(int i, pg8::Unit& u) const {
        const int L = i * G + vcu; if (L >= 256) return false;
        u.kind = 0; u.pm = L >> 2; u.pn = L & 3; u.aux = 0; u.A = a + (size_t)u.pm * astep; u.B = w + (size_t)u.pn * wstep; return true;
    }
};
template <int GATED> struct EpiPle {
    static constexpr bool PERM = true;
    bf16* yp; const float* bg;
    __device__ __forceinline__ void operator()(const pg8::f32x4 (&acc)[2][2][4][2], const pg8::Unit& u, int wr, int wc, int fr, int fq) const {
        const int row0 = u.pm * 256 + wr * 64 + fr, col0 = u.pn * 256 + wc * 32 + 8 * fq;
#pragma unroll
        for (int ai = 0; ai < 2; ++ai)
#pragma unroll
            for (int m = 0; m < 4; ++m) { bf16* rowp = yp + (size_t)(row0 + ai * 128 + m * 16) * D + col0;
#pragma unroll
                for (int bj = 0; bj < 2; ++bj) { pg8::f32x4 v0 = acc[ai][bj][m][0], v1 = acc[ai][bj][m][1];
                    if (GATED) { const pg8::f32x4 b0 = *(const pg8::f32x4*)(bg + col0 + bj * 128), b1 = *(const pg8::f32x4*)(bg + col0 + bj * 128 + 4); const pg8::u32x4 y = *(const pg8::u32x4*)(rowp + bj * 128);
                        const float yf[8] = {bf2f((bf16)y.x), bf2f((bf16)(y.x >> 16)), bf2f((bf16)y.y), bf2f((bf16)(y.y >> 16)), bf2f((bf16)y.z), bf2f((bf16)(y.z >> 16)), bf2f((bf16)y.w), bf2f((bf16)(y.w >> 16))};
#pragma unroll
                        for (int e = 0; e < 4; ++e) { v0[e] = yf[e] / (1.f + __expf(-(v0[e] + b0[e]))); v1[e] = yf[4 + e] / (1.f + __expf(-(v1[e] + b1[e]))); } }
                    pg8::u32x4 w; w.x = pg8::cvt_pk_bf16(v0[0], v0[1]); w.y = pg8::cvt_pk_bf16(v0[2], v0[3]); w.z = pg8::cvt_pk_bf16(v1[0], v1[1]); w.w = pg8::cvt_pk_bf16(v1[2], v1[3]);
                    *(pg8::u32x4*)(rowp + bj * 128) = w; } }
    }
};
namespace att {
typedef float f32x16 __attribute__((ext_vector_type(16)));
constexpr int KSLOT = 8192, VSLOT = 16384, LDS_K = 0, LDS_V = 2 * KSLOT, ATT_LDS = 2 * KSLOT + 2 * VSLOT;
__device__ __forceinline__ bf16x8 pack8(const f32x16& p, int b) {
    v4u w; w.x = pg8::cvt_pk_bf16(p[b], p[b + 1]); w.y = pg8::cvt_pk_bf16(p[b + 2], p[b + 3]); w.z = pg8::cvt_pk_bf16(p[b + 4], p[b + 5]); w.w = pg8::cvt_pk_bf16(p[b + 6], p[b + 7]);
    return __builtin_bit_cast(bf16x8, w);
}
constexpr float THR2 = 8.f;
__device__ __forceinline__ void qkt(f32x16& p0, f32x16& p1, LAS const unsigned char* ks, const bf16x8 (&qf)[4], int r32, int hi) {
#pragma unroll
    for (int r = 0; r < 16; ++r) { p0[r] = 0.f; p1[r] = 0.f; }
    LAS const unsigned char* kb = ks + hi * 1024 + r32 * 16;
#pragma unroll
    for (int kk = 0; kk < 4; ++kk) {
        const bf16x8 a0 = *(LAS const bf16x8*)(kb + kk * 2048), a1 = *(LAS const bf16x8*)(kb + kk * 2048 + 512);
        p0 = __builtin_amdgcn_mfma_f32_32x32x16_bf16(a0, qf[kk], p0, 0, 0, 0);
        p1 = __builtin_amdgcn_mfma_f32_32x32x16_bf16(a1, qf[kk], p1, 0, 0, 0);
    }
}
__device__ __forceinline__ void partialSM(f32x16& p0, f32x16& p1, float& m, float& alpha) {
    float pmax = fmaxf(p0[0], p1[0]);
#pragma unroll
    for (int r = 1; r < 16; ++r) pmax = fmaxf(pmax, fmaxf(p0[r], p1[r]));
    pmax = fmaxf(pmax, __shfl_xor(pmax, 32));
    if (__builtin_expect(__all(pmax - m <= THR2), 1)) alpha = 1.f;
    else { const float mn = fmaxf(m, pmax); alpha = __builtin_amdgcn_exp2f(m - mn); m = mn; }
    const float mm = m;
#pragma unroll
    for (int r = 0; r < 16; ++r) { p0[r] = __builtin_amdgcn_exp2f(p0[r] - mm); p1[r] -= mm; }
}
__device__ __forceinline__ void finishSM(f32x16& p0, f32x16& p1, float alpha, float& l, bf16x8 (&pf)[4]) {
    float ps = 0.f;
#pragma unroll
    for (int r = 0; r < 16; ++r) { p1[r] = __builtin_amdgcn_exp2f(p1[r]); ps += p0[r] + p1[r]; }
    l = l * alpha + ps;
    pf[0] = pack8(p0, 0); pf[1] = pack8(p0, 8); pf[2] = pack8(p1, 0); pf[3] = pack8(p1, 8);
}
__device__ __forceinline__ void pv(f32x16 (&o)[4], LAS const unsigned char* vs, const bf16x8 (&pf)[4], int r32, int hi) {
    LAS const unsigned char* vb = vs + hi * 2048 + r32 * 16;
#pragma unroll
    for (int db = 0; db < 4; ++db) {
        bf16x8 va[4];
#pragma unroll
        for (int s = 0; s < 4; ++s) va[s] = *(LAS const bf16x8*)(vb + s * 4096 + db * 512);
#pragma unroll
        for (int s = 0; s < 4; ++s) o[db] = __builtin_amdgcn_mfma_f32_32x32x16_bf16(va[s], pf[s], o[db], 0, 0, 0);
        __builtin_amdgcn_sched_group_barrier(0x100, 4, 0); __builtin_amdgcn_sched_group_barrier(0x8, 4, 0);
    }
}
__device__ __forceinline__ void resc(f32x16 (&o)[4], float alpha) {
    if (__any(alpha < 1.f)) {
#pragma unroll
        for (int db = 0; db < 4; ++db)
#pragma unroll
            for (int r = 0; r < 16; ++r) o[db][r] *= alpha;
    }
}
__device__ __forceinline__ void unit(LAS unsigned char* lds, int b, int h, int qb, const bf16* QKP, const bf16* UVT, float lam, float lam_init, const float* subg, bf16* MIXB, float* stash, int wave, int lane) {
    asm volatile("" : "+v"(lane));
    const int r32 = lane & 31, hi = lane >> 5;
    const size_t tok0 = (size_t)b * S;
    const size_t qtok = tok0 + qb * 256 + wave * 32 + r32;
    constexpr int NT = S / 64;
#pragma unroll 1
    for (int c = 0; c < 2; ++c) {
        bf16x8 qf[4];
#pragma unroll
        for (int kk = 0; kk < 4; ++kk) qf[kk] = *(const GAS bf16x8*)(QKP + qtok * 1280 + h * 128 + c * 64 + kk * 16 + hi * 8);
        f32x16 o[4];
#pragma unroll
        for (int db = 0; db < 4; ++db)
#pragma unroll
            for (int r = 0; r < 16; ++r) o[db][r] = 0.f;
        float m = -INFINITY, l = 0.f, alA, alB;
        f32x16 pA0, pA1, pB0, pB1; bf16x8 pf[4];
        const char* kub = (const char*)(QKP + tok0 * 1280 + 512 + h * 128 + c * 64 + wave * 8);
        const char* vub = (const char*)(UVT + (size_t)(768 + h * 128) * M + tok0 + wave * 8);
        const unsigned kvo = (unsigned)lane * 2560u, vvo = (unsigned)lane * (unsigned)(M * 2);
#define ATT_DMA_K(t) __builtin_amdgcn_global_load_lds((const unsigned*)(kub + (size_t)(t) * (64 * 2560) + kvo), (LAS unsigned*)(lds + LDS_K + ((t) & 1) * KSLOT + wave * 1024), 16, 0, 0)
#define ATT_DMA_V(t) do { \
            __builtin_amdgcn_global_load_lds((const unsigned*)(vub + (size_t)(t) * 128 + vvo), (LAS unsigned*)(lds + LDS_V + ((t) & 1) * VSLOT + wave * 2048), 16, 0, 0); \
            __builtin_amdgcn_global_load_lds((const unsigned*)(vub + (size_t)64 * M * 2 + (size_t)(t) * 128 + vvo), (LAS unsigned*)(lds + LDS_V + ((t) & 1) * VSLOT + wave * 2048 + 1024), 16, 0, 0); } while (0)
#define SB() __builtin_amdgcn_sched_barrier(0)
#define ATT_SYNC() do { asm volatile("s_waitcnt vmcnt(0) lgkmcnt(0)" ::: "memory"); __builtin_amdgcn_s_barrier(); asm volatile("" ::: "memory"); } while (0)
        ATT_SYNC();
        ATT_DMA_K(0); ATT_DMA_V(0);
        ATT_SYNC();
        ATT_DMA_K(1);
        qkt(pA0, pA1, lds + LDS_K, qf, r32, hi); partialSM(pA0, pA1, m, alA);
#pragma unroll 1
        for (int j = 1; j < NT - 1; j += 2) {
            ATT_SYNC(); ATT_DMA_K(j + 1); ATT_DMA_V(j);
            SB(); qkt(pB0, pB1, lds + LDS_K + KSLOT, qf, r32, hi); finishSM(pA0, pA1, alA, l, pf); SB();
            pv(o, lds + LDS_V, pf, r32, hi); partialSM(pB0, pB1, m, alB); SB(); resc(o, alB);
            ATT_SYNC(); ATT_DMA_K(j + 2); ATT_DMA_V(j + 1);
            SB(); qkt(pA0, pA1, lds + LDS_K, qf, r32, hi); finishSM(pB0, pB1, alB, l, pf); SB();
            pv(o, lds + LDS_V + VSLOT, pf, r32, hi); partialSM(pA0, pA1, m, alA); SB(); resc(o, alA);
        }
        ATT_SYNC(); ATT_DMA_V(NT - 1);
        SB(); qkt(pB0, pB1, lds + LDS_K + KSLOT, qf, r32, hi); finishSM(pA0, pA1, alA, l, pf); SB();
        pv(o, lds + LDS_V, pf, r32, hi); partialSM(pB0, pB1, m, alB); SB(); resc(o, alB);
        ATT_SYNC();
        finishSM(pB0, pB1, alB, l, pf); pv(o, lds + LDS_V + VSLOT, pf, r32, hi);
#undef ATT_DMA_K
#undef ATT_DMA_V
#undef ATT_SYNC
#undef SB
        const float lt = l + __shfl_xor(l, 32);
        int lane_e = lane; asm volatile("" : "+v"(lane_e));
        const int hi_e = lane_e >> 5; const size_t qtok_e = tok0 + qb * 256 + wave * 32 + (lane_e & 31);
        if (c == 0) {
            const float i1 = 1.f / lt;
#pragma unroll
            for (int db = 0; db < 4; ++db)
#pragma unroll
                for (int g4 = 0; g4 < 4; ++g4) *(GAS f32x4*)(stash + ((db * 4 + g4) * 64 + lane_e) * 4) = (f32x4){o[db][4 * g4] * i1, o[db][4 * g4 + 1] * i1, o[db][4 * g4 + 2] * i1, o[db][4 * g4 + 3] * i1};
        } else {
            const float i2 = lam / lt;
            float ss = 0.f;
#pragma unroll
            for (int db = 0; db < 4; ++db)
#pragma unroll
                for (int g4 = 0; g4 < 4; ++g4) { const f32x4 s1 = *(const GAS f32x4*)(stash + ((db * 4 + g4) * 64 + lane_e) * 4);
#pragma unroll
                    for (int i = 0; i < 4; ++i) { const float v = s1[i] - o[db][4 * g4 + i] * i2; o[db][4 * g4 + i] = v; ss += v * v; } }
            ss += __shfl_xor(ss, 32);
            const float rs = (1.f - lam_init) / sqrtf(ss * (1.f / 128.f) + 1e-5f);
            bf16* orow = MIXB + qtok_e * D + 256 + h * 128;
#pragma unroll
            for (int db = 0; db < 4; ++db)
#pragma unroll
                for (int g4 = 0; g4 < 4; ++g4) { const int e = 32 * db + 8 * g4 + 4 * hi_e; const f32x4 gg = *(const GAS f32x4*)(subg + e);
                    const unsigned long long w = (unsigned long long)pg8::cvt_pk_bf16(o[db][4 * g4] * rs * gg.x, o[db][4 * g4 + 1] * rs * gg.y) | ((unsigned long long)pg8::cvt_pk_bf16(o[db][4 * g4 + 2] * rs * gg.z, o[db][4 * g4 + 3] * rs * gg.w) << 32);
                    *(GAS unsigned long long*)(orow + e) = w; }
        }
    }
}
}
namespace hy {
typedef float f32x16 __attribute__((ext_vector_type(16)));
constexpr int CPY = 16456;
constexpr int LDS_F = 0, LDS_VV = 4 * CPY, LDS_END = LDS_VV + 32768;
static_assert(LDS_VV % 16 == 0 && LDS_END <= 131072, "hyena LDS map");

__device__ __forceinline__ void filter_item(LAS unsigned char* lds, int pb, const float* fw1, const float* fb1, const float* fr1, const float* fw2, const float* fb2, const float* fr2,
                                            const float* fw3, bf16* KF, float* PS, int wave, int lane) {
    LAS bf16* tile = (LAS bf16*)lds;
    LAS float* za = (LAS float*)(lds + 65536) + wave * 512;
    LAS float* zb = (LAS float*)(lds + 81920) + wave * 512;
    LAS float* sqs = (LAS float*)(lds + 98304);
    const int p0 = pb * 64 + wave * 8;
    if (lane < 33) {
#pragma unroll 1
        for (int pi = 0; pi < 8; ++pi) { const int p = p0 + pi; float z;
            if (lane == 0) z = (float)p / (float)(S - 1);
            else { const int bi = (lane - 1) & 15; const float band = 1e-4f + (float)bi * ((15.0f - 1e-4f) / 15.0f), wpos = 2.0f * 3.14159265358979323846f * (float)p / (float)S;
                   z = lane <= 16 ? cosf(wpos * band) : -sinf(wpos * band); }
            za[pi * 64 + lane] = z; }
    }
    LDS_WAIT(); asm volatile("" ::: "memory");
    float acc8[8];
    { const float b1 = fb1[lane];
#pragma unroll
      for (int pi = 0; pi < 8; ++pi) acc8[pi] = b1;
#pragma unroll 1
      for (int i = 0; i < 33; ++i) { const float w = fw1[i * 64 + lane];
#pragma unroll
          for (int pi = 0; pi < 8; ++pi) acc8[pi] += za[pi * 64 + i] * w; }
      const float f1 = fr1[lane];
#pragma unroll
      for (int pi = 0; pi < 8; ++pi) zb[pi * 64 + lane] = sinf(f1 * acc8[pi]); }
    LDS_WAIT(); asm volatile("" ::: "memory");
    { const float b2 = fb2[lane];
#pragma unroll
      for (int pi = 0; pi < 8; ++pi) acc8[pi] = b2;
#pragma unroll 1
      for (int i = 0; i < 64; ++i) { const float w = fw2[i * 64 + lane];
#pragma unroll
          for (int pi = 0; pi < 8; ++pi) acc8[pi] += zb[pi * 64 + i] * w; }
      const float f2 = fr2[lane];
      LDS_WAIT(); asm volatile("" ::: "memory");
#pragma unroll
      for (int pi = 0; pi < 8; ++pi) za[pi * 64 + lane] = sinf(f2 * acc8[pi]); }
    LDS_WAIT(); asm volatile("" ::: "memory");
    const float mind = logf(1e-2f) / 1.5f, maxd = logf(1e-2f) / 0.3f;
#pragma unroll 1
    for (int qh = 0; qh < 2; ++qh) {
        float ac[8][4];
#pragma unroll
        for (int pi = 0; pi < 8; ++pi)
#pragma unroll
            for (int q = 0; q < 4; ++q) ac[pi][q] = 0.f;
#pragma unroll 1
        for (int i = 0; i < 64; ++i) { float w[4];
#pragma unroll
            for (int q = 0; q < 4; ++q) w[q] = fw3[i * 512 + lane + 64 * (qh * 4 + q)];
#pragma unroll
            for (int pi = 0; pi < 8; ++pi) { const float hv = za[pi * 64 + i];
#pragma unroll
                for (int q = 0; q < 4; ++q) ac[pi][q] += hv * w[q]; } }
#pragma unroll
        for (int q = 0; q < 4; ++q) { const int col = lane + 64 * (qh * 4 + q), ch = col & 255; const float delta = fabsf(mind + (float)ch * ((maxd - mind) / 255.0f)); float sq = 0.f;
#pragma unroll
            for (int pi = 0; pi < 8; ++pi) { const int p = p0 + pi; const float val = ac[pi][q] * expf(-((float)p / (float)(S - 1)) * delta);
                if (!(col >= 256 && p == 0)) sq += val * val;
                tile[col * 64 + wave * 8 + pi] = (bf16)f2bf(val); }
            sqs[wave * 512 + col] = sq; }
    }
    LDS_WAIT(); __syncthreads();
    { const int p = pb * 64 + lane;
#pragma unroll 1
      for (int cc = 0; cc < 64; ++cc) { const int col = wave * 64 + cc; const bf16 v = tile[col * 64 + lane];
          if (col < 256) KF[(size_t)col * 8192 + 4095 - p] = v; else if (p != 0) KF[(size_t)(col - 256) * 8192 + 4095 + p] = v; } }
    { const int t = wave * 64 + lane; float s = 0.f;
#pragma unroll
      for (int w = 0; w < 8; ++w) s += sqs[w * 512 + t];
      PS[(size_t)pb * 512 + t] = s;
      if (pb == 0 && t < 256) KF[(size_t)t * 8192 + 8191] = 0; }
    LDS_WAIT(); __syncthreads();
}

__device__ __forceinline__ float conv1(float um, float u0, float up, float w0, float w1, float w2, float cb) { return um * w0 + u0 * w1 + up * w2 + cb; }

__device__ __forceinline__ void unit(LAS unsigned char* lds, int c, const bf16* KF, const float* PS, const bf16* UVT, const float* cw, const float* cb, const float* bias_d, bf16* HT, int wave, int lane) {
    asm volatile("" : "+s"(wave), "+v"(lane));
    const int tid = wave * 64 + lane;
    { const bf16* src = KF + (size_t)c * 8192;
#pragma unroll
      for (int i = 0; i < 2; ++i) { const int ch = tid + 512 * i; *(LAS v4u*)(lds + LDS_F + ch * 16) = *(const GAS v4u*)(src + ch * 8); } }
    { const float w0v = cw[512 + c], w1v = cw[768 + 512 + c], w2v = cw[1536 + 512 + c], cbv = cb[512 + c], w0x = cw[256 + c], w1x = cw[768 + 256 + c], w2x = cw[1536 + 256 + c], cbx = cb[256 + c];
      const bf16* rv = UVT + (size_t)(512 + c) * M; const bf16* rx = UVT + (size_t)(256 + c) * M;
#pragma unroll 1
      for (int i = 0; i < 4; ++i) { const int q = tid + 512 * i, b = q >> 9, sc = q & 511, s0 = sc * 8; const size_t g0 = (size_t)b * S + s0;
          const v4u av = *(const GAS v4u*)(rv + g0), ax = *(const GAS v4u*)(rx + g0);
          float uv[10], ux[10];
          uv[0] = s0 > 0 ? bf2f(rv[g0 - 1]) : 0.f; ux[0] = s0 > 0 ? bf2f(rx[g0 - 1]) : 0.f; uv[9] = s0 + 8 < S ? bf2f(rv[g0 + 8]) : 0.f; ux[9] = s0 + 8 < S ? bf2f(rx[g0 + 8]) : 0.f;
#pragma unroll
          for (int e = 0; e < 4; ++e) { uv[1 + 2 * e] = bf2f((bf16)av[e]); uv[2 + 2 * e] = bf2f((bf16)(av[e] >> 16)); ux[1 + 2 * e] = bf2f((bf16)ax[e]); ux[2 + 2 * e] = bf2f((bf16)(ax[e] >> 16)); }
          float o[8];
#pragma unroll
          for (int e = 0; e < 8; ++e) o[e] = conv1(uv[e], uv[e + 1], uv[e + 2], w0v, w1v, w2v, cbv) * conv1(ux[e], ux[e + 1], ux[e + 2], w0x, w1x, w2x, cbx);
          v4u w; w.x = pk2(o[0], o[1]); w.y = pk2(o[2], o[3]); w.z = pk2(o[4], o[5]); w.w = pk2(o[6], o[7]);
          *(LAS v4u*)(lds + LDS_VV + (((sc & 7) * 64 + (sc >> 3)) * 4 + b) * 16) = w; } }
    LDS_WAIT(); __syncthreads();
    {
#pragma unroll 1
      for (int i = 0; i < 4; ++i) { const int y = tid + 512 * i;
          const unsigned long long w0 = *(LAS const unsigned long long*)(lds + LDS_F + y * 8), w1 = *(LAS const unsigned long long*)(lds + LDS_F + y * 8 + 8);
#pragma unroll
          for (int p = 1; p < 4; ++p) *(LAS unsigned long long*)(lds + LDS_F + p * CPY + y * 8) = (w0 >> (16 * p)) | (w1 << (64 - 16 * p)); } }
    const float nrm = 1.0f / sqrtf(wave_sum(PS[(size_t)lane * 512 + c] + PS[(size_t)lane * 512 + 256 + c]) + 1e-6f);
    LDS_WAIT(); __syncthreads();
    const int r32 = lane & 31, hi = lane >> 5, gp = wave & 3, half = wave >> 2, iloc = r32 >> 2, b = r32 & 3;
    f32x16 acc[2][2];
#pragma unroll
    for (int rho = 0; rho < 2; ++rho)
#pragma unroll
        for (int gg = 0; gg < 2; ++gg)
#pragma unroll
            for (int r = 0; r < 16; ++r) acc[rho][gg][r] = 0.f;
    const int dlo = 16 * gp - 63 + (half ? 40 : 0), dn = half ? 39 : 40;
    int pa = LDS_F + (3 - (r32 & 3)) * CPY + (4092 - 4 * (r32 >> 2) + 8 * hi) * 2 - 64 - 128 * dlo;
    int jb = 16 * gp + iloc - dlo;
    const int pbase = LDS_VV + hi * 4096 + b * 16;
#pragma unroll 1
    for (int dd = 0; dd < dn; ++dd) {
        const int j0 = jb, j1 = jb + 8; const bool v0 = (unsigned)j0 < 64u, v1 = (unsigned)j1 < 64u;
        LAS const unsigned char* ap = lds + pa; LAS const unsigned char* bp0 = lds + pbase + (v0 ? j0 : 0) * 64; LAS const unsigned char* bp1 = lds + pbase + (v1 ? j1 : 0) * 64;
#pragma unroll
        for (int k = 0; k < 4; ++k) {
            typedef unsigned long long u64;
            const u64 a00 = *(LAS const u64*)(ap + 64 + 32 * k), a01 = *(LAS const u64*)(ap + 64 + 32 * k + 8), a10 = *(LAS const u64*)(ap + 32 * k), a11 = *(LAS const u64*)(ap + 32 * k + 8);
            v4u b0 = *(LAS const v4u*)(bp0 + k * 8192), b1 = *(LAS const v4u*)(bp1 + k * 8192);
            if (!v0) b0 = (v4u){0u, 0u, 0u, 0u};
            if (!v1) b1 = (v4u){0u, 0u, 0u, 0u};
            const bf16x8 fa0 = __builtin_bit_cast(bf16x8, (v4u){(unsigned)a00, (unsigned)(a00 >> 32), (unsigned)a01, (unsigned)(a01 >> 32)});
            const bf16x8 fa1 = __builtin_bit_cast(bf16x8, (v4u){(unsigned)a10, (unsigned)(a10 >> 32), (unsigned)a11, (unsigned)(a11 >> 32)});
            const bf16x8 fb0 = __builtin_bit_cast(bf16x8, b0), fb1 = __builtin_bit_cast(bf16x8, b1);
            acc[0][0] = __builtin_amdgcn_mfma_f32_32x32x16_bf16(fa0, fb0, acc[0][0], 0, 0, 0);
            acc[0][1] = __builtin_amdgcn_mfma_f32_32x32x16_bf16(fa0, fb1, acc[0][1], 0, 0, 0);
            acc[1][0] = __builtin_amdgcn_mfma_f32_32x32x16_bf16(fa1, fb0, acc[1][0], 0, 0, 0);
            acc[1][1] = __builtin_amdgcn_mfma_f32_32x32x16_bf16(fa1, fb1, acc[1][1], 0, 0, 0);
        }
        pa -= 128; jb -= 1;
    }
    LDS_WAIT(); __syncthreads();
    { LAS float* xw = (LAS float*)(lds + LDS_F) + (gp * 2 + (half ? 0 : 1)) * 2048 + lane;
#pragma unroll
      for (int gg = 0; gg < 2; ++gg)
#pragma unroll
          for (int r = 0; r < 16; ++r) xw[(gg * 16 + r) * 64] = half ? acc[0][gg][r] : acc[1][gg][r]; }
    LDS_WAIT(); __syncthreads();
    f32x16 fin[2];
    { LAS const float* xr = (LAS const float*)(lds + LDS_F) + (gp * 2 + (half ? 1 : 0)) * 2048 + lane;
#pragma unroll
      for (int gg = 0; gg < 2; ++gg)
#pragma unroll
          for (int r = 0; r < 16; ++r) fin[gg][r] = (half ? acc[1][gg][r] : acc[0][gg][r]) + xr[(gg * 16 + r) * 64]; }
    { const float bd = bias_d[c], w0 = cw[c], w1 = cw[768 + c], w2 = cw[1536 + c], cb0 = cb[c]; const bf16* r0p = UVT + (size_t)c * M; bf16* hrow = HT + (size_t)c * M;
#pragma unroll
      for (int gg = 0; gg < 2; ++gg)
#pragma unroll
          for (int g4 = 0; g4 < 4; ++g4) { const int i = 16 * gp + 8 * gg + iloc, rr = 32 * half + 8 * g4 + 4 * hi, t0 = 64 * i + rr; const size_t tok = (size_t)b * S + t0;
              const unsigned long long vw = *(LAS const unsigned long long*)(lds + LDS_VV + (((rr >> 3) * 64 + i) * 4 + b) * 16 + (rr & 7) * 2);
              const unsigned long long uw = *(const GAS unsigned long long*)(r0p + tok);
              float u[6]; u[0] = t0 > 0 ? bf2f(r0p[tok - 1]) : 0.f; u[5] = t0 + 4 < S ? bf2f(r0p[tok + 4]) : 0.f;
              u[1] = bf2f((bf16)uw); u[2] = bf2f((bf16)(uw >> 16)); u[3] = bf2f((bf16)(uw >> 32)); u[4] = bf2f((bf16)(uw >> 48));
              float o[4];
#pragma unroll
              for (int e = 0; e < 4; ++e) { const float vv = bf2f((bf16)(vw >> (16 * e))); o[e] = (nrm * fin[gg][4 * g4 + e] + vv * bd) * conv1(u[e], u[e + 1], u[e + 2], w0, w1, w2, cb0); }
              *(GAS unsigned long long*)(hrow + tok) = (unsigned long long)pk2(o[0], o[1]) | ((unsigned long long)pk2(o[2], o[3]) << 32); } }
    LDS_WAIT(); __syncthreads();
}
__device__ __forceinline__ void transpose_slab(LAS unsigned char* lds, int slab, const bf16* HT, bf16* MIXB, int wave, int lane) {
    const int tid = wave * 64 + lane; LAS bf16* tile = (LAS bf16*)lds;
#pragma unroll 1
    for (int i = 0; i < 4; ++i) { const int q = tid + 512 * i, c = q >> 3, tc = q & 7; const v4u w = *(const GAS v4u*)(HT + (size_t)c * M + (size_t)slab * 64 + tc * 8);
#pragma unroll
        for (int e = 0; e < 4; ++e) { tile[(tc * 8 + 2 * e) * 264 + c] = (bf16)w[e]; tile[(tc * 8 + 2 * e + 1) * 264 + c] = (bf16)(w[e] >> 16); } }
    LDS_WAIT(); __syncthreads();
#pragma unroll 1
    for (int i = 0; i < 4; ++i) { const int q = tid + 512 * i, tk = q >> 5, cc = q & 31;
        *(GAS v4u*)(MIXB + ((size_t)slab * 64 + tk) * D + cc * 8) = *(LAS const v4u*)(lds + (tk * 264 + cc * 8) * 2); }
    LDS_WAIT(); __syncthreads();
}
}
#ifndef DUP_PRO
#define DUP_PRO 1
#endif
#ifndef DUP_IN
#define DUP_IN 1
#endif
#ifndef DUP_HY
#define DUP_HY 1
#endif
#ifndef DUP_HYT
#define DUP_HYT 1
#endif
#ifndef DUP_ATT
#define DUP_ATT 1
#endif
#ifndef DUP_POOL
#define DUP_POOL 1
#endif
#ifndef DUP_WCV
#define DUP_WCV 1
#endif
#ifndef DUP_MOE1
#define DUP_MOE1 1
#endif
#ifndef DUP_MOE2
#define DUP_MOE2 1
#endif
#ifndef EN_HY
#define EN_HY 1
#endif
#ifndef EN_HYT
#define EN_HYT 1
#endif
#ifndef EN_PRO
#define EN_PRO 1
#endif
#ifndef EN_IN
#define EN_IN 1
#endif
#ifndef EN_ATT
#define EN_ATT 1
#endif
#ifndef EN_POOL
#define EN_POOL 1
#endif
#ifndef EN_OUT
#define EN_OUT 1
#endif
#ifndef EN_LN1
#define EN_LN1 1
#endif
#ifndef EN_WCV
#define EN_WCV 1
#endif
#ifndef EN_MOE1
#define EN_MOE1 1
#endif
#ifndef EN_MOE2
#define EN_MOE2 1
#endif
#ifndef EN_LN2
#define EN_LN2 1
#endif
constexpr int RING_BYTES = 135168;
constexpr int LDSCTL_OFF = RING_BYTES, MISC_OFF = LDSCTL_OFF + 320, MOETAB_OFF = LDSCTL_OFF + 1024, ROUTE_OFF = LDSCTL_OFF + 2048;
constexpr int LDS_BYTES = 151552;

struct Args { const float* in[38]; float* out; unsigned char* ws; int* eid; float* wts; int ph_lo, ph_hi, l_lo, l_hi, single, pad; };
enum { PH_PRO = 0, PH_IN = 1, PH_ATT = 2, PH_POOL = 3, PH_OUT = 4, PH_LN1 = 5, PH_WCV = 6, PH_MOE1 = 7, PH_MOE2 = 8, PH_LN2 = 9, PH_HY = 10, PH_HYT = 11, PH_END = 12 };

__global__ void __launch_bounds__(NWAVES * 64, 2) mk_fwd(Args a) {
    extern __shared__ __attribute__((aligned(16))) unsigned char lds_raw[];
    LAS unsigned char* lds = (LAS unsigned char*)lds_raw;
    volatile LAS unsigned* MISC = (volatile LAS unsigned*)(lds + MISC_OFF);
    const int wave_s = __builtin_amdgcn_readfirstlane((int)threadIdx.x >> 6);
    const int G = gridDim.x, bx = blockIdx.x, vcu0 = (G % 8 == 0) ? (bx % 8) * (G / 8) + bx / 8 : bx;
    gu32* ctl0 = (gu32*)(a.ws + WS_CTL);
    for (int u = wave_s * 64 + (int)mk_lane_id(); u < (LDS_BYTES - LDSCTL_OFF) / 4; u += NWAVES * 64) ((LAS unsigned*)(lds + LDSCTL_OFF))[u] = 0u;
    __syncthreads();
    XcdBarrier bar; bar.bar = (unsigned*)(ctl0 + CW_BAR); bar.x = 0; bar.st = nullptr;
#if defined(MK_PER_PHASE)
    if (!a.single)
#endif
    bar = xcd_barrier_post((unsigned*)(ctl0 + CW_BAR), MISC + 8, wave_s);
#if defined(MK_PER_PHASE)
#define IN(k) (a.ph_lo <= (k) && (k) < a.ph_hi)
#define SEAM() do { if (!a.single) xcd_barrier(bar, wave_s); } while (0)
#else
#define IN(k) 1
#define SEAM() xcd_barrier(bar, wave_s)
#endif
    const int NGW = G * NWAVES;
#define PHASE_PTRS() int lane_ = (int)mk_lane_id(); asm volatile("" : "+v"(lane_)); const int lane = lane_, wave = wave_s; int vcu = vcu0; asm volatile("" : "+s"(vcu)); (void)wave; const int gw = vcu * NWAVES + wave; (void)gw; unsigned char* ws = a.ws; gu32* ctl = (gu32*)(ws + WS_CTL); (void)ctl; \
    bf16* XB = (bf16*)(ws + WS_XB); bf16* QKP = (bf16*)(ws + WS_QKP); bf16* UVT = (bf16*)(ws + WS_UVT); float* CS = (float*)(ws + WS_CS); bf16* MIXB = (bf16*)(ws + WS_MIXB); \
    (void)XB; (void)QKP; (void)UVT; (void)CS; (void)MIXB
#define INP(k) (a.in[k])
#define WCV_LAYER(LEXPR, GW_, NGW_) do { const int wl_ = (LEXPR), wg_ = (GW_), wn_ = (NGW_); const int l = wl_, gw = wg_, NGW = wn_; (void)NGW; \
            LAS float* scr = (LAS float*)(lds + wave * 16384); \
            unsigned char* wb_ = ws + WS_WBUF + (size_t)(l & 1) * WBUF_STRIDE; bf16* W13 = (bf16*)(wb_ + WB_W13); bf16* W2 = (bf16*)(wb_ + WB_W2); bf16* WG = (bf16*)(wb_ + WB_WG); bf16* WP = (bf16*)(wb_ + WB_WP); \
            for (int it = gw; it < 6784; it += NGW) { \
                const float* src; int K, N, k0, n0, mode = 0; bf16* dst; \
                if (it < 4096) { const int which = it >> 11, r = it & 2047, e = r >> 7, kb = (r >> 3) & 15, nb = r & 7; \
                    src = INP(which ? 31 : 30) + ((size_t)l * 16 + e) * D * 256; K = D; N = 256; k0 = kb * 64; n0 = nb * 32; mode = 1 + which; dst = W13 + (size_t)e * 512 * D; \
                } else if (it < 6144) { const int r = it - 4096, e = r >> 7, kb = (r >> 5) & 3, nb = r & 31; \
                    src = INP(32) + ((size_t)l * 16 + e) * 256 * D; K = 256; N = D; k0 = kb * 64; n0 = nb * 32; dst = W2 + (size_t)e * D * 256 + (size_t)n0 * 256; \
                } else if (it < 6656) { const int r = it - 6144, kb = r >> 5, nb = r & 31; \
                    src = INP(33) + (size_t)l * D * D; K = D; N = D; k0 = kb * 64; n0 = nb * 32; dst = WG + (size_t)n0 * D; \
                } else { const int r = it - 6656, kb = r >> 5, nb = r & 31; \
                    src = INP(35) + (size_t)l * 256 * D; K = 256; N = D; k0 = kb * 64; n0 = nb * 32; dst = WP + (size_t)n0 * 256; } \
                p0_transpose_block(src, K, N, k0, n0, dst, mode, scr, lane); \
            } \
            const int ln = lane; \
            const float* ps = INP(1) + (size_t)l * M * 256; bf16* PB = (bf16*)(wb_ + WB_PB); \
            for (size_t i = ((size_t)gw * 64 + ln) * 8; i < (size_t)M * 256; i += (size_t)NGW * 64 * 8) { const f32x4 x0 = *(const GAS f32x4*)(ps + i), x1 = *(const GAS f32x4*)(ps + i + 4); \
                v4u o; o.x = pk2(x0.x, x0.y); o.y = pk2(x0.z, x0.w); o.z = pk2(x1.x, x1.y); o.w = pk2(x1.z, x1.w); *(GAS v4u*)(PB + i) = o; } \
    } while (0)

    if (EN_PRO && IN(PH_PRO)) {
            PHASE_PTRS();
        LAS float* scr = (LAS float*)(lds + wave * 16384);
        for (int it = gw; it < DEPTH * (16 * 72 + 16 * 32); it += NGW) {
            const int l = it / 1664, r = it % 1664; const float* src; int N, k0, n0; bf16* dst;
            if (r < 1152) { const int kb = r / 72, nb = r % 72; n0 = nb * 32; k0 = kb * 64; N = INW; src = INP(4) + (size_t)l * D * INW;
                bf16* wsw = (bf16*)(ws + WS_WIN + (size_t)l * WIN_LAYER); bf16* wnm = wsw + 1280 * 1024;
                dst = n0 < 768 ? wsw + (size_t)n0 * D : (n0 < 1792 ? wnm + (size_t)(n0 - 768) * D : wsw + (size_t)(768 + n0 - 1792) * D); }
            else { const int q = r - 1152, kb = q >> 5, nb = q & 31; n0 = nb * 32; k0 = kb * 64; N = D; src = INP(23) + (size_t)l * D * D; dst = (bf16*)(ws + WS_WOUT + (size_t)l * WOUT_LAYER) + (size_t)n0 * D; }
            p0_transpose_block(src, D, N, k0, n0, dst, 0, scr, lane);
        }
        for (int it = gw; it < DEPTH * 4 * 16 * 2; it += NGW) {
            const int l = it >> 7, g = (it >> 5) & 3, dh = (it >> 4) & 1, k = (it & 15) * 64 + lane;
            const float* wrow = INP(4) + (size_t)l * D * INW + (size_t)k * INW + 2304 + g * 64;
            const float* pw = INP(20) + (size_t)(l * 4 + g) * 64 * 64 + dh * 32;
            float acc[32];
#pragma unroll
            for (int d = 0; d < 32; ++d) acc[d] = 0.f;
#pragma unroll 1
            for (int c = 0; c < 64; ++c) { const float x = wrow[c];
#pragma unroll
                for (int d = 0; d < 32; ++d) acc[d] += x * pw[c * 64 + d]; }
            bf16* dst = (bf16*)(ws + WS_WIN + (size_t)l * WIN_LAYER) + (size_t)(1280 + 1024 + g * 64 + dh * 32) * D + k;
#pragma unroll
            for (int d = 0; d < 32; ++d) dst[(size_t)d * D] = (bf16)f2bf(acc[d]);
        }
        int ln2 = lane; asm volatile("" : "+v"(ln2));
        for (int i = gw * 64 + ln2; i < S * 8; i += NGW * 64) { const int pos = i >> 3, j = i & 7; const float ang = (float)pos * powf(500000.0f, -(float)(2 * j) / 16.0f);
            CS[pos * 16 + j] = cosf(ang); CS[pos * 16 + 8 + j] = sinf(ang); }
        for (int m = gw; m < M; m += NGW) ln_row(INP(0) + (size_t)m * D, 1.f, nullptr, nullptr, nullptr, INP(2), INP(3), nullptr, XB + (size_t)m * D, lane);
        WCV_LAYER(0, gw, NGW);
        LDS_WAIT(); __syncthreads();
        for (int it = vcu; it < DEPTH * 64; it += G) { const int fl = it >> 6, pb = it & 63;
            hy::filter_item(lds, pb, INP(7) + fl * 33 * 64, INP(8) + fl * 64, INP(9) + fl * 64, INP(10) + fl * 64 * 64, INP(11) + fl * 64, INP(12) + fl * 64, INP(13) + fl * 64 * 512,
                            (bf16*)(ws + WS_KF) + (size_t)fl * 256 * 8192, (float*)(ws + WS_PS) + (size_t)fl * 64 * 512, wave, lane); }
        SEAM();
    }
#if defined(MK_PER_PHASE)
    for (int l = a.l_lo; l < a.l_hi; ++l) {
#else
#pragma unroll 1
    for (int l = 0; l < DEPTH; ++l) {
#endif
        if (EN_IN && IN(PH_IN)) {
            PHASE_PTRS();
            const char* wsw = (const char*)(ws + WS_WIN + (size_t)l * WIN_LAYER);
            SchedIn Sc{vcu, G, (const char*)XB, wsw, wsw + (size_t)1280 * 1024 * 2};
            EpiIn E{QKP, UVT, CS};
            pg8::gemm_phase<EpiIn, SchedIn>(lds, D, Sc, E, wave);
            SEAM();
        }
        if (EN_HY && IN(PH_HY)) {
            PHASE_PTRS();
            for (int c = vcu; c < 256; c += G)
                hy::unit(lds, c, (const bf16*)(ws + WS_KF) + (size_t)l * 256 * 8192, (const float*)(ws + WS_PS) + (size_t)l * 64 * 512, UVT, INP(5) + l * 3 * 768, INP(6) + l * 768, INP(14) + l * 256, (bf16*)(ws + WS_HT), wave, lane);
        }
        if (EN_POOL && IN(PH_POOL)) {
            PHASE_PTRS();
            int ln = lane; asm volatile("" : "+v"(ln));
            const int cc = (ln & 31) * 8, gq = cc >> 6, hw = 1 << gq;
            const float* pb = INP(21) + l * 256 + cc; const float* psc = INP(22) + l * 256 + cc;
            for (int it = gw; it < M / 2; it += NGW) {
                const int tok = it * 2 + (ln >> 5), pos = tok & (S - 1);
                int lo = pos - hw, hi2 = pos + hw - 1; lo = lo < 0 ? 0 : lo; hi2 = hi2 > S - 1 ? S - 1 : hi2;
                float sacc[8];
#pragma unroll
                for (int e = 0; e < 8; ++e) sacc[e] = 0.f;
                const bf16* zp = QKP + (size_t)(tok - pos) * 1280 + 1024 + cc;
                for (int r = lo; r <= hi2; ++r) { const v4u w = *(const GAS v4u*)(zp + (size_t)r * 1280);
                    sacc[0] += bf2f((bf16)w.x); sacc[1] += bf2f((bf16)(w.x >> 16)); sacc[2] += bf2f((bf16)w.y); sacc[3] += bf2f((bf16)(w.y >> 16));
                    sacc[4] += bf2f((bf16)w.z); sacc[5] += bf2f((bf16)(w.z >> 16)); sacc[6] += bf2f((bf16)w.w); sacc[7] += bf2f((bf16)(w.w >> 16)); }
                const float inv = 1.f / (float)(hi2 - lo + 1);
                const v4u w = *(const GAS v4u*)(zp + (size_t)pos * 1280);
                float z[8] = {bf2f((bf16)w.x), bf2f((bf16)(w.x >> 16)), bf2f((bf16)w.y), bf2f((bf16)(w.y >> 16)), bf2f((bf16)w.z), bf2f((bf16)(w.z >> 16)), bf2f((bf16)w.w), bf2f((bf16)(w.w >> 16))};
                float y[8];
#pragma unroll
                for (int e = 0; e < 8; ++e) y[e] = (sacc[e] * inv - z[e] + pb[e]) * psc[e];
                v4u o; o.x = pk2(y[0], y[1]); o.y = pk2(y[2], y[3]); o.z = pk2(y[4], y[5]); o.w = pk2(y[6], y[7]);
                *(GAS v4u*)(MIXB + (size_t)tok * D + 768 + cc) = o;
            }
            SEAM();
        }
        if (EN_HYT && IN(PH_HYT)) {
            PHASE_PTRS();
            for (int s = vcu; s < 256; s += G) hy::transpose_slab(lds, s, (const bf16*)(ws + WS_HT), MIXB, wave, lane);
        }
        if (EN_ATT && IN(PH_ATT)) {
            PHASE_PTRS();
            const float lam_init = 0.8f - 0.6f * expf(-0.3f * (float)l);
            int ln = lane; asm volatile("" : "+v"(ln));
            const float lam = expf(wave_sum(INP(15)[l * 64 + ln] * INP(16)[l * 64 + ln])) - expf(wave_sum(INP(17)[l * 64 + ln] * INP(18)[l * 64 + ln])) + lam_init;
            for (int u = vcu; u < 256; u += G) att::unit(lds, (u >> 4) >> 2, (u >> 4) & 3, u & 15, QKP, UVT, lam, lam_init, INP(19) + l * 128, MIXB, (float*)(ws + WS_STASH) + ((size_t)u * 8 + wave) * 4096, wave, lane);
            SEAM();
        }
        if (EN_OUT && IN(PH_OUT)) {
            PHASE_PTRS();
            SchedOut Sc{vcu, G, (const char*)MIXB, (const char*)(ws + WS_WOUT + (size_t)l * WOUT_LAYER)};
#if defined(PROBE_OUT)
            { EpiRes E0{(bf16*)(ws + WS_STASH)}; pg8::gemm_phase<EpiRes, SchedOut>(lds, D, Sc, E0, wave); }
#endif
            EpiRes E{XB};
            pg8::gemm_phase<EpiRes, SchedOut>(lds, D, Sc, E, wave);
            SEAM();
        }
        if (EN_LN1 && IN(PH_LN1)) {
            PHASE_PTRS();
            int ln = lane; asm volatile("" : "+v"(ln));
            for (int ch = vcu; ch < M / 64; ch += G)
                ln1_router_chunk((LAS RouteLds*)(lds + ROUTE_OFF), lds, ch * 64, XB, INP(24) + l * D, INP(25) + l * D, INP(26) + (size_t)l * D * 4, INP(27) + l * 4, INP(28) + (size_t)l * D * 16, INP(29) + l * 16,
                                 ctl + CW_CNT + l * 16 * CNT_STRIDE, (int*)(ws + WS_TOKIDX), (float*)(ws + WS_GATE), wave, lane);
            SEAM();
        }
        if (EN_MOE1 && IN(PH_MOE1)) {
            PHASE_PTRS();
            moe_tab_build((LAS int*)(lds + MOETAB_OFF), ctl + CW_CNT + l * 16 * CNT_STRIDE, wave == 0 && lane == 0); const MoeTab T{(LAS const int*)(lds + MOETAB_OFF)};
            { SchedMoe<2> Sc{vcu, G, T, (const char*)XB, (const char*)(ws + WS_WBUF + (size_t)(l & 1) * WBUF_STRIDE + WB_W13), (size_t)512 * D * 2, (const int*)(ws + WS_TOKIDX), 0};
              EpiMoe1 E{(bf16*)(ws + WS_ACT), (const float*)(ws + WS_GATE), T};
              pg8::gemm_phase<EpiMoe1, SchedMoe<2>, true>(lds, D, Sc, E, wave); }
            { SchedSq Sc{vcu, G, (const char*)(ws + WS_WBUF + (size_t)(l & 1) * WBUF_STRIDE + WB_PB), (const char*)(ws + WS_WBUF + (size_t)(l & 1) * WBUF_STRIDE + WB_WP), (size_t)256 * 256 * 2, (size_t)256 * 256 * 2};
              EpiPle<0> E{(bf16*)(ws + WS_YP), nullptr};
              pg8::gemm_phase<EpiPle<0>, SchedSq>(lds, 256, Sc, E, wave); }
            { SchedSq Sc{vcu, G, (const char*)XB, (const char*)(ws + WS_WBUF + (size_t)(l & 1) * WBUF_STRIDE + WB_WG), TILEB, TILEB};
              EpiPle<1> E{(bf16*)(ws + WS_YP), INP(34) + l * D};
              pg8::gemm_phase<EpiPle<1>, SchedSq>(lds, D, Sc, E, wave); }
            if (l + 1 < DEPTH) {
                int x2 = 2 * T.pre(16) - G; x2 = x2 < 0 ? 0 : (x2 > G / 2 ? G / 2 : x2);
                if (vcu >= x2) WCV_LAYER(l + 1, (vcu - x2) * NWAVES + wave, (G - x2) * NWAVES);
            }
            SEAM();
        }
        if (EN_MOE2 && IN(PH_MOE2)) {
            PHASE_PTRS();
            moe_tab_build((LAS int*)(lds + MOETAB_OFF), ctl + CW_CNT + l * 16 * CNT_STRIDE, wave == 0 && lane == 0); const MoeTab T{(LAS const int*)(lds + MOETAB_OFF)};
            SchedMoe<4> Sc{vcu, G, T, (const char*)(ws + WS_ACT), (const char*)(ws + WS_WBUF + (size_t)(l & 1) * WBUF_STRIDE + WB_W2), (size_t)D * 256 * 2, (const int*)(ws + WS_TOKIDX), (size_t)256 * 256 * 2};
            EpiMoe2 E{(bf16*)(ws + WS_YMOE), (const int*)(ws + WS_TOKIDX), T};
            pg8::gemm_phase<EpiMoe2, SchedMoe<4>>(lds, 256, Sc, E, wave);
            SEAM();
        }
        if (EN_LN2 && IN(PH_LN2)) {
            PHASE_PTRS();
            int ln = lane; asm volatile("" : "+v"(ln));
            const bf16* YM = (const bf16*)(ws + WS_YMOE); const bf16* YP = (const bf16*)(ws + WS_YP);
            const bool lastl = (l == DEPTH - 1);
#if defined(PROBE_LN2)
            for (int m = gw; m < M; m += NGW)
                ln_row(XB + (size_t)m * D, DN_ALPHA, YM + (size_t)(2 * m) * D, YM + (size_t)(2 * m + 1) * D, YP + (size_t)m * D, INP(36) + l * D, INP(37) + l * D, (float*)nullptr, (bf16*)(ws + WS_STASH) + (size_t)m * D, ln);
#endif
            for (int m = gw; m < M; m += NGW)
                ln_row(XB + (size_t)m * D, DN_ALPHA, YM + (size_t)(2 * m) * D, YM + (size_t)(2 * m + 1) * D, YP + (size_t)m * D, INP(36) + l * D, INP(37) + l * D,
                       lastl ? a.out + (size_t)m * D : (float*)nullptr, lastl ? nullptr : XB + (size_t)m * D, ln);
            SEAM();
        }
    }
#undef IN
#undef SEAM
}
static void mk_launch(const Args& base, int ph, int l, int grid, hipStream_t stream) {
    Args a = base; a.ph_lo = ph; a.ph_hi = ph + 1; a.l_lo = l; a.l_hi = l + 1; a.single = 1;
    hipLaunchKernelGGL(mk_fwd, dim3(grid), dim3(NWAVES * 64), LDS_BYTES, stream, a);
}
extern "C" void kernel_launch(void* const* d_in, const int* in_sizes, int n_in, void* d_out, int out_size, void* d_ws, size_t ws_size, hipStream_t stream) {
    (void)in_sizes; (void)n_in; (void)out_size; (void)ws_size;
    static int grid = 0;
    if (grid == 0) {
        int dev = 0, cus = 0;
        if (hipGetDevice(&dev) != hipSuccess || hipDeviceGetAttribute(&cus, hipDeviceAttributeMultiprocessorCount, dev) != hipSuccess) { grid = -1; return; }
        if (hipFuncSetAttribute((const void*)mk_fwd, hipFuncAttributeMaxDynamicSharedMemorySize, LDS_BYTES) != hipSuccess) { grid = -1; return; }
        (void)hipGetLastError();
        grid = cus;
    }
    if (grid < 0) return;
    (void)hipMemsetAsync((char*)d_ws + WS_CTL, 0, CTL_ZERO_BYTES, stream);
    Args base{};
    for (int i = 0; i < 38; ++i) base.in[i] = (const float*)d_in[i];
    base.out = (float*)d_out; base.ws = (unsigned char*)d_ws;
    base.eid = nullptr; base.wts = nullptr;
#if defined(MK_PER_PHASE)
    mk_launch(base, PH_PRO, 0, grid, stream);
    for (int l = 0; l < DEPTH; ++l) for (int ph : {PH_IN, PH_HY, PH_HYT, PH_ATT, PH_POOL, PH_OUT, PH_LN1, PH_WCV, PH_MOE1, PH_MOE2, PH_LN2}) mk_launch(base, ph, l, grid, stream);
#else
    Args a = base; a.ph_lo = 0; a.ph_hi = PH_END; a.l_lo = 0; a.l_hi = DEPTH; a.single = 0;
    hipLaunchKernelGGL(mk_fwd, dim3(grid), dim3(NWAVES * 64), LDS_BYTES, stream, a);
#endif
}
```

```cpp
#include <hip/hip_runtime.h>
#include <stdint.h>
#include <math.h>
namespace pg8 {
#define PG8_LAS __attribute__((address_space(3)))
typedef unsigned short bf16_t;
typedef short bf16x8 __attribute__((ext_vector_type(8)));
typedef float f32x4 __attribute__((ext_vector_type(4)));
typedef unsigned u32x4 __attribute__((ext_vector_type(4)));
constexpr int BM = 256, BK = 64, HALF = 128, HTB = HALF * BK * 2  , STAGE_BYTES = 8 * HTB;

__host__ __device__ __forceinline__ int lds_byte(int r, int c) { const int st = (r >> 4) * 2 + (c >> 5), rr = r & 15, cc = c & 31, ob = rr * 64 + cc * 2; return st * 1024 + (ob ^ (((ob >> 9) & 1) << 5)); }
__host__ __device__ __forceinline__ void stage_rc(int b, int& R, int& C) { const int st = b / 1024, sb = b % 1024, swz = sb ^ (((sb >> 9) & 1) << 5); R = (st >> 1) * 16 + swz / 64; C = (st & 1) * 32 + (swz % 64) / 2; }
__host__ __device__ __forceinline__ int perm32(int rho) { const int n = rho >> 4, i = rho & 15; return 8 * (i >> 2) + 4 * n + (i & 3); }

struct Unit { const char* A; const char* B; int kind, pm, pn, aux; };

__device__ __forceinline__ unsigned cvt_pk_bf16(float lo, float hi) { unsigned r; asm volatile("v_cvt_pk_bf16_f32 %0, %1, %2" : "=v"(r) : "v"(lo), "v"(hi)); return r; }

template <class Epi, class Sched, bool GATHER = false>
__device__ __forceinline__ void gemm_phase(PG8_LAS unsigned char* lds, const int K_, const Sched& S, const Epi& E, const int wave_) {
    int K = K_; asm volatile("" : "+s"(K));
    int tid_; asm volatile("v_mbcnt_lo_u32_b32 %0, -1, 0\n\tv_mbcnt_hi_u32_b32 %0, -1, %0" : "=v"(tid_)); tid_ += wave_ * 64;
    const int tid = tid_, wid = __builtin_amdgcn_readfirstlane(tid >> 6), lane = tid & 63, wr = wid >> 2, wc = wid & 3, fr = lane & 15, fq = lane >> 4;
    const int nt = K / BK;
    unsigned voffA[2][2], voffN[2][2] = {{0u, 0u}, {0u, 0u}}, voffB[2]; int RA[2], CA[2];
#pragma unroll
    for (int i = 0; i < 2; ++i) { int R, C; stage_rc(tid * 16 + i * 8192, R, C); const int Rb = Epi::PERM ? ((R & ~31) + perm32(R & 31)) : R; RA[i] = R; CA[i] = C;
        voffA[0][i] = (unsigned)(R * K + C) * 2u; voffA[1][i] = (unsigned)((R + HALF) * K + C) * 2u; voffB[i] = (unsigned)(Rb * K + C) * 2u; }
    const size_t kstep = (size_t)(BK * 2);
    const size_t hstep = (size_t)HALF * K * 2;
    const unsigned ldsw = (unsigned)wid * 1024u;
    const int aoff = lds_byte(wr * 64 + fr, fq * 8), boff = lds_byte(wc * 32 + fr, fq * 8);
#define PG8_SA(b, h) (((b) * 2 + (h)) * HTB)
#define PG8_SB(b, h) ((4 + (b) * 2 + (h)) * HTB)
#define PG8_STAGE(bufoff, gbase, voff) do { _Pragma("unroll") for (int _i = 0; _i < 2; ++_i) \
        __builtin_amdgcn_global_load_lds((const unsigned*)((const char*)(gbase) + (voff)[_i]), (PG8_LAS unsigned*)(lds + (bufoff) + ldsw + _i * 8192), 16, 0, 0); } while (0)
#define PG8_LDA(dst, b, h) do { _Pragma("unroll") for (int m = 0; m < 4; ++m) _Pragma("unroll") for (int k = 0; k < 2; ++k) dst[m][k] = *(const PG8_LAS bf16x8*)(lds + PG8_SA(b, h) + aoff + m * 2048 + k * 1024); } while (0)
#define PG8_LDB(dst, b, h) do { _Pragma("unroll") for (int n = 0; n < 2; ++n) _Pragma("unroll") for (int k = 0; k < 2; ++k) dst[n][k] = *(const PG8_LAS bf16x8*)(lds + PG8_SB(b, h) + boff + n * 2048 + k * 1024); } while (0)
#define PG8_MMA(ai, bj, At, Bt) do { __builtin_amdgcn_s_setprio(1); _Pragma("unroll") for (int m = 0; m < 4; ++m) _Pragma("unroll") for (int n = 0; n < 2; ++n) _Pragma("unroll") for (int k = 0; k < 2; ++k) \
        acc[ai][bj][m][n] = __builtin_amdgcn_mfma_f32_16x16x32_bf16(Bt[n][k], At[m][k], acc[ai][bj][m][n], 0, 0, 0); __builtin_amdgcn_s_setprio(0); } while (0)
#define PG8_WAIT_V(n) asm volatile("s_waitcnt vmcnt(" #n ")" ::: "memory")
#define PG8_WAIT_L(n) asm volatile("s_waitcnt lgkmcnt(" #n ")" ::: "memory")
#define PG8_BAR __builtin_amdgcn_s_barrier()
#define PG8_SCHED __builtin_amdgcn_sched_barrier(0)
    Unit cur, nxt; int ui = 0;
    if (!S.next(0, cur)) return;
    if constexpr (GATHER) {
#pragma unroll
        for (int h = 0; h < 2; ++h)
#pragma unroll
            for (int i = 0; i < 2; ++i) voffA[h][i] = (unsigned)(S.arow(cur, h * HALF + RA[i]) * K + CA[i]) * 2u;
    }
    f32x4 acc[2][2][4][2];
#pragma unroll
    for (int a = 0; a < 2; ++a)
#pragma unroll
        for (int b = 0; b < 2; ++b)
#pragma unroll
            for (int m = 0; m < 4; ++m)
#pragma unroll
                for (int n = 0; n < 2; ++n) acc[a][b][m][n] = (f32x4){0.f, 0.f, 0.f, 0.f};
    bf16x8 At[4][2], B0[2][2], B1[2][2];
    const char* cA = cur.A; const char* cB = cur.B;
    PG8_STAGE(PG8_SB(0, 0), cB, voffB); PG8_STAGE(PG8_SB(0, 1), cB + hstep, voffB); PG8_STAGE(PG8_SA(0, 0), cA, voffA[0]); PG8_STAGE(PG8_SA(0, 1), cA, voffA[1]);
    if (wr == 1) PG8_BAR;
    PG8_WAIT_V(2); PG8_BAR;
    PG8_STAGE(PG8_SB(1, 0), cB + kstep, voffB); PG8_STAGE(PG8_SA(1, 0), cA + kstep, voffA[0]); PG8_STAGE(PG8_SB(1, 1), cB + hstep + kstep, voffB);
    PG8_WAIT_V(6); PG8_BAR;
    for (;;) {
        const bool has_next = S.next(ui + 1, nxt);
        const char* nA = has_next ? nxt.A : cA; const char* nB = has_next ? nxt.B : cB;
        if constexpr (GATHER) {
#pragma unroll
            for (int h = 0; h < 2; ++h)
#pragma unroll
                for (int i = 0; i < 2; ++i) voffN[h][i] = has_next ? (unsigned)(S.arow(nxt, h * HALF + RA[i]) * K + CA[i]) * 2u : voffA[h][i];
        }
#pragma unroll 1
        for (int t = 0; t < nt; t += 2) {
            const bool last = (t == nt - 2);
            const char* a1 = cA + (size_t)(t + 1) * kstep;
            const char* a2 = last ? nA : cA + (size_t)(t + 2) * kstep; const char* b2 = last ? nB : cB + (size_t)(t + 2) * kstep;
            const char* a3 = a2 + kstep; const char* b3 = b2 + kstep;
            PG8_LDB(B0, 0, 0); PG8_LDB(B1, 0, 1); PG8_SCHED; PG8_LDA(At, 0, 0); PG8_STAGE(PG8_SA(1, 1), a1, voffA[1]);
            if constexpr (GATHER) { if (last) {
#pragma unroll
                for (int h = 0; h < 2; ++h)
#pragma unroll
                    for (int i = 0; i < 2; ++i) voffA[h][i] = voffN[h][i]; } }
            PG8_WAIT_V(8); PG8_WAIT_L(0); PG8_BAR; PG8_MMA(0, 0, At, B0); PG8_MMA(0, 1, At, B1); PG8_BAR; PG8_SCHED;
            PG8_LDA(At, 0, 1); PG8_STAGE(PG8_SB(0, 0), b2, voffB); PG8_STAGE(PG8_SB(0, 1), b2 + hstep, voffB); PG8_STAGE(PG8_SA(0, 0), a2, voffA[0]);
            PG8_WAIT_V(8); PG8_WAIT_L(0); PG8_BAR; PG8_MMA(1, 0, At, B0); PG8_MMA(1, 1, At, B1); PG8_BAR; PG8_SCHED;
            PG8_LDB(B0, 1, 0); PG8_LDB(B1, 1, 1); PG8_SCHED; PG8_LDA(At, 1, 0); PG8_STAGE(PG8_SA(0, 1), a2, voffA[1]);
            PG8_WAIT_V(8); PG8_WAIT_L(0); PG8_BAR; PG8_MMA(0, 0, At, B0); PG8_MMA(0, 1, At, B1); PG8_BAR; PG8_SCHED;
            PG8_LDA(At, 1, 1); PG8_STAGE(PG8_SB(1, 0), b3, voffB); PG8_STAGE(PG8_SB(1, 1), b3 + hstep, voffB); PG8_STAGE(PG8_SA(1, 0), a3, voffA[0]);
            PG8_WAIT_V(8); PG8_WAIT_L(0); PG8_BAR; PG8_MMA(1, 0, At, B0); PG8_MMA(1, 1, At, B1); PG8_BAR; PG8_SCHED;
        }
        if (wr == 0) PG8_BAR;
        { Unit ce = cur; ce.pm = __builtin_amdgcn_readfirstlane(cur.pm); ce.pn = __builtin_amdgcn_readfirstlane(cur.pn); ce.kind = __builtin_amdgcn_readfirstlane(cur.kind); ce.aux = __builtin_amdgcn_readfirstlane(cur.aux); int fr_ = fr, fq_ = fq;
          asm volatile("" : "+s"(ce.pm), "+s"(ce.pn), "+s"(ce.kind), "+s"(ce.aux), "+v"(fr_), "+v"(fq_));
          E(acc, ce, wr, wc, fr_, fq_); }
        if (!has_next) break;
#pragma unroll
        for (int a = 0; a < 2; ++a)
#pragma unroll
            for (int b = 0; b < 2; ++b)
#pragma unroll
                for (int m = 0; m < 4; ++m)
#pragma unroll
                    for (int n = 0; n < 2; ++n) acc[a][b][m][n] = (f32x4){0.f, 0.f, 0.f, 0.f};
        cur = nxt; cA = nA; cB = nB; ++ui;
        if (wr == 1) PG8_BAR;
    }
    PG8_WAIT_V(0);
    PG8_BAR;
#undef PG8_SA
#undef PG8_SB
#undef PG8_STAGE
#undef PG8_LDA
#undef PG8_LDB
#undef PG8_MMA
#undef PG8_WAIT_V
#undef PG8_WAIT_L
#undef PG8_BAR
#undef PG8_SCHED
}
}
constexpr int D = 1024, NB = 4, S = 4096, M = NB * S, DEPTH = 4, INW = 2560;
constexpr float DN_ALPHA = 1.681792830507429f;
constexpr float QSCALE = 0.125f * 1.4426950408889634f;
constexpr int NWAVES = 8;
constexpr size_t MiB = 1u << 20;
constexpr size_t TILEB = (size_t)256 * D * 2;
constexpr size_t WS_CTL = 0, CTL_ZERO_BYTES = 1 * MiB;
constexpr size_t WS_CS = 1 * MiB;
constexpr size_t WS_WIN = 2 * MiB, WIN_LAYER = 5 * MiB;
constexpr size_t WS_XB = 22 * MiB;
constexpr size_t WS_QKP = 118 * MiB;
constexpr size_t WS_UVT = 158 * MiB;
constexpr size_t WS_MIXB = 198 * MiB;
constexpr size_t WS_STASH = 54 * MiB;
constexpr size_t WS_WOUT = 383 * MiB, WOUT_LAYER = 2 * MiB;
constexpr size_t WS_TOKIDX = 391 * MiB, WS_GATE = 392 * MiB;
constexpr size_t WS_YMOE = WS_QKP;
constexpr size_t WS_YP = 86 * MiB;
constexpr size_t WS_ACT = 230 * MiB;
constexpr size_t WS_WBUF = 288 * MiB, WBUF_STRIDE = 35 * MiB, WB_W13 = 0, WB_W2 = 16 * MiB, WB_WG = 24 * MiB, WB_WP = 26 * MiB, WB_PB = 27 * MiB;
constexpr size_t WS_KF = 262 * MiB, WS_PS = 278 * MiB, WS_HT = 280 * MiB;
constexpr size_t WS_WR = 256 * MiB;
constexpr int CW_BAR = 4096, CW_CNT = 8192, CNT_STRIDE = 64;

#define GAS __attribute__((address_space(1)))
#define LAS __attribute__((address_space(3)))
typedef unsigned short bf16;
typedef unsigned v4u __attribute__((ext_vector_type(4)));
typedef float f32x4 __attribute__((ext_vector_type(4)));
typedef short bf16x8 __attribute__((ext_vector_type(8)));
typedef GAS unsigned gu32;
typedef GAS unsigned long long gu64;
#define RLX_AGENT __ATOMIC_RELAXED, __HIP_MEMORY_SCOPE_AGENT
#define LDS_WAIT() asm volatile("s_waitcnt lgkmcnt(0)" ::: "memory")
#define VM_WAIT() asm volatile("s_waitcnt vmcnt(0)" ::: "memory")
__device__ __forceinline__ unsigned long long rt() { return __builtin_amdgcn_s_memrealtime(); }
__device__ __forceinline__ unsigned f2bf(float f) { unsigned u = __builtin_bit_cast(unsigned, f); return (u + 0x7fffu + ((u >> 16) & 1u)) >> 16; }
__device__ __forceinline__ unsigned pk2(float lo, float hi) { return f2bf(lo) | (f2bf(hi) << 16); }

#define XB_TMO      128
#define XB_XCNT(j)  (256  + 64 * (j))
#define XB_XSUB(j)  (1280 + 64 * (j))
#define XB_XGEN(j)  (2304 + 64 * (j))
#define XB_TOP      3328
#define XB_TOPGEN   3392
#define XCD_BAR_WORDS 3456
#define XB_SPIN_CAP (1u << 18)

__device__ __forceinline__ unsigned xb_ld(unsigned* p)              { return __hip_atomic_load(p, __ATOMIC_RELAXED, __HIP_MEMORY_SCOPE_AGENT); }
__device__ __forceinline__ unsigned xb_add(unsigned* p, unsigned v) { return __hip_atomic_fetch_add(p, v, __ATOMIC_RELAXED, __HIP_MEMORY_SCOPE_AGENT); }
__device__ __forceinline__ unsigned xb_xcc_id() { return (unsigned)__builtin_amdgcn_s_getreg((3 << 11) | 20) & 0xFu; }
#define XB_SPIN(cond, bar) do { unsigned _sp = 0; while (cond) { __builtin_amdgcn_s_sleep(1); \
    if ((++_sp & 255u) == 0u) { if (xb_ld(&(bar)[XB_TMO])) break; if (_sp > XB_SPIN_CAP) { atomicAdd(&(bar)[XB_TMO], 1u); break; } } } } while (0)

struct XcdBarrier {
    unsigned* bar; unsigned x;
    volatile LAS unsigned* st;
};

__device__ __forceinline__ unsigned mk_lane_id() { unsigned x; asm volatile("v_mbcnt_lo_u32_b32 %0, -1, 0\n\tv_mbcnt_hi_u32_b32 %0, -1, %0" : "=v"(x)); return x; }
__device__ __forceinline__ XcdBarrier xcd_barrier_post(unsigned* bar, volatile LAS unsigned* st, int wave) {
    XcdBarrier b; b.bar = bar; b.x = xb_xcc_id(); b.st = st;
    if (wave == 0 && mk_lane_id() == 0u) (void)xb_add(&bar[XB_XCNT(b.x)], 1u);
    return b;
}
__device__ __forceinline__ void xcd_barrier_complete(unsigned* bar, unsigned x, unsigned& nloc, unsigned& nx) {
    const unsigned G = gridDim.x * gridDim.y * gridDim.z;
    unsigned sum, cnt, mine, sp = 0u;
    for (;;) {
        sum = 0u; cnt = 0u; mine = 0u;
#pragma unroll
        for (unsigned j = 0; j < 16; ++j) { const unsigned c = xb_ld(&bar[XB_XCNT(j)]); sum += c; cnt += (c > 0u) ? 1u : 0u; mine = (j == x) ? c : mine; }
        if (sum == G) break;
        __builtin_amdgcn_s_sleep(1);
        if ((++sp & 255u) == 0u) { if (xb_ld(&bar[XB_TMO])) break; if (sp > XB_SPIN_CAP) { atomicAdd(&bar[XB_TMO], 1u); break; } }
    }
    nloc = mine > 0u ? mine : 1u; nx = cnt > 0u ? cnt : 1u;
}

__device__ __forceinline__ void xcd_barrier(const XcdBarrier& b, int wave) {
    asm volatile("" : "+s"(wave));
    const bool t0_ = (wave == 0) && (mk_lane_id() == 0u);
    asm volatile("s_waitcnt vmcnt(0)" ::: "memory");
    __syncthreads();
    if (t0_) {
        unsigned* bar = b.bar; unsigned bx_ = b.x; asm volatile("" : "+s"(bx_));
        __builtin_amdgcn_s_waitcnt(0);
        unsigned nloc = b.st[0], nx = b.st[1];
        if (nloc == 0u) { xcd_barrier_complete(bar, bx_, nloc, nx); b.st[0] = nloc; b.st[1] = nx; }
        const unsigned old = xb_add(&bar[XB_XSUB(bx_)], 1u);
        const unsigned gen = old / nloc;
        if (old + 1u == (gen + 1u) * nloc) {
            __builtin_amdgcn_fence(__ATOMIC_RELEASE, "agent");
            asm volatile("s_waitcnt vmcnt(0)" ::: "memory");
            const unsigned og = xb_add(&bar[XB_TOP], 1u);
            const unsigned tg = og / nx;
            if (og + 1u == (tg + 1u) * nx) xb_add(&bar[XB_TOPGEN], 1u);
            else XB_SPIN(xb_ld(&bar[XB_TOPGEN]) == tg, bar);
            __builtin_amdgcn_fence(__ATOMIC_ACQUIRE, "agent");
            xb_add(&bar[XB_XGEN(bx_)], 1u);
            asm volatile("s_waitcnt vmcnt(0)" ::: "memory");
        } else {
            XB_SPIN(xb_ld(&bar[XB_XGEN(bx_)]) == gen, bar);
            __builtin_amdgcn_fence(__ATOMIC_ACQUIRE, "agent");
            asm volatile("s_waitcnt vmcnt(0)" ::: "memory");
        }
    }
    __syncthreads();
}
__device__ __forceinline__ float bf2f(unsigned short b) { return __uint_as_float((unsigned)b << 16); }
#define MK_DPP(v, ctrl) __uint_as_float(__builtin_amdgcn_update_dpp(0, __float_as_uint(v), (ctrl), 0xF, 0xF, true))
__device__ __forceinline__ float xsum16(float v) { const auto r = __builtin_amdgcn_permlane16_swap(__float_as_uint(v), __float_as_uint(v), false, false); return __uint_as_float(r[0]) + __uint_as_float(r[1]); }
__device__ __forceinline__ float xsum32(float v) { const auto r = __builtin_amdgcn_permlane32_swap(__float_as_uint(v), __float_as_uint(v), false, false); return __uint_as_float(r[0]) + __uint_as_float(r[1]); }
__device__ __forceinline__ float wave_sum(float v) {
    v += MK_DPP(v, 0xB1); v += MK_DPP(v, 0x4E);
    v += MK_DPP(v, 0x141); v += MK_DPP(v, 0x140);
    return xsum32(xsum16(v));
}
__device__ __forceinline__ void p0_transpose_block(const float* W, int K, int N, int k0, int n0, bf16* WT, int mode, LAS float* scr, int lane) {
#pragma unroll 4
    for (int i = 0; i < 32; ++i) { const int kk = 2 * i + (lane >> 5); scr[kk * 33 + (lane & 31)] = W[(size_t)(k0 + kk) * N + n0 + (lane & 31)]; }
    LDS_WAIT(); asm volatile("" ::: "memory");
    const int c = lane & 7;
#pragma unroll 1
    for (int j = 0; j < 4; ++j) { const int n = (lane >> 3) + 8 * j; const LAS float* s = scr + (8 * c) * 33 + n;
        v4u o; o.x = pk2(s[0 * 33], s[1 * 33]); o.y = pk2(s[2 * 33], s[3 * 33]); o.z = pk2(s[4 * 33], s[5 * 33]); o.w = pk2(s[6 * 33], s[7 * 33]);
        const int f = n0 + n; const size_t drow = mode == 0 ? (size_t)n : (size_t)(8 * (f >> 2) + (f & 3) + (mode == 2 ? 4 : 0));
        *(GAS v4u*)(WT + drow * K + k0 + 8 * c) = o; }
    LDS_WAIT(); asm volatile("" ::: "memory");
}
template <class TX> __device__ __forceinline__ void ln_row(const TX* x0, float a, const bf16* y1, const bf16* y2, const bf16* y3, const float* g, const float* b, float* of, bf16* ob, int lane) {
    f32x4 v[4]; float s = 0.f;
#pragma unroll
    for (int j = 0; j < 4; ++j) { const int c = 4 * lane + 256 * j;
        if constexpr (sizeof(TX) == 4) v[j] = *(const GAS f32x4*)(x0 + c) * a;
        else { const unsigned long long w = *(const GAS unsigned long long*)(x0 + c); v[j] = (f32x4){bf2f((bf16)w), bf2f((bf16)(w >> 16)), bf2f((bf16)(w >> 32)), bf2f((bf16)(w >> 48))} * a; }
        if (y1) { const unsigned long long w = *(const GAS unsigned long long*)(y1 + c); v[j] += (f32x4){bf2f((bf16)w), bf2f((bf16)(w >> 16)), bf2f((bf16)(w >> 32)), bf2f((bf16)(w >> 48))}; }
        if (y2) { const unsigned long long w = *(const GAS unsigned long long*)(y2 + c); v[j] += (f32x4){bf2f((bf16)w), bf2f((bf16)(w >> 16)), bf2f((bf16)(w >> 32)), bf2f((bf16)(w >> 48))}; }
        if (y3) { const unsigned long long w = *(const GAS unsigned long long*)(y3 + c); v[j] += (f32x4){bf2f((bf16)w), bf2f((bf16)(w >> 16)), bf2f((bf16)(w >> 32)), bf2f((bf16)(w >> 48))}; }
        s += (v[j].x + v[j].y) + (v[j].z + v[j].w); }
    const float mean = wave_sum(s) * (1.f / D); float s2 = 0.f;
#pragma unroll
    for (int j = 0; j < 4; ++j) { v[j] = v[j] - mean; s2 += (v[j].x * v[j].x + v[j].y * v[j].y) + (v[j].z * v[j].z + v[j].w * v[j].w); }
    const float rstd = 1.f / sqrtf(wave_sum(s2) * (1.f / D) + 1e-5f);
#pragma unroll
    for (int j = 0; j < 4; ++j) { const int c = 4 * lane + 256 * j; const f32x4 o = v[j] * rstd * *(const GAS f32x4*)(g + c) + *(const GAS f32x4*)(b + c);
        if (of) *(GAS f32x4*)(of + c) = o;
        if (ob) *(GAS unsigned long long*)(ob + c) = (unsigned long long)pk2(o.x, o.y) | ((unsigned long long)pk2(o.z, o.w) << 32); }
}

struct SchedIn {
    int vcu, G; const char* xb; const char* wsw; const char* wnm;
    __device__ __forceinline__ bool next(int i, pg8::Unit& u) const {
        const int L = i * G + vcu; if (L >= 640) return false;
        const int t = L / 10, j = L % 10;
        const int sw = __builtin_amdgcn_readfirstlane((unsigned)(j + 27) >> 5);
        const int jj = j - 5 * sw; const char* tp = xb + (size_t)t * TILEB; const char* wp = (sw ? wsw : wnm) + (size_t)jj * TILEB;
        u.kind = sw; u.pm = sw ? jj : t; u.pn = sw ? t : jj; u.A = sw ? wp : tp; u.B = sw ? tp : wp;
        u.aux = 0; return true;
    }
};
struct EpiIn {
    static constexpr bool PERM = true;
    bf16* qkp; bf16* uvt; const float* cs;
    __device__ __forceinline__ void operator()(const pg8::f32x4 (&acc)[2][2][4][2], const pg8::Unit& u, int wr, int wc, int fr, int fq) const {
        bf16* base = u.kind == 0 ? qkp : uvt; const int ldc = u.kind == 0 ? 1280 : M;
        const int row0 = u.pm * 256 + wr * 64 + fr, col0 = u.pn * 256 + wc * 32 + 8 * fq;
        const bool rope = (u.kind == 0) && (u.pn < 4) && ((wc & 1) == 0);
        const float sc = (u.kind == 0 && u.pn < 2) ? QSCALE : 1.f;
        const float sgn = fq == 0 ? -1.f : 1.f;
        const bool vperm = (u.kind == 1) && (u.pm >= 3);
#pragma unroll
        for (int ai = 0; ai < 2; ++ai)
#pragma unroll
            for (int m = 0; m < 4; ++m) { const int row = row0 + ai * 128 + m * 16; bf16* rowp = base + (size_t)row * ldc + col0;
                f32x4 cv0 = {1.f, 1.f, 1.f, 1.f}, cv1 = cv0, sv0 = {0.f, 0.f, 0.f, 0.f}, sv1 = sv0;
                if (rope && fq < 2) { const float* t = cs + (size_t)(row & (S - 1)) * 16; cv0 = *(const f32x4*)t; cv1 = *(const f32x4*)(t + 4); sv0 = *(const f32x4*)(t + 8) * sgn; sv1 = *(const f32x4*)(t + 12) * sgn; }
#pragma unroll
                for (int bj = 0; bj < 2; ++bj) { f32x4 v0 = acc[ai][bj][m][0], v1 = acc[ai][bj][m][1];
                    if (rope) { f32x4 p0, p1;
#pragma unroll
                        for (int e = 0; e < 4; ++e) { const auto r0 = __builtin_amdgcn_permlane16_swap(__float_as_uint(v0[e]), __float_as_uint(v0[e]), false, false), r1 = __builtin_amdgcn_permlane16_swap(__float_as_uint(v1[e]), __float_as_uint(v1[e]), false, false);
                            p0[e] = __uint_as_float((fq & 1) ? r0[0] : r0[1]); p1[e] = __uint_as_float((fq & 1) ? r1[0] : r1[1]); }
                        v0 = v0 * cv0 + p0 * sv0; v1 = v1 * cv1 + p1 * sv1; }
                    v0 = v0 * sc; v1 = v1 * sc;
                    pg8::u32x4 w; w.x = pg8::cvt_pk_bf16(v0[0], v0[1]); w.y = pg8::cvt_pk_bf16(v0[2], v0[3]); w.z = pg8::cvt_pk_bf16(v1[0], v1[1]); w.w = pg8::cvt_pk_bf16(v1[2], v1[3]);
                    if (vperm) {
                        bf16* gp = rowp + bj * 128 - (fq & 1) * 8;
                        typedef unsigned u32x2 __attribute__((ext_vector_type(2)));
                        *(u32x2*)(gp + ((fq & 1) ? 4 : 0)) = (u32x2){w.x, w.y}; *(u32x2*)(gp + ((fq & 1) ? 12 : 8)) = (u32x2){w.z, w.w};
                    } else *(pg8::u32x4*)(rowp + bj * 128) = w; } }
    }
};

struct SchedOut {
    int vcu, G; const char* a; const char* w;
    __device__ __forceinline__ bool next(int i, pg8::Unit& u) const {
        const int L = i * G + vcu; if (L >= 256) return false;
        u.kind = 0; u.pm = L >> 2; u.pn = L & 3; u.aux = 0; u.A = a + (size_t)u.pm * TILEB; u.B = w + (size_t)u.pn * TILEB; return true;
    }
};
struct EpiRes {
    static constexpr bool PERM = true;
    bf16* XB;
    __device__ __forceinline__ void operator()(const pg8::f32x4 (&acc)[2][2][4][2], const pg8::Unit& u, int wr, int wc, int fr, int fq) const {
        const int row0 = u.pm * 256 + wr * 64 + fr, col0 = u.pn * 256 + wc * 32 + 8 * fq;
#pragma unroll
        for (int ai = 0; ai < 2; ++ai)
#pragma unroll
            for (int m = 0; m < 4; ++m) { bf16* rowp = XB + (size_t)(row0 + ai * 128 + m * 16) * D + col0;
#pragma unroll
                for (int bj = 0; bj < 2; ++bj) { pg8::u32x4* p = (pg8::u32x4*)(rowp + bj * 128); const pg8::u32x4 x = *p; const pg8::f32x4 v0 = acc[ai][bj][m][0], v1 = acc[ai][bj][m][1];
                    pg8::u32x4 w; w.x = pg8::cvt_pk_bf16(bf2f((bf16)x.x) * DN_ALPHA + v0[0], bf2f((bf16)(x.x >> 16)) * DN_ALPHA + v0[1]); w.y = pg8::cvt_pk_bf16(bf2f((bf16)x.y) * DN_ALPHA + v0[2], bf2f((bf16)(x.y >> 16)) * DN_ALPHA + v0[3]);
                    w.z = pg8::cvt_pk_bf16(bf2f((bf16)x.z) * DN_ALPHA + v1[0], bf2f((bf16)(x.z >> 16)) * DN_ALPHA + v1[1]); w.w = pg8::cvt_pk_bf16(bf2f((bf16)x.w) * DN_ALPHA + v1[2], bf2f((bf16)(x.w >> 16)) * DN_ALPHA + v1[3]);
                    *p = w; } }
    }
};
struct RouteLds { unsigned lcnt[16]; unsigned gbase[16]; int e0[64], e1[64]; unsigned r0[64], r1[64]; float g0[64], g1[64]; };
constexpr int RT_PITCH = 2052;
__device__ __forceinline__ void ln1_router_chunk(LAS RouteLds* R, LAS unsigned char* tile, int row0, bf16* XB, const float* g, const float* b, const float* wgc, const float* bgc, const float* wgf, const float* bgf,
                                                 gu32* cnt, int* tokidx, float* gate, int wave, int lane) {
    const int tidl = wave * 64 + lane;
    if (tidl < 16) R->lcnt[tidl] = 0u;
#pragma unroll 2
    for (int r = 0; r < 8; ++r) { const int rl = wave * 8 + r; bf16* xbrow = XB + (size_t)(row0 + rl) * D; f32x4 v[4]; float s = 0.f;
#pragma unroll
        for (int j = 0; j < 4; ++j) { const unsigned long long w = *(const GAS unsigned long long*)(xbrow + 4 * lane + 256 * j);
            v[j] = (f32x4){bf2f((bf16)w), bf2f((bf16)(w >> 16)), bf2f((bf16)(w >> 32)), bf2f((bf16)(w >> 48))}; s += (v[j].x + v[j].y) + (v[j].z + v[j].w); }
        const float mean = wave_sum(s) * (1.f / D); float s2 = 0.f;
#pragma unroll
        for (int j = 0; j < 4; ++j) { v[j] = v[j] - mean; s2 += (v[j].x * v[j].x + v[j].y * v[j].y) + (v[j].z * v[j].z + v[j].w * v[j].w); }
        const float rstd = 1.f / sqrtf(wave_sum(s2) * (1.f / D) + 1e-5f);
#pragma unroll
        for (int j = 0; j < 4; ++j) { const int c = 4 * lane + 256 * j; const f32x4 o = v[j] * rstd * *(const GAS f32x4*)(g + c) + *(const GAS f32x4*)(b + c);
            const unsigned w0 = pk2(o.x, o.y), w1 = pk2(o.z, o.w);
            *(GAS unsigned long long*)(xbrow + c) = (unsigned long long)w0 | ((unsigned long long)w1 << 32);
            LAS unsigned* tp = (LAS unsigned*)(tile + rl * RT_PITCH + c * 2); tp[0] = w0; tp[1] = w1; } }
    LDS_WAIT(); __syncthreads();
    float acc[20];
#pragma unroll
    for (int i = 0; i < 20; ++i) acc[i] = 0.f;
    { LAS const unsigned* xr = (LAS const unsigned*)(tile + lane * RT_PITCH) + wave * 64;
      const float* wc = wgc + (size_t)wave * 128 * 4; const float* wf = wgf + (size_t)wave * 128 * 16;
#pragma unroll 2
      for (int kk = 0; kk < 64; ++kk) { const unsigned w = xr[kk]; const float x0 = __uint_as_float(w << 16), x1 = __uint_as_float(w & 0xffff0000u);
#pragma unroll
          for (int i = 0; i < 4; ++i) acc[i] += x0 * wc[(2 * kk) * 4 + i] + x1 * wc[(2 * kk + 1) * 4 + i];
#pragma unroll
          for (int i = 0; i < 16; ++i) acc[4 + i] += x0 * wf[(2 * kk) * 16 + i] + x1 * wf[(2 * kk + 1) * 16 + i]; } }
    LDS_WAIT(); __syncthreads();
    { LAS float* P = (LAS float*)tile + wave * (20 * 64) + lane;
#pragma unroll
      for (int i = 0; i < 20; ++i) P[i * 64] = acc[i]; }
    LDS_WAIT(); __syncthreads();
    if (wave == 0) {
        float my[20];
#pragma unroll
        for (int i = 0; i < 20; ++i) { float t = 0.f;
#pragma unroll
            for (int w = 0; w < 8; ++w) t += ((LAS const float*)tile)[w * (20 * 64) + i * 64 + lane];
            my[i] = t; }
        const int rl = lane;
        float pg[4], mx = -INFINITY, sum = 0.f;
#pragma unroll
        for (int j = 0; j < 4; ++j) { pg[j] = my[j] + bgc[j]; mx = fmaxf(mx, pg[j]); }
#pragma unroll
        for (int j = 0; j < 4; ++j) { pg[j] = expf(pg[j] - mx); sum += pg[j]; }
        int gi = 0; float gw = pg[0];
#pragma unroll
        for (int j = 1; j < 4; ++j) if (pg[j] > gw) { gw = pg[j]; gi = j; }
        gw /= sum;
        float fs[4]; mx = -INFINITY;
#pragma unroll
        for (int j = 0; j < 4; ++j) { float t = 0.f;
#pragma unroll
            for (int q = 0; q < 4; ++q) if (q == gi) t = my[4 + q * 4 + j] + bgf[q * 4 + j];
            fs[j] = t; mx = fmaxf(mx, t); }
#pragma unroll
        for (int j = 0; j < 4; ++j) fs[j] = expf(fs[j] - mx);
        int t0 = 0; float v0 = fs[0];
#pragma unroll
        for (int j = 1; j < 4; ++j) if (fs[j] > v0) { v0 = fs[j]; t0 = j; }
        int t1 = -1; float v1 = -1.f;
#pragma unroll
        for (int j = 0; j < 4; ++j) if (j != t0 && fs[j] > v1) { v1 = fs[j]; t1 = j; }
        const float ts = v0 + v1; const int e0 = gi * 4 + t0, e1 = gi * 4 + t1;
        R->e0[rl] = e0; R->e1[rl] = e1; R->g0[rl] = gw * (v0 / ts); R->g1[rl] = gw * (v1 / ts);
        R->r0[rl] = __hip_atomic_fetch_add(&R->lcnt[e0], 1u, __ATOMIC_RELAXED, __HIP_MEMORY_SCOPE_WORKGROUP);
        R->r1[rl] = __hip_atomic_fetch_add(&R->lcnt[e1], 1u, __ATOMIC_RELAXED, __HIP_MEMORY_SCOPE_WORKGROUP);
    }
    LDS_WAIT(); __syncthreads();
    if (tidl < 16) { const unsigned n = R->lcnt[tidl]; R->gbase[tidl] = n ? __hip_atomic_fetch_add(cnt + tidl * CNT_STRIDE, n, RLX_AGENT) : 0u; }
    LDS_WAIT(); __syncthreads();
    if (tidl < 64) { const int rl = tidl, tok = row0 + rl; const int e0 = R->e0[rl], e1 = R->e1[rl]; const unsigned p0 = R->gbase[e0] + R->r0[rl], p1 = R->gbase[e1] + R->r1[rl];
        tokidx[(size_t)e0 * M + p0] = tok * 2; gate[(size_t)e0 * M + p0] = R->g0[rl]; tokidx[(size_t)e1 * M + p1] = tok * 2 + 1; gate[(size_t)e1 * M + p1] = R->g1[rl]; }
    LDS_WAIT(); __syncthreads();
}

struct MoeTab { LAS const int* p;
    __device__ __forceinline__ int cnt(int e) const { return __builtin_amdgcn_readfirstlane(p[e]); }
    __device__ __forceinline__ int pre(int e) const { return __builtin_amdgcn_readfirstlane(p[16 + e]); } };
__device__ __forceinline__ void moe_tab_build(LAS int* p, const gu32* cnt, bool t0) {
    if (t0) { int acc = 0;
        for (int e = 0; e < 16; ++e) { const int c = (int)__hip_atomic_load(cnt + e * CNT_STRIDE, RLX_AGENT); p[e] = c; p[16 + e] = acc; acc += (c + 255) >> 8; }
        p[32] = acc; }
    __syncthreads();
}
template <int NPN> struct SchedMoe {
    int vcu, G; MoeTab T; const char* a; const char* w; size_t wexp  ; const int* tokidx; size_t atile  ;
    __device__ __forceinline__ bool next(int i, pg8::Unit& u) const {
        const int L = i * G + vcu; if (L >= T.pre(16) * NPN) return false;
        const int tile = L / NPN; u.pn = L % NPN; int e = 0;
#pragma unroll 1
        for (int q = 1; q < 16; ++q) if (tile >= T.pre(q)) e = q;
        u.aux = e; u.pm = tile - T.pre(e); u.kind = tile;
        u.A = a + (size_t)tile * atile; u.B = w + (size_t)e * wexp + (size_t)u.pn * 256 * (wexp / (NPN * 256)); return true;
    }
    __device__ __forceinline__ int arow(const pg8::Unit& u, int r) const {
        const int rank = u.pm * 256 + r; const int c = T.cnt(u.aux);
        return rank < c ? (tokidx[(size_t)u.aux * M + rank] >> 1) : 0;
    }
};
struct EpiMoe1 {
    static constexpr bool PERM = true;
    bf16* act; const float* gate; MoeTab T;
    __device__ __forceinline__ void operator()(const pg8::f32x4 (&acc)[2][2][4][2], const pg8::Unit& u, int wr, int wc, int fr, int fq) const {
        const int cnt = T.cnt(u.aux);
#pragma unroll
        for (int ai = 0; ai < 2; ++ai)
#pragma unroll
            for (int m = 0; m < 4; ++m) { const int r = ai * 128 + wr * 64 + m * 16 + fr, rank = u.pm * 256 + r;
                const float gt = rank < cnt ? gate[(size_t)u.aux * M + rank] : 0.f;
                bf16* rowp = act + ((size_t)u.kind * 256 + r) * 256 + u.pn * 128 + wc * 16 + 4 * fq;
#pragma unroll
                for (int bj = 0; bj < 2; ++bj) { const pg8::f32x4 av = acc[ai][bj][m][0], cv = acc[ai][bj][m][1]; float y[4];
#pragma unroll
                    for (int e = 0; e < 4; ++e) y[e] = av[e] / (1.f + __expf(-av[e])) * cv[e] * gt;
                    *(unsigned long long*)(rowp + bj * 64) = (unsigned long long)pg8::cvt_pk_bf16(y[0], y[1]) | ((unsigned long long)pg8::cvt_pk_bf16(y[2], y[3]) << 32); } }
    }
};
struct EpiMoe2 {
    static constexpr bool PERM = true;
    bf16* ymoe; const int* tokidx; MoeTab T;
    __device__ __forceinline__ void operator()(const pg8::f32x4 (&acc)[2][2][4][2], const pg8::Unit& u, int wr, int wc, int fr, int fq) const {
        const int cnt = T.cnt(u.aux);
#pragma unroll
        for (int ai = 0; ai < 2; ++ai)
#pragma unroll
            for (int m = 0; m < 4; ++m) { const int r = ai * 128 + wr * 64 + m * 16 + fr, rank = u.pm * 256 + r;
                if (rank < cnt) { bf16* rowp = ymoe + (size_t)tokidx[(size_t)u.aux * M + rank] * D + u.pn * 256 + wc * 32 + 8 * fq;
#pragma unroll
                    for (int bj = 0; bj < 2; ++bj) { const pg8::f32x4 v0 = acc[ai][bj][m][0], v1 = acc[ai][bj][m][1];
                        pg8::u32x4 w; w.x = pg8::cvt_pk_bf16(v0[0], v0[1]); w.y = pg8::cvt_pk_bf16(v0[2], v0[3]); w.z = pg8::cvt_pk_bf16(v1[0], v1[1]); w.w = pg8::cvt_pk_bf16(v1[2], v1[3]);
                        *(pg8::u32x4*)(rowp + bj * 128) = w; } } }
    }
};
struct SchedSq {
    int vcu, G; const char* a; const char* w; size_t astep, wstep;
    __device__ __forceinline__ bool next(int i, pg8::Unit& u) const {
        const int L = i * G + vcu; if (L >= 256) return false;
        u.kind = 0; u.pm = L >> 2; u.pn = L & 3; u.aux = 0; u.A = a + (size_t)u.pm * astep; u.B = w + (size_t)u.pn * wstep; return true;
    }
};
template <int GATED> struct EpiPle {
    static constexpr bool PERM = true;
    bf16* yp; const float* bg;
    __device__ __forceinline__ void operator()(const pg8::f32x4 (&acc)[2][2][4][2], const pg8::Unit& u, int wr, int wc, int fr, int fq) const {
        const int row0 = u.pm * 256 + wr * 64 + fr, col0 = u.pn * 256 + wc * 32 + 8 * fq;
#pragma unroll
        for (int ai = 0; ai < 2; ++ai)
#pragma unroll
            for (int m = 0; m < 4; ++m) { bf16* rowp = yp + (size_t)(row0 + ai * 128 + m * 16) * D + col0;
#pragma unroll
                for (int bj = 0; bj < 2; ++bj) { pg8::f32x4 v0 = acc[ai][bj][m][0], v1 = acc[ai][bj][m][1];
                    if (GATED) { const pg8::f32x4 b0 = *(const pg8::f32x4*)(bg + col0 + bj * 128), b1 = *(const pg8::f32x4*)(bg + col0 + bj * 128 + 4); const pg8::u32x4 y = *(const pg8::u32x4*)(rowp + bj * 128);
                        const float yf[8] = {bf2f((bf16)y.x), bf2f((bf16)(y.x >> 16)), bf2f((bf16)y.y), bf2f((bf16)(y.y >> 16)), bf2f((bf16)y.z), bf2f((bf16)(y.z >> 16)), bf2f((bf16)y.w), bf2f((bf16)(y.w >> 16))};
#pragma unroll
                        for (int e = 0; e < 4; ++e) { v0[e] = yf[e] / (1.f + __expf(-(v0[e] + b0[e]))); v1[e] = yf[4 + e] / (1.f + __expf(-(v1[e] + b1[e]))); } }
                    pg8::u32x4 w; w.x = pg8::cvt_pk_bf16(v0[0], v0[1]); w.y = pg8::cvt_pk_bf16(v0[2], v0[3]); w.z = pg8::cvt_pk_bf16(v1[0], v1[1]); w.w = pg8::cvt_pk_bf16(v1[2], v1[3]);
                    *(pg8::u32x4*)(rowp + bj * 128) = w; } }
    }
};
namespace att {
typedef float f32x16 __attribute__((ext_vector_type(16)));
constexpr int KSLOT = 8192, VSLOT = 16384, LDS_K = 0, LDS_V = 2 * KSLOT, ATT_LDS = 2 * KSLOT + 2 * VSLOT;
__device__ __forceinline__ bf16x8 pack8(const f32x16& p, int b) {
    v4u w; w.x = pg8::cvt_pk_bf16(p[b], p[b + 1]); w.y = pg8::cvt_pk_bf16(p[b + 2], p[b + 3]); w.z = pg8::cvt_pk_bf16(p[b + 4], p[b + 5]); w.w = pg8::cvt_pk_bf16(p[b + 6], p[b + 7]);
    return __builtin_bit_cast(bf16x8, w);
}
constexpr float THR2 = 8.f;
__device__ __forceinline__ void qkt(f32x16& p0, f32x16& p1, LAS const unsigned char* ks, const bf16x8 (&qf)[4], int r32, int hi) {
#pragma unroll
    for (int r = 0; r < 16; ++r) { p0[r] = 0.f; p1[r] = 0.f; }
    LAS const unsigned char* kb = ks + hi * 1024 + r32 * 16;
#pragma unroll
    for (int kk = 0; kk < 4; ++kk) {
        const bf16x8 a0 = *(LAS const bf16x8*)(kb + kk * 2048), a1 = *(LAS const bf16x8*)(kb + kk * 2048 + 512);
        p0 = __builtin_amdgcn_mfma_f32_32x32x16_bf16(a0, qf[kk], p0, 0, 0, 0);
        p1 = __builtin_amdgcn_mfma_f32_32x32x16_bf16(a1, qf[kk], p1, 0, 0, 0);
    }
}
__device__ __forceinline__ void partialSM(f32x16& p0, f32x16& p1, float& m, float& alpha) {
    float pmax = fmaxf(p0[0], p1[0]);
#pragma unroll
    for (int r = 1; r < 16; ++r) pmax = fmaxf(pmax, fmaxf(p0[r], p1[r]));
    { const auto rr = __builtin_amdgcn_permlane32_swap(__float_as_uint(pmax), __float_as_uint(pmax), false, false); pmax = fmaxf(__uint_as_float(rr[0]), __uint_as_float(rr[1])); }
    if (__builtin_expect(__all(pmax - m <= THR2), 1)) alpha = 1.f;
    else { const float mn = fmaxf(m, pmax); alpha = __builtin_amdgcn_exp2f(m - mn); m = mn; }
    const float mm = m;
#pragma unroll
    for (int r = 0; r < 16; ++r) { p0[r] = __builtin_amdgcn_exp2f(p0[r] - mm); p1[r] -= mm; }
}
__device__ __forceinline__ void finishSM(f32x16& p0, f32x16& p1, float alpha, float& l, bf16x8 (&pf)[4]) {
    float ps = 0.f;
#pragma unroll
    for (int r = 0; r < 16; ++r) { p1[r] = __builtin_amdgcn_exp2f(p1[r]); ps += p0[r] + p1[r]; }
    l = l * alpha + ps;
    pf[0] = pack8(p0, 0); pf[1] = pack8(p0, 8); pf[2] = pack8(p1, 0); pf[3] = pack8(p1, 8);
}
__device__ __forceinline__ void pv(f32x16 (&o)[4], LAS const unsigned char* vs, const bf16x8 (&pf)[4], int r32, int hi) {
    LAS const unsigned char* vb = vs + hi * 2048 + r32 * 16;
#pragma unroll
    for (int db = 0; db < 4; ++db) {
        bf16x8 va[4];
#pragma unroll
        for (int s = 0; s < 4; ++s) va[s] = *(LAS const bf16x8*)(vb + s * 4096 + db * 512);
#pragma unroll
        for (int s = 0; s < 4; ++s) o[db] = __builtin_amdgcn_mfma_f32_32x32x16_bf16(va[s], pf[s], o[db], 0, 0, 0);
        __builtin_amdgcn_sched_group_barrier(0x100, 4, 0); __builtin_amdgcn_sched_group_barrier(0x8, 4, 0);
    }
}
__device__ __forceinline__ void resc(f32x16 (&o)[4], float alpha) {
    if (__any(alpha < 1.f)) {
#pragma unroll
        for (int db = 0; db < 4; ++db)
#pragma unroll
            for (int r = 0; r < 16; ++r) o[db][r] *= alpha;
    }
}
__device__ __forceinline__ void unit(LAS unsigned char* lds, int b, int h, int qb, const bf16* QKP, const bf16* UVT, float lam, float lam_init, const float* subg, bf16* MIXB, float* stash, int wave, int lane) {
    asm volatile("" : "+v"(lane));
    const int r32 = lane & 31, hi = lane >> 5;
    const size_t tok0 = (size_t)b * S;
    const size_t qtok = tok0 + qb * 256 + wave * 32 + r32;
    constexpr int NT = S / 64;
#pragma unroll 1
    for (int c = 0; c < 2; ++c) {
        bf16x8 qf[4];
#pragma unroll
        for (int kk = 0; kk < 4; ++kk) qf[kk] = *(const GAS bf16x8*)(QKP + qtok * 1280 + h * 128 + c * 64 + kk * 16 + hi * 8);
        f32x16 o[4];
#pragma unroll
        for (int db = 0; db < 4; ++db)
#pragma unroll
            for (int r = 0; r < 16; ++r) o[db][r] = 0.f;
        float m = -INFINITY, l = 0.f, alA, alB;
        f32x16 pA0, pA1, pB0, pB1; bf16x8 pf[4];
        const char* kub = (const char*)(QKP + tok0 * 1280 + 512 + h * 128 + c * 64 + wave * 8);
        const char* vub = (const char*)(UVT + (size_t)(768 + h * 128) * M + tok0 + wave * 8);
        const unsigned kvo = (unsigned)lane * 2560u, vvo = (unsigned)lane * (unsigned)(M * 2);
#define ATT_DMA_K(t) __builtin_amdgcn_global_load_lds((const unsigned*)(kub + (size_t)(t) * (64 * 2560) + kvo), (LAS unsigned*)(lds + LDS_K + ((t) & 1) * KSLOT + wave * 1024), 16, 0, 0)
#define ATT_DMA_V(t) do { \
            __builtin_amdgcn_global_load_lds((const unsigned*)(vub + (size_t)(t) * 128 + vvo), (LAS unsigned*)(lds + LDS_V + ((t) & 1) * VSLOT + wave * 2048), 16, 0, 0); \
            __builtin_amdgcn_global_load_lds((const unsigned*)(vub + (size_t)64 * M * 2 + (size_t)(t) * 128 + vvo), (LAS unsigned*)(lds + LDS_V + ((t) & 1) * VSLOT + wave * 2048 + 1024), 16, 0, 0); } while (0)
#define SB() __builtin_amdgcn_sched_barrier(0)
#define ATT_SYNC() do { asm volatile("s_waitcnt vmcnt(0) lgkmcnt(0)" ::: "memory"); __builtin_amdgcn_s_barrier(); asm volatile("" ::: "memory"); } while (0)
        const bool early = wave < 4;
        ATT_SYNC();
        ATT_DMA_K(0); ATT_DMA_V(0);
        ATT_SYNC();
        ATT_DMA_K(1);
        qkt(pA0, pA1, lds + LDS_K, qf, r32, hi); partialSM(pA0, pA1, m, alA);
#pragma unroll 1
        for (int j = 1; j < NT - 1; j += 2) {
            ATT_SYNC(); if (early) { ATT_DMA_K(j + 1); ATT_DMA_V(j); }
            SB(); qkt(pB0, pB1, lds + LDS_K + KSLOT, qf, r32, hi); finishSM(pA0, pA1, alA, l, pf); SB();
            if (!early) { ATT_DMA_K(j + 1); ATT_DMA_V(j); }
            pv(o, lds + LDS_V, pf, r32, hi); partialSM(pB0, pB1, m, alB); SB(); resc(o, alB);
            ATT_SYNC(); if (early) { ATT_DMA_K(j + 2); ATT_DMA_V(j + 1); }
            SB(); qkt(pA0, pA1, lds + LDS_K, qf, r32, hi); finishSM(pB0, pB1, alB, l, pf); SB();
            if (!early) { ATT_DMA_K(j + 2); ATT_DMA_V(j + 1); }
            pv(o, lds + LDS_V + VSLOT, pf, r32, hi); partialSM(pA0, pA1, m, alA); SB(); resc(o, alA);
        }
        ATT_SYNC(); ATT_DMA_V(NT - 1);
        SB(); qkt(pB0, pB1, lds + LDS_K + KSLOT, qf, r32, hi); finishSM(pA0, pA1, alA, l, pf); SB();
        pv(o, lds + LDS_V, pf, r32, hi); partialSM(pB0, pB1, m, alB); SB(); resc(o, alB);
        ATT_SYNC();
        finishSM(pB0, pB1, alB, l, pf); pv(o, lds + LDS_V + VSLOT, pf, r32, hi);
#undef ATT_DMA_K
#undef ATT_DMA_V
#undef ATT_SYNC
#undef SB
        const float lt = xsum32(l);
        const int lane_e = (int)mk_lane_id();
        const int hi_e = lane_e >> 5; const size_t qtok_e = tok0 + qb * 256 + wave * 32 + (lane_e & 31);
        if (c == 0) {
            const float i1 = 1.f / lt;
#pragma unroll
            for (int db = 0; db < 4; ++db)
#pragma unroll
                for (int g4 = 0; g4 < 4; ++g4) *(GAS f32x4*)(stash + ((db * 4 + g4) * 64 + lane_e) * 4) = (f32x4){o[db][4 * g4] * i1, o[db][4 * g4 + 1] * i1, o[db][4 * g4 + 2] * i1, o[db][4 * g4 + 3] * i1};
        } else {
            const float i2 = lam / lt;
            float ss = 0.f;
#pragma unroll
            for (int db = 0; db < 4; ++db)
#pragma unroll
                for (int g4 = 0; g4 < 4; ++g4) { const f32x4 s1 = *(const GAS f32x4*)(stash + ((db * 4 + g4) * 64 + lane_e) * 4);
#pragma unroll
                    for (int i = 0; i < 4; ++i) { const float v = s1[i] - o[db][4 * g4 + i] * i2; o[db][4 * g4 + i] = v; ss += v * v; } }
            ss = xsum32(ss);
            const float rs = (1.f - lam_init) / sqrtf(ss * (1.f / 128.f) + 1e-5f);
            bf16* orow = MIXB + qtok_e * D + 256 + h * 128;
#pragma unroll
            for (int db = 0; db < 4; ++db)
#pragma unroll
                for (int g4 = 0; g4 < 4; ++g4) { const int e = 32 * db + 8 * g4 + 4 * hi_e; const f32x4 gg = *(const GAS f32x4*)(subg + e);
                    const unsigned long long w = (unsigned long long)pg8::cvt_pk_bf16(o[db][4 * g4] * rs * gg.x, o[db][4 * g4 + 1] * rs * gg.y) | ((unsigned long long)pg8::cvt_pk_bf16(o[db][4 * g4 + 2] * rs * gg.z, o[db][4 * g4 + 3] * rs * gg.w) << 32);
                    *(GAS unsigned long long*)(orow + e) = w; }
        }
    }
}
}
namespace hy {
typedef float f32x16 __attribute__((ext_vector_type(16)));
constexpr int CPY = 16456;
constexpr int LDS_F = 0, LDS_VV = 4 * CPY, LDS_END = LDS_VV + 32768;
static_assert(LDS_VV % 16 == 0 && LDS_END <= 131072, "hyena LDS map");

__device__ __forceinline__ void filter_item(LAS unsigned char* lds, int pb, const float* fw1, const float* fb1, const float* fr1, const float* fw2, const float* fb2, const float* fr2,
                                            const float* fw3, bf16* KF, float* PS, int wave, int lane) {
    LAS bf16* tile = (LAS bf16*)lds;
    LAS float* za = (LAS float*)(lds + 65536) + wave * 512;
    LAS float* zb = (LAS float*)(lds + 81920) + wave * 512;
    LAS float* sqs = (LAS float*)(lds + 98304);
    const int p0 = pb * 64 + wave * 8;
    if (lane < 33) {
#pragma unroll 1
        for (int pi = 0; pi < 8; ++pi) { const int p = p0 + pi; float z;
            if (lane == 0) z = (float)p / (float)(S - 1);
            else { const int bi = (lane - 1) & 15; const float band = 1e-4f + (float)bi * ((15.0f - 1e-4f) / 15.0f), wpos = 2.0f * 3.14159265358979323846f * (float)p / (float)S;
                   z = lane <= 16 ? cosf(wpos * band) : -sinf(wpos * band); }
            za[pi * 64 + lane] = z; }
    }
    LDS_WAIT(); asm volatile("" ::: "memory");
    float acc8[8];
    { const float b1 = fb1[lane];
#pragma unroll
      for (int pi = 0; pi < 8; ++pi) acc8[pi] = b1;
#pragma unroll 1
      for (int i = 0; i < 33; ++i) { const float w = fw1[i * 64 + lane];
#pragma unroll
          for (int pi = 0; pi < 8; ++pi) acc8[pi] += za[pi * 64 + i] * w; }
      const float f1 = fr1[lane];
#pragma unroll
      for (int pi = 0; pi < 8; ++pi) zb[pi * 64 + lane] = sinf(f1 * acc8[pi]); }
    LDS_WAIT(); asm volatile("" ::: "memory");
    { const float b2 = fb2[lane];
#pragma unroll
      for (int pi = 0; pi < 8; ++pi) acc8[pi] = b2;
#pragma unroll 1
      for (int i = 0; i < 64; ++i) { const float w = fw2[i * 64 + lane];
#pragma unroll
          for (int pi = 0; pi < 8; ++pi) acc8[pi] += zb[pi * 64 + i] * w; }
      const float f2 = fr2[lane];
      LDS_WAIT(); asm volatile("" ::: "memory");
#pragma unroll
      for (int pi = 0; pi < 8; ++pi) za[pi * 64 + lane] = sinf(f2 * acc8[pi]); }
    LDS_WAIT(); asm volatile("" ::: "memory");
    const float mind = logf(1e-2f) / 1.5f, maxd = logf(1e-2f) / 0.3f;
#pragma unroll 1
    for (int qh = 0; qh < 2; ++qh) {
        float ac[8][4];
#pragma unroll
        for (int pi = 0; pi < 8; ++pi)
#pragma unroll
            for (int q = 0; q < 4; ++q) ac[pi][q] = 0.f;
#pragma unroll 1
        for (int i = 0; i < 64; ++i) { float w[4];
#pragma unroll
            for (int q = 0; q < 4; ++q) w[q] = fw3[i * 512 + lane + 64 * (qh * 4 + q)];
#pragma unroll
            for (int pi = 0; pi < 8; ++pi) { const float hv = za[pi * 64 + i];
#pragma unroll
                for (int q = 0; q < 4; ++q) ac[pi][q] += hv * w[q]; } }
#pragma unroll
        for (int q = 0; q < 4; ++q) { const int col = lane + 64 * (qh * 4 + q), ch = col & 255; const float delta = fabsf(mind + (float)ch * ((maxd - mind) / 255.0f)); float sq = 0.f;
#pragma unroll
            for (int pi = 0; pi < 8; ++pi) { const int p = p0 + pi; const float val = ac[pi][q] * expf(-((float)p / (float)(S - 1)) * delta);
                if (!(col >= 256 && p == 0)) sq += val * val;
                tile[col * 64 + wave * 8 + pi] = (bf16)f2bf(val); }
            sqs[wave * 512 + col] = sq; }
    }
    LDS_WAIT(); __syncthreads();
    { const int p = pb * 64 + lane;
#pragma unroll 1
      for (int cc = 0; cc < 64; ++cc) { const int col = wave * 64 + cc; const bf16 v = tile[col * 64 + lane];
          if (col < 256) KF[(size_t)col * 8192 + 4095 - p] = v; else if (p != 0) KF[(size_t)(col - 256) * 8192 + 4095 + p] = v; } }
    { const int t = wave * 64 + lane; float s = 0.f;
#pragma unroll
      for (int w = 0; w < 8; ++w) s += sqs[w * 512 + t];
      PS[(size_t)pb * 512 + t] = s;
      if (pb == 0 && t < 256) KF[(size_t)t * 8192 + 8191] = 0; }
    LDS_WAIT(); __syncthreads();
}

__device__ __forceinline__ float conv1(float um, float u0, float up, float w0, float w1, float w2, float cb) { return um * w0 + u0 * w1 + up * w2 + cb; }

__device__ __forceinline__ void unit(LAS unsigned char* lds, int c, const bf16* KF, const float* PS, const bf16* UVT, const float* cw, const float* cb, const float* bias_d, bf16* HT, int wave, int lane) {
    asm volatile("" : "+s"(wave), "+v"(lane));
    const int tid = wave * 64 + lane;
    { const bf16* src = KF + (size_t)c * 8192;
#pragma unroll
      for (int i = 0; i < 2; ++i) { const int ch = tid + 512 * i; *(LAS v4u*)(lds + LDS_F + ch * 16) = *(const GAS v4u*)(src + ch * 8); } }
    { const float w0v = cw[512 + c], w1v = cw[768 + 512 + c], w2v = cw[1536 + 512 + c], cbv = cb[512 + c], w0x = cw[256 + c], w1x = cw[768 + 256 + c], w2x = cw[1536 + 256 + c], cbx = cb[256 + c];
      const bf16* rv = UVT + (size_t)(512 + c) * M; const bf16* rx = UVT + (size_t)(256 + c) * M;
#pragma unroll 1
      for (int i = 0; i < 4; ++i) { const int q = tid + 512 * i, b = q >> 9, sc = q & 511, s0 = sc * 8; const size_t g0 = (size_t)b * S + s0;
          const v4u av = *(const GAS v4u*)(rv + g0), ax = *(const GAS v4u*)(rx + g0);
          float uv[10], ux[10];
          uv[0] = s0 > 0 ? bf2f(rv[g0 - 1]) : 0.f; ux[0] = s0 > 0 ? bf2f(rx[g0 - 1]) : 0.f; uv[9] = s0 + 8 < S ? bf2f(rv[g0 + 8]) : 0.f; ux[9] = s0 + 8 < S ? bf2f(rx[g0 + 8]) : 0.f;
#pragma unroll
          for (int e = 0; e < 4; ++e) { uv[1 + 2 * e] = bf2f((bf16)av[e]); uv[2 + 2 * e] = bf2f((bf16)(av[e] >> 16)); ux[1 + 2 * e] = bf2f((bf16)ax[e]); ux[2 + 2 * e] = bf2f((bf16)(ax[e] >> 16)); }
          float o[8];
#pragma unroll
          for (int e = 0; e < 8; ++e) o[e] = conv1(uv[e], uv[e + 1], uv[e + 2], w0v, w1v, w2v, cbv) * conv1(ux[e], ux[e + 1], ux[e + 2], w0x, w1x, w2x, cbx);
          v4u w; w.x = pk2(o[0], o[1]); w.y = pk2(o[2], o[3]); w.z = pk2(o[4], o[5]); w.w = pk2(o[6], o[7]);
          *(LAS v4u*)(lds + LDS_VV + (((sc & 7) * 64 + (sc >> 3)) * 4 + b) * 16) = w; } }
    LDS_WAIT(); __syncthreads();
    {
#pragma unroll 1
      for (int i = 0; i < 4; ++i) { const int y = tid + 512 * i;
          const unsigned long long w0 = *(LAS const unsigned long long*)(lds + LDS_F + y * 8), w1 = *(LAS const unsigned long long*)(lds + LDS_F + y * 8 + 8);
#pragma unroll
          for (int p = 1; p < 4; ++p) *(LAS unsigned long long*)(lds + LDS_F + p * CPY + y * 8) = (w0 >> (16 * p)) | (w1 << (64 - 16 * p)); } }
    const float nrm = 1.0f / sqrtf(wave_sum(PS[(size_t)lane * 512 + c] + PS[(size_t)lane * 512 + 256 + c]) + 1e-6f);
    LDS_WAIT(); __syncthreads();
    const int r32 = lane & 31, hi = lane >> 5, gp = wave & 3, half = wave >> 2, iloc = r32 >> 2, b = r32 & 3;
    f32x16 acc[2][2];
#pragma unroll
    for (int rho = 0; rho < 2; ++rho)
#pragma unroll
        for (int gg = 0; gg < 2; ++gg)
#pragma unroll
            for (int r = 0; r < 16; ++r) acc[rho][gg][r] = 0.f;
    const int dlo = 16 * gp - 63 + (half ? 40 : 0), dn = half ? 39 : 40;
    int pa = LDS_F + (3 - (r32 & 3)) * CPY + (4092 - 4 * (r32 >> 2) + 8 * hi) * 2 - 64 - 128 * dlo;
    int jb = 16 * gp + iloc - dlo;
    const int pbase = LDS_VV + hi * 4096 + b * 16;
#pragma unroll 1
    for (int dd = 0; dd < dn; ++dd) {
        const int j0 = jb, j1 = jb + 8; const bool v0 = (unsigned)j0 < 64u, v1 = (unsigned)j1 < 64u;
        LAS const unsigned char* ap = lds + pa; LAS const unsigned char* bp0 = lds + pbase + (v0 ? j0 : 0) * 64; LAS const unsigned char* bp1 = lds + pbase + (v1 ? j1 : 0) * 64;
#pragma unroll
        for (int k = 0; k < 4; ++k) {
            typedef unsigned long long u64;
            const u64 a00 = *(LAS const u64*)(ap + 64 + 32 * k), a01 = *(LAS const u64*)(ap + 64 + 32 * k + 8), a10 = *(LAS const u64*)(ap + 32 * k), a11 = *(LAS const u64*)(ap + 32 * k + 8);
            v4u b0 = *(LAS const v4u*)(bp0 + k * 8192), b1 = *(LAS const v4u*)(bp1 + k * 8192);
            if (!v0) b0 = (v4u){0u, 0u, 0u, 0u};
            if (!v1) b1 = (v4u){0u, 0u, 0u, 0u};
            const bf16x8 fa0 = __builtin_bit_cast(bf16x8, (v4u){(unsigned)a00, (unsigned)(a00 >> 32), (unsigned)a01, (unsigned)(a01 >> 32)});
            const bf16x8 fa1 = __builtin_bit_cast(bf16x8, (v4u){(unsigned)a10, (unsigned)(a10 >> 32), (unsigned)a11, (unsigned)(a11 >> 32)});
            const bf16x8 fb0 = __builtin_bit_cast(bf16x8, b0), fb1 = __builtin_bit_cast(bf16x8, b1);
            acc[0][0] = __builtin_amdgcn_mfma_f32_32x32x16_bf16(fa0, fb0, acc[0][0], 0, 0, 0);
            acc[0][1] = __builtin_amdgcn_mfma_f32_32x32x16_bf16(fa0, fb1, acc[0][1], 0, 0, 0);
            acc[1][0] = __builtin_amdgcn_mfma_f32_32x32x16_bf16(fa1, fb0, acc[1][0], 0, 0, 0);
            acc[1][1] = __builtin_amdgcn_mfma_f32_32x32x16_bf16(fa1, fb1, acc[1][1], 0, 0, 0);
        }
        pa -= 128; jb -= 1;
    }
    LDS_WAIT(); __syncthreads();
    { LAS float* xw = (LAS float*)(lds + LDS_F) + (gp * 2 + (half ? 0 : 1)) * 2048 + lane;
#pragma unroll
      for (int gg = 0; gg < 2; ++gg)
#pragma unroll
          for (int r = 0; r < 16; ++r) xw[(gg * 16 + r) * 64] = half ? acc[0][gg][r] : acc[1][gg][r]; }
    LDS_WAIT(); __syncthreads();
    f32x16 fin[2];
    { LAS const float* xr = (LAS const float*)(lds + LDS_F) + (gp * 2 + (half ? 1 : 0)) * 2048 + lane;
#pragma unroll
      for (int gg = 0; gg < 2; ++gg)
#pragma unroll
          for (int r = 0; r < 16; ++r) fin[gg][r] = (half ? acc[1][gg][r] : acc[0][gg][r]) + xr[(gg * 16 + r) * 64]; }
    { const float bd = bias_d[c], w0 = cw[c], w1 = cw[768 + c], w2 = cw[1536 + c], cb0 = cb[c]; const bf16* r0p = UVT + (size_t)c * M; bf16* hrow = HT + (size_t)c * M;
#pragma unroll
      for (int gg = 0; gg < 2; ++gg)
#pragma unroll
          for (int g4 = 0; g4 < 4; ++g4) { const int i = 16 * gp + 8 * gg + iloc, rr = 32 * half + 8 * g4 + 4 * hi, t0 = 64 * i + rr; const size_t tok = (size_t)b * S + t0;
              const unsigned long long vw = *(LAS const unsigned long long*)(lds + LDS_VV + (((rr >> 3) * 64 + i) * 4 + b) * 16 + (rr & 7) * 2);
              const unsigned long long uw = *(const GAS unsigned long long*)(r0p + tok);
              float u[6]; u[0] = t0 > 0 ? bf2f(r0p[tok - 1]) : 0.f; u[5] = t0 + 4 < S ? bf2f(r0p[tok + 4]) : 0.f;
              u[1] = bf2f((bf16)uw); u[2] = bf2f((bf16)(uw >> 16)); u[3] = bf2f((bf16)(uw >> 32)); u[4] = bf2f((bf16)(uw >> 48));
              float o[4];
#pragma unroll
              for (int e = 0; e < 4; ++e) { const float vv = bf2f((bf16)(vw >> (16 * e))); o[e] = (nrm * fin[gg][4 * g4 + e] + vv * bd) * conv1(u[e], u[e + 1], u[e + 2], w0, w1, w2, cb0); }
              *(GAS unsigned long long*)(hrow + tok) = (unsigned long long)pk2(o[0], o[1]) | ((unsigned long long)pk2(o[2], o[3]) << 32); } }
    LDS_WAIT(); __syncthreads();
}
__device__ __forceinline__ void transpose_slab(LAS unsigned char* lds, int slab, const bf16* HT, bf16* MIXB, int wave, int lane) {
    const int tid = wave * 64 + lane; LAS bf16* tile = (LAS bf16*)lds;
#pragma unroll 1
    for (int i = 0; i < 4; ++i) { const int q = tid + 512 * i, c = q >> 3, tc = q & 7; const v4u w = *(const GAS v4u*)(HT + (size_t)c * M + (size_t)slab * 64 + tc * 8);
#pragma unroll
        for (int e = 0; e < 4; ++e) { tile[(tc * 8 + 2 * e) * 264 + c] = (bf16)w[e]; tile[(tc * 8 + 2 * e + 1) * 264 + c] = (bf16)(w[e] >> 16); } }
    LDS_WAIT(); __syncthreads();
#pragma unroll 1
    for (int i = 0; i < 4; ++i) { const int q = tid + 512 * i, tk = q >> 5, cc = q & 31;
        *(GAS v4u*)(MIXB + ((size_t)slab * 64 + tk) * D + cc * 8) = *(LAS const v4u*)(lds + (tk * 264 + cc * 8) * 2); }
    LDS_WAIT(); __syncthreads();
}
}
#ifndef DUP_PRO
#define DUP_PRO 1
#endif
#ifndef DUP_IN
#define DUP_IN 1
#endif
#ifndef DUP_HY
#define DUP_HY 1
#endif
#ifndef DUP_POOL
#define DUP_POOL 1
#endif
#ifndef DUP_HYT
#define DUP_HYT 1
#endif
#ifndef DUP_ATT
#define DUP_ATT 1
#endif
#ifndef DUP_OUT
#define DUP_OUT 1
#endif
#ifndef DUP_LN1
#define DUP_LN1 1
#endif
#ifndef DUP_MOE1
#define DUP_MOE1 1
#endif
#ifndef DUP_MOE2
#define DUP_MOE2 1
#endif
#ifndef DUP_LN2
#define DUP_LN2 1
#endif
#ifndef EN_HY
#define EN_HY 1
#endif
#ifndef EN_HYT
#define EN_HYT 1
#endif
#ifndef EN_PRO
#define EN_PRO 1
#endif
#ifndef EN_IN
#define EN_IN 1
#endif
#ifndef EN_ATT
#define EN_ATT 1
#endif
#ifndef EN_POOL
#define EN_POOL 1
#endif
#ifndef EN_OUT
#define EN_OUT 1
#endif
#ifndef EN_LN1
#define EN_LN1 1
#endif
#ifndef EN_WCV
#define EN_WCV 1
#endif
#ifndef EN_MOE1
#define EN_MOE1 1
#endif
#ifndef EN_MOE2
#define EN_MOE2 1
#endif
#ifndef EN_LN2
#define EN_LN2 1
#endif
constexpr int RING_BYTES = 135168;
constexpr int LDSCTL_OFF = RING_BYTES, MISC_OFF = LDSCTL_OFF + 320, MOETAB_OFF = LDSCTL_OFF + 1024, ROUTE_OFF = LDSCTL_OFF + 2048;
constexpr int LDS_BYTES = 151552;

struct Args { const float* in[38]; float* out; unsigned char* ws; int* eid; float* wts; int ph_lo, ph_hi, l_lo, l_hi, single, pad; };
enum { PH_PRO = 0, PH_IN = 1, PH_ATT = 2, PH_POOL = 3, PH_OUT = 4, PH_LN1 = 5, PH_WCV = 6, PH_MOE1 = 7, PH_MOE2 = 8, PH_LN2 = 9, PH_HY = 10, PH_HYT = 11, PH_END = 12 };

__global__ void __launch_bounds__(NWAVES * 64, 2) mk_fwd(Args a) {
    extern __shared__ __attribute__((aligned(16))) unsigned char lds_raw[];
    LAS unsigned char* lds = (LAS unsigned char*)lds_raw;
    volatile LAS unsigned* MISC = (volatile LAS unsigned*)(lds + MISC_OFF);
    const int wave_s = __builtin_amdgcn_readfirstlane((int)threadIdx.x >> 6);
    const int G = gridDim.x, bx = blockIdx.x, vcu0 = (G % 8 == 0) ? (bx % 8) * (G / 8) + bx / 8 : bx;
    gu32* ctl0 = (gu32*)(a.ws + WS_CTL);
    for (int u = wave_s * 64 + (int)mk_lane_id(); u < (LDS_BYTES - LDSCTL_OFF) / 4; u += NWAVES * 64) ((LAS unsigned*)(lds + LDSCTL_OFF))[u] = 0u;
    __syncthreads();
    XcdBarrier bar; bar.bar = (unsigned*)(ctl0 + CW_BAR); bar.x = 0; bar.st = nullptr;
#if defined(MK_PER_PHASE)
    if (!a.single)
#endif
    bar = xcd_barrier_post((unsigned*)(ctl0 + CW_BAR), MISC + 8, wave_s);
#if defined(MK_PER_PHASE)
#define IN(k) (a.ph_lo <= (k) && (k) < a.ph_hi)
#define SEAM() do { if (!a.single) xcd_barrier(bar, wave_s); } while (0)
#else
#define IN(k) 1
#if defined(PROBE_BAR2)
#define SEAM() do { xcd_barrier(bar, wave_s); xcd_barrier(bar, wave_s); } while (0)
#else
#define SEAM() xcd_barrier(bar, wave_s)
#endif
#endif
    const int NGW = G * NWAVES;
#define PHASE_PTRS() int lane_ = (int)mk_lane_id(); asm volatile("" : "+v"(lane_)); const int lane = lane_, wave = wave_s; int vcu = vcu0; asm volatile("" : "+s"(vcu)); (void)wave; const int gw = vcu * NWAVES + wave; (void)gw; unsigned char* ws = a.ws; gu32* ctl = (gu32*)(ws + WS_CTL); (void)ctl; \
    bf16* XB = (bf16*)(ws + WS_XB); bf16* QKP = (bf16*)(ws + WS_QKP); bf16* UVT = (bf16*)(ws + WS_UVT); float* CS = (float*)(ws + WS_CS); bf16* MIXB = (bf16*)(ws + WS_MIXB); \
    (void)XB; (void)QKP; (void)UVT; (void)CS; (void)MIXB
#define INP(k) (a.in[k])
#define WCV_LAYER(LEXPR, GW_, NGW_) do { const int wl_ = (LEXPR), wg_ = (GW_), wn_ = (NGW_); const int l = wl_, gw = wg_, NGW = wn_; (void)NGW; \
            LAS float* scr = (LAS float*)(lds + wave * 16384); \
            unsigned char* wb_ = ws + WS_WBUF + (size_t)(l & 1) * WBUF_STRIDE; bf16* W13 = (bf16*)(wb_ + WB_W13); bf16* W2 = (bf16*)(wb_ + WB_W2); bf16* WG = (bf16*)(wb_ + WB_WG); bf16* WP = (bf16*)(wb_ + WB_WP); \
            for (int it = gw; it < 6784; it += NGW) { \
                const float* src; int K, N, k0, n0, mode = 0; bf16* dst; \
                if (it < 4096) { const int which = it >> 11, r = it & 2047, e = r >> 7, kb = (r >> 3) & 15, nb = r & 7; \
                    src = INP(which ? 31 : 30) + ((size_t)l * 16 + e) * D * 256; K = D; N = 256; k0 = kb * 64; n0 = nb * 32; mode = 1 + which; dst = W13 + (size_t)e * 512 * D; \
                } else if (it < 6144) { const int r = it - 4096, e = r >> 7, kb = (r >> 5) & 3, nb = r & 31; \
                    src = INP(32) + ((size_t)l * 16 + e) * 256 * D; K = 256; N = D; k0 = kb * 64; n0 = nb * 32; dst = W2 + (size_t)e * D * 256 + (size_t)n0 * 256; \
                } else if (it < 6656) { const int r = it - 6144, kb = r >> 5, nb = r & 31; \
                    src = INP(33) + (size_t)l * D * D; K = D; N = D; k0 = kb * 64; n0 = nb * 32; dst = WG + (size_t)n0 * D; \
                } else { const int r = it - 6656, kb = r >> 5, nb = r & 31; \
                    src = INP(35) + (size_t)l * 256 * D; K = 256; N = D; k0 = kb * 64; n0 = nb * 32; dst = WP + (size_t)n0 * 256; } \
                p0_transpose_block(src, K, N, k0, n0, dst, mode, scr, lane); \
            } \
            const int ln = lane; \
            const float* ps = INP(1) + (size_t)l * M * 256; bf16* PB = (bf16*)(wb_ + WB_PB); \
            for (size_t i = ((size_t)gw * 64 + ln) * 8; i < (size_t)M * 256; i += (size_t)NGW * 64 * 8) { const f32x4 x0 = *(const GAS f32x4*)(ps + i), x1 = *(const GAS f32x4*)(ps + i + 4); \
                v4u o; o.x = pk2(x0.x, x0.y); o.y = pk2(x0.z, x0.w); o.z = pk2(x1.x, x1.y); o.w = pk2(x1.z, x1.w); *(GAS v4u*)(PB + i) = o; } \
    } while (0)

    if (EN_PRO && IN(PH_PRO)) {
            PHASE_PTRS();
            for (int rep_ = 0; rep_ < DUP_PRO; ++rep_) {
        LAS float* scr = (LAS float*)(lds + wave * 16384);
        for (int it = gw; it < DEPTH * (16 * 72 + 16 * 32); it += NGW) {
            const int l = it / 1664, r = it % 1664; const float* src; int N, k0, n0; bf16* dst;
            if (r < 1152) { const int kb = r / 72, nb = r % 72; n0 = nb * 32; k0 = kb * 64; N = INW; src = INP(4) + (size_t)l * D * INW;
                bf16* wsw = (bf16*)(ws + WS_WIN + (size_t)l * WIN_LAYER); bf16* wnm = wsw + 1280 * 1024;
                dst = n0 < 768 ? wsw + (size_t)n0 * D : (n0 < 1792 ? wnm + (size_t)(n0 - 768) * D : wsw + (size_t)(768 + n0 - 1792) * D); }
            else { const int q = r - 1152, kb = q >> 5, nb = q & 31; n0 = nb * 32; k0 = kb * 64; N = D; src = INP(23) + (size_t)l * D * D; dst = (bf16*)(ws + WS_WOUT + (size_t)l * WOUT_LAYER) + (size_t)n0 * D; }
            p0_transpose_block(src, D, N, k0, n0, dst, 0, scr, lane);
            }
        }
        for (int it = gw; it < DEPTH * 4 * 16 * 2; it += NGW) {
            const int l = it >> 7, g = (it >> 5) & 3, dh = (it >> 4) & 1, k = (it & 15) * 64 + lane;
            const float* wrow = INP(4) + (size_t)l * D * INW + (size_t)k * INW + 2304 + g * 64;
            const float* pw = INP(20) + (size_t)(l * 4 + g) * 64 * 64 + dh * 32;
            float acc[32];
#pragma unroll
            for (int d = 0; d < 32; ++d) acc[d] = 0.f;
#pragma unroll 1
            for (int c = 0; c < 64; ++c) { const float x = wrow[c];
#pragma unroll
                for (int d = 0; d < 32; ++d) acc[d] += x * pw[c * 64 + d]; }
            bf16* dst = (bf16*)(ws + WS_WIN + (size_t)l * WIN_LAYER) + (size_t)(1280 + 1024 + g * 64 + dh * 32) * D + k;
#pragma unroll
            for (int d = 0; d < 32; ++d) dst[(size_t)d * D] = (bf16)f2bf(acc[d]);
        }
        int ln2 = lane; asm volatile("" : "+v"(ln2));
        for (int i = gw * 64 + ln2; i < S * 8; i += NGW * 64) { const int pos = i >> 3, j = i & 7; const float ang = (float)pos * powf(500000.0f, -(float)(2 * j) / 16.0f);
            CS[pos * 16 + j] = cosf(ang); CS[pos * 16 + 8 + j] = sinf(ang); }
        for (int m = gw; m < M; m += NGW) ln_row(INP(0) + (size_t)m * D, 1.f, nullptr, nullptr, nullptr, INP(2), INP(3), nullptr, XB + (size_t)m * D, lane);
        WCV_LAYER(0, gw, NGW);
        LDS_WAIT(); __syncthreads();
        for (int it = vcu; it < DEPTH * 64; it += G) { const int fl = it >> 6, pb = it & 63;
            hy::filter_item(lds, pb, INP(7) + fl * 33 * 64, INP(8) + fl * 64, INP(9) + fl * 64, INP(10) + fl * 64 * 64, INP(11) + fl * 64, INP(12) + fl * 64, INP(13) + fl * 64 * 512,
                            (bf16*)(ws + WS_KF) + (size_t)fl * 256 * 8192, (float*)(ws + WS_PS) + (size_t)fl * 64 * 512, wave, lane); }
        SEAM();
    }
#if defined(MK_PER_PHASE)
    for (int l = a.l_lo; l < a.l_hi; ++l) {
#else
#pragma unroll 1
    for (int l = 0; l < DEPTH; ++l) {
#endif
        if (EN_IN && IN(PH_IN)) {
            PHASE_PTRS();
            for (int rep_ = 0; rep_ < DUP_IN; ++rep_) {
            const char* wsw = (const char*)(ws + WS_WIN + (size_t)l * WIN_LAYER);
            SchedIn Sc{vcu, G, (const char*)XB, wsw, wsw + (size_t)1280 * 1024 * 2};
            EpiIn E{QKP, UVT, CS};
            pg8::gemm_phase<EpiIn, SchedIn>(lds, D, Sc, E, wave);
            }
            SEAM();
        }
        if (EN_HY && IN(PH_HY)) {
            PHASE_PTRS();
            for (int rep_ = 0; rep_ < DUP_HY; ++rep_) {
            for (int c = vcu; c < 256; c += G)
                hy::unit(lds, c, (const bf16*)(ws + WS_KF) + (size_t)l * 256 * 8192, (const float*)(ws + WS_PS) + (size_t)l * 64 * 512, UVT, INP(5) + l * 3 * 768, INP(6) + l * 768, INP(14) + l * 256, (bf16*)(ws + WS_HT), wave, lane);
            }
        }
        if (EN_POOL && IN(PH_POOL)) {
            PHASE_PTRS();
            for (int rep_ = 0; rep_ < DUP_POOL; ++rep_) {
            int ln = lane; asm volatile("" : "+v"(ln));
            const int cc = (ln & 31) * 8, gq = cc >> 6, hw = 1 << gq;
            const float* pb = INP(21) + l * 256 + cc; const float* psc = INP(22) + l * 256 + cc;
            for (int it = gw; it < M / 2; it += NGW) {
                const int tok = it * 2 + (ln >> 5), pos = tok & (S - 1);
                int lo = pos - hw, hi2 = pos + hw - 1; lo = lo < 0 ? 0 : lo; hi2 = hi2 > S - 1 ? S - 1 : hi2;
                float sacc[8];
#pragma unroll
                for (int e = 0; e < 8; ++e) sacc[e] = 0.f;
                const bf16* zp = QKP + (size_t)(tok - pos) * 1280 + 1024 + cc;
                for (int r = lo; r <= hi2; ++r) { const v4u w = *(const GAS v4u*)(zp + (size_t)r * 1280);
                    sacc[0] += bf2f((bf16)w.x); sacc[1] += bf2f((bf16)(w.x >> 16)); sacc[2] += bf2f((bf16)w.y); sacc[3] += bf2f((bf16)(w.y >> 16));
                    sacc[4] += bf2f((bf16)w.z); sacc[5] += bf2f((bf16)(w.z >> 16)); sacc[6] += bf2f((bf16)w.w); sacc[7] += bf2f((bf16)(w.w >> 16)); }
                const float inv = 1.f / (float)(hi2 - lo + 1);
                const v4u w = *(const GAS v4u*)(zp + (size_t)pos * 1280);
                float z[8] = {bf2f((bf16)w.x), bf2f((bf16)(w.x >> 16)), bf2f((bf16)w.y), bf2f((bf16)(w.y >> 16)), bf2f((bf16)w.z), bf2f((bf16)(w.z >> 16)), bf2f((bf16)w.w), bf2f((bf16)(w.w >> 16))};
                float y[8];
#pragma unroll
                for (int e = 0; e < 8; ++e) y[e] = (sacc[e] * inv - z[e] + pb[e]) * psc[e];
                v4u o; o.x = pk2(y[0], y[1]); o.y = pk2(y[2], y[3]); o.z = pk2(y[4], y[5]); o.w = pk2(y[6], y[7]);
                *(GAS v4u*)(MIXB + (size_t)tok * D + 768 + cc) = o;
            }
            }
            SEAM();
        }
        if (EN_HYT && IN(PH_HYT)) {
            PHASE_PTRS();
            for (int rep_ = 0; rep_ < DUP_HYT; ++rep_) {
            for (int s = vcu; s < 256; s += G) hy::transpose_slab(lds, s, (const bf16*)(ws + WS_HT), MIXB, wave, lane);
            }
        }
        if (EN_ATT && IN(PH_ATT)) {
            PHASE_PTRS();
            for (int rep_ = 0; rep_ < DUP_ATT; ++rep_) {
            const float lam_init = 0.8f - 0.6f * expf(-0.3f * (float)l);
            int ln = lane; asm volatile("" : "+v"(ln));
            const float lam = expf(wave_sum(INP(15)[l * 64 + ln] * INP(16)[l * 64 + ln])) - expf(wave_sum(INP(17)[l * 64 + ln] * INP(18)[l * 64 + ln])) + lam_init;
            for (int u = vcu; u < 256; u += G) att::unit(lds, (u >> 4) >> 2, (u >> 4) & 3, u & 15, QKP, UVT, lam, lam_init, INP(19) + l * 128, MIXB, (float*)(ws + WS_STASH) + ((size_t)u * 8 + wave) * 4096, wave, lane);
            }
            SEAM();
        }
        if (EN_OUT && IN(PH_OUT)) {
            PHASE_PTRS();
            for (int rep_ = 0; rep_ < DUP_OUT; ++rep_) {
            SchedOut Sc{vcu, G, (const char*)MIXB, (const char*)(ws + WS_WOUT + (size_t)l * WOUT_LAYER)};
#if defined(PROBE_OUT)
            { EpiRes E0{(bf16*)(ws + WS_STASH)}; pg8::gemm_phase<EpiRes, SchedOut>(lds, D, Sc, E0, wave); }
#endif
            EpiRes E{XB};
            pg8::gemm_phase<EpiRes, SchedOut>(lds, D, Sc, E, wave);
            }
            SEAM();
        }
        if (EN_LN1 && IN(PH_LN1)) {
            PHASE_PTRS();
            for (int rep_ = 0; rep_ < DUP_LN1; ++rep_) {
            int ln = lane; asm volatile("" : "+v"(ln));
            for (int ch = vcu; ch < M / 64; ch += G)
                ln1_router_chunk((LAS RouteLds*)(lds + ROUTE_OFF), lds, ch * 64, XB, INP(24) + l * D, INP(25) + l * D, INP(26) + (size_t)l * D * 4, INP(27) + l * 4, INP(28) + (size_t)l * D * 16, INP(29) + l * 16,
                                 ctl + CW_CNT + l * 16 * CNT_STRIDE, (int*)(ws + WS_TOKIDX), (float*)(ws + WS_GATE), wave, lane);
            }
            SEAM();
        }
        if (EN_MOE1 && IN(PH_MOE1)) {
            PHASE_PTRS();
            for (int rep_ = 0; rep_ < DUP_MOE1; ++rep_) {
            moe_tab_build((LAS int*)(lds + MOETAB_OFF), ctl + CW_CNT + l * 16 * CNT_STRIDE, wave == 0 && lane == 0); const MoeTab T{(LAS const int*)(lds + MOETAB_OFF)};
            { SchedMoe<2> Sc{vcu, G, T, (const char*)XB, (const char*)(ws + WS_WBUF + (size_t)(l & 1) * WBUF_STRIDE + WB_W13), (size_t)512 * D * 2, (const int*)(ws + WS_TOKIDX), 0};
              EpiMoe1 E{(bf16*)(ws + WS_ACT), (const float*)(ws + WS_GATE), T};
              pg8::gemm_phase<EpiMoe1, SchedMoe<2>, true>(lds, D, Sc, E, wave);
#if defined(PROBE_MOE1A)
              pg8::gemm_phase<EpiMoe1, SchedMoe<2>, true>(lds, D, Sc, E, wave);
#endif
            }
            { SchedSq Sc{vcu, G, (const char*)(ws + WS_WBUF + (size_t)(l & 1) * WBUF_STRIDE + WB_PB), (const char*)(ws + WS_WBUF + (size_t)(l & 1) * WBUF_STRIDE + WB_WP), (size_t)256 * 256 * 2, (size_t)256 * 256 * 2};
              EpiPle<0> E{(bf16*)(ws + WS_YP), nullptr};
              pg8::gemm_phase<EpiPle<0>, SchedSq>(lds, 256, Sc, E, wave);
#if defined(PROBE_MOE1B)
              pg8::gemm_phase<EpiPle<0>, SchedSq>(lds, 256, Sc, E, wave);
#endif
            }
            { SchedSq Sc{vcu, G, (const char*)XB, (const char*)(ws + WS_WBUF + (size_t)(l & 1) * WBUF_STRIDE + WB_WG), TILEB, TILEB};
              EpiPle<1> E{(bf16*)(ws + WS_YP), INP(34) + l * D};
              pg8::gemm_phase<EpiPle<1>, SchedSq>(lds, D, Sc, E, wave); }
            if (l + 1 < DEPTH) {
                int x2 = 2 * T.pre(16) - G; x2 = x2 < 0 ? 0 : (x2 > G / 2 ? G / 2 : x2);
                if (vcu >= x2) WCV_LAYER(l + 1, (vcu - x2) * NWAVES + wave, (G - x2) * NWAVES);
            }
            }
            SEAM();
        }
        if (EN_MOE2 && IN(PH_MOE2)) {
            PHASE_PTRS();
            for (int rep_ = 0; rep_ < DUP_MOE2; ++rep_) {
            moe_tab_build((LAS int*)(lds + MOETAB_OFF), ctl + CW_CNT + l * 16 * CNT_STRIDE, wave == 0 && lane == 0); const MoeTab T{(LAS const int*)(lds + MOETAB_OFF)};
            SchedMoe<4> Sc{vcu, G, T, (const char*)(ws + WS_ACT), (const char*)(ws + WS_WBUF + (size_t)(l & 1) * WBUF_STRIDE + WB_W2), (size_t)D * 256 * 2, (const int*)(ws + WS_TOKIDX), (size_t)256 * 256 * 2};
            EpiMoe2 E{(bf16*)(ws + WS_YMOE), (const int*)(ws + WS_TOKIDX), T};
            pg8::gemm_phase<EpiMoe2, SchedMoe<4>>(lds, 256, Sc, E, wave);
            }
            SEAM();
        }
        if (EN_LN2 && IN(PH_LN2)) {
            PHASE_PTRS();
            for (int rep_ = 0; rep_ < DUP_LN2; ++rep_) {
            int ln = lane; asm volatile("" : "+v"(ln));
            const bf16* YM = (const bf16*)(ws + WS_YMOE); const bf16* YP = (const bf16*)(ws + WS_YP);
            const bool lastl = (l == DEPTH - 1);
#if defined(PROBE_LN2)
            for (int m = gw; m < M; m += NGW)
                ln_row(XB + (size_t)m * D, DN_ALPHA, YM + (size_t)(2 * m) * D, YM + (size_t)(2 * m + 1) * D, YP + (size_t)m * D, INP(36) + l * D, INP(37) + l * D, (float*)nullptr, (bf16*)(ws + WS_STASH) + (size_t)m * D, ln);
#endif
            for (int m = gw; m < M; m += NGW)
                ln_row(XB + (size_t)m * D, DN_ALPHA, YM + (size_t)(2 * m) * D, YM + (size_t)(2 * m + 1) * D, YP + (size_t)m * D, INP(36) + l * D, INP(37) + l * D,
                       lastl ? a.out + (size_t)m * D : (float*)nullptr, lastl ? nullptr : XB + (size_t)m * D, ln);
            }
            SEAM();
        }
    }
#undef IN
#undef SEAM
}
static void mk_launch(const Args& base, int ph, int l, int grid, hipStream_t stream) {
    Args a = base; a.ph_lo = ph; a.ph_hi = ph + 1; a.l_lo = l; a.l_hi = l + 1; a.single = 1;
    hipLaunchKernelGGL(mk_fwd, dim3(grid), dim3(NWAVES * 64), LDS_BYTES, stream, a);
}
extern "C" void kernel_launch(void* const* d_in, const int* in_sizes, int n_in, void* d_out, int out_size, void* d_ws, size_t ws_size, hipStream_t stream) {
    (void)in_sizes; (void)n_in; (void)out_size; (void)ws_size;
    static int grid = 0;
    if (grid == 0) {
        int dev = 0, cus = 0;
        if (hipGetDevice(&dev) != hipSuccess || hipDeviceGetAttribute(&cus, hipDeviceAttributeMultiprocessorCount, dev) != hipSuccess) { grid = -1; return; }
        if (hipFuncSetAttribute((const void*)mk_fwd, hipFuncAttributeMaxDynamicSharedMemorySize, LDS_BYTES) != hipSuccess) { grid = -1; return; }
        (void)hipGetLastError();
        grid = cus;
    }
    if (grid < 0) return;
    (void)hipMemsetAsync((char*)d_ws + WS_CTL, 0, CTL_ZERO_BYTES, stream);
    Args base{};
    for (int i = 0; i < 38; ++i) base.in[i] = (const float*)d_in[i];
    base.out = (float*)d_out; base.ws = (unsigned char*)d_ws;
    base.eid = nullptr; base.wts = nullptr;
#if defined(MK_PER_PHASE)
    mk_launch(base, PH_PRO, 0, grid, stream);
    for (int l = 0; l < DEPTH; ++l) for (int ph : {PH_IN, PH_HY, PH_HYT, PH_ATT, PH_POOL, PH_OUT, PH_LN1, PH_WCV, PH_MOE1, PH_MOE2, PH_LN2}) mk_launch(base, ph, l, grid, stream);
#else
    Args a = base; a.ph_lo = 0; a.ph_hi = PH_END; a.l_lo = 0; a.l_hi = DEPTH; a.single = 0;
    hipLaunchKernelGGL(mk_fwd, dim3(grid), dim3(NWAVES * 64), LDS_BYTES, stream, a);
#endif
}
```

```cpp
#include <hip/hip_runtime.h>
#include <stdint.h>
#include <math.h>
namespace pg8 {
#define PG8_LAS __attribute__((address_space(3)))
typedef unsigned short bf16_t;
typedef short bf16x8 __attribute__((ext_vector_type(8)));
typedef float f32x4 __attribute__((ext_vector_type(4)));
typedef unsigned u32x4 __attribute__((ext_vector_type(4)));
constexpr int BM = 256, BK = 64, HALF = 128, HTB = HALF * BK * 2  , STAGE_BYTES = 8 * HTB;

__host__ __device__ __forceinline__ int lds_byte(int r, int c) { const int st = (r >> 4) * 2 + (c >> 5), rr = r & 15, cc = c & 31, ob = rr * 64 + cc * 2; return st * 1024 + (ob ^ (((ob >> 9) & 1) << 5)); }
__host__ __device__ __forceinline__ void stage_rc(int b, int& R, int& C) { const int st = b / 1024, sb = b % 1024, swz = sb ^ (((sb >> 9) & 1) << 5); R = (st >> 1) * 16 + swz / 64; C = (st & 1) * 32 + (swz % 64) / 2; }
__host__ __device__ __forceinline__ int perm32(int rho) { const int n = rho >> 4, i = rho & 15; return 8 * (i >> 2) + 4 * n + (i & 3); }

struct Unit { const char* A; const char* B; int kind, pm, pn, aux; };

__device__ __forceinline__ unsigned cvt_pk_bf16(float lo, float hi) { unsigned r; asm volatile("v_cvt_pk_bf16_f32 %0, %1, %2" : "=v"(r) : "v"(lo), "v"(hi)); return r; }

template <class Epi, class Sched, bool GATHER = false>
__device__ __forceinline__ void gemm_phase(PG8_LAS unsigned char* lds, const int K_, const Sched& S, const Epi& E, const int wave_) {
    int K = K_; asm volatile("" : "+s"(K));
    int tid_; asm volatile("v_mbcnt_lo_u32_b32 %0, -1, 0\n\tv_mbcnt_hi_u32_b32 %0, -1, %0" : "=v"(tid_)); tid_ += wave_ * 64;
    const int tid = tid_, wid = __builtin_amdgcn_readfirstlane(tid >> 6), lane = tid & 63, wr = wid >> 2, wc = wid & 3, fr = lane & 15, fq = lane >> 4;
    const int nt = K / BK;
    unsigned voffA[2][2], voffN[2][2] = {{0u, 0u}, {0u, 0u}}, voffB[2]; int RA[2], CA[2];
#pragma unroll
    for (int i = 0; i < 2; ++i) { int R, C; stage_rc(tid * 16 + i * 8192, R, C); const int Rb = Epi::PERM ? ((R & ~31) + perm32(R & 31)) : R; RA[i] = R; CA[i] = C;
        voffA[0][i] = (unsigned)(R * K + C) * 2u; voffA[1][i] = (unsigned)((R + HALF) * K + C) * 2u; voffB[i] = (unsigned)(Rb * K + C) * 2u; }
    const size_t kstep = (size_t)(BK * 2);
    const size_t hstep = (size_t)HALF * K * 2;
    const unsigned ldsw = (unsigned)wid * 1024u;
    const int aoff = lds_byte(wr * 64 + fr, fq * 8), boff = lds_byte(wc * 32 + fr, fq * 8);
#define PG8_SA(b, h) (((b) * 2 + (h)) * HTB)
#define PG8_SB(b, h) ((4 + (b) * 2 + (h)) * HTB)
#define PG8_STAGE(bufoff, gbase, voff) do { _Pragma("unroll") for (int _i = 0; _i < 2; ++_i) \
        __builtin_amdgcn_global_load_lds((const unsigned*)((const char*)(gbase) + (voff)[_i]), (PG8_LAS unsigned*)(lds + (bufoff) + ldsw + _i * 8192), 16, 0, 0); } while (0)
#define PG8_LDA(dst, b, h) do { _Pragma("unroll") for (int m = 0; m < 4; ++m) _Pragma("unroll") for (int k = 0; k < 2; ++k) dst[m][k] = *(const PG8_LAS bf16x8*)(lds + PG8_SA(b, h) + aoff + m * 2048 + k * 1024); } while (0)
#define PG8_LDB(dst, b, h) do { _Pragma("unroll") for (int n = 0; n < 2; ++n) _Pragma("unroll") for (int k = 0; k < 2; ++k) dst[n][k] = *(const PG8_LAS bf16x8*)(lds + PG8_SB(b, h) + boff + n * 2048 + k * 1024); } while (0)
#define PG8_MMA(ai, bj, At, Bt) do { __builtin_amdgcn_s_setprio(1); _Pragma("unroll") for (int m = 0; m < 4; ++m) _Pragma("unroll") for (int n = 0; n < 2; ++n) _Pragma("unroll") for (int k = 0; k < 2; ++k) \
        acc[ai][bj][m][n] = __builtin_amdgcn_mfma_f32_16x16x32_bf16(Bt[n][k], At[m][k], acc[ai][bj][m][n], 0, 0, 0); __builtin_amdgcn_s_setprio(0); } while (0)
#define PG8_WAIT_V(n) asm volatile("s_waitcnt vmcnt(" #n ")" ::: "memory")
#define PG8_WAIT_L(n) asm volatile("s_waitcnt lgkmcnt(" #n ")" ::: "memory")
#define PG8_BAR __builtin_amdgcn_s_barrier()
#define PG8_SCHED __builtin_amdgcn_sched_barrier(0)
    Unit cur, nxt; int ui = 0;
    if (!S.next(0, cur)) return;
    if constexpr (GATHER) {
#pragma unroll
        for (int h = 0; h < 2; ++h)
#pragma unroll
            for (int i = 0; i < 2; ++i) voffA[h][i] = (unsigned)(S.arow(cur, h * HALF + RA[i]) * K + CA[i]) * 2u;
    }
    f32x4 acc[2][2][4][2];
#pragma unroll
    for (int a = 0; a < 2; ++a)
#pragma unroll
        for (int b = 0; b < 2; ++b)
#pragma unroll
            for (int m = 0; m < 4; ++m)
#pragma unroll
                for (int n = 0; n < 2; ++n) acc[a][b][m][n] = (f32x4){0.f, 0.f, 0.f, 0.f};
    bf16x8 At[4][2], B0[2][2], B1[2][2];
    const char* cA = cur.A; const char* cB = cur.B;
    PG8_STAGE(PG8_SB(0, 0), cB, voffB); PG8_STAGE(PG8_SB(0, 1), cB + hstep, voffB); PG8_STAGE(PG8_SA(0, 0), cA, voffA[0]); PG8_STAGE(PG8_SA(0, 1), cA, voffA[1]);
    if (wr == 1) PG8_BAR;
    PG8_WAIT_V(2); PG8_BAR;
    PG8_STAGE(PG8_SB(1, 0), cB + kstep, voffB); PG8_STAGE(PG8_SA(1, 0), cA + kstep, voffA[0]); PG8_STAGE(PG8_SB(1, 1), cB + hstep + kstep, voffB);
    PG8_WAIT_V(6); PG8_BAR;
    for (;;) {
        const bool has_next = S.next(ui + 1, nxt);
        const char* nA = has_next ? nxt.A : cA; const char* nB = has_next ? nxt.B : cB;
        if constexpr (GATHER) {
#pragma unroll
            for (int h = 0; h < 2; ++h)
#pragma unroll
                for (int i = 0; i < 2; ++i) voffN[h][i] = has_next ? (unsigned)(S.arow(nxt, h * HALF + RA[i]) * K + CA[i]) * 2u : voffA[h][i];
        }
#pragma unroll 1
        for (int t = 0; t < nt; t += 2) {
            const bool last = (t == nt - 2);
            const char* a1 = cA + (size_t)(t + 1) * kstep;
            const char* a2 = last ? nA : cA + (size_t)(t + 2) * kstep; const char* b2 = last ? nB : cB + (size_t)(t + 2) * kstep;
            const char* a3 = a2 + kstep; const char* b3 = b2 + kstep;
            PG8_LDB(B0, 0, 0); PG8_LDB(B1, 0, 1); PG8_SCHED; PG8_LDA(At, 0, 0); PG8_STAGE(PG8_SA(1, 1), a1, voffA[1]);
            if constexpr (GATHER) { if (last) {
#pragma unroll
                for (int h = 0; h < 2; ++h)
#pragma unroll
                    for (int i = 0; i < 2; ++i) voffA[h][i] = voffN[h][i]; } }
            PG8_WAIT_V(8); PG8_WAIT_L(0); PG8_BAR; PG8_MMA(0, 0, At, B0); PG8_MMA(0, 1, At, B1); PG8_BAR; PG8_SCHED;
            PG8_LDA(At, 0, 1); PG8_STAGE(PG8_SB(0, 0), b2, voffB); PG8_STAGE(PG8_SB(0, 1), b2 + hstep, voffB); PG8_STAGE(PG8_SA(0, 0), a2, voffA[0]);
            PG8_WAIT_V(8); PG8_WAIT_L(0); PG8_BAR; PG8_MMA(1, 0, At, B0); PG8_MMA(1, 1, At, B1); PG8_BAR; PG8_SCHED;
            PG8_LDB(B0, 1, 0); PG8_LDB(B1, 1, 1); PG8_SCHED; PG8_LDA(At, 1, 0); PG8_STAGE(PG8_SA(0, 1), a2, voffA[1]);
            PG8_WAIT_V(8); PG8_WAIT_L(0); PG8_BAR; PG8_MMA(0, 0, At, B0); PG8_MMA(0, 1, At, B1); PG8_BAR; PG8_SCHED;
            PG8_LDA(At, 1, 1); PG8_STAGE(PG8_SB(1, 0), b3, voffB); PG8_STAGE(PG8_SB(1, 1), b3 + hstep, voffB); PG8_STAGE(PG8_SA(1, 0), a3, voffA[0]);
            PG8_WAIT_V(8); PG8_WAIT_L(0); PG8_BAR; PG8_MMA(1, 0, At, B0); PG8_MMA(1, 1, At, B1); PG8_BAR; PG8_SCHED;
        }
        if (wr == 0) PG8_BAR;
        { Unit ce = cur; ce.pm = __builtin_amdgcn_readfirstlane(cur.pm); ce.pn = __builtin_amdgcn_readfirstlane(cur.pn); ce.kind = __builtin_amdgcn_readfirstlane(cur.kind); ce.aux = __builtin_amdgcn_readfirstlane(cur.aux); int fr_ = fr, fq_ = fq;
          asm volatile("" : "+s"(ce.pm), "+s"(ce.pn), "+s"(ce.kind), "+s"(ce.aux), "+v"(fr_), "+v"(fq_));
          E(acc, ce, wr, wc, fr_, fq_); }
        if (!has_next) break;
#pragma unroll
        for (int a = 0; a < 2; ++a)
#pragma unroll
            for (int b = 0; b < 2; ++b)
#pragma unroll
                for (int m = 0; m < 4; ++m)
#pragma unroll
                    for (int n = 0; n < 2; ++n) acc[a][b][m][n] = (f32x4){0.f, 0.f, 0.f, 0.f};
        cur = nxt; cA = nA; cB = nB; ++ui;
        if (wr == 1) PG8_BAR;
    }
    PG8_WAIT_V(0);
    PG8_BAR;
#undef PG8_SA
#undef PG8_SB
#undef PG8_STAGE
#undef PG8_LDA
#undef PG8_LDB
#undef PG8_MMA
#undef PG8_WAIT_V
#undef PG8_WAIT_L
#undef PG8_BAR
#undef PG8_SCHED
}
}
constexpr int D = 1024, NB = 4, S = 4096, M = NB * S, DEPTH = 4, INW = 2560;
constexpr float DN_ALPHA = 1.681792830507429f;
constexpr float QSCALE = 0.125f * 1.4426950408889634f;
constexpr int NWAVES = 8;
constexpr size_t MiB = 1u << 20;
constexpr size_t TILEB = (size_t)256 * D * 2;
constexpr size_t WS_CTL = 0, CTL_ZERO_BYTES = 1 * MiB;
constexpr size_t WS_CS = 1 * MiB;
constexpr size_t WS_WIN = 2 * MiB, WIN_LAYER = 5 * MiB;
constexpr size_t WS_XB = 22 * MiB;
constexpr size_t WS_QKP = 118 * MiB;
constexpr size_t WS_UVT = 158 * MiB;
constexpr size_t WS_MIXB = 198 * MiB;
constexpr size_t WS_STASH = 54 * MiB;
constexpr size_t WS_WOUT = 383 * MiB, WOUT_LAYER = 2 * MiB;
constexpr size_t WS_TOKIDX = 391 * MiB, WS_GATE = 392 * MiB;
constexpr size_t WS_YMOE = WS_QKP;
constexpr size_t WS_YP = 86 * MiB;
constexpr size_t WS_ACT = 230 * MiB;
constexpr size_t WS_WBUF = 288 * MiB, WBUF_STRIDE = 35 * MiB, WB_W13 = 0, WB_W2 = 16 * MiB, WB_WG = 24 * MiB, WB_WP = 26 * MiB, WB_PB = 27 * MiB;
constexpr size_t WS_KF = 262 * MiB, WS_PS = 278 * MiB, WS_HT = 280 * MiB;
constexpr size_t WS_WR = 256 * MiB;
constexpr int CW_BAR = 4096, CW_CNT = 8192, CNT_STRIDE = 64;

#define GAS __attribute__((address_space(1)))
#define LAS __attribute__((address_space(3)))
typedef unsigned short bf16;
typedef unsigned v4u __attribute__((ext_vector_type(4)));
typedef float f32x4 __attribute__((ext_vector_type(4)));
typedef short bf16x8 __attribute__((ext_vector_type(8)));
typedef GAS unsigned gu32;
typedef GAS unsigned long long gu64;
#define RLX_AGENT __ATOMIC_RELAXED, __HIP_MEMORY_SCOPE_AGENT
#define LDS_WAIT() asm volatile("s_waitcnt lgkmcnt(0)" ::: "memory")
#define VM_WAIT() asm volatile("s_waitcnt vmcnt(0)" ::: "memory")
__device__ __forceinline__ unsigned long long rt() { return __builtin_amdgcn_s_memrealtime(); }
__device__ __forceinline__ unsigned f2bf(float f) { unsigned u = __builtin_bit_cast(unsigned, f); return (u + 0x7fffu + ((u >> 16) & 1u)) >> 16; }
__device__ __forceinline__ unsigned pk2(float lo, float hi) { return f2bf(lo) | (f2bf(hi) << 16); }

#define XB_TMO      128
#define XB_XCNT(j)  (256  + 64 * (j))
#define XB_XSUB(j)  (1280 + 64 * (j))
#define XB_XGEN(j)  (2304 + 64 * (j))
#define XB_TOP      3328
#define XB_TOPGEN   3392
#define XCD_BAR_WORDS 3456
#define XB_SPIN_CAP (1u << 18)

__device__ __forceinline__ unsigned xb_ld(unsigned* p)              { return __hip_atomic_load(p, __ATOMIC_RELAXED, __HIP_MEMORY_SCOPE_AGENT); }
__device__ __forceinline__ unsigned xb_add(unsigned* p, unsigned v) { return __hip_atomic_fetch_add(p, v, __ATOMIC_RELAXED, __HIP_MEMORY_SCOPE_AGENT); }
__device__ __forceinline__ unsigned xb_xcc_id() { return (unsigned)__builtin_amdgcn_s_getreg((3 << 11) | 20) & 0xFu; }
#define XB_SPIN(cond, bar) do { unsigned _sp = 0; while (cond) { __builtin_amdgcn_s_sleep(1); \
    if ((++_sp & 255u) == 0u) { if (xb_ld(&(bar)[XB_TMO])) break; if (_sp > XB_SPIN_CAP) { atomicAdd(&(bar)[XB_TMO], 1u); break; } } } } while (0)

struct XcdBarrier {
    unsigned* bar; unsigned x;
    volatile LAS unsigned* st;
};

__device__ __forceinline__ unsigned mk_lane_id() { unsigned x; asm volatile("v_mbcnt_lo_u32_b32 %0, -1, 0\n\tv_mbcnt_hi_u32_b32 %0, -1, %0" : "=v"(x)); return x; }
__device__ __forceinline__ XcdBarrier xcd_barrier_post(unsigned* bar, volatile LAS unsigned* st, int wave) {
    XcdBarrier b; b.bar = bar; b.x = xb_xcc_id(); b.st = st;
    if (wave == 0 && mk_lane_id() == 0u) (void)xb_add(&bar[XB_XCNT(b.x)], 1u);
    return b;
}
__device__ __forceinline__ void xcd_barrier_complete(unsigned* bar, unsigned x, unsigned& nloc, unsigned& nx) {
    const unsigned G = gridDim.x * gridDim.y * gridDim.z;
    unsigned sum, cnt, mine, sp = 0u;
    for (;;) {
        sum = 0u; cnt = 0u; mine = 0u;
#pragma unroll
        for (unsigned j = 0; j < 16; ++j) { const unsigned c = xb_ld(&bar[XB_XCNT(j)]); sum += c; cnt += (c > 0u) ? 1u : 0u; mine = (j == x) ? c : mine; }
        if (sum == G) break;
        __builtin_amdgcn_s_sleep(1);
        if ((++sp & 255u) == 0u) { if (xb_ld(&bar[XB_TMO])) break; if (sp > XB_SPIN_CAP) { atomicAdd(&bar[XB_TMO], 1u); break; } }
    }
    nloc = mine > 0u ? mine : 1u; nx = cnt > 0u ? cnt : 1u;
}

__device__ __forceinline__ void xcd_barrier(const XcdBarrier& b, int wave) {
    asm volatile("" : "+s"(wave));
    const bool t0_ = (wave == 0) && (mk_lane_id() == 0u);
    asm volatile("s_waitcnt vmcnt(0)" ::: "memory");
    __syncthreads();
    if (t0_) {
        unsigned* bar = b.bar; unsigned bx_ = b.x; asm volatile("" : "+s"(bx_));
        __builtin_amdgcn_s_waitcnt(0);
        unsigned nloc = b.st[0], nx = b.st[1];
        if (nloc == 0u) { xcd_barrier_complete(bar, bx_, nloc, nx); b.st[0] = nloc; b.st[1] = nx; }
        const unsigned old = xb_add(&bar[XB_XSUB(bx_)], 1u);
        const unsigned gen = old / nloc;
        if (old + 1u == (gen + 1u) * nloc) {
            __builtin_amdgcn_fence(__ATOMIC_RELEASE, "agent");
            asm volatile("s_waitcnt vmcnt(0)" ::: "memory");
            const unsigned og = xb_add(&bar[XB_TOP], 1u);
            const unsigned tg = og / nx;
            if (og + 1u == (tg + 1u) * nx) xb_add(&bar[XB_TOPGEN], 1u);
            else XB_SPIN(xb_ld(&bar[XB_TOPGEN]) == tg, bar);
            __builtin_amdgcn_fence(__ATOMIC_ACQUIRE, "agent");
            xb_add(&bar[XB_XGEN(bx_)], 1u);
            asm volatile("s_waitcnt vmcnt(0)" ::: "memory");
        } else {
            XB_SPIN(xb_ld(&bar[XB_XGEN(bx_)]) == gen, bar);
            __builtin_amdgcn_fence(__ATOMIC_ACQUIRE, "agent");
            asm volatile("s_waitcnt vmcnt(0)" ::: "memory");
        }
    }
    __syncthreads();
}
__device__ __forceinline__ float bf2f(unsigned short b) { return __uint_as_float((unsigned)b << 16); }
#define MK_DPP(v, ctrl) __uint_as_float(__builtin_amdgcn_update_dpp(0, __float_as_uint(v), (ctrl), 0xF, 0xF, true))
__device__ __forceinline__ float xsum16(float v) { const auto r = __builtin_amdgcn_permlane16_swap(__float_as_uint(v), __float_as_uint(v), false, false); return __uint_as_float(r[0]) + __uint_as_float(r[1]); }
__device__ __forceinline__ float xsum32(float v) { const auto r = __builtin_amdgcn_permlane32_swap(__float_as_uint(v), __float_as_uint(v), false, false); return __uint_as_float(r[0]) + __uint_as_float(r[1]); }
__device__ __forceinline__ float wave_sum(float v) {
    v += MK_DPP(v, 0xB1); v += MK_DPP(v, 0x4E);
    v += MK_DPP(v, 0x141); v += MK_DPP(v, 0x140);
    return xsum32(xsum16(v));
}
__device__ __forceinline__ void p0_transpose_block(const float* W, int K, int N, int k0, int n0, bf16* WT, int mode, LAS float* scr, int lane) {
#pragma unroll 4
    for (int i = 0; i < 32; ++i) { const int kk = 2 * i + (lane >> 5); scr[kk * 33 + (lane & 31)] = W[(size_t)(k0 + kk) * N + n0 + (lane & 31)]; }
    LDS_WAIT(); asm volatile("" ::: "memory");
    const int c = lane & 7;
#pragma unroll 1
    for (int j = 0; j < 4; ++j) { const int n = (lane >> 3) + 8 * j; const LAS float* s = scr + (8 * c) * 33 + n;
        v4u o; o.x = pk2(s[0 * 33], s[1 * 33]); o.y = pk2(s[2 * 33], s[3 * 33]); o.z = pk2(s[4 * 33], s[5 * 33]); o.w = pk2(s[6 * 33], s[7 * 33]);
        const int f = n0 + n; const size_t drow = mode == 0 ? (size_t)n : (size_t)(8 * (f >> 2) + (f & 3) + (mode == 2 ? 4 : 0));
        *(GAS v4u*)(WT + drow * K + k0 + 8 * c) = o; }
    LDS_WAIT(); asm volatile("" ::: "memory");
}
template <class TX> __device__ __forceinline__ void ln_row(const TX* x0, float a, const bf16* y1, const bf16* y2, const bf16* y3, const float* g, const float* b, float* of, bf16* ob, int lane) {
    f32x4 v[4]; float s = 0.f;
#pragma unroll
    for (int j = 0; j < 4; ++j) { const int c = 4 * lane + 256 * j;
        if constexpr (sizeof(TX) == 4) v[j] = *(const GAS f32x4*)(x0 + c) * a;
        else { const unsigned long long w = *(const GAS unsigned long long*)(x0 + c); v[j] = (f32x4){bf2f((bf16)w), bf2f((bf16)(w >> 16)), bf2f((bf16)(w >> 32)), bf2f((bf16)(w >> 48))} * a; }
        if (y1) { const unsigned long long w = *(const GAS unsigned long long*)(y1 + c); v[j] += (f32x4){bf2f((bf16)w), bf2f((bf16)(w >> 16)), bf2f((bf16)(w >> 32)), bf2f((bf16)(w >> 48))}; }
        if (y2) { const unsigned long long w = *(const GAS unsigned long long*)(y2 + c); v[j] += (f32x4){bf2f((bf16)w), bf2f((bf16)(w >> 16)), bf2f((bf16)(w >> 32)), bf2f((bf16)(w >> 48))}; }
        if (y3) { const unsigned long long w = *(const GAS unsigned long long*)(y3 + c); v[j] += (f32x4){bf2f((bf16)w), bf2f((bf16)(w >> 16)), bf2f((bf16)(w >> 32)), bf2f((bf16)(w >> 48))}; }
        s += (v[j].x + v[j].y) + (v[j].z + v[j].w); }
    const float mean = wave_sum(s) * (1.f / D); float s2 = 0.f;
#pragma unroll
    for (int j = 0; j < 4; ++j) { v[j] = v[j] - mean; s2 += (v[j].x * v[j].x + v[j].y * v[j].y) + (v[j].z * v[j].z + v[j].w * v[j].w); }
    const float rstd = __builtin_amdgcn_rsqf(wave_sum(s2) * (1.f / D) + 1e-5f);
#pragma unroll
    for (int j = 0; j < 4; ++j) { const int c = 4 * lane + 256 * j; const f32x4 o = v[j] * rstd * *(const GAS f32x4*)(g + c) + *(const GAS f32x4*)(b + c);
        if (of) *(GAS f32x4*)(of + c) = o;
        if (ob) *(GAS unsigned long long*)(ob + c) = (unsigned long long)pk2(o.x, o.y) | ((unsigned long long)pk2(o.z, o.w) << 32); }
}

struct SchedIn {
    int vcu, G; const char* xb; const char* wsw; const char* wnm;
    __device__ __forceinline__ bool next(int i, pg8::Unit& u) const {
        const int L = i * G + vcu; if (L >= 640) return false;
        const int t = L / 10, j = L % 10;
        const int sw = __builtin_amdgcn_readfirstlane((unsigned)(j + 27) >> 5);
        const int jj = j - 5 * sw; const char* tp = xb + (size_t)t * TILEB; const char* wp = (sw ? wsw : wnm) + (size_t)jj * TILEB;
        u.kind = sw; u.pm = sw ? jj : t; u.pn = sw ? t : jj; u.A = sw ? wp : tp; u.B = sw ? tp : wp;
        u.aux = 0; return true;
    }
};
struct EpiIn {
    static constexpr bool PERM = true;
    bf16* qkp; bf16* uvt; const float* cs;
    __device__ __forceinline__ void operator()(const pg8::f32x4 (&acc)[2][2][4][2], const pg8::Unit& u, int wr, int wc, int fr, int fq) const {
        bf16* base = u.kind == 0 ? qkp : uvt; const int ldc = u.kind == 0 ? 1280 : M;
        const int row0 = u.pm * 256 + wr * 64 + fr, col0 = u.pn * 256 + wc * 32 + 8 * fq;
        const bool rope = (u.kind == 0) && (u.pn < 4) && ((wc & 1) == 0);
        const float sc = (u.kind == 0 && u.pn < 2) ? QSCALE : 1.f;
        const float sgn = fq == 0 ? -1.f : 1.f;
        const bool vperm = (u.kind == 1) && (u.pm >= 3);
#pragma unroll
        for (int ai = 0; ai < 2; ++ai)
#pragma unroll
            for (int m = 0; m < 4; ++m) { const int row = row0 + ai * 128 + m * 16; bf16* rowp = base + (size_t)row * ldc + col0;
                f32x4 cv0 = {1.f, 1.f, 1.f, 1.f}, cv1 = cv0, sv0 = {0.f, 0.f, 0.f, 0.f}, sv1 = sv0;
                if (rope && fq < 2) { const float* t = cs + (size_t)(row & (S - 1)) * 16; cv0 = *(const f32x4*)t; cv1 = *(const f32x4*)(t + 4); sv0 = *(const f32x4*)(t + 8) * sgn; sv1 = *(const f32x4*)(t + 12) * sgn; }
#pragma unroll
                for (int bj = 0; bj < 2; ++bj) { f32x4 v0 = acc[ai][bj][m][0], v1 = acc[ai][bj][m][1];
                    if (rope) { f32x4 p0, p1;
#pragma unroll
                        for (int e = 0; e < 4; ++e) { const auto r0 = __builtin_amdgcn_permlane16_swap(__float_as_uint(v0[e]), __float_as_uint(v0[e]), false, false), r1 = __builtin_amdgcn_permlane16_swap(__float_as_uint(v1[e]), __float_as_uint(v1[e]), false, false);
                            p0[e] = __uint_as_float((fq & 1) ? r0[0] : r0[1]); p1[e] = __uint_as_float((fq & 1) ? r1[0] : r1[1]); }
                        v0 = v0 * cv0 + p0 * sv0; v1 = v1 * cv1 + p1 * sv1; }
                    v0 = v0 * sc; v1 = v1 * sc;
                    pg8::u32x4 w; w.x = pg8::cvt_pk_bf16(v0[0], v0[1]); w.y = pg8::cvt_pk_bf16(v0[2], v0[3]); w.z = pg8::cvt_pk_bf16(v1[0], v1[1]); w.w = pg8::cvt_pk_bf16(v1[2], v1[3]);
                    if (vperm) {
                        bf16* gp = rowp + bj * 128 - (fq & 1) * 8;
                        typedef unsigned u32x2 __attribute__((ext_vector_type(2)));
                        *(u32x2*)(gp + ((fq & 1) ? 4 : 0)) = (u32x2){w.x, w.y}; *(u32x2*)(gp + ((fq & 1) ? 12 : 8)) = (u32x2){w.z, w.w};
                    } else *(pg8::u32x4*)(rowp + bj * 128) = w; } }
    }
};

struct SchedOut {
    int vcu, G; const char* a; const char* w;
    __device__ __forceinline__ bool next(int i, pg8::Unit& u) const {
        const int L = i * G + vcu; if (L >= 256) return false;
        u.kind = 0; u.pm = L >> 2; u.pn = L & 3; u.aux = 0; u.A = a + (size_t)u.pm * TILEB; u.B = w + (size_t)u.pn * TILEB; return true;
    }
};
struct EpiRes {
    static constexpr bool PERM = true;
    bf16* XB;
    __device__ __forceinline__ void operator()(const pg8::f32x4 (&acc)[2][2][4][2], const pg8::Unit& u, int wr, int wc, int fr, int fq) const {
        const int row0 = u.pm * 256 + wr * 64 + fr, col0 = u.pn * 256 + wc * 32 + 8 * fq;
#pragma unroll
        for (int ai = 0; ai < 2; ++ai)
#pragma unroll
            for (int m = 0; m < 4; ++m) { bf16* rowp = XB + (size_t)(row0 + ai * 128 + m * 16) * D + col0;
#pragma unroll
                for (int bj = 0; bj < 2; ++bj) { pg8::u32x4* p = (pg8::u32x4*)(rowp + bj * 128); const pg8::u32x4 x = *p; const pg8::f32x4 v0 = acc[ai][bj][m][0], v1 = acc[ai][bj][m][1];
                    pg8::u32x4 w; w.x = pg8::cvt_pk_bf16(bf2f((bf16)x.x) * DN_ALPHA + v0[0], bf2f((bf16)(x.x >> 16)) * DN_ALPHA + v0[1]); w.y = pg8::cvt_pk_bf16(bf2f((bf16)x.y) * DN_ALPHA + v0[2], bf2f((bf16)(x.y >> 16)) * DN_ALPHA + v0[3]);
                    w.z = pg8::cvt_pk_bf16(bf2f((bf16)x.z) * DN_ALPHA + v1[0], bf2f((bf16)(x.z >> 16)) * DN_ALPHA + v1[1]); w.w = pg8::cvt_pk_bf16(bf2f((bf16)x.w) * DN_ALPHA + v1[2], bf2f((bf16)(x.w >> 16)) * DN_ALPHA + v1[3]);
                    *p = w; } }
    }
};
struct RouteLds { unsigned lcnt[16]; unsigned gbase[16]; int e0[64], e1[64]; unsigned r0[64], r1[64]; float g0[64], g1[64]; };
constexpr int RT_PITCH = 2052;
__device__ __forceinline__ void ln1_router_chunk(LAS RouteLds* R, LAS unsigned char* tile, int row0, bf16* XB, const float* g, const float* b, const float* wgc, const float* bgc, const float* wgf, const float* bgf,
                                                 gu32* cnt, int* tokidx, float* gate, int wave, int lane) {
    const int tidl = wave * 64 + lane;
    if (tidl < 16) R->lcnt[tidl] = 0u;
#pragma unroll 2
    for (int r = 0; r < 8; ++r) { const int rl = wave * 8 + r; bf16* xbrow = XB + (size_t)(row0 + rl) * D; f32x4 v[4]; float s = 0.f;
#pragma unroll
        for (int j = 0; j < 4; ++j) { const unsigned long long w = *(const GAS unsigned long long*)(xbrow + 4 * lane + 256 * j);
            v[j] = (f32x4){bf2f((bf16)w), bf2f((bf16)(w >> 16)), bf2f((bf16)(w >> 32)), bf2f((bf16)(w >> 48))}; s += (v[j].x + v[j].y) + (v[j].z + v[j].w); }
        const float mean = wave_sum(s) * (1.f / D); float s2 = 0.f;
#pragma unroll
        for (int j = 0; j < 4; ++j) { v[j] = v[j] - mean; s2 += (v[j].x * v[j].x + v[j].y * v[j].y) + (v[j].z * v[j].z + v[j].w * v[j].w); }
        const float rstd = __builtin_amdgcn_rsqf(wave_sum(s2) * (1.f / D) + 1e-5f);
#pragma unroll
        for (int j = 0; j < 4; ++j) { const int c = 4 * lane + 256 * j; const f32x4 o = v[j] * rstd * *(const GAS f32x4*)(g + c) + *(const GAS f32x4*)(b + c);
            const unsigned w0 = pk2(o.x, o.y), w1 = pk2(o.z, o.w);
            *(GAS unsigned long long*)(xbrow + c) = (unsigned long long)w0 | ((unsigned long long)w1 << 32);
            LAS unsigned* tp = (LAS unsigned*)(tile + rl * RT_PITCH + c * 2); tp[0] = w0; tp[1] = w1; } }
    LDS_WAIT(); __syncthreads();
    float acc[20];
#pragma unroll
    for (int i = 0; i < 20; ++i) acc[i] = 0.f;
    { LAS const unsigned* xr = (LAS const unsigned*)(tile + lane * RT_PITCH) + wave * 64;
      const float* wc = wgc + (size_t)wave * 128 * 4; const float* wf = wgf + (size_t)wave * 128 * 16;
#pragma unroll 2
      for (int kk = 0; kk < 64; ++kk) { const unsigned w = xr[kk]; const float x0 = __uint_as_float(w << 16), x1 = __uint_as_float(w & 0xffff0000u);
#pragma unroll
          for (int i = 0; i < 4; ++i) acc[i] += x0 * wc[(2 * kk) * 4 + i] + x1 * wc[(2 * kk + 1) * 4 + i];
#pragma unroll
          for (int i = 0; i < 16; ++i) acc[4 + i] += x0 * wf[(2 * kk) * 16 + i] + x1 * wf[(2 * kk + 1) * 16 + i]; } }
    LDS_WAIT(); __syncthreads();
    { LAS float* P = (LAS float*)tile + wave * (20 * 64) + lane;
#pragma unroll
      for (int i = 0; i < 20; ++i) P[i * 64] = acc[i]; }
    LDS_WAIT(); __syncthreads();
    if (wave == 0) {
        float my[20];
#pragma unroll
        for (int i = 0; i < 20; ++i) { float t = 0.f;
#pragma unroll
            for (int w = 0; w < 8; ++w) t += ((LAS const float*)tile)[w * (20 * 64) + i * 64 + lane];
            my[i] = t; }
        const int rl = lane;
        float pg[4], mx = -INFINITY, sum = 0.f;
#pragma unroll
        for (int j = 0; j < 4; ++j) { pg[j] = my[j] + bgc[j]; mx = fmaxf(mx, pg[j]); }
#pragma unroll
        for (int j = 0; j < 4; ++j) { pg[j] = expf(pg[j] - mx); sum += pg[j]; }
        int gi = 0; float gw = pg[0];
#pragma unroll
        for (int j = 1; j < 4; ++j) if (pg[j] > gw) { gw = pg[j]; gi = j; }
        gw /= sum;
        float fs[4]; mx = -INFINITY;
#pragma unroll
        for (int j = 0; j < 4; ++j) { float t = 0.f;
#pragma unroll
            for (int q = 0; q < 4; ++q) if (q == gi) t = my[4 + q * 4 + j] + bgf[q * 4 + j];
            fs[j] = t; mx = fmaxf(mx, t); }
#pragma unroll
        for (int j = 0; j < 4; ++j) fs[j] = expf(fs[j] - mx);
        int t0 = 0; float v0 = fs[0];
#pragma unroll
        for (int j = 1; j < 4; ++j) if (fs[j] > v0) { v0 = fs[j]; t0 = j; }
        int t1 = -1; float v1 = -1.f;
#pragma unroll
        for (int j = 0; j < 4; ++j) if (j != t0 && fs[j] > v1) { v1 = fs[j]; t1 = j; }
        const float ts = v0 + v1; const int e0 = gi * 4 + t0, e1 = gi * 4 + t1;
        R->e0[rl] = e0; R->e1[rl] = e1; R->g0[rl] = gw * (v0 / ts); R->g1[rl] = gw * (v1 / ts);
        R->r0[rl] = __hip_atomic_fetch_add(&R->lcnt[e0], 1u, __ATOMIC_RELAXED, __HIP_MEMORY_SCOPE_WORKGROUP);
        R->r1[rl] = __hip_atomic_fetch_add(&R->lcnt[e1], 1u, __ATOMIC_RELAXED, __HIP_MEMORY_SCOPE_WORKGROUP);
    }
    LDS_WAIT(); __syncthreads();
    if (tidl < 16) { const unsigned n = R->lcnt[tidl]; R->gbase[tidl] = n ? __hip_atomic_fetch_add(cnt + tidl * CNT_STRIDE, n, RLX_AGENT) : 0u; }
    LDS_WAIT(); __syncthreads();
    if (tidl < 64) { const int rl = tidl, tok = row0 + rl; const int e0 = R->e0[rl], e1 = R->e1[rl]; const unsigned p0 = R->gbase[e0] + R->r0[rl], p1 = R->gbase[e1] + R->r1[rl];
        tokidx[(size_t)e0 * M + p0] = tok * 2; gate[(size_t)e0 * M + p0] = R->g0[rl]; tokidx[(size_t)e1 * M + p1] = tok * 2 + 1; gate[(size_t)e1 * M + p1] = R->g1[rl]; }
    LDS_WAIT(); __syncthreads();
}

struct MoeTab { LAS const int* p;
    __device__ __forceinline__ int cnt(int e) const { return __builtin_amdgcn_readfirstlane(p[e]); }
    __device__ __forceinline__ int pre(int e) const { return __builtin_amdgcn_readfirstlane(p[16 + e]); } };
__device__ __forceinline__ void moe_tab_build(LAS int* p, const gu32* cnt, bool t0) {
    if (t0) { int acc = 0;
        for (int e = 0; e < 16; ++e) { const int c = (int)__hip_atomic_load(cnt + e * CNT_STRIDE, RLX_AGENT); p[e] = c; p[16 + e] = acc; acc += (c + 255) >> 8; }
        p[32] = acc; }
    __syncthreads();
}
template <int NPN> struct SchedMoe {
    int vcu, G; MoeTab T; const char* a; const char* w; size_t wexp  ; const int* tokidx; size_t atile  ;
    __device__ __forceinline__ bool next(int i, pg8::Unit& u) const {
        const int L = i * G + vcu; if (L >= T.pre(16) * NPN) return false;
        const int tile = L / NPN; u.pn = L % NPN; int e = 0;
#pragma unroll 1
        for (int q = 1; q < 16; ++q) if (tile >= T.pre(q)) e = q;
        u.aux = e; u.pm = tile - T.pre(e); u.kind = tile;
        u.A = a + (size_t)tile * atile; u.B = w + (size_t)e * wexp + (size_t)u.pn * 256 * (wexp / (NPN * 256)); return true;
    }
    __device__ __forceinline__ int arow(const pg8::Unit& u, int r) const {
        const int rank = u.pm * 256 + r; const int c = T.cnt(u.aux);
        return rank < c ? (tokidx[(size_t)u.aux * M + rank] >> 1) : 0;
    }
};
struct EpiMoe1 {
    static constexpr bool PERM = true;
    bf16* act; const float* gate; MoeTab T;
    __device__ __forceinline__ void operator()(const pg8::f32x4 (&acc)[2][2][4][2], const pg8::Unit& u, int wr, int wc, int fr, int fq) const {
        const int cnt = T.cnt(u.aux);
#pragma unroll
        for (int ai = 0; ai < 2; ++ai)
#pragma unroll
            for (int m = 0; m < 4; ++m) { const int r = ai * 128 + wr * 64 + m * 16 + fr, rank = u.pm * 256 + r;
                const float gt = rank < cnt ? gate[(size_t)u.aux * M + rank] : 0.f;
                bf16* rowp = act + ((size_t)u.kind * 256 + r) * 256 + u.pn * 128 + wc * 16 + 4 * fq;
#pragma unroll
                for (int bj = 0; bj < 2; ++bj) { const pg8::f32x4 av = acc[ai][bj][m][0], cv = acc[ai][bj][m][1]; float y[4];
#pragma unroll
                    for (int e = 0; e < 4; ++e) y[e] = av[e] * __builtin_amdgcn_rcpf(1.f + __builtin_amdgcn_exp2f(av[e] * -1.4426950408889634f)) * cv[e] * gt;
                    *(unsigned long long*)(rowp + bj * 64) = (unsigned long long)pg8::cvt_pk_bf16(y[0], y[1]) | ((unsigned long long)pg8::cvt_pk_bf16(y[2], y[3]) << 32); } }
    }
};
struct EpiMoe2 {
    static constexpr bool PERM = true;
    bf16* ymoe; const int* tokidx; MoeTab T;
    __device__ __forceinline__ void operator()(const pg8::f32x4 (&acc)[2][2][4][2], const pg8::Unit& u, int wr, int wc, int fr, int fq) const {
        const int cnt = T.cnt(u.aux);
#pragma unroll
        for (int ai = 0; ai < 2; ++ai)
#pragma unroll
            for (int m = 0; m < 4; ++m) { const int r = ai * 128 + wr * 64 + m * 16 + fr, rank = u.pm * 256 + r;
                if (rank < cnt) { bf16* rowp = ymoe + (size_t)tokidx[(size_t)u.aux * M + rank] * D + u.pn * 256 + wc * 32 + 8 * fq;
#pragma unroll
                    for (int bj = 0; bj < 2; ++bj) { const pg8::f32x4 v0 = acc[ai][bj][m][0], v1 = acc[ai][bj][m][1];
                        pg8::u32x4 w; w.x = pg8::cvt_pk_bf16(v0[0], v0[1]); w.y = pg8::cvt_pk_bf16(v0[2], v0[3]); w.z = pg8::cvt_pk_bf16(v1[0], v1[1]); w.w = pg8::cvt_pk_bf16(v1[2], v1[3]);
                        *(pg8::u32x4*)(rowp + bj * 128) = w; } } }
    }
};
struct SchedSq {
    int vcu, G; const char* a; const char* w; size_t astep, wstep; int vfirst;
    __device__ __forceinline__ bool next(int i, pg8::Unit& u) const {
        if (vcu < vfirst || vcu >= vfirst + G) return false;
        const int L = i * G + (vcu - vfirst); if (L >= 256) return false;
        u.kind = 0; u.pm = L >> 2; u.pn = L & 3; u.aux = 0; u.A = a + (size_t)u.pm * astep; u.B = w + (size_t)u.pn * wstep; return true;
    }
};
template <int GATED> struct EpiPle {
    static constexpr bool PERM = true;
    bf16* yp; const float* bg;
    __device__ __forceinline__ void operator()(const pg8::f32x4 (&acc)[2][2][4][2], const pg8::Unit& u, int wr, int wc, int fr, int fq) const {
        const int row0 = u.pm * 256 + wr * 64 + fr, col0 = u.pn * 256 + wc * 32 + 8 * fq;
#pragma unroll
        for (int ai = 0; ai < 2; ++ai)
#pragma unroll
            for (int m = 0; m < 4; ++m) { bf16* rowp = yp + (size_t)(row0 + ai * 128 + m * 16) * D + col0;
#pragma unroll
                for (int bj = 0; bj < 2; ++bj) { pg8::f32x4 v0 = acc[ai][bj][m][0], v1 = acc[ai][bj][m][1];
                    if (GATED) { const pg8::f32x4 b0 = *(const pg8::f32x4*)(bg + col0 + bj * 128), b1 = *(const pg8::f32x4*)(bg + col0 + bj * 128 + 4); const pg8::u32x4 y = *(const pg8::u32x4*)(rowp + bj * 128);
                        const float yf[8] = {bf2f((bf16)y.x), bf2f((bf16)(y.x >> 16)), bf2f((bf16)y.y), bf2f((bf16)(y.y >> 16)), bf2f((bf16)y.z), bf2f((bf16)(y.z >> 16)), bf2f((bf16)y.w), bf2f((bf16)(y.w >> 16))};
#pragma unroll
                        for (int e = 0; e < 4; ++e) { v0[e] = yf[e] * __builtin_amdgcn_rcpf(1.f + __builtin_amdgcn_exp2f((v0[e] + b0[e]) * -1.4426950408889634f)); v1[e] = yf[4 + e] * __builtin_amdgcn_rcpf(1.f + __builtin_amdgcn_exp2f((v1[e] + b1[e]) * -1.4426950408889634f)); } }
                    pg8::u32x4 w; w.x = pg8::cvt_pk_bf16(v0[0], v0[1]); w.y = pg8::cvt_pk_bf16(v0[2], v0[3]); w.z = pg8::cvt_pk_bf16(v1[0], v1[1]); w.w = pg8::cvt_pk_bf16(v1[2], v1[3]);
                    *(pg8::u32x4*)(rowp + bj * 128) = w; } }
    }
};
namespace att {
typedef float f32x16 __attribute__((ext_vector_type(16)));
constexpr int KSLOT = 8192, VSLOT = 16384, LDS_K = 0, LDS_V = 2 * KSLOT, ATT_LDS = 2 * KSLOT + 2 * VSLOT;
__device__ __forceinline__ bf16x8 pack8(const f32x16& p, int b) {
    v4u w; w.x = pg8::cvt_pk_bf16(p[b], p[b + 1]); w.y = pg8::cvt_pk_bf16(p[b + 2], p[b + 3]); w.z = pg8::cvt_pk_bf16(p[b + 4], p[b + 5]); w.w = pg8::cvt_pk_bf16(p[b + 6], p[b + 7]);
    return __builtin_bit_cast(bf16x8, w);
}
constexpr float THR2 = 8.f;
__device__ __forceinline__ void qkt(f32x16& p0, f32x16& p1, LAS const unsigned char* ks, const bf16x8 (&qf)[4], int r32, int hi) {
#pragma unroll
    for (int r = 0; r < 16; ++r) { p0[r] = 0.f; p1[r] = 0.f; }
    LAS const unsigned char* kb = ks + hi * 1024 + r32 * 16;
#pragma unroll
    for (int kk = 0; kk < 4; ++kk) {
        const bf16x8 a0 = *(LAS const bf16x8*)(kb + kk * 2048), a1 = *(LAS const bf16x8*)(kb + kk * 2048 + 512);
        p0 = __builtin_amdgcn_mfma_f32_32x32x16_bf16(a0, qf[kk], p0, 0, 0, 0);
        p1 = __builtin_amdgcn_mfma_f32_32x32x16_bf16(a1, qf[kk], p1, 0, 0, 0);
    }
}
__device__ __forceinline__ void partialSM(f32x16& p0, f32x16& p1, float& m, float& alpha) {
    float pmax = fmaxf(p0[0], p1[0]);
#pragma unroll
    for (int r = 1; r < 16; ++r) pmax = fmaxf(pmax, fmaxf(p0[r], p1[r]));
    { const auto rr = __builtin_amdgcn_permlane32_swap(__float_as_uint(pmax), __float_as_uint(pmax), false, false); pmax = fmaxf(__uint_as_float(rr[0]), __uint_as_float(rr[1])); }
    if (__builtin_expect(__all(pmax - m <= THR2), 1)) alpha = 1.f;
    else { const float mn = fmaxf(m, pmax); alpha = __builtin_amdgcn_exp2f(m - mn); m = mn; }
    const float mm = m;
#pragma unroll
    for (int r = 0; r < 16; ++r) { p0[r] = __builtin_amdgcn_exp2f(p0[r] - mm); p1[r] -= mm; }
}
__device__ __forceinline__ void finishSM(f32x16& p0, f32x16& p1, float alpha, float& l, bf16x8 (&pf)[4]) {
    float ps = 0.f;
#pragma unroll
    for (int r = 0; r < 16; ++r) { p1[r] = __builtin_amdgcn_exp2f(p1[r]); ps += p0[r] + p1[r]; }
    l = l * alpha + ps;
    pf[0] = pack8(p0, 0); pf[1] = pack8(p0, 8); pf[2] = pack8(p1, 0); pf[3] = pack8(p1, 8);
}
__device__ __forceinline__ void pv(f32x16 (&o)[4], LAS const unsigned char* vs, const bf16x8 (&pf)[4], int r32, int hi) {
    LAS const unsigned char* vb = vs + hi * 2048 + r32 * 16;
#pragma unroll
    for (int db = 0; db < 4; ++db) {
        bf16x8 va[4];
#pragma unroll
        for (int s = 0; s < 4; ++s) va[s] = *(LAS const bf16x8*)(vb + s * 4096 + db * 512);
#pragma unroll
        for (int s = 0; s < 4; ++s) o[db] = __builtin_amdgcn_mfma_f32_32x32x16_bf16(va[s], pf[s], o[db], 0, 0, 0);
        __builtin_amdgcn_sched_group_barrier(0x100, 4, 0); __builtin_amdgcn_sched_group_barrier(0x8, 4, 0);
    }
}
__device__ __forceinline__ void resc(f32x16 (&o)[4], float alpha) {
    if (__any(alpha < 1.f)) {
#pragma unroll
        for (int db = 0; db < 4; ++db)
#pragma unroll
            for (int r = 0; r < 16; ++r) o[db][r] *= alpha;
    }
}
__device__ __forceinline__ void unit(LAS unsigned char* lds, int b, int h, int qb, const bf16* QKP, const bf16* UVT, float lam, float lam_init, const float* subg, bf16* MIXB, float* stash, int wave, int lane) {
    asm volatile("" : "+v"(lane));
    const int r32 = lane & 31, hi = lane >> 5;
    const size_t tok0 = (size_t)b * S;
    const size_t qtok = tok0 + qb * 256 + wave * 32 + r32;
    constexpr int NT = S / 64;
#pragma unroll 1
    for (int c = 0; c < 2; ++c) {
        bf16x8 qf[4];
#pragma unroll
        for (int kk = 0; kk < 4; ++kk) qf[kk] = *(const GAS bf16x8*)(QKP + qtok * 1280 + h * 128 + c * 64 + kk * 16 + hi * 8);
        f32x16 o[4];
#pragma unroll
        for (int db = 0; db < 4; ++db)
#pragma unroll
            for (int r = 0; r < 16; ++r) o[db][r] = 0.f;
        float m = -INFINITY, l = 0.f, alA, alB;
        f32x16 pA0, pA1, pB0, pB1; bf16x8 pf[4];
        const char* kub = (const char*)(QKP + tok0 * 1280 + 512 + h * 128 + c * 64 + wave * 8);
        const char* vub = (const char*)(UVT + (size_t)(768 + h * 128) * M + tok0 + wave * 8);
        const unsigned kvo = (unsigned)lane * 2560u, vvo = (unsigned)lane * (unsigned)(M * 2);
#define ATT_DMA_K(t) __builtin_amdgcn_global_load_lds((const unsigned*)(kub + (size_t)(t) * (64 * 2560) + kvo), (LAS unsigned*)(lds + LDS_K + ((t) & 1) * KSLOT + wave * 1024), 16, 0, 0)
#define ATT_DMA_V(t) do { \
            __builtin_amdgcn_global_load_lds((const unsigned*)(vub + (size_t)(t) * 128 + vvo), (LAS unsigned*)(lds + LDS_V + ((t) & 1) * VSLOT + wave * 2048), 16, 0, 0); \
            __builtin_amdgcn_global_load_lds((const unsigned*)(vub + (size_t)64 * M * 2 + (size_t)(t) * 128 + vvo), (LAS unsigned*)(lds + LDS_V + ((t) & 1) * VSLOT + wave * 2048 + 1024), 16, 0, 0); } while (0)
#define SB() __builtin_amdgcn_sched_barrier(0)
#define ATT_SYNC() do { asm volatile("s_waitcnt vmcnt(0) lgkmcnt(0)" ::: "memory"); __builtin_amdgcn_s_barrier(); asm volatile("" ::: "memory"); } while (0)
        const bool early = wave < 4;
        ATT_SYNC();
        ATT_DMA_K(0); ATT_DMA_V(0);
        ATT_SYNC();
        ATT_DMA_K(1);
        qkt(pA0, pA1, lds + LDS_K, qf, r32, hi); partialSM(pA0, pA1, m, alA);
#pragma unroll 1
        for (int j = 1; j < NT - 1; j += 2) {
            ATT_SYNC(); if (early) { ATT_DMA_K(j + 1); ATT_DMA_V(j); }
            SB(); qkt(pB0, pB1, lds + LDS_K + KSLOT, qf, r32, hi); finishSM(pA0, pA1, alA, l, pf); SB();
            if (!early) { ATT_DMA_K(j + 1); ATT_DMA_V(j); }
            pv(o, lds + LDS_V, pf, r32, hi); partialSM(pB0, pB1, m, alB); SB(); resc(o, alB);
            ATT_SYNC(); if (early) { ATT_DMA_K(j + 2); ATT_DMA_V(j + 1); }
            SB(); qkt(pA0, pA1, lds + LDS_K, qf, r32, hi); finishSM(pB0, pB1, alB, l, pf); SB();
            if (!early) { ATT_DMA_K(j + 2); ATT_DMA_V(j + 1); }
            pv(o, lds + LDS_V + VSLOT, pf, r32, hi); partialSM(pA0, pA1, m, alA); SB(); resc(o, alA);
        }
        ATT_SYNC(); ATT_DMA_V(NT - 1);
        SB(); qkt(pB0, pB1, lds + LDS_K + KSLOT, qf, r32, hi); finishSM(pA0, pA1, alA, l, pf); SB();
        pv(o, lds + LDS_V, pf, r32, hi); partialSM(pB0, pB1, m, alB); SB(); resc(o, alB);
        ATT_SYNC();
        finishSM(pB0, pB1, alB, l, pf); pv(o, lds + LDS_V + VSLOT, pf, r32, hi);
#undef ATT_DMA_K
#undef ATT_DMA_V
#undef ATT_SYNC
#undef SB
        const float lt = xsum32(l);
        const int lane_e = (int)mk_lane_id();
        const int hi_e = lane_e >> 5; const size_t qtok_e = tok0 + qb * 256 + wave * 32 + (lane_e & 31);
        if (c == 0) {
            const float i1 = 1.f / lt;
#pragma unroll
            for (int db = 0; db < 4; ++db)
#pragma unroll
                for (int g4 = 0; g4 < 4; ++g4) *(GAS f32x4*)(stash + ((db * 4 + g4) * 64 + lane_e) * 4) = (f32x4){o[db][4 * g4] * i1, o[db][4 * g4 + 1] * i1, o[db][4 * g4 + 2] * i1, o[db][4 * g4 + 3] * i1};
        } else {
            const float i2 = lam / lt;
            float ss = 0.f;
#pragma unroll
            for (int db = 0; db < 4; ++db)
#pragma unroll
                for (int g4 = 0; g4 < 4; ++g4) { const f32x4 s1 = *(const GAS f32x4*)(stash + ((db * 4 + g4) * 64 + lane_e) * 4);
#pragma unroll
                    for (int i = 0; i < 4; ++i) { const float v = s1[i] - o[db][4 * g4 + i] * i2; o[db][4 * g4 + i] = v; ss += v * v; } }
            ss = xsum32(ss);
            const float rs = (1.f - lam_init) / sqrtf(ss * (1.f / 128.f) + 1e-5f);
            bf16* orow = MIXB + qtok_e * D + 256 + h * 128;
#pragma unroll
            for (int db = 0; db < 4; ++db)
#pragma unroll
                for (int g4 = 0; g4 < 4; ++g4) { const int e = 32 * db + 8 * g4 + 4 * hi_e; const f32x4 gg = *(const GAS f32x4*)(subg + e);
                    const unsigned long long w = (unsigned long long)pg8::cvt_pk_bf16(o[db][4 * g4] * rs * gg.x, o[db][4 * g4 + 1] * rs * gg.y) | ((unsigned long long)pg8::cvt_pk_bf16(o[db][4 * g4 + 2] * rs * gg.z, o[db][4 * g4 + 3] * rs * gg.w) << 32);
                    *(GAS unsigned long long*)(orow + e) = w; }
        }
    }
}
}
namespace hy {
typedef float f32x16 __attribute__((ext_vector_type(16)));
constexpr int CPY = 16456;
constexpr int LDS_F = 0, LDS_VV = 4 * CPY, LDS_END = LDS_VV + 32768;
static_assert(LDS_VV % 16 == 0 && LDS_END <= 131072, "hyena LDS map");

__device__ __forceinline__ void filter_item(LAS unsigned char* lds, int pb, const float* fw1, const float* fb1, const float* fr1, const float* fw2, const float* fb2, const float* fr2,
                                            const float* fw3, bf16* KF, float* PS, int wave, int lane) {
    LAS bf16* tile = (LAS bf16*)lds;
    LAS float* za = (LAS float*)(lds + 65536) + wave * 512;
    LAS float* zb = (LAS float*)(lds + 81920) + wave * 512;
    LAS float* sqs = (LAS float*)(lds + 98304);
    const int p0 = pb * 64 + wave * 8;
    if (lane < 33) {
#pragma unroll 1
        for (int pi = 0; pi < 8; ++pi) { const int p = p0 + pi; float z;
            if (lane == 0) z = (float)p / (float)(S - 1);
            else { const int bi = (lane - 1) & 15; const float band = 1e-4f + (float)bi * ((15.0f - 1e-4f) / 15.0f), wpos = 2.0f * 3.14159265358979323846f * (float)p / (float)S;
                   z = lane <= 16 ? cosf(wpos * band) : -sinf(wpos * band); }
            za[pi * 64 + lane] = z; }
    }
    LDS_WAIT(); asm volatile("" ::: "memory");
    float acc8[8];
    { const float b1 = fb1[lane];
#pragma unroll
      for (int pi = 0; pi < 8; ++pi) acc8[pi] = b1;
#pragma unroll 1
      for (int i = 0; i < 33; ++i) { const float w = fw1[i * 64 + lane];
#pragma unroll
          for (int pi = 0; pi < 8; ++pi) acc8[pi] += za[pi * 64 + i] * w; }
      const float f1 = fr1[lane];
#pragma unroll
      for (int pi = 0; pi < 8; ++pi) zb[pi * 64 + lane] = sinf(f1 * acc8[pi]); }
    LDS_WAIT(); asm volatile("" ::: "memory");
    { const float b2 = fb2[lane];
#pragma unroll
      for (int pi = 0; pi < 8; ++pi) acc8[pi] = b2;
#pragma unroll 1
      for (int i = 0; i < 64; ++i) { const float w = fw2[i * 64 + lane];
#pragma unroll
          for (int pi = 0; pi < 8; ++pi) acc8[pi] += zb[pi * 64 + i] * w; }
      const float f2 = fr2[lane];
      LDS_WAIT(); asm volatile("" ::: "memory");
#pragma unroll
      for (int pi = 0; pi < 8; ++pi) za[pi * 64 + lane] = sinf(f2 * acc8[pi]); }
    LDS_WAIT(); asm volatile("" ::: "memory");
    const float mind = logf(1e-2f) / 1.5f, maxd = logf(1e-2f) / 0.3f;
#pragma unroll 1
    for (int qh = 0; qh < 2; ++qh) {
        float ac[8][4];
#pragma unroll
        for (int pi = 0; pi < 8; ++pi)
#pragma unroll
            for (int q = 0; q < 4; ++q) ac[pi][q] = 0.f;
#pragma unroll 1
        for (int i = 0; i < 64; ++i) { float w[4];
#pragma unroll
            for (int q = 0; q < 4; ++q) w[q] = fw3[i * 512 + lane + 64 * (qh * 4 + q)];
#pragma unroll
            for (int pi = 0; pi < 8; ++pi) { const float hv = za[pi * 64 + i];
#pragma unroll
                for (int q = 0; q < 4; ++q) ac[pi][q] += hv * w[q]; } }
#pragma unroll
        for (int q = 0; q < 4; ++q) { const int col = lane + 64 * (qh * 4 + q), ch = col & 255; const float delta = fabsf(mind + (float)ch * ((maxd - mind) / 255.0f)); float sq = 0.f;
#pragma unroll
            for (int pi = 0; pi < 8; ++pi) { const int p = p0 + pi; const float val = ac[pi][q] * expf(-((float)p / (float)(S - 1)) * delta);
                if (!(col >= 256 && p == 0)) sq += val * val;
                tile[col * 64 + wave * 8 + pi] = (bf16)f2bf(val); }
            sqs[wave * 512 + col] = sq; }
    }
    LDS_WAIT(); __syncthreads();
    { const int p = pb * 64 + lane;
#pragma unroll 1
      for (int cc = 0; cc < 64; ++cc) { const int col = wave * 64 + cc; const bf16 v = tile[col * 64 + lane];
          if (col < 256) KF[(size_t)col * 8192 + 4095 - p] = v; else if (p != 0) KF[(size_t)(col - 256) * 8192 + 4095 + p] = v; } }
    { const int t = wave * 64 + lane; float s = 0.f;
#pragma unroll
      for (int w = 0; w < 8; ++w) s += sqs[w * 512 + t];
      PS[(size_t)pb * 512 + t] = s;
      if (pb == 0 && t < 256) KF[(size_t)t * 8192 + 8191] = 0; }
    LDS_WAIT(); __syncthreads();
}

__device__ __forceinline__ float conv1(float um, float u0, float up, float w0, float w1, float w2, float cb) { return um * w0 + u0 * w1 + up * w2 + cb; }

__device__ __forceinline__ void unit(LAS unsigned char* lds, int c, const bf16* KF, const float* PS, const bf16* UVT, const float* cw, const float* cb, const float* bias_d, bf16* HT, int wave, int lane) {
    asm volatile("" : "+s"(wave), "+v"(lane));
    const int tid = wave * 64 + lane;
    { const bf16* src = KF + (size_t)c * 8192;
#pragma unroll
      for (int i = 0; i < 2; ++i) { const int ch = tid + 512 * i; *(LAS v4u*)(lds + LDS_F + ch * 16) = *(const GAS v4u*)(src + ch * 8); } }
    { const float w0v = cw[512 + c], w1v = cw[768 + 512 + c], w2v = cw[1536 + 512 + c], cbv = cb[512 + c], w0x = cw[256 + c], w1x = cw[768 + 256 + c], w2x = cw[1536 + 256 + c], cbx = cb[256 + c];
      const bf16* rv = UVT + (size_t)(512 + c) * M; const bf16* rx = UVT + (size_t)(256 + c) * M;
#pragma unroll 1
      for (int i = 0; i < 4; ++i) { const int q = tid + 512 * i, b = q >> 9, sc = q & 511, s0 = sc * 8; const size_t g0 = (size_t)b * S + s0;
          const v4u av = *(const GAS v4u*)(rv + g0), ax = *(const GAS v4u*)(rx + g0);
          float uv[10], ux[10];
          uv[0] = s0 > 0 ? bf2f(rv[g0 - 1]) : 0.f; ux[0] = s0 > 0 ? bf2f(rx[g0 - 1]) : 0.f; uv[9] = s0 + 8 < S ? bf2f(rv[g0 + 8]) : 0.f; ux[9] = s0 + 8 < S ? bf2f(rx[g0 + 8]) : 0.f;
#pragma unroll
          for (int e = 0; e < 4; ++e) { uv[1 + 2 * e] = bf2f((bf16)av[e]); uv[2 + 2 * e] = bf2f((bf16)(av[e] >> 16)); ux[1 + 2 * e] = bf2f((bf16)ax[e]); ux[2 + 2 * e] = bf2f((bf16)(ax[e] >> 16)); }
          float o[8];
#pragma unroll
          for (int e = 0; e < 8; ++e) o[e] = conv1(uv[e], uv[e + 1], uv[e + 2], w0v, w1v, w2v, cbv) * conv1(ux[e], ux[e + 1], ux[e + 2], w0x, w1x, w2x, cbx);
          v4u w; w.x = pk2(o[0], o[1]); w.y = pk2(o[2], o[3]); w.z = pk2(o[4], o[5]); w.w = pk2(o[6], o[7]);
          *(LAS v4u*)(lds + LDS_VV + (((sc & 7) * 64 + (sc >> 3)) * 4 + b) * 16) = w; } }
    LDS_WAIT(); __syncthreads();
    {
#pragma unroll 1
      for (int i = 0; i < 4; ++i) { const int y = tid + 512 * i;
          const unsigned long long w0 = *(LAS const unsigned long long*)(lds + LDS_F + y * 8), w1 = *(LAS const unsigned long long*)(lds + LDS_F + y * 8 + 8);
#pragma unroll
          for (int p = 1; p < 4; ++p) *(LAS unsigned long long*)(lds + LDS_F + p * CPY + y * 8) = (w0 >> (16 * p)) | (w1 << (64 - 16 * p)); } }
    const float nrm = 1.0f / sqrtf(wave_sum(PS[(size_t)lane * 512 + c] + PS[(size_t)lane * 512 + 256 + c]) + 1e-6f);
    LDS_WAIT(); __syncthreads();
    const int r32 = lane & 31, hi = lane >> 5, gp = wave & 3, half = wave >> 2, iloc = r32 >> 2, b = r32 & 3;
    f32x16 acc[2][2];
#pragma unroll
    for (int rho = 0; rho < 2; ++rho)
#pragma unroll
        for (int gg = 0; gg < 2; ++gg)
#pragma unroll
            for (int r = 0; r < 16; ++r) acc[rho][gg][r] = 0.f;
    const int dlo = 16 * gp - 63 + (half ? 40 : 0), dn = half ? 39 : 40;
    int pa = LDS_F + (3 - (r32 & 3)) * CPY + (4092 - 4 * (r32 >> 2) + 8 * hi) * 2 - 64 - 128 * dlo;
    int jb = 16 * gp + iloc - dlo;
    const int pbase = LDS_VV + hi * 4096 + b * 16;
#pragma unroll 1
    for (int dd = 0; dd < dn; ++dd) {
        const int j0 = jb, j1 = jb + 8; const bool v0 = (unsigned)j0 < 64u, v1 = (unsigned)j1 < 64u;
        LAS const unsigned char* ap = lds + pa; LAS const unsigned char* bp0 = lds + pbase + (v0 ? j0 : 0) * 64; LAS const unsigned char* bp1 = lds + pbase + (v1 ? j1 : 0) * 64;
#pragma unroll
        for (int k = 0; k < 4; ++k) {
            typedef unsigned long long u64;
            const u64 a00 = *(LAS const u64*)(ap + 64 + 32 * k), a01 = *(LAS const u64*)(ap + 64 + 32 * k + 8), a10 = *(LAS const u64*)(ap + 32 * k), a11 = *(LAS const u64*)(ap + 32 * k + 8);
            v4u b0 = *(LAS const v4u*)(bp0 + k * 8192), b1 = *(LAS const v4u*)(bp1 + k * 8192);
            if (!v0) b0 = (v4u){0u, 0u, 0u, 0u};
            if (!v1) b1 = (v4u){0u, 0u, 0u, 0u};
            const bf16x8 fa0 = __builtin_bit_cast(bf16x8, (v4u){(unsigned)a00, (unsigned)(a00 >> 32), (unsigned)a01, (unsigned)(a01 >> 32)});
            const bf16x8 fa1 = __builtin_bit_cast(bf16x8, (v4u){(unsigned)a10, (unsigned)(a10 >> 32), (unsigned)a11, (unsigned)(a11 >> 32)});
            const bf16x8 fb0 = __builtin_bit_cast(bf16x8, b0), fb1 = __builtin_bit_cast(bf16x8, b1);
            acc[0][0] = __builtin_amdgcn_mfma_f32_32x32x16_bf16(fa0, fb0, acc[0][0], 0, 0, 0);
            acc[0][1] = __builtin_amdgcn_mfma_f32_32x32x16_bf16(fa0, fb1, acc[0][1], 0, 0, 0);
            acc[1][0] = __builtin_amdgcn_mfma_f32_32x32x16_bf16(fa1, fb0, acc[1][0], 0, 0, 0);
            acc[1][1] = __builtin_amdgcn_mfma_f32_32x32x16_bf16(fa1, fb1, acc[1][1], 0, 0, 0);
        }
        pa -= 128; jb -= 1;
    }
    LDS_WAIT(); __syncthreads();
    { LAS float* xw = (LAS float*)(lds + LDS_F) + (gp * 2 + (half ? 0 : 1)) * 2048 + lane;
#pragma unroll
      for (int gg = 0; gg < 2; ++gg)
#pragma unroll
          for (int r = 0; r < 16; ++r) xw[(gg * 16 + r) * 64] = half ? acc[0][gg][r] : acc[1][gg][r]; }
    LDS_WAIT(); __syncthreads();
    f32x16 fin[2];
    { LAS const float* xr = (LAS const float*)(lds + LDS_F) + (gp * 2 + (half ? 1 : 0)) * 2048 + lane;
#pragma unroll
      for (int gg = 0; gg < 2; ++gg)
#pragma unroll
          for (int r = 0; r < 16; ++r) fin[gg][r] = (half ? acc[1][gg][r] : acc[0][gg][r]) + xr[(gg * 16 + r) * 64]; }
    { const float bd = bias_d[c], w0 = cw[c], w1 = cw[768 + c], w2 = cw[1536 + c], cb0 = cb[c]; const bf16* r0p = UVT + (size_t)c * M; bf16* hrow = HT + (size_t)c * M;
#pragma unroll
      for (int gg = 0; gg < 2; ++gg)
#pragma unroll
          for (int g4 = 0; g4 < 4; ++g4) { const int i = 16 * gp + 8 * gg + iloc, rr = 32 * half + 8 * g4 + 4 * hi, t0 = 64 * i + rr; const size_t tok = (size_t)b * S + t0;
              const unsigned long long vw = *(LAS const unsigned long long*)(lds + LDS_VV + (((rr >> 3) * 64 + i) * 4 + b) * 16 + (rr & 7) * 2);
              const unsigned long long uw = *(const GAS unsigned long long*)(r0p + tok);
              float u[6]; u[0] = t0 > 0 ? bf2f(r0p[tok - 1]) : 0.f; u[5] = t0 + 4 < S ? bf2f(r0p[tok + 4]) : 0.f;
              u[1] = bf2f((bf16)uw); u[2] = bf2f((bf16)(uw >> 16)); u[3] = bf2f((bf16)(uw >> 32)); u[4] = bf2f((bf16)(uw >> 48));
              float o[4];
#pragma unroll
              for (int e = 0; e < 4; ++e) { const float vv = bf2f((bf16)(vw >> (16 * e))); o[e] = (nrm * fin[gg][4 * g4 + e] + vv * bd) * conv1(u[e], u[e + 1], u[e + 2], w0, w1, w2, cb0); }
              *(GAS unsigned long long*)(hrow + tok) = (unsigned long long)pk2(o[0], o[1]) | ((unsigned long long)pk2(o[2], o[3]) << 32); } }
    LDS_WAIT(); __syncthreads();
}
__device__ __forceinline__ void transpose_slab(LAS unsigned char* lds, int slab, const bf16* HT, bf16* MIXB, int wave, int lane) {
    const int tid = wave * 64 + lane; LAS bf16* tile = (LAS bf16*)lds;
#pragma unroll 1
    for (int i = 0; i < 4; ++i) { const int q = tid + 512 * i, c = q >> 3, tc = q & 7; const v4u w = *(const GAS v4u*)(HT + (size_t)c * M + (size_t)slab * 64 + tc * 8);
#pragma unroll
        for (int e = 0; e < 4; ++e) { tile[(tc * 8 + 2 * e) * 264 + c] = (bf16)w[e]; tile[(tc * 8 + 2 * e + 1) * 264 + c] = (bf16)(w[e] >> 16); } }
    LDS_WAIT(); __syncthreads();
#pragma unroll 1
    for (int i = 0; i < 4; ++i) { const int q = tid + 512 * i, tk = q >> 5, cc = q & 31;
        *(GAS v4u*)(MIXB + ((size_t)slab * 64 + tk) * D + cc * 8) = *(LAS const v4u*)(lds + (tk * 264 + cc * 8) * 2); }
    LDS_WAIT(); __syncthreads();
}
}
#ifndef DUP_PRO
#define DUP_PRO 1
#endif
#ifndef DUP_IN
#define DUP_IN 1
#endif
#ifndef DUP_HY
#define DUP_HY 1
#endif
#ifndef DUP_POOL
#define DUP_POOL 1
#endif
#ifndef DUP_HYT
#define DUP_HYT 1
#endif
#ifndef DUP_ATT
#define DUP_ATT 1
#endif
#ifndef DUP_OUT
#define DUP_OUT 1
#endif
#ifndef DUP_LN1
#define DUP_LN1 1
#endif
#ifndef DUP_MOE1
#define DUP_MOE1 1
#endif
#ifndef DUP_MOE2
#define DUP_MOE2 1
#endif
#ifndef DUP_LN2
#define DUP_LN2 1
#endif
#ifndef EN_HY
#define EN_HY 1
#endif
#ifndef EN_HYT
#define EN_HYT 1
#endif
#ifndef EN_PRO
#define EN_PRO 1
#endif
#ifndef EN_IN
#define EN_IN 1
#endif
#ifndef EN_ATT
#define EN_ATT 1
#endif
#ifndef EN_POOL
#define EN_POOL 1
#endif
#ifndef EN_OUT
#define EN_OUT 1
#endif
#ifndef EN_LN1
#define EN_LN1 1
#endif
#ifndef EN_WCV
#define EN_WCV 1
#endif
#ifndef EN_MOE1
#define EN_MOE1 1
#endif
#ifndef EN_MOE2
#define EN_MOE2 1
#endif
#ifndef EN_LN2
#define EN_LN2 1
#endif
constexpr int RING_BYTES = 135168;
constexpr int LDSCTL_OFF = RING_BYTES, MISC_OFF = LDSCTL_OFF + 320, MOETAB_OFF = LDSCTL_OFF + 1024, ROUTE_OFF = LDSCTL_OFF + 2048;
constexpr int LDS_BYTES = 151552;

struct Args { const float* in[38]; float* out; unsigned char* ws; int* eid; float* wts; int ph_lo, ph_hi, l_lo, l_hi, single, pad; };
enum { PH_PRO = 0, PH_IN = 1, PH_ATT = 2, PH_POOL = 3, PH_OUT = 4, PH_LN1 = 5, PH_WCV = 6, PH_MOE1 = 7, PH_MOE2 = 8, PH_LN2 = 9, PH_HY = 10, PH_HYT = 11, PH_END = 12 };

__global__ void __launch_bounds__(NWAVES * 64, 2) mk_fwd(Args a) {
    extern __shared__ __attribute__((aligned(16))) unsigned char lds_raw[];
    LAS unsigned char* lds = (LAS unsigned char*)lds_raw;
    volatile LAS unsigned* MISC = (volatile LAS unsigned*)(lds + MISC_OFF);
    const int wave_s = __builtin_amdgcn_readfirstlane((int)threadIdx.x >> 6);
    const int G = gridDim.x, bx = blockIdx.x, vcu0 = (G % 8 == 0) ? (bx % 8) * (G / 8) + bx / 8 : bx;
    gu32* ctl0 = (gu32*)(a.ws + WS_CTL);
    for (int u = wave_s * 64 + (int)mk_lane_id(); u < (LDS_BYTES - LDSCTL_OFF) / 4; u += NWAVES * 64) ((LAS unsigned*)(lds + LDSCTL_OFF))[u] = 0u;
    __syncthreads();
    XcdBarrier bar; bar.bar = (unsigned*)(ctl0 + CW_BAR); bar.x = 0; bar.st = nullptr;
#if defined(MK_PER_PHASE)
    if (!a.single)
#endif
    bar = xcd_barrier_post((unsigned*)(ctl0 + CW_BAR), MISC + 8, wave_s);
#if defined(MK_PER_PHASE)
#define IN(k) (a.ph_lo <= (k) && (k) < a.ph_hi)
#define SEAM() do { if (!a.single) xcd_barrier(bar, wave_s); } while (0)
#else
#define IN(k) 1
#if defined(PROBE_BAR2)
#define SEAM() do { xcd_barrier(bar, wave_s); xcd_barrier(bar, wave_s); } while (0)
#else
#define SEAM() xcd_barrier(bar, wave_s)
#endif
#endif
    const int NGW = G * NWAVES;
#define PHASE_PTRS() int lane_ = (int)mk_lane_id(); asm volatile("" : "+v"(lane_)); const int lane = lane_, wave = wave_s; int vcu = vcu0; asm volatile("" : "+s"(vcu)); (void)wave; const int gw = vcu * NWAVES + wave; (void)gw; unsigned char* ws = a.ws; gu32* ctl = (gu32*)(ws + WS_CTL); (void)ctl; \
    bf16* XB = (bf16*)(ws + WS_XB); bf16* QKP = (bf16*)(ws + WS_QKP); bf16* UVT = (bf16*)(ws + WS_UVT); float* CS = (float*)(ws + WS_CS); bf16* MIXB = (bf16*)(ws + WS_MIXB); \
    (void)XB; (void)QKP; (void)UVT; (void)CS; (void)MIXB
#define INP(k) (a.in[k])
#define WCV_LAYER(LEXPR, GW_, NGW_) do { const int wl_ = (LEXPR), wg_ = (GW_), wn_ = (NGW_); const int l = wl_, gw = wg_, NGW = wn_; (void)NGW; \
            LAS float* scr = (LAS float*)(lds + wave * 16384); \
            unsigned char* wb_ = ws + WS_WBUF + (size_t)(l & 1) * WBUF_STRIDE; bf16* W13 = (bf16*)(wb_ + WB_W13); bf16* W2 = (bf16*)(wb_ + WB_W2); bf16* WG = (bf16*)(wb_ + WB_WG); bf16* WP = (bf16*)(wb_ + WB_WP); \
            for (int it = gw; it < 6784; it += NGW) { \
                const float* src; int K, N, k0, n0, mode = 0; bf16* dst; \
                if (it < 4096) { const int which = it >> 11, r = it & 2047, e = r >> 7, kb = (r >> 3) & 15, nb = r & 7; \
                    src = INP(which ? 31 : 30) + ((size_t)l * 16 + e) * D * 256; K = D; N = 256; k0 = kb * 64; n0 = nb * 32; mode = 1 + which; dst = W13 + (size_t)e * 512 * D; \
                } else if (it < 6144) { const int r = it - 4096, e = r >> 7, kb = (r >> 5) & 3, nb = r & 31; \
                    src = INP(32) + ((size_t)l * 16 + e) * 256 * D; K = 256; N = D; k0 = kb * 64; n0 = nb * 32; dst = W2 + (size_t)e * D * 256 + (size_t)n0 * 256; \
                } else if (it < 6656) { const int r = it - 6144, kb = r >> 5, nb = r & 31; \
                    src = INP(33) + (size_t)l * D * D; K = D; N = D; k0 = kb * 64; n0 = nb * 32; dst = WG + (size_t)n0 * D; \
                } else { const int r = it - 6656, kb = r >> 5, nb = r & 31; \
                    src = INP(35) + (size_t)l * 256 * D; K = 256; N = D; k0 = kb * 64; n0 = nb * 32; dst = WP + (size_t)n0 * 256; } \
                p0_transpose_block(src, K, N, k0, n0, dst, mode, scr, lane); \
            } \
            const int ln = lane; \
            const float* ps = INP(1) + (size_t)l * M * 256; bf16* PB = (bf16*)(wb_ + WB_PB); \
            for (size_t i = ((size_t)gw * 64 + ln) * 8; i < (size_t)M * 256; i += (size_t)NGW * 64 * 8) { const f32x4 x0 = *(const GAS f32x4*)(ps + i), x1 = *(const GAS f32x4*)(ps + i + 4); \
                v4u o; o.x = pk2(x0.x, x0.y); o.y = pk2(x0.z, x0.w); o.z = pk2(x1.x, x1.y); o.w = pk2(x1.z, x1.w); *(GAS v4u*)(PB + i) = o; } \
    } while (0)

    if (EN_PRO && IN(PH_PRO)) {
            PHASE_PTRS();
            for (int rep_ = 0; rep_ < DUP_PRO; ++rep_) {
        LAS float* scr = (LAS float*)(lds + wave * 16384);
        for (int it = gw; it < DEPTH * (16 * 72 + 16 * 32); it += NGW) {
            const int l = it / 1664, r = it % 1664; const float* src; int N, k0, n0; bf16* dst;
            if (r < 1152) { const int kb = r / 72, nb = r % 72; n0 = nb * 32; k0 = kb * 64; N = INW; src = INP(4) + (size_t)l * D * INW;
                bf16* wsw = (bf16*)(ws + WS_WIN + (size_t)l * WIN_LAYER); bf16* wnm = wsw + 1280 * 1024;
                dst = n0 < 768 ? wsw + (size_t)n0 * D : (n0 < 1792 ? wnm + (size_t)(n0 - 768) * D : wsw + (size_t)(768 + n0 - 1792) * D); }
            else { const int q = r - 1152, kb = q >> 5, nb = q & 31; n0 = nb * 32; k0 = kb * 64; N = D; src = INP(23) + (size_t)l * D * D; dst = (bf16*)(ws + WS_WOUT + (size_t)l * WOUT_LAYER) + (size_t)n0 * D; }
            p0_transpose_block(src, D, N, k0, n0, dst, 0, scr, lane);
            }
        }
        for (int it = gw; it < DEPTH * 4 * 16 * 2; it += NGW) {
            const int l = it >> 7, g = (it >> 5) & 3, dh = (it >> 4) & 1, k = (it & 15) * 64 + lane;
            const float* wrow = INP(4) + (size_t)l * D * INW + (size_t)k * INW + 2304 + g * 64;
            const float* pw = INP(20) + (size_t)(l * 4 + g) * 64 * 64 + dh * 32;
            float acc[32];
#pragma unroll
            for (int d = 0; d < 32; ++d) acc[d] = 0.f;
#pragma unroll 1
            for (int c = 0; c < 64; ++c) { const float x = wrow[c];
#pragma unroll
                for (int d = 0; d < 32; ++d) acc[d] += x * pw[c * 64 + d]; }
            bf16* dst = (bf16*)(ws + WS_WIN + (size_t)l * WIN_LAYER) + (size_t)(1280 + 1024 + g * 64 + dh * 32) * D + k;
#pragma unroll
            for (int d = 0; d < 32; ++d) dst[(size_t)d * D] = (bf16)f2bf(acc[d]);
        }
        int ln2 = lane; asm volatile("" : "+v"(ln2));
        for (int i = gw * 64 + ln2; i < S * 8; i += NGW * 64) { const int pos = i >> 3, j = i & 7; const float ang = (float)pos * powf(500000.0f, -(float)(2 * j) / 16.0f);
            CS[pos * 16 + j] = cosf(ang); CS[pos * 16 + 8 + j] = sinf(ang); }
        for (int m = gw; m < M; m += NGW) ln_row(INP(0) + (size_t)m * D, 1.f, nullptr, nullptr, nullptr, INP(2), INP(3), nullptr, XB + (size_t)m * D, lane);
        WCV_LAYER(0, gw, NGW);
        LDS_WAIT(); __syncthreads();
        for (int it = vcu; it < DEPTH * 64; it += G) { const int fl = it >> 6, pb = it & 63;
            hy::filter_item(lds, pb, INP(7) + fl * 33 * 64, INP(8) + fl * 64, INP(9) + fl * 64, INP(10) + fl * 64 * 64, INP(11) + fl * 64, INP(12) + fl * 64, INP(13) + fl * 64 * 512,
                            (bf16*)(ws + WS_KF) + (size_t)fl * 256 * 8192, (float*)(ws + WS_PS) + (size_t)fl * 64 * 512, wave, lane); }
        SEAM();
    }
#if defined(MK_PER_PHASE)
    for (int l = a.l_lo; l < a.l_hi; ++l) {
#else
#pragma unroll 1
    for (int l = 0; l < DEPTH; ++l) {
#endif
        if (EN_IN && IN(PH_IN)) {
            PHASE_PTRS();
            for (int rep_ = 0; rep_ < DUP_IN; ++rep_) {
            const char* wsw = (const char*)(ws + WS_WIN + (size_t)l * WIN_LAYER);
            SchedIn Sc{vcu, G, (const char*)XB, wsw, wsw + (size_t)1280 * 1024 * 2};
            EpiIn E{QKP, UVT, CS};
            pg8::gemm_phase<EpiIn, SchedIn>(lds, D, Sc, E, wave);
            { SchedSq Sc2{vcu, G / 2, (const char*)(ws + WS_WBUF + (size_t)(l & 1) * WBUF_STRIDE + WB_PB), (const char*)(ws + WS_WBUF + (size_t)(l & 1) * WBUF_STRIDE + WB_WP), (size_t)256 * 256 * 2, (size_t)256 * 256 * 2, G / 2};
              EpiPle<0> E2{(bf16*)(ws + WS_YP), nullptr};
              pg8::gemm_phase<EpiPle<0>, SchedSq>(lds, 256, Sc2, E2, wave); }
            }
            SEAM();
        }
        if (EN_HY && IN(PH_HY)) {
            PHASE_PTRS();
            for (int rep_ = 0; rep_ < DUP_HY; ++rep_) {
            for (int c = vcu; c < 256; c += G)
                hy::unit(lds, c, (const bf16*)(ws + WS_KF) + (size_t)l * 256 * 8192, (const float*)(ws + WS_PS) + (size_t)l * 64 * 512, UVT, INP(5) + l * 3 * 768, INP(6) + l * 768, INP(14) + l * 256, (bf16*)(ws + WS_HT), wave, lane);
            }
        }
        if (EN_POOL && IN(PH_POOL)) {
            PHASE_PTRS();
            for (int rep_ = 0; rep_ < DUP_POOL; ++rep_) {
            int ln = lane; asm volatile("" : "+v"(ln));
            const int cc = (ln & 31) * 8, gq = cc >> 6, hw = 1 << gq;
            const float* pb = INP(21) + l * 256 + cc; const float* psc = INP(22) + l * 256 + cc;
            for (int it = gw; it < M / 2; it += NGW) {
                const int tok = it * 2 + (ln >> 5), pos = tok & (S - 1);
                int lo = pos - hw, hi2 = pos + hw - 1; lo = lo < 0 ? 0 : lo; hi2 = hi2 > S - 1 ? S - 1 : hi2;
                float sacc[8];
#pragma unroll
                for (int e = 0; e < 8; ++e) sacc[e] = 0.f;
                const bf16* zp = QKP + (size_t)(tok - pos) * 1280 + 1024 + cc;
                for (int r = lo; r <= hi2; ++r) { const v4u w = *(const GAS v4u*)(zp + (size_t)r * 1280);
                    sacc[0] += bf2f((bf16)w.x); sacc[1] += bf2f((bf16)(w.x >> 16)); sacc[2] += bf2f((bf16)w.y); sacc[3] += bf2f((bf16)(w.y >> 16));
                    sacc[4] += bf2f((bf16)w.z); sacc[5] += bf2f((bf16)(w.z >> 16)); sacc[6] += bf2f((bf16)w.w); sacc[7] += bf2f((bf16)(w.w >> 16)); }
                const float inv = 1.f / (float)(hi2 - lo + 1);
                const v4u w = *(const GAS v4u*)(zp + (size_t)pos * 1280);
                float z[8] = {bf2f((bf16)w.x), bf2f((bf16)(w.x >> 16)), bf2f((bf16)w.y), bf2f((bf16)(w.y >> 16)), bf2f((bf16)w.z), bf2f((bf16)(w.z >> 16)), bf2f((bf16)w.w), bf2f((bf16)(w.w >> 16))};
                float y[8];
#pragma unroll
                for (int e = 0; e < 8; ++e) y[e] = (sacc[e] * inv - z[e] + pb[e]) * psc[e];
                v4u o; o.x = pk2(y[0], y[1]); o.y = pk2(y[2], y[3]); o.z = pk2(y[4], y[5]); o.w = pk2(y[6], y[7]);
                *(GAS v4u*)(MIXB + (size_t)tok * D + 768 + cc) = o;
            }
            }
            SEAM();
        }
        if (EN_HYT && IN(PH_HYT)) {
            PHASE_PTRS();
            for (int rep_ = 0; rep_ < DUP_HYT; ++rep_) {
            for (int s = vcu; s < 256; s += G) hy::transpose_slab(lds, s, (const bf16*)(ws + WS_HT), MIXB, wave, lane);
            }
        }
        if (EN_ATT && IN(PH_ATT)) {
            PHASE_PTRS();
            for (int rep_ = 0; rep_ < DUP_ATT; ++rep_) {
            const float lam_init = 0.8f - 0.6f * expf(-0.3f * (float)l);
            int ln = lane; asm volatile("" : "+v"(ln));
            const float lam = expf(wave_sum(INP(15)[l * 64 + ln] * INP(16)[l * 64 + ln])) - expf(wave_sum(INP(17)[l * 64 + ln] * INP(18)[l * 64 + ln])) + lam_init;
            for (int u = vcu; u < 256; u += G) att::unit(lds, (u >> 4) >> 2, (u >> 4) & 3, u & 15, QKP, UVT, lam, lam_init, INP(19) + l * 128, MIXB, (float*)(ws + WS_STASH) + ((size_t)u * 8 + wave) * 4096, wave, lane);
            }
            SEAM();
        }
        if (EN_OUT && IN(PH_OUT)) {
            PHASE_PTRS();
            for (int rep_ = 0; rep_ < DUP_OUT; ++rep_) {
            SchedOut Sc{vcu, G, (const char*)MIXB, (const char*)(ws + WS_WOUT + (size_t)l * WOUT_LAYER)};
#if defined(PROBE_OUT)
            { EpiRes E0{(bf16*)(ws + WS_STASH)}; pg8::gemm_phase<EpiRes, SchedOut>(lds, D, Sc, E0, wave); }
#endif
            EpiRes E{XB};
            pg8::gemm_phase<EpiRes, SchedOut>(lds, D, Sc, E, wave);
            }
            SEAM();
        }
        if (EN_LN1 && IN(PH_LN1)) {
            PHASE_PTRS();
            for (int rep_ = 0; rep_ < DUP_LN1; ++rep_) {
            int ln = lane; asm volatile("" : "+v"(ln));
            for (int ch = vcu; ch < M / 64; ch += G)
                ln1_router_chunk((LAS RouteLds*)(lds + ROUTE_OFF), lds, ch * 64, XB, INP(24) + l * D, INP(25) + l * D, INP(26) + (size_t)l * D * 4, INP(27) + l * 4, INP(28) + (size_t)l * D * 16, INP(29) + l * 16,
                                 ctl + CW_CNT + l * 16 * CNT_STRIDE, (int*)(ws + WS_TOKIDX), (float*)(ws + WS_GATE), wave, lane);
            }
            SEAM();
        }
        if (EN_MOE1 && IN(PH_MOE1)) {
            PHASE_PTRS();
            for (int rep_ = 0; rep_ < DUP_MOE1; ++rep_) {
            moe_tab_build((LAS int*)(lds + MOETAB_OFF), ctl + CW_CNT + l * 16 * CNT_STRIDE, wave == 0 && lane == 0); const MoeTab T{(LAS const int*)(lds + MOETAB_OFF)};
            { SchedMoe<2> Sc{vcu, G, T, (const char*)XB, (const char*)(ws + WS_WBUF + (size_t)(l & 1) * WBUF_STRIDE + WB_W13), (size_t)512 * D * 2, (const int*)(ws + WS_TOKIDX), 0};
              EpiMoe1 E{(bf16*)(ws + WS_ACT), (const float*)(ws + WS_GATE), T};
              pg8::gemm_phase<EpiMoe1, SchedMoe<2>, true>(lds, D, Sc, E, wave);
#if defined(PROBE_MOE1A)
              pg8::gemm_phase<EpiMoe1, SchedMoe<2>, true>(lds, D, Sc, E, wave);
#endif
            }
            { SchedSq Sc{vcu, G, (const char*)XB, (const char*)(ws + WS_WBUF + (size_t)(l & 1) * WBUF_STRIDE + WB_WG), TILEB, TILEB, 0};
              EpiPle<1> E{(bf16*)(ws + WS_YP), INP(34) + l * D};
              pg8::gemm_phase<EpiPle<1>, SchedSq>(lds, D, Sc, E, wave); }
            if (l + 1 < DEPTH) {
                int x2 = 2 * T.pre(16) - G; x2 = x2 < 0 ? 0 : (x2 > G / 2 ? G / 2 : x2);
                if (vcu >= x2) WCV_LAYER(l + 1, (vcu - x2) * NWAVES + wave, (G - x2) * NWAVES);
            }
            }
            SEAM();
        }
        if (EN_MOE2 && IN(PH_MOE2)) {
            PHASE_PTRS();
            for (int rep_ = 0; rep_ < DUP_MOE2; ++rep_) {
            moe_tab_build((LAS int*)(lds + MOETAB_OFF), ctl + CW_CNT + l * 16 * CNT_STRIDE, wave == 0 && lane == 0); const MoeTab T{(LAS const int*)(lds + MOETAB_OFF)};
            SchedMoe<4> Sc{vcu, G, T, (const char*)(ws + WS_ACT), (const char*)(ws + WS_WBUF + (size_t)(l & 1) * WBUF_STRIDE + WB_W2), (size_t)D * 256 * 2, (const int*)(ws + WS_TOKIDX), (size_t)256 * 256 * 2};
            EpiMoe2 E{(bf16*)(ws + WS_YMOE), (const int*)(ws + WS_TOKIDX), T};
            pg8::gemm_phase<EpiMoe2, SchedMoe<4>>(lds, 256, Sc, E, wave);
            }
            SEAM();
        }
        if (EN_LN2 && IN(PH_LN2)) {
            PHASE_PTRS();
            for (int rep_ = 0; rep_ < DUP_LN2; ++rep_) {
            int ln = lane; asm volatile("" : "+v"(ln));
            const bf16* YM = (const bf16*)(ws + WS_YMOE); const bf16* YP = (const bf16*)(ws + WS_YP);
            const bool lastl = (l == DEPTH - 1);
#if defined(PROBE_LN2)
            for (int m = gw; m < M; m += NGW)
                ln_row(XB + (size_t)m * D, DN_ALPHA, YM + (size_t)(2 * m) * D, YM + (size_t)(2 * m + 1) * D, YP + (size_t)m * D, INP(36) + l * D, INP(37) + l * D, (float*)nullptr, (bf16*)(ws + WS_STASH) + (size_t)m * D, ln);
#endif
            for (int m = gw; m < M; m += NGW)
                ln_row(XB + (size_t)m * D, DN_ALPHA, YM + (size_t)(2 * m) * D, YM + (size_t)(2 * m + 1) * D, YP + (size_t)m * D, INP(36) + l * D, INP(37) + l * D,
                       lastl ? a.out + (size_t)m * D : (float*)nullptr, lastl ? nullptr : XB + (size_t)m * D, ln);
            }
            if (l != DEPTH - 1) SEAM();
        }
    }
#undef IN
#undef SEAM
}
static void mk_launch(const Args& base, int ph, int l, int grid, hipStream_t stream) {
    Args a = base; a.ph_lo = ph; a.ph_hi = ph + 1; a.l_lo = l; a.l_hi = l + 1; a.single = 1;
    hipLaunchKernelGGL(mk_fwd, dim3(grid), dim3(NWAVES * 64), LDS_BYTES, stream, a);
}
extern "C" void kernel_launch(void* const* d_in, const int* in_sizes, int n_in, void* d_out, int out_size, void* d_ws, size_t ws_size, hipStream_t stream) {
    (void)in_sizes; (void)n_in; (void)out_size; (void)ws_size;
    static int grid = 0;
    if (grid == 0) {
        int dev = 0, cus = 0;
        if (hipGetDevice(&dev) != hipSuccess || hipDeviceGetAttribute(&cus, hipDeviceAttributeMultiprocessorCount, dev) != hipSuccess) { grid = -1; return; }
        if (hipFuncSetAttribute((const void*)mk_fwd, hipFuncAttributeMaxDynamicSharedMemorySize, LDS_BYTES) != hipSuccess) { grid = -1; return; }
        (void)hipGetLastError();
        grid = cus;
    }
    if (grid < 0) return;
    (void)hipMemsetAsync((char*)d_ws + WS_CTL, 0, CTL_ZERO_BYTES, stream);
    Args base{};
    for (int i = 0; i < 38; ++i) base.in[i] = (const float*)d_in[i];
    base.out = (float*)d_out; base.ws = (unsigned char*)d_ws;
    base.eid = nullptr; base.wts = nullptr;
#if defined(MK_PER_PHASE)
    mk_launch(base, PH_PRO, 0, grid, stream);
    for (int l = 0; l < DEPTH; ++l) for (int ph : {PH_IN, PH_HY, PH_HYT, PH_ATT, PH_POOL, PH_OUT, PH_LN1, PH_WCV, PH_MOE1, PH_MOE2, PH_LN2}) mk_launch(base, ph, l, grid, stream);
#else
    Args a = base; a.ph_lo = 0; a.ph_hi = PH_END; a.l_lo = 0; a.l_hi = DEPTH; a.single = 0;
    hipLaunchKernelGGL(mk_fwd, dim3(grid), dim3(NWAVES * 64), LDS_BYTES, stream, a);
#endif
}
```

```cpp
#include <hip/hip_runtime.h>
#include <stdint.h>
#include <math.h>
namespace pg8 {
#define PG8_LAS __attribute__((address_space(3)))
typedef unsigned short bf16_t;
typedef short bf16x8 __attribute__((ext_vector_type(8)));
typedef float f32x4 __attribute__((ext_vector_type(4)));
typedef unsigned u32x4 __attribute__((ext_vector_type(4)));
constexpr int BM = 256, BK = 64, HALF = 128, HTB = HALF * BK * 2  , STAGE_BYTES = 8 * HTB;

__host__ __device__ __forceinline__ int lds_byte(int r, int c) { const int st = (r >> 4) * 2 + (c >> 5), rr = r & 15, cc = c & 31, ob = rr * 64 + cc * 2; return st * 1024 + (ob ^ (((ob >> 9) & 1) << 5)); }
__host__ __device__ __forceinline__ void stage_rc(int b, int& R, int& C) { const int st = b / 1024, sb = b % 1024, swz = sb ^ (((sb >> 9) & 1) << 5); R = (st >> 1) * 16 + swz / 64; C = (st & 1) * 32 + (swz % 64) / 2; }
__host__ __device__ __forceinline__ int perm32(int rho) { const int n = rho >> 4, i = rho & 15; return 8 * (i >> 2) + 4 * n + (i & 3); }

struct Unit { const char* A; const char* B; int kind, pm, pn, aux; };

__device__ __forceinline__ unsigned cvt_pk_bf16(float lo, float hi) { unsigned r; asm volatile("v_cvt_pk_bf16_f32 %0, %1, %2" : "=v"(r) : "v"(lo), "v"(hi)); return r; }

template <class Epi, class Sched, bool GATHER = false>
__device__ __forceinline__ void gemm_phase(PG8_LAS unsigned char* lds, const int K_, const Sched& S, const Epi& E, const int wave_) {
    int K = K_; asm volatile("" : "+s"(K));
    int tid_; asm volatile("v_mbcnt_lo_u32_b32 %0, -1, 0\n\tv_mbcnt_hi_u32_b32 %0, -1, %0" : "=v"(tid_)); tid_ += wave_ * 64;
    const int tid = tid_, wid = __builtin_amdgcn_readfirstlane(tid >> 6), lane = tid & 63, wr = wid >> 2, wc = wid & 3, fr = lane & 15, fq = lane >> 4;
    const int nt = K / BK;
    unsigned voffA[2][2], voffN[2][2] = {{0u, 0u}, {0u, 0u}}, voffB[2]; int RA[2], CA[2];
#pragma unroll
    for (int i = 0; i < 2; ++i) { int R, C; stage_rc(tid * 16 + i * 8192, R, C); const int Rb = Epi::PERM ? ((R & ~31) + perm32(R & 31)) : R; RA[i] = R; CA[i] = C;
        voffA[0][i] = (unsigned)(R * K + C) * 2u; voffA[1][i] = (unsigned)((R + HALF) * K + C) * 2u; voffB[i] = (unsigned)(Rb * K + C) * 2u; }
    const size_t kstep = (size_t)(BK * 2);
    const size_t hstep = (size_t)HALF * K * 2;
    const unsigned ldsw = (unsigned)wid * 1024u;
    const int aoff = lds_byte(wr * 64 + fr, fq * 8), boff = lds_byte(wc * 32 + fr, fq * 8);
#define PG8_SA(b, h) (((b) * 2 + (h)) * HTB)
#define PG8_SB(b, h) ((4 + (b) * 2 + (h)) * HTB)
#define PG8_STAGE(bufoff, gbase, voff) do { _Pragma("unroll") for (int _i = 0; _i < 2; ++_i) \
        __builtin_amdgcn_global_load_lds((const unsigned*)((const char*)(gbase) + (voff)[_i]), (PG8_LAS unsigned*)(lds + (bufoff) + ldsw + _i * 8192), 16, 0, 0); } while (0)
#define PG8_LDA(dst, b, h) do { _Pragma("unroll") for (int m = 0; m < 4; ++m) _Pragma("unroll") for (int k = 0; k < 2; ++k) dst[m][k] = *(const PG8_LAS bf16x8*)(lds + PG8_SA(b, h) + aoff + m * 2048 + k * 1024); } while (0)
#define PG8_LDB(dst, b, h) do { _Pragma("unroll") for (int n = 0; n < 2; ++n) _Pragma("unroll") for (int k = 0; k < 2; ++k) dst[n][k] = *(const PG8_LAS bf16x8*)(lds + PG8_SB(b, h) + boff + n * 2048 + k * 1024); } while (0)
#define PG8_MMA(ai, bj, At, Bt) do { __builtin_amdgcn_s_setprio(1); _Pragma("unroll") for (int m = 0; m < 4; ++m) _Pragma("unroll") for (int n = 0; n < 2; ++n) _Pragma("unroll") for (int k = 0; k < 2; ++k) \
        acc[ai][bj][m][n] = __builtin_amdgcn_mfma_f32_16x16x32_bf16(Bt[n][k], At[m][k], acc[ai][bj][m][n], 0, 0, 0); __builtin_amdgcn_s_setprio(0); } while (0)
#define PG8_WAIT_V(n) asm volatile("s_waitcnt vmcnt(" #n ")" ::: "memory")
#define PG8_WAIT_L(n) asm volatile("s_waitcnt lgkmcnt(" #n ")" ::: "memory")
#define PG8_BAR __builtin_amdgcn_s_barrier()
#define PG8_SCHED __builtin_amdgcn_sched_barrier(0)
    Unit cur, nxt; int ui = 0;
    if (!S.next(0, cur)) return;
    if constexpr (GATHER) {
#pragma unroll
        for (int h = 0; h < 2; ++h)
#pragma unroll
            for (int i = 0; i < 2; ++i) voffA[h][i] = (unsigned)(S.arow(cur, h * HALF + RA[i]) * K + CA[i]) * 2u;
    }
    f32x4 acc[2][2][4][2];
#pragma unroll
    for (int a = 0; a < 2; ++a)
#pragma unroll
        for (int b = 0; b < 2; ++b)
#pragma unroll
            for (int m = 0; m < 4; ++m)
#pragma unroll
                for (int n = 0; n < 2; ++n) acc[a][b][m][n] = (f32x4){0.f, 0.f, 0.f, 0.f};
    bf16x8 At[4][2], B0[2][2], B1[2][2];
    const char* cA = cur.A; const char* cB = cur.B;
    PG8_STAGE(PG8_SB(0, 0), cB, voffB); PG8_STAGE(PG8_SB(0, 1), cB + hstep, voffB); PG8_STAGE(PG8_SA(0, 0), cA, voffA[0]); PG8_STAGE(PG8_SA(0, 1), cA, voffA[1]);
    if (wr == 1) PG8_BAR;
    PG8_WAIT_V(2); PG8_BAR;
    PG8_STAGE(PG8_SB(1, 0), cB + kstep, voffB); PG8_STAGE(PG8_SA(1, 0), cA + kstep, voffA[0]); PG8_STAGE(PG8_SB(1, 1), cB + hstep + kstep, voffB);
    PG8_WAIT_V(6); PG8_BAR;
    for (;;) {
        const bool has_next = S.next(ui + 1, nxt);
        const char* nA = has_next ? nxt.A : cA; const char* nB = has_next ? nxt.B : cB;
        if constexpr (GATHER) {
#pragma unroll
            for (int h = 0; h < 2; ++h)
#pragma unroll
                for (int i = 0; i < 2; ++i) voffN[h][i] = has_next ? (unsigned)(S.arow(nxt, h * HALF + RA[i]) * K + CA[i]) * 2u : voffA[h][i];
        }
#pragma unroll 1
        for (int t = 0; t < nt; t += 2) {
            const bool last = (t == nt - 2);
            const char* a1 = cA + (size_t)(t + 1) * kstep;
            const char* a2 = last ? nA : cA + (size_t)(t + 2) * kstep; const char* b2 = last ? nB : cB + (size_t)(t + 2) * kstep;
            const char* a3 = a2 + kstep; const char* b3 = b2 + kstep;
            PG8_LDB(B0, 0, 0); PG8_LDB(B1, 0, 1); PG8_SCHED; PG8_LDA(At, 0, 0); PG8_STAGE(PG8_SA(1, 1), a1, voffA[1]);
            if constexpr (GATHER) { if (last) {
#pragma unroll
                for (int h = 0; h < 2; ++h)
#pragma unroll
                    for (int i = 0; i < 2; ++i) voffA[h][i] = voffN[h][i]; } }
            PG8_WAIT_V(8); PG8_WAIT_L(0); PG8_BAR; PG8_MMA(0, 0, At, B0); PG8_MMA(0, 1, At, B1); PG8_BAR; PG8_SCHED;
            PG8_LDA(At, 0, 1); PG8_STAGE(PG8_SB(0, 0), b2, voffB); PG8_STAGE(PG8_SB(0, 1), b2 + hstep, voffB); PG8_STAGE(PG8_SA(0, 0), a2, voffA[0]);
            PG8_WAIT_V(8); PG8_WAIT_L(0); PG8_BAR; PG8_MMA(1, 0, At, B0); PG8_MMA(1, 1, At, B1); PG8_BAR; PG8_SCHED;
            PG8_LDB(B0, 1, 0); PG8_LDB(B1, 1, 1); PG8_SCHED; PG8_LDA(At, 1, 0); PG8_STAGE(PG8_SA(0, 1), a2, voffA[1]);
            PG8_WAIT_V(8); PG8_WAIT_L(0); PG8_BAR; PG8_MMA(0, 0, At, B0); PG8_MMA(0, 1, At, B1); PG8_BAR; PG8_SCHED;
            PG8_LDA(At, 1, 1); PG8_STAGE(PG8_SB(1, 0), b3, voffB); PG8_STAGE(PG8_SB(1, 1), b3 + hstep, voffB); PG8_STAGE(PG8_SA(1, 0), a3, voffA[0]);
            PG8_WAIT_V(8); PG8_WAIT_L(0); PG8_BAR; PG8_MMA(1, 0, At, B0); PG8_MMA(1, 1, At, B1); PG8_BAR; PG8_SCHED;
        }
        if (wr == 0) PG8_BAR;
        { Unit ce = cur; ce.pm = __builtin_amdgcn_readfirstlane(cur.pm); ce.pn = __builtin_amdgcn_readfirstlane(cur.pn); ce.kind = __builtin_amdgcn_readfirstlane(cur.kind); ce.aux = __builtin_amdgcn_readfirstlane(cur.aux); int fr_ = fr, fq_ = fq;
          asm volatile("" : "+s"(ce.pm), "+s"(ce.pn), "+s"(ce.kind), "+s"(ce.aux), "+v"(fr_), "+v"(fq_));
          E(acc, ce, wr, wc, fr_, fq_); }
        if (!has_next) break;
#pragma unroll
        for (int a = 0; a < 2; ++a)
#pragma unroll
            for (int b = 0; b < 2; ++b)
#pragma unroll
                for (int m = 0; m < 4; ++m)
#pragma unroll
                    for (int n = 0; n < 2; ++n) acc[a][b][m][n] = (f32x4){0.f, 0.f, 0.f, 0.f};
        cur = nxt; cA = nA; cB = nB; ++ui;
        if (wr == 1) PG8_BAR;
    }
    PG8_WAIT_V(0);
    PG8_BAR;
#undef PG8_SA
#undef PG8_SB
#undef PG8_STAGE
#undef PG8_LDA
#undef PG8_LDB
#undef PG8_MMA
#undef PG8_WAIT_V
#undef PG8_WAIT_L
#undef PG8_BAR
#undef PG8_SCHED
}
}
constexpr int D = 1024, NB = 4, S = 4096, M = NB * S, DEPTH = 4, INW = 2560;
constexpr float DN_ALPHA = 1.681792830507429f;
constexpr float QSCALE = 0.125f * 1.4426950408889634f;
constexpr int NWAVES = 8;
constexpr size_t MiB = 1u << 20;
constexpr size_t TILEB = (size_t)256 * D * 2;
constexpr size_t WS_CTL = 0, CTL_ZERO_BYTES = 1 * MiB;
constexpr size_t WS_CS = 1 * MiB;
constexpr size_t WS_WIN = 2 * MiB, WIN_LAYER = 5 * MiB;
constexpr size_t WS_XB = 22 * MiB;
constexpr size_t WS_QKP = 118 * MiB;
constexpr size_t WS_UVT = 158 * MiB;
constexpr size_t WS_MIXB = 198 * MiB;
constexpr size_t WS_STASH = 54 * MiB;
constexpr size_t WS_WOUT = 383 * MiB, WOUT_LAYER = 2 * MiB;
constexpr size_t WS_TOKIDX = 391 * MiB, WS_GATE = 392 * MiB;
constexpr size_t WS_YMOE = WS_QKP;
constexpr size_t WS_YP = 86 * MiB;
constexpr size_t WS_ACT = 230 * MiB;
constexpr size_t WS_WBUF = 288 * MiB, WBUF_STRIDE = 35 * MiB, WB_W13 = 0, WB_W2 = 16 * MiB, WB_WG = 24 * MiB, WB_WP = 26 * MiB, WB_PB = 27 * MiB;
constexpr size_t WS_KF = 262 * MiB, WS_PS = 278 * MiB, WS_HT = 280 * MiB;
constexpr size_t WS_WR = 256 * MiB;
constexpr int CW_BAR = 4096, CW_CNT = 8192, CNT_STRIDE = 64;

#define GAS __attribute__((address_space(1)))
#define LAS __attribute__((address_space(3)))
typedef unsigned short bf16;
typedef unsigned v4u __attribute__((ext_vector_type(4)));
typedef float f32x4 __attribute__((ext_vector_type(4)));
typedef short bf16x8 __attribute__((ext_vector_type(8)));
typedef GAS unsigned gu32;
typedef GAS unsigned long long gu64;
#define RLX_AGENT __ATOMIC_RELAXED, __HIP_MEMORY_SCOPE_AGENT
#define LDS_WAIT() asm volatile("s_waitcnt lgkmcnt(0)" ::: "memory")
#define VM_WAIT() asm volatile("s_waitcnt vmcnt(0)" ::: "memory")
__device__ __forceinline__ unsigned long long rt() { return __builtin_amdgcn_s_memrealtime(); }
__device__ __forceinline__ unsigned f2bf(float f) { unsigned u = __builtin_bit_cast(unsigned, f); return (u + 0x7fffu + ((u >> 16) & 1u)) >> 16; }
__device__ __forceinline__ unsigned pk2(float lo, float hi) { return f2bf(lo) | (f2bf(hi) << 16); }

#define XB_TMO      128
#define XB_XCNT(j)  (256  + 64 * (j))
#define XB_XSUB(j)  (1280 + 64 * (j))
#define XB_XGEN(j)  (2304 + 64 * (j))
#define XB_TOP      3328
#define XB_TOPGEN   3392
#define XCD_BAR_WORDS 3456
#define XB_SPIN_CAP (1u << 18)

__device__ __forceinline__ unsigned xb_ld(unsigned* p)              { return __hip_atomic_load(p, __ATOMIC_RELAXED, __HIP_MEMORY_SCOPE_AGENT); }
__device__ __forceinline__ unsigned xb_add(unsigned* p, unsigned v) { return __hip_atomic_fetch_add(p, v, __ATOMIC_RELAXED, __HIP_MEMORY_SCOPE_AGENT); }
__device__ __forceinline__ unsigned xb_xcc_id() { return (unsigned)__builtin_amdgcn_s_getreg((3 << 11) | 20) & 0xFu; }
#define XB_SPIN(cond, bar) do { unsigned _sp = 0; while (cond) { __builtin_amdgcn_s_sleep(1); \
    if ((++_sp & 255u) == 0u) { if (xb_ld(&(bar)[XB_TMO])) break; if (_sp > XB_SPIN_CAP) { atomicAdd(&(bar)[XB_TMO], 1u); break; } } } } while (0)

struct XcdBarrier {
    unsigned* bar; unsigned x;
    volatile LAS unsigned* st;
};

__device__ __forceinline__ unsigned mk_lane_id() { unsigned x; asm volatile("v_mbcnt_lo_u32_b32 %0, -1, 0\n\tv_mbcnt_hi_u32_b32 %0, -1, %0" : "=v"(x)); return x; }
__device__ __forceinline__ XcdBarrier xcd_barrier_post(unsigned* bar, volatile LAS unsigned* st, int wave) {
    XcdBarrier b; b.bar = bar; b.x = xb_xcc_id(); b.st = st;
    if (wave == 0 && mk_lane_id() == 0u) (void)xb_add(&bar[XB_XCNT(b.x)], 1u);
    return b;
}
__device__ __forceinline__ void xcd_barrier_complete(unsigned* bar, unsigned x, unsigned& nloc, unsigned& nx) {
    const unsigned G = gridDim.x * gridDim.y * gridDim.z;
    unsigned sum, cnt, mine, sp = 0u;
    for (;;) {
        sum = 0u; cnt = 0u; mine = 0u;
#pragma unroll
        for (unsigned j = 0; j < 16; ++j) { const unsigned c = xb_ld(&bar[XB_XCNT(j)]); sum += c; cnt += (c > 0u) ? 1u : 0u; mine = (j == x) ? c : mine; }
        if (sum == G) break;
        __builtin_amdgcn_s_sleep(1);
        if ((++sp & 255u) == 0u) { if (xb_ld(&bar[XB_TMO])) break; if (sp > XB_SPIN_CAP) { atomicAdd(&bar[XB_TMO], 1u); break; } }
    }
    nloc = mine > 0u ? mine : 1u; nx = cnt > 0u ? cnt : 1u;
}

__device__ __forceinline__ void xcd_barrier(const XcdBarrier& b, int wave) {
    asm volatile("" : "+s"(wave));
    const bool t0_ = (wave == 0) && (mk_lane_id() == 0u);
    asm volatile("s_waitcnt vmcnt(0)" ::: "memory");
    __syncthreads();
    if (t0_) {
        unsigned* bar = b.bar; unsigned bx_ = b.x; asm volatile("" : "+s"(bx_));
        __builtin_amdgcn_s_waitcnt(0);
        unsigned nloc = b.st[0], nx = b.st[1];
        if (nloc == 0u) { xcd_barrier_complete(bar, bx_, nloc, nx); b.st[0] = nloc; b.st[1] = nx; }
        const unsigned old = xb_add(&bar[XB_XSUB(bx_)], 1u);
        const unsigned gen = old / nloc;
        if (old + 1u == (gen + 1u) * nloc) {
            __builtin_amdgcn_fence(__ATOMIC_RELEASE, "agent");
            asm volatile("s_waitcnt vmcnt(0)" ::: "memory");
            const unsigned og = xb_add(&bar[XB_TOP], 1u);
            const unsigned tg = og / nx;
            if (og + 1u == (tg + 1u) * nx) xb_add(&bar[XB_TOPGEN], 1u);
            else XB_SPIN(xb_ld(&bar[XB_TOPGEN]) == tg, bar);
            __builtin_amdgcn_fence(__ATOMIC_ACQUIRE, "agent");
            xb_add(&bar[XB_XGEN(bx_)], 1u);
            asm volatile("s_waitcnt vmcnt(0)" ::: "memory");
        } else {
            XB_SPIN(xb_ld(&bar[XB_XGEN(bx_)]) == gen, bar);
            __builtin_amdgcn_fence(__ATOMIC_ACQUIRE, "agent");
            asm volatile("s_waitcnt vmcnt(0)" ::: "memory");
        }
    }
    __syncthreads();
}
__device__ __forceinline__ float bf2f(unsigned short b) { return __uint_as_float((unsigned)b << 16); }
#define MK_DPP(v, ctrl) __uint_as_float(__builtin_amdgcn_update_dpp(0, __float_as_uint(v), (ctrl), 0xF, 0xF, true))
__device__ __forceinline__ float xsum16(float v) { const auto r = __builtin_amdgcn_permlane16_swap(__float_as_uint(v), __float_as_uint(v), false, false); return __uint_as_float(r[0]) + __uint_as_float(r[1]); }
__device__ __forceinline__ float xsum32(float v) { const auto r = __builtin_amdgcn_permlane32_swap(__float_as_uint(v), __float_as_uint(v), false, false); return __uint_as_float(r[0]) + __uint_as_float(r[1]); }
__device__ __forceinline__ float wave_sum(float v) {
    v += MK_DPP(v, 0xB1); v += MK_DPP(v, 0x4E);
    v += MK_DPP(v, 0x141); v += MK_DPP(v, 0x140);
    return xsum32(xsum16(v));
}
__device__ __forceinline__ void p0_transpose_block(const float* W, int K, int N, int k0, int n0, bf16* WT, int mode, LAS float* scr, int lane) {
#pragma unroll 4
    for (int i = 0; i < 32; ++i) { const int kk = 2 * i + (lane >> 5); scr[kk * 33 + (lane & 31)] = W[(size_t)(k0 + kk) * N + n0 + (lane & 31)]; }
    LDS_WAIT(); asm volatile("" ::: "memory");
    const int c = lane & 7;
#pragma unroll 1
    for (int j = 0; j < 4; ++j) { const int n = (lane >> 3) + 8 * j; const LAS float* s = scr + (8 * c) * 33 + n;
        v4u o; o.x = pk2(s[0 * 33], s[1 * 33]); o.y = pk2(s[2 * 33], s[3 * 33]); o.z = pk2(s[4 * 33], s[5 * 33]); o.w = pk2(s[6 * 33], s[7 * 33]);
        const int f = n0 + n; const size_t drow = mode == 0 ? (size_t)n : (size_t)(8 * (f >> 2) + (f & 3) + (mode == 2 ? 4 : 0));
        *(GAS v4u*)(WT + drow * K + k0 + 8 * c) = o; }
    LDS_WAIT(); asm volatile("" ::: "memory");
}
template <class TX> __device__ __forceinline__ void ln_row(const TX* x0, float a, const bf16* y1, const bf16* y2, const bf16* y3, const float* g, const float* b, float* of, bf16* ob, int lane) {
    f32x4 v[4]; float s = 0.f;
#pragma unroll
    for (int j = 0; j < 4; ++j) { const int c = 4 * lane + 256 * j;
        if constexpr (sizeof(TX) == 4) v[j] = *(const GAS f32x4*)(x0 + c) * a;
        else { const unsigned long long w = *(const GAS unsigned long long*)(x0 + c); v[j] = (f32x4){bf2f((bf16)w), bf2f((bf16)(w >> 16)), bf2f((bf16)(w >> 32)), bf2f((bf16)(w >> 48))} * a; }
        if (y1) { const unsigned long long w = *(const GAS unsigned long long*)(y1 + c); v[j] += (f32x4){bf2f((bf16)w), bf2f((bf16)(w >> 16)), bf2f((bf16)(w >> 32)), bf2f((bf16)(w >> 48))}; }
        if (y2) { const unsigned long long w = *(const GAS unsigned long long*)(y2 + c); v[j] += (f32x4){bf2f((bf16)w), bf2f((bf16)(w >> 16)), bf2f((bf16)(w >> 32)), bf2f((bf16)(w >> 48))}; }
        if (y3) { const unsigned long long w = *(const GAS unsigned long long*)(y3 + c); v[j] += (f32x4){bf2f((bf16)w), bf2f((bf16)(w >> 16)), bf2f((bf16)(w >> 32)), bf2f((bf16)(w >> 48))}; }
        s += (v[j].x + v[j].y) + (v[j].z + v[j].w); }
    const float mean = wave_sum(s) * (1.f / D); float s2 = 0.f;
#pragma unroll
    for (int j = 0; j < 4; ++j) { v[j] = v[j] - mean; s2 += (v[j].x * v[j].x + v[j].y * v[j].y) + (v[j].z * v[j].z + v[j].w * v[j].w); }
    const float rstd = __builtin_amdgcn_rsqf(wave_sum(s2) * (1.f / D) + 1e-5f);
#pragma unroll
    for (int j = 0; j < 4; ++j) { const int c = 4 * lane + 256 * j; const f32x4 o = v[j] * rstd * *(const GAS f32x4*)(g + c) + *(const GAS f32x4*)(b + c);
        if (of) *(GAS f32x4*)(of + c) = o;
        if (ob) *(GAS unsigned long long*)(ob + c) = (unsigned long long)pk2(o.x, o.y) | ((unsigned long long)pk2(o.z, o.w) << 32); }
}

struct SchedIn {
    int vcu, G; const char* xb; const char* wsw; const char* wnm;
    __device__ __forceinline__ bool next(int i, pg8::Unit& u) const {
        const int L = i * G + vcu; if (L >= 640) return false;
        const int t = L / 10, j = L % 10;
        const int sw = __builtin_amdgcn_readfirstlane((unsigned)(j + 27) >> 5);
        const int jj = j - 5 * sw; const char* tp = xb + (size_t)t * TILEB; const char* wp = (sw ? wsw : wnm) + (size_t)jj * TILEB;
        u.kind = sw; u.pm = sw ? jj : t; u.pn = sw ? t : jj; u.A = sw ? wp : tp; u.B = sw ? tp : wp;
        u.aux = 0; return true;
    }
};
struct EpiIn {
    static constexpr bool PERM = true;
    bf16* qkp; bf16* uvt; const float* cs;
    __device__ __forceinline__ void operator()(const pg8::f32x4 (&acc)[2][2][4][2], const pg8::Unit& u, int wr, int wc, int fr, int fq) const {
        bf16* base = u.kind == 0 ? qkp : uvt; const int ldc = u.kind == 0 ? 1280 : M;
        const int row0 = u.pm * 256 + wr * 64 + fr, col0 = u.pn * 256 + wc * 32 + 8 * fq;
        const bool rope = (u.kind == 0) && (u.pn < 4) && ((wc & 1) == 0);
        const float sc = (u.kind == 0 && u.pn < 2) ? QSCALE : 1.f;
        const float sgn = fq == 0 ? -1.f : 1.f;
        const bool vperm = (u.kind == 1) && (u.pm >= 3);
#pragma unroll
        for (int ai = 0; ai < 2; ++ai)
#pragma unroll
            for (int m = 0; m < 4; ++m) { const int row = row0 + ai * 128 + m * 16; bf16* rowp = base + (size_t)row * ldc + col0;
                f32x4 cv0 = {1.f, 1.f, 1.f, 1.f}, cv1 = cv0, sv0 = {0.f, 0.f, 0.f, 0.f}, sv1 = sv0;
                if (rope && fq < 2) { const float* t = cs + (size_t)(row & (S - 1)) * 16; cv0 = *(const f32x4*)t; cv1 = *(const f32x4*)(t + 4); sv0 = *(const f32x4*)(t + 8) * sgn; sv1 = *(const f32x4*)(t + 12) * sgn; }
#pragma unroll
                for (int bj = 0; bj < 2; ++bj) { f32x4 v0 = acc[ai][bj][m][0], v1 = acc[ai][bj][m][1];
                    if (rope) { f32x4 p0, p1;
#pragma unroll
                        for (int e = 0; e < 4; ++e) { const auto r0 = __builtin_amdgcn_permlane16_swap(__float_as_uint(v0[e]), __float_as_uint(v0[e]), false, false), r1 = __builtin_amdgcn_permlane16_swap(__float_as_uint(v1[e]), __float_as_uint(v1[e]), false, false);
                            p0[e] = __uint_as_float((fq & 1) ? r0[0] : r0[1]); p1[e] = __uint_as_float((fq & 1) ? r1[0] : r1[1]); }
                        v0 = v0 * cv0 + p0 * sv0; v1 = v1 * cv1 + p1 * sv1; }
                    v0 = v0 * sc; v1 = v1 * sc;
                    pg8::u32x4 w; w.x = pg8::cvt_pk_bf16(v0[0], v0[1]); w.y = pg8::cvt_pk_bf16(v0[2], v0[3]); w.z = pg8::cvt_pk_bf16(v1[0], v1[1]); w.w = pg8::cvt_pk_bf16(v1[2], v1[3]);
                    if (vperm) {
                        bf16* gp = rowp + bj * 128 - (fq & 1) * 8;
                        typedef unsigned u32x2 __attribute__((ext_vector_type(2)));
                        *(u32x2*)(gp + ((fq & 1) ? 4 : 0)) = (u32x2){w.x, w.y}; *(u32x2*)(gp + ((fq & 1) ? 12 : 8)) = (u32x2){w.z, w.w};
                    } else *(pg8::u32x4*)(rowp + bj * 128) = w; } }
    }
};

struct SchedOut {
    int vcu, G; const char* a; const char* w;
    __device__ __forceinline__ bool next(int i, pg8::Unit& u) const {
        const int L = i * G + vcu; if (L >= 256) return false;
        u.kind = 0; u.pm = L >> 2; u.pn = L & 3; u.aux = 0; u.A = a + (size_t)u.pm * TILEB; u.B = w + (size_t)u.pn * TILEB; return true;
    }
};
struct EpiRes {
    static constexpr bool PERM = true;
    bf16* XB;
    __device__ __forceinline__ void operator()(const pg8::f32x4 (&acc)[2][2][4][2], const pg8::Unit& u, int wr, int wc, int fr, int fq) const {
        const int row0 = u.pm * 256 + wr * 64 + fr, col0 = u.pn * 256 + wc * 32 + 8 * fq;
#pragma unroll
        for (int ai = 0; ai < 2; ++ai)
#pragma unroll
            for (int m = 0; m < 4; ++m) { bf16* rowp = XB + (size_t)(row0 + ai * 128 + m * 16) * D + col0;
#pragma unroll
                for (int bj = 0; bj < 2; ++bj) { pg8::u32x4* p = (pg8::u32x4*)(rowp + bj * 128); const pg8::u32x4 x = *p; const pg8::f32x4 v0 = acc[ai][bj][m][0], v1 = acc[ai][bj][m][1];
                    pg8::u32x4 w; w.x = pg8::cvt_pk_bf16(bf2f((bf16)x.x) * DN_ALPHA + v0[0], bf2f((bf16)(x.x >> 16)) * DN_ALPHA + v0[1]); w.y = pg8::cvt_pk_bf16(bf2f((bf16)x.y) * DN_ALPHA + v0[2], bf2f((bf16)(x.y >> 16)) * DN_ALPHA + v0[3]);
                    w.z = pg8::cvt_pk_bf16(bf2f((bf16)x.z) * DN_ALPHA + v1[0], bf2f((bf16)(x.z >> 16)) * DN_ALPHA + v1[1]); w.w = pg8::cvt_pk_bf16(bf2f((bf16)x.w) * DN_ALPHA + v1[2], bf2f((bf16)(x.w >> 16)) * DN_ALPHA + v1[3]);
                    *p = w; } }
    }
};
struct RouteLds { unsigned lcnt[16]; unsigned gbase[16]; int e0[64], e1[64]; unsigned r0[64], r1[64]; float g0[64], g1[64]; };
constexpr int RT_PITCH = 2064;
template <int DRY = 0> __device__ __forceinline__ void ln1_router_chunk(LAS RouteLds* R, LAS unsigned char* tile, int row0, bf16* XB, bf16* XOUT, const float* g, const float* b, const bf16* wrt, const float* bgc, const float* bgf,
                                                 gu32* cnt, int* tokidx, float* gate, int wave, int lane) {
    const int tidl = wave * 64 + lane;
    if (tidl < 16) R->lcnt[tidl] = 0u;
#pragma unroll 2
    for (int r = 0; r < 8; ++r) { const int rl = wave * 8 + r; bf16* xbrow = XB + (size_t)(row0 + rl) * D; f32x4 v[4]; float s = 0.f;
#pragma unroll
        for (int j = 0; j < 4; ++j) { const unsigned long long w = *(const GAS unsigned long long*)(xbrow + 4 * lane + 256 * j);
            v[j] = (f32x4){bf2f((bf16)w), bf2f((bf16)(w >> 16)), bf2f((bf16)(w >> 32)), bf2f((bf16)(w >> 48))}; s += (v[j].x + v[j].y) + (v[j].z + v[j].w); }
        const float mean = wave_sum(s) * (1.f / D); float s2 = 0.f;
#pragma unroll
        for (int j = 0; j < 4; ++j) { v[j] = v[j] - mean; s2 += (v[j].x * v[j].x + v[j].y * v[j].y) + (v[j].z * v[j].z + v[j].w * v[j].w); }
        const float rstd = __builtin_amdgcn_rsqf(wave_sum(s2) * (1.f / D) + 1e-5f);
#pragma unroll
        for (int j = 0; j < 4; ++j) { const int c = 4 * lane + 256 * j; const f32x4 o = v[j] * rstd * *(const GAS f32x4*)(g + c) + *(const GAS f32x4*)(b + c);
            const unsigned w0 = pk2(o.x, o.y), w1 = pk2(o.z, o.w);
            *(GAS unsigned long long*)(XOUT + (size_t)(row0 + rl) * D + c) = (unsigned long long)w0 | ((unsigned long long)w1 << 32);
            LAS unsigned* tp = (LAS unsigned*)(tile + rl * RT_PITCH + c * 2); tp[0] = w0; tp[1] = w1; } }
    LDS_WAIT(); __syncthreads();
    if (DRY == 1) return;
    typedef float f32x16_t __attribute__((ext_vector_type(16)));
    f32x16_t pacc;
#pragma unroll
    for (int r = 0; r < 16; ++r) pacc[r] = 0.f;
    { const int rt = wave & 1, kq = wave >> 1, r32 = lane & 31, hi = lane >> 5;
      LAS const unsigned char* ap = tile + (32 * rt + r32) * RT_PITCH + (256 * kq + 8 * hi) * 2;
      const bf16* bh = wrt + (size_t)r32 * D + 256 * kq + 8 * hi; const bf16* bl = bh + 32 * D;
#pragma unroll 4
      for (int ks = 0; ks < 16; ++ks) { const bf16x8 af = *(LAS const bf16x8*)(ap + ks * 32), bhf = *(const GAS bf16x8*)(bh + ks * 16), blf = *(const GAS bf16x8*)(bl + ks * 16);
          pacc = __builtin_amdgcn_mfma_f32_32x32x16_bf16(af, bhf, pacc, 0, 0, 0); pacc = __builtin_amdgcn_mfma_f32_32x32x16_bf16(af, blf, pacc, 0, 0, 0); } }
    LDS_WAIT(); __syncthreads();
    if (DRY == 2) return;
    { const int rt = wave & 1, kq = wave >> 1, r32 = lane & 31, hi = lane >> 5;
      LAS float* P = (LAS float*)tile + (kq * 64 + rt * 32) * 33 + r32;
#pragma unroll
      for (int r = 0; r < 16; ++r) P[((r & 3) + 8 * (r >> 2) + 4 * hi) * 33] = pacc[r]; }
    LDS_WAIT(); __syncthreads();
    if (wave == 0) {
        float my[20];
#pragma unroll
        for (int i = 0; i < 20; ++i) { float t = 0.f;
#pragma unroll
            for (int q = 0; q < 4; ++q) t += ((LAS const float*)tile)[(q * 64 + lane) * 33 + i];
            my[i] = t; }
        const int rl = lane;
        float pg[4], mx = -INFINITY, sum = 0.f;
#pragma unroll
        for (int j = 0; j < 4; ++j) { pg[j] = my[j] + bgc[j]; mx = fmaxf(mx, pg[j]); }
#pragma unroll
        for (int j = 0; j < 4; ++j) { pg[j] = expf(pg[j] - mx); sum += pg[j]; }
        int gi = 0; float gw = pg[0];
#pragma unroll
        for (int j = 1; j < 4; ++j) if (pg[j] > gw) { gw = pg[j]; gi = j; }
        gw /= sum;
        float fs[4]; mx = -INFINITY;
#pragma unroll
        for (int j = 0; j < 4; ++j) { float t = 0.f;
#pragma unroll
            for (int q = 0; q < 4; ++q) if (q == gi) t = my[4 + q * 4 + j] + bgf[q * 4 + j];
            fs[j] = t; mx = fmaxf(mx, t); }
#pragma unroll
        for (int j = 0; j < 4; ++j) fs[j] = expf(fs[j] - mx);
        int t0 = 0; float v0 = fs[0];
#pragma unroll
        for (int j = 1; j < 4; ++j) if (fs[j] > v0) { v0 = fs[j]; t0 = j; }
        int t1 = -1; float v1 = -1.f;
#pragma unroll
        for (int j = 0; j < 4; ++j) if (j != t0 && fs[j] > v1) { v1 = fs[j]; t1 = j; }
        const float ts = v0 + v1; const int e0 = gi * 4 + t0, e1 = gi * 4 + t1;
        R->e0[rl] = e0; R->e1[rl] = e1; R->g0[rl] = gw * (v0 / ts); R->g1[rl] = gw * (v1 / ts);
        R->r0[rl] = __hip_atomic_fetch_add(&R->lcnt[e0], 1u, __ATOMIC_RELAXED, __HIP_MEMORY_SCOPE_WORKGROUP);
        R->r1[rl] = __hip_atomic_fetch_add(&R->lcnt[e1], 1u, __ATOMIC_RELAXED, __HIP_MEMORY_SCOPE_WORKGROUP);
    }
    LDS_WAIT(); __syncthreads();
    if (DRY == 3) return;
    if (tidl < 16) { const unsigned n = R->lcnt[tidl]; R->gbase[tidl] = n ? __hip_atomic_fetch_add(cnt + tidl * CNT_STRIDE, n, RLX_AGENT) : 0u; }
    LDS_WAIT(); __syncthreads();
    if (tidl < 64) { const int rl = tidl, tok = row0 + rl; const int e0 = R->e0[rl], e1 = R->e1[rl]; const unsigned p0 = R->gbase[e0] + R->r0[rl], p1 = R->gbase[e1] + R->r1[rl];
        tokidx[(size_t)e0 * M + p0] = tok * 2; gate[(size_t)e0 * M + p0] = R->g0[rl]; tokidx[(size_t)e1 * M + p1] = tok * 2 + 1; gate[(size_t)e1 * M + p1] = R->g1[rl]; }
    LDS_WAIT(); __syncthreads();
}

struct MoeTab { LAS const int* p;
    __device__ __forceinline__ int cnt(int e) const { return __builtin_amdgcn_readfirstlane(p[e]); }
    __device__ __forceinline__ int pre(int e) const { return __builtin_amdgcn_readfirstlane(p[16 + e]); } };
__device__ __forceinline__ void moe_tab_build(LAS int* p, const gu32* cnt, bool t0) {
    if (t0) { int acc = 0;
        for (int e = 0; e < 16; ++e) { const int c = (int)__hip_atomic_load(cnt + e * CNT_STRIDE, RLX_AGENT); p[e] = c; p[16 + e] = acc; acc += (c + 255) >> 8; }
        p[32] = acc; }
    __syncthreads();
}
template <int NPN> struct SchedMoe {
    int vcu, G; MoeTab T; const char* a; const char* w; size_t wexp  ; const int* tokidx; size_t atile  ;
    __device__ __forceinline__ bool next(int i, pg8::Unit& u) const {
        const int L = i * G + vcu; if (L >= T.pre(16) * NPN) return false;
        const int tile = L / NPN; u.pn = L % NPN; int e = 0;
#pragma unroll 1
        for (int q = 1; q < 16; ++q) if (tile >= T.pre(q)) e = q;
        u.aux = e; u.pm = tile - T.pre(e); u.kind = tile;
        u.A = a + (size_t)tile * atile; u.B = w + (size_t)e * wexp + (size_t)u.pn * 256 * (wexp / (NPN * 256)); return true;
    }
    __device__ __forceinline__ int arow(const pg8::Unit& u, int r) const {
        const int rank = u.pm * 256 + r; const int c = T.cnt(u.aux);
        return rank < c ? (tokidx[(size_t)u.aux * M + rank] >> 1) : 0;
    }
};
struct EpiMoe1 {
    static constexpr bool PERM = true;
    bf16* act; const float* gate; MoeTab T;
    __device__ __forceinline__ void operator()(const pg8::f32x4 (&acc)[2][2][4][2], const pg8::Unit& u, int wr, int wc, int fr, int fq) const {
        const int cnt = T.cnt(u.aux);
#pragma unroll
        for (int ai = 0; ai < 2; ++ai)
#pragma unroll
            for (int m = 0; m < 4; ++m) { const int r = ai * 128 + wr * 64 + m * 16 + fr, rank = u.pm * 256 + r;
                const float gt = rank < cnt ? gate[(size_t)u.aux * M + rank] : 0.f;
                bf16* rowp = act + ((size_t)u.kind * 256 + r) * 256 + u.pn * 128 + wc * 16 + 4 * fq;
#pragma unroll
                for (int bj = 0; bj < 2; ++bj) { const pg8::f32x4 av = acc[ai][bj][m][0], cv = acc[ai][bj][m][1]; float y[4];
#pragma unroll
                    for (int e = 0; e < 4; ++e) y[e] = av[e] * __builtin_amdgcn_rcpf(1.f + __builtin_amdgcn_exp2f(av[e] * -1.4426950408889634f)) * cv[e] * gt;
                    *(unsigned long long*)(rowp + bj * 64) = (unsigned long long)pg8::cvt_pk_bf16(y[0], y[1]) | ((unsigned long long)pg8::cvt_pk_bf16(y[2], y[3]) << 32); } }
    }
};
struct EpiMoe2 {
    static constexpr bool PERM = true;
    bf16* ymoe; const int* tokidx; MoeTab T;
    __device__ __forceinline__ void operator()(const pg8::f32x4 (&acc)[2][2][4][2], const pg8::Unit& u, int wr, int wc, int fr, int fq) const {
        const int cnt = T.cnt(u.aux);
#pragma unroll
        for (int ai = 0; ai < 2; ++ai)
#pragma unroll
            for (int m = 0; m < 4; ++m) { const int r = ai * 128 + wr * 64 + m * 16 + fr, rank = u.pm * 256 + r;
                if (rank < cnt) { bf16* rowp = ymoe + (size_t)tokidx[(size_t)u.aux * M + rank] * D + u.pn * 256 + wc * 32 + 8 * fq;
#pragma unroll
                    for (int bj = 0; bj < 2; ++bj) { const pg8::f32x4 v0 = acc[ai][bj][m][0], v1 = acc[ai][bj][m][1];
                        pg8::u32x4 w; w.x = pg8::cvt_pk_bf16(v0[0], v0[1]); w.y = pg8::cvt_pk_bf16(v0[2], v0[3]); w.z = pg8::cvt_pk_bf16(v1[0], v1[1]); w.w = pg8::cvt_pk_bf16(v1[2], v1[3]);
                        *(pg8::u32x4*)(rowp + bj * 128) = w; } } }
    }
};
struct SchedSq {
    int vcu, G; const char* a; const char* w; size_t astep, wstep; int vfirst;
    __device__ __forceinline__ bool next(int i, pg8::Unit& u) const {
        if (vcu < vfirst || vcu >= vfirst + G) return false;
        const int L = i * G + (vcu - vfirst); if (L >= 256) return false;
        u.kind = 0; u.pm = L >> 2; u.pn = L & 3; u.aux = 0; u.A = a + (size_t)u.pm * astep; u.B = w + (size_t)u.pn * wstep; return true;
    }
};
template <int GATED> struct EpiPle {
    static constexpr bool PERM = true;
    bf16* yp; const float* bg;
    __device__ __forceinline__ void operator()(const pg8::f32x4 (&acc)[2][2][4][2], const pg8::Unit& u, int wr, int wc, int fr, int fq) const {
        const int row0 = u.pm * 256 + wr * 64 + fr, col0 = u.pn * 256 + wc * 32 + 8 * fq;
#pragma unroll
        for (int ai = 0; ai < 2; ++ai)
#pragma unroll
            for (int m = 0; m < 4; ++m) { bf16* rowp = yp + (size_t)(row0 + ai * 128 + m * 16) * D + col0;
#pragma unroll
                for (int bj = 0; bj < 2; ++bj) { pg8::f32x4 v0 = acc[ai][bj][m][0], v1 = acc[ai][bj][m][1];
                    if (GATED) { const pg8::f32x4 b0 = *(const pg8::f32x4*)(bg + col0 + bj * 128), b1 = *(const pg8::f32x4*)(bg + col0 + bj * 128 + 4); const pg8::u32x4 y = *(const pg8::u32x4*)(rowp + bj * 128);
                        const float yf[8] = {bf2f((bf16)y.x), bf2f((bf16)(y.x >> 16)), bf2f((bf16)y.y), bf2f((bf16)(y.y >> 16)), bf2f((bf16)y.z), bf2f((bf16)(y.z >> 16)), bf2f((bf16)y.w), bf2f((bf16)(y.w >> 16))};
#pragma unroll
                        for (int e = 0; e < 4; ++e) { v0[e] = yf[e] * __builtin_amdgcn_rcpf(1.f + __builtin_amdgcn_exp2f((v0[e] + b0[e]) * -1.4426950408889634f)); v1[e] = yf[4 + e] * __builtin_amdgcn_rcpf(1.f + __builtin_amdgcn_exp2f((v1[e] + b1[e]) * -1.4426950408889634f)); } }
                    pg8::u32x4 w; w.x = pg8::cvt_pk_bf16(v0[0], v0[1]); w.y = pg8::cvt_pk_bf16(v0[2], v0[3]); w.z = pg8::cvt_pk_bf16(v1[0], v1[1]); w.w = pg8::cvt_pk_bf16(v1[2], v1[3]);
                    *(pg8::u32x4*)(rowp + bj * 128) = w; } }
    }
};
namespace att {
typedef float f32x16 __attribute__((ext_vector_type(16)));
constexpr int KSLOT = 8192, VSLOT = 16384, LDS_K = 0, LDS_V = 2 * KSLOT, ATT_LDS = 2 * KSLOT + 2 * VSLOT;
__device__ __forceinline__ bf16x8 pack8(const f32x16& p, int b) {
    v4u w; w.x = pg8::cvt_pk_bf16(p[b], p[b + 1]); w.y = pg8::cvt_pk_bf16(p[b + 2], p[b + 3]); w.z = pg8::cvt_pk_bf16(p[b + 4], p[b + 5]); w.w = pg8::cvt_pk_bf16(p[b + 6], p[b + 7]);
    return __builtin_bit_cast(bf16x8, w);
}
constexpr float THR2 = 8.f;
__device__ __forceinline__ void qkt(f32x16& p0, f32x16& p1, LAS const unsigned char* ks, const bf16x8 (&qf)[4], int r32, int hi) {
#pragma unroll
    for (int r = 0; r < 16; ++r) { p0[r] = 0.f; p1[r] = 0.f; }
    LAS const unsigned char* kb = ks + hi * 1024 + r32 * 16;
#pragma unroll
    for (int kk = 0; kk < 4; ++kk) {
        const bf16x8 a0 = *(LAS const bf16x8*)(kb + kk * 2048), a1 = *(LAS const bf16x8*)(kb + kk * 2048 + 512);
        p0 = __builtin_amdgcn_mfma_f32_32x32x16_bf16(a0, qf[kk], p0, 0, 0, 0);
        p1 = __builtin_amdgcn_mfma_f32_32x32x16_bf16(a1, qf[kk], p1, 0, 0, 0);
    }
}
__device__ __forceinline__ void partialSM(f32x16& p0, f32x16& p1, float& m, float& alpha) {
    float pmax = fmaxf(p0[0], p1[0]);
#pragma unroll
    for (int r = 1; r < 16; ++r) pmax = fmaxf(pmax, fmaxf(p0[r], p1[r]));
    { const auto rr = __builtin_amdgcn_permlane32_swap(__float_as_uint(pmax), __float_as_uint(pmax), false, false); pmax = fmaxf(__uint_as_float(rr[0]), __uint_as_float(rr[1])); }
    if (__builtin_expect(__all(pmax - m <= THR2), 1)) alpha = 1.f;
    else { const float mn = fmaxf(m, pmax); alpha = __builtin_amdgcn_exp2f(m - mn); m = mn; }
    const float mm = m;
#pragma unroll
    for (int r = 0; r < 16; ++r) { p0[r] = __builtin_amdgcn_exp2f(p0[r] - mm); p1[r] -= mm; }
}
__device__ __forceinline__ void finishSM(f32x16& p0, f32x16& p1, float alpha, float& l, bf16x8 (&pf)[4]) {
    float ps = 0.f;
#pragma unroll
    for (int r = 0; r < 16; ++r) { p1[r] = __builtin_amdgcn_exp2f(p1[r]); ps += p0[r] + p1[r]; }
    l = l * alpha + ps;
    pf[0] = pack8(p0, 0); pf[1] = pack8(p0, 8); pf[2] = pack8(p1, 0); pf[3] = pack8(p1, 8);
}
__device__ __forceinline__ void pv(f32x16 (&o)[4], LAS const unsigned char* vs, const bf16x8 (&pf)[4], int r32, int hi) {
    LAS const unsigned char* vb = vs + hi * 2048 + r32 * 16;
#pragma unroll
    for (int db = 0; db < 4; ++db) {
        bf16x8 va[4];
#pragma unroll
        for (int s = 0; s < 4; ++s) va[s] = *(LAS const bf16x8*)(vb + s * 4096 + db * 512);
#pragma unroll
        for (int s = 0; s < 4; ++s) o[db] = __builtin_amdgcn_mfma_f32_32x32x16_bf16(va[s], pf[s], o[db], 0, 0, 0);
        __builtin_amdgcn_sched_group_barrier(0x100, 4, 0); __builtin_amdgcn_sched_group_barrier(0x8, 4, 0);
    }
}
__device__ __forceinline__ void resc(f32x16 (&o)[4], float alpha) {
    if (__any(alpha < 1.f)) {
#pragma unroll
        for (int db = 0; db < 4; ++db)
#pragma unroll
            for (int r = 0; r < 16; ++r) o[db][r] *= alpha;
    }
}
__device__ __forceinline__ void unit(LAS unsigned char* lds, int b, int h, int qb, const bf16* QKP, const bf16* UVT, float lam, float lam_init, const float* subg, bf16* MIXB, float* stash, int wave, int lane) {
    asm volatile("" : "+v"(lane));
    const int r32 = lane & 31, hi = lane >> 5;
    const size_t tok0 = (size_t)b * S;
    const size_t qtok = tok0 + qb * 256 + wave * 32 + r32;
    constexpr int NT = S / 64;
#pragma unroll 1
    for (int c = 0; c < 2; ++c) {
        bf16x8 qf[4];
#pragma unroll
        for (int kk = 0; kk < 4; ++kk) qf[kk] = *(const GAS bf16x8*)(QKP + qtok * 1280 + h * 128 + c * 64 + kk * 16 + hi * 8);
        f32x16 o[4];
#pragma unroll
        for (int db = 0; db < 4; ++db)
#pragma unroll
            for (int r = 0; r < 16; ++r) o[db][r] = 0.f;
        float m = -INFINITY, l = 0.f, alA, alB;
        f32x16 pA0, pA1, pB0, pB1; bf16x8 pf[4];
        const char* kub = (const char*)(QKP + tok0 * 1280 + 512 + h * 128 + c * 64 + wave * 8);
        const char* vub = (const char*)(UVT + (size_t)(768 + h * 128) * M + tok0 + wave * 8);
        const unsigned kvo = (unsigned)lane * 2560u, vvo = (unsigned)lane * (unsigned)(M * 2);
#define ATT_DMA_K(t) __builtin_amdgcn_global_load_lds((const unsigned*)(kub + (size_t)(t) * (64 * 2560) + kvo), (LAS unsigned*)(lds + LDS_K + ((t) & 1) * KSLOT + wave * 1024), 16, 0, 0)
#define ATT_DMA_V(t) do { \
            __builtin_amdgcn_global_load_lds((const unsigned*)(vub + (size_t)(t) * 128 + vvo), (LAS unsigned*)(lds + LDS_V + ((t) & 1) * VSLOT + wave * 2048), 16, 0, 0); \
            __builtin_amdgcn_global_load_lds((const unsigned*)(vub + (size_t)64 * M * 2 + (size_t)(t) * 128 + vvo), (LAS unsigned*)(lds + LDS_V + ((t) & 1) * VSLOT + wave * 2048 + 1024), 16, 0, 0); } while (0)
#define SB() __builtin_amdgcn_sched_barrier(0)
#define ATT_SYNC() do { asm volatile("s_waitcnt vmcnt(0) lgkmcnt(0)" ::: "memory"); __builtin_amdgcn_s_barrier(); asm volatile("" ::: "memory"); } while (0)
        const bool early = wave < 4;
        ATT_SYNC();
        ATT_DMA_K(0); ATT_DMA_V(0);
        ATT_SYNC();
        ATT_DMA_K(1);
        qkt(pA0, pA1, lds + LDS_K, qf, r32, hi); partialSM(pA0, pA1, m, alA);
#pragma unroll 1
        for (int j = 1; j < NT - 1; j += 2) {
            ATT_SYNC(); if (early) { ATT_DMA_K(j + 1); ATT_DMA_V(j); }
            SB(); qkt(pB0, pB1, lds + LDS_K + KSLOT, qf, r32, hi); finishSM(pA0, pA1, alA, l, pf); SB();
            if (!early) { ATT_DMA_K(j + 1); ATT_DMA_V(j); }
            pv(o, lds + LDS_V, pf, r32, hi); partialSM(pB0, pB1, m, alB); SB(); resc(o, alB);
            ATT_SYNC(); if (early) { ATT_DMA_K(j + 2); ATT_DMA_V(j + 1); }
            SB(); qkt(pA0, pA1, lds + LDS_K, qf, r32, hi); finishSM(pB0, pB1, alB, l, pf); SB();
            if (!early) { ATT_DMA_K(j + 2); ATT_DMA_V(j + 1); }
            pv(o, lds + LDS_V + VSLOT, pf, r32, hi); partialSM(pA0, pA1, m, alA); SB(); resc(o, alA);
        }
        ATT_SYNC(); ATT_DMA_V(NT - 1);
        SB(); qkt(pB0, pB1, lds + LDS_K + KSLOT, qf, r32, hi); finishSM(pA0, pA1, alA, l, pf); SB();
        pv(o, lds + LDS_V, pf, r32, hi); partialSM(pB0, pB1, m, alB); SB(); resc(o, alB);
        ATT_SYNC();
        finishSM(pB0, pB1, alB, l, pf); pv(o, lds + LDS_V + VSLOT, pf, r32, hi);
#undef ATT_DMA_K
#undef ATT_DMA_V
#undef ATT_SYNC
#undef SB
        const float lt = xsum32(l);
        const int lane_e = (int)mk_lane_id();
        const int hi_e = lane_e >> 5; const size_t qtok_e = tok0 + qb * 256 + wave * 32 + (lane_e & 31);
        if (c == 0) {
            const float i1 = 1.f / lt;
#pragma unroll
            for (int db = 0; db < 4; ++db)
#pragma unroll
                for (int g4 = 0; g4 < 4; ++g4) *(GAS f32x4*)(stash + ((db * 4 + g4) * 64 + lane_e) * 4) = (f32x4){o[db][4 * g4] * i1, o[db][4 * g4 + 1] * i1, o[db][4 * g4 + 2] * i1, o[db][4 * g4 + 3] * i1};
        } else {
            const float i2 = lam / lt;
            float ss = 0.f;
#pragma unroll
            for (int db = 0; db < 4; ++db)
#pragma unroll
                for (int g4 = 0; g4 < 4; ++g4) { const f32x4 s1 = *(const GAS f32x4*)(stash + ((db * 4 + g4) * 64 + lane_e) * 4);
#pragma unroll
                    for (int i = 0; i < 4; ++i) { const float v = s1[i] - o[db][4 * g4 + i] * i2; o[db][4 * g4 + i] = v; ss += v * v; } }
            ss = xsum32(ss);
            const float rs = (1.f - lam_init) / sqrtf(ss * (1.f / 128.f) + 1e-5f);
            bf16* orow = MIXB + qtok_e * D + 256 + h * 128;
#pragma unroll
            for (int db = 0; db < 4; ++db)
#pragma unroll
                for (int g4 = 0; g4 < 4; ++g4) { const int e = 32 * db + 8 * g4 + 4 * hi_e; const f32x4 gg = *(const GAS f32x4*)(subg + e);
                    const unsigned long long w = (unsigned long long)pg8::cvt_pk_bf16(o[db][4 * g4] * rs * gg.x, o[db][4 * g4 + 1] * rs * gg.y) | ((unsigned long long)pg8::cvt_pk_bf16(o[db][4 * g4 + 2] * rs * gg.z, o[db][4 * g4 + 3] * rs * gg.w) << 32);
                    *(GAS unsigned long long*)(orow + e) = w; }
        }
    }
}
}
namespace hy {
typedef float f32x16 __attribute__((ext_vector_type(16)));
constexpr int CPY = 16456;
constexpr int LDS_F = 0, LDS_VV = 4 * CPY, LDS_END = LDS_VV + 32768;
static_assert(LDS_VV % 16 == 0 && LDS_END <= 131072, "hyena LDS map");

__device__ __forceinline__ void filter_item(LAS unsigned char* lds, int pb, const float* fw1, const float* fb1, const float* fr1, const float* fw2, const float* fb2, const float* fr2,
                                            const float* fw3, bf16* KF, float* PS, int wave, int lane) {
    LAS bf16* tile = (LAS bf16*)lds;
    LAS float* za = (LAS float*)(lds + 65536) + wave * 512;
    LAS float* zb = (LAS float*)(lds + 81920) + wave * 512;
    LAS float* sqs = (LAS float*)(lds + 98304);
    const int p0 = pb * 64 + wave * 8;
    if (lane < 33) {
#pragma unroll 1
        for (int pi = 0; pi < 8; ++pi) { const int p = p0 + pi; float z;
            if (lane == 0) z = (float)p / (float)(S - 1);
            else { const int bi = (lane - 1) & 15; const float band = 1e-4f + (float)bi * ((15.0f - 1e-4f) / 15.0f), wpos = 2.0f * 3.14159265358979323846f * (float)p / (float)S;
                   z = lane <= 16 ? cosf(wpos * band) : -sinf(wpos * band); }
            za[pi * 64 + lane] = z; }
    }
    LDS_WAIT(); asm volatile("" ::: "memory");
    float acc8[8];
    { const float b1 = fb1[lane];
#pragma unroll
      for (int pi = 0; pi < 8; ++pi) acc8[pi] = b1;
#pragma unroll 1
      for (int i = 0; i < 33; ++i) { const float w = fw1[i * 64 + lane];
#pragma unroll
          for (int pi = 0; pi < 8; ++pi) acc8[pi] += za[pi * 64 + i] * w; }
      const float f1 = fr1[lane];
#pragma unroll
      for (int pi = 0; pi < 8; ++pi) zb[pi * 64 + lane] = sinf(f1 * acc8[pi]); }
    LDS_WAIT(); asm volatile("" ::: "memory");
    { const float b2 = fb2[lane];
#pragma unroll
      for (int pi = 0; pi < 8; ++pi) acc8[pi] = b2;
#pragma unroll 1
      for (int i = 0; i < 64; ++i) { const float w = fw2[i * 64 + lane];
#pragma unroll
          for (int pi = 0; pi < 8; ++pi) acc8[pi] += zb[pi * 64 + i] * w; }
      const float f2 = fr2[lane];
      LDS_WAIT(); asm volatile("" ::: "memory");
#pragma unroll
      for (int pi = 0; pi < 8; ++pi) za[pi * 64 + lane] = sinf(f2 * acc8[pi]); }
    LDS_WAIT(); asm volatile("" ::: "memory");
    const float mind = logf(1e-2f) / 1.5f, maxd = logf(1e-2f) / 0.3f;
#pragma unroll 1
    for (int qh = 0; qh < 2; ++qh) {
        float ac[8][4];
#pragma unroll
        for (int pi = 0; pi < 8; ++pi)
#pragma unroll
            for (int q = 0; q < 4; ++q) ac[pi][q] = 0.f;
#pragma unroll 1
        for (int i = 0; i < 64; ++i) { float w[4];
#pragma unroll
            for (int q = 0; q < 4; ++q) w[q] = fw3[i * 512 + lane + 64 * (qh * 4 + q)];
#pragma unroll
            for (int pi = 0; pi < 8; ++pi) { const float hv = za[pi * 64 + i];
#pragma unroll
                for (int q = 0; q < 4; ++q) ac[pi][q] += hv * w[q]; } }
#pragma unroll
        for (int q = 0; q < 4; ++q) { const int col = lane + 64 * (qh * 4 + q), ch = col & 255; const float delta = fabsf(mind + (float)ch * ((maxd - mind) / 255.0f)); float sq = 0.f;
#pragma unroll
            for (int pi = 0; pi < 8; ++pi) { const int p = p0 + pi; const float val = ac[pi][q] * expf(-((float)p / (float)(S - 1)) * delta);
                if (!(col >= 256 && p == 0)) sq += val * val;
                tile[col * 64 + wave * 8 + pi] = (bf16)f2bf(val); }
            sqs[wave * 512 + col] = sq; }
    }
    LDS_WAIT(); __syncthreads();
    { const int p = pb * 64 + lane;
#pragma unroll 1
      for (int cc = 0; cc < 64; ++cc) { const int col = wave * 64 + cc; const bf16 v = tile[col * 64 + lane];
          if (col < 256) KF[(size_t)col * 8192 + 4095 - p] = v; else if (p != 0) KF[(size_t)(col - 256) * 8192 + 4095 + p] = v; } }
    { const int t = wave * 64 + lane; float s = 0.f;
#pragma unroll
      for (int w = 0; w < 8; ++w) s += sqs[w * 512 + t];
      PS[(size_t)pb * 512 + t] = s;
      if (pb == 0 && t < 256) KF[(size_t)t * 8192 + 8191] = 0; }
    LDS_WAIT(); __syncthreads();
}

__device__ __forceinline__ float conv1(float um, float u0, float up, float w0, float w1, float w2, float cb) { return um * w0 + u0 * w1 + up * w2 + cb; }

__device__ __forceinline__ void unit(LAS unsigned char* lds, int c, const bf16* KF, const float* PS, const bf16* UVT, const float* cw, const float* cb, const float* bias_d, bf16* HT, int wave, int lane) {
    asm volatile("" : "+s"(wave), "+v"(lane));
    const int tid = wave * 64 + lane;
    { const bf16* src = KF + (size_t)c * 8192;
#pragma unroll
      for (int i = 0; i < 2; ++i) { const int ch = tid + 512 * i; *(LAS v4u*)(lds + LDS_F + ch * 16) = *(const GAS v4u*)(src + ch * 8); } }
    { const float w0v = cw[512 + c], w1v = cw[768 + 512 + c], w2v = cw[1536 + 512 + c], cbv = cb[512 + c], w0x = cw[256 + c], w1x = cw[768 + 256 + c], w2x = cw[1536 + 256 + c], cbx = cb[256 + c];
      const bf16* rv = UVT + (size_t)(512 + c) * M; const bf16* rx = UVT + (size_t)(256 + c) * M;
#pragma unroll 1
      for (int i = 0; i < 4; ++i) { const int q = tid + 512 * i, b = q >> 9, sc = q & 511, s0 = sc * 8; const size_t g0 = (size_t)b * S + s0;
          const v4u av = *(const GAS v4u*)(rv + g0), ax = *(const GAS v4u*)(rx + g0);
          float uv[10], ux[10];
          uv[0] = s0 > 0 ? bf2f(rv[g0 - 1]) : 0.f; ux[0] = s0 > 0 ? bf2f(rx[g0 - 1]) : 0.f; uv[9] = s0 + 8 < S ? bf2f(rv[g0 + 8]) : 0.f; ux[9] = s0 + 8 < S ? bf2f(rx[g0 + 8]) : 0.f;
#pragma unroll
          for (int e = 0; e < 4; ++e) { uv[1 + 2 * e] = bf2f((bf16)av[e]); uv[2 + 2 * e] = bf2f((bf16)(av[e] >> 16)); ux[1 + 2 * e] = bf2f((bf16)ax[e]); ux[2 + 2 * e] = bf2f((bf16)(ax[e] >> 16)); }
          float o[8];
#pragma unroll
          for (int e = 0; e < 8; ++e) o[e] = conv1(uv[e], uv[e + 1], uv[e + 2], w0v, w1v, w2v, cbv) * conv1(ux[e], ux[e + 1], ux[e + 2], w0x, w1x, w2x, cbx);
          v4u w; w.x = pk2(o[0], o[1]); w.y = pk2(o[2], o[3]); w.z = pk2(o[4], o[5]); w.w = pk2(o[6], o[7]);
          *(LAS v4u*)(lds + LDS_VV + (((sc & 7) * 64 + (sc >> 3)) * 4 + b) * 16) = w; } }
    LDS_WAIT(); __syncthreads();
    {
#pragma unroll 1
      for (int i = 0; i < 4; ++i) { const int y = tid + 512 * i;
          const unsigned long long w0 = *(LAS const unsigned long long*)(lds + LDS_F + y * 8), w1 = *(LAS const unsigned long long*)(lds + LDS_F + y * 8 + 8);
#pragma unroll
          for (int p = 1; p < 4; ++p) *(LAS unsigned long long*)(lds + LDS_F + p * CPY + y * 8) = (w0 >> (16 * p)) | (w1 << (64 - 16 * p)); } }
    const float nrm = 1.0f / sqrtf(wave_sum(PS[(size_t)lane * 512 + c] + PS[(size_t)lane * 512 + 256 + c]) + 1e-6f);
    LDS_WAIT(); __syncthreads();
    const int r32 = lane & 31, hi = lane >> 5, gp = wave & 3, half = wave >> 2, iloc = r32 >> 2, b = r32 & 3;
    f32x16 acc[2][2];
#pragma unroll
    for (int rho = 0; rho < 2; ++rho)
#pragma unroll
        for (int gg = 0; gg < 2; ++gg)
#pragma unroll
            for (int r = 0; r < 16; ++r) acc[rho][gg][r] = 0.f;
    const int dlo = 16 * gp - 63 + (half ? 40 : 0), dn = half ? 39 : 40;
    int pa = LDS_F + (3 - (r32 & 3)) * CPY + (4092 - 4 * (r32 >> 2) + 8 * hi) * 2 - 64 - 128 * dlo;
    int jb = 16 * gp + iloc - dlo;
    const int pbase = LDS_VV + hi * 4096 + b * 16;
#pragma unroll 1
    for (int dd = 0; dd < dn; ++dd) {
        const int j0 = jb, j1 = jb + 8; const bool v0 = (unsigned)j0 < 64u, v1 = (unsigned)j1 < 64u;
        LAS const unsigned char* ap = lds + pa; LAS const unsigned char* bp0 = lds + pbase + (v0 ? j0 : 0) * 64; LAS const unsigned char* bp1 = lds + pbase + (v1 ? j1 : 0) * 64;
#pragma unroll
        for (int k = 0; k < 4; ++k) {
            typedef unsigned long long u64;
            const u64 a00 = *(LAS const u64*)(ap + 64 + 32 * k), a01 = *(LAS const u64*)(ap + 64 + 32 * k + 8), a10 = *(LAS const u64*)(ap + 32 * k), a11 = *(LAS const u64*)(ap + 32 * k + 8);
            v4u b0 = *(LAS const v4u*)(bp0 + k * 8192), b1 = *(LAS const v4u*)(bp1 + k * 8192);
            if (!v0) b0 = (v4u){0u, 0u, 0u, 0u};
            if (!v1) b1 = (v4u){0u, 0u, 0u, 0u};
            const bf16x8 fa0 = __builtin_bit_cast(bf16x8, (v4u){(unsigned)a00, (unsigned)(a00 >> 32), (unsigned)a01, (unsigned)(a01 >> 32)});
            const bf16x8 fa1 = __builtin_bit_cast(bf16x8, (v4u){(unsigned)a10, (unsigned)(a10 >> 32), (unsigned)a11, (unsigned)(a11 >> 32)});
            const bf16x8 fb0 = __builtin_bit_cast(bf16x8, b0), fb1 = __builtin_bit_cast(bf16x8, b1);
            acc[0][0] = __builtin_amdgcn_mfma_f32_32x32x16_bf16(fa0, fb0, acc[0][0], 0, 0, 0);
            acc[0][1] = __builtin_amdgcn_mfma_f32_32x32x16_bf16(fa0, fb1, acc[0][1], 0, 0, 0);
            acc[1][0] = __builtin_amdgcn_mfma_f32_32x32x16_bf16(fa1, fb0, acc[1][0], 0, 0, 0);
            acc[1][1] = __builtin_amdgcn_mfma_f32_32x32x16_bf16(fa1, fb1, acc[1][1], 0, 0, 0);
        }
        pa -= 128; jb -= 1;
    }
    LDS_WAIT(); __syncthreads();
    { LAS float* xw = (LAS float*)(lds + LDS_F) + (gp * 2 + (half ? 0 : 1)) * 2048 + lane;
#pragma unroll
      for (int gg = 0; gg < 2; ++gg)
#pragma unroll
          for (int r = 0; r < 16; ++r) xw[(gg * 16 + r) * 64] = half ? acc[0][gg][r] : acc[1][gg][r]; }
    LDS_WAIT(); __syncthreads();
    f32x16 fin[2];
    { LAS const float* xr = (LAS const float*)(lds + LDS_F) + (gp * 2 + (half ? 1 : 0)) * 2048 + lane;
#pragma unroll
      for (int gg = 0; gg < 2; ++gg)
#pragma unroll
          for (int r = 0; r < 16; ++r) fin[gg][r] = (half ? acc[1][gg][r] : acc[0][gg][r]) + xr[(gg * 16 + r) * 64]; }
    { const float bd = bias_d[c], w0 = cw[c], w1 = cw[768 + c], w2 = cw[1536 + c], cb0 = cb[c]; const bf16* r0p = UVT + (size_t)c * M; bf16* hrow = HT + (size_t)c * M;
#pragma unroll
      for (int gg = 0; gg < 2; ++gg)
#pragma unroll
          for (int g4 = 0; g4 < 4; ++g4) { const int i = 16 * gp + 8 * gg + iloc, rr = 32 * half + 8 * g4 + 4 * hi, t0 = 64 * i + rr; const size_t tok = (size_t)b * S + t0;
              const unsigned long long vw = *(LAS const unsigned long long*)(lds + LDS_VV + (((rr >> 3) * 64 + i) * 4 + b) * 16 + (rr & 7) * 2);
              const unsigned long long uw = *(const GAS unsigned long long*)(r0p + tok);
              float u[6]; u[0] = t0 > 0 ? bf2f(r0p[tok - 1]) : 0.f; u[5] = t0 + 4 < S ? bf2f(r0p[tok + 4]) : 0.f;
              u[1] = bf2f((bf16)uw); u[2] = bf2f((bf16)(uw >> 16)); u[3] = bf2f((bf16)(uw >> 32)); u[4] = bf2f((bf16)(uw >> 48));
              float o[4];
#pragma unroll
              for (int e = 0; e < 4; ++e) { const float vv = bf2f((bf16)(vw >> (16 * e))); o[e] = (nrm * fin[gg][4 * g4 + e] + vv * bd) * conv1(u[e], u[e + 1], u[e + 2], w0, w1, w2, cb0); }
              *(GAS unsigned long long*)(hrow + tok) = (unsigned long long)pk2(o[0], o[1]) | ((unsigned long long)pk2(o[2], o[3]) << 32); } }
    LDS_WAIT(); __syncthreads();
}
__device__ __forceinline__ void transpose_slab(LAS unsigned char* lds, int slab, const bf16* HT, bf16* MIXB, int wave, int lane) {
    const int tid = wave * 64 + lane; LAS bf16* tile = (LAS bf16*)lds;
#pragma unroll 1
    for (int i = 0; i < 4; ++i) { const int q = tid + 512 * i, c = q >> 3, tc = q & 7; const v4u w = *(const GAS v4u*)(HT + (size_t)c * M + (size_t)slab * 64 + tc * 8);
#pragma unroll
        for (int e = 0; e < 4; ++e) { tile[(tc * 8 + 2 * e) * 264 + c] = (bf16)w[e]; tile[(tc * 8 + 2 * e + 1) * 264 + c] = (bf16)(w[e] >> 16); } }
    LDS_WAIT(); __syncthreads();
#pragma unroll 1
    for (int i = 0; i < 4; ++i) { const int q = tid + 512 * i, tk = q >> 5, cc = q & 31;
        *(GAS v4u*)(MIXB + ((size_t)slab * 64 + tk) * D + cc * 8) = *(LAS const v4u*)(lds + (tk * 264 + cc * 8) * 2); }
    LDS_WAIT(); __syncthreads();
}
}
#ifndef DUP_PRO
#define DUP_PRO 1
#endif
#ifndef DUP_IN
#define DUP_IN 1
#endif
#ifndef DUP_HY
#define DUP_HY 1
#endif
#ifndef DUP_POOL
#define DUP_POOL 1
#endif
#ifndef DUP_HYT
#define DUP_HYT 1
#endif
#ifndef DUP_ATT
#define DUP_ATT 1
#endif
#ifndef DUP_OUT
#define DUP_OUT 1
#endif
#ifndef DUP_LN1
#define DUP_LN1 1
#endif
#ifndef DUP_MOE1
#define DUP_MOE1 1
#endif
#ifndef DUP_MOE2
#define DUP_MOE2 1
#endif
#ifndef DUP_LN2
#define DUP_LN2 1
#endif
#ifndef EN_HY
#define EN_HY 1
#endif
#ifndef EN_HYT
#define EN_HYT 1
#endif
#ifndef EN_PRO
#define EN_PRO 1
#endif
#ifndef EN_IN
#define EN_IN 1
#endif
#ifndef EN_ATT
#define EN_ATT 1
#endif
#ifndef EN_POOL
#define EN_POOL 1
#endif
#ifndef EN_OUT
#define EN_OUT 1
#endif
#ifndef EN_LN1
#define EN_LN1 1
#endif
#ifndef EN_WCV
#define EN_WCV 1
#endif
#ifndef EN_MOE1
#define EN_MOE1 1
#endif
#ifndef EN_MOE2
#define EN_MOE2 1
#endif
#ifndef EN_LN2
#define EN_LN2 1
#endif
constexpr int RING_BYTES = 135168;
constexpr int LDSCTL_OFF = RING_BYTES, MISC_OFF = LDSCTL_OFF + 320, MOETAB_OFF = LDSCTL_OFF + 1024, ROUTE_OFF = LDSCTL_OFF + 2048;
constexpr int LDS_BYTES = 151552;

struct Args { const float* in[38]; float* out; unsigned char* ws; int* eid; float* wts; int ph_lo, ph_hi, l_lo, l_hi, single, pad; };
enum { PH_PRO = 0, PH_IN = 1, PH_ATT = 2, PH_POOL = 3, PH_OUT = 4, PH_LN1 = 5, PH_WCV = 6, PH_MOE1 = 7, PH_MOE2 = 8, PH_LN2 = 9, PH_HY = 10, PH_HYT = 11, PH_END = 12 };

__global__ void __launch_bounds__(NWAVES * 64, 2) mk_fwd(Args a) {
    extern __shared__ __attribute__((aligned(16))) unsigned char lds_raw[];
    LAS unsigned char* lds = (LAS unsigned char*)lds_raw;
    volatile LAS unsigned* MISC = (volatile LAS unsigned*)(lds + MISC_OFF);
    const int wave_s = __builtin_amdgcn_readfirstlane((int)threadIdx.x >> 6);
    const int G = gridDim.x, bx = blockIdx.x, vcu0 = (G % 8 == 0) ? (bx % 8) * (G / 8) + bx / 8 : bx;
    gu32* ctl0 = (gu32*)(a.ws + WS_CTL);
    for (int u = wave_s * 64 + (int)mk_lane_id(); u < (LDS_BYTES - LDSCTL_OFF) / 4; u += NWAVES * 64) ((LAS unsigned*)(lds + LDSCTL_OFF))[u] = 0u;
    __syncthreads();
    XcdBarrier bar; bar.bar = (unsigned*)(ctl0 + CW_BAR); bar.x = 0; bar.st = nullptr;
#if defined(MK_PER_PHASE)
    if (!a.single)
#endif
    bar = xcd_barrier_post((unsigned*)(ctl0 + CW_BAR), MISC + 8, wave_s);
#if defined(MK_PER_PHASE)
#define IN(k) (a.ph_lo <= (k) && (k) < a.ph_hi)
#define SEAM() do { if (!a.single) xcd_barrier(bar, wave_s); } while (0)
#else
#define IN(k) 1
#if defined(PROBE_BAR2)
#define SEAM() do { xcd_barrier(bar, wave_s); xcd_barrier(bar, wave_s); } while (0)
#else
#define SEAM() xcd_barrier(bar, wave_s)
#endif
#endif
    const int NGW = G * NWAVES;
#define PHASE_PTRS() int lane_ = (int)mk_lane_id(); asm volatile("" : "+v"(lane_)); const int lane = lane_, wave = wave_s; int vcu = vcu0; asm volatile("" : "+s"(vcu)); (void)wave; const int gw = vcu * NWAVES + wave; (void)gw; unsigned char* ws = a.ws; gu32* ctl = (gu32*)(ws + WS_CTL); (void)ctl; \
    bf16* XB = (bf16*)(ws + WS_XB); bf16* QKP = (bf16*)(ws + WS_QKP); bf16* UVT = (bf16*)(ws + WS_UVT); float* CS = (float*)(ws + WS_CS); bf16* MIXB = (bf16*)(ws + WS_MIXB); \
    (void)XB; (void)QKP; (void)UVT; (void)CS; (void)MIXB
#define INP(k) (a.in[k])
#define WCV_LAYER(LEXPR, GW_, NGW_) do { const int wl_ = (LEXPR), wg_ = (GW_), wn_ = (NGW_); const int l = wl_, gw = wg_, NGW = wn_; (void)NGW; \
            LAS float* scr = (LAS float*)(lds + wave * 16384); \
            unsigned char* wb_ = ws + WS_WBUF + (size_t)(l & 1) * WBUF_STRIDE; bf16* W13 = (bf16*)(wb_ + WB_W13); bf16* W2 = (bf16*)(wb_ + WB_W2); bf16* WG = (bf16*)(wb_ + WB_WG); bf16* WP = (bf16*)(wb_ + WB_WP); \
            for (int it = gw; it < 6784; it += NGW) { \
                const float* src; int K, N, k0, n0, mode = 0; bf16* dst; \
                if (it < 4096) { const int which = it >> 11, r = it & 2047, e = r >> 7, kb = (r >> 3) & 15, nb = r & 7; \
                    src = INP(which ? 31 : 30) + ((size_t)l * 16 + e) * D * 256; K = D; N = 256; k0 = kb * 64; n0 = nb * 32; mode = 1 + which; dst = W13 + (size_t)e * 512 * D; \
                } else if (it < 6144) { const int r = it - 4096, e = r >> 7, kb = (r >> 5) & 3, nb = r & 31; \
                    src = INP(32) + ((size_t)l * 16 + e) * 256 * D; K = 256; N = D; k0 = kb * 64; n0 = nb * 32; dst = W2 + (size_t)e * D * 256 + (size_t)n0 * 256; \
                } else if (it < 6656) { const int r = it - 6144, kb = r >> 5, nb = r & 31; \
                    src = INP(33) + (size_t)l * D * D; K = D; N = D; k0 = kb * 64; n0 = nb * 32; dst = WG + (size_t)n0 * D; \
                } else { const int r = it - 6656, kb = r >> 5, nb = r & 31; \
                    src = INP(35) + (size_t)l * 256 * D; K = 256; N = D; k0 = kb * 64; n0 = nb * 32; dst = WP + (size_t)n0 * 256; } \
                p0_transpose_block(src, K, N, k0, n0, dst, mode, scr, lane); \
            } \
            const int ln = lane; \
            const float* ps = INP(1) + (size_t)l * M * 256; bf16* PB = (bf16*)(wb_ + WB_PB); \
            for (size_t i = ((size_t)gw * 64 + ln) * 8; i < (size_t)M * 256; i += (size_t)NGW * 64 * 8) { const f32x4 x0 = *(const GAS f32x4*)(ps + i), x1 = *(const GAS f32x4*)(ps + i + 4); \
                v4u o; o.x = pk2(x0.x, x0.y); o.y = pk2(x0.z, x0.w); o.z = pk2(x1.x, x1.y); o.w = pk2(x1.z, x1.w); *(GAS v4u*)(PB + i) = o; } \
    } while (0)

    if (EN_PRO && IN(PH_PRO)) {
            PHASE_PTRS();
            for (int rep_ = 0; rep_ < DUP_PRO; ++rep_) {
        LAS float* scr = (LAS float*)(lds + wave * 16384);
        for (int it = gw; it < DEPTH * (16 * 72 + 16 * 32); it += NGW) {
            const int l = it / 1664, r = it % 1664; const float* src; int N, k0, n0; bf16* dst;
            if (r < 1152) { const int kb = r / 72, nb = r % 72; n0 = nb * 32; k0 = kb * 64; N = INW; src = INP(4) + (size_t)l * D * INW;
                bf16* wsw = (bf16*)(ws + WS_WIN + (size_t)l * WIN_LAYER); bf16* wnm = wsw + 1280 * 1024;
                dst = n0 < 768 ? wsw + (size_t)n0 * D : (n0 < 1792 ? wnm + (size_t)(n0 - 768) * D : wsw + (size_t)(768 + n0 - 1792) * D); }
            else { const int q = r - 1152, kb = q >> 5, nb = q & 31; n0 = nb * 32; k0 = kb * 64; N = D; src = INP(23) + (size_t)l * D * D; dst = (bf16*)(ws + WS_WOUT + (size_t)l * WOUT_LAYER) + (size_t)n0 * D; }
            p0_transpose_block(src, D, N, k0, n0, dst, 0, scr, lane);
            }
        }
        for (int it = gw; it < DEPTH * 4 * 16 * 2; it += NGW) {
            const int l = it >> 7, g = (it >> 5) & 3, dh = (it >> 4) & 1, k = (it & 15) * 64 + lane;
            const float* wrow = INP(4) + (size_t)l * D * INW + (size_t)k * INW + 2304 + g * 64;
            const float* pw = INP(20) + (size_t)(l * 4 + g) * 64 * 64 + dh * 32;
            float acc[32];
#pragma unroll
            for (int d = 0; d < 32; ++d) acc[d] = 0.f;
#pragma unroll 1
            for (int c = 0; c < 64; ++c) { const float x = wrow[c];
#pragma unroll
                for (int d = 0; d < 32; ++d) acc[d] += x * pw[c * 64 + d]; }
            bf16* dst = (bf16*)(ws + WS_WIN + (size_t)l * WIN_LAYER) + (size_t)(1280 + 1024 + g * 64 + dh * 32) * D + k;
#pragma unroll
            for (int d = 0; d < 32; ++d) dst[(size_t)d * D] = (bf16)f2bf(acc[d]);
        }
        for (int i = gw * 64 + lane; i < DEPTH * 32 * D; i += NGW * 64) { const int l2 = i / (32 * D), r = i % (32 * D), col = r / D, k = r % D;
            const float w = col < 4 ? INP(26)[((size_t)l2 * D + k) * 4 + col] : (col < 20 ? INP(28)[((size_t)l2 * D + k) * 16 + col - 4] : 0.f);
            const unsigned hb = f2bf(w); const float lo = w - __uint_as_float(hb << 16);
            bf16* dst = (bf16*)(ws + WS_WR) + (size_t)l2 * 64 * D; dst[(size_t)col * D + k] = (bf16)hb; dst[(size_t)(32 + col) * D + k] = (bf16)f2bf(lo); }
        int ln2 = lane; asm volatile("" : "+v"(ln2));
        for (int i = gw * 64 + ln2; i < S * 8; i += NGW * 64) { const int pos = i >> 3, j = i & 7; const float ang = (float)pos * powf(500000.0f, -(float)(2 * j) / 16.0f);
            CS[pos * 16 + j] = cosf(ang); CS[pos * 16 + 8 + j] = sinf(ang); }
        for (int m = gw; m < M; m += NGW) ln_row(INP(0) + (size_t)m * D, 1.f, nullptr, nullptr, nullptr, INP(2), INP(3), nullptr, XB + (size_t)m * D, lane);
        WCV_LAYER(0, gw, NGW);
        LDS_WAIT(); __syncthreads();
        for (int it = vcu; it < DEPTH * 64; it += G) { const int fl = it >> 6, pb = it & 63;
            hy::filter_item(lds, pb, INP(7) + fl * 33 * 64, INP(8) + fl * 64, INP(9) + fl * 64, INP(10) + fl * 64 * 64, INP(11) + fl * 64, INP(12) + fl * 64, INP(13) + fl * 64 * 512,
                            (bf16*)(ws + WS_KF) + (size_t)fl * 256 * 8192, (float*)(ws + WS_PS) + (size_t)fl * 64 * 512, wave, lane); }
        SEAM();
    }
#if defined(MK_PER_PHASE)
    for (int l = a.l_lo; l < a.l_hi; ++l) {
#else
#pragma unroll 1
    for (int l = 0; l < DEPTH; ++l) {
#endif
        if (EN_IN && IN(PH_IN)) {
            PHASE_PTRS();
            for (int rep_ = 0; rep_ < DUP_IN; ++rep_) {
            const char* wsw = (const char*)(ws + WS_WIN + (size_t)l * WIN_LAYER);
            SchedIn Sc{vcu, G, (const char*)XB, wsw, wsw + (size_t)1280 * 1024 * 2};
            EpiIn E{QKP, UVT, CS};
            pg8::gemm_phase<EpiIn, SchedIn>(lds, D, Sc, E, wave);
            { SchedSq Sc2{vcu, G / 2, (const char*)(ws + WS_WBUF + (size_t)(l & 1) * WBUF_STRIDE + WB_PB), (const char*)(ws + WS_WBUF + (size_t)(l & 1) * WBUF_STRIDE + WB_WP), (size_t)256 * 256 * 2, (size_t)256 * 256 * 2, G / 2};
              EpiPle<0> E2{(bf16*)(ws + WS_YP), nullptr};
              pg8::gemm_phase<EpiPle<0>, SchedSq>(lds, 256, Sc2, E2, wave); }
            }
            SEAM();
        }
        if (EN_HY && IN(PH_HY)) {
            PHASE_PTRS();
            for (int rep_ = 0; rep_ < DUP_HY; ++rep_) {
            for (int c = vcu; c < 256; c += G)
                hy::unit(lds, c, (const bf16*)(ws + WS_KF) + (size_t)l * 256 * 8192, (const float*)(ws + WS_PS) + (size_t)l * 64 * 512, UVT, INP(5) + l * 3 * 768, INP(6) + l * 768, INP(14) + l * 256, (bf16*)(ws + WS_HT), wave, lane);
            }
        }
        if (EN_POOL && IN(PH_POOL)) {
            PHASE_PTRS();
            for (int rep_ = 0; rep_ < DUP_POOL; ++rep_) {
            int ln = lane; asm volatile("" : "+v"(ln));
            const int cc = (ln & 31) * 8, gq = cc >> 6, hw = 1 << gq;
            const float* pb = INP(21) + l * 256 + cc; const float* psc = INP(22) + l * 256 + cc;
            for (int it = gw; it < M / 2; it += NGW) {
                const int tok = it * 2 + (ln >> 5), pos = tok & (S - 1);
                int lo = pos - hw, hi2 = pos + hw - 1; lo = lo < 0 ? 0 : lo; hi2 = hi2 > S - 1 ? S - 1 : hi2;
                float sacc[8];
#pragma unroll
                for (int e = 0; e < 8; ++e) sacc[e] = 0.f;
                const bf16* zp = QKP + (size_t)(tok - pos) * 1280 + 1024 + cc;
                for (int r = lo; r <= hi2; ++r) { const v4u w = *(const GAS v4u*)(zp + (size_t)r * 1280);
                    sacc[0] += bf2f((bf16)w.x); sacc[1] += bf2f((bf16)(w.x >> 16)); sacc[2] += bf2f((bf16)w.y); sacc[3] += bf2f((bf16)(w.y >> 16));
                    sacc[4] += bf2f((bf16)w.z); sacc[5] += bf2f((bf16)(w.z >> 16)); sacc[6] += bf2f((bf16)w.w); sacc[7] += bf2f((bf16)(w.w >> 16)); }
                const float inv = 1.f / (float)(hi2 - lo + 1);
                const v4u w = *(const GAS v4u*)(zp + (size_t)pos * 1280);
                float z[8] = {bf2f((bf16)w.x), bf2f((bf16)(w.x >> 16)), bf2f((bf16)w.y), bf2f((bf16)(w.y >> 16)), bf2f((bf16)w.z), bf2f((bf16)(w.z >> 16)), bf2f((bf16)w.w), bf2f((bf16)(w.w >> 16))};
                float y[8];
#pragma unroll
                for (int e = 0; e < 8; ++e) y[e] = (sacc[e] * inv - z[e] + pb[e]) * psc[e];
                v4u o; o.x = pk2(y[0], y[1]); o.y = pk2(y[2], y[3]); o.z = pk2(y[4], y[5]); o.w = pk2(y[6], y[7]);
                *(GAS v4u*)(MIXB + (size_t)tok * D + 768 + cc) = o;
            }
            }
            SEAM();
        }
        if (EN_HYT && IN(PH_HYT)) {
            PHASE_PTRS();
            for (int rep_ = 0; rep_ < DUP_HYT; ++rep_) {
            for (int s = vcu; s < 256; s += G) hy::transpose_slab(lds, s, (const bf16*)(ws + WS_HT), MIXB, wave, lane);
            }
        }
        if (EN_ATT && IN(PH_ATT)) {
            PHASE_PTRS();
            for (int rep_ = 0; rep_ < DUP_ATT; ++rep_) {
            const float lam_init = 0.8f - 0.6f * expf(-0.3f * (float)l);
            int ln = lane; asm volatile("" : "+v"(ln));
            const float lam = expf(wave_sum(INP(15)[l * 64 + ln] * INP(16)[l * 64 + ln])) - expf(wave_sum(INP(17)[l * 64 + ln] * INP(18)[l * 64 + ln])) + lam_init;
            for (int u = vcu; u < 256; u += G) att::unit(lds, (u >> 4) >> 2, (u >> 4) & 3, u & 15, QKP, UVT, lam, lam_init, INP(19) + l * 128, MIXB, (float*)(ws + WS_STASH) + ((size_t)u * 8 + wave) * 4096, wave, lane);
            }
            SEAM();
        }
        if (EN_OUT && IN(PH_OUT)) {
            PHASE_PTRS();
            for (int rep_ = 0; rep_ < DUP_OUT; ++rep_) {
            SchedOut Sc{vcu, G, (const char*)MIXB, (const char*)(ws + WS_WOUT + (size_t)l * WOUT_LAYER)};
#if defined(PROBE_OUT)
            { EpiRes E0{(bf16*)(ws + WS_STASH)}; pg8::gemm_phase<EpiRes, SchedOut>(lds, D, Sc, E0, wave); }
#endif
            EpiRes E{XB};
            pg8::gemm_phase<EpiRes, SchedOut>(lds, D, Sc, E, wave);
            }
            SEAM();
        }
        if (EN_LN1 && IN(PH_LN1)) {
            PHASE_PTRS();
            for (int rep_ = 0; rep_ < DUP_LN1; ++rep_) {
            int ln = lane; asm volatile("" : "+v"(ln));
#if defined(PROBE_LN1)
            for (int ch = vcu; ch < M / 64; ch += G)
                ln1_router_chunk<PROBE_LN1>((LAS RouteLds*)(lds + ROUTE_OFF), lds, ch * 64, XB, (bf16*)(ws + WS_STASH), INP(24) + l * D, INP(25) + l * D, (const bf16*)(ws + WS_WR) + (size_t)l * 64 * D, INP(27) + l * 4, INP(29) + l * 16,
                                 ctl + CW_CNT + l * 16 * CNT_STRIDE, (int*)(ws + WS_TOKIDX), (float*)(ws + WS_GATE), wave, lane);
#endif
            for (int ch = vcu; ch < M / 64; ch += G)
                ln1_router_chunk((LAS RouteLds*)(lds + ROUTE_OFF), lds, ch * 64, XB, XB, INP(24) + l * D, INP(25) + l * D, (const bf16*)(ws + WS_WR) + (size_t)l * 64 * D, INP(27) + l * 4, INP(29) + l * 16,
                                 ctl + CW_CNT + l * 16 * CNT_STRIDE, (int*)(ws + WS_TOKIDX), (float*)(ws + WS_GATE), wave, lane);
            }
            SEAM();
        }
        if (EN_MOE1 && IN(PH_MOE1)) {
            PHASE_PTRS();
            for (int rep_ = 0; rep_ < DUP_MOE1; ++rep_) {
            moe_tab_build((LAS int*)(lds + MOETAB_OFF), ctl + CW_CNT + l * 16 * CNT_STRIDE, wave == 0 && lane == 0); const MoeTab T{(LAS const int*)(lds + MOETAB_OFF)};
            { SchedMoe<2> Sc{vcu, G, T, (const char*)XB, (const char*)(ws + WS_WBUF + (size_t)(l & 1) * WBUF_STRIDE + WB_W13), (size_t)512 * D * 2, (const int*)(ws + WS_TOKIDX), 0};
              EpiMoe1 E{(bf16*)(ws + WS_ACT), (const float*)(ws + WS_GATE), T};
              pg8::gemm_phase<EpiMoe1, SchedMoe<2>, true>(lds, D, Sc, E, wave);
#if defined(PROBE_MOE1A)
              pg8::gemm_phase<EpiMoe1, SchedMoe<2>, true>(lds, D, Sc, E, wave);
#endif
            }
            { SchedSq Sc{vcu, G, (const char*)XB, (const char*)(ws + WS_WBUF + (size_t)(l & 1) * WBUF_STRIDE + WB_WG), TILEB, TILEB, 0};
              EpiPle<1> E{(bf16*)(ws + WS_YP), INP(34) + l * D};
              pg8::gemm_phase<EpiPle<1>, SchedSq>(lds, D, Sc, E, wave); }
            if (l + 1 < DEPTH) {
                int x2 = 2 * T.pre(16) - G; x2 = x2 < 0 ? 0 : (x2 > G / 2 ? G / 2 : x2);
                if (vcu >= x2) WCV_LAYER(l + 1, (vcu - x2) * NWAVES + wave, (G - x2) * NWAVES);
            }
            }
            SEAM();
        }
        if (EN_MOE2 && IN(PH_MOE2)) {
            PHASE_PTRS();
            for (int rep_ = 0; rep_ < DUP_MOE2; ++rep_) {
            moe_tab_build((LAS int*)(lds + MOETAB_OFF), ctl + CW_CNT + l * 16 * CNT_STRIDE, wave == 0 && lane == 0); const MoeTab T{(LAS const int*)(lds + MOETAB_OFF)};
            SchedMoe<4> Sc{vcu, G, T, (const char*)(ws + WS_ACT), (const char*)(ws + WS_WBUF + (size_t)(l & 1) * WBUF_STRIDE + WB_W2), (size_t)D * 256 * 2, (const int*)(ws + WS_TOKIDX), (size_t)256 * 256 * 2};
            EpiMoe2 E{(bf16*)(ws + WS_YMOE), (const int*)(ws + WS_TOKIDX), T};
            pg8::gemm_phase<EpiMoe2, SchedMoe<4>>(lds, 256, Sc, E, wave);
            }
            SEAM();
        }
        if (EN_LN2 && IN(PH_LN2)) {
            PHASE_PTRS();
            for (int rep_ = 0; rep_ < DUP_LN2; ++rep_) {
            int ln = lane; asm volatile("" : "+v"(ln));
            const bf16* YM = (const bf16*)(ws + WS_YMOE); const bf16* YP = (const bf16*)(ws + WS_YP);
            const bool lastl = (l == DEPTH - 1);
#if defined(PROBE_LN2)
            for (int m = gw; m < M; m += NGW)
                ln_row(XB + (size_t)m * D, DN_ALPHA, YM + (size_t)(2 * m) * D, YM + (size_t)(2 * m + 1) * D, YP + (size_t)m * D, INP(36) + l * D, INP(37) + l * D, (float*)nullptr, (bf16*)(ws + WS_STASH) + (size_t)m * D, ln);
#endif
            for (int m = gw; m < M; m += NGW)
                ln_row(XB + (size_t)m * D, DN_ALPHA, YM + (size_t)(2 * m) * D, YM + (size_t)(2 * m + 1) * D, YP + (size_t)m * D, INP(36) + l * D, INP(37) + l * D,
                       lastl ? a.out + (size_t)m * D : (float*)nullptr, lastl ? nullptr : XB + (size_t)m * D, ln);
            }
            if (l != DEPTH - 1) SEAM();
        }
    }
#undef IN
#undef SEAM
}
static void mk_launch(const Args& base, int ph, int l, int grid, hipStream_t stream) {
    Args a = base; a.ph_lo = ph; a.ph_hi = ph + 1; a.l_lo = l; a.l_hi = l + 1; a.single = 1;
    hipLaunchKernelGGL(mk_fwd, dim3(grid), dim3(NWAVES * 64), LDS_BYTES, stream, a);
}
extern "C" void kernel_launch(void* const* d_in, const int* in_sizes, int n_in, void* d_out, int out_size, void* d_ws, size_t ws_size, hipStream_t stream) {
    (void)in_sizes; (void)n_in; (void)out_size; (void)ws_size;
    static int grid = 0;
    if (grid == 0) {
        int dev = 0, cus = 0;
        if (hipGetDevice(&dev) != hipSuccess || hipDeviceGetAttribute(&cus, hipDeviceAttributeMultiprocessorCount, dev) != hipSuccess) { grid = -1; return; }
        if (hipFuncSetAttribute((const void*)mk_fwd, hipFuncAttributeMaxDynamicSharedMemorySize, LDS_BYTES) != hipSuccess) { grid = -1; return; }
        (void)hipGetLastError();
        grid = cus;
    }
    if (grid < 0) return;
    (void)hipMemsetAsync((char*)d_ws + WS_CTL, 0, CTL_ZERO_BYTES, stream);
    Args base{};
    for (int i = 0; i < 38; ++i) base.in[i] = (const float*)d_in[i];
    base.out = (float*)d_out; base.ws = (unsigned char*)d_ws;
    base.eid = nullptr; base.wts = nullptr;
#if defined(MK_PER_PHASE)
    mk_launch(base, PH_PRO, 0, grid, stream);
    for (int l = 0; l < DEPTH; ++l) for (int ph : {PH_IN, PH_HY, PH_HYT, PH_ATT, PH_POOL, PH_OUT, PH_LN1, PH_WCV, PH_MOE1, PH_MOE2, PH_LN2}) mk_launch(base, ph, l, grid, stream);
#else
    Args a = base; a.ph_lo = 0; a.ph_hi = PH_END; a.l_lo = 0; a.l_hi = DEPTH; a.single = 0;
    hipLaunchKernelGGL(mk_fwd, dim3(grid), dim3(NWAVES * 64), LDS_BYTES, stream, a);
#endif
}
```

```cpp
#include <hip/hip_runtime.h>
#include <stdint.h>
#include <math.h>
namespace pg8 {
#define PG8_LAS __attribute__((address_space(3)))
typedef unsigned short bf16_t;
typedef short bf16x8 __attribute__((ext_vector_type(8)));
typedef float f32x4 __attribute__((ext_vector_type(4)));
typedef unsigned u32x4 __attribute__((ext_vector_type(4)));
constexpr int BM = 256, BK = 64, HALF = 128, HTB = HALF * BK * 2  , STAGE_BYTES = 8 * HTB;

__host__ __device__ __forceinline__ int lds_byte(int r, int c) { const int st = (r >> 4) * 2 + (c >> 5), rr = r & 15, cc = c & 31, ob = rr * 64 + cc * 2; return st * 1024 + (ob ^ (((ob >> 9) & 1) << 5)); }
__host__ __device__ __forceinline__ void stage_rc(int b, int& R, int& C) { const int st = b / 1024, sb = b % 1024, swz = sb ^ (((sb >> 9) & 1) << 5); R = (st >> 1) * 16 + swz / 64; C = (st & 1) * 32 + (swz % 64) / 2; }
__host__ __device__ __forceinline__ int perm32(int rho) { const int n = rho >> 4, i = rho & 15; return 8 * (i >> 2) + 4 * n + (i & 3); }

struct Unit { const char* A; const char* B; int kind, pm, pn, aux; };

__device__ __forceinline__ unsigned cvt_pk_bf16(float lo, float hi) { unsigned r; asm volatile("v_cvt_pk_bf16_f32 %0, %1, %2" : "=v"(r) : "v"(lo), "v"(hi)); return r; }

template <class Epi, class Sched, bool GATHER = false>
__device__ __forceinline__ void gemm_phase(PG8_LAS unsigned char* lds, const int K_, const Sched& S, const Epi& E, const int wave_) {
    int K = K_; asm volatile("" : "+s"(K));
    int tid_; asm volatile("v_mbcnt_lo_u32_b32 %0, -1, 0\n\tv_mbcnt_hi_u32_b32 %0, -1, %0" : "=v"(tid_)); tid_ += wave_ * 64;
    const int tid = tid_, wid = __builtin_amdgcn_readfirstlane(tid >> 6), lane = tid & 63, wr = wid >> 2, wc = wid & 3, fr = lane & 15, fq = lane >> 4;
    const int nt = K / BK;
    unsigned voffA[2][2], voffN[2][2] = {{0u, 0u}, {0u, 0u}}, voffB[2]; int RA[2], CA[2];
#pragma unroll
    for (int i = 0; i < 2; ++i) { int R, C; stage_rc(tid * 16 + i * 8192, R, C); const int Rb = Epi::PERM ? ((R & ~31) + perm32(R & 31)) : R; RA[i] = R; CA[i] = C;
        voffA[0][i] = (unsigned)(R * K + C) * 2u; voffA[1][i] = (unsigned)((R + HALF) * K + C) * 2u; voffB[i] = (unsigned)(Rb * K + C) * 2u; }
    const size_t kstep = (size_t)(BK * 2);
    const size_t hstep = (size_t)HALF * K * 2;
    const unsigned ldsw = (unsigned)wid * 1024u;
    const int aoff = lds_byte(wr * 64 + fr, fq * 8), boff = lds_byte(wc * 32 + fr, fq * 8);
#define PG8_SA(b, h) (((b) * 2 + (h)) * HTB)
#define PG8_SB(b, h) ((4 + (b) * 2 + (h)) * HTB)
#define PG8_STAGE(bufoff, gbase, voff) do { _Pragma("unroll") for (int _i = 0; _i < 2; ++_i) \
        __builtin_amdgcn_global_load_lds((const unsigned*)((const char*)(gbase) + (voff)[_i]), (PG8_LAS unsigned*)(lds + (bufoff) + ldsw + _i * 8192), 16, 0, 0); } while (0)
#define PG8_LDA(dst, b, h) do { _Pragma("unroll") for (int m = 0; m < 4; ++m) _Pragma("unroll") for (int k = 0; k < 2; ++k) dst[m][k] = *(const PG8_LAS bf16x8*)(lds + PG8_SA(b, h) + aoff + m * 2048 + k * 1024); } while (0)
#define PG8_LDB(dst, b, h) do { _Pragma("unroll") for (int n = 0; n < 2; ++n) _Pragma("unroll") for (int k = 0; k < 2; ++k) dst[n][k] = *(const PG8_LAS bf16x8*)(lds + PG8_SB(b, h) + boff + n * 2048 + k * 1024); } while (0)
#define PG8_MMA(ai, bj, At, Bt) do { __builtin_amdgcn_s_setprio(1); _Pragma("unroll") for (int m = 0; m < 4; ++m) _Pragma("unroll") for (int n = 0; n < 2; ++n) _Pragma("unroll") for (int k = 0; k < 2; ++k) \
        acc[ai][bj][m][n] = __builtin_amdgcn_mfma_f32_16x16x32_bf16(Bt[n][k], At[m][k], acc[ai][bj][m][n], 0, 0, 0); __builtin_amdgcn_s_setprio(0); } while (0)
#define PG8_WAIT_V(n) asm volatile("s_waitcnt vmcnt(" #n ")" ::: "memory")
#define PG8_WAIT_L(n) asm volatile("s_waitcnt lgkmcnt(" #n ")" ::: "memory")
#define PG8_BAR __builtin_amdgcn_s_barrier()
#define PG8_SCHED __builtin_amdgcn_sched_barrier(0)
    Unit cur, nxt; int ui = 0;
    if (!S.next(0, cur)) return;
    if constexpr (GATHER) {
#pragma unroll
        for (int h = 0; h < 2; ++h)
#pragma unroll
            for (int i = 0; i < 2; ++i) voffA[h][i] = (unsigned)(S.arow(cur, h * HALF + RA[i]) * K + CA[i]) * 2u;
    }
    f32x4 acc[2][2][4][2];
#pragma unroll
    for (int a = 0; a < 2; ++a)
#pragma unroll
        for (int b = 0; b < 2; ++b)
#pragma unroll
            for (int m = 0; m < 4; ++m)
#pragma unroll
                for (int n = 0; n < 2; ++n) acc[a][b][m][n] = (f32x4){0.f, 0.f, 0.f, 0.f};
    bf16x8 At[4][2], B0[2][2], B1[2][2];
    const char* cA = cur.A; const char* cB = cur.B;
    PG8_STAGE(PG8_SB(0, 0), cB, voffB); PG8_STAGE(PG8_SB(0, 1), cB + hstep, voffB); PG8_STAGE(PG8_SA(0, 0), cA, voffA[0]); PG8_STAGE(PG8_SA(0, 1), cA, voffA[1]);
    if (wr == 1) PG8_BAR;
    PG8_WAIT_V(2); PG8_BAR;
    PG8_STAGE(PG8_SB(1, 0), cB + kstep, voffB); PG8_STAGE(PG8_SA(1, 0), cA + kstep, voffA[0]); PG8_STAGE(PG8_SB(1, 1), cB + hstep + kstep, voffB);
    PG8_WAIT_V(6); PG8_BAR;
    for (;;) {
        const bool has_next = S.next(ui + 1, nxt);
        const char* nA = has_next ? nxt.A : cA; const char* nB = has_next ? nxt.B : cB;
        if constexpr (GATHER) {
#pragma unroll
            for (int h = 0; h < 2; ++h)
#pragma unroll
                for (int i = 0; i < 2; ++i) voffN[h][i] = has_next ? (unsigned)(S.arow(nxt, h * HALF + RA[i]) * K + CA[i]) * 2u : voffA[h][i];
        }
#pragma unroll 1
        for (int t = 0; t < nt; t += 2) {
            const bool last = (t == nt - 2);
            const char* a1 = cA + (size_t)(t + 1) * kstep;
            const char* a2 = last ? nA : cA + (size_t)(t + 2) * kstep; const char* b2 = last ? nB : cB + (size_t)(t + 2) * kstep;
            const char* a3 = a2 + kstep; const char* b3 = b2 + kstep;
            PG8_LDB(B0, 0, 0); PG8_LDB(B1, 0, 1); PG8_SCHED; PG8_LDA(At, 0, 0); PG8_STAGE(PG8_SA(1, 1), a1, voffA[1]);
            if constexpr (GATHER) { if (last) {
#pragma unroll
                for (int h = 0; h < 2; ++h)
#pragma unroll
                    for (int i = 0; i < 2; ++i) voffA[h][i] = voffN[h][i]; } }
            PG8_WAIT_V(8); PG8_WAIT_L(0); PG8_BAR; PG8_MMA(0, 0, At, B0); PG8_MMA(0, 1, At, B1); PG8_BAR; PG8_SCHED;
            PG8_LDA(At, 0, 1); PG8_STAGE(PG8_SB(0, 0), b2, voffB); PG8_STAGE(PG8_SB(0, 1), b2 + hstep, voffB); PG8_STAGE(PG8_SA(0, 0), a2, voffA[0]);
            PG8_WAIT_V(8); PG8_WAIT_L(0); PG8_BAR; PG8_MMA(1, 0, At, B0); PG8_MMA(1, 1, At, B1); PG8_BAR; PG8_SCHED;
            PG8_LDB(B0, 1, 0); PG8_LDB(B1, 1, 1); PG8_SCHED; PG8_LDA(At, 1, 0); PG8_STAGE(PG8_SA(0, 1), a2, voffA[1]);
            PG8_WAIT_V(8); PG8_WAIT_L(0); PG8_BAR; PG8_MMA(0, 0, At, B0); PG8_MMA(0, 1, At, B1); PG8_BAR; PG8_SCHED;
            PG8_LDA(At, 1, 1); PG8_STAGE(PG8_SB(1, 0), b3, voffB); PG8_STAGE(PG8_SB(1, 1), b3 + hstep, voffB); PG8_STAGE(PG8_SA(1, 0), a3, voffA[0]);
            PG8_WAIT_V(8); PG8_WAIT_L(0); PG8_BAR; PG8_MMA(1, 0, At, B0); PG8_MMA(1, 1, At, B1); PG8_BAR; PG8_SCHED;
        }
        if (wr == 0) PG8_BAR;
        { Unit ce = cur; ce.pm = __builtin_amdgcn_readfirstlane(cur.pm); ce.pn = __builtin_amdgcn_readfirstlane(cur.pn); ce.kind = __builtin_amdgcn_readfirstlane(cur.kind); ce.aux = __builtin_amdgcn_readfirstlane(cur.aux); int fr_ = fr, fq_ = fq;
          asm volatile("" : "+s"(ce.pm), "+s"(ce.pn), "+s"(ce.kind), "+s"(ce.aux), "+v"(fr_), "+v"(fq_));
          E(acc, ce, wr, wc, fr_, fq_); }
        if (!has_next) break;
#pragma unroll
        for (int a = 0; a < 2; ++a)
#pragma unroll
            for (int b = 0; b < 2; ++b)
#pragma unroll
                for (int m = 0; m < 4; ++m)
#pragma unroll
                    for (int n = 0; n < 2; ++n) acc[a][b][m][n] = (f32x4){0.f, 0.f, 0.f, 0.f};
        cur = nxt; cA = nA; cB = nB; ++ui;
        if (wr == 1) PG8_BAR;
    }
    PG8_WAIT_V(0);
    PG8_BAR;
#undef PG8_SA
#undef PG8_SB
#undef PG8_STAGE
#undef PG8_LDA
#undef PG8_LDB
#undef PG8_MMA
#undef PG8_WAIT_V
#undef PG8_WAIT_L
#undef PG8_BAR
#undef PG8_SCHED
}
}
constexpr int D = 1024, NB = 4, S = 4096, M = NB * S, DEPTH = 4, INW = 2560;
constexpr float DN_ALPHA = 1.681792830507429f;
constexpr float QSCALE = 0.125f * 1.4426950408889634f;
constexpr int NWAVES = 8;
constexpr size_t MiB = 1u << 20;
constexpr size_t TILEB = (size_t)256 * D * 2;
constexpr size_t WS_CTL = 0, CTL_ZERO_BYTES = 1 * MiB;
constexpr size_t WS_CS = 1 * MiB;
constexpr size_t WS_WIN = 2 * MiB, WIN_LAYER = 5 * MiB;
constexpr size_t WS_XB = 22 * MiB;
constexpr size_t WS_QKP = 118 * MiB;
constexpr size_t WS_UVT = 158 * MiB;
constexpr size_t WS_MIXB = 198 * MiB;
constexpr size_t WS_STASH = 54 * MiB;
constexpr size_t WS_WOUT = 383 * MiB, WOUT_LAYER = 2 * MiB;
constexpr size_t WS_TOKIDX = 391 * MiB, WS_GATE = 392 * MiB;
constexpr size_t WS_YMOE = WS_QKP;
constexpr size_t WS_YP = 86 * MiB;
constexpr size_t WS_ACT = 230 * MiB;
constexpr size_t WS_WBUF = 288 * MiB, WBUF_STRIDE = 35 * MiB, WB_W13 = 0, WB_W2 = 16 * MiB, WB_WG = 24 * MiB, WB_WP = 26 * MiB, WB_PB = 27 * MiB;
constexpr size_t WS_KF = 262 * MiB, WS_PS = 278 * MiB, WS_HT = 280 * MiB;
constexpr size_t WS_WR = 256 * MiB;
constexpr int CW_BAR = 4096, CW_CNT = 8192, CNT_STRIDE = 64;

#define GAS __attribute__((address_space(1)))
#define LAS __attribute__((address_space(3)))
typedef unsigned short bf16;
typedef unsigned v4u __attribute__((ext_vector_type(4)));
typedef float f32x4 __attribute__((ext_vector_type(4)));
typedef short bf16x8 __attribute__((ext_vector_type(8)));
typedef GAS unsigned gu32;
typedef GAS unsigned long long gu64;
#define RLX_AGENT __ATOMIC_RELAXED, __HIP_MEMORY_SCOPE_AGENT
#define LDS_WAIT() asm volatile("s_waitcnt lgkmcnt(0)" ::: "memory")
#define VM_WAIT() asm volatile("s_waitcnt vmcnt(0)" ::: "memory")
__device__ __forceinline__ unsigned long long rt() { return __builtin_amdgcn_s_memrealtime(); }
__device__ __forceinline__ unsigned f2bf(float f) { unsigned u = __builtin_bit_cast(unsigned, f); return (u + 0x7fffu + ((u >> 16) & 1u)) >> 16; }
__device__ __forceinline__ unsigned pk2(float lo, float hi) { return f2bf(lo) | (f2bf(hi) << 16); }

#define XB_TMO      128
#define XB_XCNT(j)  (256  + 64 * (j))
#define XB_XSUB(j)  (1280 + 64 * (j))
#define XB_XGEN(j)  (2304 + 64 * (j))
#define XB_TOP      3328
#define XB_TOPGEN   3392
#define XCD_BAR_WORDS 3456
#define XB_SPIN_CAP (1u << 18)

__device__ __forceinline__ unsigned xb_ld(unsigned* p)              { return __hip_atomic_load(p, __ATOMIC_RELAXED, __HIP_MEMORY_SCOPE_AGENT); }
__device__ __forceinline__ unsigned xb_add(unsigned* p, unsigned v) { return __hip_atomic_fetch_add(p, v, __ATOMIC_RELAXED, __HIP_MEMORY_SCOPE_AGENT); }
__device__ __forceinline__ unsigned xb_xcc_id() { return (unsigned)__builtin_amdgcn_s_getreg((3 << 11) | 20) & 0xFu; }
#define XB_SPIN(cond, bar) do { unsigned _sp = 0; while (cond) { __builtin_amdgcn_s_sleep(1); \
    if ((++_sp & 255u) == 0u) { if (xb_ld(&(bar)[XB_TMO])) break; if (_sp > XB_SPIN_CAP) { atomicAdd(&(bar)[XB_TMO], 1u); break; } } } } while (0)

struct XcdBarrier {
    unsigned* bar; unsigned x;
    volatile LAS unsigned* st;
};

__device__ __forceinline__ unsigned mk_lane_id() { unsigned x; asm volatile("v_mbcnt_lo_u32_b32 %0, -1, 0\n\tv_mbcnt_hi_u32_b32 %0, -1, %0" : "=v"(x)); return x; }
__device__ __forceinline__ XcdBarrier xcd_barrier_post(unsigned* bar, volatile LAS unsigned* st, int wave) {
    XcdBarrier b; b.bar = bar; b.x = xb_xcc_id(); b.st = st;
    if (wave == 0 && mk_lane_id() == 0u) (void)xb_add(&bar[XB_XCNT(b.x)], 1u);
    return b;
}
__device__ __forceinline__ void xcd_barrier_complete(unsigned* bar, unsigned x, unsigned& nloc, unsigned& nx) {
    const unsigned G = gridDim.x * gridDim.y * gridDim.z;
    unsigned sum, cnt, mine, sp = 0u;
    for (;;) {
        sum = 0u; cnt = 0u; mine = 0u;
#pragma unroll
        for (unsigned j = 0; j < 16; ++j) { const unsigned c = xb_ld(&bar[XB_XCNT(j)]); sum += c; cnt += (c > 0u) ? 1u : 0u; mine = (j == x) ? c : mine; }
        if (sum == G) break;
        __builtin_amdgcn_s_sleep(1);
        if ((++sp & 255u) == 0u) { if (xb_ld(&bar[XB_TMO])) break; if (sp > XB_SPIN_CAP) { atomicAdd(&bar[XB_TMO], 1u); break; } }
    }
    nloc = mine > 0u ? mine : 1u; nx = cnt > 0u ? cnt : 1u;
}

__device__ __forceinline__ void xcd_barrier(const XcdBarrier& b, int wave) {
    asm volatile("" : "+s"(wave));
    const bool t0_ = (wave == 0) && (mk_lane_id() == 0u);
    asm volatile("s_waitcnt vmcnt(0)" ::: "memory");
    __syncthreads();
    if (t0_) {
        unsigned* bar = b.bar; unsigned bx_ = b.x; asm volatile("" : "+s"(bx_));
        __builtin_amdgcn_s_waitcnt(0);
        unsigned nloc = b.st[0], nx = b.st[1];
        if (nloc == 0u) { xcd_barrier_complete(bar, bx_, nloc, nx); b.st[0] = nloc; b.st[1] = nx; }
        const unsigned old = xb_add(&bar[XB_XSUB(bx_)], 1u);
        const unsigned gen = old / nloc;
        if (old + 1u == (gen + 1u) * nloc) {
            __builtin_amdgcn_fence(__ATOMIC_RELEASE, "agent");
            asm volatile("s_waitcnt vmcnt(0)" ::: "memory");
            const unsigned og = xb_add(&bar[XB_TOP], 1u);
            const unsigned tg = og / nx;
            if (og + 1u == (tg + 1u) * nx) xb_add(&bar[XB_TOPGEN], 1u);
            else XB_SPIN(xb_ld(&bar[XB_TOPGEN]) == tg, bar);
            __builtin_amdgcn_fence(__ATOMIC_ACQUIRE, "agent");
            xb_add(&bar[XB_XGEN(bx_)], 1u);
            asm volatile("s_waitcnt vmcnt(0)" ::: "memory");
        } else {
            XB_SPIN(xb_ld(&bar[XB_XGEN(bx_)]) == gen, bar);
            __builtin_amdgcn_fence(__ATOMIC_ACQUIRE, "agent");
            asm volatile("s_waitcnt vmcnt(0)" ::: "memory");
        }
    }
    __syncthreads();
}
__device__ __forceinline__ float bf2f(unsigned short b) { return __uint_as_float((unsigned)b << 16); }
#define MK_DPP(v, ctrl) __uint_as_float(__builtin_amdgcn_update_dpp(0, __float_as_uint(v), (ctrl), 0xF, 0xF, true))
__device__ __forceinline__ float xsum16(float v) { const auto r = __builtin_amdgcn_permlane16_swap(__float_as_uint(v), __float_as_uint(v), false, false); return __uint_as_float(r[0]) + __uint_as_float(r[1]); }
__device__ __forceinline__ float xsum32(float v) { const auto r = __builtin_amdgcn_permlane32_swap(__float_as_uint(v), __float_as_uint(v), false, false); return __uint_as_float(r[0]) + __uint_as_float(r[1]); }
__device__ __forceinline__ float wave_sum(float v) {
    v += MK_DPP(v, 0xB1); v += MK_DPP(v, 0x4E);
    v += MK_DPP(v, 0x141); v += MK_DPP(v, 0x140);
    return xsum32(xsum16(v));
}
__device__ __forceinline__ void p0_transpose_block(const float* W, int K, int N, int k0, int n0, bf16* WT, int mode, LAS float* scr, int lane) {
#pragma unroll 4
    for (int i = 0; i < 32; ++i) { const int kk = 2 * i + (lane >> 5); scr[kk * 33 + (lane & 31)] = W[(size_t)(k0 + kk) * N + n0 + (lane & 31)]; }
    LDS_WAIT(); asm volatile("" ::: "memory");
    const int c = lane & 7;
#pragma unroll 1
    for (int j = 0; j < 4; ++j) { const int n = (lane >> 3) + 8 * j; const LAS float* s = scr + (8 * c) * 33 + n;
        v4u o; o.x = pk2(s[0 * 33], s[1 * 33]); o.y = pk2(s[2 * 33], s[3 * 33]); o.z = pk2(s[4 * 33], s[5 * 33]); o.w = pk2(s[6 * 33], s[7 * 33]);
        const int f = n0 + n; const size_t drow = mode == 0 ? (size_t)n : (size_t)(8 * (f >> 2) + (f & 3) + (mode == 2 ? 4 : 0));
        *(GAS v4u*)(WT + drow * K + k0 + 8 * c) = o; }
    LDS_WAIT(); asm volatile("" ::: "memory");
}
template <class TX> __device__ __forceinline__ void ln_row(const TX* x0, float a, const bf16* y1, const bf16* y2, const bf16* y3, const float* g, const float* b, float* of, bf16* ob, int lane) {
    f32x4 v[4]; float s = 0.f;
#pragma unroll
    for (int j = 0; j < 4; ++j) { const int c = 4 * lane + 256 * j;
        if constexpr (sizeof(TX) == 4) v[j] = *(const GAS f32x4*)(x0 + c) * a;
        else { const unsigned long long w = *(const GAS unsigned long long*)(x0 + c); v[j] = (f32x4){bf2f((bf16)w), bf2f((bf16)(w >> 16)), bf2f((bf16)(w >> 32)), bf2f((bf16)(w >> 48))} * a; }
        if (y1) { const unsigned long long w = *(const GAS unsigned long long*)(y1 + c); v[j] += (f32x4){bf2f((bf16)w), bf2f((bf16)(w >> 16)), bf2f((bf16)(w >> 32)), bf2f((bf16)(w >> 48))}; }
        if (y2) { const unsigned long long w = *(const GAS unsigned long long*)(y2 + c); v[j] += (f32x4){bf2f((bf16)w), bf2f((bf16)(w >> 16)), bf2f((bf16)(w >> 32)), bf2f((bf16)(w >> 48))}; }
        if (y3) { const unsigned long long w = *(const GAS unsigned long long*)(y3 + c); v[j] += (f32x4){bf2f((bf16)w), bf2f((bf16)(w >> 16)), bf2f((bf16)(w >> 32)), bf2f((bf16)(w >> 48))}; }
        s += (v[j].x + v[j].y) + (v[j].z + v[j].w); }
    const float mean = wave_sum(s) * (1.f / D); float s2 = 0.f;
#pragma unroll
    for (int j = 0; j < 4; ++j) { v[j] = v[j] - mean; s2 += (v[j].x * v[j].x + v[j].y * v[j].y) + (v[j].z * v[j].z + v[j].w * v[j].w); }
    const float rstd = __builtin_amdgcn_rsqf(wave_sum(s2) * (1.f / D) + 1e-5f);
#pragma unroll
    for (int j = 0; j < 4; ++j) { const int c = 4 * lane + 256 * j; const f32x4 o = v[j] * rstd * *(const GAS f32x4*)(g + c) + *(const GAS f32x4*)(b + c);
        if (of) *(GAS f32x4*)(of + c) = o;
        if (ob) *(GAS unsigned long long*)(ob + c) = (unsigned long long)pk2(o.x, o.y) | ((unsigned long long)pk2(o.z, o.w) << 32); }
}

struct SchedIn {
    int vcu, G; const char* xb; const char* wsw; const char* wnm;
    __device__ __forceinline__ bool next(int i, pg8::Unit& u) const {
        const int L = i * G + vcu; if (L >= 640) return false;
        const int t = L / 10, j = L % 10;
        const int sw = __builtin_amdgcn_readfirstlane((unsigned)(j + 27) >> 5);
        const int jj = j - 5 * sw; const char* tp = xb + (size_t)t * TILEB; const char* wp = (sw ? wsw : wnm) + (size_t)jj * TILEB;
        u.kind = sw; u.pm = sw ? jj : t; u.pn = sw ? t : jj; u.A = sw ? wp : tp; u.B = sw ? tp : wp;
        u.aux = 0; return true;
    }
};
struct EpiIn {
    static constexpr bool PERM = true;
    bf16* qkp; bf16* uvt; const float* cs;
    __device__ __forceinline__ void operator()(const pg8::f32x4 (&acc)[2][2][4][2], const pg8::Unit& u, int wr, int wc, int fr, int fq) const {
        bf16* base = u.kind == 0 ? qkp : uvt; const int ldc = u.kind == 0 ? 1280 : M;
        const int row0 = u.pm * 256 + wr * 64 + fr, col0 = u.pn * 256 + wc * 32 + 8 * fq;
        const bool rope = (u.kind == 0) && (u.pn < 4) && ((wc & 1) == 0);
        const float sc = (u.kind == 0 && u.pn < 2) ? QSCALE : 1.f;
        const float sgn = fq == 0 ? -1.f : 1.f;
        const bool vperm = (u.kind == 1) && (u.pm >= 3);
#pragma unroll
        for (int ai = 0; ai < 2; ++ai)
#pragma unroll
            for (int m = 0; m < 4; ++m) { const int row = row0 + ai * 128 + m * 16; bf16* rowp = base + (size_t)row * ldc + col0;
                f32x4 cv0 = {1.f, 1.f, 1.f, 1.f}, cv1 = cv0, sv0 = {0.f, 0.f, 0.f, 0.f}, sv1 = sv0;
                if (rope && fq < 2) { const float* t = cs + (size_t)(row & (S - 1)) * 16; cv0 = *(const f32x4*)t; cv1 = *(const f32x4*)(t + 4); sv0 = *(const f32x4*)(t + 8) * sgn; sv1 = *(const f32x4*)(t + 12) * sgn; }
#pragma unroll
                for (int bj = 0; bj < 2; ++bj) { f32x4 v0 = acc[ai][bj][m][0], v1 = acc[ai][bj][m][1];
                    if (rope) { f32x4 p0, p1;
#pragma unroll
                        for (int e = 0; e < 4; ++e) { const auto r0 = __builtin_amdgcn_permlane16_swap(__float_as_uint(v0[e]), __float_as_uint(v0[e]), false, false), r1 = __builtin_amdgcn_permlane16_swap(__float_as_uint(v1[e]), __float_as_uint(v1[e]), false, false);
                            p0[e] = __uint_as_float((fq & 1) ? r0[0] : r0[1]); p1[e] = __uint_as_float((fq & 1) ? r1[0] : r1[1]); }
                        v0 = v0 * cv0 + p0 * sv0; v1 = v1 * cv1 + p1 * sv1; }
                    v0 = v0 * sc; v1 = v1 * sc;
                    pg8::u32x4 w; w.x = pg8::cvt_pk_bf16(v0[0], v0[1]); w.y = pg8::cvt_pk_bf16(v0[2], v0[3]); w.z = pg8::cvt_pk_bf16(v1[0], v1[1]); w.w = pg8::cvt_pk_bf16(v1[2], v1[3]);
                    if (vperm) {
                        bf16* gp = rowp + bj * 128 - (fq & 1) * 8;
                        typedef unsigned u32x2 __attribute__((ext_vector_type(2)));
                        *(u32x2*)(gp + ((fq & 1) ? 4 : 0)) = (u32x2){w.x, w.y}; *(u32x2*)(gp + ((fq & 1) ? 12 : 8)) = (u32x2){w.z, w.w};
                    } else *(pg8::u32x4*)(rowp + bj * 128) = w; } }
    }
};

struct SchedOut {
    int vcu, G; const char* a; const char* w;
    __device__ __forceinline__ bool next(int i, pg8::Unit& u) const {
        const int L = i * G + vcu; if (L >= 256) return false;
        u.kind = 0; u.pm = L >> 2; u.pn = L & 3; u.aux = 0; u.A = a + (size_t)u.pm * TILEB; u.B = w + (size_t)u.pn * TILEB; return true;
    }
};
struct EpiRes {
    static constexpr bool PERM = true;
    bf16* XB;
    __device__ __forceinline__ void operator()(const pg8::f32x4 (&acc)[2][2][4][2], const pg8::Unit& u, int wr, int wc, int fr, int fq) const {
        const int row0 = u.pm * 256 + wr * 64 + fr, col0 = u.pn * 256 + wc * 32 + 8 * fq;
#pragma unroll
        for (int ai = 0; ai < 2; ++ai)
#pragma unroll
            for (int m = 0; m < 4; ++m) { bf16* rowp = XB + (size_t)(row0 + ai * 128 + m * 16) * D + col0;
#pragma unroll
                for (int bj = 0; bj < 2; ++bj) { pg8::u32x4* p = (pg8::u32x4*)(rowp + bj * 128); const pg8::u32x4 x = *p; const pg8::f32x4 v0 = acc[ai][bj][m][0], v1 = acc[ai][bj][m][1];
                    pg8::u32x4 w; w.x = pg8::cvt_pk_bf16(bf2f((bf16)x.x) * DN_ALPHA + v0[0], bf2f((bf16)(x.x >> 16)) * DN_ALPHA + v0[1]); w.y = pg8::cvt_pk_bf16(bf2f((bf16)x.y) * DN_ALPHA + v0[2], bf2f((bf16)(x.y >> 16)) * DN_ALPHA + v0[3]);
                    w.z = pg8::cvt_pk_bf16(bf2f((bf16)x.z) * DN_ALPHA + v1[0], bf2f((bf16)(x.z >> 16)) * DN_ALPHA + v1[1]); w.w = pg8::cvt_pk_bf16(bf2f((bf16)x.w) * DN_ALPHA + v1[2], bf2f((bf16)(x.w >> 16)) * DN_ALPHA + v1[3]);
                    *p = w; } }
    }
};
struct RouteLds { unsigned lcnt[16]; unsigned gbase[16]; int e0[64], e1[64]; unsigned r0[64], r1[64]; float g0[64], g1[64]; };
constexpr int RT_PITCH = 2064;
template <int DRY = 0> __device__ __forceinline__ void ln1_router_chunk(LAS RouteLds* R, LAS unsigned char* tile, int row0, bf16* XB, bf16* XOUT, const float* g, const float* b, const bf16* wrt, const float* bgc, const float* bgf,
                                                 gu32* cnt, int* tokidx, float* gate, int wave, int lane) {
    const int tidl = wave * 64 + lane;
    if (tidl < 16) R->lcnt[tidl] = 0u;
#pragma unroll 2
    for (int r = 0; r < 8; ++r) { const int rl = wave * 8 + r; bf16* xbrow = XB + (size_t)(row0 + rl) * D; f32x4 v[4]; float s = 0.f;
#pragma unroll
        for (int j = 0; j < 4; ++j) { const unsigned long long w = *(const GAS unsigned long long*)(xbrow + 4 * lane + 256 * j);
            v[j] = (f32x4){bf2f((bf16)w), bf2f((bf16)(w >> 16)), bf2f((bf16)(w >> 32)), bf2f((bf16)(w >> 48))}; s += (v[j].x + v[j].y) + (v[j].z + v[j].w); }
        const float mean = wave_sum(s) * (1.f / D); float s2 = 0.f;
#pragma unroll
        for (int j = 0; j < 4; ++j) { v[j] = v[j] - mean; s2 += (v[j].x * v[j].x + v[j].y * v[j].y) + (v[j].z * v[j].z + v[j].w * v[j].w); }
        const float rstd = __builtin_amdgcn_rsqf(wave_sum(s2) * (1.f / D) + 1e-5f);
#pragma unroll
        for (int j = 0; j < 4; ++j) { const int c = 4 * lane + 256 * j; const f32x4 o = v[j] * rstd * *(const GAS f32x4*)(g + c) + *(const GAS f32x4*)(b + c);
            const unsigned w0 = pk2(o.x, o.y), w1 = pk2(o.z, o.w);
            *(GAS unsigned long long*)(XOUT + (size_t)(row0 + rl) * D + c) = (unsigned long long)w0 | ((unsigned long long)w1 << 32);
            LAS unsigned* tp = (LAS unsigned*)(tile + rl * RT_PITCH + c * 2); tp[0] = w0; tp[1] = w1; } }
    LDS_WAIT(); __syncthreads();
    if (DRY == 1) return;
    typedef float f32x16_t __attribute__((ext_vector_type(16)));
    f32x16_t pacc;
#pragma unroll
    for (int r = 0; r < 16; ++r) pacc[r] = 0.f;
    { const int rt = wave & 1, kq = wave >> 1, r32 = lane & 31, hi = lane >> 5;
      LAS const unsigned char* ap = tile + (32 * rt + r32) * RT_PITCH + (256 * kq + 8 * hi) * 2;
      const bf16* bh = wrt + (size_t)r32 * D + 256 * kq + 8 * hi; const bf16* bl = bh + 32 * D;
#pragma unroll 4
      for (int ks = 0; ks < 16; ++ks) { const bf16x8 af = *(LAS const bf16x8*)(ap + ks * 32), bhf = *(const GAS bf16x8*)(bh + ks * 16), blf = *(const GAS bf16x8*)(bl + ks * 16);
          pacc = __builtin_amdgcn_mfma_f32_32x32x16_bf16(af, bhf, pacc, 0, 0, 0); pacc = __builtin_amdgcn_mfma_f32_32x32x16_bf16(af, blf, pacc, 0, 0, 0); } }
    LDS_WAIT(); __syncthreads();
    if (DRY == 2) return;
    { const int rt = wave & 1, kq = wave >> 1, r32 = lane & 31, hi = lane >> 5;
      LAS float* P = (LAS float*)tile + (kq * 64 + rt * 32) * 33 + r32;
#pragma unroll
      for (int r = 0; r < 16; ++r) P[((r & 3) + 8 * (r >> 2) + 4 * hi) * 33] = pacc[r]; }
    LDS_WAIT(); __syncthreads();
    if (wave == 0) {
        float my[20];
#pragma unroll
        for (int i = 0; i < 20; ++i) { float t = 0.f;
#pragma unroll
            for (int q = 0; q < 4; ++q) t += ((LAS const float*)tile)[(q * 64 + lane) * 33 + i];
            my[i] = t; }
        const int rl = lane;
        float pg[4], mx = -INFINITY, sum = 0.f;
#pragma unroll
        for (int j = 0; j < 4; ++j) { pg[j] = my[j] + bgc[j]; mx = fmaxf(mx, pg[j]); }
#pragma unroll
        for (int j = 0; j < 4; ++j) { pg[j] = expf(pg[j] - mx); sum += pg[j]; }
        int gi = 0; float gw = pg[0];
#pragma unroll
        for (int j = 1; j < 4; ++j) if (pg[j] > gw) { gw = pg[j]; gi = j; }
        gw /= sum;
        float fs[4]; mx = -INFINITY;
#pragma unroll
        for (int j = 0; j < 4; ++j) { float t = 0.f;
#pragma unroll
            for (int q = 0; q < 4; ++q) if (q == gi) t = my[4 + q * 4 + j] + bgf[q * 4 + j];
            fs[j] = t; mx = fmaxf(mx, t); }
#pragma unroll
        for (int j = 0; j < 4; ++j) fs[j] = expf(fs[j] - mx);
        int t0 = 0; float v0 = fs[0];
#pragma unroll
        for (int j = 1; j < 4; ++j) if (fs[j] > v0) { v0 = fs[j]; t0 = j; }
        int t1 = -1; float v1 = -1.f;
#pragma unroll
        for (int j = 0; j < 4; ++j) if (j != t0 && fs[j] > v1) { v1 = fs[j]; t1 = j; }
        const float ts = v0 + v1; const int e0 = gi * 4 + t0, e1 = gi * 4 + t1;
        R->e0[rl] = e0; R->e1[rl] = e1; R->g0[rl] = gw * (v0 / ts); R->g1[rl] = gw * (v1 / ts);
        R->r0[rl] = __hip_atomic_fetch_add(&R->lcnt[e0], 1u, __ATOMIC_RELAXED, __HIP_MEMORY_SCOPE_WORKGROUP);
        R->r1[rl] = __hip_atomic_fetch_add(&R->lcnt[e1], 1u, __ATOMIC_RELAXED, __HIP_MEMORY_SCOPE_WORKGROUP);
    }
    LDS_WAIT(); __syncthreads();
    if (DRY == 3) return;
    if (tidl < 16) { const unsigned n = R->lcnt[tidl]; R->gbase[tidl] = n ? __hip_atomic_fetch_add(cnt + tidl * CNT_STRIDE, n, RLX_AGENT) : 0u; }
    LDS_WAIT(); __syncthreads();
    if (tidl < 64) { const int rl = tidl, tok = row0 + rl; const int e0 = R->e0[rl], e1 = R->e1[rl]; const unsigned p0 = R->gbase[e0] + R->r0[rl], p1 = R->gbase[e1] + R->r1[rl];
        tokidx[(size_t)e0 * M + p0] = tok * 2; gate[(size_t)e0 * M + p0] = R->g0[rl]; tokidx[(size_t)e1 * M + p1] = tok * 2 + 1; gate[(size_t)e1 * M + p1] = R->g1[rl]; }
    LDS_WAIT(); __syncthreads();
}

struct MoeTab { LAS const int* p;
    __device__ __forceinline__ int cnt(int e) const { return __builtin_amdgcn_readfirstlane(p[e]); }
    __device__ __forceinline__ int pre(int e) const { return __builtin_amdgcn_readfirstlane(p[16 + e]); } };
__device__ __forceinline__ void moe_tab_build(LAS int* p, const gu32* cnt, bool t0) {
    if (t0) { int acc = 0;
        for (int e = 0; e < 16; ++e) { const int c = (int)__hip_atomic_load(cnt + e * CNT_STRIDE, RLX_AGENT); p[e] = c; p[16 + e] = acc; acc += (c + 255) >> 8; }
        p[32] = acc; }
    __syncthreads();
}
template <int NPN> struct SchedMoe {
    int vcu, G; MoeTab T; const char* a; const char* w; size_t wexp  ; const int* tokidx; size_t atile  ;
    __device__ __forceinline__ bool next(int i, pg8::Unit& u) const {
        const int L = i * G + vcu; if (L >= T.pre(16) * NPN) return false;
        const int tile = L / NPN; u.pn = L % NPN; int e = 0;
#pragma unroll
        for (int st = 8; st >= 1; st >>= 1) if (tile >= T.pre(e + st)) e += st;
        u.aux = e; u.pm = tile - T.pre(e); u.kind = tile;
        u.A = a + (size_t)tile * atile; u.B = w + (size_t)e * wexp + (size_t)u.pn * 256 * (wexp / (NPN * 256)); return true;
    }
    __device__ __forceinline__ int arow(const pg8::Unit& u, int r) const {
        const int rank = u.pm * 256 + r; const int c = T.cnt(u.aux);
        return rank < c ? (tokidx[(size_t)u.aux * M + rank] >> 1) : 0;
    }
};
struct EpiMoe1 {
    static constexpr bool PERM = true;
    bf16* act; const float* gate; MoeTab T;
    __device__ __forceinline__ void operator()(const pg8::f32x4 (&acc)[2][2][4][2], const pg8::Unit& u, int wr, int wc, int fr, int fq) const {
        const int cnt = T.cnt(u.aux);
#pragma unroll
        for (int ai = 0; ai < 2; ++ai)
#pragma unroll
            for (int m = 0; m < 4; ++m) { const int r = ai * 128 + wr * 64 + m * 16 + fr, rank = u.pm * 256 + r;
                const float gt = rank < cnt ? gate[(size_t)u.aux * M + rank] : 0.f;
                bf16* rowp = act + ((size_t)u.kind * 256 + r) * 256 + u.pn * 128 + wc * 16 + 4 * fq;
#pragma unroll
                for (int bj = 0; bj < 2; ++bj) { const pg8::f32x4 av = acc[ai][bj][m][0], cv = acc[ai][bj][m][1]; float y[4];
#pragma unroll
                    for (int e = 0; e < 4; ++e) y[e] = av[e] * __builtin_amdgcn_rcpf(1.f + __builtin_amdgcn_exp2f(av[e] * -1.4426950408889634f)) * cv[e] * gt;
                    *(unsigned long long*)(rowp + bj * 64) = (unsigned long long)pg8::cvt_pk_bf16(y[0], y[1]) | ((unsigned long long)pg8::cvt_pk_bf16(y[2], y[3]) << 32); } }
    }
};
struct EpiMoe2 {
    static constexpr bool PERM = true;
    bf16* ymoe; const int* tokidx; MoeTab T;
    __device__ __forceinline__ void operator()(const pg8::f32x4 (&acc)[2][2][4][2], const pg8::Unit& u, int wr, int wc, int fr, int fq) const {
        const int cnt = T.cnt(u.aux);
#pragma unroll
        for (int ai = 0; ai < 2; ++ai)
#pragma unroll
            for (int m = 0; m < 4; ++m) { const int r = ai * 128 + wr * 64 + m * 16 + fr, rank = u.pm * 256 + r;
                if (rank < cnt) { bf16* rowp = ymoe + (size_t)tokidx[(size_t)u.aux * M + rank] * D + u.pn * 256 + wc * 32 + 8 * fq;
#pragma unroll
                    for (int bj = 0; bj < 2; ++bj) { const pg8::f32x4 v0 = acc[ai][bj][m][0], v1 = acc[ai][bj][m][1];
                        pg8::u32x4 w; w.x = pg8::cvt_pk_bf16(v0[0], v0[1]); w.y = pg8::cvt_pk_bf16(v0[2], v0[3]); w.z = pg8::cvt_pk_bf16(v1[0], v1[1]); w.w = pg8::cvt_pk_bf16(v1[2], v1[3]);
                        *(pg8::u32x4*)(rowp + bj * 128) = w; } } }
    }
};
struct SchedSq {
    int vcu, G; const char* a; const char* w; size_t astep, wstep; int vfirst;
    __device__ __forceinline__ bool next(int i, pg8::Unit& u) const {
        if (vcu < vfirst || vcu >= vfirst + G) return false;
        const int L = i * G + (vcu - vfirst); if (L >= 256) return false;
        u.kind = 0; u.pm = L >> 2; u.pn = L & 3; u.aux = 0; u.A = a + (size_t)u.pm * astep; u.B = w + (size_t)u.pn * wstep; return true;
    }
};
template <int GATED> struct EpiPle {
    static constexpr bool PERM = true;
    bf16* yp; const float* bg;
    __device__ __forceinline__ void operator()(const pg8::f32x4 (&acc)[2][2][4][2], const pg8::Unit& u, int wr, int wc, int fr, int fq) const {
        const int row0 = u.pm * 256 + wr * 64 + fr, col0 = u.pn * 256 + wc * 32 + 8 * fq;
#pragma unroll
        for (int ai = 0; ai < 2; ++ai)
#pragma unroll
            for (int m = 0; m < 4; ++m) { bf16* rowp = yp + (size_t)(row0 + ai * 128 + m * 16) * D + col0;
#pragma unroll
                for (int bj = 0; bj < 2; ++bj) { pg8::f32x4 v0 = acc[ai][bj][m][0], v1 = acc[ai][bj][m][1];
                    if (GATED) { const pg8::f32x4 b0 = *(const pg8::f32x4*)(bg + col0 + bj * 128), b1 = *(const pg8::f32x4*)(bg + col0 + bj * 128 + 4); const pg8::u32x4 y = *(const pg8::u32x4*)(rowp + bj * 128);
                        const float yf[8] = {bf2f((bf16)y.x), bf2f((bf16)(y.x >> 16)), bf2f((bf16)y.y), bf2f((bf16)(y.y >> 16)), bf2f((bf16)y.z), bf2f((bf16)(y.z >> 16)), bf2f((bf16)y.w), bf2f((bf16)(y.w >> 16))};
#pragma unroll
                        for (int e = 0; e < 4; ++e) { v0[e] = yf[e] * __builtin_amdgcn_rcpf(1.f + __builtin_amdgcn_exp2f((v0[e] + b0[e]) * -1.4426950408889634f)); v1[e] = yf[4 + e] * __builtin_amdgcn_rcpf(1.f + __builtin_amdgcn_exp2f((v1[e] + b1[e]) * -1.4426950408889634f)); } }
                    pg8::u32x4 w; w.x = pg8::cvt_pk_bf16(v0[0], v0[1]); w.y = pg8::cvt_pk_bf16(v0[2], v0[3]); w.z = pg8::cvt_pk_bf16(v1[0], v1[1]); w.w = pg8::cvt_pk_bf16(v1[2], v1[3]);
                    *(pg8::u32x4*)(rowp + bj * 128) = w; } }
    }
};
namespace att {
typedef float f32x16 __attribute__((ext_vector_type(16)));
constexpr int KSLOT = 8192, VSLOT = 16384, LDS_K = 0, LDS_V = 2 * KSLOT, ATT_LDS = 2 * KSLOT + 2 * VSLOT;
__device__ __forceinline__ bf16x8 pack8(const f32x16& p, int b) {
    v4u w; w.x = pg8::cvt_pk_bf16(p[b], p[b + 1]); w.y = pg8::cvt_pk_bf16(p[b + 2], p[b + 3]); w.z = pg8::cvt_pk_bf16(p[b + 4], p[b + 5]); w.w = pg8::cvt_pk_bf16(p[b + 6], p[b + 7]);
    return __builtin_bit_cast(bf16x8, w);
}
constexpr float THR2 = 8.f;
__device__ __forceinline__ void qkt(f32x16& p0, f32x16& p1, LAS const unsigned char* ks, const bf16x8 (&qf)[4], int r32, int hi) {
#pragma unroll
    for (int r = 0; r < 16; ++r) { p0[r] = 0.f; p1[r] = 0.f; }
    LAS const unsigned char* kb = ks + hi * 1024 + r32 * 16;
#pragma unroll
    for (int kk = 0; kk < 4; ++kk) {
        const bf16x8 a0 = *(LAS const bf16x8*)(kb + kk * 2048), a1 = *(LAS const bf16x8*)(kb + kk * 2048 + 512);
        p0 = __builtin_amdgcn_mfma_f32_32x32x16_bf16(a0, qf[kk], p0, 0, 0, 0);
        p1 = __builtin_amdgcn_mfma_f32_32x32x16_bf16(a1, qf[kk], p1, 0, 0, 0);
    }
}
__device__ __forceinline__ void partialSM(f32x16& p0, f32x16& p1, float& m, float& alpha) {
    float pmax = fmaxf(p0[0], p1[0]);
#pragma unroll
    for (int r = 1; r < 16; ++r) pmax = fmaxf(pmax, fmaxf(p0[r], p1[r]));
    { const auto rr = __builtin_amdgcn_permlane32_swap(__float_as_uint(pmax), __float_as_uint(pmax), false, false); pmax = fmaxf(__uint_as_float(rr[0]), __uint_as_float(rr[1])); }
    if (__builtin_expect(__all(pmax - m <= THR2), 1)) alpha = 1.f;
    else { const float mn = fmaxf(m, pmax); alpha = __builtin_amdgcn_exp2f(m - mn); m = mn; }
    const float mm = m;
#pragma unroll
    for (int r = 0; r < 16; ++r) { p0[r] = __builtin_amdgcn_exp2f(p0[r] - mm); p1[r] -= mm; }
}
__device__ __forceinline__ void finishSM(f32x16& p0, f32x16& p1, float alpha, float& l, bf16x8 (&pf)[4]) {
    float ps = 0.f;
#pragma unroll
    for (int r = 0; r < 16; ++r) { p1[r] = __builtin_amdgcn_exp2f(p1[r]); ps += p0[r] + p1[r]; }
    l = l * alpha + ps;
    pf[0] = pack8(p0, 0); pf[1] = pack8(p0, 8); pf[2] = pack8(p1, 0); pf[3] = pack8(p1, 8);
}
__device__ __forceinline__ void pv(f32x16 (&o)[4], LAS const unsigned char* vs, const bf16x8 (&pf)[4], int r32, int hi) {
    LAS const unsigned char* vb = vs + hi * 2048 + r32 * 16;
#pragma unroll
    for (int db = 0; db < 4; ++db) {
        bf16x8 va[4];
#pragma unroll
        for (int s = 0; s < 4; ++s) va[s] = *(LAS const bf16x8*)(vb + s * 4096 + db * 512);
#pragma unroll
        for (int s = 0; s < 4; ++s) o[db] = __builtin_amdgcn_mfma_f32_32x32x16_bf16(va[s], pf[s], o[db], 0, 0, 0);
        __builtin_amdgcn_sched_group_barrier(0x100, 4, 0); __builtin_amdgcn_sched_group_barrier(0x8, 4, 0);
    }
}
__device__ __forceinline__ void resc(f32x16 (&o)[4], float alpha) {
    if (__any(alpha < 1.f)) {
#pragma unroll
        for (int db = 0; db < 4; ++db)
#pragma unroll
            for (int r = 0; r < 16; ++r) o[db][r] *= alpha;
    }
}
__device__ __forceinline__ void unit(LAS unsigned char* lds, int b, int h, int qb, const bf16* QKP, const bf16* UVT, float lam, float lam_init, const float* subg, bf16* MIXB, float* stash, int wave, int lane) {
    asm volatile("" : "+v"(lane));
    const int r32 = lane & 31, hi = lane >> 5;
    const size_t tok0 = (size_t)b * S;
    const size_t qtok = tok0 + qb * 256 + wave * 32 + r32;
    constexpr int NT = S / 64;
#pragma unroll 1
    for (int c = 0; c < 2; ++c) {
        bf16x8 qf[4];
#pragma unroll
        for (int kk = 0; kk < 4; ++kk) qf[kk] = *(const GAS bf16x8*)(QKP + qtok * 1280 + h * 128 + c * 64 + kk * 16 + hi * 8);
        f32x16 o[4];
#pragma unroll
        for (int db = 0; db < 4; ++db)
#pragma unroll
            for (int r = 0; r < 16; ++r) o[db][r] = 0.f;
        float m = -INFINITY, l = 0.f, alA, alB;
        f32x16 pA0, pA1, pB0, pB1; bf16x8 pf[4];
        const char* kub = (const char*)(QKP + tok0 * 1280 + 512 + h * 128 + c * 64 + wave * 8);
        const char* vub = (const char*)(UVT + (size_t)(768 + h * 128) * M + tok0 + wave * 8);
        const unsigned kvo = (unsigned)lane * 2560u, vvo = (unsigned)lane * (unsigned)(M * 2);
#define ATT_DMA_K(t) __builtin_amdgcn_global_load_lds((const unsigned*)(kub + (size_t)(t) * (64 * 2560) + kvo), (LAS unsigned*)(lds + LDS_K + ((t) & 1) * KSLOT + wave * 1024), 16, 0, 0)
#define ATT_DMA_V(t) do { \
            __builtin_amdgcn_global_load_lds((const unsigned*)(vub + (size_t)(t) * 128 + vvo), (LAS unsigned*)(lds + LDS_V + ((t) & 1) * VSLOT + wave * 2048), 16, 0, 0); \
            __builtin_amdgcn_global_load_lds((const unsigned*)(vub + (size_t)64 * M * 2 + (size_t)(t) * 128 + vvo), (LAS unsigned*)(lds + LDS_V + ((t) & 1) * VSLOT + wave * 2048 + 1024), 16, 0, 0); } while (0)
#define SB() __builtin_amdgcn_sched_barrier(0)
#define ATT_SYNC() do { asm volatile("s_waitcnt vmcnt(0) lgkmcnt(0)" ::: "memory"); __builtin_amdgcn_s_barrier(); asm volatile("" ::: "memory"); } while (0)
        const bool early = wave < 4;
        ATT_SYNC();
        ATT_DMA_K(0); ATT_DMA_V(0);
        ATT_SYNC();
        ATT_DMA_K(1);
        qkt(pA0, pA1, lds + LDS_K, qf, r32, hi); partialSM(pA0, pA1, m, alA);
#pragma unroll 1
        for (int j = 1; j < NT - 1; j += 2) {
            ATT_SYNC(); if (early) { ATT_DMA_K(j + 1); ATT_DMA_V(j); }
            SB(); qkt(pB0, pB1, lds + LDS_K + KSLOT, qf, r32, hi); finishSM(pA0, pA1, alA, l, pf); SB();
            if (!early) { ATT_DMA_K(j + 1); ATT_DMA_V(j); }
            pv(o, lds + LDS_V, pf, r32, hi); partialSM(pB0, pB1, m, alB); SB(); resc(o, alB);
            ATT_SYNC(); if (early) { ATT_DMA_K(j + 2); ATT_DMA_V(j + 1); }
            SB(); qkt(pA0, pA1, lds + LDS_K, qf, r32, hi); finishSM(pB0, pB1, alB, l, pf); SB();
            if (!early) { ATT_DMA_K(j + 2); ATT_DMA_V(j + 1); }
            pv(o, lds + LDS_V + VSLOT, pf, r32, hi); partialSM(pA0, pA1, m, alA); SB(); resc(o, alA);
        }
        ATT_SYNC(); ATT_DMA_V(NT - 1);
        SB(); qkt(pB0, pB1, lds + LDS_K + KSLOT, qf, r32, hi); finishSM(pA0, pA1, alA, l, pf); SB();
        pv(o, lds + LDS_V, pf, r32, hi); partialSM(pB0, pB1, m, alB); SB(); resc(o, alB);
        ATT_SYNC();
        finishSM(pB0, pB1, alB, l, pf); pv(o, lds + LDS_V + VSLOT, pf, r32, hi);
#undef ATT_DMA_K
#undef ATT_DMA_V
#undef ATT_SYNC
#undef SB
        const float lt = xsum32(l);
        const int lane_e = (int)mk_lane_id();
        const int hi_e = lane_e >> 5; const size_t qtok_e = tok0 + qb * 256 + wave * 32 + (lane_e & 31);
        if (c == 0) {
            const float i1 = 1.f / lt;
#pragma unroll
            for (int db = 0; db < 4; ++db)
#pragma unroll
                for (int g4 = 0; g4 < 4; ++g4) *(GAS f32x4*)(stash + ((db * 4 + g4) * 64 + lane_e) * 4) = (f32x4){o[db][4 * g4] * i1, o[db][4 * g4 + 1] * i1, o[db][4 * g4 + 2] * i1, o[db][4 * g4 + 3] * i1};
        } else {
            const float i2 = lam / lt;
            float ss = 0.f;
#pragma unroll
            for (int db = 0; db < 4; ++db)
#pragma unroll
                for (int g4 = 0; g4 < 4; ++g4) { const f32x4 s1 = *(const GAS f32x4*)(stash + ((db * 4 + g4) * 64 + lane_e) * 4);
#pragma unroll
                    for (int i = 0; i < 4; ++i) { const float v = s1[i] - o[db][4 * g4 + i] * i2; o[db][4 * g4 + i] = v; ss += v * v; } }
            ss = xsum32(ss);
            const float rs = (1.f - lam_init) / sqrtf(ss * (1.f / 128.f) + 1e-5f);
            bf16* orow = MIXB + qtok_e * D + 256 + h * 128;
#pragma unroll
            for (int db = 0; db < 4; ++db)
#pragma unroll
                for (int g4 = 0; g4 < 4; ++g4) { const int e = 32 * db + 8 * g4 + 4 * hi_e; const f32x4 gg = *(const GAS f32x4*)(subg + e);
                    const unsigned long long w = (unsigned long long)pg8::cvt_pk_bf16(o[db][4 * g4] * rs * gg.x, o[db][4 * g4 + 1] * rs * gg.y) | ((unsigned long long)pg8::cvt_pk_bf16(o[db][4 * g4 + 2] * rs * gg.z, o[db][4 * g4 + 3] * rs * gg.w) << 32);
                    *(GAS unsigned long long*)(orow + e) = w; }
        }
    }
}
}
namespace hy {
typedef float f32x16 __attribute__((ext_vector_type(16)));
constexpr int CPY = 16456;
constexpr int LDS_F = 0, LDS_VV = 4 * CPY, LDS_END = LDS_VV + 32768;
static_assert(LDS_VV % 16 == 0 && LDS_END <= 131072, "hyena LDS map");

__device__ __forceinline__ void filter_item(LAS unsigned char* lds, int pb, const float* fw1, const float* fb1, const float* fr1, const float* fw2, const float* fb2, const float* fr2,
                                            const float* fw3, bf16* KF, float* PS, int wave, int lane) {
    LAS bf16* tile = (LAS bf16*)lds;
    LAS float* za = (LAS float*)(lds + 65536) + wave * 512;
    LAS float* zb = (LAS float*)(lds + 81920) + wave * 512;
    LAS float* sqs = (LAS float*)(lds + 98304);
    const int p0 = pb * 64 + wave * 8;
    if (lane < 33) {
#pragma unroll 1
        for (int pi = 0; pi < 8; ++pi) { const int p = p0 + pi; float z;
            if (lane == 0) z = (float)p / (float)(S - 1);
            else { const int bi = (lane - 1) & 15; const float band = 1e-4f + (float)bi * ((15.0f - 1e-4f) / 15.0f), wpos = 2.0f * 3.14159265358979323846f * (float)p / (float)S;
                   z = lane <= 16 ? cosf(wpos * band) : -sinf(wpos * band); }
            za[pi * 64 + lane] = z; }
    }
    LDS_WAIT(); asm volatile("" ::: "memory");
    float acc8[8];
    { const float b1 = fb1[lane];
#pragma unroll
      for (int pi = 0; pi < 8; ++pi) acc8[pi] = b1;
#pragma unroll 1
      for (int i = 0; i < 33; ++i) { const float w = fw1[i * 64 + lane];
#pragma unroll
          for (int pi = 0; pi < 8; ++pi) acc8[pi] += za[pi * 64 + i] * w; }
      const float f1 = fr1[lane];
#pragma unroll
      for (int pi = 0; pi < 8; ++pi) zb[pi * 64 + lane] = sinf(f1 * acc8[pi]); }
    LDS_WAIT(); asm volatile("" ::: "memory");
    { const float b2 = fb2[lane];
#pragma unroll
      for (int pi = 0; pi < 8; ++pi) acc8[pi] = b2;
#pragma unroll 1
      for (int i = 0; i < 64; ++i) { const float w = fw2[i * 64 + lane];
#pragma unroll
          for (int pi = 0; pi < 8; ++pi) acc8[pi] += zb[pi * 64 + i] * w; }
      const float f2 = fr2[lane];
      LDS_WAIT(); asm volatile("" ::: "memory");
#pragma unroll
      for (int pi = 0; pi < 8; ++pi) za[pi * 64 + lane] = sinf(f2 * acc8[pi]); }
    LDS_WAIT(); asm volatile("" ::: "memory");
    const float mind = logf(1e-2f) / 1.5f, maxd = logf(1e-2f) / 0.3f;
#pragma unroll 1
    for (int qh = 0; qh < 2; ++qh) {
        float ac[8][4];
#pragma unroll
        for (int pi = 0; pi < 8; ++pi)
#pragma unroll
            for (int q = 0; q < 4; ++q) ac[pi][q] = 0.f;
#pragma unroll 1
        for (int i = 0; i < 64; ++i) { float w[4];
#pragma unroll
            for (int q = 0; q < 4; ++q) w[q] = fw3[i * 512 + lane + 64 * (qh * 4 + q)];
#pragma unroll
            for (int pi = 0; pi < 8; ++pi) { const float hv = za[pi * 64 + i];
#pragma unroll
                for (int q = 0; q < 4; ++q) ac[pi][q] += hv * w[q]; } }
#pragma unroll
        for (int q = 0; q < 4; ++q) { const int col = lane + 64 * (qh * 4 + q), ch = col & 255; const float delta = fabsf(mind + (float)ch * ((maxd - mind) / 255.0f)); float sq = 0.f;
#pragma unroll
            for (int pi = 0; pi < 8; ++pi) { const int p = p0 + pi; const float val = ac[pi][q] * expf(-((float)p / (float)(S - 1)) * delta);
                if (!(col >= 256 && p == 0)) sq += val * val;
                tile[col * 64 + wave * 8 + pi] = (bf16)f2bf(val); }
            sqs[wave * 512 + col] = sq; }
    }
    LDS_WAIT(); __syncthreads();
    { const int p = pb * 64 + lane;
#pragma unroll 1
      for (int cc = 0; cc < 64; ++cc) { const int col = wave * 64 + cc; const bf16 v = tile[col * 64 + lane];
          if (col < 256) KF[(size_t)col * 8192 + 4095 - p] = v; else if (p != 0) KF[(size_t)(col - 256) * 8192 + 4095 + p] = v; } }
    { const int t = wave * 64 + lane; float s = 0.f;
#pragma unroll
      for (int w = 0; w < 8; ++w) s += sqs[w * 512 + t];
      PS[(size_t)pb * 512 + t] = s;
      if (pb == 0 && t < 256) KF[(size_t)t * 8192 + 8191] = 0; }
    LDS_WAIT(); __syncthreads();
}

__device__ __forceinline__ float conv1(float um, float u0, float up, float w0, float w1, float w2, float cb) { return um * w0 + u0 * w1 + up * w2 + cb; }

__device__ __forceinline__ void unit(LAS unsigned char* lds, int c, const bf16* KF, const float* PS, const bf16* UVT, const float* cw, const float* cb, const float* bias_d, bf16* HT, int wave, int lane) {
    asm volatile("" : "+s"(wave), "+v"(lane));
    const int tid = wave * 64 + lane;
    { const bf16* src = KF + (size_t)c * 8192;
#pragma unroll
      for (int i = 0; i < 2; ++i) { const int ch = tid + 512 * i; *(LAS v4u*)(lds + LDS_F + ch * 16) = *(const GAS v4u*)(src + ch * 8); } }
    { const float w0v = cw[512 + c], w1v = cw[768 + 512 + c], w2v = cw[1536 + 512 + c], cbv = cb[512 + c], w0x = cw[256 + c], w1x = cw[768 + 256 + c], w2x = cw[1536 + 256 + c], cbx = cb[256 + c];
      const bf16* rv = UVT + (size_t)(512 + c) * M; const bf16* rx = UVT + (size_t)(256 + c) * M;
#pragma unroll
      for (int i = 0; i < 4; ++i) { const int q = tid + 512 * i, b = q >> 9, sc = q & 511, s0 = sc * 8; const size_t g0 = (size_t)b * S + s0;
          const v4u av = *(const GAS v4u*)(rv + g0), ax = *(const GAS v4u*)(rx + g0);
          float uv[10], ux[10];
          uv[0] = s0 > 0 ? bf2f(rv[g0 - 1]) : 0.f; ux[0] = s0 > 0 ? bf2f(rx[g0 - 1]) : 0.f; uv[9] = s0 + 8 < S ? bf2f(rv[g0 + 8]) : 0.f; ux[9] = s0 + 8 < S ? bf2f(rx[g0 + 8]) : 0.f;
#pragma unroll
          for (int e = 0; e < 4; ++e) { uv[1 + 2 * e] = bf2f((bf16)av[e]); uv[2 + 2 * e] = bf2f((bf16)(av[e] >> 16)); ux[1 + 2 * e] = bf2f((bf16)ax[e]); ux[2 + 2 * e] = bf2f((bf16)(ax[e] >> 16)); }
          float o[8];
#pragma unroll
          for (int e = 0; e < 8; ++e) o[e] = conv1(uv[e], uv[e + 1], uv[e + 2], w0v, w1v, w2v, cbv) * conv1(ux[e], ux[e + 1], ux[e + 2], w0x, w1x, w2x, cbx);
          v4u w; w.x = pk2(o[0], o[1]); w.y = pk2(o[2], o[3]); w.z = pk2(o[4], o[5]); w.w = pk2(o[6], o[7]);
          *(LAS v4u*)(lds + LDS_VV + (((sc & 7) * 64 + (sc >> 3)) * 4 + b) * 16) = w; } }
    LDS_WAIT(); __syncthreads();
    {
#pragma unroll 1
      for (int i = 0; i < 4; ++i) { const int y = tid + 512 * i;
          const unsigned long long w0 = *(LAS const unsigned long long*)(lds + LDS_F + y * 8), w1 = *(LAS const unsigned long long*)(lds + LDS_F + y * 8 + 8);
#pragma unroll
          for (int p = 1; p < 4; ++p) *(LAS unsigned long long*)(lds + LDS_F + p * CPY + y * 8) = (w0 >> (16 * p)) | (w1 << (64 - 16 * p)); } }
    const float nrm = 1.0f / sqrtf(wave_sum(PS[(size_t)lane * 512 + c] + PS[(size_t)lane * 512 + 256 + c]) + 1e-6f);
    LDS_WAIT(); __syncthreads();
    const int r32 = lane & 31, hi = lane >> 5, gp = wave & 3, half = wave >> 2, iloc = r32 >> 2, b = r32 & 3;
    f32x16 acc[2][2];
#pragma unroll
    for (int rho = 0; rho < 2; ++rho)
#pragma unroll
        for (int gg = 0; gg < 2; ++gg)
#pragma unroll
            for (int r = 0; r < 16; ++r) acc[rho][gg][r] = 0.f;
    const int dlo = 16 * gp - 63 + (half ? 40 : 0), dn = half ? 39 : 40;
    int pa = LDS_F + (3 - (r32 & 3)) * CPY + (4092 - 4 * (r32 >> 2) + 8 * hi) * 2 - 64 - 128 * dlo;
    int jb = 16 * gp + iloc - dlo;
    const int pbase = LDS_VV + hi * 4096 + b * 16;
#pragma unroll 1
    for (int dd = 0; dd < dn; ++dd) {
        const int j0 = jb, j1 = jb + 8; const bool v0 = (unsigned)j0 < 64u, v1 = (unsigned)j1 < 64u;
        LAS const unsigned char* ap = lds + pa; LAS const unsigned char* bp0 = lds + pbase + (v0 ? j0 : 0) * 64; LAS const unsigned char* bp1 = lds + pbase + (v1 ? j1 : 0) * 64;
#pragma unroll
        for (int k = 0; k < 4; ++k) {
            typedef unsigned long long u64;
            const u64 a00 = *(LAS const u64*)(ap + 64 + 32 * k), a01 = *(LAS const u64*)(ap + 64 + 32 * k + 8), a10 = *(LAS const u64*)(ap + 32 * k), a11 = *(LAS const u64*)(ap + 32 * k + 8);
            v4u b0 = *(LAS const v4u*)(bp0 + k * 8192), b1 = *(LAS const v4u*)(bp1 + k * 8192);
            if (!v0) b0 = (v4u){0u, 0u, 0u, 0u};
            if (!v1) b1 = (v4u){0u, 0u, 0u, 0u};
            const bf16x8 fa0 = __builtin_bit_cast(bf16x8, (v4u){(unsigned)a00, (unsigned)(a00 >> 32), (unsigned)a01, (unsigned)(a01 >> 32)});
            const bf16x8 fa1 = __builtin_bit_cast(bf16x8, (v4u){(unsigned)a10, (unsigned)(a10 >> 32), (unsigned)a11, (unsigned)(a11 >> 32)});
            const bf16x8 fb0 = __builtin_bit_cast(bf16x8, b0), fb1 = __builtin_bit_cast(bf16x8, b1);
            acc[0][0] = __builtin_amdgcn_mfma_f32_32x32x16_bf16(fa0, fb0, acc[0][0], 0, 0, 0);
            acc[0][1] = __builtin_amdgcn_mfma_f32_32x32x16_bf16(fa0, fb1, acc[0][1], 0, 0, 0);
            acc[1][0] = __builtin_amdgcn_mfma_f32_32x32x16_bf16(fa1, fb0, acc[1][0], 0, 0, 0);
            acc[1][1] = __builtin_amdgcn_mfma_f32_32x32x16_bf16(fa1, fb1, acc[1][1], 0, 0, 0);
        }
        pa -= 128; jb -= 1;
    }
    LDS_WAIT(); __syncthreads();
    { LAS float* xw = (LAS float*)(lds + LDS_F) + (gp * 2 + (half ? 0 : 1)) * 2048 + lane;
#pragma unroll
      for (int gg = 0; gg < 2; ++gg)
#pragma unroll
          for (int r = 0; r < 16; ++r) xw[(gg * 16 + r) * 64] = half ? acc[0][gg][r] : acc[1][gg][r]; }
    LDS_WAIT(); __syncthreads();
    f32x16 fin[2];
    { LAS const float* xr = (LAS const float*)(lds + LDS_F) + (gp * 2 + (half ? 1 : 0)) * 2048 + lane;
#pragma unroll
      for (int gg = 0; gg < 2; ++gg)
#pragma unroll
          for (int r = 0; r < 16; ++r) fin[gg][r] = (half ? acc[1][gg][r] : acc[0][gg][r]) + xr[(gg * 16 + r) * 64]; }
    { const float bd = bias_d[c], w0 = cw[c], w1 = cw[768 + c], w2 = cw[1536 + c], cb0 = cb[c]; const bf16* r0p = UVT + (size_t)c * M; bf16* hrow = HT + (size_t)c * M;
#pragma unroll
      for (int gg = 0; gg < 2; ++gg)
#pragma unroll
          for (int g4 = 0; g4 < 4; ++g4) { const int i = 16 * gp + 8 * gg + iloc, rr = 32 * half + 8 * g4 + 4 * hi, t0 = 64 * i + rr; const size_t tok = (size_t)b * S + t0;
              const unsigned long long vw = *(LAS const unsigned long long*)(lds + LDS_VV + (((rr >> 3) * 64 + i) * 4 + b) * 16 + (rr & 7) * 2);
              const unsigned long long uw = *(const GAS unsigned long long*)(r0p + tok);
              float u[6]; u[0] = t0 > 0 ? bf2f(r0p[tok - 1]) : 0.f; u[5] = t0 + 4 < S ? bf2f(r0p[tok + 4]) : 0.f;
              u[1] = bf2f((bf16)uw); u[2] = bf2f((bf16)(uw >> 16)); u[3] = bf2f((bf16)(uw >> 32)); u[4] = bf2f((bf16)(uw >> 48));
              float o[4];
#pragma unroll
              for (int e = 0; e < 4; ++e) { const float vv = bf2f((bf16)(vw >> (16 * e))); o[e] = (nrm * fin[gg][4 * g4 + e] + vv * bd) * conv1(u[e], u[e + 1], u[e + 2], w0, w1, w2, cb0); }
              *(GAS unsigned long long*)(hrow + tok) = (unsigned long long)pk2(o[0], o[1]) | ((unsigned long long)pk2(o[2], o[3]) << 32); } }
    LDS_WAIT(); __syncthreads();
}
__device__ __forceinline__ void transpose_slab(LAS unsigned char* lds, int slab, const bf16* HT, bf16* MIXB, int wave, int lane) {
    const int tid = wave * 64 + lane; LAS bf16* tile = (LAS bf16*)lds;
#pragma unroll 1
    for (int i = 0; i < 4; ++i) { const int q = tid + 512 * i, c = q >> 3, tc = q & 7; const v4u w = *(const GAS v4u*)(HT + (size_t)c * M + (size_t)slab * 64 + tc * 8);
#pragma unroll
        for (int e = 0; e < 4; ++e) { tile[(tc * 8 + 2 * e) * 264 + c] = (bf16)w[e]; tile[(tc * 8 + 2 * e + 1) * 264 + c] = (bf16)(w[e] >> 16); } }
    LDS_WAIT(); __syncthreads();
#pragma unroll 1
    for (int i = 0; i < 4; ++i) { const int q = tid + 512 * i, tk = q >> 5, cc = q & 31;
        *(GAS v4u*)(MIXB + ((size_t)slab * 64 + tk) * D + cc * 8) = *(LAS const v4u*)(lds + (tk * 264 + cc * 8) * 2); }
    LDS_WAIT(); __syncthreads();
}
}
#ifndef DUP_PRO
#define DUP_PRO 1
#endif
#ifndef DUP_IN
#define DUP_IN 1
#endif
#ifndef DUP_HY
#define DUP_HY 1
#endif
#ifndef DUP_POOL
#define DUP_POOL 1
#endif
#ifndef DUP_HYT
#define DUP_HYT 1
#endif
#ifndef DUP_ATT
#define DUP_ATT 1
#endif
#ifndef DUP_OUT
#define DUP_OUT 1
#endif
#ifndef DUP_LN1
#define DUP_LN1 1
#endif
#ifndef DUP_MOE1
#define DUP_MOE1 1
#endif
#ifndef DUP_MOE2
#define DUP_MOE2 1
#endif
#ifndef DUP_LN2
#define DUP_LN2 1
#endif
#ifndef EN_HY
#define EN_HY 1
#endif
#ifndef EN_HYT
#define EN_HYT 1
#endif
#ifndef EN_PRO
#define EN_PRO 1
#endif
#ifndef EN_IN
#define EN_IN 1
#endif
#ifndef EN_ATT
#define EN_ATT 1
#endif
#ifndef EN_POOL
#define EN_POOL 1
#endif
#ifndef EN_OUT
#define EN_OUT 1
#endif
#ifndef EN_LN1
#define EN_LN1 1
#endif
#ifndef EN_WCV
#define EN_WCV 1
#endif
#ifndef EN_MOE1
#define EN_MOE1 1
#endif
#ifndef EN_MOE2
#define EN_MOE2 1
#endif
#ifndef EN_LN2
#define EN_LN2 1
#endif
constexpr int RING_BYTES = 135168;
constexpr int LDSCTL_OFF = RING_BYTES, MISC_OFF = LDSCTL_OFF + 320, MOETAB_OFF = LDSCTL_OFF + 1024, ROUTE_OFF = LDSCTL_OFF + 2048;
constexpr int LDS_BYTES = 151552;

struct Args { const float* in[38]; float* out; unsigned char* ws; int* eid; float* wts; int ph_lo, ph_hi, l_lo, l_hi, single, pad; };
enum { PH_PRO = 0, PH_IN = 1, PH_ATT = 2, PH_POOL = 3, PH_OUT = 4, PH_LN1 = 5, PH_WCV = 6, PH_MOE1 = 7, PH_MOE2 = 8, PH_LN2 = 9, PH_HY = 10, PH_HYT = 11, PH_END = 12 };

__global__ void __launch_bounds__(NWAVES * 64, 2) mk_fwd(Args a) {
    extern __shared__ __attribute__((aligned(16))) unsigned char lds_raw[];
    LAS unsigned char* lds = (LAS unsigned char*)lds_raw;
    volatile LAS unsigned* MISC = (volatile LAS unsigned*)(lds + MISC_OFF);
    const int wave_s = __builtin_amdgcn_readfirstlane((int)threadIdx.x >> 6);
    const int G = gridDim.x, bx = blockIdx.x, vcu0 = (G % 8 == 0) ? (bx % 8) * (G / 8) + bx / 8 : bx;
    gu32* ctl0 = (gu32*)(a.ws + WS_CTL);
    for (int u = wave_s * 64 + (int)mk_lane_id(); u < (LDS_BYTES - LDSCTL_OFF) / 4; u += NWAVES * 64) ((LAS unsigned*)(lds + LDSCTL_OFF))[u] = 0u;
    __syncthreads();
    XcdBarrier bar; bar.bar = (unsigned*)(ctl0 + CW_BAR); bar.x = 0; bar.st = nullptr;
#if defined(MK_PER_PHASE)
    if (!a.single)
#endif
    bar = xcd_barrier_post((unsigned*)(ctl0 + CW_BAR), MISC + 8, wave_s);
#if defined(MK_PER_PHASE)
#define IN(k) (a.ph_lo <= (k) && (k) < a.ph_hi)
#define SEAM() do { if (!a.single) xcd_barrier(bar, wave_s); } while (0)
#else
#define IN(k) 1
#if defined(PROBE_BAR2)
#define SEAM() do { xcd_barrier(bar, wave_s); xcd_barrier(bar, wave_s); } while (0)
#else
#define SEAM() xcd_barrier(bar, wave_s)
#endif
#endif
    const int NGW = G * NWAVES;
#define PHASE_PTRS() int lane_ = (int)mk_lane_id(); asm volatile("" : "+v"(lane_)); const int lane = lane_, wave = wave_s; int vcu = vcu0; asm volatile("" : "+s"(vcu)); (void)wave; const int gw = vcu * NWAVES + wave; (void)gw; unsigned char* ws = a.ws; gu32* ctl = (gu32*)(ws + WS_CTL); (void)ctl; \
    bf16* XB = (bf16*)(ws + WS_XB); bf16* QKP = (bf16*)(ws + WS_QKP); bf16* UVT = (bf16*)(ws + WS_UVT); float* CS = (float*)(ws + WS_CS); bf16* MIXB = (bf16*)(ws + WS_MIXB); \
    (void)XB; (void)QKP; (void)UVT; (void)CS; (void)MIXB
#define INP(k) (a.in[k])
#define WCV_LAYER(LEXPR, GW_, NGW_) do { const int wl_ = (LEXPR), wg_ = (GW_), wn_ = (NGW_); const int l = wl_, gw = wg_, NGW = wn_; (void)NGW; \
            LAS float* scr = (LAS float*)(lds + wave * 16384); \
            unsigned char* wb_ = ws + WS_WBUF + (size_t)(l & 1) * WBUF_STRIDE; bf16* W13 = (bf16*)(wb_ + WB_W13); bf16* W2 = (bf16*)(wb_ + WB_W2); bf16* WG = (bf16*)(wb_ + WB_WG); bf16* WP = (bf16*)(wb_ + WB_WP); \
            for (int it = gw; it < 6784; it += NGW) { \
                const float* src; int K, N, k0, n0, mode = 0; bf16* dst; \
                if (it < 4096) { const int which = it >> 11, r = it & 2047, e = r >> 7, kb = (r >> 3) & 15, nb = r & 7; \
                    src = INP(which ? 31 : 30) + ((size_t)l * 16 + e) * D * 256; K = D; N = 256; k0 = kb * 64; n0 = nb * 32; mode = 1 + which; dst = W13 + (size_t)e * 512 * D; \
                } else if (it < 6144) { const int r = it - 4096, e = r >> 7, kb = (r >> 5) & 3, nb = r & 31; \
                    src = INP(32) + ((size_t)l * 16 + e) * 256 * D; K = 256; N = D; k0 = kb * 64; n0 = nb * 32; dst = W2 + (size_t)e * D * 256 + (size_t)n0 * 256; \
                } else if (it < 6656) { const int r = it - 6144, kb = r >> 5, nb = r & 31; \
                    src = INP(33) + (size_t)l * D * D; K = D; N = D; k0 = kb * 64; n0 = nb * 32; dst = WG + (size_t)n0 * D; \
                } else { const int r = it - 6656, kb = r >> 5, nb = r & 31; \
                    src = INP(35) + (size_t)l * 256 * D; K = 256; N = D; k0 = kb * 64; n0 = nb * 32; dst = WP + (size_t)n0 * 256; } \
                p0_transpose_block(src, K, N, k0, n0, dst, mode, scr, lane); \
            } \
            const int ln = lane; \
            const float* ps = INP(1) + (size_t)l * M * 256; bf16* PB = (bf16*)(wb_ + WB_PB); \
            for (size_t i = ((size_t)gw * 64 + ln) * 8; i < (size_t)M * 256; i += (size_t)NGW * 64 * 8) { const f32x4 x0 = *(const GAS f32x4*)(ps + i), x1 = *(const GAS f32x4*)(ps + i + 4); \
                v4u o; o.x = pk2(x0.x, x0.y); o.y = pk2(x0.z, x0.w); o.z = pk2(x1.x, x1.y); o.w = pk2(x1.z, x1.w); *(GAS v4u*)(PB + i) = o; } \
    } while (0)

    if (EN_PRO && IN(PH_PRO)) {
            PHASE_PTRS();
            for (int rep_ = 0; rep_ < DUP_PRO; ++rep_) {
        LAS float* scr = (LAS float*)(lds + wave * 16384);
        for (int it = gw; it < DEPTH * (16 * 72 + 16 * 32); it += NGW) {
            const int l = it / 1664, r = it % 1664; const float* src; int N, k0, n0; bf16* dst;
            if (r < 1152) { const int kb = r / 72, nb = r % 72; n0 = nb * 32; k0 = kb * 64; N = INW; src = INP(4) + (size_t)l * D * INW;
                bf16* wsw = (bf16*)(ws + WS_WIN + (size_t)l * WIN_LAYER); bf16* wnm = wsw + 1280 * 1024;
                dst = n0 < 768 ? wsw + (size_t)n0 * D : (n0 < 1792 ? wnm + (size_t)(n0 - 768) * D : wsw + (size_t)(768 + n0 - 1792) * D); }
            else { const int q = r - 1152, kb = q >> 5, nb = q & 31; n0 = nb * 32; k0 = kb * 64; N = D; src = INP(23) + (size_t)l * D * D; dst = (bf16*)(ws + WS_WOUT + (size_t)l * WOUT_LAYER) + (size_t)n0 * D; }
            p0_transpose_block(src, D, N, k0, n0, dst, 0, scr, lane);
            }
        }
        for (int it = gw; it < DEPTH * 4 * 16 * 2; it += NGW) {
            const int l = it >> 7, g = (it >> 5) & 3, dh = (it >> 4) & 1, k = (it & 15) * 64 + lane;
            const float* wrow = INP(4) + (size_t)l * D * INW + (size_t)k * INW + 2304 + g * 64;
            const float* pw = INP(20) + (size_t)(l * 4 + g) * 64 * 64 + dh * 32;
            float acc[32];
#pragma unroll
            for (int d = 0; d < 32; ++d) acc[d] = 0.f;
#pragma unroll 1
            for (int c = 0; c < 64; ++c) { const float x = wrow[c];
#pragma unroll
                for (int d = 0; d < 32; ++d) acc[d] += x * pw[c * 64 + d]; }
            bf16* dst = (bf16*)(ws + WS_WIN + (size_t)l * WIN_LAYER) + (size_t)(1280 + 1024 + g * 64 + dh * 32) * D + k;
#pragma unroll
            for (int d = 0; d < 32; ++d) dst[(size_t)d * D] = (bf16)f2bf(acc[d]);
        }
        for (int i = gw * 64 + lane; i < DEPTH * 32 * D; i += NGW * 64) { const int l2 = i / (32 * D), r = i % (32 * D), col = r / D, k = r % D;
            const float w = col < 4 ? INP(26)[((size_t)l2 * D + k) * 4 + col] : (col < 20 ? INP(28)[((size_t)l2 * D + k) * 16 + col - 4] : 0.f);
            const unsigned hb = f2bf(w); const float lo = w - __uint_as_float(hb << 16);
            bf16* dst = (bf16*)(ws + WS_WR) + (size_t)l2 * 64 * D; dst[(size_t)col * D + k] = (bf16)hb; dst[(size_t)(32 + col) * D + k] = (bf16)f2bf(lo); }
        int ln2 = lane; asm volatile("" : "+v"(ln2));
        for (int i = gw * 64 + ln2; i < S * 8; i += NGW * 64) { const int pos = i >> 3, j = i & 7; const float ang = (float)pos * powf(500000.0f, -(float)(2 * j) / 16.0f);
            CS[pos * 16 + j] = cosf(ang); CS[pos * 16 + 8 + j] = sinf(ang); }
        for (int m = gw; m < M; m += NGW) ln_row(INP(0) + (size_t)m * D, 1.f, nullptr, nullptr, nullptr, INP(2), INP(3), nullptr, XB + (size_t)m * D, lane);
        WCV_LAYER(0, gw, NGW);
        LDS_WAIT(); __syncthreads();
        for (int it = vcu; it < DEPTH * 64; it += G) { const int fl = it >> 6, pb = it & 63;
            hy::filter_item(lds, pb, INP(7) + fl * 33 * 64, INP(8) + fl * 64, INP(9) + fl * 64, INP(10) + fl * 64 * 64, INP(11) + fl * 64, INP(12) + fl * 64, INP(13) + fl * 64 * 512,
                            (bf16*)(ws + WS_KF) + (size_t)fl * 256 * 8192, (float*)(ws + WS_PS) + (size_t)fl * 64 * 512, wave, lane); }
        SEAM();
    }
#if defined(MK_PER_PHASE)
    for (int l = a.l_lo; l < a.l_hi; ++l) {
#else
#pragma unroll 1
    for (int l = 0; l < DEPTH; ++l) {
#endif
        if (EN_IN && IN(PH_IN)) {
            PHASE_PTRS();
            for (int rep_ = 0; rep_ < DUP_IN; ++rep_) {
            const char* wsw = (const char*)(ws + WS_WIN + (size_t)l * WIN_LAYER);
            SchedIn Sc{vcu, G, (const char*)XB, wsw, wsw + (size_t)1280 * 1024 * 2};
            EpiIn E{QKP, UVT, CS};
            pg8::gemm_phase<EpiIn, SchedIn>(lds, D, Sc, E, wave);
            { SchedSq Sc2{vcu, G / 2, (const char*)(ws + WS_WBUF + (size_t)(l & 1) * WBUF_STRIDE + WB_PB), (const char*)(ws + WS_WBUF + (size_t)(l & 1) * WBUF_STRIDE + WB_WP), (size_t)256 * 256 * 2, (size_t)256 * 256 * 2, G / 2};
              EpiPle<0> E2{(bf16*)(ws + WS_YP), nullptr};
              pg8::gemm_phase<EpiPle<0>, SchedSq>(lds, 256, Sc2, E2, wave); }
            }
            SEAM();
        }
        if (EN_HY && IN(PH_HY)) {
            PHASE_PTRS();
            for (int rep_ = 0; rep_ < DUP_HY; ++rep_) {
            for (int c = vcu; c < 256; c += G)
                hy::unit(lds, c, (const bf16*)(ws + WS_KF) + (size_t)l * 256 * 8192, (const float*)(ws + WS_PS) + (size_t)l * 64 * 512, UVT, INP(5) + l * 3 * 768, INP(6) + l * 768, INP(14) + l * 256, (bf16*)(ws + WS_HT), wave, lane);
            }
        }
        if (EN_POOL && IN(PH_POOL)) {
            PHASE_PTRS();
            for (int rep_ = 0; rep_ < DUP_POOL; ++rep_) {
            int ln = lane; asm volatile("" : "+v"(ln));
            const int cc = (ln & 31) * 8, gq = cc >> 6, hw = 1 << gq;
            const float* pb = INP(21) + l * 256 + cc; const float* psc = INP(22) + l * 256 + cc;
            for (int it = gw; it < M / 2; it += NGW) {
                const int tok = it * 2 + (ln >> 5), pos = tok & (S - 1);
                int lo = pos - hw, hi2 = pos + hw - 1; lo = lo < 0 ? 0 : lo; hi2 = hi2 > S - 1 ? S - 1 : hi2;
                float sacc[8];
#pragma unroll
                for (int e = 0; e < 8; ++e) sacc[e] = 0.f;
                const bf16* zp = QKP + (size_t)(tok - pos) * 1280 + 1024 + cc;
                for (int r = lo; r <= hi2; ++r) { const v4u w = *(const GAS v4u*)(zp + (size_t)r * 1280);
                    sacc[0] += bf2f((bf16)w.x); sacc[1] += bf2f((bf16)(w.x >> 16)); sacc[2] += bf2f((bf16)w.y); sacc[3] += bf2f((bf16)(w.y >> 16));
                    sacc[4] += bf2f((bf16)w.z); sacc[5] += bf2f((bf16)(w.z >> 16)); sacc[6] += bf2f((bf16)w.w); sacc[7] += bf2f((bf16)(w.w >> 16)); }
                const float inv = 1.f / (float)(hi2 - lo + 1);
                const v4u w = *(const GAS v4u*)(zp + (size_t)pos * 1280);
                float z[8] = {bf2f((bf16)w.x), bf2f((bf16)(w.x >> 16)), bf2f((bf16)w.y), bf2f((bf16)(w.y >> 16)), bf2f((bf16)w.z), bf2f((bf16)(w.z >> 16)), bf2f((bf16)w.w), bf2f((bf16)(w.w >> 16))};
                float y[8];
#pragma unroll
                for (int e = 0; e < 8; ++e) y[e] = (sacc[e] * inv - z[e] + pb[e]) * psc[e];
                v4u o; o.x = pk2(y[0], y[1]); o.y = pk2(y[2], y[3]); o.z = pk2(y[4], y[5]); o.w = pk2(y[6], y[7]);
                *(GAS v4u*)(MIXB + (size_t)tok * D + 768 + cc) = o;
            }
            }
            SEAM();
        }
        if (EN_HYT && IN(PH_HYT)) {
            PHASE_PTRS();
            for (int rep_ = 0; rep_ < DUP_HYT; ++rep_) {
            for (int s = vcu; s < 256; s += G) hy::transpose_slab(lds, s, (const bf16*)(ws + WS_HT), MIXB, wave, lane);
            }
        }
        if (EN_ATT && IN(PH_ATT)) {
            PHASE_PTRS();
            for (int rep_ = 0; rep_ < DUP_ATT; ++rep_) {
            const float lam_init = 0.8f - 0.6f * expf(-0.3f * (float)l);
            int ln = lane; asm volatile("" : "+v"(ln));
            const float lam = expf(wave_sum(INP(15)[l * 64 + ln] * INP(16)[l * 64 + ln])) - expf(wave_sum(INP(17)[l * 64 + ln] * INP(18)[l * 64 + ln])) + lam_init;
            for (int u = vcu; u < 256; u += G) att::unit(lds, (u >> 4) >> 2, (u >> 4) & 3, u & 15, QKP, UVT, lam, lam_init, INP(19) + l * 128, MIXB, (float*)(ws + WS_STASH) + ((size_t)u * 8 + wave) * 4096, wave, lane);
            }
            SEAM();
        }
        if (EN_OUT && IN(PH_OUT)) {
            PHASE_PTRS();
            for (int rep_ = 0; rep_ < DUP_OUT; ++rep_) {
            SchedOut Sc{vcu, G, (const char*)MIXB, (const char*)(ws + WS_WOUT + (size_t)l * WOUT_LAYER)};
#if defined(PROBE_OUT)
            { EpiRes E0{(bf16*)(ws + WS_STASH)}; pg8::gemm_phase<EpiRes, SchedOut>(lds, D, Sc, E0, wave); }
#endif
            EpiRes E{XB};
            pg8::gemm_phase<EpiRes, SchedOut>(lds, D, Sc, E, wave);
            }
            SEAM();
        }
        if (EN_LN1 && IN(PH_LN1)) {
            PHASE_PTRS();
            for (int rep_ = 0; rep_ < DUP_LN1; ++rep_) {
            int ln = lane; asm volatile("" : "+v"(ln));
#if defined(PROBE_LN1)
            for (int ch = vcu; ch < M / 64; ch += G)
                ln1_router_chunk<PROBE_LN1>((LAS RouteLds*)(lds + ROUTE_OFF), lds, ch * 64, XB, (bf16*)(ws + WS_STASH), INP(24) + l * D, INP(25) + l * D, (const bf16*)(ws + WS_WR) + (size_t)l * 64 * D, INP(27) + l * 4, INP(29) + l * 16,
                                 ctl + CW_CNT + l * 16 * CNT_STRIDE, (int*)(ws + WS_TOKIDX), (float*)(ws + WS_GATE), wave, lane);
#endif
            for (int ch = vcu; ch < M / 64; ch += G)
                ln1_router_chunk((LAS RouteLds*)(lds + ROUTE_OFF), lds, ch * 64, XB, XB, INP(24) + l * D, INP(25) + l * D, (const bf16*)(ws + WS_WR) + (size_t)l * 64 * D, INP(27) + l * 4, INP(29) + l * 16,
                                 ctl + CW_CNT + l * 16 * CNT_STRIDE, (int*)(ws + WS_TOKIDX), (float*)(ws + WS_GATE), wave, lane);
            }
            SEAM();
        }
        if (EN_MOE1 && IN(PH_MOE1)) {
            PHASE_PTRS();
            for (int rep_ = 0; rep_ < DUP_MOE1; ++rep_) {
            moe_tab_build((LAS int*)(lds + MOETAB_OFF), ctl + CW_CNT + l * 16 * CNT_STRIDE, wave == 0 && lane == 0); const MoeTab T{(LAS const int*)(lds + MOETAB_OFF)};
            { SchedMoe<2> Sc{vcu, G, T, (const char*)XB, (const char*)(ws + WS_WBUF + (size_t)(l & 1) * WBUF_STRIDE + WB_W13), (size_t)512 * D * 2, (const int*)(ws + WS_TOKIDX), 0};
              EpiMoe1 E{(bf16*)(ws + WS_ACT), (const float*)(ws + WS_GATE), T};
              pg8::gemm_phase<EpiMoe1, SchedMoe<2>, true>(lds, D, Sc, E, wave);
#if defined(PROBE_MOE1A)
              pg8::gemm_phase<EpiMoe1, SchedMoe<2>, true>(lds, D, Sc, E, wave);
#endif
            }
            { SchedSq Sc{vcu, G, (const char*)XB, (const char*)(ws + WS_WBUF + (size_t)(l & 1) * WBUF_STRIDE + WB_WG), TILEB, TILEB, 0};
              EpiPle<1> E{(bf16*)(ws + WS_YP), INP(34) + l * D};
              pg8::gemm_phase<EpiPle<1>, SchedSq>(lds, D, Sc, E, wave); }
            if (l + 1 < DEPTH) {
                int x2 = 2 * T.pre(16) - G; x2 = x2 < 0 ? 0 : (x2 > G / 2 ? G / 2 : x2);
                if (vcu >= x2) WCV_LAYER(l + 1, (vcu - x2) * NWAVES + wave, (G - x2) * NWAVES);
            }
            }
            SEAM();
        }
        if (EN_MOE2 && IN(PH_MOE2)) {
            PHASE_PTRS();
            for (int rep_ = 0; rep_ < DUP_MOE2; ++rep_) {
            moe_tab_build((LAS int*)(lds + MOETAB_OFF), ctl + CW_CNT + l * 16 * CNT_STRIDE, wave == 0 && lane == 0); const MoeTab T{(LAS const int*)(lds + MOETAB_OFF)};
            SchedMoe<4> Sc{vcu, G, T, (const char*)(ws + WS_ACT), (const char*)(ws + WS_WBUF + (size_t)(l & 1) * WBUF_STRIDE + WB_W2), (size_t)D * 256 * 2, (const int*)(ws + WS_TOKIDX), (size_t)256 * 256 * 2};
            EpiMoe2 E{(bf16*)(ws + WS_YMOE), (const int*)(ws + WS_TOKIDX), T};
            pg8::gemm_phase<EpiMoe2, SchedMoe<4>>(lds, 256, Sc, E, wave);
            }
            SEAM();
        }
        if (EN_LN2 && IN(PH_LN2)) {
            PHASE_PTRS();
            for (int rep_ = 0; rep_ < DUP_LN2; ++rep_) {
            int ln = lane; asm volatile("" : "+v"(ln));
            const bf16* YM = (const bf16*)(ws + WS_YMOE); const bf16* YP = (const bf16*)(ws + WS_YP);
            const bool lastl = (l == DEPTH - 1);
#if defined(PROBE_LN2)
            for (int m = gw; m < M; m += NGW)
                ln_row(XB + (size_t)m * D, DN_ALPHA, YM + (size_t)(2 * m) * D, YM + (size_t)(2 * m + 1) * D, YP + (size_t)m * D, INP(36) + l * D, INP(37) + l * D, (float*)nullptr, (bf16*)(ws + WS_STASH) + (size_t)m * D, ln);
#endif
            for (int m = gw; m < M; m += NGW)
                ln_row(XB + (size_t)m * D, DN_ALPHA, YM + (size_t)(2 * m) * D, YM + (size_t)(2 * m + 1) * D, YP + (size_t)m * D, INP(36) + l * D, INP(37) + l * D,
                       lastl ? a.out + (size_t)m * D : (float*)nullptr, lastl ? nullptr : XB + (size_t)m * D, ln);
            }
            if (l != DEPTH - 1) SEAM();
        }
    }
#undef IN
#undef SEAM
}
static void mk_launch(const Args& base, int ph, int l, int grid, hipStream_t stream) {
    Args a = base; a.ph_lo = ph; a.ph_hi = ph + 1; a.l_lo = l; a.l_hi = l + 1; a.single = 1;
    hipLaunchKernelGGL(mk_fwd, dim3(grid), dim3(NWAVES * 64), LDS_BYTES, stream, a);
}
extern "C" void kernel_launch(void* const* d_in, const int* in_sizes, int n_in, void* d_out, int out_size, void* d_ws, size_t ws_size, hipStream_t stream) {
    (void)in_sizes; (void)n_in; (void)out_size; (void)ws_size;
    static int grid = 0;
    if (grid == 0) {
        int dev = 0, cus = 0;
        if (hipGetDevice(&dev) != hipSuccess || hipDeviceGetAttribute(&cus, hipDeviceAttributeMultiprocessorCount, dev) != hipSuccess) { grid = -1; return; }
        if (hipFuncSetAttribute((const void*)mk_fwd, hipFuncAttributeMaxDynamicSharedMemorySize, LDS_BYTES) != hipSuccess) { grid = -1; return; }
        (void)hipGetLastError();
        grid = cus;
    }
    if (grid < 0) return;
    (void)hipMemsetAsync((char*)d_ws + WS_CTL, 0, CTL_ZERO_BYTES, stream);
    Args base{};
    for (int i = 0; i < 38; ++i) base.in[i] = (const float*)d_in[i];
    base.out = (float*)d_out; base.ws = (unsigned char*)d_ws;
    base.eid = nullptr; base.wts = nullptr;
#if defined(MK_PER_PHASE)
    mk_launch(base, PH_PRO, 0, grid, stream);
    for (int l = 0; l < DEPTH; ++l) for (int ph : {PH_IN, PH_HY, PH_HYT, PH_ATT, PH_POOL, PH_OUT, PH_LN1, PH_WCV, PH_MOE1, PH_MOE2, PH_LN2}) mk_launch(base, ph, l, grid, stream);
#else
    Args a = base; a.ph_lo = 0; a.ph_hi = PH_END; a.l_lo = 0; a.l_hi = DEPTH; a.single = 0;
    hipLaunchKernelGGL(mk_fwd, dim3(grid), dim3(NWAVES * 64), LDS_BYTES, stream, a);
#endif
}
```

```cpp
#include <hip/hip_runtime.h>
#include <stdint.h>
#include <math.h>
namespace pg8 {
#define PG8_LAS __attribute__((address_space(3)))
typedef unsigned short bf16_t;
typedef short bf16x8 __attribute__((ext_vector_type(8)));
typedef float f32x4 __attribute__((ext_vector_type(4)));
typedef unsigned u32x4 __attribute__((ext_vector_type(4)));
constexpr int BM = 256, BK = 64, HALF = 128, HTB = HALF * BK * 2  , STAGE_BYTES = 8 * HTB;

__host__ __device__ __forceinline__ int lds_byte(int r, int c) { const int st = (r >> 4) * 2 + (c >> 5), rr = r & 15, cc = c & 31, ob = rr * 64 + cc * 2; return st * 1024 + (ob ^ (((ob >> 9) & 1) << 5)); }
__host__ __device__ __forceinline__ void stage_rc(int b, int& R, int& C) { const int st = b / 1024, sb = b % 1024, swz = sb ^ (((sb >> 9) & 1) << 5); R = (st >> 1) * 16 + swz / 64; C = (st & 1) * 32 + (swz % 64) / 2; }
__host__ __device__ __forceinline__ int perm32(int rho) { const int n = rho >> 4, i = rho & 15; return 8 * (i >> 2) + 4 * n + (i & 3); }

struct Unit { const char* A; const char* B; int kind, pm, pn, aux; };

__device__ __forceinline__ unsigned cvt_pk_bf16(float lo, float hi) { unsigned r; asm volatile("v_cvt_pk_bf16_f32 %0, %1, %2" : "=v"(r) : "v"(lo), "v"(hi)); return r; }

template <class Epi, class Sched, bool GATHER = false>
__device__ __forceinline__ void gemm_phase(PG8_LAS unsigned char* lds, const int K_, const Sched& S, const Epi& E, const int wave_) {
    int K = K_; asm volatile("" : "+s"(K));
    int tid_; asm volatile("v_mbcnt_lo_u32_b32 %0, -1, 0\n\tv_mbcnt_hi_u32_b32 %0, -1, %0" : "=v"(tid_)); tid_ += wave_ * 64;
    const int tid = tid_, wid = __builtin_amdgcn_readfirstlane(tid >> 6), lane = tid & 63, wr = wid >> 2, wc = wid & 3, fr = lane & 15, fq = lane >> 4;
    const int nt = K / BK;
    unsigned voffA[2][2], voffN[2][2] = {{0u, 0u}, {0u, 0u}}, voffB[2]; int RA[2], CA[2];
#pragma unroll
    for (int i = 0; i < 2; ++i) { int R, C; stage_rc(tid * 16 + i * 8192, R, C); const int Rb = Epi::PERM ? ((R & ~31) + perm32(R & 31)) : R; RA[i] = R; CA[i] = C;
        voffA[0][i] = (unsigned)(R * K + C) * 2u; voffA[1][i] = (unsigned)((R + HALF) * K + C) * 2u; voffB[i] = (unsigned)(Rb * K + C) * 2u; }
    const size_t kstep = (size_t)(BK * 2);
    const size_t hstep = (size_t)HALF * K * 2;
    const unsigned ldsw = (unsigned)wid * 1024u;
    const int aoff = lds_byte(wr * 64 + fr, fq * 8), boff = lds_byte(wc * 32 + fr, fq * 8);
#define PG8_SA(b, h) (((b) * 2 + (h)) * HTB)
#define PG8_SB(b, h) ((4 + (b) * 2 + (h)) * HTB)
#define PG8_STAGE(bufoff, gbase, voff) do { _Pragma("unroll") for (int _i = 0; _i < 2; ++_i) \
        __builtin_amdgcn_global_load_lds((const unsigned*)((const char*)(gbase) + (voff)[_i]), (PG8_LAS unsigned*)(lds + (bufoff) + ldsw + _i * 8192), 16, 0, 0); } while (0)
#define PG8_LDA(dst, b, h) do { _Pragma("unroll") for (int m = 0; m < 4; ++m) _Pragma("unroll") for (int k = 0; k < 2; ++k) dst[m][k] = *(const PG8_LAS bf16x8*)(lds + PG8_SA(b, h) + aoff + m * 2048 + k * 1024); } while (0)
#define PG8_LDB(dst, b, h) do { _Pragma("unroll") for (int n = 0; n < 2; ++n) _Pragma("unroll") for (int k = 0; k < 2; ++k) dst[n][k] = *(const PG8_LAS bf16x8*)(lds + PG8_SB(b, h) + boff + n * 2048 + k * 1024); } while (0)
#define PG8_MMA(ai, bj, At, Bt) do { __builtin_amdgcn_s_setprio(1); _Pragma("unroll") for (int m = 0; m < 4; ++m) _Pragma("unroll") for (int n = 0; n < 2; ++n) _Pragma("unroll") for (int k = 0; k < 2; ++k) \
        acc[ai][bj][m][n] = __builtin_amdgcn_mfma_f32_16x16x32_bf16(Bt[n][k], At[m][k], acc[ai][bj][m][n], 0, 0, 0); __builtin_amdgcn_s_setprio(0); } while (0)
#define PG8_WAIT_V(n) asm volatile("s_waitcnt vmcnt(" #n ")" ::: "memory")
#define PG8_WAIT_L(n) asm volatile("s_waitcnt lgkmcnt(" #n ")" ::: "memory")
#define PG8_BAR __builtin_amdgcn_s_barrier()
#define PG8_SCHED __builtin_amdgcn_sched_barrier(0)
    Unit cur, nxt; int ui = 0;
    if (!S.next(0, cur)) return;
    if constexpr (GATHER) {
#pragma unroll
        for (int h = 0; h < 2; ++h)
#pragma unroll
            for (int i = 0; i < 2; ++i) voffA[h][i] = (unsigned)(S.arow(cur, h * HALF + RA[i]) * K + CA[i]) * 2u;
    }
    f32x4 acc[2][2][4][2];
#pragma unroll
    for (int a = 0; a < 2; ++a)
#pragma unroll
        for (int b = 0; b < 2; ++b)
#pragma unroll
            for (int m = 0; m < 4; ++m)
#pragma unroll
                for (int n = 0; n < 2; ++n) acc[a][b][m][n] = (f32x4){0.f, 0.f, 0.f, 0.f};
    bf16x8 At[4][2], B0[2][2], B1[2][2];
    const char* cA = cur.A; const char* cB = cur.B;
    PG8_STAGE(PG8_SB(0, 0), cB, voffB); PG8_STAGE(PG8_SB(0, 1), cB + hstep, voffB); PG8_STAGE(PG8_SA(0, 0), cA, voffA[0]); PG8_STAGE(PG8_SA(0, 1), cA, voffA[1]);
    if (wr == 1) PG8_BAR;
    PG8_WAIT_V(2); PG8_BAR;
    PG8_STAGE(PG8_SB(1, 0), cB + kstep, voffB); PG8_STAGE(PG8_SA(1, 0), cA + kstep, voffA[0]); PG8_STAGE(PG8_SB(1, 1), cB + hstep + kstep, voffB);
    PG8_WAIT_V(6); PG8_BAR;
    for (;;) {
        const bool has_next = S.next(ui + 1, nxt);
        const char* nA = has_next ? nxt.A : cA; const char* nB = has_next ? nxt.B : cB;
        if constexpr (GATHER) {
#pragma unroll
            for (int h = 0; h < 2; ++h)
#pragma unroll
                for (int i = 0; i < 2; ++i) voffN[h][i] = has_next ? (unsigned)(S.arow(nxt, h * HALF + RA[i]) * K + CA[i]) * 2u : voffA[h][i];
        }
#pragma unroll 1
        for (int t = 0; t < nt; t += 2) {
            const bool last = (t == nt - 2);
            const char* a1 = cA + (size_t)(t + 1) * kstep;
            const char* a2 = last ? nA : cA + (size_t)(t + 2) * kstep; const char* b2 = last ? nB : cB + (size_t)(t + 2) * kstep;
            const char* a3 = a2 + kstep; const char* b3 = b2 + kstep;
            PG8_LDB(B0, 0, 0); PG8_LDB(B1, 0, 1); PG8_SCHED; PG8_LDA(At, 0, 0); PG8_STAGE(PG8_SA(1, 1), a1, voffA[1]);
            if constexpr (GATHER) { if (last) {
#pragma unroll
                for (int h = 0; h < 2; ++h)
#pragma unroll
                    for (int i = 0; i < 2; ++i) voffA[h][i] = voffN[h][i]; } }
            PG8_WAIT_V(8); PG8_WAIT_L(0); PG8_BAR; PG8_MMA(0, 0, At, B0); PG8_MMA(0, 1, At, B1); PG8_BAR; PG8_SCHED;
            PG8_LDA(At, 0, 1); PG8_STAGE(PG8_SB(0, 0), b2, voffB); PG8_STAGE(PG8_SB(0, 1), b2 + hstep, voffB); PG8_STAGE(PG8_SA(0, 0), a2, voffA[0]);
            PG8_WAIT_V(8); PG8_WAIT_L(0); PG8_BAR; PG8_MMA(1, 0, At, B0); PG8_MMA(1, 1, At, B1); PG8_BAR; PG8_SCHED;
            PG8_LDB(B0, 1, 0); PG8_LDB(B1, 1, 1); PG8_SCHED; PG8_LDA(At, 1, 0); PG8_STAGE(PG8_SA(0, 1), a2, voffA[1]);
            PG8_WAIT_V(8); PG8_WAIT_L(0); PG8_BAR; PG8_MMA(0, 0, At, B0); PG8_MMA(0, 1, At, B1); PG8_BAR; PG8_SCHED;
            PG8_LDA(At, 1, 1); PG8_STAGE(PG8_SB(1, 0), b3, voffB); PG8_STAGE(PG8_SB(1, 1), b3 + hstep, voffB); PG8_STAGE(PG8_SA(1, 0), a3, voffA[0]);
            PG8_WAIT_V(8); PG8_WAIT_L(0); PG8_BAR; PG8_MMA(1, 0, At, B0); PG8_MMA(1, 1, At, B1); PG8_BAR; PG8_SCHED;
        }
        if (wr == 0) PG8_BAR;
        { Unit ce = cur; ce.pm = __builtin_amdgcn_readfirstlane(cur.pm); ce.pn = __builtin_amdgcn_readfirstlane(cur.pn); ce.kind = __builtin_amdgcn_readfirstlane(cur.kind); ce.aux = __builtin_amdgcn_readfirstlane(cur.aux); int fr_ = fr, fq_ = fq;
          asm volatile("" : "+s"(ce.pm), "+s"(ce.pn), "+s"(ce.kind), "+s"(ce.aux), "+v"(fr_), "+v"(fq_));
          E(acc, ce, wr, wc, fr_, fq_); }
        if (!has_next) break;
#pragma unroll
        for (int a = 0; a < 2; ++a)
#pragma unroll
            for (int b = 0; b < 2; ++b)
#pragma unroll
                for (int m = 0; m < 4; ++m)
#pragma unroll
                    for (int n = 0; n < 2; ++n) acc[a][b][m][n] = (f32x4){0.f, 0.f, 0.f, 0.f};
        cur = nxt; cA = nA; cB = nB; ++ui;
        if (wr == 1) PG8_BAR;
    }
    PG8_WAIT_V(0);
    PG8_BAR;
#undef PG8_SA
#undef PG8_SB
#undef PG8_STAGE
#undef PG8_LDA
#undef PG8_LDB
#undef PG8_MMA
#undef PG8_WAIT_V
#undef PG8_WAIT_L
#undef PG8_BAR
#undef PG8_SCHED
}
}
constexpr int D = 1024, NB = 4, S = 4096, M = NB * S, DEPTH = 4, INW = 2560;
constexpr float DN_ALPHA = 1.681792830507429f;
constexpr float QSCALE = 0.125f * 1.4426950408889634f;
constexpr int NWAVES = 8;
constexpr size_t MiB = 1u << 20;
constexpr size_t TILEB = (size_t)256 * D * 2;
constexpr size_t WS_CTL = 0, CTL_ZERO_BYTES = 1 * MiB;
constexpr size_t WS_CS = 1 * MiB;
constexpr size_t WS_WIN = 2 * MiB, WIN_LAYER = 5 * MiB;
constexpr size_t WS_XB = 22 * MiB;
constexpr size_t WS_QKP = 118 * MiB;
constexpr size_t WS_UVT = 158 * MiB;
constexpr size_t WS_MIXB = 198 * MiB;
constexpr size_t WS_STASH = 54 * MiB;
constexpr size_t WS_WOUT = 383 * MiB, WOUT_LAYER = 2 * MiB;
constexpr size_t WS_TOKIDX = 391 * MiB, WS_GATE = 392 * MiB;
constexpr size_t WS_YMOE = WS_QKP;
constexpr size_t WS_YP = 86 * MiB;
constexpr size_t WS_ACT = 230 * MiB;
constexpr size_t WS_WBUF = 288 * MiB, WBUF_STRIDE = 35 * MiB, WB_W13 = 0, WB_W2 = 16 * MiB, WB_WG = 24 * MiB, WB_WP = 26 * MiB, WB_PB = 27 * MiB;
constexpr size_t WS_KF = 262 * MiB, WS_PS = 278 * MiB, WS_HT = 280 * MiB;
constexpr size_t WS_WR = 256 * MiB;
constexpr int CW_BAR = 4096, CW_CNT = 8192, CNT_STRIDE = 64;

#define GAS __attribute__((address_space(1)))
#define LAS __attribute__((address_space(3)))
typedef unsigned short bf16;
typedef unsigned v4u __attribute__((ext_vector_type(4)));
typedef float f32x4 __attribute__((ext_vector_type(4)));
typedef short bf16x8 __attribute__((ext_vector_type(8)));
typedef GAS unsigned gu32;
typedef GAS unsigned long long gu64;
#define RLX_AGENT __ATOMIC_RELAXED, __HIP_MEMORY_SCOPE_AGENT
#define LDS_WAIT() asm volatile("s_waitcnt lgkmcnt(0)" ::: "memory")
#define VM_WAIT() asm volatile("s_waitcnt vmcnt(0)" ::: "memory")
__device__ __forceinline__ unsigned long long rt() { return __builtin_amdgcn_s_memrealtime(); }
__device__ __forceinline__ unsigned f2bf(float f) { unsigned u = __builtin_bit_cast(unsigned, f); return (u + 0x7fffu + ((u >> 16) & 1u)) >> 16; }
__device__ __forceinline__ unsigned pk2(float lo, float hi) { return f2bf(lo) | (f2bf(hi) << 16); }

#define XB_TMO      128
#define XB_XCNT(j)  (256  + 64 * (j))
#define XB_XSUB(j)  (1280 + 64 * (j))
#define XB_XGEN(j)  (2304 + 64 * (j))
#define XB_TOP      3328
#define XB_TOPGEN   3392
#define XCD_BAR_WORDS 3456
#define XB_SPIN_CAP (1u << 18)

__device__ __forceinline__ unsigned xb_ld(unsigned* p)              { return __hip_atomic_load(p, __ATOMIC_RELAXED, __HIP_MEMORY_SCOPE_AGENT); }
__device__ __forceinline__ unsigned xb_add(unsigned* p, unsigned v) { return __hip_atomic_fetch_add(p, v, __ATOMIC_RELAXED, __HIP_MEMORY_SCOPE_AGENT); }
__device__ __forceinline__ unsigned xb_xcc_id() { return (unsigned)__builtin_amdgcn_s_getreg((3 << 11) | 20) & 0xFu; }
#define XB_SPIN(cond, bar) do { unsigned _sp = 0; while (cond) { __builtin_amdgcn_s_sleep(1); \
    if ((++_sp & 255u) == 0u) { if (xb_ld(&(bar)[XB_TMO])) break; if (_sp > XB_SPIN_CAP) { atomicAdd(&(bar)[XB_TMO], 1u); break; } } } } while (0)

struct XcdBarrier {
    unsigned* bar; unsigned x;
    volatile LAS unsigned* st;
};

__device__ __forceinline__ unsigned mk_lane_id() { unsigned x; asm volatile("v_mbcnt_lo_u32_b32 %0, -1, 0\n\tv_mbcnt_hi_u32_b32 %0, -1, %0" : "=v"(x)); return x; }
__device__ __forceinline__ XcdBarrier xcd_barrier_post(unsigned* bar, volatile LAS unsigned* st, int wave) {
    XcdBarrier b; b.bar = bar; b.x = xb_xcc_id(); b.st = st;
    if (wave == 0 && mk_lane_id() == 0u) (void)xb_add(&bar[XB_XCNT(b.x)], 1u);
    return b;
}
__device__ __forceinline__ void xcd_barrier_complete(unsigned* bar, unsigned x, unsigned& nloc, unsigned& nx) {
    const unsigned G = gridDim.x * gridDim.y * gridDim.z;
    unsigned sum, cnt, mine, sp = 0u;
    for (;;) {
        sum = 0u; cnt = 0u; mine = 0u;
#pragma unroll
        for (unsigned j = 0; j < 16; ++j) { const unsigned c = xb_ld(&bar[XB_XCNT(j)]); sum += c; cnt += (c > 0u) ? 1u : 0u; mine = (j == x) ? c : mine; }
        if (sum == G) break;
        __builtin_amdgcn_s_sleep(1);
        if ((++sp & 255u) == 0u) { if (xb_ld(&bar[XB_TMO])) break; if (sp > XB_SPIN_CAP) { atomicAdd(&bar[XB_TMO], 1u); break; } }
    }
    nloc = mine > 0u ? mine : 1u; nx = cnt > 0u ? cnt : 1u;
}

__device__ __forceinline__ void xcd_barrier(const XcdBarrier& b, int wave) {
    asm volatile("" : "+s"(wave));
    const bool t0_ = (wave == 0) && (mk_lane_id() == 0u);
    asm volatile("s_waitcnt vmcnt(0)" ::: "memory");
    __syncthreads();
    if (t0_) {
        unsigned* bar = b.bar; unsigned bx_ = b.x; asm volatile("" : "+s"(bx_));
        __builtin_amdgcn_s_waitcnt(0);
        unsigned nloc = b.st[0], nx = b.st[1];
        if (nloc == 0u) { xcd_barrier_complete(bar, bx_, nloc, nx); b.st[0] = nloc; b.st[1] = nx; }
        const unsigned old = xb_add(&bar[XB_XSUB(bx_)], 1u);
        const unsigned gen = old / nloc;
        if (old + 1u == (gen + 1u) * nloc) {
            __builtin_amdgcn_fence(__ATOMIC_RELEASE, "agent");
            asm volatile("s_waitcnt vmcnt(0)" ::: "memory");
            const unsigned og = xb_add(&bar[XB_TOP], 1u);
            const unsigned tg = og / nx;
            if (og + 1u == (tg + 1u) * nx) xb_add(&bar[XB_TOPGEN], 1u);
            else XB_SPIN(xb_ld(&bar[XB_TOPGEN]) == tg, bar);
            __builtin_amdgcn_fence(__ATOMIC_ACQUIRE, "agent");
            xb_add(&bar[XB_XGEN(bx_)], 1u);
            asm volatile("s_waitcnt vmcnt(0)" ::: "memory");
        } else {
            XB_SPIN(xb_ld(&bar[XB_XGEN(bx_)]) == gen, bar);
            __builtin_amdgcn_fence(__ATOMIC_ACQUIRE, "agent");
            asm volatile("s_waitcnt vmcnt(0)" ::: "memory");
        }
    }
    __syncthreads();
}
__device__ __forceinline__ float bf2f(unsigned short b) { return __uint_as_float((unsigned)b << 16); }
#define MK_DPP(v, ctrl) __uint_as_float(__builtin_amdgcn_update_dpp(0, __float_as_uint(v), (ctrl), 0xF, 0xF, true))
__device__ __forceinline__ float xsum16(float v) { const auto r = __builtin_amdgcn_permlane16_swap(__float_as_uint(v), __float_as_uint(v), false, false); return __uint_as_float(r[0]) + __uint_as_float(r[1]); }
__device__ __forceinline__ float xsum32(float v) { const auto r = __builtin_amdgcn_permlane32_swap(__float_as_uint(v), __float_as_uint(v), false, false); return __uint_as_float(r[0]) + __uint_as_float(r[1]); }
__device__ __forceinline__ float wave_sum(float v) {
    v += MK_DPP(v, 0xB1); v += MK_DPP(v, 0x4E);
    v += MK_DPP(v, 0x141); v += MK_DPP(v, 0x140);
    return xsum32(xsum16(v));
}
__device__ __forceinline__ void p0_transpose_block(const float* W, int K, int N, int k0, int n0, bf16* WT, int mode, LAS float* scr, int lane) {
#pragma unroll 4
    for (int i = 0; i < 32; ++i) { const int kk = 2 * i + (lane >> 5); scr[kk * 33 + (lane & 31)] = W[(size_t)(k0 + kk) * N + n0 + (lane & 31)]; }
    LDS_WAIT(); asm volatile("" ::: "memory");
    const int c = lane & 7;
#pragma unroll 1
    for (int j = 0; j < 4; ++j) { const int n = (lane >> 3) + 8 * j; const LAS float* s = scr + (8 * c) * 33 + n;
        v4u o; o.x = pk2(s[0 * 33], s[1 * 33]); o.y = pk2(s[2 * 33], s[3 * 33]); o.z = pk2(s[4 * 33], s[5 * 33]); o.w = pk2(s[6 * 33], s[7 * 33]);
        const int f = n0 + n; const size_t drow = mode == 0 ? (size_t)n : (size_t)(8 * (f >> 2) + (f & 3) + (mode == 2 ? 4 : 0));
        *(GAS v4u*)(WT + drow * K + k0 + 8 * c) = o; }
    LDS_WAIT(); asm volatile("" ::: "memory");
}
template <class TX> __device__ __forceinline__ void ln_row(const TX* x0, float a, const bf16* y1, const bf16* y2, const bf16* y3, const float* g, const float* b, float* of, bf16* ob, int lane) {
    f32x4 v[4]; float s = 0.f;
#pragma unroll
    for (int j = 0; j < 4; ++j) { const int c = 4 * lane + 256 * j;
        if constexpr (sizeof(TX) == 4) v[j] = *(const GAS f32x4*)(x0 + c) * a;
        else { const unsigned long long w = *(const GAS unsigned long long*)(x0 + c); v[j] = (f32x4){bf2f((bf16)w), bf2f((bf16)(w >> 16)), bf2f((bf16)(w >> 32)), bf2f((bf16)(w >> 48))} * a; }
        if (y1) { const unsigned long long w = *(const GAS unsigned long long*)(y1 + c); v[j] += (f32x4){bf2f((bf16)w), bf2f((bf16)(w >> 16)), bf2f((bf16)(w >> 32)), bf2f((bf16)(w >> 48))}; }
        if (y2) { const unsigned long long w = *(const GAS unsigned long long*)(y2 + c); v[j] += (f32x4){bf2f((bf16)w), bf2f((bf16)(w >> 16)), bf2f((bf16)(w >> 32)), bf2f((bf16)(w >> 48))}; }
        if (y3) { const unsigned long long w = *(const GAS unsigned long long*)(y3 + c); v[j] += (f32x4){bf2f((bf16)w), bf2f((bf16)(w >> 16)), bf2f((bf16)(w >> 32)), bf2f((bf16)(w >> 48))}; }
        s += (v[j].x + v[j].y) + (v[j].z + v[j].w); }
    const float mean = wave_sum(s) * (1.f / D); float s2 = 0.f;
#pragma unroll
    for (int j = 0; j < 4; ++j) { v[j] = v[j] - mean; s2 += (v[j].x * v[j].x + v[j].y * v[j].y) + (v[j].z * v[j].z + v[j].w * v[j].w); }
    const float rstd = __builtin_amdgcn_rsqf(wave_sum(s2) * (1.f / D) + 1e-5f);
#pragma unroll
    for (int j = 0; j < 4; ++j) { const int c = 4 * lane + 256 * j; const f32x4 o = v[j] * rstd * *(const GAS f32x4*)(g + c) + *(const GAS f32x4*)(b + c);
        if (of) *(GAS f32x4*)(of + c) = o;
        if (ob) *(GAS unsigned long long*)(ob + c) = (unsigned long long)pk2(o.x, o.y) | ((unsigned long long)pk2(o.z, o.w) << 32); }
}

struct SchedIn {
    int vcu, G; const char* xb; const char* wsw; const char* wnm;
    __device__ __forceinline__ bool next(int i, pg8::Unit& u) const {
        const int L = i * G + vcu; if (L >= 640) return false;
        const int t = L / 10, j = L % 10;
        const int sw = __builtin_amdgcn_readfirstlane((unsigned)(j + 27) >> 5);
        const int jj = j - 5 * sw; const char* tp = xb + (size_t)t * TILEB; const char* wp = (sw ? wsw : wnm) + (size_t)jj * TILEB;
        u.kind = sw; u.pm = sw ? jj : t; u.pn = sw ? t : jj; u.A = sw ? wp : tp; u.B = sw ? tp : wp;
        u.aux = 0; return true;
    }
};
struct EpiIn {
    static constexpr bool PERM = true;
    bf16* qkp; bf16* uvt; const float* cs;
    __device__ __forceinline__ void operator()(const pg8::f32x4 (&acc)[2][2][4][2], const pg8::Unit& u, int wr, int wc, int fr, int fq) const {
        bf16* base = u.kind == 0 ? qkp : uvt; const int ldc = u.kind == 0 ? 1280 : M;
        const int row0 = u.pm * 256 + wr * 64 + fr, col0 = u.pn * 256 + wc * 32 + 8 * fq;
        const bool rope = (u.kind == 0) && (u.pn < 4) && ((wc & 1) == 0);
        const float sc = (u.kind == 0 && u.pn < 2) ? QSCALE : 1.f;
        const float sgn = fq == 0 ? -1.f : 1.f;
        const bool vperm = (u.kind == 1) && (u.pm >= 3);
#pragma unroll
        for (int ai = 0; ai < 2; ++ai)
#pragma unroll
            for (int m = 0; m < 4; ++m) { const int row = row0 + ai * 128 + m * 16; bf16* rowp = base + (size_t)row * ldc + col0;
                f32x4 cv0 = {1.f, 1.f, 1.f, 1.f}, cv1 = cv0, sv0 = {0.f, 0.f, 0.f, 0.f}, sv1 = sv0;
                if (rope && fq < 2) { const float* t = cs + (size_t)(row & (S - 1)) * 16; cv0 = *(const f32x4*)t; cv1 = *(const f32x4*)(t + 4); sv0 = *(const f32x4*)(t + 8) * sgn; sv1 = *(const f32x4*)(t + 12) * sgn; }
#pragma unroll
                for (int bj = 0; bj < 2; ++bj) { f32x4 v0 = acc[ai][bj][m][0], v1 = acc[ai][bj][m][1];
                    if (rope) { f32x4 p0, p1;
#pragma unroll
                        for (int e = 0; e < 4; ++e) { const auto r0 = __builtin_amdgcn_permlane16_swap(__float_as_uint(v0[e]), __float_as_uint(v0[e]), false, false), r1 = __builtin_amdgcn_permlane16_swap(__float_as_uint(v1[e]), __float_as_uint(v1[e]), false, false);
                            p0[e] = __uint_as_float((fq & 1) ? r0[0] : r0[1]); p1[e] = __uint_as_float((fq & 1) ? r1[0] : r1[1]); }
                        v0 = v0 * cv0 + p0 * sv0; v1 = v1 * cv1 + p1 * sv1; }
                    v0 = v0 * sc; v1 = v1 * sc;
                    pg8::u32x4 w; w.x = pg8::cvt_pk_bf16(v0[0], v0[1]); w.y = pg8::cvt_pk_bf16(v0[2], v0[3]); w.z = pg8::cvt_pk_bf16(v1[0], v1[1]); w.w = pg8::cvt_pk_bf16(v1[2], v1[3]);
                    if (vperm) {
                        bf16* gp = rowp + bj * 128 - (fq & 1) * 8;
                        typedef unsigned u32x2 __attribute__((ext_vector_type(2)));
                        *(u32x2*)(gp + ((fq & 1) ? 4 : 0)) = (u32x2){w.x, w.y}; *(u32x2*)(gp + ((fq & 1) ? 12 : 8)) = (u32x2){w.z, w.w};
                    } else *(pg8::u32x4*)(rowp + bj * 128) = w; } }
    }
};

struct SchedOut {
    int vcu, G; const char* a; const char* w;
    __device__ __forceinline__ bool next(int i, pg8::Unit& u) const {
        const int L = i * G + vcu; if (L >= 256) return false;
        u.kind = 0; u.pm = L >> 2; u.pn = L & 3; u.aux = 0; u.A = a + (size_t)u.pm * TILEB; u.B = w + (size_t)u.pn * TILEB; return true;
    }
};
struct EpiRes {
    static constexpr bool PERM = true;
    bf16* XB;
    __device__ __forceinline__ void operator()(const pg8::f32x4 (&acc)[2][2][4][2], const pg8::Unit& u, int wr, int wc, int fr, int fq) const {
        const int row0 = u.pm * 256 + wr * 64 + fr, col0 = u.pn * 256 + wc * 32 + 8 * fq;
#pragma unroll
        for (int ai = 0; ai < 2; ++ai)
#pragma unroll
            for (int m = 0; m < 4; ++m) { bf16* rowp = XB + (size_t)(row0 + ai * 128 + m * 16) * D + col0;
#pragma unroll
                for (int bj = 0; bj < 2; ++bj) { pg8::u32x4* p = (pg8::u32x4*)(rowp + bj * 128); const pg8::u32x4 x = *p; const pg8::f32x4 v0 = acc[ai][bj][m][0], v1 = acc[ai][bj][m][1];
                    pg8::u32x4 w; w.x = pg8::cvt_pk_bf16(bf2f((bf16)x.x) * DN_ALPHA + v0[0], bf2f((bf16)(x.x >> 16)) * DN_ALPHA + v0[1]); w.y = pg8::cvt_pk_bf16(bf2f((bf16)x.y) * DN_ALPHA + v0[2], bf2f((bf16)(x.y >> 16)) * DN_ALPHA + v0[3]);
                    w.z = pg8::cvt_pk_bf16(bf2f((bf16)x.z) * DN_ALPHA + v1[0], bf2f((bf16)(x.z >> 16)) * DN_ALPHA + v1[1]); w.w = pg8::cvt_pk_bf16(bf2f((bf16)x.w) * DN_ALPHA + v1[2], bf2f((bf16)(x.w >> 16)) * DN_ALPHA + v1[3]);
                    *p = w; } }
    }
};
struct RouteLds { unsigned lcnt[16]; unsigned gbase[16]; int e0[64], e1[64]; unsigned r0[64], r1[64]; float g0[64], g1[64]; };
constexpr int RT_PITCH = 2064;
template <int DRY = 0> __device__ __forceinline__ void ln1_router_chunk(LAS RouteLds* R, LAS unsigned char* tile, int row0, bf16* XB, bf16* XOUT, const float* g, const float* b, const bf16* wrt, const float* bgc, const float* bgf,
                                                 gu32* cnt, int* tokidx, float* gate, int wave, int lane) {
    const int tidl = wave * 64 + lane;
    if (tidl < 16) R->lcnt[tidl] = 0u;
#pragma unroll 2
    for (int r = 0; r < 8; ++r) { const int rl = wave * 8 + r; bf16* xbrow = XB + (size_t)(row0 + rl) * D; f32x4 v[4]; float s = 0.f;
#pragma unroll
        for (int j = 0; j < 4; ++j) { const unsigned long long w = *(const GAS unsigned long long*)(xbrow + 4 * lane + 256 * j);
            v[j] = (f32x4){bf2f((bf16)w), bf2f((bf16)(w >> 16)), bf2f((bf16)(w >> 32)), bf2f((bf16)(w >> 48))}; s += (v[j].x + v[j].y) + (v[j].z + v[j].w); }
        const float mean = wave_sum(s) * (1.f / D); float s2 = 0.f;
#pragma unroll
        for (int j = 0; j < 4; ++j) { v[j] = v[j] - mean; s2 += (v[j].x * v[j].x + v[j].y * v[j].y) + (v[j].z * v[j].z + v[j].w * v[j].w); }
        const float rstd = __builtin_amdgcn_rsqf(wave_sum(s2) * (1.f / D) + 1e-5f);
#pragma unroll
        for (int j = 0; j < 4; ++j) { const int c = 4 * lane + 256 * j; const f32x4 o = v[j] * rstd * *(const GAS f32x4*)(g + c) + *(const GAS f32x4*)(b + c);
            const unsigned w0 = pk2(o.x, o.y), w1 = pk2(o.z, o.w);
            *(GAS unsigned long long*)(XOUT + (size_t)(row0 + rl) * D + c) = (unsigned long long)w0 | ((unsigned long long)w1 << 32);
            LAS unsigned* tp = (LAS unsigned*)(tile + rl * RT_PITCH + c * 2); tp[0] = w0; tp[1] = w1; } }
    LDS_WAIT(); __syncthreads();
    if (DRY == 1) return;
    typedef float f32x16_t __attribute__((ext_vector_type(16)));
    f32x16_t pacc;
#pragma unroll
    for (int r = 0; r < 16; ++r) pacc[r] = 0.f;
    { const int rt = wave & 1, kq = wave >> 1, r32 = lane & 31, hi = lane >> 5;
      LAS const unsigned char* ap = tile + (32 * rt + r32) * RT_PITCH + (256 * kq + 8 * hi) * 2;
      const bf16* bh = wrt + (size_t)r32 * D + 256 * kq + 8 * hi; const bf16* bl = bh + 32 * D;
#pragma unroll 4
      for (int ks = 0; ks < 16; ++ks) { const bf16x8 af = *(LAS const bf16x8*)(ap + ks * 32), bhf = *(const GAS bf16x8*)(bh + ks * 16), blf = *(const GAS bf16x8*)(bl + ks * 16);
          pacc = __builtin_amdgcn_mfma_f32_32x32x16_bf16(af, bhf, pacc, 0, 0, 0); pacc = __builtin_amdgcn_mfma_f32_32x32x16_bf16(af, blf, pacc, 0, 0, 0); } }
    LDS_WAIT(); __syncthreads();
    if (DRY == 2) return;
    { const int rt = wave & 1, kq = wave >> 1, r32 = lane & 31, hi = lane >> 5;
      LAS float* P = (LAS float*)tile + (kq * 64 + rt * 32) * 33 + r32;
#pragma unroll
      for (int r = 0; r < 16; ++r) P[((r & 3) + 8 * (r >> 2) + 4 * hi) * 33] = pacc[r]; }
    LDS_WAIT(); __syncthreads();
    if (wave == 0) {
        float my[20];
#pragma unroll
        for (int i = 0; i < 20; ++i) { float t = 0.f;
#pragma unroll
            for (int q = 0; q < 4; ++q) t += ((LAS const float*)tile)[(q * 64 + lane) * 33 + i];
            my[i] = t; }
        const int rl = lane;
        float pg[4], mx = -INFINITY, sum = 0.f;
#pragma unroll
        for (int j = 0; j < 4; ++j) { pg[j] = my[j] + bgc[j]; mx = fmaxf(mx, pg[j]); }
#pragma unroll
        for (int j = 0; j < 4; ++j) { pg[j] = expf(pg[j] - mx); sum += pg[j]; }
        int gi = 0; float gw = pg[0];
#pragma unroll
        for (int j = 1; j < 4; ++j) if (pg[j] > gw) { gw = pg[j]; gi = j; }
        gw /= sum;
        float fs[4]; mx = -INFINITY;
#pragma unroll
        for (int j = 0; j < 4; ++j) { float t = 0.f;
#pragma unroll
            for (int q = 0; q < 4; ++q) if (q == gi) t = my[4 + q * 4 + j] + bgf[q * 4 + j];
            fs[j] = t; mx = fmaxf(mx, t); }
#pragma unroll
        for (int j = 0; j < 4; ++j) fs[j] = expf(fs[j] - mx);
        int t0 = 0; float v0 = fs[0];
#pragma unroll
        for (int j = 1; j < 4; ++j) if (fs[j] > v0) { v0 = fs[j]; t0 = j; }
        int t1 = -1; float v1 = -1.f;
#pragma unroll
        for (int j = 0; j < 4; ++j) if (j != t0 && fs[j] > v1) { v1 = fs[j]; t1 = j; }
        const float ts = v0 + v1; const int e0 = gi * 4 + t0, e1 = gi * 4 + t1;
        R->e0[rl] = e0; R->e1[rl] = e1; R->g0[rl] = gw * (v0 / ts); R->g1[rl] = gw * (v1 / ts);
        R->r0[rl] = __hip_atomic_fetch_add(&R->lcnt[e0], 1u, __ATOMIC_RELAXED, __HIP_MEMORY_SCOPE_WORKGROUP);
        R->r1[rl] = __hip_atomic_fetch_add(&R->lcnt[e1], 1u, __ATOMIC_RELAXED, __HIP_MEMORY_SCOPE_WORKGROUP);
    }
    LDS_WAIT(); __syncthreads();
    if (DRY == 3) return;
    if (tidl < 16) { const unsigned n = R->lcnt[tidl]; R->gbase[tidl] = n ? __hip_atomic_fetch_add(cnt + tidl * CNT_STRIDE, n, RLX_AGENT) : 0u; }
    LDS_WAIT(); __syncthreads();
    if (tidl < 64) { const int rl = tidl, tok = row0 + rl; const int e0 = R->e0[rl], e1 = R->e1[rl]; const unsigned p0 = R->gbase[e0] + R->r0[rl], p1 = R->gbase[e1] + R->r1[rl];
        tokidx[(size_t)e0 * M + p0] = tok * 2; gate[(size_t)e0 * M + p0] = R->g0[rl]; tokidx[(size_t)e1 * M + p1] = tok * 2 + 1; gate[(size_t)e1 * M + p1] = R->g1[rl]; }
    LDS_WAIT(); __syncthreads();
}

struct MoeTab { LAS const int* p;
    __device__ __forceinline__ int cnt(int e) const { return __builtin_amdgcn_readfirstlane(p[e]); }
    __device__ __forceinline__ int pre(int e) const { return __builtin_amdgcn_readfirstlane(p[16 + e]); } };
__device__ __forceinline__ void moe_tab_build(LAS int* p, const gu32* cnt, bool t0) {
    if (t0) { int acc = 0;
        for (int e = 0; e < 16; ++e) { const int c = (int)__hip_atomic_load(cnt + e * CNT_STRIDE, RLX_AGENT); p[e] = c; p[16 + e] = acc; acc += (c + 255) >> 8; }
        p[32] = acc; }
    __syncthreads();
}
template <int NPN> struct SchedMoe {
    int vcu, G; MoeTab T; const char* a; const char* w; size_t wexp  ; const int* tokidx; size_t atile  ;
    __device__ __forceinline__ bool next(int i, pg8::Unit& u) const {
        const int L = i * G + vcu; if (L >= T.pre(16) * NPN) return false;
        const int tile = L / NPN; u.pn = L % NPN; int e = 0;
#pragma unroll
        for (int st = 8; st >= 1; st >>= 1) if (tile >= T.pre(e + st)) e += st;
        u.aux = e; u.pm = tile - T.pre(e); u.kind = tile;
        u.A = a + (size_t)tile * atile; u.B = w + (size_t)e * wexp + (size_t)u.pn * 256 * (wexp / (NPN * 256)); return true;
    }
    __device__ __forceinline__ int arow(const pg8::Unit& u, int r) const {
        const int rank = u.pm * 256 + r; const int c = T.cnt(u.aux);
        return rank < c ? (tokidx[(size_t)u.aux * M + rank] >> 1) : 0;
    }
};
struct EpiMoe1 {
    static constexpr bool PERM = true;
    bf16* act; const float* gate; MoeTab T;
    __device__ __forceinline__ void operator()(const pg8::f32x4 (&acc)[2][2][4][2], const pg8::Unit& u, int wr, int wc, int fr, int fq) const {
        const int cnt = T.cnt(u.aux);
#pragma unroll
        for (int ai = 0; ai < 2; ++ai)
#pragma unroll
            for (int m = 0; m < 4; ++m) { const int r = ai * 128 + wr * 64 + m * 16 + fr, rank = u.pm * 256 + r;
                const float gt = rank < cnt ? gate[(size_t)u.aux * M + rank] : 0.f;
                bf16* rowp = act + ((size_t)u.kind * 256 + r) * 256 + u.pn * 128 + wc * 16 + 4 * fq;
#pragma unroll
                for (int bj = 0; bj < 2; ++bj) { const pg8::f32x4 av = acc[ai][bj][m][0], cv = acc[ai][bj][m][1]; float y[4];
#pragma unroll
                    for (int e = 0; e < 4; ++e) y[e] = av[e] * __builtin_amdgcn_rcpf(1.f + __builtin_amdgcn_exp2f(av[e] * -1.4426950408889634f)) * cv[e] * gt;
                    *(unsigned long long*)(rowp + bj * 64) = (unsigned long long)pg8::cvt_pk_bf16(y[0], y[1]) | ((unsigned long long)pg8::cvt_pk_bf16(y[2], y[3]) << 32); } }
    }
};
struct EpiMoe2 {
    static constexpr bool PERM = true;
    bf16* ymoe; const int* tokidx; MoeTab T;
    __device__ __forceinline__ void operator()(const pg8::f32x4 (&acc)[2][2][4][2], const pg8::Unit& u, int wr, int wc, int fr, int fq) const {
        const int cnt = T.cnt(u.aux);
#pragma unroll
        for (int ai = 0; ai < 2; ++ai)
#pragma unroll
            for (int m = 0; m < 4; ++m) { const int r = ai * 128 + wr * 64 + m * 16 + fr, rank = u.pm * 256 + r;
                if (rank < cnt) { bf16* rowp = ymoe + (size_t)tokidx[(size_t)u.aux * M + rank] * D + u.pn * 256 + wc * 32 + 8 * fq;
#pragma unroll
                    for (int bj = 0; bj < 2; ++bj) { const pg8::f32x4 v0 = acc[ai][bj][m][0], v1 = acc[ai][bj][m][1];
                        pg8::u32x4 w; w.x = pg8::cvt_pk_bf16(v0[0], v0[1]); w.y = pg8::cvt_pk_bf16(v0[2], v0[3]); w.z = pg8::cvt_pk_bf16(v1[0], v1[1]); w.w = pg8::cvt_pk_bf16(v1[2], v1[3]);
                        *(pg8::u32x4*)(rowp + bj * 128) = w; } } }
    }
};
struct SchedSq {
    int vcu, G; const char* a; const char* w; size_t astep, wstep; int vfirst;
    __device__ __forceinline__ bool next(int i, pg8::Unit& u) const {
        if (vcu < vfirst || vcu >= vfirst + G) return false;
        const int L = i * G + (vcu - vfirst); if (L >= 256) return false;
        u.kind = 0; u.pm = L >> 2; u.pn = L & 3; u.aux = 0; u.A = a + (size_t)u.pm * astep; u.B = w + (size_t)u.pn * wstep; return true;
    }
};
template <int GATED> struct EpiPle {
    static constexpr bool PERM = true;
    bf16* yp; const float* bg;
    __device__ __forceinline__ void operator()(const pg8::f32x4 (&acc)[2][2][4][2], const pg8::Unit& u, int wr, int wc, int fr, int fq) const {
        const int row0 = u.pm * 256 + wr * 64 + fr, col0 = u.pn * 256 + wc * 32 + 8 * fq;
#pragma unroll
        for (int ai = 0; ai < 2; ++ai)
#pragma unroll
            for (int m = 0; m < 4; ++m) { bf16* rowp = yp + (size_t)(row0 + ai * 128 + m * 16) * D + col0;
#pragma unroll
                for (int bj = 0; bj < 2; ++bj) { pg8::f32x4 v0 = acc[ai][bj][m][0], v1 = acc[ai][bj][m][1];
                    if (GATED) { const pg8::f32x4 b0 = *(const pg8::f32x4*)(bg + col0 + bj * 128), b1 = *(const pg8::f32x4*)(bg + col0 + bj * 128 + 4); const pg8::u32x4 y = *(const pg8::u32x4*)(rowp + bj * 128);
                        const float yf[8] = {bf2f((bf16)y.x), bf2f((bf16)(y.x >> 16)), bf2f((bf16)y.y), bf2f((bf16)(y.y >> 16)), bf2f((bf16)y.z), bf2f((bf16)(y.z >> 16)), bf2f((bf16)y.w), bf2f((bf16)(y.w >> 16))};
#pragma unroll
                        for (int e = 0; e < 4; ++e) { v0[e] = yf[e] * __builtin_amdgcn_rcpf(1.f + __builtin_amdgcn_exp2f((v0[e] + b0[e]) * -1.4426950408889634f)); v1[e] = yf[4 + e] * __builtin_amdgcn_rcpf(1.f + __builtin_amdgcn_exp2f((v1[e] + b1[e]) * -1.4426950408889634f)); } }
                    pg8::u32x4 w; w.x = pg8::cvt_pk_bf16(v0[0], v0[1]); w.y = pg8::cvt_pk_bf16(v0[2], v0[3]); w.z = pg8::cvt_pk_bf16(v1[0], v1[1]); w.w = pg8::cvt_pk_bf16(v1[2], v1[3]);
                    *(pg8::u32x4*)(rowp + bj * 128) = w; } }
    }
};
namespace att {
typedef float f32x16 __attribute__((ext_vector_type(16)));
constexpr int KSLOT = 8192, VSLOT = 16384, LDS_K = 0, LDS_V = 2 * KSLOT, ATT_LDS = 2 * KSLOT + 2 * VSLOT;
__device__ __forceinline__ bf16x8 pack8(const f32x16& p, int b) {
    v4u w; w.x = pg8::cvt_pk_bf16(p[b], p[b + 1]); w.y = pg8::cvt_pk_bf16(p[b + 2], p[b + 3]); w.z = pg8::cvt_pk_bf16(p[b + 4], p[b + 5]); w.w = pg8::cvt_pk_bf16(p[b + 6], p[b + 7]);
    return __builtin_bit_cast(bf16x8, w);
}
constexpr float THR2 = 8.f;
__device__ __forceinline__ void qkt(f32x16& p0, f32x16& p1, LAS const unsigned char* ks, const bf16x8 (&qf)[4], int r32, int hi) {
#pragma unroll
    for (int r = 0; r < 16; ++r) { p0[r] = 0.f; p1[r] = 0.f; }
    LAS const unsigned char* kb = ks + hi * 1024 + r32 * 16;
#pragma unroll
    for (int kk = 0; kk < 4; ++kk) {
        const bf16x8 a0 = *(LAS const bf16x8*)(kb + kk * 2048), a1 = *(LAS const bf16x8*)(kb + kk * 2048 + 512);
        p0 = __builtin_amdgcn_mfma_f32_32x32x16_bf16(a0, qf[kk], p0, 0, 0, 0);
        p1 = __builtin_amdgcn_mfma_f32_32x32x16_bf16(a1, qf[kk], p1, 0, 0, 0);
    }
}
__device__ __forceinline__ void partialSM(f32x16& p0, f32x16& p1, float& m, float& alpha) {
    float pmax = fmaxf(p0[0], p1[0]);
#pragma unroll
    for (int r = 1; r < 16; ++r) pmax = fmaxf(pmax, fmaxf(p0[r], p1[r]));
    { const auto rr = __builtin_amdgcn_permlane32_swap(__float_as_uint(pmax), __float_as_uint(pmax), false, false); pmax = fmaxf(__uint_as_float(rr[0]), __uint_as_float(rr[1])); }
    if (__builtin_expect(__all(pmax - m <= THR2), 1)) alpha = 1.f;
    else { const float mn = fmaxf(m, pmax); alpha = __builtin_amdgcn_exp2f(m - mn); m = mn; }
    const float mm = m;
#pragma unroll
    for (int r = 0; r < 16; ++r) { p0[r] = __builtin_amdgcn_exp2f(p0[r] - mm); p1[r] -= mm; }
}
__device__ __forceinline__ void finishSM(f32x16& p0, f32x16& p1, float alpha, float& l, bf16x8 (&pf)[4]) {
    float ps = 0.f;
#pragma unroll
    for (int r = 0; r < 16; ++r) { p1[r] = __builtin_amdgcn_exp2f(p1[r]); ps += p0[r] + p1[r]; }
    l = l * alpha + ps;
    pf[0] = pack8(p0, 0); pf[1] = pack8(p0, 8); pf[2] = pack8(p1, 0); pf[3] = pack8(p1, 8);
}
__device__ __forceinline__ void pv(f32x16 (&o)[4], LAS const unsigned char* vs, const bf16x8 (&pf)[4], int r32, int hi) {
    LAS const unsigned char* vb = vs + hi * 2048 + r32 * 16;
#pragma unroll
    for (int db = 0; db < 4; ++db) {
        bf16x8 va[4];
#pragma unroll
        for (int s = 0; s < 4; ++s) va[s] = *(LAS const bf16x8*)(vb + s * 4096 + db * 512);
#pragma unroll
        for (int s = 0; s < 4; ++s) o[db] = __builtin_amdgcn_mfma_f32_32x32x16_bf16(va[s], pf[s], o[db], 0, 0, 0);
        __builtin_amdgcn_sched_group_barrier(0x100, 4, 0); __builtin_amdgcn_sched_group_barrier(0x8, 4, 0);
    }
}
__device__ __forceinline__ void resc(f32x16 (&o)[4], float alpha) {
    if (__any(alpha < 1.f)) {
#pragma unroll
        for (int db = 0; db < 4; ++db)
#pragma unroll
            for (int r = 0; r < 16; ++r) o[db][r] *= alpha;
    }
}
__device__ __forceinline__ void unit(LAS unsigned char* lds, int b, int h, int qb, const bf16* QKP, const bf16* UVT, float lam, float lam_init, const float* subg, bf16* MIXB, float* stash, int wave, int lane) {
    asm volatile("" : "+v"(lane));
    const int r32 = lane & 31, hi = lane >> 5;
    const size_t tok0 = (size_t)b * S;
    const size_t qtok = tok0 + qb * 256 + wave * 32 + r32;
    constexpr int NT = S / 64;
#pragma unroll 1
    for (int c = 0; c < 2; ++c) {
        bf16x8 qf[4];
#pragma unroll
        for (int kk = 0; kk < 4; ++kk) qf[kk] = *(const GAS bf16x8*)(QKP + qtok * 1280 + h * 128 + c * 64 + kk * 16 + hi * 8);
        f32x16 o[4];
#pragma unroll
        for (int db = 0; db < 4; ++db)
#pragma unroll
            for (int r = 0; r < 16; ++r) o[db][r] = 0.f;
        float m = -INFINITY, l = 0.f, alA, alB;
        f32x16 pA0, pA1, pB0, pB1; bf16x8 pf[4];
        const char* kub = (const char*)(QKP + tok0 * 1280 + 512 + h * 128 + c * 64 + wave * 8);
        const char* vub = (const char*)(UVT + (size_t)(768 + h * 128) * M + tok0 + wave * 8);
        const unsigned kvo = (unsigned)lane * 2560u, vvo = (unsigned)lane * (unsigned)(M * 2);
#define ATT_DMA_K(t) __builtin_amdgcn_global_load_lds((const unsigned*)(kub + (size_t)(t) * (64 * 2560) + kvo), (LAS unsigned*)(lds + LDS_K + ((t) & 1) * KSLOT + wave * 1024), 16, 0, 0)
#define ATT_DMA_V(t) do { \
            __builtin_amdgcn_global_load_lds((const unsigned*)(vub + (size_t)(t) * 128 + vvo), (LAS unsigned*)(lds + LDS_V + ((t) & 1) * VSLOT + wave * 2048), 16, 0, 0); \
            __builtin_amdgcn_global_load_lds((const unsigned*)(vub + (size_t)64 * M * 2 + (size_t)(t) * 128 + vvo), (LAS unsigned*)(lds + LDS_V + ((t) & 1) * VSLOT + wave * 2048 + 1024), 16, 0, 0); } while (0)
#define SB() __builtin_amdgcn_sched_barrier(0)
#define ATT_SYNC() do { asm volatile("s_waitcnt vmcnt(0) lgkmcnt(0)" ::: "memory"); __builtin_amdgcn_s_barrier(); asm volatile("" ::: "memory"); } while (0)
        const bool early = wave < 4;
        ATT_SYNC();
        ATT_DMA_K(0); ATT_DMA_V(0);
        ATT_SYNC();
        ATT_DMA_K(1);
        qkt(pA0, pA1, lds + LDS_K, qf, r32, hi); partialSM(pA0, pA1, m, alA);
#pragma unroll 1
        for (int j = 1; j < NT - 1; j += 2) {
            ATT_SYNC(); if (early) { ATT_DMA_K(j + 1); ATT_DMA_V(j); }
            SB(); qkt(pB0, pB1, lds + LDS_K + KSLOT, qf, r32, hi); finishSM(pA0, pA1, alA, l, pf); SB();
            if (!early) { ATT_DMA_K(j + 1); ATT_DMA_V(j); }
            pv(o, lds + LDS_V, pf, r32, hi); partialSM(pB0, pB1, m, alB); SB(); resc(o, alB);
            ATT_SYNC(); if (early) { ATT_DMA_K(j + 2); ATT_DMA_V(j + 1); }
            SB(); qkt(pA0, pA1, lds + LDS_K, qf, r32, hi); finishSM(pB0, pB1, alB, l, pf); SB();
            if (!early) { ATT_DMA_K(j + 2); ATT_DMA_V(j + 1); }
            pv(o, lds + LDS_V + VSLOT, pf, r32, hi); partialSM(pA0, pA1, m, alA); SB(); resc(o, alA);
        }
        ATT_SYNC(); ATT_DMA_V(NT - 1);
        SB(); qkt(pB0, pB1, lds + LDS_K + KSLOT, qf, r32, hi); finishSM(pA0, pA1, alA, l, pf); SB();
        pv(o, lds + LDS_V, pf, r32, hi); partialSM(pB0, pB1, m, alB); SB(); resc(o, alB);
        ATT_SYNC();
        finishSM(pB0, pB1, alB, l, pf); pv(o, lds + LDS_V + VSLOT, pf, r32, hi);
#undef ATT_DMA_K
#undef ATT_DMA_V
#undef ATT_SYNC
#undef SB
        const float lt = xsum32(l);
        const int lane_e = (int)mk_lane_id();
        const int hi_e = lane_e >> 5; const size_t qtok_e = tok0 + qb * 256 + wave * 32 + (lane_e & 31);
        if (c == 0) {
            const float i1 = 1.f / lt;
#pragma unroll
            for (int db = 0; db < 4; ++db)
#pragma unroll
                for (int g4 = 0; g4 < 4; ++g4) *(GAS f32x4*)(stash + ((db * 4 + g4) * 64 + lane_e) * 4) = (f32x4){o[db][4 * g4] * i1, o[db][4 * g4 + 1] * i1, o[db][4 * g4 + 2] * i1, o[db][4 * g4 + 3] * i1};
        } else {
            const float i2 = lam / lt;
            float ss = 0.f;
#pragma unroll
            for (int db = 0; db < 4; ++db)
#pragma unroll
                for (int g4 = 0; g4 < 4; ++g4) { const f32x4 s1 = *(const GAS f32x4*)(stash + ((db * 4 + g4) * 64 + lane_e) * 4);
#pragma unroll
                    for (int i = 0; i < 4; ++i) { const float v = s1[i] - o[db][4 * g4 + i] * i2; o[db][4 * g4 + i] = v; ss += v * v; } }
            ss = xsum32(ss);
            const float rs = (1.f - lam_init) / sqrtf(ss * (1.f / 128.f) + 1e-5f);
            bf16* orow = MIXB + qtok_e * D + 256 + h * 128;
#pragma unroll
            for (int db = 0; db < 4; ++db)
#pragma unroll
                for (int g4 = 0; g4 < 4; ++g4) { const int e = 32 * db + 8 * g4 + 4 * hi_e; const f32x4 gg = *(const GAS f32x4*)(subg + e);
                    const unsigned long long w = (unsigned long long)pg8::cvt_pk_bf16(o[db][4 * g4] * rs * gg.x, o[db][4 * g4 + 1] * rs * gg.y) | ((unsigned long long)pg8::cvt_pk_bf16(o[db][4 * g4 + 2] * rs * gg.z, o[db][4 * g4 + 3] * rs * gg.w) << 32);
                    *(GAS unsigned long long*)(orow + e) = w; }
        }
    }
}
}
namespace hy {
typedef float f32x16 __attribute__((ext_vector_type(16)));
constexpr int CPY = 16456;
constexpr int VJ = 65, VK8 = VJ * 64;
constexpr int LDS_F = 0, LDS_VV = 4 * CPY, LDS_END = LDS_VV + 8 * VK8;
static_assert(LDS_VV % 16 == 0 && LDS_END <= 131072, "hyena LDS map");

__device__ __forceinline__ void filter_item(LAS unsigned char* lds, int pb, const float* fw1, const float* fb1, const float* fr1, const float* fw2, const float* fb2, const float* fr2,
                                            const float* fw3, bf16* KF, float* PS, int wave, int lane) {
    LAS bf16* tile = (LAS bf16*)lds;
    LAS float* za = (LAS float*)(lds + 65536) + wave * 512;
    LAS float* zb = (LAS float*)(lds + 81920) + wave * 512;
    LAS float* sqs = (LAS float*)(lds + 98304);
    const int p0 = pb * 64 + wave * 8;
    if (lane < 33) {
#pragma unroll 1
        for (int pi = 0; pi < 8; ++pi) { const int p = p0 + pi; float z;
            if (lane == 0) z = (float)p / (float)(S - 1);
            else { const int bi = (lane - 1) & 15; const float band = 1e-4f + (float)bi * ((15.0f - 1e-4f) / 15.0f), wpos = 2.0f * 3.14159265358979323846f * (float)p / (float)S;
                   z = lane <= 16 ? cosf(wpos * band) : -sinf(wpos * band); }
            za[pi * 64 + lane] = z; }
    }
    LDS_WAIT(); asm volatile("" ::: "memory");
    float acc8[8];
    { const float b1 = fb1[lane];
#pragma unroll
      for (int pi = 0; pi < 8; ++pi) acc8[pi] = b1;
#pragma unroll 1
      for (int i = 0; i < 33; ++i) { const float w = fw1[i * 64 + lane];
#pragma unroll
          for (int pi = 0; pi < 8; ++pi) acc8[pi] += za[pi * 64 + i] * w; }
      const float f1 = fr1[lane];
#pragma unroll
      for (int pi = 0; pi < 8; ++pi) zb[pi * 64 + lane] = sinf(f1 * acc8[pi]); }
    LDS_WAIT(); asm volatile("" ::: "memory");
    { const float b2 = fb2[lane];
#pragma unroll
      for (int pi = 0; pi < 8; ++pi) acc8[pi] = b2;
#pragma unroll 1
      for (int i = 0; i < 64; ++i) { const float w = fw2[i * 64 + lane];
#pragma unroll
          for (int pi = 0; pi < 8; ++pi) acc8[pi] += zb[pi * 64 + i] * w; }
      const float f2 = fr2[lane];
      LDS_WAIT(); asm volatile("" ::: "memory");
#pragma unroll
      for (int pi = 0; pi < 8; ++pi) za[pi * 64 + lane] = sinf(f2 * acc8[pi]); }
    LDS_WAIT(); asm volatile("" ::: "memory");
    const float mind = logf(1e-2f) / 1.5f, maxd = logf(1e-2f) / 0.3f;
#pragma unroll 1
    for (int qh = 0; qh < 2; ++qh) {
        float ac[8][4];
#pragma unroll
        for (int pi = 0; pi < 8; ++pi)
#pragma unroll
            for (int q = 0; q < 4; ++q) ac[pi][q] = 0.f;
#pragma unroll 1
        for (int i = 0; i < 64; ++i) { float w[4];
#pragma unroll
            for (int q = 0; q < 4; ++q) w[q] = fw3[i * 512 + lane + 64 * (qh * 4 + q)];
#pragma unroll
            for (int pi = 0; pi < 8; ++pi) { const float hv = za[pi * 64 + i];
#pragma unroll
                for (int q = 0; q < 4; ++q) ac[pi][q] += hv * w[q]; } }
#pragma unroll
        for (int q = 0; q < 4; ++q) { const int col = lane + 64 * (qh * 4 + q), ch = col & 255; const float delta = fabsf(mind + (float)ch * ((maxd - mind) / 255.0f)); float sq = 0.f;
#pragma unroll
            for (int pi = 0; pi < 8; ++pi) { const int p = p0 + pi; const float val = ac[pi][q] * expf(-((float)p / (float)(S - 1)) * delta);
                if (!(col >= 256 && p == 0)) sq += val * val;
                tile[col * 64 + wave * 8 + pi] = (bf16)f2bf(val); }
            sqs[wave * 512 + col] = sq; }
    }
    LDS_WAIT(); __syncthreads();
    { const int p = pb * 64 + lane;
#pragma unroll 1
      for (int cc = 0; cc < 64; ++cc) { const int col = wave * 64 + cc; const bf16 v = tile[col * 64 + lane];
          if (col < 256) KF[(size_t)col * 8192 + 4095 - p] = v; else if (p != 0) KF[(size_t)(col - 256) * 8192 + 4095 + p] = v; } }
    { const int t = wave * 64 + lane; float s = 0.f;
#pragma unroll
      for (int w = 0; w < 8; ++w) s += sqs[w * 512 + t];
      PS[(size_t)pb * 512 + t] = s;
      if (pb == 0 && t < 256) KF[(size_t)t * 8192 + 8191] = 0; }
    LDS_WAIT(); __syncthreads();
}

__device__ __forceinline__ float conv1(float um, float u0, float up, float w0, float w1, float w2, float cb) { return um * w0 + u0 * w1 + up * w2 + cb; }

__device__ __forceinline__ void unit(LAS unsigned char* lds, int c, const bf16* KF, const float* PS, const bf16* UVT, const float* cw, const float* cb, const float* bias_d, bf16* HT, int wave, int lane) {
    lane = (int)mk_lane_id(); asm volatile("" : "+s"(wave));
    const int tid = wave * 64 + lane;
    { const bf16* src = KF + (size_t)c * 8192;
#pragma unroll
      for (int i = 0; i < 2; ++i) { const int ch = tid + 512 * i; *(LAS v4u*)(lds + LDS_F + ch * 16) = *(const GAS v4u*)(src + ch * 8); } }
    { const float w0v = cw[512 + c], w1v = cw[768 + 512 + c], w2v = cw[1536 + 512 + c], cbv = cb[512 + c], w0x = cw[256 + c], w1x = cw[768 + 256 + c], w2x = cw[1536 + 256 + c], cbx = cb[256 + c];
      const bf16* rv = UVT + (size_t)(512 + c) * M; const bf16* rx = UVT + (size_t)(256 + c) * M;
#pragma unroll
      for (int i = 0; i < 4; ++i) { const int q = tid + 512 * i, b = q >> 9, sc = q & 511, s0 = sc * 8; const size_t g0 = (size_t)b * S + s0;
          const v4u av = *(const GAS v4u*)(rv + g0), ax = *(const GAS v4u*)(rx + g0);
          float uv[10], ux[10];
          uv[0] = s0 > 0 ? bf2f(rv[g0 - 1]) : 0.f; ux[0] = s0 > 0 ? bf2f(rx[g0 - 1]) : 0.f; uv[9] = s0 + 8 < S ? bf2f(rv[g0 + 8]) : 0.f; ux[9] = s0 + 8 < S ? bf2f(rx[g0 + 8]) : 0.f;
#pragma unroll
          for (int e = 0; e < 4; ++e) { uv[1 + 2 * e] = bf2f((bf16)av[e]); uv[2 + 2 * e] = bf2f((bf16)(av[e] >> 16)); ux[1 + 2 * e] = bf2f((bf16)ax[e]); ux[2 + 2 * e] = bf2f((bf16)(ax[e] >> 16)); }
          float o[8];
#pragma unroll
          for (int e = 0; e < 8; ++e) o[e] = conv1(uv[e], uv[e + 1], uv[e + 2], w0v, w1v, w2v, cbv) * conv1(ux[e], ux[e + 1], ux[e + 2], w0x, w1x, w2x, cbx);
          v4u w; w.x = pk2(o[0], o[1]); w.y = pk2(o[2], o[3]); w.z = pk2(o[4], o[5]); w.w = pk2(o[6], o[7]);
          *(LAS v4u*)(lds + LDS_VV + (((sc & 7) * VJ + (sc >> 3)) * 4 + b) * 16) = w; }
      if (tid < 32) { unsigned z_; asm volatile("v_mov_b32 %0, 0" : "=v"(z_)); *(LAS v4u*)(lds + LDS_VV + (((tid >> 2) * VJ + 64) * 4 + (tid & 3)) * 16) = (v4u){z_, z_, z_, z_}; } }
    LDS_WAIT(); __syncthreads();
    {
#pragma unroll 1
      for (int i = 0; i < 4; ++i) { const int y = tid + 512 * i;
          const unsigned long long w0 = *(LAS const unsigned long long*)(lds + LDS_F + y * 8), w1 = *(LAS const unsigned long long*)(lds + LDS_F + y * 8 + 8);
#pragma unroll
          for (int p = 1; p < 4; ++p) *(LAS unsigned long long*)(lds + LDS_F + p * CPY + y * 8) = (w0 >> (16 * p)) | (w1 << (64 - 16 * p)); } }
    const float nrm = 1.0f / sqrtf(wave_sum(PS[(size_t)lane * 512 + c] + PS[(size_t)lane * 512 + 256 + c]) + 1e-6f);
    LDS_WAIT(); __syncthreads();
    const int r32 = lane & 31, hi = lane >> 5, gp = wave & 3, half = wave >> 2, iloc = r32 >> 2, b = r32 & 3;
    f32x16 acc[2][2];
#pragma unroll
    for (int rho = 0; rho < 2; ++rho)
#pragma unroll
        for (int gg = 0; gg < 2; ++gg)
#pragma unroll
            for (int r = 0; r < 16; ++r) acc[rho][gg][r] = 0.f;
    const int dlo = 16 * gp - 63 + (half ? 40 : 0), dn = half ? 39 : 40;
    int pa = LDS_F + (3 - (r32 & 3)) * CPY + (4092 - 4 * (r32 >> 2) + 8 * hi) * 2 - 64 - 128 * dlo;
    int jb = 16 * gp + iloc - dlo;
    const int pbase = LDS_VV + hi * VK8 + b * 16;
    typedef unsigned long long u64;
    struct Frag { u64 a[4][4]; v4u b[4][2]; };
#define HY_LOAD(F) do { const int j0_ = jb, j1_ = jb + 8; LAS const unsigned char* ap_ = lds + pa; \
        LAS const unsigned char* bp0_ = lds + pbase + ((unsigned)j0_ < 64u ? j0_ : 64) * 64; LAS const unsigned char* bp1_ = lds + pbase + ((unsigned)j1_ < 64u ? j1_ : 64) * 64; \
        _Pragma("unroll") for (int k = 0; k < 4; ++k) { F.a[k][0] = *(LAS const u64*)(ap_ + 64 + 32 * k); F.a[k][1] = *(LAS const u64*)(ap_ + 64 + 32 * k + 8); F.a[k][2] = *(LAS const u64*)(ap_ + 32 * k); F.a[k][3] = *(LAS const u64*)(ap_ + 32 * k + 8); \
            F.b[k][0] = *(LAS const v4u*)(bp0_ + k * (2 * VK8)); F.b[k][1] = *(LAS const v4u*)(bp1_ + k * (2 * VK8)); } \
        pa -= 128; jb -= 1; } while (0)
#define HY_MMA(F) do { _Pragma("unroll") for (int k = 0; k < 4; ++k) { \
            const bf16x8 fa0 = __builtin_bit_cast(bf16x8, (v4u){(unsigned)F.a[k][0], (unsigned)(F.a[k][0] >> 32), (unsigned)F.a[k][1], (unsigned)(F.a[k][1] >> 32)}); \
            const bf16x8 fa1 = __builtin_bit_cast(bf16x8, (v4u){(unsigned)F.a[k][2], (unsigned)(F.a[k][2] >> 32), (unsigned)F.a[k][3], (unsigned)(F.a[k][3] >> 32)}); \
            const bf16x8 fb0 = __builtin_bit_cast(bf16x8, F.b[k][0]), fb1 = __builtin_bit_cast(bf16x8, F.b[k][1]); \
            acc[0][0] = __builtin_amdgcn_mfma_f32_32x32x16_bf16(fa0, fb0, acc[0][0], 0, 0, 0); acc[0][1] = __builtin_amdgcn_mfma_f32_32x32x16_bf16(fa0, fb1, acc[0][1], 0, 0, 0); \
            acc[1][0] = __builtin_amdgcn_mfma_f32_32x32x16_bf16(fa1, fb0, acc[1][0], 0, 0, 0); acc[1][1] = __builtin_amdgcn_mfma_f32_32x32x16_bf16(fa1, fb1, acc[1][1], 0, 0, 0); } } while (0)
#define HY_MIX() do { _Pragma("unroll") for (int i_ = 0; i_ < 8; ++i_) { __builtin_amdgcn_sched_group_barrier(0x100, 3, 0); __builtin_amdgcn_sched_group_barrier(0x8, 2, 0); } } while (0)
    Frag FA, FB;
    HY_LOAD(FA);
    int dd = 0;
#pragma unroll 1
    for (; dd + 2 <= dn; dd += 2) {
        HY_LOAD(FB); HY_MMA(FA); HY_MIX();
        if (dd + 2 < dn) { HY_LOAD(FA); HY_MMA(FB); HY_MIX(); } else { HY_MMA(FB); }
    }
    if (dd < dn) HY_MMA(FA);
#undef HY_MIX
#undef HY_LOAD
#undef HY_MMA
    const int lane_b = (int)mk_lane_id(), r32_b = lane_b & 31, hi_b = lane_b >> 5, iloc_b = r32_b >> 2, b_b = r32_b & 3;
    LDS_WAIT(); __syncthreads();
    { LAS float* xw = (LAS float*)(lds + LDS_F) + (gp * 2 + (half ? 0 : 1)) * 2048 + lane_b;
#pragma unroll
      for (int gg = 0; gg < 2; ++gg)
#pragma unroll
          for (int r = 0; r < 16; ++r) xw[(gg * 16 + r) * 64] = half ? acc[0][gg][r] : acc[1][gg][r]; }
    LDS_WAIT(); __syncthreads();
    f32x16 fin[2];
    { LAS const float* xr = (LAS const float*)(lds + LDS_F) + (gp * 2 + (half ? 1 : 0)) * 2048 + lane_b;
#pragma unroll
      for (int gg = 0; gg < 2; ++gg)
#pragma unroll
          for (int r = 0; r < 16; ++r) fin[gg][r] = (half ? acc[1][gg][r] : acc[0][gg][r]) + xr[(gg * 16 + r) * 64]; }
    { const float bd = bias_d[c], w0 = cw[c], w1 = cw[768 + c], w2 = cw[1536 + c], cb0 = cb[c]; const bf16* r0p = UVT + (size_t)c * M; bf16* hrow = HT + (size_t)c * M;
#pragma unroll
      for (int gg = 0; gg < 2; ++gg)
#pragma unroll
          for (int g4 = 0; g4 < 4; ++g4) { const int i = 16 * gp + 8 * gg + iloc_b, rr = 32 * half + 8 * g4 + 4 * hi_b, t0 = 64 * i + rr; const size_t tok = (size_t)b_b * S + t0;
              const unsigned long long vw = *(LAS const unsigned long long*)(lds + LDS_VV + (((rr >> 3) * VJ + i) * 4 + b_b) * 16 + (rr & 7) * 2);
              const unsigned long long uw = *(const GAS unsigned long long*)(r0p + tok);
              float u[6]; u[0] = t0 > 0 ? bf2f(r0p[tok - 1]) : 0.f; u[5] = t0 + 4 < S ? bf2f(r0p[tok + 4]) : 0.f;
              u[1] = bf2f((bf16)uw); u[2] = bf2f((bf16)(uw >> 16)); u[3] = bf2f((bf16)(uw >> 32)); u[4] = bf2f((bf16)(uw >> 48));
              float o[4];
#pragma unroll
              for (int e = 0; e < 4; ++e) { const float vv = bf2f((bf16)(vw >> (16 * e))); o[e] = (nrm * fin[gg][4 * g4 + e] + vv * bd) * conv1(u[e], u[e + 1], u[e + 2], w0, w1, w2, cb0); }
              *(GAS unsigned long long*)(hrow + tok) = (unsigned long long)pk2(o[0], o[1]) | ((unsigned long long)pk2(o[2], o[3]) << 32); } }
    LDS_WAIT(); __syncthreads();
}
__device__ __forceinline__ void transpose_slab(LAS unsigned char* lds, int slab, const bf16* HT, bf16* MIXB, int wave, int lane) {
    const int tid = wave * 64 + lane; LAS bf16* tile = (LAS bf16*)lds;
#pragma unroll 1
    for (int i = 0; i < 4; ++i) { const int q = tid + 512 * i, c = q >> 3, tc = q & 7; const v4u w = *(const GAS v4u*)(HT + (size_t)c * M + (size_t)slab * 64 + tc * 8);
#pragma unroll
        for (int e = 0; e < 4; ++e) { tile[(tc * 8 + 2 * e) * 264 + c] = (bf16)w[e]; tile[(tc * 8 + 2 * e + 1) * 264 + c] = (bf16)(w[e] >> 16); } }
    LDS_WAIT(); __syncthreads();
#pragma unroll 1
    for (int i = 0; i < 4; ++i) { const int q = tid + 512 * i, tk = q >> 5, cc = q & 31;
        *(GAS v4u*)(MIXB + ((size_t)slab * 64 + tk) * D + cc * 8) = *(LAS const v4u*)(lds + (tk * 264 + cc * 8) * 2); }
    LDS_WAIT(); __syncthreads();
}
}
#ifndef DUP_PRO
#define DUP_PRO 1
#endif
#ifndef DUP_IN
#define DUP_IN 1
#endif
#ifndef DUP_HY
#define DUP_HY 1
#endif
#ifndef DUP_POOL
#define DUP_POOL 1
#endif
#ifndef DUP_HYT
#define DUP_HYT 1
#endif
#ifndef DUP_ATT
#define DUP_ATT 1
#endif
#ifndef DUP_OUT
#define DUP_OUT 1
#endif
#ifndef DUP_LN1
#define DUP_LN1 1
#endif
#ifndef DUP_MOE1
#define DUP_MOE1 1
#endif
#ifndef DUP_MOE2
#define DUP_MOE2 1
#endif
#ifndef DUP_LN2
#define DUP_LN2 1
#endif
#ifndef EN_HY
#define EN_HY 1
#endif
#ifndef EN_HYT
#define EN_HYT 1
#endif
#ifndef EN_PRO
#define EN_PRO 1
#endif
#ifndef EN_IN
#define EN_IN 1
#endif
#ifndef EN_ATT
#define EN_ATT 1
#endif
#ifndef EN_POOL
#define EN_POOL 1
#endif
#ifndef EN_OUT
#define EN_OUT 1
#endif
#ifndef EN_LN1
#define EN_LN1 1
#endif
#ifndef EN_WCV
#define EN_WCV 1
#endif
#ifndef EN_MOE1
#define EN_MOE1 1
#endif
#ifndef EN_MOE2
#define EN_MOE2 1
#endif
#ifndef EN_LN2
#define EN_LN2 1
#endif
constexpr int RING_BYTES = 135168;
constexpr int LDSCTL_OFF = RING_BYTES, MISC_OFF = LDSCTL_OFF + 320, MOETAB_OFF = LDSCTL_OFF + 1024, ROUTE_OFF = LDSCTL_OFF + 2048;
constexpr int LDS_BYTES = 151552;

struct Args { const float* in[38]; float* out; unsigned char* ws; int* eid; float* wts; int ph_lo, ph_hi, l_lo, l_hi, single, pad; };
enum { PH_PRO = 0, PH_IN = 1, PH_ATT = 2, PH_POOL = 3, PH_OUT = 4, PH_LN1 = 5, PH_WCV = 6, PH_MOE1 = 7, PH_MOE2 = 8, PH_LN2 = 9, PH_HY = 10, PH_HYT = 11, PH_END = 12 };

__global__ void __launch_bounds__(NWAVES * 64, 2) mk_fwd(Args a) {
    extern __shared__ __attribute__((aligned(16))) unsigned char lds_raw[];
    LAS unsigned char* lds = (LAS unsigned char*)lds_raw;
    volatile LAS unsigned* MISC = (volatile LAS unsigned*)(lds + MISC_OFF);
    const int wave_s = __builtin_amdgcn_readfirstlane((int)threadIdx.x >> 6);
    const int G = gridDim.x, bx = blockIdx.x, vcu0 = (G % 8 == 0) ? (bx % 8) * (G / 8) + bx / 8 : bx;
    gu32* ctl0 = (gu32*)(a.ws + WS_CTL);
    for (int u = wave_s * 64 + (int)mk_lane_id(); u < (LDS_BYTES - LDSCTL_OFF) / 4; u += NWAVES * 64) ((LAS unsigned*)(lds + LDSCTL_OFF))[u] = 0u;
    __syncthreads();
    XcdBarrier bar; bar.bar = (unsigned*)(ctl0 + CW_BAR); bar.x = 0; bar.st = nullptr;
#if defined(MK_PER_PHASE)
    if (!a.single)
#endif
    bar = xcd_barrier_post((unsigned*)(ctl0 + CW_BAR), MISC + 8, wave_s);
#if defined(MK_PER_PHASE)
#define IN(k) (a.ph_lo <= (k) && (k) < a.ph_hi)
#define SEAM() do { if (!a.single) xcd_barrier(bar, wave_s); } while (0)
#else
#define IN(k) 1
#if defined(PROBE_BAR2)
#define SEAM() do { xcd_barrier(bar, wave_s); xcd_barrier(bar, wave_s); } while (0)
#else
#define SEAM() xcd_barrier(bar, wave_s)
#endif
#endif
    const int NGW = G * NWAVES;
#define PHASE_PTRS() int lane_ = (int)mk_lane_id(); asm volatile("" : "+v"(lane_)); const int lane = lane_, wave = wave_s; int vcu = vcu0; asm volatile("" : "+s"(vcu)); (void)wave; const int gw = vcu * NWAVES + wave; (void)gw; unsigned char* ws = a.ws; gu32* ctl = (gu32*)(ws + WS_CTL); (void)ctl; \
    bf16* XB = (bf16*)(ws + WS_XB); bf16* QKP = (bf16*)(ws + WS_QKP); bf16* UVT = (bf16*)(ws + WS_UVT); float* CS = (float*)(ws + WS_CS); bf16* MIXB = (bf16*)(ws + WS_MIXB); \
    (void)XB; (void)QKP; (void)UVT; (void)CS; (void)MIXB
#define INP(k) (a.in[k])
#define WCV_LAYER(LEXPR, GW_, NGW_) do { const int wl_ = (LEXPR), wg_ = (GW_), wn_ = (NGW_); const int l = wl_, gw = wg_, NGW = wn_; (void)NGW; \
            LAS float* scr = (LAS float*)(lds + wave * 16384); \
            unsigned char* wb_ = ws + WS_WBUF + (size_t)(l & 1) * WBUF_STRIDE; bf16* W13 = (bf16*)(wb_ + WB_W13); bf16* W2 = (bf16*)(wb_ + WB_W2); bf16* WG = (bf16*)(wb_ + WB_WG); bf16* WP = (bf16*)(wb_ + WB_WP); \
            for (int it = gw; it < 6784; it += NGW) { \
                const float* src; int K, N, k0, n0, mode = 0; bf16* dst; \
                if (it < 4096) { const int which = it >> 11, r = it & 2047, e = r >> 7, kb = (r >> 3) & 15, nb = r & 7; \
                    src = INP(which ? 31 : 30) + ((size_t)l * 16 + e) * D * 256; K = D; N = 256; k0 = kb * 64; n0 = nb * 32; mode = 1 + which; dst = W13 + (size_t)e * 512 * D; \
                } else if (it < 6144) { const int r = it - 4096, e = r >> 7, kb = (r >> 5) & 3, nb = r & 31; \
                    src = INP(32) + ((size_t)l * 16 + e) * 256 * D; K = 256; N = D; k0 = kb * 64; n0 = nb * 32; dst = W2 + (size_t)e * D * 256 + (size_t)n0 * 256; \
                } else if (it < 6656) { const int r = it - 6144, kb = r >> 5, nb = r & 31; \
                    src = INP(33) + (size_t)l * D * D; K = D; N = D; k0 = kb * 64; n0 = nb * 32; dst = WG + (size_t)n0 * D; \
                } else { const int r = it - 6656, kb = r >> 5, nb = r & 31; \
                    src = INP(35) + (size_t)l * 256 * D; K = 256; N = D; k0 = kb * 64; n0 = nb * 32; dst = WP + (size_t)n0 * 256; } \
                p0_transpose_block(src, K, N, k0, n0, dst, mode, scr, lane); \
            } \
            const int ln = lane; \
            const float* ps = INP(1) + (size_t)l * M * 256; bf16* PB = (bf16*)(wb_ + WB_PB); \
            for (size_t i = ((size_t)gw * 64 + ln) * 8; i < (size_t)M * 256; i += (size_t)NGW * 64 * 8) { const f32x4 x0 = *(const GAS f32x4*)(ps + i), x1 = *(const GAS f32x4*)(ps + i + 4); \
                v4u o; o.x = pk2(x0.x, x0.y); o.y = pk2(x0.z, x0.w); o.z = pk2(x1.x, x1.y); o.w = pk2(x1.z, x1.w); *(GAS v4u*)(PB + i) = o; } \
    } while (0)

    if (EN_PRO && IN(PH_PRO)) {
            PHASE_PTRS();
            for (int rep_ = 0; rep_ < DUP_PRO; ++rep_) {
        LAS float* scr = (LAS float*)(lds + wave * 16384);
        for (int it = gw; it < DEPTH * (16 * 72 + 16 * 32); it += NGW) {
            const int l = it / 1664, r = it % 1664; const float* src; int N, k0, n0; bf16* dst;
            if (r < 1152) { const int kb = r / 72, nb = r % 72; n0 = nb * 32; k0 = kb * 64; N = INW; src = INP(4) + (size_t)l * D * INW;
                bf16* wsw = (bf16*)(ws + WS_WIN + (size_t)l * WIN_LAYER); bf16* wnm = wsw + 1280 * 1024;
                dst = n0 < 768 ? wsw + (size_t)n0 * D : (n0 < 1792 ? wnm + (size_t)(n0 - 768) * D : wsw + (size_t)(768 + n0 - 1792) * D); }
            else { const int q = r - 1152, kb = q >> 5, nb = q & 31; n0 = nb * 32; k0 = kb * 64; N = D; src = INP(23) + (size_t)l * D * D; dst = (bf16*)(ws + WS_WOUT + (size_t)l * WOUT_LAYER) + (size_t)n0 * D; }
            p0_transpose_block(src, D, N, k0, n0, dst, 0, scr, lane);
            }
        }
        for (int it = gw; it < DEPTH * 4 * 16 * 2; it += NGW) {
            const int l = it >> 7, g = (it >> 5) & 3, dh = (it >> 4) & 1, k = (it & 15) * 64 + lane;
            const float* wrow = INP(4) + (size_t)l * D * INW + (size_t)k * INW + 2304 + g * 64;
            const float* pw = INP(20) + (size_t)(l * 4 + g) * 64 * 64 + dh * 32;
            float acc[32];
#pragma unroll
            for (int d = 0; d < 32; ++d) acc[d] = 0.f;
#pragma unroll 1
            for (int c = 0; c < 64; ++c) { const float x = wrow[c];
#pragma unroll
                for (int d = 0; d < 32; ++d) acc[d] += x * pw[c * 64 + d]; }
            bf16* dst = (bf16*)(ws + WS_WIN + (size_t)l * WIN_LAYER) + (size_t)(1280 + 1024 + g * 64 + dh * 32) * D + k;
#pragma unroll
            for (int d = 0; d < 32; ++d) dst[(size_t)d * D] = (bf16)f2bf(acc[d]);
        }
        for (int i = gw * 64 + lane; i < DEPTH * 32 * D; i += NGW * 64) { const int l2 = i / (32 * D), r = i % (32 * D), col = r / D, k = r % D;
            const float w = col < 4 ? INP(26)[((size_t)l2 * D + k) * 4 + col] : (col < 20 ? INP(28)[((size_t)l2 * D + k) * 16 + col - 4] : 0.f);
            const unsigned hb = f2bf(w); const float lo = w - __uint_as_float(hb << 16);
            bf16* dst = (bf16*)(ws + WS_WR) + (size_t)l2 * 64 * D; dst[(size_t)col * D + k] = (bf16)hb; dst[(size_t)(32 + col) * D + k] = (bf16)f2bf(lo); }
        int ln2 = lane; asm volatile("" : "+v"(ln2));
        for (int i = gw * 64 + ln2; i < S * 8; i += NGW * 64) { const int pos = i >> 3, j = i & 7; const float ang = (float)pos * powf(500000.0f, -(float)(2 * j) / 16.0f);
            CS[pos * 16 + j] = cosf(ang); CS[pos * 16 + 8 + j] = sinf(ang); }
        for (int m = gw; m < M; m += NGW) ln_row(INP(0) + (size_t)m * D, 1.f, nullptr, nullptr, nullptr, INP(2), INP(3), nullptr, XB + (size_t)m * D, lane);
        WCV_LAYER(0, gw, NGW);
        LDS_WAIT(); __syncthreads();
        for (int it = vcu; it < DEPTH * 64; it += G) { const int fl = it >> 6, pb = it & 63;
            hy::filter_item(lds, pb, INP(7) + fl * 33 * 64, INP(8) + fl * 64, INP(9) + fl * 64, INP(10) + fl * 64 * 64, INP(11) + fl * 64, INP(12) + fl * 64, INP(13) + fl * 64 * 512,
                            (bf16*)(ws + WS_KF) + (size_t)fl * 256 * 8192, (float*)(ws + WS_PS) + (size_t)fl * 64 * 512, wave, lane); }
        SEAM();
    }
#if defined(MK_PER_PHASE)
    for (int l = a.l_lo; l < a.l_hi; ++l) {
#else
#pragma unroll 1
    for (int l = 0; l < DEPTH; ++l) {
#endif
        if (EN_IN && IN(PH_IN)) {
            PHASE_PTRS();
            for (int rep_ = 0; rep_ < DUP_IN; ++rep_) {
            const char* wsw = (const char*)(ws + WS_WIN + (size_t)l * WIN_LAYER);
            SchedIn Sc{vcu, G, (const char*)XB, wsw, wsw + (size_t)1280 * 1024 * 2};
            EpiIn E{QKP, UVT, CS};
            pg8::gemm_phase<EpiIn, SchedIn>(lds, D, Sc, E, wave);
            { SchedSq Sc2{vcu, G / 2, (const char*)(ws + WS_WBUF + (size_t)(l & 1) * WBUF_STRIDE + WB_PB), (const char*)(ws + WS_WBUF + (size_t)(l & 1) * WBUF_STRIDE + WB_WP), (size_t)256 * 256 * 2, (size_t)256 * 256 * 2, G / 2};
              EpiPle<0> E2{(bf16*)(ws + WS_YP), nullptr};
              pg8::gemm_phase<EpiPle<0>, SchedSq>(lds, 256, Sc2, E2, wave); }
            }
            SEAM();
        }
        if (EN_HY && IN(PH_HY)) {
            PHASE_PTRS();
            for (int rep_ = 0; rep_ < DUP_HY; ++rep_) {
            for (int c = vcu; c < 256; c += G)
                hy::unit(lds, c, (const bf16*)(ws + WS_KF) + (size_t)l * 256 * 8192, (const float*)(ws + WS_PS) + (size_t)l * 64 * 512, UVT, INP(5) + l * 3 * 768, INP(6) + l * 768, INP(14) + l * 256, (bf16*)(ws + WS_HT), wave, lane);
            }
        }
        if (EN_POOL && IN(PH_POOL)) {
            PHASE_PTRS();
            for (int rep_ = 0; rep_ < DUP_POOL; ++rep_) {
            int ln = lane; asm volatile("" : "+v"(ln));
            const int cc = (ln & 31) * 8, gq = cc >> 6, hw = 1 << gq;
            const float* pb = INP(21) + l * 256 + cc; const float* psc = INP(22) + l * 256 + cc;
            for (int it = gw; it < M / 2; it += NGW) {
                const int tok = it * 2 + (ln >> 5), pos = tok & (S - 1);
                int lo = pos - hw, hi2 = pos + hw - 1; lo = lo < 0 ? 0 : lo; hi2 = hi2 > S - 1 ? S - 1 : hi2;
                float sacc[8];
#pragma unroll
                for (int e = 0; e < 8; ++e) sacc[e] = 0.f;
                const bf16* zp = QKP + (size_t)(tok - pos) * 1280 + 1024 + cc;
                for (int r = lo; r <= hi2; ++r) { const v4u w = *(const GAS v4u*)(zp + (size_t)r * 1280);
                    sacc[0] += bf2f((bf16)w.x); sacc[1] += bf2f((bf16)(w.x >> 16)); sacc[2] += bf2f((bf16)w.y); sacc[3] += bf2f((bf16)(w.y >> 16));
                    sacc[4] += bf2f((bf16)w.z); sacc[5] += bf2f((bf16)(w.z >> 16)); sacc[6] += bf2f((bf16)w.w); sacc[7] += bf2f((bf16)(w.w >> 16)); }
                const float inv = 1.f / (float)(hi2 - lo + 1);
                const v4u w = *(const GAS v4u*)(zp + (size_t)pos * 1280);
                float z[8] = {bf2f((bf16)w.x), bf2f((bf16)(w.x >> 16)), bf2f((bf16)w.y), bf2f((bf16)(w.y >> 16)), bf2f((bf16)w.z), bf2f((bf16)(w.z >> 16)), bf2f((bf16)w.w), bf2f((bf16)(w.w >> 16))};
                float y[8];
#pragma unroll
                for (int e = 0; e < 8; ++e) y[e] = (sacc[e] * inv - z[e] + pb[e]) * psc[e];
                v4u o; o.x = pk2(y[0], y[1]); o.y = pk2(y[2], y[3]); o.z = pk2(y[4], y[5]); o.w = pk2(y[6], y[7]);
                *(GAS v4u*)(MIXB + (size_t)tok * D + 768 + cc) = o;
            }
            }
            SEAM();
        }
        if (EN_HYT && IN(PH_HYT)) {
            PHASE_PTRS();
            for (int rep_ = 0; rep_ < DUP_HYT; ++rep_) {
            for (int s = vcu; s < 256; s += G) hy::transpose_slab(lds, s, (const bf16*)(ws + WS_HT), MIXB, wave, lane);
            }
        }
        if (EN_ATT && IN(PH_ATT)) {
            PHASE_PTRS();
            for (int rep_ = 0; rep_ < DUP_ATT; ++rep_) {
            const float lam_init = 0.8f - 0.6f * expf(-0.3f * (float)l);
            int ln = lane; asm volatile("" : "+v"(ln));
            const float lam = expf(wave_sum(INP(15)[l * 64 + ln] * INP(16)[l * 64 + ln])) - expf(wave_sum(INP(17)[l * 64 + ln] * INP(18)[l * 64 + ln])) + lam_init;
            for (int u = vcu; u < 256; u += G) att::unit(lds, (u >> 4) >> 2, (u >> 4) & 3, u & 15, QKP, UVT, lam, lam_init, INP(19) + l * 128, MIXB, (float*)(ws + WS_STASH) + ((size_t)u * 8 + wave) * 4096, wave, lane);
            }
            SEAM();
        }
        if (EN_OUT && IN(PH_OUT)) {
            PHASE_PTRS();
            for (int rep_ = 0; rep_ < DUP_OUT; ++rep_) {
            SchedOut Sc{vcu, G, (const char*)MIXB, (const char*)(ws + WS_WOUT + (size_t)l * WOUT_LAYER)};
#if defined(PROBE_OUT)
            { EpiRes E0{(bf16*)(ws + WS_STASH)}; pg8::gemm_phase<EpiRes, SchedOut>(lds, D, Sc, E0, wave); }
#endif
            EpiRes E{XB};
            pg8::gemm_phase<EpiRes, SchedOut>(lds, D, Sc, E, wave);
            }
            SEAM();
        }
        if (EN_LN1 && IN(PH_LN1)) {
            PHASE_PTRS();
            for (int rep_ = 0; rep_ < DUP_LN1; ++rep_) {
            int ln = lane; asm volatile("" : "+v"(ln));
#if defined(PROBE_LN1)
            for (int ch = vcu; ch < M / 64; ch += G)
                ln1_router_chunk<PROBE_LN1>((LAS RouteLds*)(lds + ROUTE_OFF), lds, ch * 64, XB, (bf16*)(ws + WS_STASH), INP(24) + l * D, INP(25) + l * D, (const bf16*)(ws + WS_WR) + (size_t)l * 64 * D, INP(27) + l * 4, INP(29) + l * 16,
                                 ctl + CW_CNT + l * 16 * CNT_STRIDE, (int*)(ws + WS_TOKIDX), (float*)(ws + WS_GATE), wave, lane);
#endif
            for (int ch = vcu; ch < M / 64; ch += G)
                ln1_router_chunk((LAS RouteLds*)(lds + ROUTE_OFF), lds, ch * 64, XB, XB, INP(24) + l * D, INP(25) + l * D, (const bf16*)(ws + WS_WR) + (size_t)l * 64 * D, INP(27) + l * 4, INP(29) + l * 16,
                                 ctl + CW_CNT + l * 16 * CNT_STRIDE, (int*)(ws + WS_TOKIDX), (float*)(ws + WS_GATE), wave, lane);
            }
            SEAM();
        }
        if (EN_MOE1 && IN(PH_MOE1)) {
            PHASE_PTRS();
            for (int rep_ = 0; rep_ < DUP_MOE1; ++rep_) {
            moe_tab_build((LAS int*)(lds + MOETAB_OFF), ctl + CW_CNT + l * 16 * CNT_STRIDE, wave == 0 && lane == 0); const MoeTab T{(LAS const int*)(lds + MOETAB_OFF)};
            { SchedMoe<2> Sc{vcu, G, T, (const char*)XB, (const char*)(ws + WS_WBUF + (size_t)(l & 1) * WBUF_STRIDE + WB_W13), (size_t)512 * D * 2, (const int*)(ws + WS_TOKIDX), 0};
              EpiMoe1 E{(bf16*)(ws + WS_ACT), (const float*)(ws + WS_GATE), T};
              pg8::gemm_phase<EpiMoe1, SchedMoe<2>, true>(lds, D, Sc, E, wave);
#if defined(PROBE_MOE1A)
              pg8::gemm_phase<EpiMoe1, SchedMoe<2>, true>(lds, D, Sc, E, wave);
#endif
            }
            { SchedSq Sc{vcu, G, (const char*)XB, (const char*)(ws + WS_WBUF + (size_t)(l & 1) * WBUF_STRIDE + WB_WG), TILEB, TILEB, 0};
              EpiPle<1> E{(bf16*)(ws + WS_YP), INP(34) + l * D};
              pg8::gemm_phase<EpiPle<1>, SchedSq>(lds, D, Sc, E, wave); }
            if (l + 1 < DEPTH) {
                int x2 = 2 * T.pre(16) - G; x2 = x2 < 0 ? 0 : (x2 > G / 2 ? G / 2 : x2);
                if (vcu >= x2) WCV_LAYER(l + 1, (vcu - x2) * NWAVES + wave, (G - x2) * NWAVES);
            }
            }
            SEAM();
        }
        if (EN_MOE2 && IN(PH_MOE2)) {
            PHASE_PTRS();
            for (int rep_ = 0; rep_ < DUP_MOE2; ++rep_) {
            moe_tab_build((LAS int*)(lds + MOETAB_OFF), ctl + CW_CNT + l * 16 * CNT_STRIDE, wave == 0 && lane == 0); const MoeTab T{(LAS const int*)(lds + MOETAB_OFF)};
            SchedMoe<4> Sc{vcu, G, T, (const char*)(ws + WS_ACT), (const char*)(ws + WS_WBUF + (size_t)(l & 1) * WBUF_STRIDE + WB_W2), (size_t)D * 256 * 2, (const int*)(ws + WS_TOKIDX), (size_t)256 * 256 * 2};
            EpiMoe2 E{(bf16*)(ws + WS_YMOE), (const int*)(ws + WS_TOKIDX), T};
            pg8::gemm_phase<EpiMoe2, SchedMoe<4>>(lds, 256, Sc, E, wave);
            }
            SEAM();
        }
        if (EN_LN2 && IN(PH_LN2)) {
            PHASE_PTRS();
            for (int rep_ = 0; rep_ < DUP_LN2; ++rep_) {
            int ln = lane; asm volatile("" : "+v"(ln));
            const bf16* YM = (const bf16*)(ws + WS_YMOE); const bf16* YP = (const bf16*)(ws + WS_YP);
            const bool lastl = (l == DEPTH - 1);
#if defined(PROBE_LN2)
            for (int m = gw; m < M; m += NGW)
                ln_row(XB + (size_t)m * D, DN_ALPHA, YM + (size_t)(2 * m) * D, YM + (size_t)(2 * m + 1) * D, YP + (size_t)m * D, INP(36) + l * D, INP(37) + l * D, (float*)nullptr, (bf16*)(ws + WS_STASH) + (size_t)m * D, ln);
#endif
            for (int m = gw; m < M; m += NGW)
                ln_row(XB + (size_t)m * D, DN_ALPHA, YM + (size_t)(2 * m) * D, YM + (size_t)(2 * m + 1) * D, YP + (size_t)m * D, INP(36) + l * D, INP(37) + l * D,
                       lastl ? a.out + (size_t)m * D : (float*)nullptr, lastl ? nullptr : XB + (size_t)m * D, ln);
            }
            if (l != DEPTH - 1) SEAM();
        }
    }
#undef IN
#undef SEAM
}
static void mk_launch(const Args& base, int ph, int l, int grid, hipStream_t stream) {
    Args a = base; a.ph_lo = ph; a.ph_hi = ph + 1; a.l_lo = l; a.l_hi = l + 1; a.single = 1;
    hipLaunchKernelGGL(mk_fwd, dim3(grid), dim3(NWAVES * 64), LDS_BYTES, stream, a);
}
extern "C" void kernel_launch(void* const* d_in, const int* in_sizes, int n_in, void* d_out, int out_size, void* d_ws, size_t ws_size, hipStream_t stream) {
    (void)in_sizes; (void)n_in; (void)out_size; (void)ws_size;
    static int grid = 0;
    if (grid == 0) {
        int dev = 0, cus = 0;
        if (hipGetDevice(&dev) != hipSuccess || hipDeviceGetAttribute(&cus, hipDeviceAttributeMultiprocessorCount, dev) != hipSuccess) { grid = -1; return; }
        if (hipFuncSetAttribute((const void*)mk_fwd, hipFuncAttributeMaxDynamicSharedMemorySize, LDS_BYTES) != hipSuccess) { grid = -1; return; }
        (void)hipGetLastError();
        grid = cus;
    }
    if (grid < 0) return;
    (void)hipMemsetAsync((char*)d_ws + WS_CTL, 0, CTL_ZERO_BYTES, stream);
    Args base{};
    for (int i = 0; i < 38; ++i) base.in[i] = (const float*)d_in[i];
    base.out = (float*)d_out; base.ws = (unsigned char*)d_ws;
    base.eid = nullptr; base.wts = nullptr;
#if defined(MK_PER_PHASE)
    mk_launch(base, PH_PRO, 0, grid, stream);
    for (int l = 0; l < DEPTH; ++l) for (int ph : {PH_IN, PH_HY, PH_HYT, PH_ATT, PH_POOL, PH_OUT, PH_LN1, PH_WCV, PH_MOE1, PH_MOE2, PH_LN2}) mk_launch(base, ph, l, grid, stream);
#else
    Args a = base; a.ph_lo = 0; a.ph_hi = PH_END; a.l_lo = 0; a.l_hi = DEPTH; a.single = 0;
    hipLaunchKernelGGL(mk_fwd, dim3(grid), dim3(NWAVES * 64), LDS_BYTES, stream, a);
#endif
}
```

```cpp
#include <hip/hip_runtime.h>
#include <stdint.h>
#include <math.h>
namespace pg8 {
#define PG8_LAS __attribute__((address_space(3)))
typedef unsigned short bf16_t;
typedef short bf16x8 __attribute__((ext_vector_type(8)));
typedef float f32x4 __attribute__((ext_vector_type(4)));
typedef unsigned u32x4 __attribute__((ext_vector_type(4)));
constexpr int BM = 256, BK = 64, HALF = 128, HTB = HALF * BK * 2  , STAGE_BYTES = 8 * HTB;

__host__ __device__ __forceinline__ int lds_byte(int r, int c) { const int st = (r >> 4) * 2 + (c >> 5), rr = r & 15, cc = c & 31, ob = rr * 64 + cc * 2; return st * 1024 + (ob ^ (((ob >> 9) & 1) << 5)); }
__host__ __device__ __forceinline__ void stage_rc(int b, int& R, int& C) { const int st = b / 1024, sb = b % 1024, swz = sb ^ (((sb >> 9) & 1) << 5); R = (st >> 1) * 16 + swz / 64; C = (st & 1) * 32 + (swz % 64) / 2; }
__host__ __device__ __forceinline__ int perm32(int rho) { const int n = rho >> 4, i = rho & 15; return 8 * (i >> 2) + 4 * n + (i & 3); }

struct Unit { const char* A; const char* B; int kind, pm, pn, aux; };

__device__ __forceinline__ unsigned cvt_pk_bf16(float lo, float hi) { unsigned r; asm volatile("v_cvt_pk_bf16_f32 %0, %1, %2" : "=v"(r) : "v"(lo), "v"(hi)); return r; }

template <class Epi, class Sched, bool GATHER = false>
__device__ __forceinline__ void gemm_phase(PG8_LAS unsigned char* lds, const int K_, const Sched& S, const Epi& E, const int wave_) {
    int K = K_; asm volatile("" : "+s"(K));
    int tid_; asm volatile("v_mbcnt_lo_u32_b32 %0, -1, 0\n\tv_mbcnt_hi_u32_b32 %0, -1, %0" : "=v"(tid_)); tid_ += wave_ * 64;
    const int tid = tid_, wid = __builtin_amdgcn_readfirstlane(tid >> 6), lane = tid & 63, wr = wid >> 2, wc = wid & 3, fr = lane & 15, fq = lane >> 4;
    const int nt = K / BK;
    unsigned voffA[2][2], voffN[2][2] = {{0u, 0u}, {0u, 0u}}, voffB[2]; int RA[2], CA[2];
#pragma unroll
    for (int i = 0; i < 2; ++i) { int R, C; stage_rc(tid * 16 + i * 8192, R, C); const int Rb = Epi::PERM ? ((R & ~31) + perm32(R & 31)) : R; RA[i] = R; CA[i] = C;
        voffA[0][i] = (unsigned)(R * K + C) * 2u; voffA[1][i] = (unsigned)((R + HALF) * K + C) * 2u; voffB[i] = (unsigned)(Rb * K + C) * 2u; }
    const size_t kstep = (size_t)(BK * 2);
    const size_t hstep = (size_t)HALF * K * 2;
    const unsigned ldsw = (unsigned)wid * 1024u;
    const int aoff = lds_byte(wr * 64 + fr, fq * 8), boff = lds_byte(wc * 32 + fr, fq * 8);
#define PG8_SA(b, h) (((b) * 2 + (h)) * HTB)
#define PG8_SB(b, h) ((4 + (b) * 2 + (h)) * HTB)
#define PG8_STAGE(bufoff, gbase, voff) do { _Pragma("unroll") for (int _i = 0; _i < 2; ++_i) \
        __builtin_amdgcn_global_load_lds((const unsigned*)((const char*)(gbase) + (voff)[_i]), (PG8_LAS unsigned*)(lds + (bufoff) + ldsw + _i * 8192), 16, 0, 0); } while (0)
#define PG8_LDA(dst, b, h) do { _Pragma("unroll") for (int m = 0; m < 4; ++m) _Pragma("unroll") for (int k = 0; k < 2; ++k) dst[m][k] = *(const PG8_LAS bf16x8*)(lds + PG8_SA(b, h) + aoff + m * 2048 + k * 1024); } while (0)
#define PG8_LDB(dst, b, h) do { _Pragma("unroll") for (int n = 0; n < 2; ++n) _Pragma("unroll") for (int k = 0; k < 2; ++k) dst[n][k] = *(const PG8_LAS bf16x8*)(lds + PG8_SB(b, h) + boff + n * 2048 + k * 1024); } while (0)
#define PG8_MMA(ai, bj, At, Bt) do { __builtin_amdgcn_s_setprio(1); _Pragma("unroll") for (int m = 0; m < 4; ++m) _Pragma("unroll") for (int n = 0; n < 2; ++n) _Pragma("unroll") for (int k = 0; k < 2; ++k) \
        acc[ai][bj][m][n] = __builtin_amdgcn_mfma_f32_16x16x32_bf16(Bt[n][k], At[m][k], acc[ai][bj][m][n], 0, 0, 0); __builtin_amdgcn_s_setprio(0); } while (0)
#define PG8_WAIT_V(n) asm volatile("s_waitcnt vmcnt(" #n ")" ::: "memory")
#define PG8_WAIT_L(n) asm volatile("s_waitcnt lgkmcnt(" #n ")" ::: "memory")
#define PG8_BAR __builtin_amdgcn_s_barrier()
#define PG8_SCHED __builtin_amdgcn_sched_barrier(0)
    Unit cur, nxt; int ui = 0;
    if (!S.next(0, cur)) return;
    if constexpr (GATHER) {
#pragma unroll
        for (int h = 0; h < 2; ++h)
#pragma unroll
            for (int i = 0; i < 2; ++i) voffA[h][i] = (unsigned)(S.arow(cur, h * HALF + RA[i]) * K + CA[i]) * 2u;
    }
    f32x4 acc[2][2][4][2];
#pragma unroll
    for (int a = 0; a < 2; ++a)
#pragma unroll
        for (int b = 0; b < 2; ++b)
#pragma unroll
            for (int m = 0; m < 4; ++m)
#pragma unroll
                for (int n = 0; n < 2; ++n) acc[a][b][m][n] = (f32x4){0.f, 0.f, 0.f, 0.f};
    bf16x8 At[4][2], B0[2][2], B1[2][2];
    const char* cA = cur.A; const char* cB = cur.B;
    PG8_STAGE(PG8_SB(0, 0), cB, voffB); PG8_STAGE(PG8_SB(0, 1), cB + hstep, voffB); PG8_STAGE(PG8_SA(0, 0), cA, voffA[0]); PG8_STAGE(PG8_SA(0, 1), cA, voffA[1]);
    if (wr == 1) PG8_BAR;
    PG8_WAIT_V(2); PG8_BAR;
    PG8_STAGE(PG8_SB(1, 0), cB + kstep, voffB); PG8_STAGE(PG8_SA(1, 0), cA + kstep, voffA[0]); PG8_STAGE(PG8_SB(1, 1), cB + hstep + kstep, voffB);
    PG8_WAIT_V(6); PG8_BAR;
    for (;;) {
        const bool has_next = S.next(ui + 1, nxt);
        const char* nA = has_next ? nxt.A : cA; const char* nB = has_next ? nxt.B : cB;
        if constexpr (GATHER) {
#pragma unroll
            for (int h = 0; h < 2; ++h)
#pragma unroll
                for (int i = 0; i < 2; ++i) voffN[h][i] = has_next ? (unsigned)(S.arow(nxt, h * HALF + RA[i]) * K + CA[i]) * 2u : voffA[h][i];
        }
#pragma unroll 1
        for (int t = 0; t < nt; t += 2) {
            const bool last = (t == nt - 2);
            const char* a1 = cA + (size_t)(t + 1) * kstep;
            const char* a2 = last ? nA : cA + (size_t)(t + 2) * kstep; const char* b2 = last ? nB : cB + (size_t)(t + 2) * kstep;
            const char* a3 = a2 + kstep; const char* b3 = b2 + kstep;
            PG8_LDB(B0, 0, 0); PG8_LDB(B1, 0, 1); PG8_SCHED; PG8_LDA(At, 0, 0); PG8_STAGE(PG8_SA(1, 1), a1, voffA[1]);
            if constexpr (GATHER) { if (last) {
#pragma unroll
                for (int h = 0; h < 2; ++h)
#pragma unroll
                    for (int i = 0; i < 2; ++i) voffA[h][i] = voffN[h][i]; } }
            PG8_WAIT_V(8); PG8_WAIT_L(0); PG8_BAR; PG8_MMA(0, 0, At, B0); PG8_MMA(0, 1, At, B1); PG8_BAR; PG8_SCHED;
            PG8_LDA(At, 0, 1); PG8_STAGE(PG8_SB(0, 0), b2, voffB); PG8_STAGE(PG8_SB(0, 1), b2 + hstep, voffB); PG8_STAGE(PG8_SA(0, 0), a2, voffA[0]);
            PG8_WAIT_V(8); PG8_WAIT_L(0); PG8_BAR; PG8_MMA(1, 0, At, B0); PG8_MMA(1, 1, At, B1); PG8_BAR; PG8_SCHED;
            PG8_LDB(B0, 1, 0); PG8_LDB(B1, 1, 1); PG8_SCHED; PG8_LDA(At, 1, 0); PG8_STAGE(PG8_SA(0, 1), a2, voffA[1]);
            PG8_WAIT_V(8); PG8_WAIT_L(0); PG8_BAR; PG8_MMA(0, 0, At, B0); PG8_MMA(0, 1, At, B1); PG8_BAR; PG8_SCHED;
            PG8_LDA(At, 1, 1); PG8_STAGE(PG8_SB(1, 0), b3, voffB); PG8_STAGE(PG8_SB(1, 1), b3 + hstep, voffB); PG8_STAGE(PG8_SA(1, 0), a3, voffA[0]);
            PG8_WAIT_V(8); PG8_WAIT_L(0); PG8_BAR; PG8_MMA(1, 0, At, B0); PG8_MMA(1, 1, At, B1); PG8_BAR; PG8_SCHED;
        }
        if (wr == 0) PG8_BAR;
        { Unit ce = cur; ce.pm = __builtin_amdgcn_readfirstlane(cur.pm); ce.pn = __builtin_amdgcn_readfirstlane(cur.pn); ce.kind = __builtin_amdgcn_readfirstlane(cur.kind); ce.aux = __builtin_amdgcn_readfirstlane(cur.aux); int fr_ = fr, fq_ = fq;
          asm volatile("" : "+s"(ce.pm), "+s"(ce.pn), "+s"(ce.kind), "+s"(ce.aux), "+v"(fr_), "+v"(fq_));
          E(acc, ce, wr, wc, fr_, fq_); }
        if (!has_next) break;
#pragma unroll
        for (int a = 0; a < 2; ++a)
#pragma unroll
            for (int b = 0; b < 2; ++b)
#pragma unroll
                for (int m = 0; m < 4; ++m)
#pragma unroll
                    for (int n = 0; n < 2; ++n) acc[a][b][m][n] = (f32x4){0.f, 0.f, 0.f, 0.f};
        cur = nxt; cA = nA; cB = nB; ++ui;
        if (wr == 1) PG8_BAR;
    }
    PG8_WAIT_V(0);
    PG8_BAR;
#undef PG8_SA
#undef PG8_SB
#undef PG8_STAGE
#undef PG8_LDA
#undef PG8_LDB
#undef PG8_MMA
#undef PG8_WAIT_V
#undef PG8_WAIT_L
#undef PG8_BAR
#undef PG8_SCHED
}
}
constexpr int D = 1024, NB = 4, S = 4096, M = NB * S, DEPTH = 4, INW = 2560;
constexpr float DN_ALPHA = 1.681792830507429f;
constexpr float QSCALE = 0.125f * 1.4426950408889634f;
constexpr int NWAVES = 8;
constexpr size_t MiB = 1u << 20;
constexpr size_t TILEB = (size_t)256 * D * 2;
constexpr size_t WS_CTL = 0, CTL_ZERO_BYTES = 1 * MiB;
constexpr size_t WS_CS = 1 * MiB;
constexpr size_t WS_WIN = 2 * MiB, WIN_LAYER = 5 * MiB;
constexpr size_t WS_XB = 22 * MiB;
constexpr size_t WS_QKP = 118 * MiB;
constexpr size_t WS_UVT = 158 * MiB;
constexpr size_t WS_MIXB = 198 * MiB;
constexpr size_t WS_STASH = 54 * MiB;
constexpr size_t WS_WOUT = 383 * MiB, WOUT_LAYER = 2 * MiB;
constexpr size_t WS_TOKIDX = 391 * MiB, WS_GATE = 392 * MiB;
constexpr size_t WS_YMOE = WS_QKP;
constexpr size_t WS_YP = 86 * MiB;
constexpr size_t WS_ACT = 230 * MiB;
constexpr size_t WS_WBUF = 288 * MiB, WBUF_STRIDE = 35 * MiB, WB_W13 = 0, WB_W2 = 16 * MiB, WB_WG = 24 * MiB, WB_WP = 26 * MiB, WB_PB = 27 * MiB;
constexpr size_t WS_KF = 262 * MiB, WS_PS = 278 * MiB, WS_HT = 280 * MiB;
constexpr size_t WS_WR = 256 * MiB;
constexpr int CW_BAR = 4096, CW_CNT = 8192, CNT_STRIDE = 64;

#define GAS __attribute__((address_space(1)))
#define LAS __attribute__((address_space(3)))
typedef unsigned short bf16;
typedef unsigned v4u __attribute__((ext_vector_type(4)));
typedef float f32x4 __attribute__((ext_vector_type(4)));
typedef short bf16x8 __attribute__((ext_vector_type(8)));
typedef GAS unsigned gu32;
typedef GAS unsigned long long gu64;
#define RLX_AGENT __ATOMIC_RELAXED, __HIP_MEMORY_SCOPE_AGENT
#define LDS_WAIT() asm volatile("s_waitcnt lgkmcnt(0)" ::: "memory")
#define VM_WAIT() asm volatile("s_waitcnt vmcnt(0)" ::: "memory")
__device__ __forceinline__ unsigned long long rt() { return __builtin_amdgcn_s_memrealtime(); }
__device__ __forceinline__ unsigned f2bf(float f) { unsigned u = __builtin_bit_cast(unsigned, f); return (u + 0x7fffu + ((u >> 16) & 1u)) >> 16; }
__device__ __forceinline__ unsigned pk2(float lo, float hi) { return f2bf(lo) | (f2bf(hi) << 16); }

#define XB_TMO      128
#define XB_XCNT(j)  (256  + 64 * (j))
#define XB_XSUB(j)  (1280 + 64 * (j))
#define XB_XGEN(j)  (2304 + 64 * (j))
#define XB_TOP      3328
#define XB_TOPGEN   3392
#define XCD_BAR_WORDS 3456
#define XB_SPIN_CAP (1u << 18)

__device__ __forceinline__ unsigned xb_ld(unsigned* p)              { return __hip_atomic_load(p, __ATOMIC_RELAXED, __HIP_MEMORY_SCOPE_AGENT); }
__device__ __forceinline__ unsigned xb_add(unsigned* p, unsigned v) { return __hip_atomic_fetch_add(p, v, __ATOMIC_RELAXED, __HIP_MEMORY_SCOPE_AGENT); }
__device__ __forceinline__ unsigned xb_xcc_id() { return (unsigned)__builtin_amdgcn_s_getreg((3 << 11) | 20) & 0xFu; }
#define XB_SPIN(cond, bar) do { unsigned _sp = 0; while (cond) { __builtin_amdgcn_s_sleep(1); \
    if ((++_sp & 255u) == 0u) { if (xb_ld(&(bar)[XB_TMO])) break; if (_sp > XB_SPIN_CAP) { atomicAdd(&(bar)[XB_TMO], 1u); break; } } } } while (0)

struct XcdBarrier {
    unsigned* bar; unsigned x;
    volatile LAS unsigned* st;
};

__device__ __forceinline__ unsigned mk_lane_id() { unsigned x; asm volatile("v_mbcnt_lo_u32_b32 %0, -1, 0\n\tv_mbcnt_hi_u32_b32 %0, -1, %0" : "=v"(x)); return x; }
__device__ __forceinline__ XcdBarrier xcd_barrier_post(unsigned* bar, volatile LAS unsigned* st, int wave) {
    XcdBarrier b; b.bar = bar; b.x = xb_xcc_id(); b.st = st;
    if (wave == 0 && mk_lane_id() == 0u) (void)xb_add(&bar[XB_XCNT(b.x)], 1u);
    return b;
}
__device__ __forceinline__ void xcd_barrier_complete(unsigned* bar, unsigned x, unsigned& nloc, unsigned& nx) {
    const unsigned G = gridDim.x * gridDim.y * gridDim.z;
    unsigned sum, cnt, mine, sp = 0u;
    for (;;) {
        sum = 0u; cnt = 0u; mine = 0u;
#pragma unroll
        for (unsigned j = 0; j < 16; ++j) { const unsigned c = xb_ld(&bar[XB_XCNT(j)]); sum += c; cnt += (c > 0u) ? 1u : 0u; mine = (j == x) ? c : mine; }
        if (sum == G) break;
        __builtin_amdgcn_s_sleep(1);
        if ((++sp & 255u) == 0u) { if (xb_ld(&bar[XB_TMO])) break; if (sp > XB_SPIN_CAP) { atomicAdd(&bar[XB_TMO], 1u); break; } }
    }
    nloc = mine > 0u ? mine : 1u; nx = cnt > 0u ? cnt : 1u;
}

__device__ __forceinline__ void xcd_barrier(const XcdBarrier& b, int wave) {
    asm volatile("" : "+s"(wave));
    const bool t0_ = (wave == 0) && (mk_lane_id() == 0u);
    asm volatile("s_waitcnt vmcnt(0)" ::: "memory");
    __syncthreads();
    if (t0_) {
        unsigned* bar = b.bar; unsigned bx_ = b.x; asm volatile("" : "+s"(bx_));
        __builtin_amdgcn_s_waitcnt(0);
        unsigned nloc = b.st[0], nx = b.st[1];
        if (nloc == 0u) { xcd_barrier_complete(bar, bx_, nloc, nx); b.st[0] = nloc; b.st[1] = nx; }
        const unsigned old = xb_add(&bar[XB_XSUB(bx_)], 1u);
        const unsigned gen = old / nloc;
        if (old + 1u == (gen + 1u) * nloc) {
            __builtin_amdgcn_fence(__ATOMIC_RELEASE, "agent");
            asm volatile("s_waitcnt vmcnt(0)" ::: "memory");
            const unsigned og = xb_add(&bar[XB_TOP], 1u);
            const unsigned tg = og / nx;
            if (og + 1u == (tg + 1u) * nx) xb_add(&bar[XB_TOPGEN], 1u);
            else XB_SPIN(xb_ld(&bar[XB_TOPGEN]) == tg, bar);
            __builtin_amdgcn_fence(__ATOMIC_ACQUIRE, "agent");
            xb_add(&bar[XB_XGEN(bx_)], 1u);
            asm volatile("s_waitcnt vmcnt(0)" ::: "memory");
        } else {
            XB_SPIN(xb_ld(&bar[XB_XGEN(bx_)]) == gen, bar);
            __builtin_amdgcn_fence(__ATOMIC_ACQUIRE, "agent");
            asm volatile("s_waitcnt vmcnt(0)" ::: "memory");
        }
    }
    __syncthreads();
}
__device__ __forceinline__ float bf2f(unsigned short b) { return __uint_as_float((unsigned)b << 16); }
#define MK_DPP(v, ctrl) __uint_as_float(__builtin_amdgcn_update_dpp(0, __float_as_uint(v), (ctrl), 0xF, 0xF, true))
__device__ __forceinline__ float xsum16(float v) { const auto r = __builtin_amdgcn_permlane16_swap(__float_as_uint(v), __float_as_uint(v), false, false); return __uint_as_float(r[0]) + __uint_as_float(r[1]); }
__device__ __forceinline__ float xsum32(float v) { const auto r = __builtin_amdgcn_permlane32_swap(__float_as_uint(v), __float_as_uint(v), false, false); return __uint_as_float(r[0]) + __uint_as_float(r[1]); }
__device__ __forceinline__ float wave_sum(float v) {
    v += MK_DPP(v, 0xB1); v += MK_DPP(v, 0x4E);
    v += MK_DPP(v, 0x141); v += MK_DPP(v, 0x140);
    return xsum32(xsum16(v));
}
__device__ __forceinline__ void p0_transpose_block(const float* W, int K, int N, int k0, int n0, bf16* WT, int mode, LAS float* scr, int lane) {
#pragma unroll 4
    for (int i = 0; i < 32; ++i) { const int kk = 2 * i + (lane >> 5); scr[kk * 33 + (lane & 31)] = W[(size_t)(k0 + kk) * N + n0 + (lane & 31)]; }
    LDS_WAIT(); asm volatile("" ::: "memory");
    const int c = lane & 7;
#pragma unroll 1
    for (int j = 0; j < 4; ++j) { const int n = (lane >> 3) + 8 * j; const LAS float* s = scr + (8 * c) * 33 + n;
        v4u o; o.x = pk2(s[0 * 33], s[1 * 33]); o.y = pk2(s[2 * 33], s[3 * 33]); o.z = pk2(s[4 * 33], s[5 * 33]); o.w = pk2(s[6 * 33], s[7 * 33]);
        const int f = n0 + n; const size_t drow = mode == 0 ? (size_t)n : (size_t)(8 * (f >> 2) + (f & 3) + (mode == 2 ? 4 : 0));
        *(GAS v4u*)(WT + drow * K + k0 + 8 * c) = o; }
    LDS_WAIT(); asm volatile("" ::: "memory");
}
template <class TX> __device__ __forceinline__ void ln_row(const TX* x0, float a, const bf16* y1, const bf16* y2, const bf16* y3, const float* g, const float* b, float* of, bf16* ob, int lane) {
    f32x4 v[4]; float s = 0.f;
#pragma unroll
    for (int j = 0; j < 4; ++j) { const int c = 4 * lane + 256 * j;
        if constexpr (sizeof(TX) == 4) v[j] = *(const GAS f32x4*)(x0 + c) * a;
        else { const unsigned long long w = *(const GAS unsigned long long*)(x0 + c); v[j] = (f32x4){bf2f((bf16)w), bf2f((bf16)(w >> 16)), bf2f((bf16)(w >> 32)), bf2f((bf16)(w >> 48))} * a; }
        if (y1) { const unsigned long long w = *(const GAS unsigned long long*)(y1 + c); v[j] += (f32x4){bf2f((bf16)w), bf2f((bf16)(w >> 16)), bf2f((bf16)(w >> 32)), bf2f((bf16)(w >> 48))}; }
        if (y2) { const unsigned long long w = *(const GAS unsigned long long*)(y2 + c); v[j] += (f32x4){bf2f((bf16)w), bf2f((bf16)(w >> 16)), bf2f((bf16)(w >> 32)), bf2f((bf16)(w >> 48))}; }
        if (y3) { const unsigned long long w = *(const GAS unsigned long long*)(y3 + c); v[j] += (f32x4){bf2f((bf16)w), bf2f((bf16)(w >> 16)), bf2f((bf16)(w >> 32)), bf2f((bf16)(w >> 48))}; }
        s += (v[j].x + v[j].y) + (v[j].z + v[j].w); }
    const float mean = wave_sum(s) * (1.f / D); float s2 = 0.f;
#pragma unroll
    for (int j = 0; j < 4; ++j) { v[j] = v[j] - mean; s2 += (v[j].x * v[j].x + v[j].y * v[j].y) + (v[j].z * v[j].z + v[j].w * v[j].w); }
    const float rstd = __builtin_amdgcn_rsqf(wave_sum(s2) * (1.f / D) + 1e-5f);
#pragma unroll
    for (int j = 0; j < 4; ++j) { const int c = 4 * lane + 256 * j; const f32x4 o = v[j] * rstd * *(const GAS f32x4*)(g + c) + *(const GAS f32x4*)(b + c);
        if (of) *(GAS f32x4*)(of + c) = o;
        if (ob) *(GAS unsigned long long*)(ob + c) = (unsigned long long)pk2(o.x, o.y) | ((unsigned long long)pk2(o.z, o.w) << 32); }
}

struct SchedIn {
    int vcu, G; const char* xb; const char* wsw; const char* wnm;
    __device__ __forceinline__ bool next(int i, pg8::Unit& u) const {
        const int L = i * G + vcu; if (L >= 640) return false;
        const int t = L / 10, j = L % 10;
        const int sw = __builtin_amdgcn_readfirstlane((unsigned)(j + 27) >> 5);
        const int jj = j - 5 * sw; const char* tp = xb + (size_t)t * TILEB; const char* wp = (sw ? wsw : wnm) + (size_t)jj * TILEB;
        u.kind = sw; u.pm = sw ? jj : t; u.pn = sw ? t : jj; u.A = sw ? wp : tp; u.B = sw ? tp : wp;
        u.aux = 0; return true;
    }
};
struct EpiIn {
    static constexpr bool PERM = true;
    bf16* qkp; bf16* uvt; const float* cs;
    __device__ __forceinline__ void operator()(const pg8::f32x4 (&acc)[2][2][4][2], const pg8::Unit& u, int wr, int wc, int fr, int fq) const {
        bf16* base = u.kind == 0 ? qkp : uvt; const int ldc = u.kind == 0 ? 1280 : M;
        const int row0 = u.pm * 256 + wr * 64 + fr, col0 = u.pn * 256 + wc * 32 + 8 * fq;
        const bool rope = (u.kind == 0) && (u.pn < 4) && ((wc & 1) == 0);
        const float sc = (u.kind == 0 && u.pn < 2) ? QSCALE : 1.f;
        const float sgn = fq == 0 ? -1.f : 1.f;
        const bool vperm = (u.kind == 1) && (u.pm >= 3);
#pragma unroll
        for (int ai = 0; ai < 2; ++ai)
#pragma unroll
            for (int m = 0; m < 4; ++m) { const int row = row0 + ai * 128 + m * 16; bf16* rowp = base + (size_t)row * ldc + col0;
                f32x4 cv0 = {1.f, 1.f, 1.f, 1.f}, cv1 = cv0, sv0 = {0.f, 0.f, 0.f, 0.f}, sv1 = sv0;
                if (rope && fq < 2) { const float* t = cs + (size_t)(row & (S - 1)) * 16; cv0 = *(const f32x4*)t; cv1 = *(const f32x4*)(t + 4); sv0 = *(const f32x4*)(t + 8) * sgn; sv1 = *(const f32x4*)(t + 12) * sgn; }
#pragma unroll
                for (int bj = 0; bj < 2; ++bj) { f32x4 v0 = acc[ai][bj][m][0], v1 = acc[ai][bj][m][1];
                    if (rope) { f32x4 p0, p1;
#pragma unroll
                        for (int e = 0; e < 4; ++e) { const auto r0 = __builtin_amdgcn_permlane16_swap(__float_as_uint(v0[e]), __float_as_uint(v0[e]), false, false), r1 = __builtin_amdgcn_permlane16_swap(__float_as_uint(v1[e]), __float_as_uint(v1[e]), false, false);
                            p0[e] = __uint_as_float((fq & 1) ? r0[0] : r0[1]); p1[e] = __uint_as_float((fq & 1) ? r1[0] : r1[1]); }
                        v0 = v0 * cv0 + p0 * sv0; v1 = v1 * cv1 + p1 * sv1; }
                    v0 = v0 * sc; v1 = v1 * sc;
                    pg8::u32x4 w; w.x = pg8::cvt_pk_bf16(v0[0], v0[1]); w.y = pg8::cvt_pk_bf16(v0[2], v0[3]); w.z = pg8::cvt_pk_bf16(v1[0], v1[1]); w.w = pg8::cvt_pk_bf16(v1[2], v1[3]);
                    if (vperm) {
                        bf16* gp = rowp + bj * 128 - (fq & 1) * 8;
                        typedef unsigned u32x2 __attribute__((ext_vector_type(2)));
                        *(u32x2*)(gp + ((fq & 1) ? 4 : 0)) = (u32x2){w.x, w.y}; *(u32x2*)(gp + ((fq & 1) ? 12 : 8)) = (u32x2){w.z, w.w};
                    } else *(pg8::u32x4*)(rowp + bj * 128) = w; } }
    }
};

struct SchedOut {
    int vcu, G; const char* a; const char* w;
    __device__ __forceinline__ bool next(int i, pg8::Unit& u) const {
        const int L = i * G + vcu; if (L >= 256) return false;
        u.kind = 0; u.pm = L >> 2; u.pn = L & 3; u.aux = 0; u.A = a + (size_t)u.pm * TILEB; u.B = w + (size_t)u.pn * TILEB; return true;
    }
};
struct EpiRes {
    static constexpr bool PERM = true;
    bf16* XB;
    __device__ __forceinline__ void operator()(const pg8::f32x4 (&acc)[2][2][4][2], const pg8::Unit& u, int wr, int wc, int fr, int fq) const {
        const int row0 = u.pm * 256 + wr * 64 + fr, col0 = u.pn * 256 + wc * 32 + 8 * fq;
#pragma unroll
        for (int ai = 0; ai < 2; ++ai)
#pragma unroll
            for (int m = 0; m < 4; ++m) { bf16* rowp = XB + (size_t)(row0 + ai * 128 + m * 16) * D + col0;
#pragma unroll
                for (int bj = 0; bj < 2; ++bj) { pg8::u32x4* p = (pg8::u32x4*)(rowp + bj * 128); const pg8::u32x4 x = *p; const pg8::f32x4 v0 = acc[ai][bj][m][0], v1 = acc[ai][bj][m][1];
                    pg8::u32x4 w; w.x = pg8::cvt_pk_bf16(bf2f((bf16)x.x) * DN_ALPHA + v0[0], bf2f((bf16)(x.x >> 16)) * DN_ALPHA + v0[1]); w.y = pg8::cvt_pk_bf16(bf2f((bf16)x.y) * DN_ALPHA + v0[2], bf2f((bf16)(x.y >> 16)) * DN_ALPHA + v0[3]);
                    w.z = pg8::cvt_pk_bf16(bf2f((bf16)x.z) * DN_ALPHA + v1[0], bf2f((bf16)(x.z >> 16)) * DN_ALPHA + v1[1]); w.w = pg8::cvt_pk_bf16(bf2f((bf16)x.w) * DN_ALPHA + v1[2], bf2f((bf16)(x.w >> 16)) * DN_ALPHA + v1[3]);
                    *p = w; } }
    }
};
struct RouteLds { unsigned lcnt[16]; unsigned gbase[16]; int e0[64], e1[64]; unsigned r0[64], r1[64]; float g0[64], g1[64]; };
constexpr int RT_PITCH = 2064;
template <int DRY = 0> __device__ __forceinline__ void ln1_router_chunk(LAS RouteLds* R, LAS unsigned char* tile, int row0, bf16* XB, bf16* XOUT, const float* g, const float* b, const bf16* wrt, const float* bgc, const float* bgf,
                                                 gu32* cnt, int* tokidx, float* gate, int wave, int lane) {
    const int tidl = wave * 64 + lane;
    if (tidl < 16) R->lcnt[tidl] = 0u;
#pragma unroll 2
    for (int r = 0; r < 8; ++r) { const int rl = wave * 8 + r; bf16* xbrow = XB + (size_t)(row0 + rl) * D; f32x4 v[4]; float s = 0.f;
#pragma unroll
        for (int j = 0; j < 4; ++j) { const unsigned long long w = *(const GAS unsigned long long*)(xbrow + 4 * lane + 256 * j);
            v[j] = (f32x4){bf2f((bf16)w), bf2f((bf16)(w >> 16)), bf2f((bf16)(w >> 32)), bf2f((bf16)(w >> 48))}; s += (v[j].x + v[j].y) + (v[j].z + v[j].w); }
        const float mean = wave_sum(s) * (1.f / D); float s2 = 0.f;
#pragma unroll
        for (int j = 0; j < 4; ++j) { v[j] = v[j] - mean; s2 += (v[j].x * v[j].x + v[j].y * v[j].y) + (v[j].z * v[j].z + v[j].w * v[j].w); }
        const float rstd = __builtin_amdgcn_rsqf(wave_sum(s2) * (1.f / D) + 1e-5f);
#pragma unroll
        for (int j = 0; j < 4; ++j) { const int c = 4 * lane + 256 * j; const f32x4 o = v[j] * rstd * *(const GAS f32x4*)(g + c) + *(const GAS f32x4*)(b + c);
            const unsigned w0 = pk2(o.x, o.y), w1 = pk2(o.z, o.w);
            *(GAS unsigned long long*)(XOUT + (size_t)(row0 + rl) * D + c) = (unsigned long long)w0 | ((unsigned long long)w1 << 32);
            LAS unsigned* tp = (LAS unsigned*)(tile + rl * RT_PITCH + c * 2); tp[0] = w0; tp[1] = w1; } }
    LDS_WAIT(); __syncthreads();
    if (DRY == 1) return;
    typedef float f32x16_t __attribute__((ext_vector_type(16)));
    f32x16_t pacc;
#pragma unroll
    for (int r = 0; r < 16; ++r) pacc[r] = 0.f;
    { const int rt = wave & 1, kq = wave >> 1, r32 = lane & 31, hi = lane >> 5;
      LAS const unsigned char* ap = tile + (32 * rt + r32) * RT_PITCH + (256 * kq + 8 * hi) * 2;
      const bf16* bh = wrt + (size_t)r32 * D + 256 * kq + 8 * hi; const bf16* bl = bh + 32 * D;
#pragma unroll 4
      for (int ks = 0; ks < 16; ++ks) { const bf16x8 af = *(LAS const bf16x8*)(ap + ks * 32), bhf = *(const GAS bf16x8*)(bh + ks * 16), blf = *(const GAS bf16x8*)(bl + ks * 16);
          pacc = __builtin_amdgcn_mfma_f32_32x32x16_bf16(af, bhf, pacc, 0, 0, 0); pacc = __builtin_amdgcn_mfma_f32_32x32x16_bf16(af, blf, pacc, 0, 0, 0); } }
    LDS_WAIT(); __syncthreads();
    if (DRY == 2) return;
    { const int rt = wave & 1, kq = wave >> 1, r32 = lane & 31, hi = lane >> 5;
      LAS float* P = (LAS float*)tile + (kq * 64 + rt * 32) * 33 + r32;
#pragma unroll
      for (int r = 0; r < 16; ++r) P[((r & 3) + 8 * (r >> 2) + 4 * hi) * 33] = pacc[r]; }
    LDS_WAIT(); __syncthreads();
    if (wave == 0) {
        float my[20];
#pragma unroll
        for (int i = 0; i < 20; ++i) { float t = 0.f;
#pragma unroll
            for (int q = 0; q < 4; ++q) t += ((LAS const float*)tile)[(q * 64 + lane) * 33 + i];
            my[i] = t; }
        const int rl = lane;
        float pg[4], mx = -INFINITY, sum = 0.f;
#pragma unroll
        for (int j = 0; j < 4; ++j) { pg[j] = my[j] + bgc[j]; mx = fmaxf(mx, pg[j]); }
#pragma unroll
        for (int j = 0; j < 4; ++j) { pg[j] = expf(pg[j] - mx); sum += pg[j]; }
        int gi = 0; float gw = pg[0];
#pragma unroll
        for (int j = 1; j < 4; ++j) if (pg[j] > gw) { gw = pg[j]; gi = j; }
        gw /= sum;
        float fs[4]; mx = -INFINITY;
#pragma unroll
        for (int j = 0; j < 4; ++j) { float t = 0.f;
#pragma unroll
            for (int q = 0; q < 4; ++q) if (q == gi) t = my[4 + q * 4 + j] + bgf[q * 4 + j];
            fs[j] = t; mx = fmaxf(mx, t); }
#pragma unroll
        for (int j = 0; j < 4; ++j) fs[j] = expf(fs[j] - mx);
        int t0 = 0; float v0 = fs[0];
#pragma unroll
        for (int j = 1; j < 4; ++j) if (fs[j] > v0) { v0 = fs[j]; t0 = j; }
        int t1 = -1; float v1 = -1.f;
#pragma unroll
        for (int j = 0; j < 4; ++j) if (j != t0 && fs[j] > v1) { v1 = fs[j]; t1 = j; }
        const float ts = v0 + v1; const int e0 = gi * 4 + t0, e1 = gi * 4 + t1;
        R->e0[rl] = e0; R->e1[rl] = e1; R->g0[rl] = gw * (v0 / ts); R->g1[rl] = gw * (v1 / ts);
        R->r0[rl] = __hip_atomic_fetch_add(&R->lcnt[e0], 1u, __ATOMIC_RELAXED, __HIP_MEMORY_SCOPE_WORKGROUP);
        R->r1[rl] = __hip_atomic_fetch_add(&R->lcnt[e1], 1u, __ATOMIC_RELAXED, __HIP_MEMORY_SCOPE_WORKGROUP);
    }
    LDS_WAIT(); __syncthreads();
    if (DRY == 3) return;
    if (tidl < 16) { const unsigned n = R->lcnt[tidl]; R->gbase[tidl] = n ? __hip_atomic_fetch_add(cnt + tidl * CNT_STRIDE, n, RLX_AGENT) : 0u; }
    LDS_WAIT(); __syncthreads();
    if (tidl < 64) { const int rl = tidl, tok = row0 + rl; const int e0 = R->e0[rl], e1 = R->e1[rl]; const unsigned p0 = R->gbase[e0] + R->r0[rl], p1 = R->gbase[e1] + R->r1[rl];
        tokidx[(size_t)e0 * M + p0] = tok * 2; gate[(size_t)e0 * M + p0] = R->g0[rl]; tokidx[(size_t)e1 * M + p1] = tok * 2 + 1; gate[(size_t)e1 * M + p1] = R->g1[rl]; }
    LDS_WAIT(); __syncthreads();
}

struct MoeTab { LAS const int* p;
    __device__ __forceinline__ int cnt(int e) const { return __builtin_amdgcn_readfirstlane(p[e]); }
    __device__ __forceinline__ int pre(int e) const { return __builtin_amdgcn_readfirstlane(p[16 + e]); } };
__device__ __forceinline__ void moe_tab_build(LAS int* p, const gu32* cnt, bool t0) {
    if (t0) { int acc = 0;
        for (int e = 0; e < 16; ++e) { const int c = (int)__hip_atomic_load(cnt + e * CNT_STRIDE, RLX_AGENT); p[e] = c; p[16 + e] = acc; acc += (c + 255) >> 8; }
        p[32] = acc; }
    __syncthreads();
}
template <int NPN> struct SchedMoe {
    int vcu, G; MoeTab T; const char* a; const char* w; size_t wexp  ; const int* tokidx; size_t atile  ;
    __device__ __forceinline__ bool next(int i, pg8::Unit& u) const {
        const int L = i * G + vcu; if (L >= T.pre(16) * NPN) return false;
        const int tile = L / NPN; u.pn = L % NPN; int e = 0;
#pragma unroll
        for (int st = 8; st >= 1; st >>= 1) if (tile >= T.pre(e + st)) e += st;
        u.aux = e; u.pm = tile - T.pre(e); u.kind = tile;
        u.A = a + (size_t)tile * atile; u.B = w + (size_t)e * wexp + (size_t)u.pn * 256 * (wexp / (NPN * 256)); return true;
    }
    __device__ __forceinline__ int arow(const pg8::Unit& u, int r) const {
        const int rank = u.pm * 256 + r; const int c = T.cnt(u.aux);
        return rank < c ? (tokidx[(size_t)u.aux * M + rank] >> 1) : 0;
    }
};
struct EpiMoe1 {
    static constexpr bool PERM = true;
    bf16* act; const float* gate; MoeTab T;
    __device__ __forceinline__ void operator()(const pg8::f32x4 (&acc)[2][2][4][2], const pg8::Unit& u, int wr, int wc, int fr, int fq) const {
        const int cnt = T.cnt(u.aux);
#pragma unroll
        for (int ai = 0; ai < 2; ++ai)
#pragma unroll
            for (int m = 0; m < 4; ++m) { const int r = ai * 128 + wr * 64 + m * 16 + fr, rank = u.pm * 256 + r;
                const float gt = rank < cnt ? gate[(size_t)u.aux * M + rank] : 0.f;
                bf16* rowp = act + ((size_t)u.kind * 256 + r) * 256 + u.pn * 128 + wc * 16 + 4 * fq;
#pragma unroll
                for (int bj = 0; bj < 2; ++bj) { const pg8::f32x4 av = acc[ai][bj][m][0], cv = acc[ai][bj][m][1]; float y[4];
#pragma unroll
                    for (int e = 0; e < 4; ++e) y[e] = av[e] * __builtin_amdgcn_rcpf(1.f + __builtin_amdgcn_exp2f(av[e] * -1.4426950408889634f)) * cv[e] * gt;
                    *(unsigned long long*)(rowp + bj * 64) = (unsigned long long)pg8::cvt_pk_bf16(y[0], y[1]) | ((unsigned long long)pg8::cvt_pk_bf16(y[2], y[3]) << 32); } }
    }
};
struct EpiMoe2 {
    static constexpr bool PERM = true;
    bf16* ymoe; const int* tokidx; MoeTab T;
    __device__ __forceinline__ void operator()(const pg8::f32x4 (&acc)[2][2][4][2], const pg8::Unit& u, int wr, int wc, int fr, int fq) const {
        const int cnt = T.cnt(u.aux);
#pragma unroll
        for (int ai = 0; ai < 2; ++ai)
#pragma unroll
            for (int m = 0; m < 4; ++m) { const int r = ai * 128 + wr * 64 + m * 16 + fr, rank = u.pm * 256 + r;
                if (rank < cnt) { bf16* rowp = ymoe + (size_t)tokidx[(size_t)u.aux * M + rank] * D + u.pn * 256 + wc * 32 + 8 * fq;
#pragma unroll
                    for (int bj = 0; bj < 2; ++bj) { const pg8::f32x4 v0 = acc[ai][bj][m][0], v1 = acc[ai][bj][m][1];
                        pg8::u32x4 w; w.x = pg8::cvt_pk_bf16(v0[0], v0[1]); w.y = pg8::cvt_pk_bf16(v0[2], v0[3]); w.z = pg8::cvt_pk_bf16(v1[0], v1[1]); w.w = pg8::cvt_pk_bf16(v1[2], v1[3]);
                        *(pg8::u32x4*)(rowp + bj * 128) = w; } } }
    }
};
struct SchedSq {
    int vcu, G; const char* a; const char* w; size_t astep, wstep; int vfirst;
    __device__ __forceinline__ bool next(int i, pg8::Unit& u) const {
        if (vcu < vfirst || vcu >= vfirst + G) return false;
        const int L = i * G + (vcu - vfirst); if (L >= 256) return false;
        u.kind = 0; u.pm = L >> 2; u.pn = L & 3; u.aux = 0; u.A = a + (size_t)u.pm * astep; u.B = w + (size_t)u.pn * wstep; return true;
    }
};
template <int GATED> struct EpiPle {
    static constexpr bool PERM = true;
    bf16* yp; const float* bg;
    __device__ __forceinline__ void operator()(const pg8::f32x4 (&acc)[2][2][4][2], const pg8::Unit& u, int wr, int wc, int fr, int fq) const {
        const int row0 = u.pm * 256 + wr * 64 + fr, col0 = u.pn * 256 + wc * 32 + 8 * fq;
#pragma unroll
        for (int ai = 0; ai < 2; ++ai)
#pragma unroll
            for (int m = 0; m < 4; ++m) { bf16* rowp = yp + (size_t)(row0 + ai * 128 + m * 16) * D + col0;
#pragma unroll
                for (int bj = 0; bj < 2; ++bj) { pg8::f32x4 v0 = acc[ai][bj][m][0], v1 = acc[ai][bj][m][1];
                    if (GATED) { const pg8::f32x4 b0 = *(const pg8::f32x4*)(bg + col0 + bj * 128), b1 = *(const pg8::f32x4*)(bg + col0 + bj * 128 + 4); const pg8::u32x4 y = *(const pg8::u32x4*)(rowp + bj * 128);
                        const float yf[8] = {bf2f((bf16)y.x), bf2f((bf16)(y.x >> 16)), bf2f((bf16)y.y), bf2f((bf16)(y.y >> 16)), bf2f((bf16)y.z), bf2f((bf16)(y.z >> 16)), bf2f((bf16)y.w), bf2f((bf16)(y.w >> 16))};
#pragma unroll
                        for (int e = 0; e < 4; ++e) { v0[e] = yf[e] * __builtin_amdgcn_rcpf(1.f + __builtin_amdgcn_exp2f((v0[e] + b0[e]) * -1.4426950408889634f)); v1[e] = yf[4 + e] * __builtin_amdgcn_rcpf(1.f + __builtin_amdgcn_exp2f((v1[e] + b1[e]) * -1.4426950408889634f)); } }
                    pg8::u32x4 w; w.x = pg8::cvt_pk_bf16(v0[0], v0[1]); w.y = pg8::cvt_pk_bf16(v0[2], v0[3]); w.z = pg8::cvt_pk_bf16(v1[0], v1[1]); w.w = pg8::cvt_pk_bf16(v1[2], v1[3]);
                    *(pg8::u32x4*)(rowp + bj * 128) = w; } }
    }
};
namespace att {
typedef float f32x16 __attribute__((ext_vector_type(16)));
constexpr int KSLOT = 8192, VSLOT = 16384, LDS_K = 0, LDS_V = 2 * KSLOT, ATT_LDS = 2 * KSLOT + 2 * VSLOT;
__device__ __forceinline__ bf16x8 pack8(const f32x16& p, int b) {
    v4u w; w.x = pg8::cvt_pk_bf16(p[b], p[b + 1]); w.y = pg8::cvt_pk_bf16(p[b + 2], p[b + 3]); w.z = pg8::cvt_pk_bf16(p[b + 4], p[b + 5]); w.w = pg8::cvt_pk_bf16(p[b + 6], p[b + 7]);
    return __builtin_bit_cast(bf16x8, w);
}
constexpr float THR2 = 8.f;
__device__ __forceinline__ void qkt(f32x16& p0, f32x16& p1, LAS const unsigned char* ks, const bf16x8 (&qf)[4], int r32, int hi) {
#pragma unroll
    for (int r = 0; r < 16; ++r) { p0[r] = 0.f; p1[r] = 0.f; }
    LAS const unsigned char* kb = ks + hi * 1024 + r32 * 16;
#pragma unroll
    for (int kk = 0; kk < 4; ++kk) {
        const bf16x8 a0 = *(LAS const bf16x8*)(kb + kk * 2048), a1 = *(LAS const bf16x8*)(kb + kk * 2048 + 512);
        p0 = __builtin_amdgcn_mfma_f32_32x32x16_bf16(a0, qf[kk], p0, 0, 0, 0);
        p1 = __builtin_amdgcn_mfma_f32_32x32x16_bf16(a1, qf[kk], p1, 0, 0, 0);
    }
}
__device__ __forceinline__ void partialSM(f32x16& p0, f32x16& p1, float& m, float& alpha) {
    float pmax = fmaxf(p0[0], p1[0]);
#pragma unroll
    for (int r = 1; r < 16; ++r) pmax = fmaxf(pmax, fmaxf(p0[r], p1[r]));
    { const auto rr = __builtin_amdgcn_permlane32_swap(__float_as_uint(pmax), __float_as_uint(pmax), false, false); pmax = fmaxf(__uint_as_float(rr[0]), __uint_as_float(rr[1])); }
    if (__builtin_expect(__all(pmax - m <= THR2), 1)) alpha = 1.f;
    else { const float mn = fmaxf(m, pmax); alpha = __builtin_amdgcn_exp2f(m - mn); m = mn; }
    const float mm = m;
#pragma unroll
    for (int r = 0; r < 16; ++r) { p0[r] = __builtin_amdgcn_exp2f(p0[r] - mm); p1[r] -= mm; }
}
__device__ __forceinline__ void finishSM(f32x16& p0, f32x16& p1, float alpha, float& l, bf16x8 (&pf)[4]) {
    float ps = 0.f;
#pragma unroll
    for (int r = 0; r < 16; ++r) { p1[r] = __builtin_amdgcn_exp2f(p1[r]); ps += p0[r] + p1[r]; }
    l = l * alpha + ps;
    pf[0] = pack8(p0, 0); pf[1] = pack8(p0, 8); pf[2] = pack8(p1, 0); pf[3] = pack8(p1, 8);
}
__device__ __forceinline__ void pv(f32x16 (&o)[4], LAS const unsigned char* vs, const bf16x8 (&pf)[4], int r32, int hi) {
    LAS const unsigned char* vb = vs + hi * 2048 + r32 * 16;
#pragma unroll
    for (int db = 0; db < 4; ++db) {
        bf16x8 va[4];
#pragma unroll
        for (int s = 0; s < 4; ++s) va[s] = *(LAS const bf16x8*)(vb + s * 4096 + db * 512);
#pragma unroll
        for (int s = 0; s < 4; ++s) o[db] = __builtin_amdgcn_mfma_f32_32x32x16_bf16(va[s], pf[s], o[db], 0, 0, 0);
        __builtin_amdgcn_sched_group_barrier(0x100, 4, 0); __builtin_amdgcn_sched_group_barrier(0x8, 4, 0);
    }
}
__device__ __forceinline__ void resc(f32x16 (&o)[4], float alpha) {
    if (__any(alpha < 1.f)) {
#pragma unroll
        for (int db = 0; db < 4; ++db)
#pragma unroll
            for (int r = 0; r < 16; ++r) o[db][r] *= alpha;
    }
}
__device__ __forceinline__ void unit(LAS unsigned char* lds, int b, int h, int qb, const bf16* QKP, const bf16* UVT, float lam, float lam_init, const float* subg, bf16* MIXB, float* stash, int wave, int lane) {
    asm volatile("" : "+v"(lane));
    const int r32 = lane & 31, hi = lane >> 5;
    const size_t tok0 = (size_t)b * S;
    const size_t qtok = tok0 + qb * 256 + wave * 32 + r32;
    constexpr int NT = S / 64;
#pragma unroll 1
    for (int c = 0; c < 2; ++c) {
        bf16x8 qf[4];
#pragma unroll
        for (int kk = 0; kk < 4; ++kk) qf[kk] = *(const GAS bf16x8*)(QKP + qtok * 1280 + h * 128 + c * 64 + kk * 16 + hi * 8);
        f32x16 o[4];
#pragma unroll
        for (int db = 0; db < 4; ++db)
#pragma unroll
            for (int r = 0; r < 16; ++r) o[db][r] = 0.f;
        float m = -INFINITY, l = 0.f, alA, alB;
        f32x16 pA0, pA1, pB0, pB1; bf16x8 pf[4];
        const char* kub = (const char*)(QKP + tok0 * 1280 + 512 + h * 128 + c * 64 + wave * 8);
        const char* vub = (const char*)(UVT + (size_t)(768 + h * 128) * M + tok0 + wave * 8);
        const unsigned kvo = (unsigned)lane * 2560u, vvo = (unsigned)lane * (unsigned)(M * 2);
#define ATT_DMA_K(t) __builtin_amdgcn_global_load_lds((const unsigned*)(kub + (size_t)(t) * (64 * 2560) + kvo), (LAS unsigned*)(lds + LDS_K + ((t) & 1) * KSLOT + wave * 1024), 16, 0, 0)
#define ATT_DMA_V(t) do { \
            __builtin_amdgcn_global_load_lds((const unsigned*)(vub + (size_t)(t) * 128 + vvo), (LAS unsigned*)(lds + LDS_V + ((t) & 1) * VSLOT + wave * 2048), 16, 0, 0); \
            __builtin_amdgcn_global_load_lds((const unsigned*)(vub + (size_t)64 * M * 2 + (size_t)(t) * 128 + vvo), (LAS unsigned*)(lds + LDS_V + ((t) & 1) * VSLOT + wave * 2048 + 1024), 16, 0, 0); } while (0)
#define SB() __builtin_amdgcn_sched_barrier(0)
#define ATT_SYNC() do { asm volatile("s_waitcnt vmcnt(0) lgkmcnt(0)" ::: "memory"); __builtin_amdgcn_s_barrier(); asm volatile("" ::: "memory"); } while (0)
        const bool early = wave < 4;
        ATT_SYNC();
        ATT_DMA_K(0); ATT_DMA_V(0);
        ATT_SYNC();
        ATT_DMA_K(1);
        qkt(pA0, pA1, lds + LDS_K, qf, r32, hi); partialSM(pA0, pA1, m, alA);
#pragma unroll 1
        for (int j = 1; j < NT - 1; j += 2) {
            ATT_SYNC(); if (early) { ATT_DMA_K(j + 1); ATT_DMA_V(j); }
            SB(); qkt(pB0, pB1, lds + LDS_K + KSLOT, qf, r32, hi); finishSM(pA0, pA1, alA, l, pf); SB();
            if (!early) { ATT_DMA_K(j + 1); ATT_DMA_V(j); }
            pv(o, lds + LDS_V, pf, r32, hi); partialSM(pB0, pB1, m, alB); SB(); resc(o, alB);
            ATT_SYNC(); if (early) { ATT_DMA_K(j + 2); ATT_DMA_V(j + 1); }
            SB(); qkt(pA0, pA1, lds + LDS_K, qf, r32, hi); finishSM(pB0, pB1, alB, l, pf); SB();
            if (!early) { ATT_DMA_K(j + 2); ATT_DMA_V(j + 1); }
            pv(o, lds + LDS_V + VSLOT, pf, r32, hi); partialSM(pA0, pA1, m, alA); SB(); resc(o, alA);
        }
        ATT_SYNC(); ATT_DMA_V(NT - 1);
        SB(); qkt(pB0, pB1, lds + LDS_K + KSLOT, qf, r32, hi); finishSM(pA0, pA1, alA, l, pf); SB();
        pv(o, lds + LDS_V, pf, r32, hi); partialSM(pB0, pB1, m, alB); SB(); resc(o, alB);
        ATT_SYNC();
        finishSM(pB0, pB1, alB, l, pf); pv(o, lds + LDS_V + VSLOT, pf, r32, hi);
#undef ATT_DMA_K
#undef ATT_DMA_V
#undef ATT_SYNC
#undef SB
        const float lt = xsum32(l);
        const int lane_e = (int)mk_lane_id();
        const int hi_e = lane_e >> 5; const size_t qtok_e = tok0 + qb * 256 + wave * 32 + (lane_e & 31);
        if (c == 0) {
            const float i1 = 1.f / lt;
#pragma unroll
            for (int db = 0; db < 4; ++db)
#pragma unroll
                for (int g4 = 0; g4 < 4; ++g4) *(GAS f32x4*)(stash + ((db * 4 + g4) * 64 + lane_e) * 4) = (f32x4){o[db][4 * g4] * i1, o[db][4 * g4 + 1] * i1, o[db][4 * g4 + 2] * i1, o[db][4 * g4 + 3] * i1};
        } else {
            const float i2 = lam / lt;
            float ss = 0.f;
#pragma unroll
            for (int db = 0; db < 4; ++db)
#pragma unroll
                for (int g4 = 0; g4 < 4; ++g4) { const f32x4 s1 = *(const GAS f32x4*)(stash + ((db * 4 + g4) * 64 + lane_e) * 4);
#pragma unroll
                    for (int i = 0; i < 4; ++i) { const float v = s1[i] - o[db][4 * g4 + i] * i2; o[db][4 * g4 + i] = v; ss += v * v; } }
            ss = xsum32(ss);
            const float rs = (1.f - lam_init) / sqrtf(ss * (1.f / 128.f) + 1e-5f);
            bf16* orow = MIXB + qtok_e * D + 256 + h * 128;
#pragma unroll
            for (int db = 0; db < 4; ++db)
#pragma unroll
                for (int g4 = 0; g4 < 4; ++g4) { const int e = 32 * db + 8 * g4 + 4 * hi_e; const f32x4 gg = *(const GAS f32x4*)(subg + e);
                    const unsigned long long w = (unsigned long long)pg8::cvt_pk_bf16(o[db][4 * g4] * rs * gg.x, o[db][4 * g4 + 1] * rs * gg.y) | ((unsigned long long)pg8::cvt_pk_bf16(o[db][4 * g4 + 2] * rs * gg.z, o[db][4 * g4 + 3] * rs * gg.w) << 32);
                    *(GAS unsigned long long*)(orow + e) = w; }
        }
    }
}
}
namespace hy {
typedef float f32x16 __attribute__((ext_vector_type(16)));
constexpr int CPY = 16456;
constexpr int VJ = 65, VK8 = VJ * 64;
constexpr int LDS_F = 0, LDS_VV = 4 * CPY, LDS_END = LDS_VV + 8 * VK8;
static_assert(LDS_VV % 16 == 0 && LDS_END <= 131072, "hyena LDS map");

__device__ __forceinline__ void filter_item(LAS unsigned char* lds, int pb, const float* fw1, const float* fb1, const float* fr1, const float* fw2, const float* fb2, const float* fr2,
                                            const float* fw3, bf16* KF, float* PS, int wave, int lane) {
    LAS bf16* tile = (LAS bf16*)lds;
    LAS float* za = (LAS float*)(lds + 65536) + wave * 512;
    LAS float* zb = (LAS float*)(lds + 81920) + wave * 512;
    LAS float* sqs = (LAS float*)(lds + 98304);
    const int p0 = pb * 64 + wave * 8;
    if (lane < 33) {
#pragma unroll 1
        for (int pi = 0; pi < 8; ++pi) { const int p = p0 + pi; float z;
            if (lane == 0) z = (float)p / (float)(S - 1);
            else { const int bi = (lane - 1) & 15; const float band = 1e-4f + (float)bi * ((15.0f - 1e-4f) / 15.0f), wpos = 2.0f * 3.14159265358979323846f * (float)p / (float)S;
                   z = lane <= 16 ? cosf(wpos * band) : -sinf(wpos * band); }
            za[pi * 64 + lane] = z; }
    }
    LDS_WAIT(); asm volatile("" ::: "memory");
    float acc8[8];
    { const float b1 = fb1[lane];
#pragma unroll
      for (int pi = 0; pi < 8; ++pi) acc8[pi] = b1;
#pragma unroll 1
      for (int i = 0; i < 33; ++i) { const float w = fw1[i * 64 + lane];
#pragma unroll
          for (int pi = 0; pi < 8; ++pi) acc8[pi] += za[pi * 64 + i] * w; }
      const float f1 = fr1[lane];
#pragma unroll
      for (int pi = 0; pi < 8; ++pi) zb[pi * 64 + lane] = sinf(f1 * acc8[pi]); }
    LDS_WAIT(); asm volatile("" ::: "memory");
    { const float b2 = fb2[lane];
#pragma unroll
      for (int pi = 0; pi < 8; ++pi) acc8[pi] = b2;
#pragma unroll 1
      for (int i = 0; i < 64; ++i) { const float w = fw2[i * 64 + lane];
#pragma unroll
          for (int pi = 0; pi < 8; ++pi) acc8[pi] += zb[pi * 64 + i] * w; }
      const float f2 = fr2[lane];
      LDS_WAIT(); asm volatile("" ::: "memory");
#pragma unroll
      for (int pi = 0; pi < 8; ++pi) za[pi * 64 + lane] = sinf(f2 * acc8[pi]); }
    LDS_WAIT(); asm volatile("" ::: "memory");
    const float mind = logf(1e-2f) / 1.5f, maxd = logf(1e-2f) / 0.3f;
#pragma unroll 1
    for (int qh = 0; qh < 2; ++qh) {
        float ac[8][4];
#pragma unroll
        for (int pi = 0; pi < 8; ++pi)
#pragma unroll
            for (int q = 0; q < 4; ++q) ac[pi][q] = 0.f;
#pragma unroll 1
        for (int i = 0; i < 64; ++i) { float w[4];
#pragma unroll
            for (int q = 0; q < 4; ++q) w[q] = fw3[i * 512 + lane + 64 * (qh * 4 + q)];
#pragma unroll
            for (int pi = 0; pi < 8; ++pi) { const float hv = za[pi * 64 + i];
#pragma unroll
                for (int q = 0; q < 4; ++q) ac[pi][q] += hv * w[q]; } }
#pragma unroll
        for (int q = 0; q < 4; ++q) { const int col = lane + 64 * (qh * 4 + q), ch = col & 255; const float delta = fabsf(mind + (float)ch * ((maxd - mind) / 255.0f)); float sq = 0.f;
#pragma unroll
            for (int pi = 0; pi < 8; ++pi) { const int p = p0 + pi; const float val = ac[pi][q] * expf(-((float)p / (float)(S - 1)) * delta);
                if (!(col >= 256 && p == 0)) sq += val * val;
                tile[col * 64 + wave * 8 + pi] = (bf16)f2bf(val); }
            sqs[wave * 512 + col] = sq; }
    }
    LDS_WAIT(); __syncthreads();
    { const int p = pb * 64 + lane;
#pragma unroll 1
      for (int cc = 0; cc < 64; ++cc) { const int col = wave * 64 + cc; const bf16 v = tile[col * 64 + lane];
          if (col < 256) KF[(size_t)col * 8192 + 4095 - p] = v; else if (p != 0) KF[(size_t)(col - 256) * 8192 + 4095 + p] = v; } }
    { const int t = wave * 64 + lane; float s = 0.f;
#pragma unroll
      for (int w = 0; w < 8; ++w) s += sqs[w * 512 + t];
      PS[(size_t)pb * 512 + t] = s;
      if (pb == 0 && t < 256) KF[(size_t)t * 8192 + 8191] = 0; }
    LDS_WAIT(); __syncthreads();
}

__device__ __forceinline__ float conv1(float um, float u0, float up, float w0, float w1, float w2, float cb) { return um * w0 + u0 * w1 + up * w2 + cb; }

__device__ __forceinline__ void unit(LAS unsigned char* lds, int c, const bf16* KF, const float* PS, const bf16* UVT, const float* cw, const float* cb, const float* bias_d, bf16* HT, int wave, int lane) {
    lane = (int)mk_lane_id(); asm volatile("" : "+s"(wave));
    const int tid = wave * 64 + lane;
    { const bf16* src = KF + (size_t)c * 8192;
#pragma unroll
      for (int i = 0; i < 2; ++i) { const int ch = tid + 512 * i; *(LAS v4u*)(lds + LDS_F + ch * 16) = *(const GAS v4u*)(src + ch * 8); } }
    { const float w0v = cw[512 + c], w1v = cw[768 + 512 + c], w2v = cw[1536 + 512 + c], cbv = cb[512 + c], w0x = cw[256 + c], w1x = cw[768 + 256 + c], w2x = cw[1536 + 256 + c], cbx = cb[256 + c];
      const bf16* rv = UVT + (size_t)(512 + c) * M; const bf16* rx = UVT + (size_t)(256 + c) * M;
#pragma unroll
      for (int i = 0; i < 4; ++i) { const int q = tid + 512 * i, b = q >> 9, sc = q & 511, s0 = sc * 8; const size_t g0 = (size_t)b * S + s0;
          const v4u av = *(const GAS v4u*)(rv + g0), ax = *(const GAS v4u*)(rx + g0);
          float uv[10], ux[10];
          uv[0] = s0 > 0 ? bf2f(rv[g0 - 1]) : 0.f; ux[0] = s0 > 0 ? bf2f(rx[g0 - 1]) : 0.f; uv[9] = s0 + 8 < S ? bf2f(rv[g0 + 8]) : 0.f; ux[9] = s0 + 8 < S ? bf2f(rx[g0 + 8]) : 0.f;
#pragma unroll
          for (int e = 0; e < 4; ++e) { uv[1 + 2 * e] = bf2f((bf16)av[e]); uv[2 + 2 * e] = bf2f((bf16)(av[e] >> 16)); ux[1 + 2 * e] = bf2f((bf16)ax[e]); ux[2 + 2 * e] = bf2f((bf16)(ax[e] >> 16)); }
          float o[8];
#pragma unroll
          for (int e = 0; e < 8; ++e) o[e] = conv1(uv[e], uv[e + 1], uv[e + 2], w0v, w1v, w2v, cbv) * conv1(ux[e], ux[e + 1], ux[e + 2], w0x, w1x, w2x, cbx);
          v4u w; w.x = pk2(o[0], o[1]); w.y = pk2(o[2], o[3]); w.z = pk2(o[4], o[5]); w.w = pk2(o[6], o[7]);
          *(LAS v4u*)(lds + LDS_VV + (((sc & 7) * VJ + (sc >> 3)) * 4 + b) * 16) = w; }
      if (tid < 32) { unsigned z_; asm volatile("v_mov_b32 %0, 0" : "=v"(z_)); *(LAS v4u*)(lds + LDS_VV + (((tid >> 2) * VJ + 64) * 4 + (tid & 3)) * 16) = (v4u){z_, z_, z_, z_}; } }
    LDS_WAIT(); __syncthreads();
    {
#pragma unroll 1
      for (int i = 0; i < 4; ++i) { const int y = tid + 512 * i;
          const unsigned long long w0 = *(LAS const unsigned long long*)(lds + LDS_F + y * 8), w1 = *(LAS const unsigned long long*)(lds + LDS_F + y * 8 + 8);
#pragma unroll
          for (int p = 1; p < 4; ++p) *(LAS unsigned long long*)(lds + LDS_F + p * CPY + y * 8) = (w0 >> (16 * p)) | (w1 << (64 - 16 * p)); } }
    const float nrm = 1.0f / sqrtf(wave_sum(PS[(size_t)lane * 512 + c] + PS[(size_t)lane * 512 + 256 + c]) + 1e-6f);
    LDS_WAIT(); __syncthreads();
    const int r32 = lane & 31, hi = lane >> 5, gp = wave & 3, half = wave >> 2, iloc = r32 >> 2, b = r32 & 3;
    f32x16 acc[2][2];
#pragma unroll
    for (int rho = 0; rho < 2; ++rho)
#pragma unroll
        for (int gg = 0; gg < 2; ++gg)
#pragma unroll
            for (int r = 0; r < 16; ++r) acc[rho][gg][r] = 0.f;
    const int dlo = 16 * gp - 63 + (half ? 40 : 0), dn = half ? 39 : 40;
    int pa = LDS_F + (3 - (r32 & 3)) * CPY + (4092 - 4 * (r32 >> 2) + 8 * hi) * 2 - 64 - 128 * dlo;
    int jb = 16 * gp + iloc - dlo;
    const int pbase = LDS_VV + hi * VK8 + b * 16;
    typedef unsigned long long u64;
    struct Frag { u64 a[4][4]; v4u b[4][2]; };
#define HY_LOAD(F) do { const int j0_ = jb, j1_ = jb + 8; LAS const unsigned char* ap_ = lds + pa; \
        LAS const unsigned char* bp0_ = lds + pbase + ((unsigned)j0_ < 64u ? j0_ : 64) * 64; LAS const unsigned char* bp1_ = lds + pbase + ((unsigned)j1_ < 64u ? j1_ : 64) * 64; \
        _Pragma("unroll") for (int k = 0; k < 4; ++k) { F.a[k][0] = *(LAS const u64*)(ap_ + 64 + 32 * k); F.a[k][1] = *(LAS const u64*)(ap_ + 64 + 32 * k + 8); F.a[k][2] = *(LAS const u64*)(ap_ + 32 * k); F.a[k][3] = *(LAS const u64*)(ap_ + 32 * k + 8); \
            F.b[k][0] = *(LAS const v4u*)(bp0_ + k * (2 * VK8)); F.b[k][1] = *(LAS const v4u*)(bp1_ + k * (2 * VK8)); } \
        pa -= 128; jb -= 1; } while (0)
#define HY_MMA(F) do { _Pragma("unroll") for (int k = 0; k < 4; ++k) { \
            const bf16x8 fa0 = __builtin_bit_cast(bf16x8, (v4u){(unsigned)F.a[k][0], (unsigned)(F.a[k][0] >> 32), (unsigned)F.a[k][1], (unsigned)(F.a[k][1] >> 32)}); \
            const bf16x8 fa1 = __builtin_bit_cast(bf16x8, (v4u){(unsigned)F.a[k][2], (unsigned)(F.a[k][2] >> 32), (unsigned)F.a[k][3], (unsigned)(F.a[k][3] >> 32)}); \
            const bf16x8 fb0 = __builtin_bit_cast(bf16x8, F.b[k][0]), fb1 = __builtin_bit_cast(bf16x8, F.b[k][1]); \
            acc[0][0] = __builtin_amdgcn_mfma_f32_32x32x16_bf16(fa0, fb0, acc[0][0], 0, 0, 0); acc[0][1] = __builtin_amdgcn_mfma_f32_32x32x16_bf16(fa0, fb1, acc[0][1], 0, 0, 0); \
            acc[1][0] = __builtin_amdgcn_mfma_f32_32x32x16_bf16(fa1, fb0, acc[1][0], 0, 0, 0); acc[1][1] = __builtin_amdgcn_mfma_f32_32x32x16_bf16(fa1, fb1, acc[1][1], 0, 0, 0); } } while (0)
#define HY_MIX() do { _Pragma("unroll") for (int i_ = 0; i_ < 8; ++i_) { __builtin_amdgcn_sched_group_barrier(0x100, 3, 0); __builtin_amdgcn_sched_group_barrier(0x8, 2, 0); } } while (0)
    Frag FA, FB;
    HY_LOAD(FA);
    int dd = 0;
#pragma unroll 1
    for (; dd + 2 <= dn; dd += 2) {
        HY_LOAD(FB); HY_MMA(FA); HY_MIX();
        if (dd + 2 < dn) { HY_LOAD(FA); HY_MMA(FB); HY_MIX(); } else { HY_MMA(FB); }
    }
    if (dd < dn) HY_MMA(FA);
#undef HY_MIX
#undef HY_LOAD
#undef HY_MMA
    const int lane_b = (int)mk_lane_id(), r32_b = lane_b & 31, hi_b = lane_b >> 5, iloc_b = r32_b >> 2, b_b = r32_b & 3;
    LDS_WAIT(); __syncthreads();
    { LAS float* xw = (LAS float*)(lds + LDS_F) + (gp * 2 + (half ? 0 : 1)) * 2048 + lane_b;
#pragma unroll
      for (int gg = 0; gg < 2; ++gg)
#pragma unroll
          for (int r = 0; r < 16; ++r) xw[(gg * 16 + r) * 64] = half ? acc[0][gg][r] : acc[1][gg][r]; }
    LDS_WAIT(); __syncthreads();
    f32x16 fin[2];
    { LAS const float* xr = (LAS const float*)(lds + LDS_F) + (gp * 2 + (half ? 1 : 0)) * 2048 + lane_b;
#pragma unroll
      for (int gg = 0; gg < 2; ++gg)
#pragma unroll
          for (int r = 0; r < 16; ++r) fin[gg][r] = (half ? acc[1][gg][r] : acc[0][gg][r]) + xr[(gg * 16 + r) * 64]; }
    { const float bd = bias_d[c], w0 = cw[c], w1 = cw[768 + c], w2 = cw[1536 + c], cb0 = cb[c]; const bf16* r0p = UVT + (size_t)c * M; bf16* hrow = HT + (size_t)c * M;
#pragma unroll
      for (int gg = 0; gg < 2; ++gg)
#pragma unroll
          for (int g4 = 0; g4 < 4; ++g4) { const int i = 16 * gp + 8 * gg + iloc_b, rr = 32 * half + 8 * g4 + 4 * hi_b, t0 = 64 * i + rr; const size_t tok = (size_t)b_b * S + t0;
              const unsigned long long vw = *(LAS const unsigned long long*)(lds + LDS_VV + (((rr >> 3) * VJ + i) * 4 + b_b) * 16 + (rr & 7) * 2);
              const unsigned long long uw = *(const GAS unsigned long long*)(r0p + tok);
              float u[6]; u[0] = t0 > 0 ? bf2f(r0p[tok - 1]) : 0.f; u[5] = t0 + 4 < S ? bf2f(r0p[tok + 4]) : 0.f;
              u[1] = bf2f((bf16)uw); u[2] = bf2f((bf16)(uw >> 16)); u[3] = bf2f((bf16)(uw >> 32)); u[4] = bf2f((bf16)(uw >> 48));
              float o[4];
#pragma unroll
              for (int e = 0; e < 4; ++e) { const float vv = bf2f((bf16)(vw >> (16 * e))); o[e] = (nrm * fin[gg][4 * g4 + e] + vv * bd) * conv1(u[e], u[e + 1], u[e + 2], w0, w1, w2, cb0); }
              *(GAS unsigned long long*)(hrow + tok) = (unsigned long long)pk2(o[0], o[1]) | ((unsigned long long)pk2(o[2], o[3]) << 32); } }
    LDS_WAIT(); __syncthreads();
}
__device__ __forceinline__ void transpose_slab(LAS unsigned char* lds, int slab, const bf16* HT, bf16* MIXB, int wave, int lane) {
    const int tid = wave * 64 + lane; LAS bf16* tile = (LAS bf16*)lds;
#pragma unroll 1
    for (int i = 0; i < 4; ++i) { const int q = tid + 512 * i, c = q >> 3, tc = q & 7; const v4u w = *(const GAS v4u*)(HT + (size_t)c * M + (size_t)slab * 64 + tc * 8);
#pragma unroll
        for (int e = 0; e < 4; ++e) { tile[(tc * 8 + 2 * e) * 264 + c] = (bf16)w[e]; tile[(tc * 8 + 2 * e + 1) * 264 + c] = (bf16)(w[e] >> 16); } }
    LDS_WAIT(); __syncthreads();
#pragma unroll 1
    for (int i = 0; i < 4; ++i) { const int q = tid + 512 * i, tk = q >> 5, cc = q & 31;
        *(GAS v4u*)(MIXB + ((size_t)slab * 64 + tk) * D + cc * 8) = *(LAS const v4u*)(lds + (tk * 264 + cc * 8) * 2); }
    LDS_WAIT(); __syncthreads();
}
}
#ifndef DUP_PRO
#define DUP_PRO 1
#endif
#ifndef DUP_IN
#define DUP_IN 1
#endif
#ifndef DUP_HY
#define DUP_HY 1
#endif
#ifndef DUP_POOL
#define DUP_POOL 1
#endif
#ifndef DUP_HYT
#define DUP_HYT 1
#endif
#ifndef DUP_ATT
#define DUP_ATT 1
#endif
#ifndef DUP_OUT
#define DUP_OUT 1
#endif
#ifndef DUP_LN1
#define DUP_LN1 1
#endif
#ifndef DUP_MOE1
#define DUP_MOE1 1
#endif
#ifndef DUP_MOE2
#define DUP_MOE2 1
#endif
#ifndef DUP_LN2
#define DUP_LN2 1
#endif
#ifndef EN_HY
#define EN_HY 1
#endif
#ifndef EN_HYT
#define EN_HYT 1
#endif
#ifndef EN_PRO
#define EN_PRO 1
#endif
#ifndef EN_IN
#define EN_IN 1
#endif
#ifndef EN_ATT
#define EN_ATT 1
#endif
#ifndef EN_POOL
#define EN_POOL 1
#endif
#ifndef EN_OUT
#define EN_OUT 1
#endif
#ifndef EN_LN1
#define EN_LN1 1
#endif
#ifndef EN_WCV
#define EN_WCV 1
#endif
#ifndef EN_MOE1
#define EN_MOE1 1
#endif
#ifndef EN_MOE2
#define EN_MOE2 1
#endif
#ifndef EN_LN2
#define EN_LN2 1
#endif
constexpr int RING_BYTES = 135168;
constexpr int LDSCTL_OFF = RING_BYTES, MISC_OFF = LDSCTL_OFF + 320, MOETAB_OFF = LDSCTL_OFF + 1024, ROUTE_OFF = LDSCTL_OFF + 2048;
constexpr int LDS_BYTES = 151552;

struct Args { const float* in[38]; float* out; unsigned char* ws; int* eid; float* wts; int ph_lo, ph_hi, l_lo, l_hi, single, pad; };
enum { PH_PRO = 0, PH_IN = 1, PH_ATT = 2, PH_POOL = 3, PH_OUT = 4, PH_LN1 = 5, PH_WCV = 6, PH_MOE1 = 7, PH_MOE2 = 8, PH_LN2 = 9, PH_HY = 10, PH_HYT = 11, PH_END = 12 };

__global__ void __launch_bounds__(NWAVES * 64, 2) mk_fwd(Args a) {
    extern __shared__ __attribute__((aligned(16))) unsigned char lds_raw[];
    LAS unsigned char* lds = (LAS unsigned char*)lds_raw;
    volatile LAS unsigned* MISC = (volatile LAS unsigned*)(lds + MISC_OFF);
    const int wave_s = __builtin_amdgcn_readfirstlane((int)threadIdx.x >> 6);
    const int G = gridDim.x, bx = blockIdx.x, vcu0 = (G % 8 == 0) ? (bx % 8) * (G / 8) + bx / 8 : bx;
    gu32* ctl0 = (gu32*)(a.ws + WS_CTL);
    for (int u = wave_s * 64 + (int)mk_lane_id(); u < (LDS_BYTES - LDSCTL_OFF) / 4; u += NWAVES * 64) ((LAS unsigned*)(lds + LDSCTL_OFF))[u] = 0u;
    __syncthreads();
    XcdBarrier bar; bar.bar = (unsigned*)(ctl0 + CW_BAR); bar.x = 0; bar.st = nullptr;
#if defined(MK_PER_PHASE)
    if (!a.single)
#endif
    bar = xcd_barrier_post((unsigned*)(ctl0 + CW_BAR), MISC + 8, wave_s);
#if defined(MK_PER_PHASE)
#define IN(k) (a.ph_lo <= (k) && (k) < a.ph_hi)
#define SEAM() do { if (!a.single) xcd_barrier(bar, wave_s); } while (0)
#else
#define IN(k) 1
#if defined(PROBE_BAR2)
#define SEAM() do { xcd_barrier(bar, wave_s); xcd_barrier(bar, wave_s); } while (0)
#else
#define SEAM() xcd_barrier(bar, wave_s)
#endif
#endif
    const int NGW = G * NWAVES;
#define PHASE_PTRS() int lane_ = (int)mk_lane_id(); asm volatile("" : "+v"(lane_)); const int lane = lane_, wave = wave_s; int vcu = vcu0; asm volatile("" : "+s"(vcu)); (void)wave; const int gw = vcu * NWAVES + wave; (void)gw; unsigned char* ws = a.ws; gu32* ctl = (gu32*)(ws + WS_CTL); (void)ctl; \
    bf16* XB = (bf16*)(ws + WS_XB); bf16* QKP = (bf16*)(ws + WS_QKP); bf16* UVT = (bf16*)(ws + WS_UVT); float* CS = (float*)(ws + WS_CS); bf16* MIXB = (bf16*)(ws + WS_MIXB); \
    (void)XB; (void)QKP; (void)UVT; (void)CS; (void)MIXB
#define INP(k) (a.in[k])
#define WCV_SPLIT_IT 3730
#define WCV_SPLIT_PB ((size_t)M * 256 / 16 * 9)
#define WCV_LAYER(LEXPR, GW_, NGW_, IT0_, IT1_, PB0_, PB1_) do { const int wl_ = (LEXPR), wg_ = (GW_), wn_ = (NGW_); const int l = wl_, gw = wg_, NGW = wn_; (void)NGW; const int it0_ = (IT0_), it1_ = (IT1_); const size_t pb0_ = (PB0_), pb1_ = (PB1_); \
            LAS float* scr = (LAS float*)(lds + wave * 16384); \
            unsigned char* wb_ = ws + WS_WBUF + (size_t)(l & 1) * WBUF_STRIDE; bf16* W13 = (bf16*)(wb_ + WB_W13); bf16* W2 = (bf16*)(wb_ + WB_W2); bf16* WG = (bf16*)(wb_ + WB_WG); bf16* WP = (bf16*)(wb_ + WB_WP); \
            for (int it = it0_ + gw; it < it1_; it += NGW) { \
                const float* src; int K, N, k0, n0, mode = 0; bf16* dst; \
                if (it < 4096) { const int which = it >> 11, r = it & 2047, e = r >> 7, kb = (r >> 3) & 15, nb = r & 7; \
                    src = INP(which ? 31 : 30) + ((size_t)l * 16 + e) * D * 256; K = D; N = 256; k0 = kb * 64; n0 = nb * 32; mode = 1 + which; dst = W13 + (size_t)e * 512 * D; \
                } else if (it < 6144) { const int r = it - 4096, e = r >> 7, kb = (r >> 5) & 3, nb = r & 31; \
                    src = INP(32) + ((size_t)l * 16 + e) * 256 * D; K = 256; N = D; k0 = kb * 64; n0 = nb * 32; dst = W2 + (size_t)e * D * 256 + (size_t)n0 * 256; \
                } else if (it < 6656) { const int r = it - 6144, kb = r >> 5, nb = r & 31; \
                    src = INP(33) + (size_t)l * D * D; K = D; N = D; k0 = kb * 64; n0 = nb * 32; dst = WG + (size_t)n0 * D; \
                } else { const int r = it - 6656, kb = r >> 5, nb = r & 31; \
                    src = INP(35) + (size_t)l * 256 * D; K = 256; N = D; k0 = kb * 64; n0 = nb * 32; dst = WP + (size_t)n0 * 256; } \
                p0_transpose_block(src, K, N, k0, n0, dst, mode, scr, lane); \
            } \
            const int ln = lane; \
            const float* ps = INP(1) + (size_t)l * M * 256; bf16* PB = (bf16*)(wb_ + WB_PB); \
            for (size_t i = pb0_ + ((size_t)gw * 64 + ln) * 8; i < pb1_; i += (size_t)NGW * 64 * 8) { const f32x4 x0 = *(const GAS f32x4*)(ps + i), x1 = *(const GAS f32x4*)(ps + i + 4); \
                v4u o; o.x = pk2(x0.x, x0.y); o.y = pk2(x0.z, x0.w); o.z = pk2(x1.x, x1.y); o.w = pk2(x1.z, x1.w); *(GAS v4u*)(PB + i) = o; } \
    } while (0)

    if (EN_PRO && IN(PH_PRO)) {
            PHASE_PTRS();
            for (int rep_ = 0; rep_ < DUP_PRO; ++rep_) {
        LAS float* scr = (LAS float*)(lds + wave * 16384);
        for (int it = gw; it < DEPTH * (16 * 72 + 16 * 32); it += NGW) {
            const int l = it / 1664, r = it % 1664; const float* src; int N, k0, n0; bf16* dst;
            if (r < 1152) { const int kb = r / 72, nb = r % 72; n0 = nb * 32; k0 = kb * 64; N = INW; src = INP(4) + (size_t)l * D * INW;
                bf16* wsw = (bf16*)(ws + WS_WIN + (size_t)l * WIN_LAYER); bf16* wnm = wsw + 1280 * 1024;
                dst = n0 < 768 ? wsw + (size_t)n0 * D : (n0 < 1792 ? wnm + (size_t)(n0 - 768) * D : wsw + (size_t)(768 + n0 - 1792) * D); }
            else { const int q = r - 1152, kb = q >> 5, nb = q & 31; n0 = nb * 32; k0 = kb * 64; N = D; src = INP(23) + (size_t)l * D * D; dst = (bf16*)(ws + WS_WOUT + (size_t)l * WOUT_LAYER) + (size_t)n0 * D; }
            p0_transpose_block(src, D, N, k0, n0, dst, 0, scr, lane);
            }
        }
        for (int it = gw; it < DEPTH * 4 * 16 * 2; it += NGW) {
            const int l = it >> 7, g = (it >> 5) & 3, dh = (it >> 4) & 1, k = (it & 15) * 64 + lane;
            const float* wrow = INP(4) + (size_t)l * D * INW + (size_t)k * INW + 2304 + g * 64;
            const float* pw = INP(20) + (size_t)(l * 4 + g) * 64 * 64 + dh * 32;
            float acc[32];
#pragma unroll
            for (int d = 0; d < 32; ++d) acc[d] = 0.f;
#pragma unroll 1
            for (int c = 0; c < 64; ++c) { const float x = wrow[c];
#pragma unroll
                for (int d = 0; d < 32; ++d) acc[d] += x * pw[c * 64 + d]; }
            bf16* dst = (bf16*)(ws + WS_WIN + (size_t)l * WIN_LAYER) + (size_t)(1280 + 1024 + g * 64 + dh * 32) * D + k;
#pragma unroll
            for (int d = 0; d < 32; ++d) dst[(size_t)d * D] = (bf16)f2bf(acc[d]);
        }
        for (int i = gw * 64 + lane; i < DEPTH * 32 * D; i += NGW * 64) { const int l2 = i / (32 * D), r = i % (32 * D), col = r / D, k = r % D;
            const float w = col < 4 ? INP(26)[((size_t)l2 * D + k) * 4 + col] : (col < 20 ? INP(28)[((size_t)l2 * D + k) * 16 + col - 4] : 0.f);
            const unsigned hb = f2bf(w); const float lo = w - __uint_as_float(hb << 16);
            bf16* dst = (bf16*)(ws + WS_WR) + (size_t)l2 * 64 * D; dst[(size_t)col * D + k] = (bf16)hb; dst[(size_t)(32 + col) * D + k] = (bf16)f2bf(lo); }
        int ln2 = lane; asm volatile("" : "+v"(ln2));
        for (int i = gw * 64 + ln2; i < S * 8; i += NGW * 64) { const int pos = i >> 3, j = i & 7; const float ang = (float)pos * powf(500000.0f, -(float)(2 * j) / 16.0f);
            CS[pos * 16 + j] = cosf(ang); CS[pos * 16 + 8 + j] = sinf(ang); }
        for (int m = gw; m < M; m += NGW) ln_row(INP(0) + (size_t)m * D, 1.f, nullptr, nullptr, nullptr, INP(2), INP(3), nullptr, XB + (size_t)m * D, lane);
        WCV_LAYER(0, gw, NGW, 0, 6784, (size_t)0, (size_t)M * 256);
        LDS_WAIT(); __syncthreads();
        for (int it = vcu; it < DEPTH * 64; it += G) { const int fl = it >> 6, pb = it & 63;
            hy::filter_item(lds, pb, INP(7) + fl * 33 * 64, INP(8) + fl * 64, INP(9) + fl * 64, INP(10) + fl * 64 * 64, INP(11) + fl * 64, INP(12) + fl * 64, INP(13) + fl * 64 * 512,
                            (bf16*)(ws + WS_KF) + (size_t)fl * 256 * 8192, (float*)(ws + WS_PS) + (size_t)fl * 64 * 512, wave, lane); }
        SEAM();
    }
#if defined(MK_PER_PHASE)
    for (int l = a.l_lo; l < a.l_hi; ++l) {
#else
#pragma unroll 1
    for (int l = 0; l < DEPTH; ++l) {
#endif
        if (EN_IN && IN(PH_IN)) {
            PHASE_PTRS();
            for (int rep_ = 0; rep_ < DUP_IN; ++rep_) {
            const char* wsw = (const char*)(ws + WS_WIN + (size_t)l * WIN_LAYER);
            SchedIn Sc{vcu, G, (const char*)XB, wsw, wsw + (size_t)1280 * 1024 * 2};
            EpiIn E{QKP, UVT, CS};
            pg8::gemm_phase<EpiIn, SchedIn>(lds, D, Sc, E, wave);
            { SchedSq Sc2{vcu, G / 2, (const char*)(ws + WS_WBUF + (size_t)(l & 1) * WBUF_STRIDE + WB_PB), (const char*)(ws + WS_WBUF + (size_t)(l & 1) * WBUF_STRIDE + WB_WP), (size_t)256 * 256 * 2, (size_t)256 * 256 * 2, G / 2};
              EpiPle<0> E2{(bf16*)(ws + WS_YP), nullptr};
              pg8::gemm_phase<EpiPle<0>, SchedSq>(lds, 256, Sc2, E2, wave); }
            }
            SEAM();
        }
        if (EN_HY && IN(PH_HY)) {
            PHASE_PTRS();
            for (int rep_ = 0; rep_ < DUP_HY; ++rep_) {
            for (int c = vcu; c < 256; c += G)
                hy::unit(lds, c, (const bf16*)(ws + WS_KF) + (size_t)l * 256 * 8192, (const float*)(ws + WS_PS) + (size_t)l * 64 * 512, UVT, INP(5) + l * 3 * 768, INP(6) + l * 768, INP(14) + l * 256, (bf16*)(ws + WS_HT), wave, lane);
            }
        }
        if (EN_POOL && IN(PH_POOL)) {
            PHASE_PTRS();
            for (int rep_ = 0; rep_ < DUP_POOL; ++rep_) {
            int ln = lane; asm volatile("" : "+v"(ln));
            const int cc = (ln & 31) * 8, gq = cc >> 6, hw = 1 << gq;
            const float* pb = INP(21) + l * 256 + cc; const float* psc = INP(22) + l * 256 + cc;
            for (int it = gw; it < M / 2; it += NGW) {
                const int tok = it * 2 + (ln >> 5), pos = tok & (S - 1);
                int lo = pos - hw, hi2 = pos + hw - 1; lo = lo < 0 ? 0 : lo; hi2 = hi2 > S - 1 ? S - 1 : hi2;
                float sacc[8];
#pragma unroll
                for (int e = 0; e < 8; ++e) sacc[e] = 0.f;
                const bf16* zp = QKP + (size_t)(tok - pos) * 1280 + 1024 + cc;
                for (int r = lo; r <= hi2; ++r) { const v4u w = *(const GAS v4u*)(zp + (size_t)r * 1280);
                    sacc[0] += bf2f((bf16)w.x); sacc[1] += bf2f((bf16)(w.x >> 16)); sacc[2] += bf2f((bf16)w.y); sacc[3] += bf2f((bf16)(w.y >> 16));
                    sacc[4] += bf2f((bf16)w.z); sacc[5] += bf2f((bf16)(w.z >> 16)); sacc[6] += bf2f((bf16)w.w); sacc[7] += bf2f((bf16)(w.w >> 16)); }
                const float inv = 1.f / (float)(hi2 - lo + 1);
                const v4u w = *(const GAS v4u*)(zp + (size_t)pos * 1280);
                float z[8] = {bf2f((bf16)w.x), bf2f((bf16)(w.x >> 16)), bf2f((bf16)w.y), bf2f((bf16)(w.y >> 16)), bf2f((bf16)w.z), bf2f((bf16)(w.z >> 16)), bf2f((bf16)w.w), bf2f((bf16)(w.w >> 16))};
                float y[8];
#pragma unroll
                for (int e = 0; e < 8; ++e) y[e] = (sacc[e] * inv - z[e] + pb[e]) * psc[e];
                v4u o; o.x = pk2(y[0], y[1]); o.y = pk2(y[2], y[3]); o.z = pk2(y[4], y[5]); o.w = pk2(y[6], y[7]);
                *(GAS v4u*)(MIXB + (size_t)tok * D + 768 + cc) = o;
            }
            }
            SEAM();
        }
        if (EN_HYT && IN(PH_HYT)) {
            PHASE_PTRS();
            for (int rep_ = 0; rep_ < DUP_HYT; ++rep_) {
            for (int s = vcu; s < 256; s += G) hy::transpose_slab(lds, s, (const bf16*)(ws + WS_HT), MIXB, wave, lane);
            }
        }
        if (EN_ATT && IN(PH_ATT)) {
            PHASE_PTRS();
            for (int rep_ = 0; rep_ < DUP_ATT; ++rep_) {
            const float lam_init = 0.8f - 0.6f * expf(-0.3f * (float)l);
            int ln = lane; asm volatile("" : "+v"(ln));
            const float lam = expf(wave_sum(INP(15)[l * 64 + ln] * INP(16)[l * 64 + ln])) - expf(wave_sum(INP(17)[l * 64 + ln] * INP(18)[l * 64 + ln])) + lam_init;
            for (int u = vcu; u < 256; u += G) att::unit(lds, (u >> 4) >> 2, (u >> 4) & 3, u & 15, QKP, UVT, lam, lam_init, INP(19) + l * 128, MIXB, (float*)(ws + WS_STASH) + ((size_t)u * 8 + wave) * 4096, wave, lane);
            }
            SEAM();
        }
        if (EN_OUT && IN(PH_OUT)) {
            PHASE_PTRS();
            for (int rep_ = 0; rep_ < DUP_OUT; ++rep_) {
            SchedOut Sc{vcu, G, (const char*)MIXB, (const char*)(ws + WS_WOUT + (size_t)l * WOUT_LAYER)};
#if defined(PROBE_OUT)
            { EpiRes E0{(bf16*)(ws + WS_STASH)}; pg8::gemm_phase<EpiRes, SchedOut>(lds, D, Sc, E0, wave); }
#endif
            EpiRes E{XB};
            pg8::gemm_phase<EpiRes, SchedOut>(lds, D, Sc, E, wave);
            }
            SEAM();
        }
        if (EN_LN1 && IN(PH_LN1)) {
            PHASE_PTRS();
            for (int rep_ = 0; rep_ < DUP_LN1; ++rep_) {
            int ln = lane; asm volatile("" : "+v"(ln));
#if defined(PROBE_LN1)
            for (int ch = vcu; ch < M / 64; ch += G)
                ln1_router_chunk<PROBE_LN1>((LAS RouteLds*)(lds + ROUTE_OFF), lds, ch * 64, XB, (bf16*)(ws + WS_STASH), INP(24) + l * D, INP(25) + l * D, (const bf16*)(ws + WS_WR) + (size_t)l * 64 * D, INP(27) + l * 4, INP(29) + l * 16,
                                 ctl + CW_CNT + l * 16 * CNT_STRIDE, (int*)(ws + WS_TOKIDX), (float*)(ws + WS_GATE), wave, lane);
#endif
            for (int ch = vcu; ch < M / 64; ch += G)
                ln1_router_chunk((LAS RouteLds*)(lds + ROUTE_OFF), lds, ch * 64, XB, XB, INP(24) + l * D, INP(25) + l * D, (const bf16*)(ws + WS_WR) + (size_t)l * 64 * D, INP(27) + l * 4, INP(29) + l * 16,
                                 ctl + CW_CNT + l * 16 * CNT_STRIDE, (int*)(ws + WS_TOKIDX), (float*)(ws + WS_GATE), wave, lane);
            }
            SEAM();
        }
        if (EN_MOE1 && IN(PH_MOE1)) {
            PHASE_PTRS();
            for (int rep_ = 0; rep_ < DUP_MOE1; ++rep_) {
            moe_tab_build((LAS int*)(lds + MOETAB_OFF), ctl + CW_CNT + l * 16 * CNT_STRIDE, wave == 0 && lane == 0); const MoeTab T{(LAS const int*)(lds + MOETAB_OFF)};
            { SchedMoe<2> Sc{vcu, G, T, (const char*)XB, (const char*)(ws + WS_WBUF + (size_t)(l & 1) * WBUF_STRIDE + WB_W13), (size_t)512 * D * 2, (const int*)(ws + WS_TOKIDX), 0};
              EpiMoe1 E{(bf16*)(ws + WS_ACT), (const float*)(ws + WS_GATE), T};
              pg8::gemm_phase<EpiMoe1, SchedMoe<2>, true>(lds, D, Sc, E, wave);
#if defined(PROBE_MOE1A)
              pg8::gemm_phase<EpiMoe1, SchedMoe<2>, true>(lds, D, Sc, E, wave);
#endif
            }
            { SchedSq Sc{vcu, G, (const char*)XB, (const char*)(ws + WS_WBUF + (size_t)(l & 1) * WBUF_STRIDE + WB_WG), TILEB, TILEB, 0};
              EpiPle<1> E{(bf16*)(ws + WS_YP), INP(34) + l * D};
              pg8::gemm_phase<EpiPle<1>, SchedSq>(lds, D, Sc, E, wave); }
            if (l + 1 < DEPTH) {
                int x2 = 2 * T.pre(16) - G; x2 = x2 < 0 ? 0 : (x2 > G / 2 ? G / 2 : x2);
                if (vcu >= x2) WCV_LAYER(l + 1, (vcu - x2) * NWAVES + wave, (G - x2) * NWAVES, 0, WCV_SPLIT_IT, (size_t)0, WCV_SPLIT_PB);
            }
            }
            SEAM();
        }
        if (EN_MOE2 && IN(PH_MOE2)) {
            PHASE_PTRS();
            for (int rep_ = 0; rep_ < DUP_MOE2; ++rep_) {
            moe_tab_build((LAS int*)(lds + MOETAB_OFF), ctl + CW_CNT + l * 16 * CNT_STRIDE, wave == 0 && lane == 0); const MoeTab T{(LAS const int*)(lds + MOETAB_OFF)};
            SchedMoe<4> Sc{vcu, G, T, (const char*)(ws + WS_ACT), (const char*)(ws + WS_WBUF + (size_t)(l & 1) * WBUF_STRIDE + WB_W2), (size_t)D * 256 * 2, (const int*)(ws + WS_TOKIDX), (size_t)256 * 256 * 2};
            EpiMoe2 E{(bf16*)(ws + WS_YMOE), (const int*)(ws + WS_TOKIDX), T};
            pg8::gemm_phase<EpiMoe2, SchedMoe<4>>(lds, 256, Sc, E, wave);
            if (l + 1 < DEPTH) {
                int x3 = 4 * T.pre(16) - 2 * G; x3 = x3 < 0 ? 0 : (x3 > G / 2 ? G / 2 : x3);
                if (vcu >= x3) WCV_LAYER(l + 1, (vcu - x3) * NWAVES + wave, (G - x3) * NWAVES, WCV_SPLIT_IT, 6784, WCV_SPLIT_PB, (size_t)M * 256);
            }
            }
            SEAM();
        }
        if (EN_LN2 && IN(PH_LN2)) {
            PHASE_PTRS();
            for (int rep_ = 0; rep_ < DUP_LN2; ++rep_) {
            int ln = lane; asm volatile("" : "+v"(ln));
            const bf16* YM = (const bf16*)(ws + WS_YMOE); const bf16* YP = (const bf16*)(ws + WS_YP);
            const bool lastl = (l == DEPTH - 1);
#if defined(PROBE_LN2)
            for (int m = gw; m < M; m += NGW)
                ln_row(XB + (size_t)m * D, DN_ALPHA, YM + (size_t)(2 * m) * D, YM + (size_t)(2 * m + 1) * D, YP + (size_t)m * D, INP(36) + l * D, INP(37) + l * D, (float*)nullptr, (bf16*)(ws + WS_STASH) + (size_t)m * D, ln);
#endif
            for (int m = gw; m < M; m += NGW)
                ln_row(XB + (size_t)m * D, DN_ALPHA, YM + (size_t)(2 * m) * D, YM + (size_t)(2 * m + 1) * D, YP + (size_t)m * D, INP(36) + l * D, INP(37) + l * D,
                       lastl ? a.out + (size_t)m * D : (float*)nullptr, lastl ? nullptr : XB + (size_t)m * D, ln);
            }
            if (l != DEPTH - 1) SEAM();
        }
    }
#undef IN
#undef SEAM
}
static void mk_launch(const Args& base, int ph, int l, int grid, hipStream_t stream) {
    Args a = base; a.ph_lo = ph; a.ph_hi = ph + 1; a.l_lo = l; a.l_hi = l + 1; a.single = 1;
    hipLaunchKernelGGL(mk_fwd, dim3(grid), dim3(NWAVES * 64), LDS_BYTES, stream, a);
}
extern "C" void kernel_launch(void* const* d_in, const int* in_sizes, int n_in, void* d_out, int out_size, void* d_ws, size_t ws_size, hipStream_t stream) {
    (void)in_sizes; (void)n_in; (void)out_size; (void)ws_size;
    static int grid = 0;
    if (grid == 0) {
        int dev = 0, cus = 0;
        if (hipGetDevice(&dev) != hipSuccess || hipDeviceGetAttribute(&cus, hipDeviceAttributeMultiprocessorCount, dev) != hipSuccess) { grid = -1; return; }
        if (hipFuncSetAttribute((const void*)mk_fwd, hipFuncAttributeMaxDynamicSharedMemorySize, LDS_BYTES) != hipSuccess) { grid = -1; return; }
        (void)hipGetLastError();
        grid = cus;
    }
    if (grid < 0) return;
    (void)hipMemsetAsync((char*)d_ws + WS_CTL, 0, CTL_ZERO_BYTES, stream);
    Args base{};
    for (int i = 0; i < 38; ++i) base.in[i] = (const float*)d_in[i];
    base.out = (float*)d_out; base.ws = (unsigned char*)d_ws;
    base.eid = nullptr; base.wts = nullptr;
#if defined(MK_PER_PHASE)
    mk_launch(base, PH_PRO, 0, grid, stream);
    for (int l = 0; l < DEPTH; ++l) for (int ph : {PH_IN, PH_HY, PH_HYT, PH_ATT, PH_POOL, PH_OUT, PH_LN1, PH_WCV, PH_MOE1, PH_MOE2, PH_LN2}) mk_launch(base, ph, l, grid, stream);
#else
    Args a = base; a.ph_lo = 0; a.ph_hi = PH_END; a.l_lo = 0; a.l_hi = DEPTH; a.single = 0;
    hipLaunchKernelGGL(mk_fwd, dim3(grid), dim3(NWAVES * 64), LDS_BYTES, stream, a);
#endif
}
```

```cpp
#include <hip/hip_runtime.h>
#include <stdint.h>
#include <math.h>
namespace pg8 {
#define PG8_LAS __attribute__((address_space(3)))
typedef unsigned short bf16_t;
typedef short bf16x8 __attribute__((ext_vector_type(8)));
typedef float f32x4 __attribute__((ext_vector_type(4)));
typedef unsigned u32x4 __attribute__((ext_vector_type(4)));
constexpr int BM = 256, BK = 64, HALF = 128, HTB = HALF * BK * 2  , STAGE_BYTES = 8 * HTB;

__host__ __device__ __forceinline__ int lds_byte(int r, int c) { const int st = (r >> 4) * 2 + (c >> 5), rr = r & 15, cc = c & 31, ob = rr * 64 + cc * 2; return st * 1024 + (ob ^ (((ob >> 9) & 1) << 5)); }
__host__ __device__ __forceinline__ void stage_rc(int b, int& R, int& C) { const int st = b / 1024, sb = b % 1024, swz = sb ^ (((sb >> 9) & 1) << 5); R = (st >> 1) * 16 + swz / 64; C = (st & 1) * 32 + (swz % 64) / 2; }
__host__ __device__ __forceinline__ int perm32(int rho) { const int n = rho >> 4, i = rho & 15; return 8 * (i >> 2) + 4 * n + (i & 3); }

struct Unit { const char* A; const char* B; int kind, pm, pn, aux; };

__device__ __forceinline__ unsigned cvt_pk_bf16(float lo, float hi) { unsigned r; asm volatile("v_cvt_pk_bf16_f32 %0, %1, %2" : "=v"(r) : "v"(lo), "v"(hi)); return r; }

template <class Epi, class Sched, bool GATHER = false>
__device__ __forceinline__ void gemm_phase(PG8_LAS unsigned char* lds, const int K_, const Sched& S, const Epi& E, const int wave_) {
    int K = K_; asm volatile("" : "+s"(K));
    int tid_; asm volatile("v_mbcnt_lo_u32_b32 %0, -1, 0\n\tv_mbcnt_hi_u32_b32 %0, -1, %0" : "=v"(tid_)); tid_ += wave_ * 64;
    const int tid = tid_, wid = __builtin_amdgcn_readfirstlane(tid >> 6), lane = tid & 63, wr = wid >> 2, wc = wid & 3, fr = lane & 15, fq = lane >> 4;
    const int nt = K / BK;
    unsigned voffA[2][2], voffN[2][2] = {{0u, 0u}, {0u, 0u}}, voffB[2]; int RA[2], CA[2];
#pragma unroll
    for (int i = 0; i < 2; ++i) { int R, C; stage_rc(tid * 16 + i * 8192, R, C); const int Rb = Epi::PERM ? ((R & ~31) + perm32(R & 31)) : R; RA[i] = R; CA[i] = C;
        voffA[0][i] = (unsigned)(R * K + C) * 2u; voffA[1][i] = (unsigned)((R + HALF) * K + C) * 2u; voffB[i] = (unsigned)(Rb * K + C) * 2u; }
    const size_t kstep = (size_t)(BK * 2);
    const size_t hstep = (size_t)HALF * K * 2;
    const unsigned ldsw = (unsigned)wid * 1024u;
    const int aoff = lds_byte(wr * 64 + fr, fq * 8), boff = lds_byte(wc * 32 + fr, fq * 8);
#define PG8_SA(b, h) (((b) * 2 + (h)) * HTB)
#define PG8_SB(b, h) ((4 + (b) * 2 + (h)) * HTB)
#define PG8_STAGE(bufoff, gbase, voff) do { _Pragma("unroll") for (int _i = 0; _i < 2; ++_i) \
        __builtin_amdgcn_global_load_lds((const unsigned*)((const char*)(gbase) + (voff)[_i]), (PG8_LAS unsigned*)(lds + (bufoff) + ldsw + _i * 8192), 16, 0, 0); } while (0)
#define PG8_LDA(dst, b, h) do { _Pragma("unroll") for (int m = 0; m < 4; ++m) _Pragma("unroll") for (int k = 0; k < 2; ++k) dst[m][k] = *(const PG8_LAS bf16x8*)(lds + PG8_SA(b, h) + aoff + m * 2048 + k * 1024); } while (0)
#define PG8_LDB(dst, b, h) do { _Pragma("unroll") for (int n = 0; n < 2; ++n) _Pragma("unroll") for (int k = 0; k < 2; ++k) dst[n][k] = *(const PG8_LAS bf16x8*)(lds + PG8_SB(b, h) + boff + n * 2048 + k * 1024); } while (0)
#define PG8_MMA(ai, bj, At, Bt) do { __builtin_amdgcn_s_setprio(1); _Pragma("unroll") for (int m = 0; m < 4; ++m) _Pragma("unroll") for (int n = 0; n < 2; ++n) _Pragma("unroll") for (int k = 0; k < 2; ++k) \
        acc[ai][bj][m][n] = __builtin_amdgcn_mfma_f32_16x16x32_bf16(Bt[n][k], At[m][k], acc[ai][bj][m][n], 0, 0, 0); __builtin_amdgcn_s_setprio(0); } while (0)
#define PG8_WAIT_V(n) asm volatile("s_waitcnt vmcnt(" #n ")" ::: "memory")
#define PG8_WAIT_L(n) asm volatile("s_waitcnt lgkmcnt(" #n ")" ::: "memory")
#define PG8_BAR __builtin_amdgcn_s_barrier()
#define PG8_SCHED __builtin_amdgcn_sched_barrier(0)
    Unit cur, nxt; int ui = 0;
    if (!S.next(0, cur)) return;
    if constexpr (GATHER) {
#pragma unroll
        for (int h = 0; h < 2; ++h)
#pragma unroll
            for (int i = 0; i < 2; ++i) voffA[h][i] = (unsigned)(S.arow(cur, h * HALF + RA[i]) * K + CA[i]) * 2u;
    }
    f32x4 acc[2][2][4][2];
#pragma unroll
    for (int a = 0; a < 2; ++a)
#pragma unroll
        for (int b = 0; b < 2; ++b)
#pragma unroll
            for (int m = 0; m < 4; ++m)
#pragma unroll
                for (int n = 0; n < 2; ++n) acc[a][b][m][n] = (f32x4){0.f, 0.f, 0.f, 0.f};
    bf16x8 At[4][2], B0[2][2], B1[2][2];
    const char* cA = cur.A; const char* cB = cur.B;
    PG8_STAGE(PG8_SB(0, 0), cB, voffB); PG8_STAGE(PG8_SB(0, 1), cB + hstep, voffB); PG8_STAGE(PG8_SA(0, 0), cA, voffA[0]); PG8_STAGE(PG8_SA(0, 1), cA, voffA[1]);
    if (wr == 1) PG8_BAR;
    PG8_WAIT_V(2); PG8_BAR;
    PG8_STAGE(PG8_SB(1, 0), cB + kstep, voffB); PG8_STAGE(PG8_SA(1, 0), cA + kstep, voffA[0]); PG8_STAGE(PG8_SB(1, 1), cB + hstep + kstep, voffB);
    PG8_WAIT_V(6); PG8_BAR;
    for (;;) {
        const bool has_next = S.next(ui + 1, nxt);
        const char* nA = has_next ? nxt.A : cA; const char* nB = has_next ? nxt.B : cB;
        if constexpr (GATHER) {
#pragma unroll
            for (int h = 0; h < 2; ++h)
#pragma unroll
                for (int i = 0; i < 2; ++i) voffN[h][i] = has_next ? (unsigned)(S.arow(nxt, h * HALF + RA[i]) * K + CA[i]) * 2u : voffA[h][i];
        }
#pragma unroll 1
        for (int t = 0; t < nt; t += 2) {
            const bool last = (t == nt - 2);
            const char* a1 = cA + (size_t)(t + 1) * kstep;
            const char* a2 = last ? nA : cA + (size_t)(t + 2) * kstep; const char* b2 = last ? nB : cB + (size_t)(t + 2) * kstep;
            const char* a3 = a2 + kstep; const char* b3 = b2 + kstep;
            PG8_LDB(B0, 0, 0); PG8_LDB(B1, 0, 1); PG8_SCHED; PG8_LDA(At, 0, 0); PG8_STAGE(PG8_SA(1, 1), a1, voffA[1]);
            if constexpr (GATHER) { if (last) {
#pragma unroll
                for (int h = 0; h < 2; ++h)
#pragma unroll
                    for (int i = 0; i < 2; ++i) voffA[h][i] = voffN[h][i]; } }
            PG8_WAIT_V(8); PG8_WAIT_L(0); PG8_BAR; PG8_MMA(0, 0, At, B0); PG8_MMA(0, 1, At, B1); PG8_BAR; PG8_SCHED;
            PG8_LDA(At, 0, 1); PG8_STAGE(PG8_SB(0, 0), b2, voffB); PG8_STAGE(PG8_SB(0, 1), b2 + hstep, voffB); PG8_STAGE(PG8_SA(0, 0), a2, voffA[0]);
            PG8_WAIT_V(8); PG8_WAIT_L(0); PG8_BAR; PG8_MMA(1, 0, At, B0); PG8_MMA(1, 1, At, B1); PG8_BAR; PG8_SCHED;
            PG8_LDB(B0, 1, 0); PG8_LDB(B1, 1, 1); PG8_SCHED; PG8_LDA(At, 1, 0); PG8_STAGE(PG8_SA(0, 1), a2, voffA[1]);
            PG8_WAIT_V(8); PG8_WAIT_L(0); PG8_BAR; PG8_MMA(0, 0, At, B0); PG8_MMA(0, 1, At, B1); PG8_BAR; PG8_SCHED;
            PG8_LDA(At, 1, 1); PG8_STAGE(PG8_SB(1, 0), b3, voffB); PG8_STAGE(PG8_SB(1, 1), b3 + hstep, voffB); PG8_STAGE(PG8_SA(1, 0), a3, voffA[0]);
            PG8_WAIT_V(8); PG8_WAIT_L(0); PG8_BAR; PG8_MMA(1, 0, At, B0); PG8_MMA(1, 1, At, B1); PG8_BAR; PG8_SCHED;
        }
        if (wr == 0) PG8_BAR;
        { Unit ce = cur; ce.pm = __builtin_amdgcn_readfirstlane(cur.pm); ce.pn = __builtin_amdgcn_readfirstlane(cur.pn); ce.kind = __builtin_amdgcn_readfirstlane(cur.kind); ce.aux = __builtin_amdgcn_readfirstlane(cur.aux); int fr_ = fr, fq_ = fq;
          asm volatile("" : "+s"(ce.pm), "+s"(ce.pn), "+s"(ce.kind), "+s"(ce.aux), "+v"(fr_), "+v"(fq_));
          E(acc, ce, wr, wc, fr_, fq_); }
        if (!has_next) break;
#pragma unroll
        for (int a = 0; a < 2; ++a)
#pragma unroll
            for (int b = 0; b < 2; ++b)
#pragma unroll
                for (int m = 0; m < 4; ++m)
#pragma unroll
                    for (int n = 0; n < 2; ++n) acc[a][b][m][n] = (f32x4){0.f, 0.f, 0.f, 0.f};
        cur = nxt; cA = nA; cB = nB; ++ui;
        if (wr == 1) PG8_BAR;
    }
    PG8_WAIT_V(0);
    PG8_BAR;
#undef PG8_SA
#undef PG8_SB
#undef PG8_STAGE
#undef PG8_LDA
#undef PG8_LDB
#undef PG8_MMA
#undef PG8_WAIT_V
#undef PG8_WAIT_L
#undef PG8_BAR
#undef PG8_SCHED
}
}
constexpr int D = 1024, NB = 4, S = 4096, M = NB * S, DEPTH = 4, INW = 2560;
constexpr float DN_ALPHA = 1.681792830507429f;
constexpr float QSCALE = 0.125f * 1.4426950408889634f;
constexpr int NWAVES = 8;
constexpr size_t MiB = 1u << 20;
constexpr size_t TILEB = (size_t)256 * D * 2;
constexpr size_t WS_CTL = 0, CTL_ZERO_BYTES = 1 * MiB;
constexpr size_t WS_CS = 1 * MiB;
constexpr size_t WS_WIN = 2 * MiB, WIN_LAYER = 5 * MiB;
constexpr size_t WS_XB = 22 * MiB;
constexpr size_t WS_QKP = 118 * MiB;
constexpr size_t WS_UVT = 158 * MiB;
constexpr size_t WS_MIXB = 198 * MiB;
constexpr size_t WS_STASH = 54 * MiB;
constexpr size_t WS_WOUT = 383 * MiB, WOUT_LAYER = 2 * MiB;
constexpr size_t WS_TOKIDX = 391 * MiB, WS_GATE = 392 * MiB;
constexpr size_t WS_YMOE = WS_QKP;
constexpr size_t WS_YP = 86 * MiB;
constexpr size_t WS_ACT = 230 * MiB;
constexpr size_t WS_WBUF = 288 * MiB, WBUF_STRIDE = 35 * MiB, WB_W13 = 0, WB_W2 = 16 * MiB, WB_WG = 24 * MiB, WB_WP = 26 * MiB, WB_PB = 27 * MiB;
constexpr size_t WS_KF = 262 * MiB, WS_PS = 278 * MiB, WS_HT = 280 * MiB;
constexpr size_t WS_WR = 256 * MiB;
constexpr int CW_BAR = 4096, CW_CNT = 8192, CNT_STRIDE = 64;

#define GAS __attribute__((address_space(1)))
#define LAS __attribute__((address_space(3)))
typedef unsigned short bf16;
typedef unsigned v4u __attribute__((ext_vector_type(4)));
typedef float f32x4 __attribute__((ext_vector_type(4)));
typedef short bf16x8 __attribute__((ext_vector_type(8)));
typedef GAS unsigned gu32;
typedef GAS unsigned long long gu64;
#define RLX_AGENT __ATOMIC_RELAXED, __HIP_MEMORY_SCOPE_AGENT
#define LDS_WAIT() asm volatile("s_waitcnt lgkmcnt(0)" ::: "memory")
#define VM_WAIT() asm volatile("s_waitcnt vmcnt(0)" ::: "memory")
__device__ __forceinline__ unsigned long long rt() { return __builtin_amdgcn_s_memrealtime(); }
__device__ __forceinline__ unsigned f2bf(float f) { unsigned u = __builtin_bit_cast(unsigned, f); return (u + 0x7fffu + ((u >> 16) & 1u)) >> 16; }
__device__ __forceinline__ unsigned pk2(float lo, float hi) { return f2bf(lo) | (f2bf(hi) << 16); }

#define XB_TMO      128
#define XB_XCNT(j)  (256  + 64 * (j))
#define XB_XSUB(j)  (1280 + 64 * (j))
#define XB_XGEN(j)  (2304 + 64 * (j))
#define XB_TOP      3328
#define XB_TOPGEN   3392
#define XCD_BAR_WORDS 3456
#define XB_SPIN_CAP (1u << 18)

__device__ __forceinline__ unsigned xb_ld(unsigned* p)              { return __hip_atomic_load(p, __ATOMIC_RELAXED, __HIP_MEMORY_SCOPE_AGENT); }
__device__ __forceinline__ unsigned xb_add(unsigned* p, unsigned v) { return __hip_atomic_fetch_add(p, v, __ATOMIC_RELAXED, __HIP_MEMORY_SCOPE_AGENT); }
__device__ __forceinline__ unsigned xb_xcc_id() { return (unsigned)__builtin_amdgcn_s_getreg((3 << 11) | 20) & 0xFu; }
#define XB_SPIN(cond, bar) do { unsigned _sp = 0; while (cond) { __builtin_amdgcn_s_sleep(1); \
    if ((++_sp & 255u) == 0u) { if (xb_ld(&(bar)[XB_TMO])) break; if (_sp > XB_SPIN_CAP) { atomicAdd(&(bar)[XB_TMO], 1u); break; } } } } while (0)

struct XcdBarrier {
    unsigned* bar; unsigned x;
    volatile LAS unsigned* st;
};

__device__ __forceinline__ unsigned mk_lane_id() { unsigned x; asm volatile("v_mbcnt_lo_u32_b32 %0, -1, 0\n\tv_mbcnt_hi_u32_b32 %0, -1, %0" : "=v"(x)); return x; }
__device__ __forceinline__ XcdBarrier xcd_barrier_post(unsigned* bar, volatile LAS unsigned* st, int wave) {
    XcdBarrier b; b.bar = bar; b.x = xb_xcc_id(); b.st = st;
    if (wave == 0 && mk_lane_id() == 0u) (void)xb_add(&bar[XB_XCNT(b.x)], 1u);
    return b;
}
__device__ __forceinline__ void xcd_barrier_complete(unsigned* bar, unsigned x, unsigned& nloc, unsigned& nx) {
    const unsigned G = gridDim.x * gridDim.y * gridDim.z;
    unsigned sum, cnt, mine, sp = 0u;
    for (;;) {
        sum = 0u; cnt = 0u; mine = 0u;
#pragma unroll
        for (unsigned j = 0; j < 16; ++j) { const unsigned c = xb_ld(&bar[XB_XCNT(j)]); sum += c; cnt += (c > 0u) ? 1u : 0u; mine = (j == x) ? c : mine; }
        if (sum == G) break;
        __builtin_amdgcn_s_sleep(1);
        if ((++sp & 255u) == 0u) { if (xb_ld(&bar[XB_TMO])) break; if (sp > XB_SPIN_CAP) { atomicAdd(&bar[XB_TMO], 1u); break; } }
    }
    nloc = mine > 0u ? mine : 1u; nx = cnt > 0u ? cnt : 1u;
}

__device__ __forceinline__ void xcd_barrier(const XcdBarrier& b, int wave) {
    asm volatile("" : "+s"(wave));
    const bool t0_ = (wave == 0) && (mk_lane_id() == 0u);
    asm volatile("s_waitcnt vmcnt(0)" ::: "memory");
    __syncthreads();
    if (t0_) {
        unsigned* bar = b.bar; unsigned bx_ = b.x; asm volatile("" : "+s"(bx_));
        __builtin_amdgcn_s_waitcnt(0);
        unsigned nloc = b.st[0], nx = b.st[1];
        if (nloc == 0u) { xcd_barrier_complete(bar, bx_, nloc, nx); b.st[0] = nloc; b.st[1] = nx; }
        const unsigned old = xb_add(&bar[XB_XSUB(bx_)], 1u);
        const unsigned gen = old / nloc;
        if (old + 1u == (gen + 1u) * nloc) {
            __builtin_amdgcn_fence(__ATOMIC_RELEASE, "agent");
            asm volatile("s_waitcnt vmcnt(0)" ::: "memory");
            const unsigned og = xb_add(&bar[XB_TOP], 1u);
            const unsigned tg = og / nx;
            if (og + 1u == (tg + 1u) * nx) xb_add(&bar[XB_TOPGEN], 1u);
            else XB_SPIN(xb_ld(&bar[XB_TOPGEN]) == tg, bar);
            __builtin_amdgcn_fence(__ATOMIC_ACQUIRE, "agent");
            xb_add(&bar[XB_XGEN(bx_)], 1u);
            asm volatile("s_waitcnt vmcnt(0)" ::: "memory");
        } else {
            XB_SPIN(xb_ld(&bar[XB_XGEN(bx_)]) == gen, bar);
            __builtin_amdgcn_fence(__ATOMIC_ACQUIRE, "agent");
            asm volatile("s_waitcnt vmcnt(0)" ::: "memory");
        }
    }
    __syncthreads();
}
__device__ __forceinline__ float bf2f(unsigned short b) { return __uint_as_float((unsigned)b << 16); }
#define MK_DPP(v, ctrl) __uint_as_float(__builtin_amdgcn_update_dpp(0, __float_as_uint(v), (ctrl), 0xF, 0xF, true))
__device__ __forceinline__ float xsum16(float v) { const auto r = __builtin_amdgcn_permlane16_swap(__float_as_uint(v), __float_as_uint(v), false, false); return __uint_as_float(r[0]) + __uint_as_float(r[1]); }
__device__ __forceinline__ float xsum32(float v) { const auto r = __builtin_amdgcn_permlane32_swap(__float_as_uint(v), __float_as_uint(v), false, false); return __uint_as_float(r[0]) + __uint_as_float(r[1]); }
__device__ __forceinline__ float wave_sum(float v) {
    v += MK_DPP(v, 0xB1); v += MK_DPP(v, 0x4E);
    v += MK_DPP(v, 0x141); v += MK_DPP(v, 0x140);
    return xsum32(xsum16(v));
}
__device__ __forceinline__ void p0_transpose_block(const float* W, int K, int N, int k0, int n0, bf16* WT, int mode, LAS float* scr, int lane) {
#pragma unroll 4
    for (int i = 0; i < 32; ++i) { const int kk = 2 * i + (lane >> 5); scr[kk * 33 + (lane & 31)] = W[(size_t)(k0 + kk) * N + n0 + (lane & 31)]; }
    LDS_WAIT(); asm volatile("" ::: "memory");
    const int c = lane & 7;
#pragma unroll 1
    for (int j = 0; j < 4; ++j) { const int n = (lane >> 3) + 8 * j; const LAS float* s = scr + (8 * c) * 33 + n;
        v4u o; o.x = pk2(s[0 * 33], s[1 * 33]); o.y = pk2(s[2 * 33], s[3 * 33]); o.z = pk2(s[4 * 33], s[5 * 33]); o.w = pk2(s[6 * 33], s[7 * 33]);
        const int f = n0 + n; const size_t drow = mode == 0 ? (size_t)n : (size_t)(8 * (f >> 2) + (f & 3) + (mode == 2 ? 4 : 0));
        *(GAS v4u*)(WT + drow * K + k0 + 8 * c) = o; }
    LDS_WAIT(); asm volatile("" ::: "memory");
}
template <class TX> __device__ __forceinline__ void ln_row(const TX* x0, float a, const bf16* y1, const bf16* y2, const bf16* y3, const float* g, const float* b, float* of, bf16* ob, int lane) {
    f32x4 v[4]; float s = 0.f;
#pragma unroll
    for (int j = 0; j < 4; ++j) { const int c = 4 * lane + 256 * j;
        if constexpr (sizeof(TX) == 4) v[j] = *(const GAS f32x4*)(x0 + c) * a;
        else { const unsigned long long w = *(const GAS unsigned long long*)(x0 + c); v[j] = (f32x4){bf2f((bf16)w), bf2f((bf16)(w >> 16)), bf2f((bf16)(w >> 32)), bf2f((bf16)(w >> 48))} * a; }
        if (y1) { const unsigned long long w = *(const GAS unsigned long long*)(y1 + c); v[j] += (f32x4){bf2f((bf16)w), bf2f((bf16)(w >> 16)), bf2f((bf16)(w >> 32)), bf2f((bf16)(w >> 48))}; }
        if (y2) { const unsigned long long w = *(const GAS unsigned long long*)(y2 + c); v[j] += (f32x4){bf2f((bf16)w), bf2f((bf16)(w >> 16)), bf2f((bf16)(w >> 32)), bf2f((bf16)(w >> 48))}; }
        if (y3) { const unsigned long long w = *(const GAS unsigned long long*)(y3 + c); v[j] += (f32x4){bf2f((bf16)w), bf2f((bf16)(w >> 16)), bf2f((bf16)(w >> 32)), bf2f((bf16)(w >> 48))}; }
        s += (v[j].x + v[j].y) + (v[j].z + v[j].w); }
    const float mean = wave_sum(s) * (1.f / D); float s2 = 0.f;
#pragma unroll
    for (int j = 0; j < 4; ++j) { v[j] = v[j] - mean; s2 += (v[j].x * v[j].x + v[j].y * v[j].y) + (v[j].z * v[j].z + v[j].w * v[j].w); }
    const float rstd = __builtin_amdgcn_rsqf(wave_sum(s2) * (1.f / D) + 1e-5f);
#pragma unroll
    for (int j = 0; j < 4; ++j) { const int c = 4 * lane + 256 * j; const f32x4 o = v[j] * rstd * *(const GAS f32x4*)(g + c) + *(const GAS f32x4*)(b + c);
        if (of) *(GAS f32x4*)(of + c) = o;
        if (ob) *(GAS unsigned long long*)(ob + c) = (unsigned long long)pk2(o.x, o.y) | ((unsigned long long)pk2(o.z, o.w) << 32); }
}

__device__ __forceinline__ void ln2_row4(const bf16* x0, float a, const bf16* ym, const bf16* yp, const float* g, const float* b, float* of, bf16* ob, int lane) {
    f32x4 v[4][4]; float s[4];
#pragma unroll
    for (int r = 0; r < 4; ++r) { s[r] = 0.f;
#pragma unroll
        for (int j = 0; j < 4; ++j) { const int c = 4 * lane + 256 * j;
            const unsigned long long w0 = *(const GAS unsigned long long*)(x0 + (size_t)r * D + c), w1 = *(const GAS unsigned long long*)(ym + (size_t)r * 2 * D + c), w2 = *(const GAS unsigned long long*)(ym + (size_t)r * 2 * D + D + c), w3 = *(const GAS unsigned long long*)(yp + (size_t)r * D + c);
            v[r][j] = (f32x4){bf2f((bf16)w0), bf2f((bf16)(w0 >> 16)), bf2f((bf16)(w0 >> 32)), bf2f((bf16)(w0 >> 48))} * a;
            v[r][j] += (f32x4){bf2f((bf16)w1), bf2f((bf16)(w1 >> 16)), bf2f((bf16)(w1 >> 32)), bf2f((bf16)(w1 >> 48))};
            v[r][j] += (f32x4){bf2f((bf16)w2), bf2f((bf16)(w2 >> 16)), bf2f((bf16)(w2 >> 32)), bf2f((bf16)(w2 >> 48))};
            v[r][j] += (f32x4){bf2f((bf16)w3), bf2f((bf16)(w3 >> 16)), bf2f((bf16)(w3 >> 32)), bf2f((bf16)(w3 >> 48))};
            s[r] += (v[r][j].x + v[r][j].y) + (v[r][j].z + v[r][j].w); } }
    float rstd[4];
#pragma unroll
    for (int r = 0; r < 4; ++r) { const float mean = wave_sum(s[r]) * (1.f / D); float s2 = 0.f;
#pragma unroll
        for (int j = 0; j < 4; ++j) { v[r][j] = v[r][j] - mean; s2 += (v[r][j].x * v[r][j].x + v[r][j].y * v[r][j].y) + (v[r][j].z * v[r][j].z + v[r][j].w * v[r][j].w); }
        rstd[r] = __builtin_amdgcn_rsqf(wave_sum(s2) * (1.f / D) + 1e-5f); }
#pragma unroll
    for (int j = 0; j < 4; ++j) { const int c = 4 * lane + 256 * j; const f32x4 gg = *(const GAS f32x4*)(g + c), bb = *(const GAS f32x4*)(b + c);
#pragma unroll
        for (int r = 0; r < 4; ++r) { const f32x4 o = v[r][j] * rstd[r] * gg + bb;
            if (of) *(GAS f32x4*)(of + (size_t)r * D + c) = o;
            if (ob) *(GAS unsigned long long*)(ob + (size_t)r * D + c) = (unsigned long long)pk2(o.x, o.y) | ((unsigned long long)pk2(o.z, o.w) << 32); } }
}

struct SchedIn {
    int vcu, G; const char* xb; const char* wsw; const char* wnm;
    __device__ __forceinline__ bool next(int i, pg8::Unit& u) const {
        const int L = i * G + vcu; if (L >= 640) return false;
        const int t = L / 10, j = L % 10;
        const int sw = __builtin_amdgcn_readfirstlane((unsigned)(j + 27) >> 5);
        const int jj = j - 5 * sw; const char* tp = xb + (size_t)t * TILEB; const char* wp = (sw ? wsw : wnm) + (size_t)jj * TILEB;
        u.kind = sw; u.pm = sw ? jj : t; u.pn = sw ? t : jj; u.A = sw ? wp : tp; u.B = sw ? tp : wp;
        u.aux = 0; return true;
    }
};
struct EpiIn {
    static constexpr bool PERM = true;
    bf16* qkp; bf16* uvt; const float* cs;
    __device__ __forceinline__ void operator()(const pg8::f32x4 (&acc)[2][2][4][2], const pg8::Unit& u, int wr, int wc, int fr, int fq) const {
        bf16* base = u.kind == 0 ? qkp : uvt; const int ldc = u.kind == 0 ? 1280 : M;
        const int row0 = u.pm * 256 + wr * 64 + fr, col0 = u.pn * 256 + wc * 32 + 8 * fq;
        const bool rope = (u.kind == 0) && (u.pn < 4) && ((wc & 1) == 0);
        const float sc = (u.kind == 0 && u.pn < 2) ? QSCALE : 1.f;
        const float sgn = fq == 0 ? -1.f : 1.f;
        const bool vperm = (u.kind == 1) && (u.pm >= 3);
#pragma unroll
        for (int ai = 0; ai < 2; ++ai)
#pragma unroll
            for (int m = 0; m < 4; ++m) { const int row = row0 + ai * 128 + m * 16; bf16* rowp = base + (size_t)row * ldc + col0;
                f32x4 cv0 = {1.f, 1.f, 1.f, 1.f}, cv1 = cv0, sv0 = {0.f, 0.f, 0.f, 0.f}, sv1 = sv0;
                if (rope && fq < 2) { const float* t = cs + (size_t)(row & (S - 1)) * 16; cv0 = *(const f32x4*)t; cv1 = *(const f32x4*)(t + 4); sv0 = *(const f32x4*)(t + 8) * sgn; sv1 = *(const f32x4*)(t + 12) * sgn; }
#pragma unroll
                for (int bj = 0; bj < 2; ++bj) { f32x4 v0 = acc[ai][bj][m][0], v1 = acc[ai][bj][m][1];
                    if (rope) { f32x4 p0, p1;
#pragma unroll
                        for (int e = 0; e < 4; ++e) { const auto r0 = __builtin_amdgcn_permlane16_swap(__float_as_uint(v0[e]), __float_as_uint(v0[e]), false, false), r1 = __builtin_amdgcn_permlane16_swap(__float_as_uint(v1[e]), __float_as_uint(v1[e]), false, false);
                            p0[e] = __uint_as_float((fq & 1) ? r0[0] : r0[1]); p1[e] = __uint_as_float((fq & 1) ? r1[0] : r1[1]); }
                        v0 = v0 * cv0 + p0 * sv0; v1 = v1 * cv1 + p1 * sv1; }
                    v0 = v0 * sc; v1 = v1 * sc;
                    pg8::u32x4 w; w.x = pg8::cvt_pk_bf16(v0[0], v0[1]); w.y = pg8::cvt_pk_bf16(v0[2], v0[3]); w.z = pg8::cvt_pk_bf16(v1[0], v1[1]); w.w = pg8::cvt_pk_bf16(v1[2], v1[3]);
                    if (vperm) {
                        bf16* gp = rowp + bj * 128 - (fq & 1) * 8;
                        typedef unsigned u32x2 __attribute__((ext_vector_type(2)));
                        *(u32x2*)(gp + ((fq & 1) ? 4 : 0)) = (u32x2){w.x, w.y}; *(u32x2*)(gp + ((fq & 1) ? 12 : 8)) = (u32x2){w.z, w.w};
                    } else *(pg8::u32x4*)(rowp + bj * 128) = w; } }
    }
};

struct SchedOut {
    int vcu, G; const char* a; const char* w;
    __device__ __forceinline__ bool next(int i, pg8::Unit& u) const {
        const int L = i * G + vcu; if (L >= 256) return false;
        u.kind = 0; u.pm = L >> 2; u.pn = L & 3; u.aux = 0; u.A = a + (size_t)u.pm * TILEB; u.B = w + (size_t)u.pn * TILEB; return true;
    }
};
struct EpiRes {
    static constexpr bool PERM = true;
    bf16* XB;
    __device__ __forceinline__ void operator()(const pg8::f32x4 (&acc)[2][2][4][2], const pg8::Unit& u, int wr, int wc, int fr, int fq) const {
        const int row0 = u.pm * 256 + wr * 64 + fr, col0 = u.pn * 256 + wc * 32 + 8 * fq;
#pragma unroll
        for (int ai = 0; ai < 2; ++ai)
#pragma unroll
            for (int m = 0; m < 4; ++m) { bf16* rowp = XB + (size_t)(row0 + ai * 128 + m * 16) * D + col0;
#pragma unroll
                for (int bj = 0; bj < 2; ++bj) { pg8::u32x4* p = (pg8::u32x4*)(rowp + bj * 128); const pg8::u32x4 x = *p; const pg8::f32x4 v0 = acc[ai][bj][m][0], v1 = acc[ai][bj][m][1];
                    pg8::u32x4 w; w.x = pg8::cvt_pk_bf16(bf2f((bf16)x.x) * DN_ALPHA + v0[0], bf2f((bf16)(x.x >> 16)) * DN_ALPHA + v0[1]); w.y = pg8::cvt_pk_bf16(bf2f((bf16)x.y) * DN_ALPHA + v0[2], bf2f((bf16)(x.y >> 16)) * DN_ALPHA + v0[3]);
                    w.z = pg8::cvt_pk_bf16(bf2f((bf16)x.z) * DN_ALPHA + v1[0], bf2f((bf16)(x.z >> 16)) * DN_ALPHA + v1[1]); w.w = pg8::cvt_pk_bf16(bf2f((bf16)x.w) * DN_ALPHA + v1[2], bf2f((bf16)(x.w >> 16)) * DN_ALPHA + v1[3]);
                    *p = w; } }
    }
};
struct RouteLds { unsigned lcnt[16]; unsigned gbase[16]; int e0[64], e1[64]; unsigned r0[64], r1[64]; float g0[64], g1[64]; };
constexpr int RT_PITCH = 2064;
template <int DRY = 0> __device__ __forceinline__ void ln1_router_chunk(LAS RouteLds* R, LAS unsigned char* tile, int row0, bf16* XB, bf16* XOUT, const float* g, const float* b, const bf16* wrt, const float* bgc, const float* bgf,
                                                 gu32* cnt, int* tokidx, float* gate, int wave, int lane) {
    const int tidl = wave * 64 + lane;
    if (tidl < 16) R->lcnt[tidl] = 0u;
#pragma unroll 2
    for (int r = 0; r < 8; ++r) { const int rl = wave * 8 + r; bf16* xbrow = XB + (size_t)(row0 + rl) * D; f32x4 v[4]; float s = 0.f;
#pragma unroll
        for (int j = 0; j < 4; ++j) { const unsigned long long w = *(const GAS unsigned long long*)(xbrow + 4 * lane + 256 * j);
            v[j] = (f32x4){bf2f((bf16)w), bf2f((bf16)(w >> 16)), bf2f((bf16)(w >> 32)), bf2f((bf16)(w >> 48))}; s += (v[j].x + v[j].y) + (v[j].z + v[j].w); }
        const float mean = wave_sum(s) * (1.f / D); float s2 = 0.f;
#pragma unroll
        for (int j = 0; j < 4; ++j) { v[j] = v[j] - mean; s2 += (v[j].x * v[j].x + v[j].y * v[j].y) + (v[j].z * v[j].z + v[j].w * v[j].w); }
        const float rstd = __builtin_amdgcn_rsqf(wave_sum(s2) * (1.f / D) + 1e-5f);
#pragma unroll
        for (int j = 0; j < 4; ++j) { const int c = 4 * lane + 256 * j; const f32x4 o = v[j] * rstd * *(const GAS f32x4*)(g + c) + *(const GAS f32x4*)(b + c);
            const unsigned w0 = pk2(o.x, o.y), w1 = pk2(o.z, o.w);
            *(GAS unsigned long long*)(XOUT + (size_t)(row0 + rl) * D + c) = (unsigned long long)w0 | ((unsigned long long)w1 << 32);
            LAS unsigned* tp = (LAS unsigned*)(tile + rl * RT_PITCH + c * 2); tp[0] = w0; tp[1] = w1; } }
    LDS_WAIT(); __syncthreads();
    if (DRY == 1) return;
    typedef float f32x16_t __attribute__((ext_vector_type(16)));
    f32x16_t pacc;
#pragma unroll
    for (int r = 0; r < 16; ++r) pacc[r] = 0.f;
    { const int rt = wave & 1, kq = wave >> 1, r32 = lane & 31, hi = lane >> 5;
      LAS const unsigned char* ap = tile + (32 * rt + r32) * RT_PITCH + (256 * kq + 8 * hi) * 2;
      const bf16* bh = wrt + (size_t)r32 * D + 256 * kq + 8 * hi; const bf16* bl = bh + 32 * D;
#pragma unroll 4
      for (int ks = 0; ks < 16; ++ks) { const bf16x8 af = *(LAS const bf16x8*)(ap + ks * 32), bhf = *(const GAS bf16x8*)(bh + ks * 16), blf = *(const GAS bf16x8*)(bl + ks * 16);
          pacc = __builtin_amdgcn_mfma_f32_32x32x16_bf16(af, bhf, pacc, 0, 0, 0); pacc = __builtin_amdgcn_mfma_f32_32x32x16_bf16(af, blf, pacc, 0, 0, 0); } }
    LDS_WAIT(); __syncthreads();
    if (DRY == 2) return;
    { const int rt = wave & 1, kq = wave >> 1, r32 = lane & 31, hi = lane >> 5;
      LAS float* P = (LAS float*)tile + (kq * 64 + rt * 32) * 33 + r32;
#pragma unroll
      for (int r = 0; r < 16; ++r) P[((r & 3) + 8 * (r >> 2) + 4 * hi) * 33] = pacc[r]; }
    LDS_WAIT(); __syncthreads();
    if (wave == 0) {
        float my[20];
#pragma unroll
        for (int i = 0; i < 20; ++i) { float t = 0.f;
#pragma unroll
            for (int q = 0; q < 4; ++q) t += ((LAS const float*)tile)[(q * 64 + lane) * 33 + i];
            my[i] = t; }
        const int rl = lane;
        float pg[4], mx = -INFINITY, sum = 0.f;
#pragma unroll
        for (int j = 0; j < 4; ++j) { pg[j] = my[j] + bgc[j]; mx = fmaxf(mx, pg[j]); }
#pragma unroll
        for (int j = 0; j < 4; ++j) { pg[j] = expf(pg[j] - mx); sum += pg[j]; }
        int gi = 0; float gw = pg[0];
#pragma unroll
        for (int j = 1; j < 4; ++j) if (pg[j] > gw) { gw = pg[j]; gi = j; }
        gw /= sum;
        float fs[4]; mx = -INFINITY;
#pragma unroll
        for (int j = 0; j < 4; ++j) { float t = 0.f;
#pragma unroll
            for (int q = 0; q < 4; ++q) if (q == gi) t = my[4 + q * 4 + j] + bgf[q * 4 + j];
            fs[j] = t; mx = fmaxf(mx, t); }
#pragma unroll
        for (int j = 0; j < 4; ++j) fs[j] = expf(fs[j] - mx);
        int t0 = 0; float v0 = fs[0];
#pragma unroll
        for (int j = 1; j < 4; ++j) if (fs[j] > v0) { v0 = fs[j]; t0 = j; }
        int t1 = -1; float v1 = -1.f;
#pragma unroll
        for (int j = 0; j < 4; ++j) if (j != t0 && fs[j] > v1) { v1 = fs[j]; t1 = j; }
        const float ts = v0 + v1; const int e0 = gi * 4 + t0, e1 = gi * 4 + t1;
        R->e0[rl] = e0; R->e1[rl] = e1; R->g0[rl] = gw * (v0 / ts); R->g1[rl] = gw * (v1 / ts);
        R->r0[rl] = __hip_atomic_fetch_add(&R->lcnt[e0], 1u, __ATOMIC_RELAXED, __HIP_MEMORY_SCOPE_WORKGROUP);
        R->r1[rl] = __hip_atomic_fetch_add(&R->lcnt[e1], 1u, __ATOMIC_RELAXED, __HIP_MEMORY_SCOPE_WORKGROUP);
    }
    LDS_WAIT(); __syncthreads();
    if (DRY == 3) return;
    if (tidl < 16) { const unsigned n = R->lcnt[tidl]; R->gbase[tidl] = n ? __hip_atomic_fetch_add(cnt + tidl * CNT_STRIDE, n, RLX_AGENT) : 0u; }
    LDS_WAIT(); __syncthreads();
    if (tidl < 64) { const int rl = tidl, tok = row0 + rl; const int e0 = R->e0[rl], e1 = R->e1[rl]; const unsigned p0 = R->gbase[e0] + R->r0[rl], p1 = R->gbase[e1] + R->r1[rl];
        tokidx[(size_t)e0 * M + p0] = tok * 2; gate[(size_t)e0 * M + p0] = R->g0[rl]; tokidx[(size_t)e1 * M + p1] = tok * 2 + 1; gate[(size_t)e1 * M + p1] = R->g1[rl]; }
    LDS_WAIT(); __syncthreads();
}

struct MoeTab { LAS const int* p;
    __device__ __forceinline__ int cnt(int e) const { return __builtin_amdgcn_readfirstlane(p[e]); }
    __device__ __forceinline__ int pre(int e) const { return __builtin_amdgcn_readfirstlane(p[16 + e]); } };
__device__ __forceinline__ void moe_tab_build(LAS int* p, const gu32* cnt, bool t0) {
    if (t0) { int acc = 0;
        for (int e = 0; e < 16; ++e) { const int c = (int)__hip_atomic_load(cnt + e * CNT_STRIDE, RLX_AGENT); p[e] = c; p[16 + e] = acc; acc += (c + 255) >> 8; }
        p[32] = acc; }
    __syncthreads();
}
template <int NPN> struct SchedMoe {
    int vcu, G; MoeTab T; const char* a; const char* w; size_t wexp  ; const int* tokidx; size_t atile  ;
    __device__ __forceinline__ bool next(int i, pg8::Unit& u) const {
        const int L = i * G + vcu; if (L >= T.pre(16) * NPN) return false;
        const int tile = L / NPN; u.pn = L % NPN; int e = 0;
#pragma unroll
        for (int st = 8; st >= 1; st >>= 1) if (tile >= T.pre(e + st)) e += st;
        u.aux = e; u.pm = tile - T.pre(e); u.kind = tile;
        u.A = a + (size_t)tile * atile; u.B = w + (size_t)e * wexp + (size_t)u.pn * 256 * (wexp / (NPN * 256)); return true;
    }
    __device__ __forceinline__ int arow(const pg8::Unit& u, int r) const {
        const int rank = u.pm * 256 + r; const int c = T.cnt(u.aux);
        return rank < c ? (tokidx[(size_t)u.aux * M + rank] >> 1) : 0;
    }
};
struct EpiMoe1 {
    static constexpr bool PERM = true;
    bf16* act; const float* gate; MoeTab T;
    __device__ __forceinline__ void operator()(const pg8::f32x4 (&acc)[2][2][4][2], const pg8::Unit& u, int wr, int wc, int fr, int fq) const {
        const int cnt = T.cnt(u.aux);
#pragma unroll
        for (int ai = 0; ai < 2; ++ai)
#pragma unroll
            for (int m = 0; m < 4; ++m) { const int r = ai * 128 + wr * 64 + m * 16 + fr, rank = u.pm * 256 + r;
                const float gt = rank < cnt ? gate[(size_t)u.aux * M + rank] : 0.f;
                bf16* rowp = act + ((size_t)u.kind * 256 + r) * 256 + u.pn * 128 + wc * 16 + 4 * fq;
#pragma unroll
                for (int bj = 0; bj < 2; ++bj) { const pg8::f32x4 av = acc[ai][bj][m][0], cv = acc[ai][bj][m][1]; float y[4];
#pragma unroll
                    for (int e = 0; e < 4; ++e) y[e] = av[e] * __builtin_amdgcn_rcpf(1.f + __builtin_amdgcn_exp2f(av[e] * -1.4426950408889634f)) * cv[e] * gt;
                    *(unsigned long long*)(rowp + bj * 64) = (unsigned long long)pg8::cvt_pk_bf16(y[0], y[1]) | ((unsigned long long)pg8::cvt_pk_bf16(y[2], y[3]) << 32); } }
    }
};
struct EpiMoe2 {
    static constexpr bool PERM = true;
    bf16* ymoe; const int* tokidx; MoeTab T;
    __device__ __forceinline__ void operator()(const pg8::f32x4 (&acc)[2][2][4][2], const pg8::Unit& u, int wr, int wc, int fr, int fq) const {
        const int cnt = T.cnt(u.aux);
#pragma unroll
        for (int ai = 0; ai < 2; ++ai)
#pragma unroll
            for (int m = 0; m < 4; ++m) { const int r = ai * 128 + wr * 64 + m * 16 + fr, rank = u.pm * 256 + r;
                if (rank < cnt) { bf16* rowp = ymoe + (size_t)tokidx[(size_t)u.aux * M + rank] * D + u.pn * 256 + wc * 32 + 8 * fq;
#pragma unroll
                    for (int bj = 0; bj < 2; ++bj) { const pg8::f32x4 v0 = acc[ai][bj][m][0], v1 = acc[ai][bj][m][1];
                        pg8::u32x4 w; w.x = pg8::cvt_pk_bf16(v0[0], v0[1]); w.y = pg8::cvt_pk_bf16(v0[2], v0[3]); w.z = pg8::cvt_pk_bf16(v1[0], v1[1]); w.w = pg8::cvt_pk_bf16(v1[2], v1[3]);
                        *(pg8::u32x4*)(rowp + bj * 128) = w; } } }
    }
};
struct SchedSq {
    int vcu, G; const char* a; const char* w; size_t astep, wstep; int vfirst;
    __device__ __forceinline__ bool next(int i, pg8::Unit& u) const {
        if (vcu < vfirst || vcu >= vfirst + G) return false;
        const int L = i * G + (vcu - vfirst); if (L >= 256) return false;
        u.kind = 0; u.pm = L >> 2; u.pn = L & 3; u.aux = 0; u.A = a + (size_t)u.pm * astep; u.B = w + (size_t)u.pn * wstep; return true;
    }
};
template <int GATED> struct EpiPle {
    static constexpr bool PERM = true;
    bf16* yp; const float* bg;
    __device__ __forceinline__ void operator()(const pg8::f32x4 (&acc)[2][2][4][2], const pg8::Unit& u, int wr, int wc, int fr, int fq) const {
        const int row0 = u.pm * 256 + wr * 64 + fr, col0 = u.pn * 256 + wc * 32 + 8 * fq;
#pragma unroll
        for (int ai = 0; ai < 2; ++ai)
#pragma unroll
            for (int m = 0; m < 4; ++m) { bf16* rowp = yp + (size_t)(row0 + ai * 128 + m * 16) * D + col0;
#pragma unroll
                for (int bj = 0; bj < 2; ++bj) { pg8::f32x4 v0 = acc[ai][bj][m][0], v1 = acc[ai][bj][m][1];
                    if (GATED) { const pg8::f32x4 b0 = *(const pg8::f32x4*)(bg + col0 + bj * 128), b1 = *(const pg8::f32x4*)(bg + col0 + bj * 128 + 4); const pg8::u32x4 y = *(const pg8::u32x4*)(rowp + bj * 128);
                        const float yf[8] = {bf2f((bf16)y.x), bf2f((bf16)(y.x >> 16)), bf2f((bf16)y.y), bf2f((bf16)(y.y >> 16)), bf2f((bf16)y.z), bf2f((bf16)(y.z >> 16)), bf2f((bf16)y.w), bf2f((bf16)(y.w >> 16))};
#pragma unroll
                        for (int e = 0; e < 4; ++e) { v0[e] = yf[e] * __builtin_amdgcn_rcpf(1.f + __builtin_amdgcn_exp2f((v0[e] + b0[e]) * -1.4426950408889634f)); v1[e] = yf[4 + e] * __builtin_amdgcn_rcpf(1.f + __builtin_amdgcn_exp2f((v1[e] + b1[e]) * -1.4426950408889634f)); } }
                    pg8::u32x4 w; w.x = pg8::cvt_pk_bf16(v0[0], v0[1]); w.y = pg8::cvt_pk_bf16(v0[2], v0[3]); w.z = pg8::cvt_pk_bf16(v1[0], v1[1]); w.w = pg8::cvt_pk_bf16(v1[2], v1[3]);
                    *(pg8::u32x4*)(rowp + bj * 128) = w; } }
    }
};
namespace att {
typedef float f32x16 __attribute__((ext_vector_type(16)));
constexpr int KSLOT = 8192, VSLOT = 16384, LDS_K = 0, LDS_V = 2 * KSLOT, ATT_LDS = 2 * KSLOT + 2 * VSLOT;
__device__ __forceinline__ bf16x8 pack8(const f32x16& p, int b) {
    v4u w; w.x = pg8::cvt_pk_bf16(p[b], p[b + 1]); w.y = pg8::cvt_pk_bf16(p[b + 2], p[b + 3]); w.z = pg8::cvt_pk_bf16(p[b + 4], p[b + 5]); w.w = pg8::cvt_pk_bf16(p[b + 6], p[b + 7]);
    return __builtin_bit_cast(bf16x8, w);
}
constexpr float THR2 = 8.f;
__device__ __forceinline__ void qkt(f32x16& p0, f32x16& p1, LAS const unsigned char* ks, const bf16x8 (&qf)[4], int r32, int hi) {
#pragma unroll
    for (int r = 0; r < 16; ++r) { p0[r] = 0.f; p1[r] = 0.f; }
    LAS const unsigned char* kb = ks + hi * 1024 + r32 * 16;
#pragma unroll
    for (int kk = 0; kk < 4; ++kk) {
        const bf16x8 a0 = *(LAS const bf16x8*)(kb + kk * 2048), a1 = *(LAS const bf16x8*)(kb + kk * 2048 + 512);
        p0 = __builtin_amdgcn_mfma_f32_32x32x16_bf16(a0, qf[kk], p0, 0, 0, 0);
        p1 = __builtin_amdgcn_mfma_f32_32x32x16_bf16(a1, qf[kk], p1, 0, 0, 0);
    }
}
__device__ __forceinline__ void partialSM(f32x16& p0, f32x16& p1, float& m, float& alpha) {
    float pmax = fmaxf(p0[0], p1[0]);
#pragma unroll
    for (int r = 1; r < 16; ++r) pmax = fmaxf(pmax, fmaxf(p0[r], p1[r]));
    { const auto rr = __builtin_amdgcn_permlane32_swap(__float_as_uint(pmax), __float_as_uint(pmax), false, false); pmax = fmaxf(__uint_as_float(rr[0]), __uint_as_float(rr[1])); }
    if (__builtin_expect(__all(pmax - m <= THR2), 1)) alpha = 1.f;
    else { const float mn = fmaxf(m, pmax); alpha = __builtin_amdgcn_exp2f(m - mn); m = mn; }
    const float mm = m;
#pragma unroll
    for (int r = 0; r < 16; ++r) { p0[r] = __builtin_amdgcn_exp2f(p0[r] - mm); p1[r] -= mm; }
}
__device__ __forceinline__ void finishSM(f32x16& p0, f32x16& p1, float alpha, float& l, bf16x8 (&pf)[4]) {
    float ps = 0.f;
#pragma unroll
    for (int r = 0; r < 16; ++r) { p1[r] = __builtin_amdgcn_exp2f(p1[r]); ps += p0[r] + p1[r]; }
    l = l * alpha + ps;
    pf[0] = pack8(p0, 0); pf[1] = pack8(p0, 8); pf[2] = pack8(p1, 0); pf[3] = pack8(p1, 8);
}
__device__ __forceinline__ void pv(f32x16 (&o)[4], LAS const unsigned char* vs, const bf16x8 (&pf)[4], int r32, int hi) {
    LAS const unsigned char* vb = vs + hi * 2048 + r32 * 16;
#pragma unroll
    for (int db = 0; db < 4; ++db) {
        bf16x8 va[4];
#pragma unroll
        for (int s = 0; s < 4; ++s) va[s] = *(LAS const bf16x8*)(vb + s * 4096 + db * 512);
#pragma unroll
        for (int s = 0; s < 4; ++s) o[db] = __builtin_amdgcn_mfma_f32_32x32x16_bf16(va[s], pf[s], o[db], 0, 0, 0);
        __builtin_amdgcn_sched_group_barrier(0x100, 4, 0); __builtin_amdgcn_sched_group_barrier(0x8, 4, 0);
    }
}
__device__ __forceinline__ void resc(f32x16 (&o)[4], float alpha) {
    if (__any(alpha < 1.f)) {
#pragma unroll
        for (int db = 0; db < 4; ++db)
#pragma unroll
            for (int r = 0; r < 16; ++r) o[db][r] *= alpha;
    }
}
__device__ __forceinline__ void unit(LAS unsigned char* lds, int b, int h, int qb, const bf16* QKP, const bf16* UVT, float lam, float lam_init, const float* subg, bf16* MIXB, float* stash, int wave, int lane) {
    asm volatile("" : "+v"(lane));
    const int r32 = lane & 31, hi = lane >> 5;
    const size_t tok0 = (size_t)b * S;
    const size_t qtok = tok0 + qb * 256 + wave * 32 + r32;
    constexpr int NT = S / 64;
#pragma unroll 1
    for (int c = 0; c < 2; ++c) {
        bf16x8 qf[4];
#pragma unroll
        for (int kk = 0; kk < 4; ++kk) qf[kk] = *(const GAS bf16x8*)(QKP + qtok * 1280 + h * 128 + c * 64 + kk * 16 + hi * 8);
        f32x16 o[4];
#pragma unroll
        for (int db = 0; db < 4; ++db)
#pragma unroll
            for (int r = 0; r < 16; ++r) o[db][r] = 0.f;
        float m = -INFINITY, l = 0.f, alA, alB;
        f32x16 pA0, pA1, pB0, pB1; bf16x8 pf[4];
        const char* kub = (const char*)(QKP + tok0 * 1280 + 512 + h * 128 + c * 64 + wave * 8);
        const char* vub = (const char*)(UVT + (size_t)(768 + h * 128) * M + tok0 + wave * 8);
        const unsigned kvo = (unsigned)lane * 2560u, vvo = (unsigned)lane * (unsigned)(M * 2);
#define ATT_DMA_K(t) __builtin_amdgcn_global_load_lds((const unsigned*)(kub + (size_t)(t) * (64 * 2560) + kvo), (LAS unsigned*)(lds + LDS_K + ((t) & 1) * KSLOT + wave * 1024), 16, 0, 0)
#define ATT_DMA_V(t) do { \
            __builtin_amdgcn_global_load_lds((const unsigned*)(vub + (size_t)(t) * 128 + vvo), (LAS unsigned*)(lds + LDS_V + ((t) & 1) * VSLOT + wave * 2048), 16, 0, 0); \
            __builtin_amdgcn_global_load_lds((const unsigned*)(vub + (size_t)64 * M * 2 + (size_t)(t) * 128 + vvo), (LAS unsigned*)(lds + LDS_V + ((t) & 1) * VSLOT + wave * 2048 + 1024), 16, 0, 0); } while (0)
#define SB() __builtin_amdgcn_sched_barrier(0)
#define ATT_SYNC() do { asm volatile("s_waitcnt vmcnt(0) lgkmcnt(0)" ::: "memory"); __builtin_amdgcn_s_barrier(); asm volatile("" ::: "memory"); } while (0)
        const bool early = wave < 4;
        ATT_SYNC();
        ATT_DMA_K(0); ATT_DMA_V(0);
        ATT_SYNC();
        ATT_DMA_K(1);
        qkt(pA0, pA1, lds + LDS_K, qf, r32, hi); partialSM(pA0, pA1, m, alA);
#pragma unroll 1
        for (int j = 1; j < NT - 1; j += 2) {
            ATT_SYNC(); if (early) { ATT_DMA_K(j + 1); ATT_DMA_V(j); }
            SB(); qkt(pB0, pB1, lds + LDS_K + KSLOT, qf, r32, hi); finishSM(pA0, pA1, alA, l, pf); SB();
            if (!early) { ATT_DMA_K(j + 1); ATT_DMA_V(j); }
            pv(o, lds + LDS_V, pf, r32, hi); partialSM(pB0, pB1, m, alB); SB(); resc(o, alB);
            ATT_SYNC(); if (early) { ATT_DMA_K(j + 2); ATT_DMA_V(j + 1); }
            SB(); qkt(pA0, pA1, lds + LDS_K, qf, r32, hi); finishSM(pB0, pB1, alB, l, pf); SB();
            if (!early) { ATT_DMA_K(j + 2); ATT_DMA_V(j + 1); }
            pv(o, lds + LDS_V + VSLOT, pf, r32, hi); partialSM(pA0, pA1, m, alA); SB(); resc(o, alA);
        }
        ATT_SYNC(); ATT_DMA_V(NT - 1);
        SB(); qkt(pB0, pB1, lds + LDS_K + KSLOT, qf, r32, hi); finishSM(pA0, pA1, alA, l, pf); SB();
        pv(o, lds + LDS_V, pf, r32, hi); partialSM(pB0, pB1, m, alB); SB(); resc(o, alB);
        ATT_SYNC();
        finishSM(pB0, pB1, alB, l, pf); pv(o, lds + LDS_V + VSLOT, pf, r32, hi);
#undef ATT_DMA_K
#undef ATT_DMA_V
#undef ATT_SYNC
#undef SB
        const float lt = xsum32(l);
        const int lane_e = (int)mk_lane_id();
        const int hi_e = lane_e >> 5; const size_t qtok_e = tok0 + qb * 256 + wave * 32 + (lane_e & 31);
        if (c == 0) {
            const float i1 = 1.f / lt;
#pragma unroll
            for (int db = 0; db < 4; ++db)
#pragma unroll
                for (int g4 = 0; g4 < 4; ++g4) *(GAS f32x4*)(stash + ((db * 4 + g4) * 64 + lane_e) * 4) = (f32x4){o[db][4 * g4] * i1, o[db][4 * g4 + 1] * i1, o[db][4 * g4 + 2] * i1, o[db][4 * g4 + 3] * i1};
        } else {
            const float i2 = lam / lt;
            float ss = 0.f;
#pragma unroll
            for (int db = 0; db < 4; ++db)
#pragma unroll
                for (int g4 = 0; g4 < 4; ++g4) { const f32x4 s1 = *(const GAS f32x4*)(stash + ((db * 4 + g4) * 64 + lane_e) * 4);
#pragma unroll
                    for (int i = 0; i < 4; ++i) { const float v = s1[i] - o[db][4 * g4 + i] * i2; o[db][4 * g4 + i] = v; ss += v * v; } }
            ss = xsum32(ss);
            const float rs = (1.f - lam_init) / sqrtf(ss * (1.f / 128.f) + 1e-5f);
            bf16* orow = MIXB + qtok_e * D + 256 + h * 128;
#pragma unroll
            for (int db = 0; db < 4; ++db)
#pragma unroll
                for (int g4 = 0; g4 < 4; ++g4) { const int e = 32 * db + 8 * g4 + 4 * hi_e; const f32x4 gg = *(const GAS f32x4*)(subg + e);
                    const unsigned long long w = (unsigned long long)pg8::cvt_pk_bf16(o[db][4 * g4] * rs * gg.x, o[db][4 * g4 + 1] * rs * gg.y) | ((unsigned long long)pg8::cvt_pk_bf16(o[db][4 * g4 + 2] * rs * gg.z, o[db][4 * g4 + 3] * rs * gg.w) << 32);
                    *(GAS unsigned long long*)(orow + e) = w; }
        }
    }
}
}
namespace hy {
typedef float f32x16 __attribute__((ext_vector_type(16)));
constexpr int CPY = 16456;
constexpr int VJ = 65, VK8 = VJ * 64;
constexpr int LDS_F = 0, LDS_VV = 4 * CPY, LDS_END = LDS_VV + 8 * VK8;
static_assert(LDS_VV % 16 == 0 && LDS_END <= 131072, "hyena LDS map");

__device__ __forceinline__ void filter_item(LAS unsigned char* lds, int pb, const float* fw1, const float* fb1, const float* fr1, const float* fw2, const float* fb2, const float* fr2,
                                            const float* fw3, bf16* KF, float* PS, int wave, int lane) {
    LAS bf16* tile = (LAS bf16*)lds;
    LAS float* za = (LAS float*)(lds + 65536) + wave * 512;
    LAS float* zb = (LAS float*)(lds + 81920) + wave * 512;
    LAS float* sqs = (LAS float*)(lds + 98304);
    const int p0 = pb * 64 + wave * 8;
    if (lane < 33) {
#pragma unroll 1
        for (int pi = 0; pi < 8; ++pi) { const int p = p0 + pi; float z;
            if (lane == 0) z = (float)p / (float)(S - 1);
            else { const int bi = (lane - 1) & 15; const float band = 1e-4f + (float)bi * ((15.0f - 1e-4f) / 15.0f), wpos = 2.0f * 3.14159265358979323846f * (float)p / (float)S;
                   z = lane <= 16 ? cosf(wpos * band) : -sinf(wpos * band); }
            za[pi * 64 + lane] = z; }
    }
    LDS_WAIT(); asm volatile("" ::: "memory");
    float acc8[8];
    { const float b1 = fb1[lane];
#pragma unroll
      for (int pi = 0; pi < 8; ++pi) acc8[pi] = b1;
#pragma unroll 1
      for (int i = 0; i < 33; ++i) { const float w = fw1[i * 64 + lane];
#pragma unroll
          for (int pi = 0; pi < 8; ++pi) acc8[pi] += za[pi * 64 + i] * w; }
      const float f1 = fr1[lane];
#pragma unroll
      for (int pi = 0; pi < 8; ++pi) zb[pi * 64 + lane] = sinf(f1 * acc8[pi]); }
    LDS_WAIT(); asm volatile("" ::: "memory");
    { const float b2 = fb2[lane];
#pragma unroll
      for (int pi = 0; pi < 8; ++pi) acc8[pi] = b2;
#pragma unroll 1
      for (int i = 0; i < 64; ++i) { const float w = fw2[i * 64 + lane];
#pragma unroll
          for (int pi = 0; pi < 8; ++pi) acc8[pi] += zb[pi * 64 + i] * w; }
      const float f2 = fr2[lane];
      LDS_WAIT(); asm volatile("" ::: "memory");
#pragma unroll
      for (int pi = 0; pi < 8; ++pi) za[pi * 64 + lane] = sinf(f2 * acc8[pi]); }
    LDS_WAIT(); asm volatile("" ::: "memory");
    const float mind = logf(1e-2f) / 1.5f, maxd = logf(1e-2f) / 0.3f;
#pragma unroll 1
    for (int qh = 0; qh < 2; ++qh) {
        float ac[8][4];
#pragma unroll
        for (int pi = 0; pi < 8; ++pi)
#pragma unroll
            for (int q = 0; q < 4; ++q) ac[pi][q] = 0.f;
#pragma unroll 1
        for (int i = 0; i < 64; ++i) { float w[4];
#pragma unroll
            for (int q = 0; q < 4; ++q) w[q] = fw3[i * 512 + lane + 64 * (qh * 4 + q)];
#pragma unroll
            for (int pi = 0; pi < 8; ++pi) { const float hv = za[pi * 64 + i];
#pragma unroll
                for (int q = 0; q < 4; ++q) ac[pi][q] += hv * w[q]; } }
#pragma unroll
        for (int q = 0; q < 4; ++q) { const int col = lane + 64 * (qh * 4 + q), ch = col & 255; const float delta = fabsf(mind + (float)ch * ((maxd - mind) / 255.0f)); float sq = 0.f;
#pragma unroll
            for (int pi = 0; pi < 8; ++pi) { const int p = p0 + pi; const float val = ac[pi][q] * expf(-((float)p / (float)(S - 1)) * delta);
                if (!(col >= 256 && p == 0)) sq += val * val;
                tile[col * 64 + wave * 8 + pi] = (bf16)f2bf(val); }
            sqs[wave * 512 + col] = sq; }
    }
    LDS_WAIT(); __syncthreads();
    { const int p = pb * 64 + lane;
#pragma unroll 1
      for (int cc = 0; cc < 64; ++cc) { const int col = wave * 64 + cc; const bf16 v = tile[col * 64 + lane];
          if (col < 256) KF[(size_t)col * 8192 + 4095 - p] = v; else if (p != 0) KF[(size_t)(col - 256) * 8192 + 4095 + p] = v; } }
    { const int t = wave * 64 + lane; float s = 0.f;
#pragma unroll
      for (int w = 0; w < 8; ++w) s += sqs[w * 512 + t];
      PS[(size_t)pb * 512 + t] = s;
      if (pb == 0 && t < 256) KF[(size_t)t * 8192 + 8191] = 0; }
    LDS_WAIT(); __syncthreads();
}

__device__ __forceinline__ float conv1(float um, float u0, float up, float w0, float w1, float w2, float cb) { return um * w0 + u0 * w1 + up * w2 + cb; }

__device__ __forceinline__ void unit(LAS unsigned char* lds, int c, const bf16* KF, const float* PS, const bf16* UVT, const float* cw, const float* cb, const float* bias_d, bf16* HT, int wave, int lane) {
    lane = (int)mk_lane_id(); asm volatile("" : "+s"(wave));
    const int tid = wave * 64 + lane;
    { const bf16* src = KF + (size_t)c * 8192;
#pragma unroll
      for (int i = 0; i < 2; ++i) { const int ch = tid + 512 * i; *(LAS v4u*)(lds + LDS_F + ch * 16) = *(const GAS v4u*)(src + ch * 8); } }
    { const float w0v = cw[512 + c], w1v = cw[768 + 512 + c], w2v = cw[1536 + 512 + c], cbv = cb[512 + c], w0x = cw[256 + c], w1x = cw[768 + 256 + c], w2x = cw[1536 + 256 + c], cbx = cb[256 + c];
      const bf16* rv = UVT + (size_t)(512 + c) * M; const bf16* rx = UVT + (size_t)(256 + c) * M;
#pragma unroll
      for (int i = 0; i < 4; ++i) { const int q = tid + 512 * i, b = q >> 9, sc = q & 511, s0 = sc * 8; const size_t g0 = (size_t)b * S + s0;
          const v4u av = *(const GAS v4u*)(rv + g0), ax = *(const GAS v4u*)(rx + g0);
          float uv[10], ux[10];
          uv[0] = s0 > 0 ? bf2f(rv[g0 - 1]) : 0.f; ux[0] = s0 > 0 ? bf2f(rx[g0 - 1]) : 0.f; uv[9] = s0 + 8 < S ? bf2f(rv[g0 + 8]) : 0.f; ux[9] = s0 + 8 < S ? bf2f(rx[g0 + 8]) : 0.f;
#pragma unroll
          for (int e = 0; e < 4; ++e) { uv[1 + 2 * e] = bf2f((bf16)av[e]); uv[2 + 2 * e] = bf2f((bf16)(av[e] >> 16)); ux[1 + 2 * e] = bf2f((bf16)ax[e]); ux[2 + 2 * e] = bf2f((bf16)(ax[e] >> 16)); }
          float o[8];
#pragma unroll
          for (int e = 0; e < 8; ++e) o[e] = conv1(uv[e], uv[e + 1], uv[e + 2], w0v, w1v, w2v, cbv) * conv1(ux[e], ux[e + 1], ux[e + 2], w0x, w1x, w2x, cbx);
          v4u w; w.x = pk2(o[0], o[1]); w.y = pk2(o[2], o[3]); w.z = pk2(o[4], o[5]); w.w = pk2(o[6], o[7]);
          *(LAS v4u*)(lds + LDS_VV + (((sc & 7) * VJ + (sc >> 3)) * 4 + b) * 16) = w; }
      if (tid < 32) { unsigned z_; asm volatile("v_mov_b32 %0, 0" : "=v"(z_)); *(LAS v4u*)(lds + LDS_VV + (((tid >> 2) * VJ + 64) * 4 + (tid & 3)) * 16) = (v4u){z_, z_, z_, z_}; } }
    LDS_WAIT(); __syncthreads();
    {
#pragma unroll 1
      for (int i = 0; i < 4; ++i) { const int y = tid + 512 * i;
          const unsigned long long w0 = *(LAS const unsigned long long*)(lds + LDS_F + y * 8), w1 = *(LAS const unsigned long long*)(lds + LDS_F + y * 8 + 8);
#pragma unroll
          for (int p = 1; p < 4; ++p) *(LAS unsigned long long*)(lds + LDS_F + p * CPY + y * 8) = (w0 >> (16 * p)) | (w1 << (64 - 16 * p)); } }
    const float nrm = 1.0f / sqrtf(wave_sum(PS[(size_t)lane * 512 + c] + PS[(size_t)lane * 512 + 256 + c]) + 1e-6f);
    LDS_WAIT(); __syncthreads();
    const int r32 = lane & 31, hi = lane >> 5, gp = wave & 3, half = wave >> 2, iloc = r32 >> 2, b = r32 & 3;
    f32x16 acc[2][2];
#pragma unroll
    for (int rho = 0; rho < 2; ++rho)
#pragma unroll
        for (int gg = 0; gg < 2; ++gg)
#pragma unroll
            for (int r = 0; r < 16; ++r) acc[rho][gg][r] = 0.f;
    const int dlo = 16 * gp - 63 + (half ? 40 : 0), dn = half ? 39 : 40;
    int pa = LDS_F + (3 - (r32 & 3)) * CPY + (4092 - 4 * (r32 >> 2) + 8 * hi) * 2 - 64 - 128 * dlo;
    int jb = 16 * gp + iloc - dlo;
    const int pbase = LDS_VV + hi * VK8 + b * 16;
    typedef unsigned long long u64;
    struct Frag { u64 a[4][4]; v4u b[4][2]; };
#define HY_LOAD(F) do { const int j0_ = jb, j1_ = jb + 8; LAS const unsigned char* ap_ = lds + pa; \
        LAS const unsigned char* bp0_ = lds + pbase + ((unsigned)j0_ < 64u ? j0_ : 64) * 64; LAS const unsigned char* bp1_ = lds + pbase + ((unsigned)j1_ < 64u ? j1_ : 64) * 64; \
        _Pragma("unroll") for (int k = 0; k < 4; ++k) { F.a[k][0] = *(LAS const u64*)(ap_ + 64 + 32 * k); F.a[k][1] = *(LAS const u64*)(ap_ + 64 + 32 * k + 8); F.a[k][2] = *(LAS const u64*)(ap_ + 32 * k); F.a[k][3] = *(LAS const u64*)(ap_ + 32 * k + 8); \
            F.b[k][0] = *(LAS const v4u*)(bp0_ + k * (2 * VK8)); F.b[k][1] = *(LAS const v4u*)(bp1_ + k * (2 * VK8)); } \
        pa -= 128; jb -= 1; } while (0)
#define HY_MMA(F) do { _Pragma("unroll") for (int k = 0; k < 4; ++k) { \
            const bf16x8 fa0 = __builtin_bit_cast(bf16x8, (v4u){(unsigned)F.a[k][0], (unsigned)(F.a[k][0] >> 32), (unsigned)F.a[k][1], (unsigned)(F.a[k][1] >> 32)}); \
            const bf16x8 fa1 = __builtin_bit_cast(bf16x8, (v4u){(unsigned)F.a[k][2], (unsigned)(F.a[k][2] >> 32), (unsigned)F.a[k][3], (unsigned)(F.a[k][3] >> 32)}); \
            const bf16x8 fb0 = __builtin_bit_cast(bf16x8, F.b[k][0]), fb1 = __builtin_bit_cast(bf16x8, F.b[k][1]); \
            acc[0][0] = __builtin_amdgcn_mfma_f32_32x32x16_bf16(fa0, fb0, acc[0][0], 0, 0, 0); acc[0][1] = __builtin_amdgcn_mfma_f32_32x32x16_bf16(fa0, fb1, acc[0][1], 0, 0, 0); \
            acc[1][0] = __builtin_amdgcn_mfma_f32_32x32x16_bf16(fa1, fb0, acc[1][0], 0, 0, 0); acc[1][1] = __builtin_amdgcn_mfma_f32_32x32x16_bf16(fa1, fb1, acc[1][1], 0, 0, 0); } } while (0)
#define HY_MIX() do { _Pragma("unroll") for (int i_ = 0; i_ < 8; ++i_) { __builtin_amdgcn_sched_group_barrier(0x100, 3, 0); __builtin_amdgcn_sched_group_barrier(0x8, 2, 0); } } while (0)
    Frag FA, FB;
    HY_LOAD(FA);
    int dd = 0;
#pragma unroll 1
    for (; dd + 2 <= dn; dd += 2) {
        HY_LOAD(FB); HY_MMA(FA); HY_MIX();
        if (dd + 2 < dn) { HY_LOAD(FA); HY_MMA(FB); HY_MIX(); } else { HY_MMA(FB); }
    }
    if (dd < dn) HY_MMA(FA);
#undef HY_MIX
#undef HY_LOAD
#undef HY_MMA
    const int lane_b = (int)mk_lane_id(), r32_b = lane_b & 31, hi_b = lane_b >> 5, iloc_b = r32_b >> 2, b_b = r32_b & 3;
    LDS_WAIT(); __syncthreads();
    { LAS float* xw = (LAS float*)(lds + LDS_F) + (gp * 2 + (half ? 0 : 1)) * 2048 + lane_b;
#pragma unroll
      for (int gg = 0; gg < 2; ++gg)
#pragma unroll
          for (int r = 0; r < 16; ++r) xw[(gg * 16 + r) * 64] = half ? acc[0][gg][r] : acc[1][gg][r]; }
    LDS_WAIT(); __syncthreads();
    f32x16 fin[2];
    { LAS const float* xr = (LAS const float*)(lds + LDS_F) + (gp * 2 + (half ? 1 : 0)) * 2048 + lane_b;
#pragma unroll
      for (int gg = 0; gg < 2; ++gg)
#pragma unroll
          for (int r = 0; r < 16; ++r) fin[gg][r] = (half ? acc[1][gg][r] : acc[0][gg][r]) + xr[(gg * 16 + r) * 64]; }
    { const float bd = bias_d[c], w0 = cw[c], w1 = cw[768 + c], w2 = cw[1536 + c], cb0 = cb[c]; const bf16* r0p = UVT + (size_t)c * M; bf16* hrow = HT + (size_t)c * M;
#pragma unroll
      for (int gg = 0; gg < 2; ++gg)
#pragma unroll
          for (int g4 = 0; g4 < 4; ++g4) { const int i = 16 * gp + 8 * gg + iloc_b, rr = 32 * half + 8 * g4 + 4 * hi_b, t0 = 64 * i + rr; const size_t tok = (size_t)b_b * S + t0;
              const unsigned long long vw = *(LAS const unsigned long long*)(lds + LDS_VV + (((rr >> 3) * VJ + i) * 4 + b_b) * 16 + (rr & 7) * 2);
              const unsigned long long uw = *(const GAS unsigned long long*)(r0p + tok);
              float u[6]; u[0] = t0 > 0 ? bf2f(r0p[tok - 1]) : 0.f; u[5] = t0 + 4 < S ? bf2f(r0p[tok + 4]) : 0.f;
              u[1] = bf2f((bf16)uw); u[2] = bf2f((bf16)(uw >> 16)); u[3] = bf2f((bf16)(uw >> 32)); u[4] = bf2f((bf16)(uw >> 48));
              float o[4];
#pragma unroll
              for (int e = 0; e < 4; ++e) { const float vv = bf2f((bf16)(vw >> (16 * e))); o[e] = (nrm * fin[gg][4 * g4 + e] + vv * bd) * conv1(u[e], u[e + 1], u[e + 2], w0, w1, w2, cb0); }
              *(GAS unsigned long long*)(hrow + tok) = (unsigned long long)pk2(o[0], o[1]) | ((unsigned long long)pk2(o[2], o[3]) << 32); } }
    LDS_WAIT(); __syncthreads();
}
__device__ __forceinline__ void transpose_slab(LAS unsigned char* lds, int slab, const bf16* HT, bf16* MIXB, int wave, int lane) {
    const int tid = wave * 64 + lane; LAS bf16* tile = (LAS bf16*)lds;
#pragma unroll 1
    for (int i = 0; i < 4; ++i) { const int q = tid + 512 * i, c = q >> 3, tc = q & 7; const v4u w = *(const GAS v4u*)(HT + (size_t)c * M + (size_t)slab * 64 + tc * 8);
#pragma unroll
        for (int e = 0; e < 4; ++e) { tile[(tc * 8 + 2 * e) * 264 + c] = (bf16)w[e]; tile[(tc * 8 + 2 * e + 1) * 264 + c] = (bf16)(w[e] >> 16); } }
    LDS_WAIT(); __syncthreads();
#pragma unroll 1
    for (int i = 0; i < 4; ++i) { const int q = tid + 512 * i, tk = q >> 5, cc = q & 31;
        *(GAS v4u*)(MIXB + ((size_t)slab * 64 + tk) * D + cc * 8) = *(LAS const v4u*)(lds + (tk * 264 + cc * 8) * 2); }
    LDS_WAIT(); __syncthreads();
}
}
#ifndef DUP_PRO
#define DUP_PRO 1
#endif
#ifndef DUP_IN
#define DUP_IN 1
#endif
#ifndef DUP_HY
#define DUP_HY 1
#endif
#ifndef DUP_POOL
#define DUP_POOL 1
#endif
#ifndef DUP_HYT
#define DUP_HYT 1
#endif
#ifndef DUP_ATT
#define DUP_ATT 1
#endif
#ifndef DUP_OUT
#define DUP_OUT 1
#endif
#ifndef DUP_LN1
#define DUP_LN1 1
#endif
#ifndef DUP_MOE1
#define DUP_MOE1 1
#endif
#ifndef DUP_MOE2
#define DUP_MOE2 1
#endif
#ifndef DUP_LN2
#define DUP_LN2 1
#endif
#ifndef EN_HY
#define EN_HY 1
#endif
#ifndef EN_HYT
#define EN_HYT 1
#endif
#ifndef EN_PRO
#define EN_PRO 1
#endif
#ifndef EN_IN
#define EN_IN 1
#endif
#ifndef EN_ATT
#define EN_ATT 1
#endif
#ifndef EN_POOL
#define EN_POOL 1
#endif
#ifndef EN_OUT
#define EN_OUT 1
#endif
#ifndef EN_LN1
#define EN_LN1 1
#endif
#ifndef EN_WCV
#define EN_WCV 1
#endif
#ifndef EN_MOE1
#define EN_MOE1 1
#endif
#ifndef EN_MOE2
#define EN_MOE2 1
#endif
#ifndef EN_LN2
#define EN_LN2 1
#endif
constexpr int RING_BYTES = 135168;
constexpr int LDSCTL_OFF = RING_BYTES, MISC_OFF = LDSCTL_OFF + 320, MOETAB_OFF = LDSCTL_OFF + 1024, ROUTE_OFF = LDSCTL_OFF + 2048;
constexpr int LDS_BYTES = 151552;

struct Args { const float* in[38]; float* out; unsigned char* ws; int* eid; float* wts; int ph_lo, ph_hi, l_lo, l_hi, single, pad; };
enum { PH_PRO = 0, PH_IN = 1, PH_ATT = 2, PH_POOL = 3, PH_OUT = 4, PH_LN1 = 5, PH_WCV = 6, PH_MOE1 = 7, PH_MOE2 = 8, PH_LN2 = 9, PH_HY = 10, PH_HYT = 11, PH_END = 12 };

__global__ void __launch_bounds__(NWAVES * 64, 2) mk_fwd(Args a) {
    extern __shared__ __attribute__((aligned(16))) unsigned char lds_raw[];
    LAS unsigned char* lds = (LAS unsigned char*)lds_raw;
    volatile LAS unsigned* MISC = (volatile LAS unsigned*)(lds + MISC_OFF);
    const int wave_s = __builtin_amdgcn_readfirstlane((int)threadIdx.x >> 6);
    const int G = gridDim.x, bx = blockIdx.x, vcu0 = (G % 8 == 0) ? (bx % 8) * (G / 8) + bx / 8 : bx;
    gu32* ctl0 = (gu32*)(a.ws + WS_CTL);
    for (int u = wave_s * 64 + (int)mk_lane_id(); u < (LDS_BYTES - LDSCTL_OFF) / 4; u += NWAVES * 64) ((LAS unsigned*)(lds + LDSCTL_OFF))[u] = 0u;
    __syncthreads();
    XcdBarrier bar; bar.bar = (unsigned*)(ctl0 + CW_BAR); bar.x = 0; bar.st = nullptr;
#if defined(MK_PER_PHASE)
    if (!a.single)
#endif
    bar = xcd_barrier_post((unsigned*)(ctl0 + CW_BAR), MISC + 8, wave_s);
#if defined(MK_PER_PHASE)
#define IN(k) (a.ph_lo <= (k) && (k) < a.ph_hi)
#define SEAM() do { if (!a.single) xcd_barrier(bar, wave_s); } while (0)
#else
#define IN(k) 1
#if defined(PROBE_BAR2)
#define SEAM() do { xcd_barrier(bar, wave_s); xcd_barrier(bar, wave_s); } while (0)
#else
#define SEAM() xcd_barrier(bar, wave_s)
#endif
#endif
    const int NGW = G * NWAVES;
#define PHASE_PTRS() int lane_ = (int)mk_lane_id(); asm volatile("" : "+v"(lane_)); const int lane = lane_, wave = wave_s; int vcu = vcu0; asm volatile("" : "+s"(vcu)); (void)wave; const int gw = vcu * NWAVES + wave; (void)gw; unsigned char* ws = a.ws; gu32* ctl = (gu32*)(ws + WS_CTL); (void)ctl; \
    bf16* XB = (bf16*)(ws + WS_XB); bf16* QKP = (bf16*)(ws + WS_QKP); bf16* UVT = (bf16*)(ws + WS_UVT); float* CS = (float*)(ws + WS_CS); bf16* MIXB = (bf16*)(ws + WS_MIXB); \
    (void)XB; (void)QKP; (void)UVT; (void)CS; (void)MIXB
#define INP(k) (a.in[k])
#define WCV_SPLIT_IT 3730
#define WCV_SPLIT_PB ((size_t)M * 256 / 16 * 9)
#define WCV_LAYER(LEXPR, GW_, NGW_, IT0_, IT1_, PB0_, PB1_) do { const int wl_ = (LEXPR), wg_ = (GW_), wn_ = (NGW_); const int l = wl_, gw = wg_, NGW = wn_; (void)NGW; const int it0_ = (IT0_), it1_ = (IT1_); const size_t pb0_ = (PB0_), pb1_ = (PB1_); \
            LAS float* scr = (LAS float*)(lds + wave * 16384); \
            unsigned char* wb_ = ws + WS_WBUF + (size_t)(l & 1) * WBUF_STRIDE; bf16* W13 = (bf16*)(wb_ + WB_W13); bf16* W2 = (bf16*)(wb_ + WB_W2); bf16* WG = (bf16*)(wb_ + WB_WG); bf16* WP = (bf16*)(wb_ + WB_WP); \
            for (int it = it0_ + gw; it < it1_; it += NGW) { \
                const float* src; int K, N, k0, n0, mode = 0; bf16* dst; \
                if (it < 4096) { const int which = it >> 11, r = it & 2047, e = r >> 7, kb = (r >> 3) & 15, nb = r & 7; \
                    src = INP(which ? 31 : 30) + ((size_t)l * 16 + e) * D * 256; K = D; N = 256; k0 = kb * 64; n0 = nb * 32; mode = 1 + which; dst = W13 + (size_t)e * 512 * D; \
                } else if (it < 6144) { const int r = it - 4096, e = r >> 7, kb = (r >> 5) & 3, nb = r & 31; \
                    src = INP(32) + ((size_t)l * 16 + e) * 256 * D; K = 256; N = D; k0 = kb * 64; n0 = nb * 32; dst = W2 + (size_t)e * D * 256 + (size_t)n0 * 256; \
                } else if (it < 6656) { const int r = it - 6144, kb = r >> 5, nb = r & 31; \
                    src = INP(33) + (size_t)l * D * D; K = D; N = D; k0 = kb * 64; n0 = nb * 32; dst = WG + (size_t)n0 * D; \
                } else { const int r = it - 6656, kb = r >> 5, nb = r & 31; \
                    src = INP(35) + (size_t)l * 256 * D; K = 256; N = D; k0 = kb * 64; n0 = nb * 32; dst = WP + (size_t)n0 * 256; } \
                p0_transpose_block(src, K, N, k0, n0, dst, mode, scr, lane); \
            } \
            const int ln = lane; \
            const float* ps = INP(1) + (size_t)l * M * 256; bf16* PB = (bf16*)(wb_ + WB_PB); \
            for (size_t i = pb0_ + ((size_t)gw * 64 + ln) * 8; i < pb1_; i += (size_t)NGW * 64 * 8) { const f32x4 x0 = *(const GAS f32x4*)(ps + i), x1 = *(const GAS f32x4*)(ps + i + 4); \
                v4u o; o.x = pk2(x0.x, x0.y); o.y = pk2(x0.z, x0.w); o.z = pk2(x1.x, x1.y); o.w = pk2(x1.z, x1.w); *(GAS v4u*)(PB + i) = o; } \
    } while (0)

    if (EN_PRO && IN(PH_PRO)) {
            PHASE_PTRS();
            for (int rep_ = 0; rep_ < DUP_PRO; ++rep_) {
        LAS float* scr = (LAS float*)(lds + wave * 16384);
        for (int it = gw; it < DEPTH * (16 * 72 + 16 * 32); it += NGW) {
            const int l = it / 1664, r = it % 1664; const float* src; int N, k0, n0; bf16* dst;
            if (r < 1152) { const int kb = r / 72, nb = r % 72; n0 = nb * 32; k0 = kb * 64; N = INW; src = INP(4) + (size_t)l * D * INW;
                bf16* wsw = (bf16*)(ws + WS_WIN + (size_t)l * WIN_LAYER); bf16* wnm = wsw + 1280 * 1024;
                dst = n0 < 768 ? wsw + (size_t)n0 * D : (n0 < 1792 ? wnm + (size_t)(n0 - 768) * D : wsw + (size_t)(768 + n0 - 1792) * D); }
            else { const int q = r - 1152, kb = q >> 5, nb = q & 31; n0 = nb * 32; k0 = kb * 64; N = D; src = INP(23) + (size_t)l * D * D; dst = (bf16*)(ws + WS_WOUT + (size_t)l * WOUT_LAYER) + (size_t)n0 * D; }
            p0_transpose_block(src, D, N, k0, n0, dst, 0, scr, lane);
            }
        }
        for (int it = gw; it < DEPTH * 4 * 16 * 2; it += NGW) {
            const int l = it >> 7, g = (it >> 5) & 3, dh = (it >> 4) & 1, k = (it & 15) * 64 + lane;
            const float* wrow = INP(4) + (size_t)l * D * INW + (size_t)k * INW + 2304 + g * 64;
            const float* pw = INP(20) + (size_t)(l * 4 + g) * 64 * 64 + dh * 32;
            float acc[32];
#pragma unroll
            for (int d = 0; d < 32; ++d) acc[d] = 0.f;
#pragma unroll 1
            for (int c = 0; c < 64; ++c) { const float x = wrow[c];
#pragma unroll
                for (int d = 0; d < 32; ++d) acc[d] += x * pw[c * 64 + d]; }
            bf16* dst = (bf16*)(ws + WS_WIN + (size_t)l * WIN_LAYER) + (size_t)(1280 + 1024 + g * 64 + dh * 32) * D + k;
#pragma unroll
            for (int d = 0; d < 32; ++d) dst[(size_t)d * D] = (bf16)f2bf(acc[d]);
        }
        for (int i = gw * 64 + lane; i < DEPTH * 32 * D; i += NGW * 64) { const int l2 = i / (32 * D), r = i % (32 * D), col = r / D, k = r % D;
            const float w = col < 4 ? INP(26)[((size_t)l2 * D + k) * 4 + col] : (col < 20 ? INP(28)[((size_t)l2 * D + k) * 16 + col - 4] : 0.f);
            const unsigned hb = f2bf(w); const float lo = w - __uint_as_float(hb << 16);
            bf16* dst = (bf16*)(ws + WS_WR) + (size_t)l2 * 64 * D; dst[(size_t)col * D + k] = (bf16)hb; dst[(size_t)(32 + col) * D + k] = (bf16)f2bf(lo); }
        int ln2 = lane; asm volatile("" : "+v"(ln2));
        for (int i = gw * 64 + ln2; i < S * 8; i += NGW * 64) { const int pos = i >> 3, j = i & 7; const float ang = (float)pos * powf(500000.0f, -(float)(2 * j) / 16.0f);
            CS[pos * 16 + j] = cosf(ang); CS[pos * 16 + 8 + j] = sinf(ang); }
        for (int m = gw; m < M; m += NGW) ln_row(INP(0) + (size_t)m * D, 1.f, nullptr, nullptr, nullptr, INP(2), INP(3), nullptr, XB + (size_t)m * D, lane);
        WCV_LAYER(0, gw, NGW, 0, 6784, (size_t)0, (size_t)M * 256);
        LDS_WAIT(); __syncthreads();
        for (int it = vcu; it < DEPTH * 64; it += G) { const int fl = it >> 6, pb = it & 63;
            hy::filter_item(lds, pb, INP(7) + fl * 33 * 64, INP(8) + fl * 64, INP(9) + fl * 64, INP(10) + fl * 64 * 64, INP(11) + fl * 64, INP(12) + fl * 64, INP(13) + fl * 64 * 512,
                            (bf16*)(ws + WS_KF) + (size_t)fl * 256 * 8192, (float*)(ws + WS_PS) + (size_t)fl * 64 * 512, wave, lane); }
        SEAM();
    }
#if defined(MK_PER_PHASE)
    for (int l = a.l_lo; l < a.l_hi; ++l) {
#else
#pragma unroll 1
    for (int l = 0; l < DEPTH; ++l) {
#endif
        if (EN_IN && IN(PH_IN)) {
            PHASE_PTRS();
            for (int rep_ = 0; rep_ < DUP_IN; ++rep_) {
            const char* wsw = (const char*)(ws + WS_WIN + (size_t)l * WIN_LAYER);
            SchedIn Sc{vcu, G, (const char*)XB, wsw, wsw + (size_t)1280 * 1024 * 2};
            EpiIn E{QKP, UVT, CS};
            pg8::gemm_phase<EpiIn, SchedIn>(lds, D, Sc, E, wave);
            { SchedSq Sc2{vcu, G / 2, (const char*)(ws + WS_WBUF + (size_t)(l & 1) * WBUF_STRIDE + WB_PB), (const char*)(ws + WS_WBUF + (size_t)(l & 1) * WBUF_STRIDE + WB_WP), (size_t)256 * 256 * 2, (size_t)256 * 256 * 2, G / 2};
              EpiPle<0> E2{(bf16*)(ws + WS_YP), nullptr};
              pg8::gemm_phase<EpiPle<0>, SchedSq>(lds, 256, Sc2, E2, wave); }
            }
            SEAM();
        }
        if (EN_HY && IN(PH_HY)) {
            PHASE_PTRS();
            for (int rep_ = 0; rep_ < DUP_HY; ++rep_) {
            for (int c = vcu; c < 256; c += G)
                hy::unit(lds, c, (const bf16*)(ws + WS_KF) + (size_t)l * 256 * 8192, (const float*)(ws + WS_PS) + (size_t)l * 64 * 512, UVT, INP(5) + l * 3 * 768, INP(6) + l * 768, INP(14) + l * 256, (bf16*)(ws + WS_HT), wave, lane);
            }
        }
        if (EN_POOL && IN(PH_POOL)) {
            PHASE_PTRS();
            for (int rep_ = 0; rep_ < DUP_POOL; ++rep_) {
            int ln = lane; asm volatile("" : "+v"(ln));
            const int cc = (ln & 31) * 8, gq = cc >> 6, hw = 1 << gq;
            const float* pb = INP(21) + l * 256 + cc; const float* psc = INP(22) + l * 256 + cc;
            for (int it = gw; it < M / 2; it += NGW) {
                const int tok = it * 2 + (ln >> 5), pos = tok & (S - 1);
                int lo = pos - hw, hi2 = pos + hw - 1; lo = lo < 0 ? 0 : lo; hi2 = hi2 > S - 1 ? S - 1 : hi2;
                float sacc[8];
#pragma unroll
                for (int e = 0; e < 8; ++e) sacc[e] = 0.f;
                const bf16* zp = QKP + (size_t)(tok - pos) * 1280 + 1024 + cc;
                for (int r = lo; r <= hi2; ++r) { const v4u w = *(const GAS v4u*)(zp + (size_t)r * 1280);
                    sacc[0] += bf2f((bf16)w.x); sacc[1] += bf2f((bf16)(w.x >> 16)); sacc[2] += bf2f((bf16)w.y); sacc[3] += bf2f((bf16)(w.y >> 16));
                    sacc[4] += bf2f((bf16)w.z); sacc[5] += bf2f((bf16)(w.z >> 16)); sacc[6] += bf2f((bf16)w.w); sacc[7] += bf2f((bf16)(w.w >> 16)); }
                const float inv = 1.f / (float)(hi2 - lo + 1);
                const v4u w = *(const GAS v4u*)(zp + (size_t)pos * 1280);
                float z[8] = {bf2f((bf16)w.x), bf2f((bf16)(w.x >> 16)), bf2f((bf16)w.y), bf2f((bf16)(w.y >> 16)), bf2f((bf16)w.z), bf2f((bf16)(w.z >> 16)), bf2f((bf16)w.w), bf2f((bf16)(w.w >> 16))};
                float y[8];
#pragma unroll
                for (int e = 0; e < 8; ++e) y[e] = (sacc[e] * inv - z[e] + pb[e]) * psc[e];
                v4u o; o.x = pk2(y[0], y[1]); o.y = pk2(y[2], y[3]); o.z = pk2(y[4], y[5]); o.w = pk2(y[6], y[7]);
                *(GAS v4u*)(MIXB + (size_t)tok * D + 768 + cc) = o;
            }
            }
            SEAM();
        }
        if (EN_HYT && IN(PH_HYT)) {
            PHASE_PTRS();
            for (int rep_ = 0; rep_ < DUP_HYT; ++rep_) {
            for (int s = vcu; s < 256; s += G) hy::transpose_slab(lds, s, (const bf16*)(ws + WS_HT), MIXB, wave, lane);
            }
        }
        if (EN_ATT && IN(PH_ATT)) {
            PHASE_PTRS();
            for (int rep_ = 0; rep_ < DUP_ATT; ++rep_) {
            const float lam_init = 0.8f - 0.6f * expf(-0.3f * (float)l);
            int ln = lane; asm volatile("" : "+v"(ln));
            const float lam = expf(wave_sum(INP(15)[l * 64 + ln] * INP(16)[l * 64 + ln])) - expf(wave_sum(INP(17)[l * 64 + ln] * INP(18)[l * 64 + ln])) + lam_init;
            for (int u = vcu; u < 256; u += G) att::unit(lds, (u >> 4) >> 2, (u >> 4) & 3, u & 15, QKP, UVT, lam, lam_init, INP(19) + l * 128, MIXB, (float*)(ws + WS_STASH) + ((size_t)u * 8 + wave) * 4096, wave, lane);
            }
            SEAM();
        }
        if (EN_OUT && IN(PH_OUT)) {
            PHASE_PTRS();
            for (int rep_ = 0; rep_ < DUP_OUT; ++rep_) {
            SchedOut Sc{vcu, G, (const char*)MIXB, (const char*)(ws + WS_WOUT + (size_t)l * WOUT_LAYER)};
#if defined(PROBE_OUT)
            { EpiRes E0{(bf16*)(ws + WS_STASH)}; pg8::gemm_phase<EpiRes, SchedOut>(lds, D, Sc, E0, wave); }
#endif
            EpiRes E{XB};
            pg8::gemm_phase<EpiRes, SchedOut>(lds, D, Sc, E, wave);
            }
            SEAM();
        }
        if (EN_LN1 && IN(PH_LN1)) {
            PHASE_PTRS();
            for (int rep_ = 0; rep_ < DUP_LN1; ++rep_) {
            int ln = lane; asm volatile("" : "+v"(ln));
#if defined(PROBE_LN1)
            for (int ch = vcu; ch < M / 64; ch += G)
                ln1_router_chunk<PROBE_LN1>((LAS RouteLds*)(lds + ROUTE_OFF), lds, ch * 64, XB, (bf16*)(ws + WS_STASH), INP(24) + l * D, INP(25) + l * D, (const bf16*)(ws + WS_WR) + (size_t)l * 64 * D, INP(27) + l * 4, INP(29) + l * 16,
                                 ctl + CW_CNT + l * 16 * CNT_STRIDE, (int*)(ws + WS_TOKIDX), (float*)(ws + WS_GATE), wave, lane);
#endif
            for (int ch = vcu; ch < M / 64; ch += G)
                ln1_router_chunk((LAS RouteLds*)(lds + ROUTE_OFF), lds, ch * 64, XB, XB, INP(24) + l * D, INP(25) + l * D, (const bf16*)(ws + WS_WR) + (size_t)l * 64 * D, INP(27) + l * 4, INP(29) + l * 16,
                                 ctl + CW_CNT + l * 16 * CNT_STRIDE, (int*)(ws + WS_TOKIDX), (float*)(ws + WS_GATE), wave, lane);
            }
            SEAM();
        }
        if (EN_MOE1 && IN(PH_MOE1)) {
            PHASE_PTRS();
            for (int rep_ = 0; rep_ < DUP_MOE1; ++rep_) {
            moe_tab_build((LAS int*)(lds + MOETAB_OFF), ctl + CW_CNT + l * 16 * CNT_STRIDE, wave == 0 && lane == 0); const MoeTab T{(LAS const int*)(lds + MOETAB_OFF)};
            { SchedMoe<2> Sc{vcu, G, T, (const char*)XB, (const char*)(ws + WS_WBUF + (size_t)(l & 1) * WBUF_STRIDE + WB_W13), (size_t)512 * D * 2, (const int*)(ws + WS_TOKIDX), 0};
              EpiMoe1 E{(bf16*)(ws + WS_ACT), (const float*)(ws + WS_GATE), T};
              pg8::gemm_phase<EpiMoe1, SchedMoe<2>, true>(lds, D, Sc, E, wave);
#if defined(PROBE_MOE1A)
              pg8::gemm_phase<EpiMoe1, SchedMoe<2>, true>(lds, D, Sc, E, wave);
#endif
            }
            { SchedSq Sc{vcu, G, (const char*)XB, (const char*)(ws + WS_WBUF + (size_t)(l & 1) * WBUF_STRIDE + WB_WG), TILEB, TILEB, 0};
              EpiPle<1> E{(bf16*)(ws + WS_YP), INP(34) + l * D};
              pg8::gemm_phase<EpiPle<1>, SchedSq>(lds, D, Sc, E, wave); }
            if (l + 1 < DEPTH) {
                int x2 = 2 * T.pre(16) - G; x2 = x2 < 0 ? 0 : (x2 > G / 2 ? G / 2 : x2);
                if (vcu >= x2) WCV_LAYER(l + 1, (vcu - x2) * NWAVES + wave, (G - x2) * NWAVES, 0, WCV_SPLIT_IT, (size_t)0, WCV_SPLIT_PB);
            }
            }
            SEAM();
        }
        if (EN_MOE2 && IN(PH_MOE2)) {
            PHASE_PTRS();
            for (int rep_ = 0; rep_ < DUP_MOE2; ++rep_) {
            moe_tab_build((LAS int*)(lds + MOETAB_OFF), ctl + CW_CNT + l * 16 * CNT_STRIDE, wave == 0 && lane == 0); const MoeTab T{(LAS const int*)(lds + MOETAB_OFF)};
            SchedMoe<4> Sc{vcu, G, T, (const char*)(ws + WS_ACT), (const char*)(ws + WS_WBUF + (size_t)(l & 1) * WBUF_STRIDE + WB_W2), (size_t)D * 256 * 2, (const int*)(ws + WS_TOKIDX), (size_t)256 * 256 * 2};
            EpiMoe2 E{(bf16*)(ws + WS_YMOE), (const int*)(ws + WS_TOKIDX), T};
            pg8::gemm_phase<EpiMoe2, SchedMoe<4>>(lds, 256, Sc, E, wave);
            if (l + 1 < DEPTH) {
                int x3 = 4 * T.pre(16) - 2 * G; x3 = x3 < 0 ? 0 : (x3 > G / 2 ? G / 2 : x3);
                if (vcu >= x3) WCV_LAYER(l + 1, (vcu - x3) * NWAVES + wave, (G - x3) * NWAVES, WCV_SPLIT_IT, 6784, WCV_SPLIT_PB, (size_t)M * 256);
            }
            }
            SEAM();
        }
        if (EN_LN2 && IN(PH_LN2)) {
            PHASE_PTRS();
            for (int rep_ = 0; rep_ < DUP_LN2; ++rep_) {
            int ln = lane; asm volatile("" : "+v"(ln));
            const bf16* YM = (const bf16*)(ws + WS_YMOE); const bf16* YP = (const bf16*)(ws + WS_YP);
            const bool lastl = (l == DEPTH - 1);
#if defined(PROBE_LN2)
            for (int m = gw; m < M; m += NGW)
                ln_row(XB + (size_t)m * D, DN_ALPHA, YM + (size_t)(2 * m) * D, YM + (size_t)(2 * m + 1) * D, YP + (size_t)m * D, INP(36) + l * D, INP(37) + l * D, (float*)nullptr, (bf16*)(ws + WS_STASH) + (size_t)m * D, ln);
#endif
            for (int m = 4 * gw; m < M; m += 4 * NGW)
                ln2_row4(XB + (size_t)m * D, DN_ALPHA, YM + (size_t)(2 * m) * D, YP + (size_t)m * D, INP(36) + l * D, INP(37) + l * D,
                         lastl ? a.out + (size_t)m * D : (float*)nullptr, lastl ? (bf16*)nullptr : XB + (size_t)m * D, ln);
            }
            if (l != DEPTH - 1) SEAM();
        }
    }
#undef IN
#undef SEAM
}
static void mk_launch(const Args& base, int ph, int l, int grid, hipStream_t stream) {
    Args a = base; a.ph_lo = ph; a.ph_hi = ph + 1; a.l_lo = l; a.l_hi = l + 1; a.single = 1;
    hipLaunchKernelGGL(mk_fwd, dim3(grid), dim3(NWAVES * 64), LDS_BYTES, stream, a);
}
extern "C" void kernel_launch(void* const* d_in, const int* in_sizes, int n_in, void* d_out, int out_size, void* d_ws, size_t ws_size, hipStream_t stream) {
    (void)in_sizes; (void)n_in; (void)out_size; (void)ws_size;
    static int grid = 0;
    if (grid == 0) {
        int dev = 0, cus = 0;
        if (hipGetDevice(&dev) != hipSuccess || hipDeviceGetAttribute(&cus, hipDeviceAttributeMultiprocessorCount, dev) != hipSuccess) { grid = -1; return; }
        if (hipFuncSetAttribute((const void*)mk_fwd, hipFuncAttributeMaxDynamicSharedMemorySize, LDS_BYTES) != hipSuccess) { grid = -1; return; }
        (void)hipGetLastError();
        grid = cus;
    }
    if (grid < 0) return;
    (void)hipMemsetAsync((char*)d_ws + WS_CTL, 0, CTL_ZERO_BYTES, stream);
    Args base{};
    for (int i = 0; i < 38; ++i) base.in[i] = (const float*)d_in[i];
    base.out = (float*)d_out; base.ws = (unsigned char*)d_ws;
    base.eid = nullptr; base.wts = nullptr;
#if defined(MK_PER_PHASE)
    mk_launch(base, PH_PRO, 0, grid, stream);
    for (int l = 0; l < DEPTH; ++l) for (int ph : {PH_IN, PH_HY, PH_HYT, PH_ATT, PH_POOL, PH_OUT, PH_LN1, PH_WCV, PH_MOE1, PH_MOE2, PH_LN2}) mk_launch(base, ph, l, grid, stream);
#else
    Args a = base; a.ph_lo = 0; a.ph_hi = PH_END; a.l_lo = 0; a.l_hi = DEPTH; a.single = 0;
    hipLaunchKernelGGL(mk_fwd, dim3(grid), dim3(NWAVES * 64), LDS_BYTES, stream, a);
#endif
}
```

```cpp
#include <hip/hip_runtime.h>
#include <stdint.h>
#include <math.h>
namespace pg8 {
#define PG8_LAS __attribute__((address_space(3)))
typedef unsigned short bf16_t;
typedef short bf16x8 __attribute__((ext_vector_type(8)));
typedef float f32x4 __attribute__((ext_vector_type(4)));
typedef unsigned u32x4 __attribute__((ext_vector_type(4)));
constexpr int BM = 256, BK = 64, HALF = 128, HTB = HALF * BK * 2  , STAGE_BYTES = 8 * HTB;

__host__ __device__ __forceinline__ int lds_byte(int r, int c) { const int st = (r >> 4) * 2 + (c >> 5), rr = r & 15, cc = c & 31, ob = rr * 64 + cc * 2; return st * 1024 + (ob ^ (((ob >> 9) & 1) << 5)); }
__host__ __device__ __forceinline__ void stage_rc(int b, int& R, int& C) { const int st = b / 1024, sb = b % 1024, swz = sb ^ (((sb >> 9) & 1) << 5); R = (st >> 1) * 16 + swz / 64; C = (st & 1) * 32 + (swz % 64) / 2; }
__host__ __device__ __forceinline__ int perm32(int rho) { const int n = rho >> 4, i = rho & 15; return 8 * (i >> 2) + 4 * n + (i & 3); }

struct Unit { const char* A; const char* B; int kind, pm, pn, aux; };

__device__ __forceinline__ unsigned cvt_pk_bf16(float lo, float hi) { unsigned r; asm volatile("v_cvt_pk_bf16_f32 %0, %1, %2" : "=v"(r) : "v"(lo), "v"(hi)); return r; }

template <class Epi, class Sched, bool GATHER = false>
__device__ __forceinline__ void gemm_phase(PG8_LAS unsigned char* lds, const int K_, const Sched& S, const Epi& E, const int wave_) {
    int K = K_; asm volatile("" : "+s"(K));
    int tid_; asm volatile("v_mbcnt_lo_u32_b32 %0, -1, 0\n\tv_mbcnt_hi_u32_b32 %0, -1, %0" : "=v"(tid_)); tid_ += wave_ * 64;
    const int tid = tid_, wid = __builtin_amdgcn_readfirstlane(tid >> 6), lane = tid & 63, wr = wid >> 2, wc = wid & 3, fr = lane & 15, fq = lane >> 4;
    const int nt = K / BK;
    unsigned voffA[2][2], voffN[2][2] = {{0u, 0u}, {0u, 0u}}, voffB[2]; int RA[2], CA[2];
#pragma unroll
    for (int i = 0; i < 2; ++i) { int R, C; stage_rc(tid * 16 + i * 8192, R, C); const int Rb = Epi::PERM ? ((R & ~31) + perm32(R & 31)) : R; RA[i] = R; CA[i] = C;
        voffA[0][i] = (unsigned)(R * K + C) * 2u; voffA[1][i] = (unsigned)((R + HALF) * K + C) * 2u; voffB[i] = (unsigned)(Rb * K + C) * 2u; }
    const size_t kstep = (size_t)(BK * 2);
    const size_t hstep = (size_t)HALF * K * 2;
    const unsigned ldsw = (unsigned)wid * 1024u;
    const int aoff = lds_byte(wr * 64 + fr, fq * 8), boff = lds_byte(wc * 32 + fr, fq * 8);
#define PG8_SA(b, h) (((b) * 2 + (h)) * HTB)
#define PG8_SB(b, h) ((4 + (b) * 2 + (h)) * HTB)
#define PG8_STAGE(bufoff, gbase, voff) do { _Pragma("unroll") for (int _i = 0; _i < 2; ++_i) \
        __builtin_amdgcn_global_load_lds((const unsigned*)((const char*)(gbase) + (voff)[_i]), (PG8_LAS unsigned*)(lds + (bufoff) + ldsw + _i * 8192), 16, 0, 0); } while (0)
#define PG8_LDA(dst, b, h) do { _Pragma("unroll") for (int m = 0; m < 4; ++m) _Pragma("unroll") for (int k = 0; k < 2; ++k) dst[m][k] = *(const PG8_LAS bf16x8*)(lds + PG8_SA(b, h) + aoff + m * 2048 + k * 1024); } while (0)
#define PG8_LDB(dst, b, h) do { _Pragma("unroll") for (int n = 0; n < 2; ++n) _Pragma("unroll") for (int k = 0; k < 2; ++k) dst[n][k] = *(const PG8_LAS bf16x8*)(lds + PG8_SB(b, h) + boff + n * 2048 + k * 1024); } while (0)
#define PG8_MMA(ai, bj, At, Bt) do { __builtin_amdgcn_s_setprio(1); _Pragma("unroll") for (int m = 0; m < 4; ++m) _Pragma("unroll") for (int n = 0; n < 2; ++n) _Pragma("unroll") for (int k = 0; k < 2; ++k) \
        acc[ai][bj][m][n] = __builtin_amdgcn_mfma_f32_16x16x32_bf16(Bt[n][k], At[m][k], acc[ai][bj][m][n], 0, 0, 0); __builtin_amdgcn_s_setprio(0); } while (0)
#define PG8_WAIT_V(n) asm volatile("s_waitcnt vmcnt(" #n ")" ::: "memory")
#define PG8_WAIT_L(n) asm volatile("s_waitcnt lgkmcnt(" #n ")" ::: "memory")
#define PG8_BAR __builtin_amdgcn_s_barrier()
#define PG8_SCHED __builtin_amdgcn_sched_barrier(0)
    Unit cur, nxt; int ui = 0;
    if (!S.next(0, cur)) return;
    if constexpr (GATHER) {
#pragma unroll
        for (int h = 0; h < 2; ++h)
#pragma unroll
            for (int i = 0; i < 2; ++i) voffA[h][i] = (unsigned)(S.arow(cur, h * HALF + RA[i]) * K + CA[i]) * 2u;
    }
    f32x4 acc[2][2][4][2];
#pragma unroll
    for (int a = 0; a < 2; ++a)
#pragma unroll
        for (int b = 0; b < 2; ++b)
#pragma unroll
            for (int m = 0; m < 4; ++m)
#pragma unroll
                for (int n = 0; n < 2; ++n) acc[a][b][m][n] = (f32x4){0.f, 0.f, 0.f, 0.f};
    bf16x8 At[4][2], B0[2][2], B1[2][2];
    const char* cA = cur.A; const char* cB = cur.B;
    PG8_STAGE(PG8_SB(0, 0), cB, voffB); PG8_STAGE(PG8_SB(0, 1), cB + hstep, voffB); PG8_STAGE(PG8_SA(0, 0), cA, voffA[0]); PG8_STAGE(PG8_SA(0, 1), cA, voffA[1]);
    if (wr == 1) PG8_BAR;
    PG8_WAIT_V(2); PG8_BAR;
    PG8_STAGE(PG8_SB(1, 0), cB + kstep, voffB); PG8_STAGE(PG8_SA(1, 0), cA + kstep, voffA[0]); PG8_STAGE(PG8_SB(1, 1), cB + hstep + kstep, voffB);
    PG8_WAIT_V(6); PG8_BAR;
    for (;;) {
        const bool has_next = S.next(ui + 1, nxt);
        const char* nA = has_next ? nxt.A : cA; const char* nB = has_next ? nxt.B : cB;
        if constexpr (GATHER) {
#pragma unroll
            for (int h = 0; h < 2; ++h)
#pragma unroll
                for (int i = 0; i < 2; ++i) voffN[h][i] = has_next ? (unsigned)(S.arow(nxt, h * HALF + RA[i]) * K + CA[i]) * 2u : voffA[h][i];
        }
#pragma unroll 1
        for (int t = 0; t < nt; t += 2) {
            const bool last = (t == nt - 2);
            const char* a1 = cA + (size_t)(t + 1) * kstep;
            const char* a2 = last ? nA : cA + (size_t)(t + 2) * kstep; const char* b2 = last ? nB : cB + (size_t)(t + 2) * kstep;
            const char* a3 = a2 + kstep; const char* b3 = b2 + kstep;
            PG8_LDB(B0, 0, 0); PG8_LDB(B1, 0, 1); PG8_SCHED; PG8_LDA(At, 0, 0); PG8_STAGE(PG8_SA(1, 1), a1, voffA[1]);
            if constexpr (GATHER) { if (last) {
#pragma unroll
                for (int h = 0; h < 2; ++h)
#pragma unroll
                    for (int i = 0; i < 2; ++i) voffA[h][i] = voffN[h][i]; } }
            PG8_WAIT_V(8); PG8_WAIT_L(0); PG8_BAR; PG8_MMA(0, 0, At, B0); PG8_MMA(0, 1, At, B1); PG8_BAR; PG8_SCHED;
            PG8_LDA(At, 0, 1); PG8_STAGE(PG8_SB(0, 0), b2, voffB); PG8_STAGE(PG8_SB(0, 1), b2 + hstep, voffB); PG8_STAGE(PG8_SA(0, 0), a2, voffA[0]);
            PG8_WAIT_V(8); PG8_WAIT_L(0); PG8_BAR; PG8_MMA(1, 0, At, B0); PG8_MMA(1, 1, At, B1); PG8_BAR; PG8_SCHED;
            PG8_LDB(B0, 1, 0); PG8_LDB(B1, 1, 1); PG8_SCHED; PG8_LDA(At, 1, 0); PG8_STAGE(PG8_SA(0, 1), a2, voffA[1]);
            PG8_WAIT_V(8); PG8_WAIT_L(0); PG8_BAR; PG8_MMA(0, 0, At, B0); PG8_MMA(0, 1, At, B1); PG8_BAR; PG8_SCHED;
            PG8_LDA(At, 1, 1); PG8_STAGE(PG8_SB(1, 0), b3, voffB); PG8_STAGE(PG8_SB(1, 1), b3 + hstep, voffB); PG8_STAGE(PG8_SA(1, 0), a3, voffA[0]);
            PG8_WAIT_V(8); PG8_WAIT_L(0); PG8_BAR; PG8_MMA(1, 0, At, B0); PG8_MMA(1, 1, At, B1); PG8_BAR; PG8_SCHED;
        }
        if (wr == 0) PG8_BAR;
        { Unit ce = cur; ce.pm = __builtin_amdgcn_readfirstlane(cur.pm); ce.pn = __builtin_amdgcn_readfirstlane(cur.pn); ce.kind = __builtin_amdgcn_readfirstlane(cur.kind); ce.aux = __builtin_amdgcn_readfirstlane(cur.aux); int fr_ = fr, fq_ = fq;
          asm volatile("" : "+s"(ce.pm), "+s"(ce.pn), "+s"(ce.kind), "+s"(ce.aux), "+v"(fr_), "+v"(fq_));
          E(acc, ce, wr, wc, fr_, fq_); }
        if (!has_next) break;
#pragma unroll
        for (int a = 0; a < 2; ++a)
#pragma unroll
            for (int b = 0; b < 2; ++b)
#pragma unroll
                for (int m = 0; m < 4; ++m)
#pragma unroll
                    for (int n = 0; n < 2; ++n) acc[a][b][m][n] = (f32x4){0.f, 0.f, 0.f, 0.f};
        cur = nxt; cA = nA; cB = nB; ++ui;
        if (wr == 1) PG8_BAR;
    }
    PG8_WAIT_V(0);
    PG8_BAR;
#undef PG8_SA
#undef PG8_SB
#undef PG8_STAGE
#undef PG8_LDA
#undef PG8_LDB
#undef PG8_MMA
#undef PG8_WAIT_V
#undef PG8_WAIT_L
#undef PG8_BAR
#undef PG8_SCHED
}
}
constexpr int D = 1024, NB = 4, S = 4096, M = NB * S, DEPTH = 4, INW = 2560;
constexpr float DN_ALPHA = 1.681792830507429f;
constexpr float QSCALE = 0.125f * 1.4426950408889634f;
constexpr int NWAVES = 8;
constexpr size_t MiB = 1u << 20;
constexpr size_t TILEB = (size_t)256 * D * 2;
constexpr size_t WS_CTL = 0, CTL_ZERO_BYTES = 1 * MiB;
constexpr size_t WS_CS = 1 * MiB;
constexpr size_t WS_WIN = 2 * MiB, WIN_LAYER = 5 * MiB;
constexpr size_t WS_XB = 22 * MiB;
constexpr size_t WS_QKP = 118 * MiB;
constexpr size_t WS_UVT = 158 * MiB;
constexpr size_t WS_MIXB = 198 * MiB;
constexpr size_t WS_STASH = 54 * MiB;
constexpr size_t WS_WOUT = 383 * MiB, WOUT_LAYER = 2 * MiB;
constexpr size_t WS_TOKIDX = 391 * MiB, WS_GATE = 392 * MiB;
constexpr size_t WS_YMOE = WS_QKP;
constexpr size_t WS_YP = 86 * MiB;
constexpr size_t WS_ACT = 230 * MiB;
constexpr size_t WS_WBUF = 288 * MiB, WBUF_STRIDE = 35 * MiB, WB_W13 = 0, WB_W2 = 16 * MiB, WB_WG = 24 * MiB, WB_WP = 26 * MiB, WB_PB = 27 * MiB;
constexpr size_t WS_KF = 262 * MiB, WS_PS = 278 * MiB, WS_HT = 280 * MiB;
constexpr size_t WS_WR = 256 * MiB;
constexpr int CW_BAR = 4096, CW_CNT = 8192, CNT_STRIDE = 64;

#define GAS __attribute__((address_space(1)))
#define LAS __attribute__((address_space(3)))
typedef unsigned short bf16;
typedef unsigned v4u __attribute__((ext_vector_type(4)));
typedef float f32x4 __attribute__((ext_vector_type(4)));
typedef short bf16x8 __attribute__((ext_vector_type(8)));
typedef GAS unsigned gu32;
typedef GAS unsigned long long gu64;
#define RLX_AGENT __ATOMIC_RELAXED, __HIP_MEMORY_SCOPE_AGENT
#define LDS_WAIT() asm volatile("s_waitcnt lgkmcnt(0)" ::: "memory")
#define VM_WAIT() asm volatile("s_waitcnt vmcnt(0)" ::: "memory")
__device__ __forceinline__ unsigned long long rt() { return __builtin_amdgcn_s_memrealtime(); }
__device__ __forceinline__ unsigned f2bf(float f) { unsigned u = __builtin_bit_cast(unsigned, f); return (u + 0x7fffu + ((u >> 16) & 1u)) >> 16; }
__device__ __forceinline__ unsigned pk2(float lo, float hi) { return f2bf(lo) | (f2bf(hi) << 16); }

#define XB_TMO      128
#define XB_XCNT(j)  (256  + 64 * (j))
#define XB_XSUB(j)  (1280 + 64 * (j))
#define XB_XGEN(j)  (2304 + 64 * (j))
#define XB_TOP      3328
#define XB_TOPGEN   3392
#define XCD_BAR_WORDS 3456
#define XB_SPIN_CAP (1u << 18)

__device__ __forceinline__ unsigned xb_ld(unsigned* p)              { return __hip_atomic_load(p, __ATOMIC_RELAXED, __HIP_MEMORY_SCOPE_AGENT); }
__device__ __forceinline__ unsigned xb_add(unsigned* p, unsigned v) { return __hip_atomic_fetch_add(p, v, __ATOMIC_RELAXED, __HIP_MEMORY_SCOPE_AGENT); }
__device__ __forceinline__ unsigned xb_xcc_id() { return (unsigned)__builtin_amdgcn_s_getreg((3 << 11) | 20) & 0xFu; }
#define XB_SPIN(cond, bar) do { unsigned _sp = 0; while (cond) { __builtin_amdgcn_s_sleep(1); \
    if ((++_sp & 255u) == 0u) { if (xb_ld(&(bar)[XB_TMO])) break; if (_sp > XB_SPIN_CAP) { atomicAdd(&(bar)[XB_TMO], 1u); break; } } } } while (0)

struct XcdBarrier {
    unsigned* bar; unsigned x;
    volatile LAS unsigned* st;
};

__device__ __forceinline__ unsigned mk_lane_id() { unsigned x; asm volatile("v_mbcnt_lo_u32_b32 %0, -1, 0\n\tv_mbcnt_hi_u32_b32 %0, -1, %0" : "=v"(x)); return x; }
__device__ __forceinline__ XcdBarrier xcd_barrier_post(unsigned* bar, volatile LAS unsigned* st, int wave) {
    XcdBarrier b; b.bar = bar; b.x = xb_xcc_id(); b.st = st;
    if (wave == 0 && mk_lane_id() == 0u) (void)xb_add(&bar[XB_XCNT(b.x)], 1u);
    return b;
}
__device__ __forceinline__ void xcd_barrier_complete(unsigned* bar, unsigned x, unsigned& nloc, unsigned& nx) {
    const unsigned G = gridDim.x * gridDim.y * gridDim.z;
    unsigned sum, cnt, mine, sp = 0u;
    for (;;) {
        sum = 0u; cnt = 0u; mine = 0u;
#pragma unroll
        for (unsigned j = 0; j < 16; ++j) { const unsigned c = xb_ld(&bar[XB_XCNT(j)]); sum += c; cnt += (c > 0u) ? 1u : 0u; mine = (j == x) ? c : mine; }
        if (sum == G) break;
        __builtin_amdgcn_s_sleep(1);
        if ((++sp & 255u) == 0u) { if (xb_ld(&bar[XB_TMO])) break; if (sp > XB_SPIN_CAP) { atomicAdd(&bar[XB_TMO], 1u); break; } }
    }
    nloc = mine > 0u ? mine : 1u; nx = cnt > 0u ? cnt : 1u;
}

__device__ __forceinline__ void xcd_barrier(const XcdBarrier& b, int wave) {
    asm volatile("" : "+s"(wave));
    const bool t0_ = (wave == 0) && (mk_lane_id() == 0u);
    asm volatile("s_waitcnt vmcnt(0)" ::: "memory");
    __syncthreads();
    if (t0_) {
        unsigned* bar = b.bar; unsigned bx_ = b.x; asm volatile("" : "+s"(bx_));
        __builtin_amdgcn_s_waitcnt(0);
        unsigned nloc = b.st[0], nx = b.st[1];
        if (nloc == 0u) { xcd_barrier_complete(bar, bx_, nloc, nx); b.st[0] = nloc; b.st[1] = nx; }
        const unsigned old = xb_add(&bar[XB_XSUB(bx_)], 1u);
        const unsigned gen = old / nloc;
        if (old + 1u == (gen + 1u) * nloc) {
            __builtin_amdgcn_fence(__ATOMIC_RELEASE, "agent");
            asm volatile("s_waitcnt vmcnt(0)" ::: "memory");
            const unsigned og = xb_add(&bar[XB_TOP], 1u);
            const unsigned tg = og / nx;
            if (og + 1u == (tg + 1u) * nx) xb_add(&bar[XB_TOPGEN], 1u);
            else XB_SPIN(xb_ld(&bar[XB_TOPGEN]) == tg, bar);
            __builtin_amdgcn_fence(__ATOMIC_ACQUIRE, "agent");
            xb_add(&bar[XB_XGEN(bx_)], 1u);
            asm volatile("s_waitcnt vmcnt(0)" ::: "memory");
        } else {
            XB_SPIN(xb_ld(&bar[XB_XGEN(bx_)]) == gen, bar);
            __builtin_amdgcn_fence(__ATOMIC_ACQUIRE, "agent");
            asm volatile("s_waitcnt vmcnt(0)" ::: "memory");
        }
    }
    __syncthreads();
}
__device__ __forceinline__ float bf2f(unsigned short b) { return __uint_as_float((unsigned)b << 16); }
#define MK_DPP(v, ctrl) __uint_as_float(__builtin_amdgcn_update_dpp(0, __float_as_uint(v), (ctrl), 0xF, 0xF, true))
__device__ __forceinline__ float xsum16(float v) { const auto r = __builtin_amdgcn_permlane16_swap(__float_as_uint(v), __float_as_uint(v), false, false); return __uint_as_float(r[0]) + __uint_as_float(r[1]); }
__device__ __forceinline__ float xsum32(float v) { const auto r = __builtin_amdgcn_permlane32_swap(__float_as_uint(v), __float_as_uint(v), false, false); return __uint_as_float(r[0]) + __uint_as_float(r[1]); }
__device__ __forceinline__ float wave_sum(float v) {
    v += MK_DPP(v, 0xB1); v += MK_DPP(v, 0x4E);
    v += MK_DPP(v, 0x141); v += MK_DPP(v, 0x140);
    return xsum32(xsum16(v));
}
__device__ __forceinline__ void p0_transpose_block(const float* W, int K, int N, int k0, int n0, bf16* WT, int mode, LAS float* scr, int lane) {
#pragma unroll
    for (int i = 0; i < 8; ++i) { const int kk = 8 * i + (lane >> 3), n4 = (lane & 7) * 4;
        const f32x4 w = *(const GAS f32x4*)(W + (size_t)(k0 + kk) * N + n0 + n4);
        LAS float* d = scr + kk * 33 + n4; d[0] = w.x; d[1] = w.y; d[2] = w.z; d[3] = w.w; }
    LDS_WAIT(); asm volatile("" ::: "memory");
    const int c = lane & 7;
#pragma unroll 1
    for (int j = 0; j < 4; ++j) { const int n = (lane >> 3) + 8 * j; const LAS float* s = scr + (8 * c) * 33 + n;
        v4u o; o.x = pk2(s[0 * 33], s[1 * 33]); o.y = pk2(s[2 * 33], s[3 * 33]); o.z = pk2(s[4 * 33], s[5 * 33]); o.w = pk2(s[6 * 33], s[7 * 33]);
        const int f = n0 + n; const size_t drow = mode == 0 ? (size_t)n : (size_t)(8 * (f >> 2) + (f & 3) + (mode == 2 ? 4 : 0));
        *(GAS v4u*)(WT + drow * K + k0 + 8 * c) = o; }
    LDS_WAIT(); asm volatile("" ::: "memory");
}
template <class TX> __device__ __forceinline__ void ln_row(const TX* x0, float a, const bf16* y1, const bf16* y2, const bf16* y3, const float* g, const float* b, float* of, bf16* ob, int lane) {
    f32x4 v[4]; float s = 0.f;
#pragma unroll
    for (int j = 0; j < 4; ++j) { const int c = 4 * lane + 256 * j;
        if constexpr (sizeof(TX) == 4) v[j] = *(const GAS f32x4*)(x0 + c) * a;
        else { const unsigned long long w = *(const GAS unsigned long long*)(x0 + c); v[j] = (f32x4){bf2f((bf16)w), bf2f((bf16)(w >> 16)), bf2f((bf16)(w >> 32)), bf2f((bf16)(w >> 48))} * a; }
        if (y1) { const unsigned long long w = *(const GAS unsigned long long*)(y1 + c); v[j] += (f32x4){bf2f((bf16)w), bf2f((bf16)(w >> 16)), bf2f((bf16)(w >> 32)), bf2f((bf16)(w >> 48))}; }
        if (y2) { const unsigned long long w = *(const GAS unsigned long long*)(y2 + c); v[j] += (f32x4){bf2f((bf16)w), bf2f((bf16)(w >> 16)), bf2f((bf16)(w >> 32)), bf2f((bf16)(w >> 48))}; }
        if (y3) { const unsigned long long w = *(const GAS unsigned long long*)(y3 + c); v[j] += (f32x4){bf2f((bf16)w), bf2f((bf16)(w >> 16)), bf2f((bf16)(w >> 32)), bf2f((bf16)(w >> 48))}; }
        s += (v[j].x + v[j].y) + (v[j].z + v[j].w); }
    const float mean = wave_sum(s) * (1.f / D); float s2 = 0.f;
#pragma unroll
    for (int j = 0; j < 4; ++j) { v[j] = v[j] - mean; s2 += (v[j].x * v[j].x + v[j].y * v[j].y) + (v[j].z * v[j].z + v[j].w * v[j].w); }
    const float rstd = __builtin_amdgcn_rsqf(wave_sum(s2) * (1.f / D) + 1e-5f);
#pragma unroll
    for (int j = 0; j < 4; ++j) { const int c = 4 * lane + 256 * j; const f32x4 o = v[j] * rstd * *(const GAS f32x4*)(g + c) + *(const GAS f32x4*)(b + c);
        if (of) *(GAS f32x4*)(of + c) = o;
        if (ob) *(GAS unsigned long long*)(ob + c) = (unsigned long long)pk2(o.x, o.y) | ((unsigned long long)pk2(o.z, o.w) << 32); }
}

__device__ __forceinline__ void bf8_acc(f32x4& lo, f32x4& hi, const v4u w, float a) {
    lo += (f32x4){bf2f((bf16)w.x), bf2f((bf16)(w.x >> 16)), bf2f((bf16)w.y), bf2f((bf16)(w.y >> 16))} * a; hi += (f32x4){bf2f((bf16)w.z), bf2f((bf16)(w.z >> 16)), bf2f((bf16)w.w), bf2f((bf16)(w.w >> 16))} * a; }
__device__ __forceinline__ void ln2_row4(const bf16* x0, float a, const bf16* ym, const bf16* yp, const float* g, const float* b, float* of, bf16* ob, int lane) {
    f32x4 v[4][4]; float s[4];
#pragma unroll
    for (int r = 0; r < 4; ++r) {
#pragma unroll
        for (int p = 0; p < 2; ++p) { const int c = 8 * lane + 512 * p;
            const v4u w0 = *(const GAS v4u*)(x0 + (size_t)r * D + c), w1 = *(const GAS v4u*)(ym + (size_t)r * 2 * D + c), w2 = *(const GAS v4u*)(ym + (size_t)r * 2 * D + D + c), w3 = *(const GAS v4u*)(yp + (size_t)r * D + c);
            v[r][2 * p] = (f32x4){0.f, 0.f, 0.f, 0.f}; v[r][2 * p + 1] = (f32x4){0.f, 0.f, 0.f, 0.f};
            bf8_acc(v[r][2 * p], v[r][2 * p + 1], w0, a); bf8_acc(v[r][2 * p], v[r][2 * p + 1], w1, 1.f); bf8_acc(v[r][2 * p], v[r][2 * p + 1], w2, 1.f); bf8_acc(v[r][2 * p], v[r][2 * p + 1], w3, 1.f); }
        s[r] = 0.f;
#pragma unroll
        for (int j = 0; j < 4; ++j) s[r] += (v[r][j].x + v[r][j].y) + (v[r][j].z + v[r][j].w); }
    float rstd[4];
#pragma unroll
    for (int r = 0; r < 4; ++r) { const float mean = wave_sum(s[r]) * (1.f / D); float s2 = 0.f;
#pragma unroll
        for (int j = 0; j < 4; ++j) { v[r][j] = v[r][j] - mean; s2 += (v[r][j].x * v[r][j].x + v[r][j].y * v[r][j].y) + (v[r][j].z * v[r][j].z + v[r][j].w * v[r][j].w); }
        rstd[r] = __builtin_amdgcn_rsqf(wave_sum(s2) * (1.f / D) + 1e-5f); }
#pragma unroll
    for (int p = 0; p < 2; ++p) { const int c = 8 * lane + 512 * p; const f32x4 g0 = *(const GAS f32x4*)(g + c), g1 = *(const GAS f32x4*)(g + c + 4), b0 = *(const GAS f32x4*)(b + c), b1 = *(const GAS f32x4*)(b + c + 4);
#pragma unroll
        for (int r = 0; r < 4; ++r) { const f32x4 o0 = v[r][2 * p] * rstd[r] * g0 + b0, o1 = v[r][2 * p + 1] * rstd[r] * g1 + b1;
            if (of) { *(GAS f32x4*)(of + (size_t)r * D + c) = o0; *(GAS f32x4*)(of + (size_t)r * D + c + 4) = o1; }
            if (ob) { v4u w; w.x = pk2(o0.x, o0.y); w.y = pk2(o0.z, o0.w); w.z = pk2(o1.x, o1.y); w.w = pk2(o1.z, o1.w); *(GAS v4u*)(ob + (size_t)r * D + c) = w; } } }
}

__device__ __forceinline__ void ln0_row4(const float* x0, const float* g, const float* b, bf16* ob, int lane) {
    f32x4 v[4][4]; float s[4];
#pragma unroll
    for (int r = 0; r < 4; ++r) { s[r] = 0.f;
#pragma unroll
        for (int p = 0; p < 2; ++p) { const int c = 8 * lane + 512 * p; v[r][2 * p] = __builtin_nontemporal_load((const GAS f32x4*)(x0 + (size_t)r * D + c)); v[r][2 * p + 1] = __builtin_nontemporal_load((const GAS f32x4*)(x0 + (size_t)r * D + c + 4)); }
#pragma unroll
        for (int j = 0; j < 4; ++j) s[r] += (v[r][j].x + v[r][j].y) + (v[r][j].z + v[r][j].w); }
    float rstd[4];
#pragma unroll
    for (int r = 0; r < 4; ++r) { const float mean = wave_sum(s[r]) * (1.f / D); float s2 = 0.f;
#pragma unroll
        for (int j = 0; j < 4; ++j) { v[r][j] = v[r][j] - mean; s2 += (v[r][j].x * v[r][j].x + v[r][j].y * v[r][j].y) + (v[r][j].z * v[r][j].z + v[r][j].w * v[r][j].w); }
        rstd[r] = __builtin_amdgcn_rsqf(wave_sum(s2) * (1.f / D) + 1e-5f); }
#pragma unroll
    for (int p = 0; p < 2; ++p) { const int c = 8 * lane + 512 * p; const f32x4 g0 = *(const GAS f32x4*)(g + c), g1 = *(const GAS f32x4*)(g + c + 4), b0 = *(const GAS f32x4*)(b + c), b1 = *(const GAS f32x4*)(b + c + 4);
#pragma unroll
        for (int r = 0; r < 4; ++r) { const f32x4 o0 = v[r][2 * p] * rstd[r] * g0 + b0, o1 = v[r][2 * p + 1] * rstd[r] * g1 + b1;
            v4u w; w.x = pk2(o0.x, o0.y); w.y = pk2(o0.z, o0.w); w.z = pk2(o1.x, o1.y); w.w = pk2(o1.z, o1.w); *(GAS v4u*)(ob + (size_t)r * D + c) = w; } }
}

struct SchedIn {
    int vcu, G; const char* xb; const char* wsw; const char* wnm;
    __device__ __forceinline__ bool next(int i, pg8::Unit& u) const {
        const int L = i * G + vcu; if (L >= 640) return false;
        const int t = L / 10, j = L % 10;
        const int sw = __builtin_amdgcn_readfirstlane((unsigned)(j + 27) >> 5);
        const int jj = j - 5 * sw; const char* tp = xb + (size_t)t * TILEB; const char* wp = (sw ? wsw : wnm) + (size_t)jj * TILEB;
        u.kind = sw; u.pm = sw ? jj : t; u.pn = sw ? t : jj; u.A = sw ? wp : tp; u.B = sw ? tp : wp;
        u.aux = 0; return true;
    }
};
struct EpiIn {
    static constexpr bool PERM = true;
    bf16* qkp; bf16* uvt; const float* cs;
    __device__ __forceinline__ void operator()(const pg8::f32x4 (&acc)[2][2][4][2], const pg8::Unit& u, int wr, int wc, int fr, int fq) const {
        bf16* base = u.kind == 0 ? qkp : uvt; const int ldc = u.kind == 0 ? 1280 : M;
        const int row0 = u.pm * 256 + wr * 64 + fr, col0 = u.pn * 256 + wc * 32 + 8 * fq;
        const bool rope = (u.kind == 0) && (u.pn < 4) && ((wc & 1) == 0);
        const float sc = (u.kind == 0 && u.pn < 2) ? QSCALE : 1.f;
        const float sgn = fq == 0 ? -1.f : 1.f;
        const bool vperm = (u.kind == 1) && (u.pm >= 3);
#pragma unroll
        for (int ai = 0; ai < 2; ++ai)
#pragma unroll
            for (int m = 0; m < 4; ++m) { const int row = row0 + ai * 128 + m * 16; bf16* rowp = base + (size_t)row * ldc + col0;
                f32x4 cv0 = {1.f, 1.f, 1.f, 1.f}, cv1 = cv0, sv0 = {0.f, 0.f, 0.f, 0.f}, sv1 = sv0;
                if (rope && fq < 2) { const float* t = cs + (size_t)(row & (S - 1)) * 16; cv0 = *(const f32x4*)t; cv1 = *(const f32x4*)(t + 4); sv0 = *(const f32x4*)(t + 8) * sgn; sv1 = *(const f32x4*)(t + 12) * sgn; }
#pragma unroll
                for (int bj = 0; bj < 2; ++bj) { f32x4 v0 = acc[ai][bj][m][0], v1 = acc[ai][bj][m][1];
                    if (rope) { f32x4 p0, p1;
#pragma unroll
                        for (int e = 0; e < 4; ++e) { const auto r0 = __builtin_amdgcn_permlane16_swap(__float_as_uint(v0[e]), __float_as_uint(v0[e]), false, false), r1 = __builtin_amdgcn_permlane16_swap(__float_as_uint(v1[e]), __float_as_uint(v1[e]), false, false);
                            p0[e] = __uint_as_float((fq & 1) ? r0[0] : r0[1]); p1[e] = __uint_as_float((fq & 1) ? r1[0] : r1[1]); }
                        v0 = v0 * cv0 + p0 * sv0; v1 = v1 * cv1 + p1 * sv1; }
                    v0 = v0 * sc; v1 = v1 * sc;
                    pg8::u32x4 w; w.x = pg8::cvt_pk_bf16(v0[0], v0[1]); w.y = pg8::cvt_pk_bf16(v0[2], v0[3]); w.z = pg8::cvt_pk_bf16(v1[0], v1[1]); w.w = pg8::cvt_pk_bf16(v1[2], v1[3]);
                    if (vperm) {
                        bf16* gp = rowp + bj * 128 - (fq & 1) * 8;
                        typedef unsigned u32x2 __attribute__((ext_vector_type(2)));
                        *(u32x2*)(gp + ((fq & 1) ? 4 : 0)) = (u32x2){w.x, w.y}; *(u32x2*)(gp + ((fq & 1) ? 12 : 8)) = (u32x2){w.z, w.w};
                    } else *(pg8::u32x4*)(rowp + bj * 128) = w; } }
    }
};

struct SchedOut {
    int vcu, G; const char* a; const char* w;
    __device__ __forceinline__ bool next(int i, pg8::Unit& u) const {
        const int L = i * G + vcu; if (L >= 256) return false;
        u.kind = 0; u.pm = L >> 2; u.pn = L & 3; u.aux = 0; u.A = a + (size_t)u.pm * TILEB; u.B = w + (size_t)u.pn * TILEB; return true;
    }
};
struct EpiRes {
    static constexpr bool PERM = true;
    bf16* XB;
    __device__ __forceinline__ void operator()(const pg8::f32x4 (&acc)[2][2][4][2], const pg8::Unit& u, int wr, int wc, int fr, int fq) const {
        const int row0 = u.pm * 256 + wr * 64 + fr, col0 = u.pn * 256 + wc * 32 + 8 * fq;
#pragma unroll
        for (int ai = 0; ai < 2; ++ai)
#pragma unroll
            for (int m = 0; m < 4; ++m) { bf16* rowp = XB + (size_t)(row0 + ai * 128 + m * 16) * D + col0;
#pragma unroll
                for (int bj = 0; bj < 2; ++bj) { pg8::u32x4* p = (pg8::u32x4*)(rowp + bj * 128); const pg8::u32x4 x = *p; const pg8::f32x4 v0 = acc[ai][bj][m][0], v1 = acc[ai][bj][m][1];
                    pg8::u32x4 w; w.x = pg8::cvt_pk_bf16(bf2f((bf16)x.x) * DN_ALPHA + v0[0], bf2f((bf16)(x.x >> 16)) * DN_ALPHA + v0[1]); w.y = pg8::cvt_pk_bf16(bf2f((bf16)x.y) * DN_ALPHA + v0[2], bf2f((bf16)(x.y >> 16)) * DN_ALPHA + v0[3]);
                    w.z = pg8::cvt_pk_bf16(bf2f((bf16)x.z) * DN_ALPHA + v1[0], bf2f((bf16)(x.z >> 16)) * DN_ALPHA + v1[1]); w.w = pg8::cvt_pk_bf16(bf2f((bf16)x.w) * DN_ALPHA + v1[2], bf2f((bf16)(x.w >> 16)) * DN_ALPHA + v1[3]);
                    *p = w; } }
    }
};
struct RouteLds { unsigned lcnt[16]; unsigned gbase[16]; int e0[64], e1[64]; unsigned r0[64], r1[64]; float g0[64], g1[64]; };
constexpr int RT_PITCH = 2064;
template <int DRY = 0> __device__ __forceinline__ void ln1_router_chunk(LAS RouteLds* R, LAS unsigned char* tile, int row0, bf16* XB, bf16* XOUT, const float* g, const float* b, const bf16* wrt, const float* bgc, const float* bgf,
                                                 gu32* cnt, int* tokidx, float* gate, int wave, int lane) {
    const int tidl = wave * 64 + lane;
    if (tidl < 16) R->lcnt[tidl] = 0u;
#pragma unroll 2
    for (int r = 0; r < 8; ++r) { const int rl = wave * 8 + r; bf16* xbrow = XB + (size_t)(row0 + rl) * D; f32x4 v[4]; float s = 0.f;
#pragma unroll
        for (int p = 0; p < 2; ++p) { const v4u w = *(const GAS v4u*)(xbrow + 8 * lane + 512 * p);
            v[2 * p] = (f32x4){bf2f((bf16)w.x), bf2f((bf16)(w.x >> 16)), bf2f((bf16)w.y), bf2f((bf16)(w.y >> 16))}; v[2 * p + 1] = (f32x4){bf2f((bf16)w.z), bf2f((bf16)(w.z >> 16)), bf2f((bf16)w.w), bf2f((bf16)(w.w >> 16))};
            s += ((v[2 * p].x + v[2 * p].y) + (v[2 * p].z + v[2 * p].w)) + ((v[2 * p + 1].x + v[2 * p + 1].y) + (v[2 * p + 1].z + v[2 * p + 1].w)); }
        const float mean = wave_sum(s) * (1.f / D); float s2 = 0.f;
#pragma unroll
        for (int j = 0; j < 4; ++j) { v[j] = v[j] - mean; s2 += (v[j].x * v[j].x + v[j].y * v[j].y) + (v[j].z * v[j].z + v[j].w * v[j].w); }
        const float rstd = __builtin_amdgcn_rsqf(wave_sum(s2) * (1.f / D) + 1e-5f);
#pragma unroll
        for (int p = 0; p < 2; ++p) { const int c = 8 * lane + 512 * p;
            const f32x4 o0 = v[2 * p] * rstd * *(const GAS f32x4*)(g + c) + *(const GAS f32x4*)(b + c), o1 = v[2 * p + 1] * rstd * *(const GAS f32x4*)(g + c + 4) + *(const GAS f32x4*)(b + c + 4);
            v4u w; w.x = pk2(o0.x, o0.y); w.y = pk2(o0.z, o0.w); w.z = pk2(o1.x, o1.y); w.w = pk2(o1.z, o1.w);
            *(GAS v4u*)(xbrow + c) = w;
            *(LAS v4u*)(tile + rl * RT_PITCH + c * 2) = w; } }
    LDS_WAIT(); __syncthreads();
    if (DRY == 1) return;
    typedef float f32x16_t __attribute__((ext_vector_type(16)));
    f32x16_t pacc;
#pragma unroll
    for (int r = 0; r < 16; ++r) pacc[r] = 0.f;
    { const int rt = wave & 1, kq = wave >> 1, r32 = lane & 31, hi = lane >> 5;
      LAS const unsigned char* ap = tile + (32 * rt + r32) * RT_PITCH + (256 * kq + 8 * hi) * 2;
      const bf16* bh = wrt + (size_t)r32 * D + 256 * kq + 8 * hi; const bf16* bl = bh + 32 * D;
#pragma unroll 4
      for (int ks = 0; ks < 16; ++ks) { const bf16x8 af = *(LAS const bf16x8*)(ap + ks * 32), bhf = *(const GAS bf16x8*)(bh + ks * 16), blf = *(const GAS bf16x8*)(bl + ks * 16);
          pacc = __builtin_amdgcn_mfma_f32_32x32x16_bf16(af, bhf, pacc, 0, 0, 0); pacc = __builtin_amdgcn_mfma_f32_32x32x16_bf16(af, blf, pacc, 0, 0, 0); } }
    LDS_WAIT(); __syncthreads();
    if (DRY == 2) return;
    { const int rt = wave & 1, kq = wave >> 1, r32 = lane & 31, hi = lane >> 5;
      LAS float* P = (LAS float*)tile + (kq * 64 + rt * 32) * 33 + r32;
#pragma unroll
      for (int r = 0; r < 16; ++r) P[((r & 3) + 8 * (r >> 2) + 4 * hi) * 33] = pacc[r]; }
    LDS_WAIT(); __syncthreads();
    if (wave == 0) {
        float my[20];
#pragma unroll
        for (int i = 0; i < 20; ++i) { float t = 0.f;
#pragma unroll
            for (int q = 0; q < 4; ++q) t += ((LAS const float*)tile)[(q * 64 + lane) * 33 + i];
            my[i] = t; }
        const int rl = lane;
        float pg[4], mx = -INFINITY, sum = 0.f;
#pragma unroll
        for (int j = 0; j < 4; ++j) { pg[j] = my[j] + bgc[j]; mx = fmaxf(mx, pg[j]); }
#pragma unroll
        for (int j = 0; j < 4; ++j) { pg[j] = expf(pg[j] - mx); sum += pg[j]; }
        int gi = 0; float gw = pg[0];
#pragma unroll
        for (int j = 1; j < 4; ++j) if (pg[j] > gw) { gw = pg[j]; gi = j; }
        gw /= sum;
        float fs[4]; mx = -INFINITY;
#pragma unroll
        for (int j = 0; j < 4; ++j) { float t = 0.f;
#pragma unroll
            for (int q = 0; q < 4; ++q) if (q == gi) t = my[4 + q * 4 + j] + bgf[q * 4 + j];
            fs[j] = t; mx = fmaxf(mx, t); }
#pragma unroll
        for (int j = 0; j < 4; ++j) fs[j] = expf(fs[j] - mx);
        int t0 = 0; float v0 = fs[0];
#pragma unroll
        for (int j = 1; j < 4; ++j) if (fs[j] > v0) { v0 = fs[j]; t0 = j; }
        int t1 = -1; float v1 = -1.f;
#pragma unroll
        for (int j = 0; j < 4; ++j) if (j != t0 && fs[j] > v1) { v1 = fs[j]; t1 = j; }
        const float ts = v0 + v1; const int e0 = gi * 4 + t0, e1 = gi * 4 + t1;
        R->e0[rl] = e0; R->e1[rl] = e1; R->g0[rl] = gw * (v0 / ts); R->g1[rl] = gw * (v1 / ts);
        R->r0[rl] = __hip_atomic_fetch_add(&R->lcnt[e0], 1u, __ATOMIC_RELAXED, __HIP_MEMORY_SCOPE_WORKGROUP);
        R->r1[rl] = __hip_atomic_fetch_add(&R->lcnt[e1], 1u, __ATOMIC_RELAXED, __HIP_MEMORY_SCOPE_WORKGROUP);
    }
    LDS_WAIT(); __syncthreads();
    if (DRY == 3) return;
    if (tidl < 16) { const unsigned n = R->lcnt[tidl]; R->gbase[tidl] = n ? __hip_atomic_fetch_add(cnt + tidl * CNT_STRIDE, n, RLX_AGENT) : 0u; }
    LDS_WAIT(); __syncthreads();
    if (tidl < 64) { const int rl = tidl, tok = row0 + rl; const int e0 = R->e0[rl], e1 = R->e1[rl]; const unsigned p0 = R->gbase[e0] + R->r0[rl], p1 = R->gbase[e1] + R->r1[rl];
        tokidx[(size_t)e0 * M + p0] = tok * 2; gate[(size_t)e0 * M + p0] = R->g0[rl]; tokidx[(size_t)e1 * M + p1] = tok * 2 + 1; gate[(size_t)e1 * M + p1] = R->g1[rl]; }
    LDS_WAIT(); __syncthreads();
}

struct MoeTab { LAS const int* p;
    __device__ __forceinline__ int cnt(int e) const { return __builtin_amdgcn_readfirstlane(p[e]); }
    __device__ __forceinline__ int pre(int e) const { return __builtin_amdgcn_readfirstlane(p[16 + e]); } };
__device__ __forceinline__ void moe_tab_build(LAS int* p, const gu32* cnt, bool t0) {
    if (t0) { int acc = 0;
        for (int e = 0; e < 16; ++e) { const int c = (int)__hip_atomic_load(cnt + e * CNT_STRIDE, RLX_AGENT); p[e] = c; p[16 + e] = acc; acc += (c + 255) >> 8; }
        p[32] = acc; }
    __syncthreads();
}
template <int NPN> struct SchedMoe {
    int vcu, G; MoeTab T; const char* a; const char* w; size_t wexp  ; const int* tokidx; size_t atile  ;
    __device__ __forceinline__ bool next(int i, pg8::Unit& u) const {
        const int L = i * G + vcu; if (L >= T.pre(16) * NPN) return false;
        const int tile = L / NPN; u.pn = L % NPN; int e = 0;
#pragma unroll
        for (int st = 8; st >= 1; st >>= 1) if (tile >= T.pre(e + st)) e += st;
        u.aux = e; u.pm = tile - T.pre(e); u.kind = tile;
        u.A = a + (size_t)tile * atile; u.B = w + (size_t)e * wexp + (size_t)u.pn * 256 * (wexp / (NPN * 256)); return true;
    }
    __device__ __forceinline__ int arow(const pg8::Unit& u, int r) const {
        const int rank = u.pm * 256 + r; const int c = T.cnt(u.aux);
        return rank < c ? (tokidx[(size_t)u.aux * M + rank] >> 1) : 0;
    }
};
struct EpiMoe1 {
    static constexpr bool PERM = true;
    bf16* act; const float* gate; MoeTab T;
    __device__ __forceinline__ void operator()(const pg8::f32x4 (&acc)[2][2][4][2], const pg8::Unit& u, int wr, int wc, int fr, int fq) const {
        const int cnt = T.cnt(u.aux);
#pragma unroll
        for (int ai = 0; ai < 2; ++ai)
#pragma unroll
            for (int m = 0; m < 4; ++m) { const int r = ai * 128 + wr * 64 + m * 16 + fr, rank = u.pm * 256 + r;
                const float gt = rank < cnt ? gate[(size_t)u.aux * M + rank] : 0.f;
                bf16* rowp = act + ((size_t)u.kind * 256 + r) * 256 + u.pn * 128 + wc * 16 + 4 * fq;
#pragma unroll
                for (int bj = 0; bj < 2; ++bj) { const pg8::f32x4 av = acc[ai][bj][m][0], cv = acc[ai][bj][m][1]; float y[4];
#pragma unroll
                    for (int e = 0; e < 4; ++e) y[e] = av[e] * __builtin_amdgcn_rcpf(1.f + __builtin_amdgcn_exp2f(av[e] * -1.4426950408889634f)) * cv[e] * gt;
                    *(unsigned long long*)(rowp + bj * 64) = (unsigned long long)pg8::cvt_pk_bf16(y[0], y[1]) | ((unsigned long long)pg8::cvt_pk_bf16(y[2], y[3]) << 32); } }
    }
};
struct EpiMoe2 {
    static constexpr bool PERM = true;
    bf16* ymoe; const int* tokidx; MoeTab T;
    __device__ __forceinline__ void operator()(const pg8::f32x4 (&acc)[2][2][4][2], const pg8::Unit& u, int wr, int wc, int fr, int fq) const {
        const int cnt = T.cnt(u.aux);
#pragma unroll
        for (int ai = 0; ai < 2; ++ai)
#pragma unroll
            for (int m = 0; m < 4; ++m) { const int r = ai * 128 + wr * 64 + m * 16 + fr, rank = u.pm * 256 + r;
                if (rank < cnt) { bf16* rowp = ymoe + (size_t)tokidx[(size_t)u.aux * M + rank] * D + u.pn * 256 + wc * 32 + 8 * fq;
#pragma unroll
                    for (int bj = 0; bj < 2; ++bj) { const pg8::f32x4 v0 = acc[ai][bj][m][0], v1 = acc[ai][bj][m][1];
                        pg8::u32x4 w; w.x = pg8::cvt_pk_bf16(v0[0], v0[1]); w.y = pg8::cvt_pk_bf16(v0[2], v0[3]); w.z = pg8::cvt_pk_bf16(v1[0], v1[1]); w.w = pg8::cvt_pk_bf16(v1[2], v1[3]);
                        *(pg8::u32x4*)(rowp + bj * 128) = w; } } }
    }
};
struct SchedSq {
    int vcu, G; const char* a; const char* w; size_t astep, wstep; int vfirst;
    __device__ __forceinline__ bool next(int i, pg8::Unit& u) const {
        if (vcu < vfirst || vcu >= vfirst + G) return false;
        const int L = i * G + (vcu - vfirst); if (L >= 256) return false;
        u.kind = 0; u.pm = L >> 2; u.pn = L & 3; u.aux = 0; u.A = a + (size_t)u.pm * astep; u.B = w + (size_t)u.pn * wstep; return true;
    }
};
template <int GATED> struct EpiPle {
    static constexpr bool PERM = true;
    bf16* yp; const float* bg;
    __device__ __forceinline__ void operator()(const pg8::f32x4 (&acc)[2][2][4][2], const pg8::Unit& u, int wr, int wc, int fr, int fq) const {
        const int row0 = u.pm * 256 + wr * 64 + fr, col0 = u.pn * 256 + wc * 32 + 8 * fq;
#pragma unroll
        for (int ai = 0; ai < 2; ++ai)
#pragma unroll
            for (int m = 0; m < 4; ++m) { bf16* rowp = yp + (size_t)(row0 + ai * 128 + m * 16) * D + col0;
#pragma unroll
                for (int bj = 0; bj < 2; ++bj) { pg8::f32x4 v0 = acc[ai][bj][m][0], v1 = acc[ai][bj][m][1];
                    if (GATED) { const pg8::f32x4 b0 = *(const pg8::f32x4*)(bg + col0 + bj * 128), b1 = *(const pg8::f32x4*)(bg + col0 + bj * 128 + 4); const pg8::u32x4 y = *(const pg8::u32x4*)(rowp + bj * 128);
                        const float yf[8] = {bf2f((bf16)y.x), bf2f((bf16)(y.x >> 16)), bf2f((bf16)y.y), bf2f((bf16)(y.y >> 16)), bf2f((bf16)y.z), bf2f((bf16)(y.z >> 16)), bf2f((bf16)y.w), bf2f((bf16)(y.w >> 16))};
#pragma unroll
                        for (int e = 0; e < 4; ++e) { v0[e] = yf[e] * __builtin_amdgcn_rcpf(1.f + __builtin_amdgcn_exp2f((v0[e] + b0[e]) * -1.4426950408889634f)); v1[e] = yf[4 + e] * __builtin_amdgcn_rcpf(1.f + __builtin_amdgcn_exp2f((v1[e] + b1[e]) * -1.4426950408889634f)); } }
                    pg8::u32x4 w; w.x = pg8::cvt_pk_bf16(v0[0], v0[1]); w.y = pg8::cvt_pk_bf16(v0[2], v0[3]); w.z = pg8::cvt_pk_bf16(v1[0], v1[1]); w.w = pg8::cvt_pk_bf16(v1[2], v1[3]);
                    *(pg8::u32x4*)(rowp + bj * 128) = w; } }
    }
};
namespace att {
typedef float f32x16 __attribute__((ext_vector_type(16)));
constexpr int KSLOT = 8192, VSLOT = 16384, LDS_K = 0, LDS_V = 2 * KSLOT, ATT_LDS = 2 * KSLOT + 2 * VSLOT;
__device__ __forceinline__ bf16x8 pack8(const f32x16& p, int b) {
    v4u w; w.x = pg8::cvt_pk_bf16(p[b], p[b + 1]); w.y = pg8::cvt_pk_bf16(p[b + 2], p[b + 3]); w.z = pg8::cvt_pk_bf16(p[b + 4], p[b + 5]); w.w = pg8::cvt_pk_bf16(p[b + 6], p[b + 7]);
    return __builtin_bit_cast(bf16x8, w);
}
constexpr float THR2 = 8.f;
__device__ __forceinline__ void qkt_load(bf16x8 (&kf)[8], LAS const unsigned char* ks, int r32, int hi) {
    LAS const unsigned char* kb = ks + hi * 1024 + r32 * 16;
#pragma unroll
    for (int kk = 0; kk < 4; ++kk) { kf[2 * kk] = *(LAS const bf16x8*)(kb + kk * 2048); kf[2 * kk + 1] = *(LAS const bf16x8*)(kb + kk * 2048 + 512); }
}
__device__ __forceinline__ void qkt_mma(f32x16& p0, f32x16& p1, const bf16x8 (&kf)[8], const bf16x8 (&qf)[4]) {
#pragma unroll
    for (int r = 0; r < 16; ++r) { p0[r] = 0.f; p1[r] = 0.f; }
#pragma unroll
    for (int kk = 0; kk < 4; ++kk) {
        p0 = __builtin_amdgcn_mfma_f32_32x32x16_bf16(kf[2 * kk], qf[kk], p0, 0, 0, 0);
        p1 = __builtin_amdgcn_mfma_f32_32x32x16_bf16(kf[2 * kk + 1], qf[kk], p1, 0, 0, 0);
    }
}
__device__ __forceinline__ void qkt(f32x16& p0, f32x16& p1, LAS const unsigned char* ks, const bf16x8 (&qf)[4], int r32, int hi) {
    bf16x8 kf[8]; qkt_load(kf, ks, r32, hi); qkt_mma(p0, p1, kf, qf);
}
typedef float f32x2 __attribute__((ext_vector_type(2)));
#define ATT_PAIR(p, i) ((f32x2){p[2 * (i)], p[2 * (i) + 1]})
__device__ __forceinline__ void partialSM0(f32x16& p0, f32x16& p1, float& m, float& alpha) {
    float pmax = fmaxf(p0[0], p1[0]);
#pragma unroll
    for (int r = 1; r < 16; ++r) pmax = fmaxf(pmax, fmaxf(p0[r], p1[r]));
    { const auto rr = __builtin_amdgcn_permlane32_swap(__float_as_uint(pmax), __float_as_uint(pmax), false, false); pmax = fmaxf(__uint_as_float(rr[0]), __uint_as_float(rr[1])); }
    alpha = 1.f; m = pmax;
#pragma unroll
    for (int r = 0; r < 16; ++r) { p0[r] = __builtin_amdgcn_exp2f(p0[r] - pmax); p1[r] -= pmax; }
}
__device__ __forceinline__ void partialSM(f32x16& p0, f32x16& p1, float& m, float& alpha) {
    { const float nm = -m; p0 += nm; p1 += nm; }
    float x = fmaxf(p0[0], p0[1]), y = fmaxf(p1[0], p1[1]);
#pragma unroll
    for (int r = 2; r < 16; r += 2) { x = fmaxf(x, fmaxf(p0[r], p0[r + 1])); y = fmaxf(y, fmaxf(p1[r], p1[r + 1])); }
    float pmax = fmaxf(x, y);
    { const auto rr = __builtin_amdgcn_permlane32_swap(__float_as_uint(pmax), __float_as_uint(pmax), false, false); pmax = fmaxf(__uint_as_float(rr[0]), __uint_as_float(rr[1])); }
    if (__builtin_expect(__all(pmax <= THR2), 1)) alpha = 1.f;
    else { const float d = fmaxf(pmax, 0.f); alpha = __builtin_amdgcn_exp2f(-d); m += d; const float nd = -d; p0 += nd; p1 += nd; }
#pragma unroll
    for (int r = 0; r < 16; ++r) p0[r] = __builtin_amdgcn_exp2f(p0[r]);
}
__device__ __forceinline__ void finishExp(f32x16& p1) {
#pragma unroll
    for (int r = 0; r < 16; ++r) p1[r] = __builtin_amdgcn_exp2f(p1[r]);
}
__device__ __forceinline__ void finishRest(f32x16& p0, f32x16& p1, float alpha, float& l, bf16x8 (&pf)[4]) {
    f32x2 ps = ATT_PAIR(p0, 0) + ATT_PAIR(p1, 0);
#pragma unroll
    for (int i = 1; i < 8; ++i) { ps += ATT_PAIR(p0, i); ps += ATT_PAIR(p1, i); }
    l = l * alpha + (ps.x + ps.y);
    pf[0] = pack8(p0, 0); pf[1] = pack8(p0, 8); pf[2] = pack8(p1, 0); pf[3] = pack8(p1, 8);
}
__device__ __forceinline__ void finishSM(f32x16& p0, f32x16& p1, float alpha, float& l, bf16x8 (&pf)[4]) { finishExp(p1); finishRest(p0, p1, alpha, l, pf); }
__device__ __forceinline__ void pv(f32x16 (&o)[4], LAS const unsigned char* vs, const bf16x8 (&pf)[4], int r32, int hi) {
    LAS const unsigned char* vb = vs + hi * 2048 + r32 * 16;
    bf16x8 va[2][4];
#pragma unroll
    for (int s = 0; s < 4; ++s) va[0][s] = *(LAS const bf16x8*)(vb + s * 4096);
    __builtin_amdgcn_sched_group_barrier(0x100, 4, 0);
#pragma unroll
    for (int db = 0; db < 4; ++db) {
        if (db < 3) {
#pragma unroll
            for (int s = 0; s < 4; ++s) va[(db + 1) & 1][s] = *(LAS const bf16x8*)(vb + s * 4096 + (db + 1) * 512);
        }
#pragma unroll
        for (int s = 0; s < 4; ++s) o[db] = __builtin_amdgcn_mfma_f32_32x32x16_bf16(va[db & 1][s], pf[s], o[db], 0, 0, 0);
        if (db < 3) __builtin_amdgcn_sched_group_barrier(0x100, 4, 0);
        __builtin_amdgcn_sched_group_barrier(0x8, 4, 0);
    }
}
__device__ __forceinline__ void resc(f32x16 (&o)[4], float alpha) {
    if (__any(alpha < 1.f)) {
#pragma unroll
        for (int db = 0; db < 4; ++db)
#pragma unroll
            for (int r = 0; r < 16; ++r) o[db][r] *= alpha;
    }
}
#define ATT_SGB(mask, n) __builtin_amdgcn_sched_group_barrier(mask, n, 0)
__device__ __forceinline__ void v_load(bf16x8 (&va)[8], LAS const unsigned char* vs, int half, int r32, int hi) {
    LAS const unsigned char* vb = vs + hi * 2048 + r32 * 16 + half * 1024;
#pragma unroll
    for (int h2 = 0; h2 < 2; ++h2)
#pragma unroll
        for (int s = 0; s < 4; ++s) va[h2 * 4 + s] = *(LAS const bf16x8*)(vb + s * 4096 + h2 * 512);
}
__device__ __forceinline__ void firstSM(f32x16& p0, f32x16& p1, f32x16& nm, float& alpha, float& ps0) {
    float pmax = fmaxf(p0[0], p1[0]);
#pragma unroll
    for (int r = 1; r < 16; ++r) pmax = fmaxf(pmax, fmaxf(p0[r], p1[r]));
    { const auto rr = __builtin_amdgcn_permlane32_swap(__float_as_uint(pmax), __float_as_uint(pmax), false, false); pmax = fmaxf(__uint_as_float(rr[0]), __uint_as_float(rr[1])); }
    alpha = 1.f;
    const float nmm = -pmax;
#pragma unroll
    for (int r = 0; r < 16; ++r) nm[r] = nmm;
    float s = 0.f;
#pragma unroll
    for (int r = 0; r < 16; ++r) { p0[r] = __builtin_amdgcn_exp2f(p0[r] + nmm); s += p0[r]; p1[r] += nmm; }
    ps0 = s;
}
__device__ __forceinline__ void blk1(f32x16& q0, f32x16& q1, const f32x16& nm, LAS const unsigned char* ks, const bf16x8 (&qf)[4],
                                     f32x16& f0, f32x16& f1, float alf, float psf, float& l, bf16x8 (&pf)[4], int r32, int hi) {
    bf16x8 kf[8]; qkt_load(kf, ks, r32, hi);
    __builtin_amdgcn_sched_barrier(0);
    float s1 = psf;
#pragma unroll
    for (int r = 0; r < 4; ++r) { f1[r] = __builtin_amdgcn_exp2f(f1[r]); s1 += f1[r]; }
    pf[0] = pack8(f0, 0);
    asm volatile("" : "+v"(s1));
    __builtin_amdgcn_sched_barrier(0);
#pragma unroll
    for (int kk = 0; kk < 4; ++kk) {
        if (kk == 0) { q0 = __builtin_amdgcn_mfma_f32_32x32x16_bf16(kf[0], qf[0], nm, 0, 0, 0); q1 = __builtin_amdgcn_mfma_f32_32x32x16_bf16(kf[1], qf[0], nm, 0, 0, 0); }
        else { q0 = __builtin_amdgcn_mfma_f32_32x32x16_bf16(kf[2 * kk], qf[kk], q0, 0, 0, 0); q1 = __builtin_amdgcn_mfma_f32_32x32x16_bf16(kf[2 * kk + 1], qf[kk], q1, 0, 0, 0); }
#pragma unroll
        for (int r = 4 + 3 * kk; r < 7 + 3 * kk; ++r) { f1[r] = __builtin_amdgcn_exp2f(f1[r]); s1 += f1[r]; }
        if (kk == 0) pf[1] = pack8(f0, 8);
        if (kk == 1) pf[2] = pack8(f1, 0);
        if (kk == 3) { pf[3] = pack8(f1, 8); l = l * alf + s1; asm volatile("" : "+v"(l)); }
        else asm volatile("" : "+v"(s1));
        __builtin_amdgcn_sched_barrier(0);
    }
}
__device__ __forceinline__ float blk2a(f32x16& oa, f32x16& ob, bf16x8 (&vn)[8], LAS const unsigned char* vs, const bf16x8 (&pf)[4], const f32x16& q0, const f32x16& q1, int r32, int hi) {
    bf16x8 va[8]; v_load(va, vs, 0, r32, hi);
    int x = __float_as_int(q0[0]), y = __float_as_int(q1[0]);
#pragma unroll
    for (int r = 1; r < 15; r += 2) { x = max(max(x, __float_as_int(q0[r])), __float_as_int(q0[r + 1])); y = max(max(y, __float_as_int(q1[r])), __float_as_int(q1[r + 1])); }
    x = max(max(x, __float_as_int(q0[15])), max(y, __float_as_int(q1[15])));
    { const auto rr = __builtin_amdgcn_permlane32_swap((unsigned)x, (unsigned)x, false, false); x = max((int)rr[0], (int)rr[1]); }
#pragma unroll
    for (int s = 0; s < 4; ++s) { oa = __builtin_amdgcn_mfma_f32_32x32x16_bf16(va[s], pf[s], oa, 0, 0, 0); ob = __builtin_amdgcn_mfma_f32_32x32x16_bf16(va[4 + s], pf[s], ob, 0, 0, 0); }
    v_load(vn, vs, 1, r32, hi);
    ATT_SGB(0x100, 8); ATT_SGB(0x2, 4);
#pragma unroll
    for (int i = 0; i < 4; ++i) { ATT_SGB(0x8, 1); ATT_SGB(0x2, 2); }
    ATT_SGB(0x100, 8);
#pragma unroll
    for (int i = 0; i < 4; ++i) { ATT_SGB(0x8, 1); ATT_SGB(0x2, 3); }
    return __int_as_float(x);
}
__device__ __forceinline__ float blk2b(f32x16& oc, f32x16& od, const bf16x8 (&vn)[8], const bf16x8 (&pf)[4], f32x16& q0) {
    float s = 0.f;
#pragma unroll
    for (int r = 0; r < 16; ++r) { q0[r] = __builtin_amdgcn_exp2f(q0[r]); s += q0[r]; }
#pragma unroll
    for (int s_ = 0; s_ < 4; ++s_) { oc = __builtin_amdgcn_mfma_f32_32x32x16_bf16(vn[s_], pf[s_], oc, 0, 0, 0); od = __builtin_amdgcn_mfma_f32_32x32x16_bf16(vn[4 + s_], pf[s_], od, 0, 0, 0); }
#pragma unroll
    for (int i = 0; i < 8; ++i) { ATT_SGB(0x8, 1); ATT_SGB(0x402, 4); }
    asm volatile("" : "+v"(s));
    return s;
}
template <int VAR = 0>
__device__ __forceinline__ void unit(LAS unsigned char* lds, int b, int h, int qb, const bf16* QKP, const bf16* UVT, float lam, float lam_init, const float* subg, bf16* MIXB, float* stash, int wave, int lane, int c0 = 0, int c1 = 2) {
    lane = (int)mk_lane_id();
    const int r32 = lane & 31, hi = lane >> 5;
    if (wave >= 4) __builtin_amdgcn_s_setprio(1);
    const size_t tok0 = (size_t)b * S;
    constexpr int NT = S / 64;
#pragma unroll 1
    for (int cc = c0; cc < c1; ++cc) {
        const int c = cc & 1;
        bf16x8 qf[4];
        { const int lane_q = (int)mk_lane_id();
          const bf16* qp = QKP + (tok0 + qb * 256 + wave * 32 + (lane_q & 31)) * 1280 + h * 128 + c * 64 + (lane_q >> 5) * 8;
#pragma unroll
          for (int kk = 0; kk < 4; ++kk) qf[kk] = *(const GAS bf16x8*)(qp + kk * 16); }
        f32x16 o[4];
#pragma unroll
        for (int db = 0; db < 4; ++db)
#pragma unroll
            for (int r = 0; r < 16; ++r) o[db][r] = 0.f;
        float l = 0.f, alA, alB, psA, psB;
        f32x16 pA0, pA1, pB0, pB1, nm; bf16x8 pf[4];
        const char* kub = (const char*)(QKP + tok0 * 1280 + 512 + h * 128 + c * 64 + wave * 8);
        const char* vub = (const char*)(UVT + (size_t)(768 + h * 128) * M + tok0 + wave * 8);
        const unsigned kvo = (unsigned)lane * 2560u; unsigned vvo = (unsigned)lane * (unsigned)(M * 2);
#define ATT_DMA_K(t) __builtin_amdgcn_global_load_lds((const unsigned*)(kub + (size_t)(t) * (64 * 2560) + kvo), (LAS unsigned*)(lds + LDS_K + ((t) & 1) * KSLOT + wave * 1024), 16, 0, 0)
#define ATT_DMA_V(t) do { \
            __builtin_amdgcn_global_load_lds((const unsigned*)(vub + (size_t)(t) * 128 + vvo), (LAS unsigned*)(lds + LDS_V + ((t) & 1) * VSLOT + wave * 2048), 16, 0, 0); \
            __builtin_amdgcn_global_load_lds((const unsigned*)(vub + (size_t)64 * M * 2 + (size_t)(t) * 128 + vvo), (LAS unsigned*)(lds + LDS_V + ((t) & 1) * VSLOT + wave * 2048 + 1024), 16, 0, 0); } while (0)
#define SB() __builtin_amdgcn_sched_barrier(0)
#define ATT_SYNC() do { asm volatile("s_waitcnt vmcnt(0) lgkmcnt(0)" ::: "memory"); __builtin_amdgcn_s_barrier(); asm volatile("" ::: "memory"); } while (0)
#define ATT_DECIDE(pm_, al_, q0_, q1_) do { if (__builtin_expect(__all((pm_) <= THR2), 1)) al_ = 1.f; \
            else { const float d_ = fmaxf(pm_, 0.f); al_ = __builtin_amdgcn_exp2f(-d_); const float nd_ = -d_; nm += nd_; q0_ += nd_; q1_ += nd_; } } while (0)
#define ATT_STEP(q0_, q1_, alq_, psq_, ks_, f0_, f1_, alf_, psf_, vs_, LATE_DMA) do { \
            SB(); blk1(q0_, q1_, nm, ks_, qf, f0_, f1_, alf_, psf_, l, pf, r32, hi); SB(); \
            LATE_DMA; \
            { bf16x8 vn_[8]; const float pm_ = blk2a(o[0], o[1], vn_, vs_, pf, q0_, q1_, r32, hi); SB(); \
              ATT_DECIDE(pm_, alq_, q0_, q1_); SB(); \
              psq_ = blk2b(o[2], o[3], vn_, pf, q0_); SB(); } \
            resc(o, alq_); } while (0)
        const bool early = wave < 4;
        ATT_SYNC();
        ATT_DMA_K(0); ATT_DMA_V(0);
        ATT_SYNC();
        ATT_DMA_K(1);
        qkt(pA0, pA1, lds + LDS_K, qf, r32, hi); firstSM(pA0, pA1, nm, alA, psA);
#pragma unroll 1
        for (int j = 1; j < NT - 1; j += 2) {
            ATT_SYNC(); if (early) { ATT_DMA_K(j + 1); ATT_DMA_V(j); }
            ATT_STEP(pB0, pB1, alB, psB, lds + LDS_K + KSLOT, pA0, pA1, alA, psA, lds + LDS_V, if (!early) { ATT_DMA_K(j + 1); ATT_DMA_V(j); });
            ATT_SYNC(); if (early) { ATT_DMA_K(j + 2); ATT_DMA_V(j + 1); }
            ATT_STEP(pA0, pA1, alA, psA, lds + LDS_K, pB0, pB1, alB, psB, lds + LDS_V + VSLOT, if (!early) { ATT_DMA_K(j + 2); ATT_DMA_V(j + 1); });
        }
        asm volatile("" : "+v"(vvo));
        ATT_SYNC(); ATT_DMA_V(NT - 1);
        ATT_STEP(pB0, pB1, alB, psB, lds + LDS_K + KSLOT, pA0, pA1, alA, psA, lds + LDS_V, (void)0);
        ATT_SYNC();
        { float s1 = psB;
#pragma unroll
          for (int r = 0; r < 16; ++r) { pB1[r] = __builtin_amdgcn_exp2f(pB1[r]); s1 += pB1[r]; }
          l = l * alB + s1;
          pf[0] = pack8(pB0, 0); pf[1] = pack8(pB0, 8); pf[2] = pack8(pB1, 0); pf[3] = pack8(pB1, 8); }
        pv(o, lds + LDS_V + VSLOT, pf, r32, hi);
#undef ATT_DECIDE
#undef ATT_STEP
#undef ATT_DMA_K
#undef ATT_DMA_V
#undef ATT_SYNC
#undef SB
        const float lt = xsum32(l);
        const int lane_e = (int)mk_lane_id();
        const int hi_e = lane_e >> 5; const size_t qtok_e = tok0 + qb * 256 + wave * 32 + (lane_e & 31);
        if (cc >= 2) {
            if (lam == 123456.f) { for (int db = 0; db < 4; ++db) for (int r = 0; r < 16; ++r) stash[(db * 16 + r) * 64 + lane_e] = o[db][r] + lt; }
        } else if (c == 0) {
            const float i1 = 1.f / lt;
#pragma unroll
            for (int db = 0; db < 4; ++db)
#pragma unroll
                for (int g4 = 0; g4 < 4; ++g4) *(GAS f32x4*)(stash + ((db * 4 + g4) * 64 + lane_e) * 4) = (f32x4){o[db][4 * g4] * i1, o[db][4 * g4 + 1] * i1, o[db][4 * g4 + 2] * i1, o[db][4 * g4 + 3] * i1};
        } else {
            const float i2 = lam / lt;
            float ss = 0.f;
#pragma unroll
            for (int db = 0; db < 4; ++db)
#pragma unroll
                for (int g4 = 0; g4 < 4; ++g4) { const f32x4 s1 = *(const GAS f32x4*)(stash + ((db * 4 + g4) * 64 + lane_e) * 4);
#pragma unroll
                    for (int i = 0; i < 4; ++i) { const float v = s1[i] - o[db][4 * g4 + i] * i2; o[db][4 * g4 + i] = v; ss += v * v; } }
            ss = xsum32(ss);
            const float rs = (1.f - lam_init) / sqrtf(ss * (1.f / 128.f) + 1e-5f);
            bf16* orow = MIXB + qtok_e * D + 256 + h * 128;
#pragma unroll
            for (int db = 0; db < 4; ++db)
#pragma unroll
                for (int g4 = 0; g4 < 4; ++g4) { const int e = 32 * db + 8 * g4 + 4 * hi_e; const f32x4 gg = *(const GAS f32x4*)(subg + e);
                    const unsigned long long w = (unsigned long long)pg8::cvt_pk_bf16(o[db][4 * g4] * rs * gg.x, o[db][4 * g4 + 1] * rs * gg.y) | ((unsigned long long)pg8::cvt_pk_bf16(o[db][4 * g4 + 2] * rs * gg.z, o[db][4 * g4 + 3] * rs * gg.w) << 32);
                    *(GAS unsigned long long*)(orow + e) = w; }
        }
    }
    __builtin_amdgcn_s_setprio(0);
}
}
namespace hy {
typedef float f32x16 __attribute__((ext_vector_type(16)));
constexpr int CPY = 16456;
constexpr int VJ = 65, VK8 = VJ * 64;
constexpr int LDS_F = 0, LDS_VV = 4 * CPY, LDS_END = LDS_VV + 8 * VK8;
static_assert(LDS_VV % 16 == 0 && LDS_END <= 131072, "hyena LDS map");

__device__ __forceinline__ void filter_item(LAS unsigned char* lds, int pb, const float* fw1, const float* fb1, const float* fr1, const float* fw2, const float* fb2, const float* fr2,
                                            const float* fw3, bf16* KF, float* PS, int wave, int lane) {
    LAS bf16* tile = (LAS bf16*)lds;
    LAS float* za = (LAS float*)(lds + 65536) + wave * 512;
    LAS float* zb = (LAS float*)(lds + 81920) + wave * 512;
    LAS float* sqs = (LAS float*)(lds + 98304);
    const int p0 = pb * 64 + wave * 8;
    if (lane < 33) {
#pragma unroll 1
        for (int pi = 0; pi < 8; ++pi) { const int p = p0 + pi; float z;
            if (lane == 0) z = (float)p / (float)(S - 1);
            else { const int bi = (lane - 1) & 15; const float band = 1e-4f + (float)bi * ((15.0f - 1e-4f) / 15.0f), wpos = 2.0f * 3.14159265358979323846f * (float)p / (float)S;
                   z = lane <= 16 ? cosf(wpos * band) : -sinf(wpos * band); }
            za[pi * 64 + lane] = z; }
    }
    LDS_WAIT(); asm volatile("" ::: "memory");
    float acc8[8];
    { const float b1 = fb1[lane];
#pragma unroll
      for (int pi = 0; pi < 8; ++pi) acc8[pi] = b1;
#pragma unroll 1
      for (int i = 0; i < 33; ++i) { const float w = fw1[i * 64 + lane];
#pragma unroll
          for (int pi = 0; pi < 8; ++pi) acc8[pi] += za[pi * 64 + i] * w; }
      const float f1 = fr1[lane];
#pragma unroll
      for (int pi = 0; pi < 8; ++pi) zb[pi * 64 + lane] = sinf(f1 * acc8[pi]); }
    LDS_WAIT(); asm volatile("" ::: "memory");
    { const float b2 = fb2[lane];
#pragma unroll
      for (int pi = 0; pi < 8; ++pi) acc8[pi] = b2;
#pragma unroll 1
      for (int i = 0; i < 64; ++i) { const float w = fw2[i * 64 + lane];
#pragma unroll
          for (int pi = 0; pi < 8; ++pi) acc8[pi] += zb[pi * 64 + i] * w; }
      const float f2 = fr2[lane];
      LDS_WAIT(); asm volatile("" ::: "memory");
#pragma unroll
      for (int pi = 0; pi < 8; ++pi) za[pi * 64 + lane] = sinf(f2 * acc8[pi]); }
    LDS_WAIT(); asm volatile("" ::: "memory");
    const float mind = logf(1e-2f) / 1.5f, maxd = logf(1e-2f) / 0.3f;
#pragma unroll 1
    for (int qh = 0; qh < 2; ++qh) {
        float ac[8][4];
#pragma unroll
        for (int pi = 0; pi < 8; ++pi)
#pragma unroll
            for (int q = 0; q < 4; ++q) ac[pi][q] = 0.f;
#pragma unroll 1
        for (int i = 0; i < 64; ++i) { float w[4];
#pragma unroll
            for (int q = 0; q < 4; ++q) w[q] = fw3[i * 512 + lane + 64 * (qh * 4 + q)];
#pragma unroll
            for (int pi = 0; pi < 8; ++pi) { const float hv = za[pi * 64 + i];
#pragma unroll
                for (int q = 0; q < 4; ++q) ac[pi][q] += hv * w[q]; } }
#pragma unroll
        for (int q = 0; q < 4; ++q) { const int col = lane + 64 * (qh * 4 + q), ch = col & 255; const float delta = fabsf(mind + (float)ch * ((maxd - mind) / 255.0f)); float sq = 0.f;
#pragma unroll
            for (int pi = 0; pi < 8; ++pi) { const int p = p0 + pi; const float val = ac[pi][q] * expf(-((float)p / (float)(S - 1)) * delta);
                if (!(col >= 256 && p == 0)) sq += val * val;
                tile[col * 64 + wave * 8 + pi] = (bf16)f2bf(val); }
            sqs[wave * 512 + col] = sq; }
    }
    LDS_WAIT(); __syncthreads();
    { const int p = pb * 64 + lane;
#pragma unroll 1
      for (int cc = 0; cc < 64; ++cc) { const int col = wave * 64 + cc; const bf16 v = tile[col * 64 + lane];
          if (col < 256) KF[(size_t)col * 8192 + 4095 - p] = v; else if (p != 0) KF[(size_t)(col - 256) * 8192 + 4095 + p] = v; } }
    { const int t = wave * 64 + lane; float s = 0.f;
#pragma unroll
      for (int w = 0; w < 8; ++w) s += sqs[w * 512 + t];
      PS[(size_t)pb * 512 + t] = s;
      if (pb == 0 && t < 256) KF[(size_t)t * 8192 + 8191] = 0; }
    LDS_WAIT(); __syncthreads();
}

__device__ __forceinline__ float conv1(float um, float u0, float up, float w0, float w1, float w2, float cb) { return um * w0 + u0 * w1 + up * w2 + cb; }

__device__ __forceinline__ void unit(LAS unsigned char* lds, int c, const bf16* KF, const float* PS, const bf16* UVT, const float* cw, const float* cb, const float* bias_d, bf16* HT, int wave, int lane) {
    lane = (int)mk_lane_id(); asm volatile("" : "+s"(wave));
    const int tid = wave * 64 + lane;
    { const bf16* src = KF + (size_t)c * 8192;
#pragma unroll
      for (int i = 0; i < 2; ++i) { const int ch = tid + 512 * i; *(LAS v4u*)(lds + LDS_F + ch * 16) = *(const GAS v4u*)(src + ch * 8); } }
    { const float w0v = cw[512 + c], w1v = cw[768 + 512 + c], w2v = cw[1536 + 512 + c], cbv = cb[512 + c], w0x = cw[256 + c], w1x = cw[768 + 256 + c], w2x = cw[1536 + 256 + c], cbx = cb[256 + c];
      const bf16* rv = UVT + (size_t)(512 + c) * M; const bf16* rx = UVT + (size_t)(256 + c) * M;
#pragma unroll
      for (int i = 0; i < 4; ++i) { const int q = tid + 512 * i, b = q >> 9, sc = q & 511, s0 = sc * 8; const size_t g0 = (size_t)b * S + s0;
          const v4u av = *(const GAS v4u*)(rv + g0), ax = *(const GAS v4u*)(rx + g0);
          float uv[10], ux[10];
          uv[0] = s0 > 0 ? bf2f(rv[g0 - 1]) : 0.f; ux[0] = s0 > 0 ? bf2f(rx[g0 - 1]) : 0.f; uv[9] = s0 + 8 < S ? bf2f(rv[g0 + 8]) : 0.f; ux[9] = s0 + 8 < S ? bf2f(rx[g0 + 8]) : 0.f;
#pragma unroll
          for (int e = 0; e < 4; ++e) { uv[1 + 2 * e] = bf2f((bf16)av[e]); uv[2 + 2 * e] = bf2f((bf16)(av[e] >> 16)); ux[1 + 2 * e] = bf2f((bf16)ax[e]); ux[2 + 2 * e] = bf2f((bf16)(ax[e] >> 16)); }
          float o[8];
#pragma unroll
          for (int e = 0; e < 8; ++e) o[e] = conv1(uv[e], uv[e + 1], uv[e + 2], w0v, w1v, w2v, cbv) * conv1(ux[e], ux[e + 1], ux[e + 2], w0x, w1x, w2x, cbx);
          v4u w; w.x = pk2(o[0], o[1]); w.y = pk2(o[2], o[3]); w.z = pk2(o[4], o[5]); w.w = pk2(o[6], o[7]);
          *(LAS v4u*)(lds + LDS_VV + (((sc & 7) * VJ + (sc >> 3)) * 4 + b) * 16) = w; }
      if (tid < 32) { unsigned z_; asm volatile("v_mov_b32 %0, 0" : "=v"(z_)); *(LAS v4u*)(lds + LDS_VV + (((tid >> 2) * VJ + 64) * 4 + (tid & 3)) * 16) = (v4u){z_, z_, z_, z_}; } }
    LDS_WAIT(); __syncthreads();
    {
#pragma unroll 1
      for (int i = 0; i < 4; ++i) { const int y = tid + 512 * i;
          const unsigned long long w0 = *(LAS const unsigned long long*)(lds + LDS_F + y * 8), w1 = *(LAS const unsigned long long*)(lds + LDS_F + y * 8 + 8);
#pragma unroll
          for (int p = 1; p < 4; ++p) *(LAS unsigned long long*)(lds + LDS_F + p * CPY + y * 8) = (w0 >> (16 * p)) | (w1 << (64 - 16 * p)); } }
    const float nrm = 1.0f / sqrtf(wave_sum(PS[(size_t)lane * 512 + c] + PS[(size_t)lane * 512 + 256 + c]) + 1e-6f);
    LDS_WAIT(); __syncthreads();
    const int r32 = lane & 31, hi = lane >> 5, gp = wave & 3, half = wave >> 2, iloc = r32 >> 2, b = r32 & 3;
    f32x16 acc[2][2];
#pragma unroll
    for (int rho = 0; rho < 2; ++rho)
#pragma unroll
        for (int gg = 0; gg < 2; ++gg)
#pragma unroll
            for (int r = 0; r < 16; ++r) acc[rho][gg][r] = 0.f;
    const int dlo = 16 * gp - 63 + (half ? 40 : 0), dn = half ? 39 : 40;
    int pa = LDS_F + (3 - (r32 & 3)) * CPY + (4092 - 4 * (r32 >> 2) + 8 * hi) * 2 - 64 - 128 * dlo;
    int jb = 16 * gp + iloc - dlo;
    const int pbase = LDS_VV + hi * VK8 + b * 16;
    typedef unsigned long long u64;
    struct Frag { u64 a[4][4]; v4u b[4][2]; };
#define HY_LOAD(F) do { const int j0_ = jb, j1_ = jb + 8; LAS const unsigned char* ap_ = lds + pa; \
        LAS const unsigned char* bp0_ = lds + pbase + ((unsigned)j0_ < 64u ? j0_ : 64) * 64; LAS const unsigned char* bp1_ = lds + pbase + ((unsigned)j1_ < 64u ? j1_ : 64) * 64; \
        _Pragma("unroll") for (int k = 0; k < 4; ++k) { F.a[k][0] = *(LAS const u64*)(ap_ + 64 + 32 * k); F.a[k][1] = *(LAS const u64*)(ap_ + 64 + 32 * k + 8); F.a[k][2] = *(LAS const u64*)(ap_ + 32 * k); F.a[k][3] = *(LAS const u64*)(ap_ + 32 * k + 8); \
            F.b[k][0] = *(LAS const v4u*)(bp0_ + k * (2 * VK8)); F.b[k][1] = *(LAS const v4u*)(bp1_ + k * (2 * VK8)); } \
        pa -= 128; jb -= 1; } while (0)
#define HY_MMA(F) do { _Pragma("unroll") for (int k = 0; k < 4; ++k) { \
            const bf16x8 fa0 = __builtin_bit_cast(bf16x8, (v4u){(unsigned)F.a[k][0], (unsigned)(F.a[k][0] >> 32), (unsigned)F.a[k][1], (unsigned)(F.a[k][1] >> 32)}); \
            const bf16x8 fa1 = __builtin_bit_cast(bf16x8, (v4u){(unsigned)F.a[k][2], (unsigned)(F.a[k][2] >> 32), (unsigned)F.a[k][3], (unsigned)(F.a[k][3] >> 32)}); \
            const bf16x8 fb0 = __builtin_bit_cast(bf16x8, F.b[k][0]), fb1 = __builtin_bit_cast(bf16x8, F.b[k][1]); \
            acc[0][0] = __builtin_amdgcn_mfma_f32_32x32x16_bf16(fa0, fb0, acc[0][0], 0, 0, 0); acc[0][1] = __builtin_amdgcn_mfma_f32_32x32x16_bf16(fa0, fb1, acc[0][1], 0, 0, 0); \
            acc[1][0] = __builtin_amdgcn_mfma_f32_32x32x16_bf16(fa1, fb0, acc[1][0], 0, 0, 0); acc[1][1] = __builtin_amdgcn_mfma_f32_32x32x16_bf16(fa1, fb1, acc[1][1], 0, 0, 0); } } while (0)
#define HY_MIX() do { _Pragma("unroll") for (int i_ = 0; i_ < 8; ++i_) { __builtin_amdgcn_sched_group_barrier(0x100, 3, 0); __builtin_amdgcn_sched_group_barrier(0x8, 2, 0); } } while (0)
    Frag FA, FB;
    HY_LOAD(FA);
    int dd = 0;
#pragma unroll 1
    for (; dd + 2 <= dn; dd += 2) {
        HY_LOAD(FB); HY_MMA(FA); HY_MIX();
        if (dd + 2 < dn) { HY_LOAD(FA); HY_MMA(FB); HY_MIX(); } else { HY_MMA(FB); }
    }
    if (dd < dn) HY_MMA(FA);
#undef HY_MIX
#undef HY_LOAD
#undef HY_MMA
    const int lane_b = (int)mk_lane_id(), r32_b = lane_b & 31, hi_b = lane_b >> 5, iloc_b = r32_b >> 2, b_b = r32_b & 3;
    LDS_WAIT(); __syncthreads();
    { LAS float* xw = (LAS float*)(lds + LDS_F) + (gp * 2 + (half ? 0 : 1)) * 2048 + lane_b;
#pragma unroll
      for (int gg = 0; gg < 2; ++gg)
#pragma unroll
          for (int r = 0; r < 16; ++r) xw[(gg * 16 + r) * 64] = half ? acc[0][gg][r] : acc[1][gg][r]; }
    LDS_WAIT(); __syncthreads();
    f32x16 fin[2];
    { LAS const float* xr = (LAS const float*)(lds + LDS_F) + (gp * 2 + (half ? 1 : 0)) * 2048 + lane_b;
#pragma unroll
      for (int gg = 0; gg < 2; ++gg)
#pragma unroll
          for (int r = 0; r < 16; ++r) fin[gg][r] = (half ? acc[1][gg][r] : acc[0][gg][r]) + xr[(gg * 16 + r) * 64]; }
    { const float bd = bias_d[c], w0 = cw[c], w1 = cw[768 + c], w2 = cw[1536 + c], cb0 = cb[c]; const bf16* r0p = UVT + (size_t)c * M; bf16* hrow = HT + (size_t)c * M;
#pragma unroll
      for (int gg = 0; gg < 2; ++gg)
#pragma unroll
          for (int g4 = 0; g4 < 4; ++g4) { const int i = 16 * gp + 8 * gg + iloc_b, rr = 32 * half + 8 * g4 + 4 * hi_b, t0 = 64 * i + rr; const size_t tok = (size_t)b_b * S + t0;
              const unsigned long long vw = *(LAS const unsigned long long*)(lds + LDS_VV + (((rr >> 3) * VJ + i) * 4 + b_b) * 16 + (rr & 7) * 2);
              const unsigned long long uw = *(const GAS unsigned long long*)(r0p + tok);
              float u[6]; u[0] = t0 > 0 ? bf2f(r0p[tok - 1]) : 0.f; u[5] = t0 + 4 < S ? bf2f(r0p[tok + 4]) : 0.f;
              u[1] = bf2f((bf16)uw); u[2] = bf2f((bf16)(uw >> 16)); u[3] = bf2f((bf16)(uw >> 32)); u[4] = bf2f((bf16)(uw >> 48));
              float o[4];
#pragma unroll
              for (int e = 0; e < 4; ++e) { const float vv = bf2f((bf16)(vw >> (16 * e))); o[e] = (nrm * fin[gg][4 * g4 + e] + vv * bd) * conv1(u[e], u[e + 1], u[e + 2], w0, w1, w2, cb0); }
              *(GAS unsigned long long*)(hrow + tok) = (unsigned long long)pk2(o[0], o[1]) | ((unsigned long long)pk2(o[2], o[3]) << 32); } }
    LDS_WAIT(); __syncthreads();
}
__device__ __forceinline__ void transpose_slab(LAS unsigned char* lds, int slab, const bf16* HT, bf16* MIXB, int wave, int lane) {
    const int tid = wave * 64 + lane; LAS bf16* tile = (LAS bf16*)lds;
#pragma unroll 1
    for (int i = 0; i < 4; ++i) { const int q = tid + 512 * i, c = q >> 3, tc = q & 7; const v4u w = *(const GAS v4u*)(HT + (size_t)c * M + (size_t)slab * 64 + tc * 8);
#pragma unroll
        for (int e = 0; e < 4; ++e) { tile[(tc * 8 + 2 * e) * 264 + c] = (bf16)w[e]; tile[(tc * 8 + 2 * e + 1) * 264 + c] = (bf16)(w[e] >> 16); } }
    LDS_WAIT(); __syncthreads();
#pragma unroll 1
    for (int i = 0; i < 4; ++i) { const int q = tid + 512 * i, tk = q >> 5, cc = q & 31;
        *(GAS v4u*)(MIXB + ((size_t)slab * 64 + tk) * D + cc * 8) = *(LAS const v4u*)(lds + (tk * 264 + cc * 8) * 2); }
    LDS_WAIT(); __syncthreads();
}
}
#ifndef DUP_PRO
#define DUP_PRO 1
#endif
#ifndef DUP_IN
#define DUP_IN 1
#endif
#ifndef DUP_HY
#define DUP_HY 1
#endif
#ifndef DUP_POOL
#define DUP_POOL 1
#endif
#ifndef DUP_HYT
#define DUP_HYT 1
#endif
#ifndef DUP_ATT
#define DUP_ATT 1
#endif
#ifndef DUP_OUT
#define DUP_OUT 1
#endif
#ifndef DUP_LN1
#define DUP_LN1 1
#endif
#ifndef DUP_MOE1
#define DUP_MOE1 1
#endif
#ifndef DUP_MOE2
#define DUP_MOE2 1
#endif
#ifndef DUP_LN2
#define DUP_LN2 1
#endif
#ifndef EN_HY
#define EN_HY 1
#endif
#ifndef EN_HYT
#define EN_HYT 1
#endif
#ifndef EN_PRO
#define EN_PRO 1
#endif
#ifndef EN_IN
#define EN_IN 1
#endif
#ifndef EN_ATT
#define EN_ATT 1
#endif
#ifndef EN_POOL
#define EN_POOL 1
#endif
#ifndef EN_OUT
#define EN_OUT 1
#endif
#ifndef EN_LN1
#define EN_LN1 1
#endif
#ifndef EN_WCV
#define EN_WCV 1
#endif
#ifndef EN_MOE1
#define EN_MOE1 1
#endif
#ifndef EN_MOE2
#define EN_MOE2 1
#endif
#ifndef EN_LN2
#define EN_LN2 1
#endif
constexpr int RING_BYTES = 135168;
constexpr int LDSCTL_OFF = RING_BYTES, MISC_OFF = LDSCTL_OFF + 320, MOETAB_OFF = LDSCTL_OFF + 1024, ROUTE_OFF = LDSCTL_OFF + 2048;
constexpr int LDS_BYTES = 151552;

struct Args { const float* in[38]; float* out; unsigned char* ws; int* eid; float* wts; int ph_lo, ph_hi, l_lo, l_hi, single, pad; };
enum { PH_PRO = 0, PH_IN = 1, PH_ATT = 2, PH_POOL = 3, PH_OUT = 4, PH_LN1 = 5, PH_WCV = 6, PH_MOE1 = 7, PH_MOE2 = 8, PH_LN2 = 9, PH_HY = 10, PH_HYT = 11, PH_END = 12 };

__global__ void __launch_bounds__(NWAVES * 64, 2) mk_fwd(Args a) {
    extern __shared__ __attribute__((aligned(16))) unsigned char lds_raw[];
    LAS unsigned char* lds = (LAS unsigned char*)lds_raw;
    volatile LAS unsigned* MISC = (volatile LAS unsigned*)(lds + MISC_OFF);
    const int wave_s = __builtin_amdgcn_readfirstlane((int)threadIdx.x >> 6);
    const int G = gridDim.x, bx = blockIdx.x, vcu0 = (G % 8 == 0) ? (bx % 8) * (G / 8) + bx / 8 : bx;
    gu32* ctl0 = (gu32*)(a.ws + WS_CTL);
    for (int u = wave_s * 64 + (int)mk_lane_id(); u < (LDS_BYTES - LDSCTL_OFF) / 4; u += NWAVES * 64) ((LAS unsigned*)(lds + LDSCTL_OFF))[u] = 0u;
    __syncthreads();
    XcdBarrier bar; bar.bar = (unsigned*)(ctl0 + CW_BAR); bar.x = 0; bar.st = nullptr;
#if defined(MK_PER_PHASE)
    if (!a.single)
#endif
    bar = xcd_barrier_post((unsigned*)(ctl0 + CW_BAR), MISC + 8, wave_s);
#if defined(MK_PER_PHASE)
#define IN(k) (a.ph_lo <= (k) && (k) < a.ph_hi)
#define SEAM() do { if (!a.single) xcd_barrier(bar, wave_s); } while (0)
#else
#define IN(k) 1
#if defined(PROBE_BAR2)
#define SEAM() do { xcd_barrier(bar, wave_s); xcd_barrier(bar, wave_s); } while (0)
#else
#define SEAM() xcd_barrier(bar, wave_s)
#endif
#endif
    const int NGW = G * NWAVES;
#define PHASE_PTRS() int lane_ = (int)mk_lane_id(); asm volatile("" : "+v"(lane_)); const int lane = lane_, wave = wave_s; int vcu = vcu0; asm volatile("" : "+s"(vcu)); (void)wave; const int gw = vcu * NWAVES + wave; (void)gw; unsigned char* ws = a.ws; gu32* ctl = (gu32*)(ws + WS_CTL); (void)ctl; \
    bf16* XB = (bf16*)(ws + WS_XB); bf16* QKP = (bf16*)(ws + WS_QKP); bf16* UVT = (bf16*)(ws + WS_UVT); float* CS = (float*)(ws + WS_CS); bf16* MIXB = (bf16*)(ws + WS_MIXB); \
    (void)XB; (void)QKP; (void)UVT; (void)CS; (void)MIXB
#define INP(k) (a.in[k])
#define WCV_SPLIT_IT 3730
#define WCV_SPLIT_PB ((size_t)M * 256 / 16 * 9)
#define WCV_LAYER(LEXPR, GW_, NGW_, IT0_, IT1_, PB0_, PB1_) do { const int wl_ = (LEXPR), wg_ = (GW_), wn_ = (NGW_); const int l = wl_, gw = wg_, NGW = wn_; (void)NGW; const int it0_ = (IT0_), it1_ = (IT1_); const size_t pb0_ = (PB0_), pb1_ = (PB1_); \
            LAS float* scr = (LAS float*)(lds + wave * 16384); \
            unsigned char* wb_ = ws + WS_WBUF + (size_t)(l & 1) * WBUF_STRIDE; bf16* W13 = (bf16*)(wb_ + WB_W13); bf16* W2 = (bf16*)(wb_ + WB_W2); bf16* WG = (bf16*)(wb_ + WB_WG); bf16* WP = (bf16*)(wb_ + WB_WP); \
            for (int it = it0_ + gw; it < it1_; it += NGW) { \
                const float* src; int K, N, k0, n0, mode = 0; bf16* dst; \
                if (it < 4096) { const int which = it >> 11, r = it & 2047, e = r >> 7, kb = (r >> 3) & 15, nb = r & 7; \
                    src = INP(which ? 31 : 30) + ((size_t)l * 16 + e) * D * 256; K = D; N = 256; k0 = kb * 64; n0 = nb * 32; mode = 1 + which; dst = W13 + (size_t)e * 512 * D; \
                } else if (it < 6144) { const int r = it - 4096, e = r >> 7, kb = (r >> 5) & 3, nb = r & 31; \
                    src = INP(32) + ((size_t)l * 16 + e) * 256 * D; K = 256; N = D; k0 = kb * 64; n0 = nb * 32; dst = W2 + (size_t)e * D * 256 + (size_t)n0 * 256; \
                } else if (it < 6656) { const int r = it - 6144, kb = r >> 5, nb = r & 31; \
                    src = INP(33) + (size_t)l * D * D; K = D; N = D; k0 = kb * 64; n0 = nb * 32; dst = WG + (size_t)n0 * D; \
                } else { const int r = it - 6656, kb = r >> 5, nb = r & 31; \
                    src = INP(35) + (size_t)l * 256 * D; K = 256; N = D; k0 = kb * 64; n0 = nb * 32; dst = WP + (size_t)n0 * 256; } \
                p0_transpose_block(src, K, N, k0, n0, dst, mode, scr, lane); \
            } \
            const int ln = lane; \
            const float* ps = INP(1) + (size_t)l * M * 256; bf16* PB = (bf16*)(wb_ + WB_PB); \
            for (size_t i = pb0_ + ((size_t)gw * 64 + ln) * 8; i < pb1_; i += (size_t)NGW * 64 * 8) { const f32x4 x0 = *(const GAS f32x4*)(ps + i), x1 = *(const GAS f32x4*)(ps + i + 4); \
                v4u o; o.x = pk2(x0.x, x0.y); o.y = pk2(x0.z, x0.w); o.z = pk2(x1.x, x1.y); o.w = pk2(x1.z, x1.w); *(GAS v4u*)(PB + i) = o; } \
    } while (0)

    if (EN_PRO && IN(PH_PRO)) {
            PHASE_PTRS();
        int odd_ = vcu & 1; asm volatile("" : "+s"(odd_));
#pragma unroll 1
        for (int pass_ = 0; pass_ < 2; ++pass_) {
        if ((pass_ == 0) != (odd_ != 0)) {
            for (int rep_ = 0; rep_ < DUP_PRO; ++rep_) {
        LAS float* scr = (LAS float*)(lds + wave * 16384);
        for (int it = gw; it < DEPTH * (16 * 72 + 16 * 32); it += NGW) {
            const int l = it / 1664, r = it % 1664; const float* src; int N, k0, n0; bf16* dst;
            if (r < 1152) { const int kb = r / 72, nb = r % 72; n0 = nb * 32; k0 = kb * 64; N = INW; src = INP(4) + (size_t)l * D * INW;
                bf16* wsw = (bf16*)(ws + WS_WIN + (size_t)l * WIN_LAYER); bf16* wnm = wsw + 1280 * 1024;
                dst = n0 < 768 ? wsw + (size_t)n0 * D : (n0 < 1792 ? wnm + (size_t)(n0 - 768) * D : wsw + (size_t)(768 + n0 - 1792) * D); }
            else { const int q = r - 1152, kb = q >> 5, nb = q & 31; n0 = nb * 32; k0 = kb * 64; N = D; src = INP(23) + (size_t)l * D * D; dst = (bf16*)(ws + WS_WOUT + (size_t)l * WOUT_LAYER) + (size_t)n0 * D; }
            p0_transpose_block(src, D, N, k0, n0, dst, 0, scr, lane);
            }
        }
        for (int it = gw; it < DEPTH * 4 * 16 * 2; it += NGW) {
            const int l = it >> 7, g = (it >> 5) & 3, dh = (it >> 4) & 1, k = (it & 15) * 64 + lane;
            const float* wrow = INP(4) + (size_t)l * D * INW + (size_t)k * INW + 2304 + g * 64;
            const float* pw = INP(20) + (size_t)(l * 4 + g) * 64 * 64 + dh * 32;
            float acc[32];
#pragma unroll
            for (int d = 0; d < 32; ++d) acc[d] = 0.f;
#pragma unroll 1
            for (int c = 0; c < 64; ++c) { const float x = wrow[c];
#pragma unroll
                for (int d = 0; d < 32; ++d) acc[d] += x * pw[c * 64 + d]; }
            bf16* dst = (bf16*)(ws + WS_WIN + (size_t)l * WIN_LAYER) + (size_t)(1280 + 1024 + g * 64 + dh * 32) * D + k;
#pragma unroll
            for (int d = 0; d < 32; ++d) dst[(size_t)d * D] = (bf16)f2bf(acc[d]);
        }
        for (int i = gw * 64 + lane; i < DEPTH * 32 * D; i += NGW * 64) { const int l2 = i / (32 * D), r = i % (32 * D), col = r / D, k = r % D;
            const float w = col < 4 ? INP(26)[((size_t)l2 * D + k) * 4 + col] : (col < 20 ? INP(28)[((size_t)l2 * D + k) * 16 + col - 4] : 0.f);
            const unsigned hb = f2bf(w); const float lo = w - __uint_as_float(hb << 16);
            bf16* dst = (bf16*)(ws + WS_WR) + (size_t)l2 * 64 * D; dst[(size_t)col * D + k] = (bf16)hb; dst[(size_t)(32 + col) * D + k] = (bf16)f2bf(lo); }
        int ln2 = lane; asm volatile("" : "+v"(ln2));
        for (int i = gw * 64 + ln2; i < S * 8; i += NGW * 64) { const int pos = i >> 3, j = i & 7; const float ang = (float)pos * powf(500000.0f, -(float)(2 * j) / 16.0f);
            CS[pos * 16 + j] = cosf(ang); CS[pos * 16 + 8 + j] = sinf(ang); }
        for (int m = 4 * gw; m < M; m += 4 * NGW) ln0_row4(INP(0) + (size_t)m * D, INP(2), INP(3), XB + (size_t)m * D, lane);
        WCV_LAYER(0, gw, NGW, 0, 6784, (size_t)0, (size_t)M * 256);
        } else {
        LDS_WAIT(); __syncthreads();
        for (int it = vcu; it < DEPTH * 64; it += G) { const int fl = it >> 6, pb = it & 63;
            hy::filter_item(lds, pb, INP(7) + fl * 33 * 64, INP(8) + fl * 64, INP(9) + fl * 64, INP(10) + fl * 64 * 64, INP(11) + fl * 64, INP(12) + fl * 64, INP(13) + fl * 64 * 512,
                            (bf16*)(ws + WS_KF) + (size_t)fl * 256 * 8192, (float*)(ws + WS_PS) + (size_t)fl * 64 * 512, wave, lane); }
        LDS_WAIT(); __syncthreads();
        } }
        SEAM();
    }
#if defined(MK_PER_PHASE)
    for (int l = a.l_lo; l < a.l_hi; ++l) {
#else
#pragma unroll 1
    for (int l = 0; l < DEPTH; ++l) {
#endif
        if (EN_IN && IN(PH_IN)) {
            PHASE_PTRS();
            for (int rep_ = 0; rep_ < DUP_IN; ++rep_) {
            const char* wsw = (const char*)(ws + WS_WIN + (size_t)l * WIN_LAYER);
            SchedIn Sc{vcu, G, (const char*)XB, wsw, wsw + (size_t)1280 * 1024 * 2};
            EpiIn E{QKP, UVT, CS};
            pg8::gemm_phase<EpiIn, SchedIn>(lds, D, Sc, E, wave);
            { SchedSq Sc2{vcu, G / 2, (const char*)(ws + WS_WBUF + (size_t)(l & 1) * WBUF_STRIDE + WB_PB), (const char*)(ws + WS_WBUF + (size_t)(l & 1) * WBUF_STRIDE + WB_WP), (size_t)256 * 256 * 2, (size_t)256 * 256 * 2, G / 2};
              EpiPle<0> E2{(bf16*)(ws + WS_YP), nullptr};
              pg8::gemm_phase<EpiPle<0>, SchedSq>(lds, 256, Sc2, E2, wave); }
            }
            SEAM();
        }
        if (EN_HY && IN(PH_HY)) {
            PHASE_PTRS();
            for (int rep_ = 0; rep_ < DUP_HY; ++rep_) {
            for (int c = vcu; c < 256; c += G)
                hy::unit(lds, c, (const bf16*)(ws + WS_KF) + (size_t)l * 256 * 8192, (const float*)(ws + WS_PS) + (size_t)l * 64 * 512, UVT, INP(5) + l * 3 * 768, INP(6) + l * 768, INP(14) + l * 256, (bf16*)(ws + WS_HT), wave, lane);
            }
        }
        if (EN_POOL && IN(PH_POOL)) {
            PHASE_PTRS();
            for (int rep_ = 0; rep_ < DUP_POOL; ++rep_) {
            int ln = lane; asm volatile("" : "+v"(ln));
            const int cc = (ln & 31) * 8, gq = cc >> 6, hw = 1 << gq;
            const float* pb = INP(21) + l * 256 + cc; const float* psc = INP(22) + l * 256 + cc;
            for (int it = gw; it < M / 2; it += NGW) {
                const int tok = it * 2 + (ln >> 5), pos = tok & (S - 1);
                int lo = pos - hw, hi2 = pos + hw - 1; lo = lo < 0 ? 0 : lo; hi2 = hi2 > S - 1 ? S - 1 : hi2;
                float sacc[8];
#pragma unroll
                for (int e = 0; e < 8; ++e) sacc[e] = 0.f;
                const bf16* zp = QKP + (size_t)(tok - pos) * 1280 + 1024 + cc;
                for (int r = lo; r <= hi2; ++r) { const v4u w = *(const GAS v4u*)(zp + (size_t)r * 1280);
                    sacc[0] += bf2f((bf16)w.x); sacc[1] += bf2f((bf16)(w.x >> 16)); sacc[2] += bf2f((bf16)w.y); sacc[3] += bf2f((bf16)(w.y >> 16));
                    sacc[4] += bf2f((bf16)w.z); sacc[5] += bf2f((bf16)(w.z >> 16)); sacc[6] += bf2f((bf16)w.w); sacc[7] += bf2f((bf16)(w.w >> 16)); }
                const float inv = 1.f / (float)(hi2 - lo + 1);
                const v4u w = *(const GAS v4u*)(zp + (size_t)pos * 1280);
                float z[8] = {bf2f((bf16)w.x), bf2f((bf16)(w.x >> 16)), bf2f((bf16)w.y), bf2f((bf16)(w.y >> 16)), bf2f((bf16)w.z), bf2f((bf16)(w.z >> 16)), bf2f((bf16)w.w), bf2f((bf16)(w.w >> 16))};
                float y[8];
#pragma unroll
                for (int e = 0; e < 8; ++e) y[e] = (sacc[e] * inv - z[e] + pb[e]) * psc[e];
                v4u o; o.x = pk2(y[0], y[1]); o.y = pk2(y[2], y[3]); o.z = pk2(y[4], y[5]); o.w = pk2(y[6], y[7]);
                *(GAS v4u*)(MIXB + (size_t)tok * D + 768 + cc) = o;
            }
            }
            SEAM();
        }
        if (EN_HYT && IN(PH_HYT)) {
            PHASE_PTRS();
            for (int rep_ = 0; rep_ < DUP_HYT; ++rep_) {
            for (int s = vcu; s < 256; s += G) hy::transpose_slab(lds, s, (const bf16*)(ws + WS_HT), MIXB, wave, lane);
            }
        }
        if (EN_ATT && IN(PH_ATT)) {
            PHASE_PTRS();
            for (int rep_ = 0; rep_ < DUP_ATT; ++rep_) {
            const float lam_init = 0.8f - 0.6f * expf(-0.3f * (float)l);
            int ln = lane; asm volatile("" : "+v"(ln));
            const float lam = expf(wave_sum(INP(15)[l * 64 + ln] * INP(16)[l * 64 + ln])) - expf(wave_sum(INP(17)[l * 64 + ln] * INP(18)[l * 64 + ln])) + lam_init;
            for (int u = vcu; u < 256; u += G) { att::unit(lds, (u >> 4) >> 2, (u >> 4) & 3, u & 15, QKP, UVT, lam, lam_init, INP(19) + l * 128, MIXB, (float*)(ws + WS_STASH) + ((size_t)u * 8 + wave) * 4096, wave, lane);
#ifdef ATT_PROBE_VAR
                att::unit<ATT_PROBE_VAR>(lds, (u >> 4) >> 2, (u >> 4) & 3, u & 15, QKP, UVT, lam, lam_init, INP(19) + l * 128, MIXB, (float*)(ws + WS_STASH) + ((size_t)u * 8 + wave) * 4096, wave, lane, 2, 3);
#endif
            }
            }
            SEAM();
        }
        if (EN_OUT && IN(PH_OUT)) {
            PHASE_PTRS();
            for (int rep_ = 0; rep_ < DUP_OUT; ++rep_) {
            SchedOut Sc{vcu, G, (const char*)MIXB, (const char*)(ws + WS_WOUT + (size_t)l * WOUT_LAYER)};
#if defined(PROBE_OUT)
            { EpiRes E0{(bf16*)(ws + WS_STASH)}; pg8::gemm_phase<EpiRes, SchedOut>(lds, D, Sc, E0, wave); }
#endif
            EpiRes E{XB};
            pg8::gemm_phase<EpiRes, SchedOut>(lds, D, Sc, E, wave);
            }
            SEAM();
        }
        if (EN_LN1 && IN(PH_LN1)) {
            PHASE_PTRS();
            for (int rep_ = 0; rep_ < DUP_LN1; ++rep_) {
            int ln = lane; asm volatile("" : "+v"(ln));
#if defined(PROBE_LN1)
            for (int ch = vcu; ch < M / 64; ch += G)
                ln1_router_chunk<PROBE_LN1>((LAS RouteLds*)(lds + ROUTE_OFF), lds, ch * 64, XB, (bf16*)(ws + WS_STASH), INP(24) + l * D, INP(25) + l * D, (const bf16*)(ws + WS_WR) + (size_t)l * 64 * D, INP(27) + l * 4, INP(29) + l * 16,
                                 ctl + CW_CNT + l * 16 * CNT_STRIDE, (int*)(ws + WS_TOKIDX), (float*)(ws + WS_GATE), wave, lane);
#endif
            for (int ch = vcu; ch < M / 64; ch += G)
                ln1_router_chunk((LAS RouteLds*)(lds + ROUTE_OFF), lds, ch * 64, XB, XB, INP(24) + l * D, INP(25) + l * D, (const bf16*)(ws + WS_WR) + (size_t)l * 64 * D, INP(27) + l * 4, INP(29) + l * 16,
                                 ctl + CW_CNT + l * 16 * CNT_STRIDE, (int*)(ws + WS_TOKIDX), (float*)(ws + WS_GATE), wave, lane);
            }
            SEAM();
        }
        if (EN_MOE1 && IN(PH_MOE1)) {
            PHASE_PTRS();
            for (int rep_ = 0; rep_ < DUP_MOE1; ++rep_) {
            moe_tab_build((LAS int*)(lds + MOETAB_OFF), ctl + CW_CNT + l * 16 * CNT_STRIDE, wave == 0 && lane == 0); const MoeTab T{(LAS const int*)(lds + MOETAB_OFF)};
            { SchedMoe<2> Sc{vcu, G, T, (const char*)XB, (const char*)(ws + WS_WBUF + (size_t)(l & 1) * WBUF_STRIDE + WB_W13), (size_t)512 * D * 2, (const int*)(ws + WS_TOKIDX), 0};
              EpiMoe1 E{(bf16*)(ws + WS_ACT), (const float*)(ws + WS_GATE), T};
              pg8::gemm_phase<EpiMoe1, SchedMoe<2>, true>(lds, D, Sc, E, wave);
#if defined(PROBE_MOE1A)
              pg8::gemm_phase<EpiMoe1, SchedMoe<2>, true>(lds, D, Sc, E, wave);
#endif
            }
            { SchedSq Sc{vcu, G, (const char*)XB, (const char*)(ws + WS_WBUF + (size_t)(l & 1) * WBUF_STRIDE + WB_WG), TILEB, TILEB, 0};
              EpiPle<1> E{(bf16*)(ws + WS_YP), INP(34) + l * D};
              pg8::gemm_phase<EpiPle<1>, SchedSq>(lds, D, Sc, E, wave); }
            if (l + 1 < DEPTH) {
                int x2 = 2 * T.pre(16) - G; x2 = x2 < 0 ? 0 : (x2 > G / 2 ? G / 2 : x2);
                if (vcu >= x2) WCV_LAYER(l + 1, (vcu - x2) * NWAVES + wave, (G - x2) * NWAVES, 0, WCV_SPLIT_IT, (size_t)0, WCV_SPLIT_PB);
            }
            }
            SEAM();
        }
        if (EN_MOE2 && IN(PH_MOE2)) {
            PHASE_PTRS();
            for (int rep_ = 0; rep_ < DUP_MOE2; ++rep_) {
            moe_tab_build((LAS int*)(lds + MOETAB_OFF), ctl + CW_CNT + l * 16 * CNT_STRIDE, wave == 0 && lane == 0); const MoeTab T{(LAS const int*)(lds + MOETAB_OFF)};
            SchedMoe<4> Sc{vcu, G, T, (const char*)(ws + WS_ACT), (const char*)(ws + WS_WBUF + (size_t)(l & 1) * WBUF_STRIDE + WB_W2), (size_t)D * 256 * 2, (const int*)(ws + WS_TOKIDX), (size_t)256 * 256 * 2};
            EpiMoe2 E{(bf16*)(ws + WS_YMOE), (const int*)(ws + WS_TOKIDX), T};
            pg8::gemm_phase<EpiMoe2, SchedMoe<4>>(lds, 256, Sc, E, wave);
            if (l + 1 < DEPTH) {
                int x3 = 4 * T.pre(16) - 2 * G; x3 = x3 < 0 ? 0 : (x3 > G / 2 ? G / 2 : x3);
                if (vcu >= x3) WCV_LAYER(l + 1, (vcu - x3) * NWAVES + wave, (G - x3) * NWAVES, WCV_SPLIT_IT, 6784, WCV_SPLIT_PB, (size_t)M * 256);
            }
            }
            SEAM();
        }
        if (EN_LN2 && IN(PH_LN2)) {
            PHASE_PTRS();
            for (int rep_ = 0; rep_ < DUP_LN2; ++rep_) {
            int ln = lane; asm volatile("" : "+v"(ln));
            const bf16* YM = (const bf16*)(ws + WS_YMOE); const bf16* YP = (const bf16*)(ws + WS_YP);
            const bool lastl = (l == DEPTH - 1);
#if defined(PROBE_LN2)
            for (int m = gw; m < M; m += NGW)
                ln_row(XB + (size_t)m * D, DN_ALPHA, YM + (size_t)(2 * m) * D, YM + (size_t)(2 * m + 1) * D, YP + (size_t)m * D, INP(36) + l * D, INP(37) + l * D, (float*)nullptr, (bf16*)(ws + WS_STASH) + (size_t)m * D, ln);
#endif
            for (int m = 4 * gw; m < M; m += 4 * NGW)
                ln2_row4(XB + (size_t)m * D, DN_ALPHA, YM + (size_t)(2 * m) * D, YP + (size_t)m * D, INP(36) + l * D, INP(37) + l * D,
                         lastl ? a.out + (size_t)m * D : (float*)nullptr, lastl ? (bf16*)nullptr : XB + (size_t)m * D, ln);
            }
            if (l != DEPTH - 1) SEAM();
        }
    }
#undef IN
#undef SEAM
}
static void mk_launch(const Args& base, int ph, int l, int grid, hipStream_t stream) {
    Args a = base; a.ph_lo = ph; a.ph_hi = ph + 1; a.l_lo = l; a.l_hi = l + 1; a.single = 1;
    hipLaunchKernelGGL(mk_fwd, dim3(grid), dim3(NWAVES * 64), LDS_BYTES, stream, a);
}
extern "C" void kernel_launch(void* const* d_in, const int* in_sizes, int n_in, void* d_out, int out_size, void* d_ws, size_t ws_size, hipStream_t stream) {
    (void)in_sizes; (void)n_in; (void)out_size; (void)ws_size;
    static int grid = 0;
    if (grid == 0) {
        int dev = 0, cus = 0;
        if (hipGetDevice(&dev) != hipSuccess || hipDeviceGetAttribute(&cus, hipDeviceAttributeMultiprocessorCount, dev) != hipSuccess) { grid = -1; return; }
        if (hipFuncSetAttribute((const void*)mk_fwd, hipFuncAttributeMaxDynamicSharedMemorySize, LDS_BYTES) != hipSuccess) { grid = -1; return; }
        (void)hipGetLastError();
        grid = cus;
    }
    if (grid < 0) return;
    (void)hipMemsetAsync((char*)d_ws + WS_CTL, 0, CTL_ZERO_BYTES, stream);
    Args base{};
    for (int i = 0; i < 38; ++i) base.in[i] = (const float*)d_in[i];
    base.out = (float*)d_out; base.ws = (unsigned char*)d_ws;
    base.eid = nullptr; base.wts = nullptr;
#if defined(MK_PER_PHASE)
    mk_launch(base, PH_PRO, 0, grid, stream);
    for (int l = 0; l < DEPTH; ++l) for (int ph : {PH_IN, PH_HY, PH_HYT, PH_ATT, PH_POOL, PH_OUT, PH_LN1, PH_WCV, PH_MOE1, PH_MOE2, PH_LN2}) mk_launch(base, ph, l, grid, stream);
#else
    Args a = base; a.ph_lo = 0; a.ph_hi = PH_END; a.l_lo = 0; a.l_hi = DEPTH; a.single = 0;
    hipLaunchKernelGGL(mk_fwd, dim3(grid), dim3(NWAVES * 64), LDS_BYTES, stream, a);
#endif
}
```

```cpp
#include <hip/hip_runtime.h>
#include <stdint.h>
#include <math.h>
namespace pg8 {
#define PG8_LAS __attribute__((address_space(3)))
typedef unsigned short bf16_t;
typedef short bf16x8 __attribute__((ext_vector_type(8)));
typedef float f32x4 __attribute__((ext_vector_type(4)));
typedef unsigned u32x4 __attribute__((ext_vector_type(4)));
constexpr int BM = 256, BK = 64, HALF = 128, HTB = HALF * BK * 2  , STAGE_BYTES = 8 * HTB;

__host__ __device__ __forceinline__ int lds_byte(int r, int c) { const int st = (r >> 4) * 2 + (c >> 5), rr = r & 15, cc = c & 31, ob = rr * 64 + cc * 2; return st * 1024 + (ob ^ (((ob >> 9) & 1) << 5)); }
__host__ __device__ __forceinline__ void stage_rc(int b, int& R, int& C) { const int st = b / 1024, sb = b % 1024, swz = sb ^ (((sb >> 9) & 1) << 5); R = (st >> 1) * 16 + swz / 64; C = (st & 1) * 32 + (swz % 64) / 2; }
__host__ __device__ __forceinline__ int perm32(int rho) { const int n = rho >> 4, i = rho & 15; return 8 * (i >> 2) + 4 * n + (i & 3); }

struct Unit { const char* A; const char* B; int kind, pm, pn, aux; };

__device__ __forceinline__ unsigned cvt_pk_bf16(float lo, float hi) { unsigned r; asm volatile("v_cvt_pk_bf16_f32 %0, %1, %2" : "=v"(r) : "v"(lo), "v"(hi)); return r; }

template <class Epi, class Sched, bool GATHER = false>
__device__ __forceinline__ void gemm_phase(PG8_LAS unsigned char* lds, const int K_, const Sched& S, const Epi& E, const int wave_) {
    int K = K_; asm volatile("" : "+s"(K));
    int tid_; asm volatile("v_mbcnt_lo_u32_b32 %0, -1, 0\n\tv_mbcnt_hi_u32_b32 %0, -1, %0" : "=v"(tid_)); tid_ += wave_ * 64;
    const int tid = tid_, wid = __builtin_amdgcn_readfirstlane(tid >> 6), lane = tid & 63, wr = wid >> 2, wc = wid & 3, fr = lane & 15, fq = lane >> 4;
    const int nt = K / BK;
    unsigned voffA[2][2], voffN[2][2] = {{0u, 0u}, {0u, 0u}}, voffB[2]; int RA[2], CA[2];
#pragma unroll
    for (int i = 0; i < 2; ++i) { int R, C; stage_rc(tid * 16 + i * 8192, R, C); const int Rb = Epi::PERM ? ((R & ~31) + perm32(R & 31)) : R; RA[i] = R; CA[i] = C;
        voffA[0][i] = (unsigned)(R * K + C) * 2u; voffA[1][i] = (unsigned)((R + HALF) * K + C) * 2u; voffB[i] = (unsigned)(Rb * K + C) * 2u; }
    const size_t kstep = (size_t)(BK * 2);
    const size_t hstep = (size_t)HALF * K * 2;
    const unsigned ldsw = (unsigned)wid * 1024u;
    const int aoff = lds_byte(wr * 64 + fr, fq * 8), boff = lds_byte(wc * 32 + fr, fq * 8);
#define PG8_SA(b, h) (((b) * 2 + (h)) * HTB)
#define PG8_SB(b, h) ((4 + (b) * 2 + (h)) * HTB)
#define PG8_STAGE(bufoff, gbase, voff) do { _Pragma("unroll") for (int _i = 0; _i < 2; ++_i) \
        __builtin_amdgcn_global_load_lds((const unsigned*)((const char*)(gbase) + (voff)[_i]), (PG8_LAS unsigned*)(lds + (bufoff) + ldsw + _i * 8192), 16, 0, 0); } while (0)
#define PG8_LDA(dst, b, h) do { _Pragma("unroll") for (int m = 0; m < 4; ++m) _Pragma("unroll") for (int k = 0; k < 2; ++k) dst[m][k] = *(const PG8_LAS bf16x8*)(lds + PG8_SA(b, h) + aoff + m * 2048 + k * 1024); } while (0)
#define PG8_LDB(dst, b, h) do { _Pragma("unroll") for (int n = 0; n < 2; ++n) _Pragma("unroll") for (int k = 0; k < 2; ++k) dst[n][k] = *(const PG8_LAS bf16x8*)(lds + PG8_SB(b, h) + boff + n * 2048 + k * 1024); } while (0)
#define PG8_MMA(ai, bj, At, Bt) do { __builtin_amdgcn_s_setprio(1); _Pragma("unroll") for (int m = 0; m < 4; ++m) _Pragma("unroll") for (int n = 0; n < 2; ++n) _Pragma("unroll") for (int k = 0; k < 2; ++k) \
        acc[ai][bj][m][n] = __builtin_amdgcn_mfma_f32_16x16x32_bf16(Bt[n][k], At[m][k], acc[ai][bj][m][n], 0, 0, 0); __builtin_amdgcn_s_setprio(0); } while (0)
#define PG8_WAIT_V(n) asm volatile("s_waitcnt vmcnt(" #n ")" ::: "memory")
#define PG8_WAIT_L(n) asm volatile("s_waitcnt lgkmcnt(" #n ")" ::: "memory")
#define PG8_BAR __builtin_amdgcn_s_barrier()
#define PG8_SCHED __builtin_amdgcn_sched_barrier(0)
    Unit cur, nxt; int ui = 0;
    if (!S.next(0, cur)) return;
    if constexpr (GATHER) {
#pragma unroll
        for (int h = 0; h < 2; ++h)
#pragma unroll
            for (int i = 0; i < 2; ++i) voffA[h][i] = (unsigned)(S.arow(cur, h * HALF + RA[i]) * K + CA[i]) * 2u;
    }
    f32x4 acc[2][2][4][2];
#pragma unroll
    for (int a = 0; a < 2; ++a)
#pragma unroll
        for (int b = 0; b < 2; ++b)
#pragma unroll
            for (int m = 0; m < 4; ++m)
#pragma unroll
                for (int n = 0; n < 2; ++n) acc[a][b][m][n] = (f32x4){0.f, 0.f, 0.f, 0.f};
    bf16x8 At[4][2], B0[2][2], B1[2][2];
    const char* cA = cur.A; const char* cB = cur.B;
    PG8_STAGE(PG8_SB(0, 0), cB, voffB); PG8_STAGE(PG8_SB(0, 1), cB + hstep, voffB); PG8_STAGE(PG8_SA(0, 0), cA, voffA[0]); PG8_STAGE(PG8_SA(0, 1), cA, voffA[1]);
    if (wr == 1) PG8_BAR;
    PG8_WAIT_V(2); PG8_BAR;
    PG8_STAGE(PG8_SB(1, 0), cB + kstep, voffB); PG8_STAGE(PG8_SA(1, 0), cA + kstep, voffA[0]); PG8_STAGE(PG8_SB(1, 1), cB + hstep + kstep, voffB);
    PG8_WAIT_V(6); PG8_BAR;
    for (;;) {
        const bool has_next = S.next(ui + 1, nxt);
        const char* nA = has_next ? nxt.A : cA; const char* nB = has_next ? nxt.B : cB;
        if constexpr (GATHER) {
#pragma unroll
            for (int h = 0; h < 2; ++h)
#pragma unroll
                for (int i = 0; i < 2; ++i) voffN[h][i] = has_next ? (unsigned)(S.arow(nxt, h * HALF + RA[i]) * K + CA[i]) * 2u : voffA[h][i];
        }
#pragma unroll 1
        for (int t = 0; t < nt; t += 2) {
            const bool last = (t == nt - 2);
            const char* a1 = cA + (size_t)(t + 1) * kstep;
            const char* a2 = last ? nA : cA + (size_t)(t + 2) * kstep; const char* b2 = last ? nB : cB + (size_t)(t + 2) * kstep;
            const char* a3 = a2 + kstep; const char* b3 = b2 + kstep;
            PG8_LDB(B0, 0, 0); PG8_LDB(B1, 0, 1); PG8_SCHED; PG8_LDA(At, 0, 0); PG8_STAGE(PG8_SA(1, 1), a1, voffA[1]);
            if constexpr (GATHER) { if (last) {
#pragma unroll
                for (int h = 0; h < 2; ++h)
#pragma unroll
                    for (int i = 0; i < 2; ++i) voffA[h][i] = voffN[h][i]; } }
            PG8_WAIT_V(8); PG8_WAIT_L(0); PG8_BAR; PG8_MMA(0, 0, At, B0); PG8_MMA(0, 1, At, B1); PG8_BAR; PG8_SCHED;
            PG8_LDA(At, 0, 1); PG8_STAGE(PG8_SB(0, 0), b2, voffB); PG8_STAGE(PG8_SB(0, 1), b2 + hstep, voffB); PG8_STAGE(PG8_SA(0, 0), a2, voffA[0]);
            PG8_WAIT_V(8); PG8_WAIT_L(0); PG8_BAR; PG8_MMA(1, 0, At, B0); PG8_MMA(1, 1, At, B1); PG8_BAR; PG8_SCHED;
            PG8_LDB(B0, 1, 0); PG8_LDB(B1, 1, 1); PG8_SCHED; PG8_LDA(At, 1, 0); PG8_STAGE(PG8_SA(0, 1), a2, voffA[1]);
            PG8_WAIT_V(8); PG8_WAIT_L(0); PG8_BAR; PG8_MMA(0, 0, At, B0); PG8_MMA(0, 1, At, B1); PG8_BAR; PG8_SCHED;
            PG8_LDA(At, 1, 1); PG8_STAGE(PG8_SB(1, 0), b3, voffB); PG8_STAGE(PG8_SB(1, 1), b3 + hstep, voffB); PG8_STAGE(PG8_SA(1, 0), a3, voffA[0]);
            PG8_WAIT_V(8); PG8_WAIT_L(0); PG8_BAR; PG8_MMA(1, 0, At, B0); PG8_MMA(1, 1, At, B1); PG8_BAR; PG8_SCHED;
        }
        if (wr == 0) PG8_BAR;
        { Unit ce = cur; ce.pm = __builtin_amdgcn_readfirstlane(cur.pm); ce.pn = __builtin_amdgcn_readfirstlane(cur.pn); ce.kind = __builtin_amdgcn_readfirstlane(cur.kind); ce.aux = __builtin_amdgcn_readfirstlane(cur.aux); int fr_ = fr, fq_ = fq;
          asm volatile("" : "+s"(ce.pm), "+s"(ce.pn), "+s"(ce.kind), "+s"(ce.aux), "+v"(fr_), "+v"(fq_));
          E(acc, ce, wr, wc, fr_, fq_); }
        if (!has_next) break;
#pragma unroll
        for (int a = 0; a < 2; ++a)
#pragma unroll
            for (int b = 0; b < 2; ++b)
#pragma unroll
                for (int m = 0; m < 4; ++m)
#pragma unroll
                    for (int n = 0; n < 2; ++n) acc[a][b][m][n] = (f32x4){0.f, 0.f, 0.f, 0.f};
        cur = nxt; cA = nA; cB = nB; ++ui;
        if (wr == 1) PG8_BAR;
    }
    PG8_WAIT_V(0);
    PG8_BAR;
#undef PG8_SA
#undef PG8_SB
#undef PG8_STAGE
#undef PG8_LDA
#undef PG8_LDB
#undef PG8_MMA
#undef PG8_WAIT_V
#undef PG8_WAIT_L
#undef PG8_BAR
#undef PG8_SCHED
}
}
constexpr int D = 1024, NB = 4, S = 4096, M = NB * S, DEPTH = 4, INW = 2560;
constexpr float DN_ALPHA = 1.681792830507429f;
constexpr float QSCALE = 0.125f * 1.4426950408889634f;
constexpr int NWAVES = 8;
constexpr size_t MiB = 1u << 20;
constexpr size_t TILEB = (size_t)256 * D * 2;
constexpr size_t WS_CTL = 0, CTL_ZERO_BYTES = 1 * MiB;
constexpr size_t WS_CS = 1 * MiB;
constexpr size_t WS_WIN = 2 * MiB, WIN_LAYER = 5 * MiB;
constexpr size_t WS_XB = 22 * MiB;
constexpr size_t WS_QKP = 118 * MiB;
constexpr size_t WS_UVT = 158 * MiB;
constexpr size_t WS_MIXB = 198 * MiB;
constexpr size_t WS_STASH = 54 * MiB;
constexpr size_t WS_WOUT = 383 * MiB, WOUT_LAYER = 2 * MiB;
constexpr size_t WS_TOKIDX = 391 * MiB, WS_GATE = 392 * MiB;
constexpr size_t WS_YMOE = WS_QKP;
constexpr size_t WS_YP = 86 * MiB;
constexpr size_t WS_ACT = 230 * MiB;
constexpr size_t WS_WBUF = 288 * MiB, WBUF_STRIDE = 35 * MiB, WB_W13 = 0, WB_W2 = 16 * MiB, WB_WG = 24 * MiB, WB_WP = 26 * MiB, WB_PB = 27 * MiB;
constexpr size_t WS_KF = 262 * MiB, WS_PS = 278 * MiB, WS_HT = 280 * MiB;
constexpr size_t WS_WR = 256 * MiB;
constexpr int CW_BAR = 4096, CW_CNT = 8192, CNT_STRIDE = 64;

#define GAS __attribute__((address_space(1)))
#define LAS __attribute__((address_space(3)))
typedef unsigned short bf16;
typedef unsigned v4u __attribute__((ext_vector_type(4)));
typedef float f32x4 __attribute__((ext_vector_type(4)));
typedef short bf16x8 __attribute__((ext_vector_type(8)));
typedef GAS unsigned gu32;
typedef GAS unsigned long long gu64;
#define RLX_AGENT __ATOMIC_RELAXED, __HIP_MEMORY_SCOPE_AGENT
#define LDS_WAIT() asm volatile("s_waitcnt lgkmcnt(0)" ::: "memory")
#define VM_WAIT() asm volatile("s_waitcnt vmcnt(0)" ::: "memory")
__device__ __forceinline__ unsigned long long rt() { return __builtin_amdgcn_s_memrealtime(); }
__device__ __forceinline__ unsigned f2bf(float f) { unsigned u = __builtin_bit_cast(unsigned, f); return (u + 0x7fffu + ((u >> 16) & 1u)) >> 16; }
__device__ __forceinline__ unsigned pk2(float lo, float hi) { return f2bf(lo) | (f2bf(hi) << 16); }

#define XB_TMO      128
#define XB_XCNT(j)  (256  + 64 * (j))
#define XB_XSUB(j)  (1280 + 64 * (j))
#define XB_XGEN(j)  (2304 + 64 * (j))
#define XB_TOP      3328
#define XB_TOPGEN   3392
#define XCD_BAR_WORDS 3456
#define XB_SPIN_CAP (1u << 18)

__device__ __forceinline__ unsigned xb_ld(unsigned* p)              { return __hip_atomic_load(p, __ATOMIC_RELAXED, __HIP_MEMORY_SCOPE_AGENT); }
__device__ __forceinline__ unsigned xb_add(unsigned* p, unsigned v) { return __hip_atomic_fetch_add(p, v, __ATOMIC_RELAXED, __HIP_MEMORY_SCOPE_AGENT); }
__device__ __forceinline__ unsigned xb_xcc_id() { return (unsigned)__builtin_amdgcn_s_getreg((3 << 11) | 20) & 0xFu; }
#define XB_SPIN(cond, bar) do { unsigned _sp = 0; while (cond) { __builtin_amdgcn_s_sleep(1); \
    if ((++_sp & 255u) == 0u) { if (xb_ld(&(bar)[XB_TMO])) break; if (_sp > XB_SPIN_CAP) { atomicAdd(&(bar)[XB_TMO], 1u); break; } } } } while (0)

struct XcdBarrier {
    unsigned* bar; unsigned x;
    volatile LAS unsigned* st;
};

__device__ __forceinline__ unsigned mk_lane_id() { unsigned x; asm volatile("v_mbcnt_lo_u32_b32 %0, -1, 0\n\tv_mbcnt_hi_u32_b32 %0, -1, %0" : "=v"(x)); return x; }
__device__ __forceinline__ XcdBarrier xcd_barrier_post(unsigned* bar, volatile LAS unsigned* st, int wave) {
    XcdBarrier b; b.bar = bar; b.x = xb_xcc_id(); b.st = st;
    if (wave == 0 && mk_lane_id() == 0u) (void)xb_add(&bar[XB_XCNT(b.x)], 1u);
    return b;
}
__device__ __forceinline__ void xcd_barrier_complete(unsigned* bar, unsigned x, unsigned& nloc, unsigned& nx) {
    const unsigned G = gridDim.x * gridDim.y * gridDim.z;
    unsigned sum, cnt, mine, sp = 0u;
    for (;;) {
        sum = 0u; cnt = 0u; mine = 0u;
#pragma unroll
        for (unsigned j = 0; j < 16; ++j) { const unsigned c = xb_ld(&bar[XB_XCNT(j)]); sum += c; cnt += (c > 0u) ? 1u : 0u; mine = (j == x) ? c : mine; }
        if (sum == G) break;
        __builtin_amdgcn_s_sleep(1);
        if ((++sp & 255u) == 0u) { if (xb_ld(&bar[XB_TMO])) break; if (sp > XB_SPIN_CAP) { atomicAdd(&bar[XB_TMO], 1u); break; } }
    }
    nloc = mine > 0u ? mine : 1u; nx = cnt > 0u ? cnt : 1u;
}

__device__ __forceinline__ void xcd_barrier(const XcdBarrier& b, int wave) {
    asm volatile("" : "+s"(wave));
    const bool t0_ = (wave == 0) && (mk_lane_id() == 0u);
    asm volatile("s_waitcnt vmcnt(0)" ::: "memory");
    __syncthreads();
    if (t0_) {
        unsigned* bar = b.bar; unsigned bx_ = b.x; asm volatile("" : "+s"(bx_));
        __builtin_amdgcn_s_waitcnt(0);
        unsigned nloc = b.st[0], nx = b.st[1];
        if (nloc == 0u) { xcd_barrier_complete(bar, bx_, nloc, nx); b.st[0] = nloc; b.st[1] = nx; }
        const unsigned old = xb_add(&bar[XB_XSUB(bx_)], 1u);
        const unsigned gen = old / nloc;
        if (old + 1u == (gen + 1u) * nloc) {
            __builtin_amdgcn_fence(__ATOMIC_RELEASE, "agent");
            asm volatile("s_waitcnt vmcnt(0)" ::: "memory");
            const unsigned og = xb_add(&bar[XB_TOP], 1u);
            const unsigned tg = og / nx;
            if (og + 1u == (tg + 1u) * nx) xb_add(&bar[XB_TOPGEN], 1u);
            else XB_SPIN(xb_ld(&bar[XB_TOPGEN]) == tg, bar);
            __builtin_amdgcn_fence(__ATOMIC_ACQUIRE, "agent");
            xb_add(&bar[XB_XGEN(bx_)], 1u);
            asm volatile("s_waitcnt vmcnt(0)" ::: "memory");
        } else {
            XB_SPIN(xb_ld(&bar[XB_XGEN(bx_)]) == gen, bar);
            __builtin_amdgcn_fence(__ATOMIC_ACQUIRE, "agent");
            asm volatile("s_waitcnt vmcnt(0)" ::: "memory");
        }
    }
    __syncthreads();
}
__device__ __forceinline__ float bf2f(unsigned short b) { return __uint_as_float((unsigned)b << 16); }
#define MK_DPP(v, ctrl) __uint_as_float(__builtin_amdgcn_update_dpp(0, __float_as_uint(v), (ctrl), 0xF, 0xF, true))
__device__ __forceinline__ float xsum16(float v) { const auto r = __builtin_amdgcn_permlane16_swap(__float_as_uint(v), __float_as_uint(v), false, false); return __uint_as_float(r[0]) + __uint_as_float(r[1]); }
__device__ __forceinline__ float xsum32(float v) { const auto r = __builtin_amdgcn_permlane32_swap(__float_as_uint(v), __float_as_uint(v), false, false); return __uint_as_float(r[0]) + __uint_as_float(r[1]); }
__device__ __forceinline__ float wave_sum(float v) {
    v += MK_DPP(v, 0xB1); v += MK_DPP(v, 0x4E);
    v += MK_DPP(v, 0x141); v += MK_DPP(v, 0x140);
    return xsum32(xsum16(v));
}
__device__ __forceinline__ void p0_transpose_block(const float* W, int K, int N, int k0, int n0, bf16* WT, int mode, LAS float* scr, int lane) {
#pragma unroll
    for (int i = 0; i < 8; ++i) { const int kk = 8 * i + (lane >> 3), n4 = (lane & 7) * 4;
        const f32x4 w = *(const GAS f32x4*)(W + (size_t)(k0 + kk) * N + n0 + n4);
        LAS float* d = scr + kk * 33 + n4; d[0] = w.x; d[1] = w.y; d[2] = w.z; d[3] = w.w; }
    LDS_WAIT(); asm volatile("" ::: "memory");
    const int c = lane & 7;
#pragma unroll 1
    for (int j = 0; j < 4; ++j) { const int n = (lane >> 3) + 8 * j; const LAS float* s = scr + (8 * c) * 33 + n;
        v4u o; o.x = pk2(s[0 * 33], s[1 * 33]); o.y = pk2(s[2 * 33], s[3 * 33]); o.z = pk2(s[4 * 33], s[5 * 33]); o.w = pk2(s[6 * 33], s[7 * 33]);
        const int f = n0 + n; const size_t drow = mode == 0 ? (size_t)n : (size_t)(8 * (f >> 2) + (f & 3) + (mode == 2 ? 4 : 0));
        *(GAS v4u*)(WT + drow * K + k0 + 8 * c) = o; }
    LDS_WAIT(); asm volatile("" ::: "memory");
}
template <class TX> __device__ __forceinline__ void ln_row(const TX* x0, float a, const bf16* y1, const bf16* y2, const bf16* y3, const float* g, const float* b, float* of, bf16* ob, int lane) {
    f32x4 v[4]; float s = 0.f;
#pragma unroll
    for (int j = 0; j < 4; ++j) { const int c = 4 * lane + 256 * j;
        if constexpr (sizeof(TX) == 4) v[j] = *(const GAS f32x4*)(x0 + c) * a;
        else { const unsigned long long w = *(const GAS unsigned long long*)(x0 + c); v[j] = (f32x4){bf2f((bf16)w), bf2f((bf16)(w >> 16)), bf2f((bf16)(w >> 32)), bf2f((bf16)(w >> 48))} * a; }
        if (y1) { const unsigned long long w = *(const GAS unsigned long long*)(y1 + c); v[j] += (f32x4){bf2f((bf16)w), bf2f((bf16)(w >> 16)), bf2f((bf16)(w >> 32)), bf2f((bf16)(w >> 48))}; }
        if (y2) { const unsigned long long w = *(const GAS unsigned long long*)(y2 + c); v[j] += (f32x4){bf2f((bf16)w), bf2f((bf16)(w >> 16)), bf2f((bf16)(w >> 32)), bf2f((bf16)(w >> 48))}; }
        if (y3) { const unsigned long long w = *(const GAS unsigned long long*)(y3 + c); v[j] += (f32x4){bf2f((bf16)w), bf2f((bf16)(w >> 16)), bf2f((bf16)(w >> 32)), bf2f((bf16)(w >> 48))}; }
        s += (v[j].x + v[j].y) + (v[j].z + v[j].w); }
    const float mean = wave_sum(s) * (1.f / D); float s2 = 0.f;
#pragma unroll
    for (int j = 0; j < 4; ++j) { v[j] = v[j] - mean; s2 += (v[j].x * v[j].x + v[j].y * v[j].y) + (v[j].z * v[j].z + v[j].w * v[j].w); }
    const float rstd = __builtin_amdgcn_rsqf(wave_sum(s2) * (1.f / D) + 1e-5f);
#pragma unroll
    for (int j = 0; j < 4; ++j) { const int c = 4 * lane + 256 * j; const f32x4 o = v[j] * rstd * *(const GAS f32x4*)(g + c) + *(const GAS f32x4*)(b + c);
        if (of) *(GAS f32x4*)(of + c) = o;
        if (ob) *(GAS unsigned long long*)(ob + c) = (unsigned long long)pk2(o.x, o.y) | ((unsigned long long)pk2(o.z, o.w) << 32); }
}

__device__ __forceinline__ void bf8_acc(f32x4& lo, f32x4& hi, const v4u w, float a) {
    lo += (f32x4){bf2f((bf16)w.x), bf2f((bf16)(w.x >> 16)), bf2f((bf16)w.y), bf2f((bf16)(w.y >> 16))} * a; hi += (f32x4){bf2f((bf16)w.z), bf2f((bf16)(w.z >> 16)), bf2f((bf16)w.w), bf2f((bf16)(w.w >> 16))} * a; }
__device__ __forceinline__ void ln2_row4(const bf16* x0, float a, const bf16* ym, const bf16* yp, const float* g, const float* b, float* of, bf16* ob, int lane) {
    f32x4 v[4][4]; float s[4];
#pragma unroll
    for (int r = 0; r < 4; ++r) {
#pragma unroll
        for (int p = 0; p < 2; ++p) { const int c = 8 * lane + 512 * p;
            const v4u w0 = *(const GAS v4u*)(x0 + (size_t)r * D + c), w1 = *(const GAS v4u*)(ym + (size_t)r * 2 * D + c), w2 = *(const GAS v4u*)(ym + (size_t)r * 2 * D + D + c), w3 = *(const GAS v4u*)(yp + (size_t)r * D + c);
            v[r][2 * p] = (f32x4){0.f, 0.f, 0.f, 0.f}; v[r][2 * p + 1] = (f32x4){0.f, 0.f, 0.f, 0.f};
            bf8_acc(v[r][2 * p], v[r][2 * p + 1], w0, a); bf8_acc(v[r][2 * p], v[r][2 * p + 1], w1, 1.f); bf8_acc(v[r][2 * p], v[r][2 * p + 1], w2, 1.f); bf8_acc(v[r][2 * p], v[r][2 * p + 1], w3, 1.f); }
        s[r] = 0.f;
#pragma unroll
        for (int j = 0; j < 4; ++j) s[r] += (v[r][j].x + v[r][j].y) + (v[r][j].z + v[r][j].w); }
    float rstd[4];
#pragma unroll
    for (int r = 0; r < 4; ++r) { const float mean = wave_sum(s[r]) * (1.f / D); float s2 = 0.f;
#pragma unroll
        for (int j = 0; j < 4; ++j) { v[r][j] = v[r][j] - mean; s2 += (v[r][j].x * v[r][j].x + v[r][j].y * v[r][j].y) + (v[r][j].z * v[r][j].z + v[r][j].w * v[r][j].w); }
        rstd[r] = __builtin_amdgcn_rsqf(wave_sum(s2) * (1.f / D) + 1e-5f); }
#pragma unroll
    for (int p = 0; p < 2; ++p) { const int c = 8 * lane + 512 * p; const f32x4 g0 = *(const GAS f32x4*)(g + c), g1 = *(const GAS f32x4*)(g + c + 4), b0 = *(const GAS f32x4*)(b + c), b1 = *(const GAS f32x4*)(b + c + 4);
#pragma unroll
        for (int r = 0; r < 4; ++r) { const f32x4 o0 = v[r][2 * p] * rstd[r] * g0 + b0, o1 = v[r][2 * p + 1] * rstd[r] * g1 + b1;
            if (of) { *(GAS f32x4*)(of + (size_t)r * D + c) = o0; *(GAS f32x4*)(of + (size_t)r * D + c + 4) = o1; }
            if (ob) { v4u w; w.x = pk2(o0.x, o0.y); w.y = pk2(o0.z, o0.w); w.z = pk2(o1.x, o1.y); w.w = pk2(o1.z, o1.w); *(GAS v4u*)(ob + (size_t)r * D + c) = w; } } }
}

__device__ __forceinline__ void ln0_row4(const float* x0, const float* g, const float* b, bf16* ob, int lane) {
    f32x4 v[4][4]; float s[4];
#pragma unroll
    for (int r = 0; r < 4; ++r) { s[r] = 0.f;
#pragma unroll
        for (int p = 0; p < 2; ++p) { const int c = 8 * lane + 512 * p; v[r][2 * p] = __builtin_nontemporal_load((const GAS f32x4*)(x0 + (size_t)r * D + c)); v[r][2 * p + 1] = __builtin_nontemporal_load((const GAS f32x4*)(x0 + (size_t)r * D + c + 4)); }
#pragma unroll
        for (int j = 0; j < 4; ++j) s[r] += (v[r][j].x + v[r][j].y) + (v[r][j].z + v[r][j].w); }
    float rstd[4];
#pragma unroll
    for (int r = 0; r < 4; ++r) { const float mean = wave_sum(s[r]) * (1.f / D); float s2 = 0.f;
#pragma unroll
        for (int j = 0; j < 4; ++j) { v[r][j] = v[r][j] - mean; s2 += (v[r][j].x * v[r][j].x + v[r][j].y * v[r][j].y) + (v[r][j].z * v[r][j].z + v[r][j].w * v[r][j].w); }
        rstd[r] = __builtin_amdgcn_rsqf(wave_sum(s2) * (1.f / D) + 1e-5f); }
#pragma unroll
    for (int p = 0; p < 2; ++p) { const int c = 8 * lane + 512 * p; const f32x4 g0 = *(const GAS f32x4*)(g + c), g1 = *(const GAS f32x4*)(g + c + 4), b0 = *(const GAS f32x4*)(b + c), b1 = *(const GAS f32x4*)(b + c + 4);
#pragma unroll
        for (int r = 0; r < 4; ++r) { const f32x4 o0 = v[r][2 * p] * rstd[r] * g0 + b0, o1 = v[r][2 * p + 1] * rstd[r] * g1 + b1;
            v4u w; w.x = pk2(o0.x, o0.y); w.y = pk2(o0.z, o0.w); w.z = pk2(o1.x, o1.y); w.w = pk2(o1.z, o1.w); *(GAS v4u*)(ob + (size_t)r * D + c) = w; } }
}

struct SchedIn {
    int vcu, G; const char* xb; const char* wsw; const char* wnm;
    __device__ __forceinline__ bool next(int i, pg8::Unit& u) const {
        const int L = i * G + vcu; if (L >= 640) return false;
        const int t = L / 10, j = L % 10;
        const int sw = __builtin_amdgcn_readfirstlane((unsigned)(j + 27) >> 5);
        const int jj = j - 5 * sw; const char* tp = xb + (size_t)t * TILEB; const char* wp = (sw ? wsw : wnm) + (size_t)jj * TILEB;
        u.kind = sw; u.pm = sw ? jj : t; u.pn = sw ? t : jj; u.A = sw ? wp : tp; u.B = sw ? tp : wp;
        u.aux = 0; return true;
    }
};
struct EpiIn {
    static constexpr bool PERM = true;
    bf16* qkp; bf16* uvt; const float* cs;
    __device__ __forceinline__ void operator()(const pg8::f32x4 (&acc)[2][2][4][2], const pg8::Unit& u, int wr, int wc, int fr, int fq) const {
        bf16* base = u.kind == 0 ? qkp : uvt; const int ldc = u.kind == 0 ? 1280 : M;
        const int row0 = u.pm * 256 + wr * 64 + fr, col0 = u.pn * 256 + wc * 32 + 8 * fq;
        const bool rope = (u.kind == 0) && (u.pn < 4) && ((wc & 1) == 0);
        const float sc = (u.kind == 0 && u.pn < 2) ? QSCALE : 1.f;
        const float sgn = fq == 0 ? -1.f : 1.f;
        const bool vperm = (u.kind == 1) && (u.pm >= 3);
#pragma unroll
        for (int ai = 0; ai < 2; ++ai)
#pragma unroll
            for (int m = 0; m < 4; ++m) { const int row = row0 + ai * 128 + m * 16; bf16* rowp = base + (size_t)row * ldc + col0;
                f32x4 cv0 = {1.f, 1.f, 1.f, 1.f}, cv1 = cv0, sv0 = {0.f, 0.f, 0.f, 0.f}, sv1 = sv0;
                if (rope && fq < 2) { const float* t = cs + (size_t)(row & (S - 1)) * 16; cv0 = *(const f32x4*)t; cv1 = *(const f32x4*)(t + 4); sv0 = *(const f32x4*)(t + 8) * sgn; sv1 = *(const f32x4*)(t + 12) * sgn; }
#pragma unroll
                for (int bj = 0; bj < 2; ++bj) { f32x4 v0 = acc[ai][bj][m][0], v1 = acc[ai][bj][m][1];
                    if (rope) { f32x4 p0, p1;
#pragma unroll
                        for (int e = 0; e < 4; ++e) { const auto r0 = __builtin_amdgcn_permlane16_swap(__float_as_uint(v0[e]), __float_as_uint(v0[e]), false, false), r1 = __builtin_amdgcn_permlane16_swap(__float_as_uint(v1[e]), __float_as_uint(v1[e]), false, false);
                            p0[e] = __uint_as_float((fq & 1) ? r0[0] : r0[1]); p1[e] = __uint_as_float((fq & 1) ? r1[0] : r1[1]); }
                        v0 = v0 * cv0 + p0 * sv0; v1 = v1 * cv1 + p1 * sv1; }
                    v0 = v0 * sc; v1 = v1 * sc;
                    pg8::u32x4 w; w.x = pg8::cvt_pk_bf16(v0[0], v0[1]); w.y = pg8::cvt_pk_bf16(v0[2], v0[3]); w.z = pg8::cvt_pk_bf16(v1[0], v1[1]); w.w = pg8::cvt_pk_bf16(v1[2], v1[3]);
                    if (vperm) {
                        bf16* gp = rowp + bj * 128 - (fq & 1) * 8;
                        typedef unsigned u32x2 __attribute__((ext_vector_type(2)));
                        *(u32x2*)(gp + ((fq & 1) ? 4 : 0)) = (u32x2){w.x, w.y}; *(u32x2*)(gp + ((fq & 1) ? 12 : 8)) = (u32x2){w.z, w.w};
                    } else *(pg8::u32x4*)(rowp + bj * 128) = w; } }
    }
};

struct SchedOut {
    int vcu, G; const char* a; const char* w;
    __device__ __forceinline__ bool next(int i, pg8::Unit& u) const {
        const int L = i * G + vcu; if (L >= 256) return false;
        u.kind = 0; u.pm = L >> 2; u.pn = L & 3; u.aux = 0; u.A = a + (size_t)u.pm * TILEB; u.B = w + (size_t)u.pn * TILEB; return true;
    }
};
struct EpiRes {
    static constexpr bool PERM = true;
    bf16* XB;
    __device__ __forceinline__ void operator()(const pg8::f32x4 (&acc)[2][2][4][2], const pg8::Unit& u, int wr, int wc, int fr, int fq) const {
        const int row0 = u.pm * 256 + wr * 64 + fr, col0 = u.pn * 256 + wc * 32 + 8 * fq;
#pragma unroll
        for (int ai = 0; ai < 2; ++ai)
#pragma unroll
            for (int m = 0; m < 4; ++m) { bf16* rowp = XB + (size_t)(row0 + ai * 128 + m * 16) * D + col0;
#pragma unroll
                for (int bj = 0; bj < 2; ++bj) { pg8::u32x4* p = (pg8::u32x4*)(rowp + bj * 128); const pg8::u32x4 x = *p; const pg8::f32x4 v0 = acc[ai][bj][m][0], v1 = acc[ai][bj][m][1];
                    pg8::u32x4 w; w.x = pg8::cvt_pk_bf16(bf2f((bf16)x.x) * DN_ALPHA + v0[0], bf2f((bf16)(x.x >> 16)) * DN_ALPHA + v0[1]); w.y = pg8::cvt_pk_bf16(bf2f((bf16)x.y) * DN_ALPHA + v0[2], bf2f((bf16)(x.y >> 16)) * DN_ALPHA + v0[3]);
                    w.z = pg8::cvt_pk_bf16(bf2f((bf16)x.z) * DN_ALPHA + v1[0], bf2f((bf16)(x.z >> 16)) * DN_ALPHA + v1[1]); w.w = pg8::cvt_pk_bf16(bf2f((bf16)x.w) * DN_ALPHA + v1[2], bf2f((bf16)(x.w >> 16)) * DN_ALPHA + v1[3]);
                    *p = w; } }
    }
};
struct RouteLds { unsigned lcnt[16]; unsigned gbase[16]; int e0[64], e1[64]; unsigned r0[64], r1[64]; float g0[64], g1[64]; };
constexpr int RT_PITCH = 2064;
template <int DRY = 0> __device__ __forceinline__ void ln1_router_chunk(LAS RouteLds* R, LAS unsigned char* tile, int row0, bf16* XB, bf16* XOUT, const float* g, const float* b, const bf16* wrt, const float* bgc, const float* bgf,
                                                 gu32* cnt, int* tokidx, float* gate, int wave, int lane) {
    const int tidl = wave * 64 + lane;
    if (tidl < 16) R->lcnt[tidl] = 0u;
#pragma unroll 2
    for (int r = 0; r < 8; ++r) { const int rl = wave * 8 + r; bf16* xbrow = XB + (size_t)(row0 + rl) * D; f32x4 v[4]; float s = 0.f;
#pragma unroll
        for (int p = 0; p < 2; ++p) { const v4u w = *(const GAS v4u*)(xbrow + 8 * lane + 512 * p);
            v[2 * p] = (f32x4){bf2f((bf16)w.x), bf2f((bf16)(w.x >> 16)), bf2f((bf16)w.y), bf2f((bf16)(w.y >> 16))}; v[2 * p + 1] = (f32x4){bf2f((bf16)w.z), bf2f((bf16)(w.z >> 16)), bf2f((bf16)w.w), bf2f((bf16)(w.w >> 16))};
            s += ((v[2 * p].x + v[2 * p].y) + (v[2 * p].z + v[2 * p].w)) + ((v[2 * p + 1].x + v[2 * p + 1].y) + (v[2 * p + 1].z + v[2 * p + 1].w)); }
        const float mean = wave_sum(s) * (1.f / D); float s2 = 0.f;
#pragma unroll
        for (int j = 0; j < 4; ++j) { v[j] = v[j] - mean; s2 += (v[j].x * v[j].x + v[j].y * v[j].y) + (v[j].z * v[j].z + v[j].w * v[j].w); }
        const float rstd = __builtin_amdgcn_rsqf(wave_sum(s2) * (1.f / D) + 1e-5f);
#pragma unroll
        for (int p = 0; p < 2; ++p) { const int c = 8 * lane + 512 * p;
            const f32x4 o0 = v[2 * p] * rstd * *(const GAS f32x4*)(g + c) + *(const GAS f32x4*)(b + c), o1 = v[2 * p + 1] * rstd * *(const GAS f32x4*)(g + c + 4) + *(const GAS f32x4*)(b + c + 4);
            v4u w; w.x = pk2(o0.x, o0.y); w.y = pk2(o0.z, o0.w); w.z = pk2(o1.x, o1.y); w.w = pk2(o1.z, o1.w);
            *(GAS v4u*)(xbrow + c) = w;
            *(LAS v4u*)(tile + rl * RT_PITCH + c * 2) = w; } }
    LDS_WAIT(); __syncthreads();
    if (DRY == 1) return;
    typedef float f32x16_t __attribute__((ext_vector_type(16)));
    f32x16_t pacc;
#pragma unroll
    for (int r = 0; r < 16; ++r) pacc[r] = 0.f;
    { const int rt = wave & 1, kq = wave >> 1, r32 = lane & 31, hi = lane >> 5;
      LAS const unsigned char* ap = tile + (32 * rt + r32) * RT_PITCH + (256 * kq + 8 * hi) * 2;
      const bf16* bh = wrt + (size_t)r32 * D + 256 * kq + 8 * hi; const bf16* bl = bh + 32 * D;
#pragma unroll 4
      for (int ks = 0; ks < 16; ++ks) { const bf16x8 af = *(LAS const bf16x8*)(ap + ks * 32), bhf = *(const GAS bf16x8*)(bh + ks * 16), blf = *(const GAS bf16x8*)(bl + ks * 16);
          pacc = __builtin_amdgcn_mfma_f32_32x32x16_bf16(af, bhf, pacc, 0, 0, 0); pacc = __builtin_amdgcn_mfma_f32_32x32x16_bf16(af, blf, pacc, 0, 0, 0); } }
    LDS_WAIT(); __syncthreads();
    if (DRY == 2) return;
    { const int rt = wave & 1, kq = wave >> 1, r32 = lane & 31, hi = lane >> 5;
      LAS float* P = (LAS float*)tile + (kq * 64 + rt * 32) * 33 + r32;
#pragma unroll
      for (int r = 0; r < 16; ++r) P[((r & 3) + 8 * (r >> 2) + 4 * hi) * 33] = pacc[r]; }
    LDS_WAIT(); __syncthreads();
    if (wave == 0) {
        float my[20];
#pragma unroll
        for (int i = 0; i < 20; ++i) { float t = 0.f;
#pragma unroll
            for (int q = 0; q < 4; ++q) t += ((LAS const float*)tile)[(q * 64 + lane) * 33 + i];
            my[i] = t; }
        const int rl = lane;
        float pg[4], mx = -INFINITY, sum = 0.f;
#pragma unroll
        for (int j = 0; j < 4; ++j) { pg[j] = my[j] + bgc[j]; mx = fmaxf(mx, pg[j]); }
#pragma unroll
        for (int j = 0; j < 4; ++j) { pg[j] = expf(pg[j] - mx); sum += pg[j]; }
        int gi = 0; float gw = pg[0];
#pragma unroll
        for (int j = 1; j < 4; ++j) if (pg[j] > gw) { gw = pg[j]; gi = j; }
        gw /= sum;
        float fs[4]; mx = -INFINITY;
#pragma unroll
        for (int j = 0; j < 4; ++j) { float t = 0.f;
#pragma unroll
            for (int q = 0; q < 4; ++q) if (q == gi) t = my[4 + q * 4 + j] + bgf[q * 4 + j];
            fs[j] = t; mx = fmaxf(mx, t); }
#pragma unroll
        for (int j = 0; j < 4; ++j) fs[j] = expf(fs[j] - mx);
        int t0 = 0; float v0 = fs[0];
#pragma unroll
        for (int j = 1; j < 4; ++j) if (fs[j] > v0) { v0 = fs[j]; t0 = j; }
        int t1 = -1; float v1 = -1.f;
#pragma unroll
        for (int j = 0; j < 4; ++j) if (j != t0 && fs[j] > v1) { v1 = fs[j]; t1 = j; }
        const float ts = v0 + v1; const int e0 = gi * 4 + t0, e1 = gi * 4 + t1;
        R->e0[rl] = e0; R->e1[rl] = e1; R->g0[rl] = gw * (v0 / ts); R->g1[rl] = gw * (v1 / ts);
        R->r0[rl] = __hip_atomic_fetch_add(&R->lcnt[e0], 1u, __ATOMIC_RELAXED, __HIP_MEMORY_SCOPE_WORKGROUP);
        R->r1[rl] = __hip_atomic_fetch_add(&R->lcnt[e1], 1u, __ATOMIC_RELAXED, __HIP_MEMORY_SCOPE_WORKGROUP);
    }
    LDS_WAIT(); __syncthreads();
    if (DRY == 3) return;
    if (tidl < 16) { const unsigned n = R->lcnt[tidl]; R->gbase[tidl] = n ? __hip_atomic_fetch_add(cnt + tidl * CNT_STRIDE, n, RLX_AGENT) : 0u; }
    LDS_WAIT(); __syncthreads();
    if (tidl < 64) { const int rl = tidl, tok = row0 + rl; const int e0 = R->e0[rl], e1 = R->e1[rl]; const unsigned p0 = R->gbase[e0] + R->r0[rl], p1 = R->gbase[e1] + R->r1[rl];
        tokidx[(size_t)e0 * M + p0] = tok * 2; gate[(size_t)e0 * M + p0] = R->g0[rl]; tokidx[(size_t)e1 * M + p1] = tok * 2 + 1; gate[(size_t)e1 * M + p1] = R->g1[rl]; }
    LDS_WAIT(); __syncthreads();
}

struct MoeTab { LAS const int* p;
    __device__ __forceinline__ int cnt(int e) const { return __builtin_amdgcn_readfirstlane(p[e]); }
    __device__ __forceinline__ int pre(int e) const { return __builtin_amdgcn_readfirstlane(p[16 + e]); } };
__device__ __forceinline__ void moe_tab_build(LAS int* p, const gu32* cnt, bool t0) {
    if (t0) { int acc = 0;
        for (int e = 0; e < 16; ++e) { const int c = (int)__hip_atomic_load(cnt + e * CNT_STRIDE, RLX_AGENT); p[e] = c; p[16 + e] = acc; acc += (c + 255) >> 8; }
        p[32] = acc; }
    __syncthreads();
}
template <int NPN> struct SchedMoe {
    int vcu, G; MoeTab T; const char* a; const char* w; size_t wexp  ; const int* tokidx; size_t atile  ;
    __device__ __forceinline__ bool next(int i, pg8::Unit& u) const {
        const int L = i * G + vcu; if (L >= T.pre(16) * NPN) return false;
        const int tile = L / NPN; u.pn = L % NPN; int e = 0;
#pragma unroll
        for (int st = 8; st >= 1; st >>= 1) if (tile >= T.pre(e + st)) e += st;
        u.aux = e; u.pm = tile - T.pre(e); u.kind = tile;
        u.A = a + (size_t)tile * atile; u.B = w + (size_t)e * wexp + (size_t)u.pn * 256 * (wexp / (NPN * 256)); return true;
    }
    __device__ __forceinline__ int arow(const pg8::Unit& u, int r) const {
        const int rank = u.pm * 256 + r; const int c = T.cnt(u.aux);
        return rank < c ? (tokidx[(size_t)u.aux * M + rank] >> 1) : 0;
    }
};
struct EpiMoe1 {
    static constexpr bool PERM = true;
    bf16* act; const float* gate; MoeTab T;
    __device__ __forceinline__ void operator()(const pg8::f32x4 (&acc)[2][2][4][2], const pg8::Unit& u, int wr, int wc, int fr, int fq) const {
        const int cnt = T.cnt(u.aux);
#pragma unroll
        for (int ai = 0; ai < 2; ++ai)
#pragma unroll
            for (int m = 0; m < 4; ++m) { const int r = ai * 128 + wr * 64 + m * 16 + fr, rank = u.pm * 256 + r;
                const float gt = rank < cnt ? gate[(size_t)u.aux * M + rank] : 0.f;
                bf16* rowp = act + ((size_t)u.kind * 256 + r) * 256 + u.pn * 128 + wc * 16 + 4 * fq;
#pragma unroll
                for (int bj = 0; bj < 2; ++bj) { const pg8::f32x4 av = acc[ai][bj][m][0], cv = acc[ai][bj][m][1]; float y[4];
#pragma unroll
                    for (int e = 0; e < 4; ++e) y[e] = av[e] * __builtin_amdgcn_rcpf(1.f + __builtin_amdgcn_exp2f(av[e] * -1.4426950408889634f)) * cv[e] * gt;
                    *(unsigned long long*)(rowp + bj * 64) = (unsigned long long)pg8::cvt_pk_bf16(y[0], y[1]) | ((unsigned long long)pg8::cvt_pk_bf16(y[2], y[3]) << 32); } }
    }
};
struct EpiMoe2 {
    static constexpr bool PERM = true;
    bf16* ymoe; const int* tokidx; MoeTab T;
    __device__ __forceinline__ void operator()(const pg8::f32x4 (&acc)[2][2][4][2], const pg8::Unit& u, int wr, int wc, int fr, int fq) const {
        const int cnt = T.cnt(u.aux);
#pragma unroll
        for (int ai = 0; ai < 2; ++ai)
#pragma unroll
            for (int m = 0; m < 4; ++m) { const int r = ai * 128 + wr * 64 + m * 16 + fr, rank = u.pm * 256 + r;
                if (rank < cnt) { bf16* rowp = ymoe + (size_t)tokidx[(size_t)u.aux * M + rank] * D + u.pn * 256 + wc * 32 + 8 * fq;
#pragma unroll
                    for (int bj = 0; bj < 2; ++bj) { const pg8::f32x4 v0 = acc[ai][bj][m][0], v1 = acc[ai][bj][m][1];
                        pg8::u32x4 w; w.x = pg8::cvt_pk_bf16(v0[0], v0[1]); w.y = pg8::cvt_pk_bf16(v0[2], v0[3]); w.z = pg8::cvt_pk_bf16(v1[0], v1[1]); w.w = pg8::cvt_pk_bf16(v1[2], v1[3]);
                        *(pg8::u32x4*)(rowp + bj * 128) = w; } } }
    }
};
struct SchedSq {
    int vcu, G; const char* a; const char* w; size_t astep, wstep; int vfirst;
    __device__ __forceinline__ bool next(int i, pg8::Unit& u) const {
        if (vcu < vfirst || vcu >= vfirst + G) return false;
        const int L = i * G + (vcu - vfirst); if (L >= 256) return false;
        u.kind = 0; u.pm = L >> 2; u.pn = L & 3; u.aux = 0; u.A = a + (size_t)u.pm * astep; u.B = w + (size_t)u.pn * wstep; return true;
    }
};
template <int GATED> struct EpiPle {
    static constexpr bool PERM = true;
    bf16* yp; const float* bg;
    __device__ __forceinline__ void operator()(const pg8::f32x4 (&acc)[2][2][4][2], const pg8::Unit& u, int wr, int wc, int fr, int fq) const {
        const int row0 = u.pm * 256 + wr * 64 + fr, col0 = u.pn * 256 + wc * 32 + 8 * fq;
#pragma unroll
        for (int ai = 0; ai < 2; ++ai)
#pragma unroll
            for (int m = 0; m < 4; ++m) { bf16* rowp = yp + (size_t)(row0 + ai * 128 + m * 16) * D + col0;
#pragma unroll
                for (int bj = 0; bj < 2; ++bj) { pg8::f32x4 v0 = acc[ai][bj][m][0], v1 = acc[ai][bj][m][1];
                    if (GATED) { const pg8::f32x4 b0 = *(const pg8::f32x4*)(bg + col0 + bj * 128), b1 = *(const pg8::f32x4*)(bg + col0 + bj * 128 + 4); const pg8::u32x4 y = *(const pg8::u32x4*)(rowp + bj * 128);
                        const float yf[8] = {bf2f((bf16)y.x), bf2f((bf16)(y.x >> 16)), bf2f((bf16)y.y), bf2f((bf16)(y.y >> 16)), bf2f((bf16)y.z), bf2f((bf16)(y.z >> 16)), bf2f((bf16)y.w), bf2f((bf16)(y.w >> 16))};
#pragma unroll
                        for (int e = 0; e < 4; ++e) { v0[e] = yf[e] * __builtin_amdgcn_rcpf(1.f + __builtin_amdgcn_exp2f((v0[e] + b0[e]) * -1.4426950408889634f)); v1[e] = yf[4 + e] * __builtin_amdgcn_rcpf(1.f + __builtin_amdgcn_exp2f((v1[e] + b1[e]) * -1.4426950408889634f)); } }
                    pg8::u32x4 w; w.x = pg8::cvt_pk_bf16(v0[0], v0[1]); w.y = pg8::cvt_pk_bf16(v0[2], v0[3]); w.z = pg8::cvt_pk_bf16(v1[0], v1[1]); w.w = pg8::cvt_pk_bf16(v1[2], v1[3]);
                    *(pg8::u32x4*)(rowp + bj * 128) = w; } }
    }
};
namespace att {
typedef float f32x16 __attribute__((ext_vector_type(16)));
constexpr int KSLOT = 8192, VSLOT = 16384, LDS_K = 0, LDS_V = 2 * KSLOT, ATT_LDS = 2 * KSLOT + 2 * VSLOT;
__device__ __forceinline__ bf16x8 pack8(const f32x16& p, int b) {
    v4u w; w.x = pg8::cvt_pk_bf16(p[b], p[b + 1]); w.y = pg8::cvt_pk_bf16(p[b + 2], p[b + 3]); w.z = pg8::cvt_pk_bf16(p[b + 4], p[b + 5]); w.w = pg8::cvt_pk_bf16(p[b + 6], p[b + 7]);
    return __builtin_bit_cast(bf16x8, w);
}
constexpr float THR2 = 8.f;
__device__ __forceinline__ void qkt_load(bf16x8 (&kf)[8], LAS const unsigned char* ks, int r32, int hi) {
    LAS const unsigned char* kb = ks + hi * 1024 + r32 * 16;
#pragma unroll
    for (int kk = 0; kk < 4; ++kk) { kf[2 * kk] = *(LAS const bf16x8*)(kb + kk * 2048); kf[2 * kk + 1] = *(LAS const bf16x8*)(kb + kk * 2048 + 512); }
}
__device__ __forceinline__ void qkt_mma(f32x16& p0, f32x16& p1, const bf16x8 (&kf)[8], const bf16x8 (&qf)[4]) {
#pragma unroll
    for (int r = 0; r < 16; ++r) { p0[r] = 0.f; p1[r] = 0.f; }
#pragma unroll
    for (int kk = 0; kk < 4; ++kk) {
        p0 = __builtin_amdgcn_mfma_f32_32x32x16_bf16(kf[2 * kk], qf[kk], p0, 0, 0, 0);
        p1 = __builtin_amdgcn_mfma_f32_32x32x16_bf16(kf[2 * kk + 1], qf[kk], p1, 0, 0, 0);
    }
}
__device__ __forceinline__ void qkt(f32x16& p0, f32x16& p1, LAS const unsigned char* ks, const bf16x8 (&qf)[4], int r32, int hi) {
    bf16x8 kf[8]; qkt_load(kf, ks, r32, hi); qkt_mma(p0, p1, kf, qf);
}
typedef float f32x2 __attribute__((ext_vector_type(2)));
#define ATT_PAIR(p, i) ((f32x2){p[2 * (i)], p[2 * (i) + 1]})
__device__ __forceinline__ void partialSM0(f32x16& p0, f32x16& p1, float& m, float& alpha) {
    float pmax = fmaxf(p0[0], p1[0]);
#pragma unroll
    for (int r = 1; r < 16; ++r) pmax = fmaxf(pmax, fmaxf(p0[r], p1[r]));
    { const auto rr = __builtin_amdgcn_permlane32_swap(__float_as_uint(pmax), __float_as_uint(pmax), false, false); pmax = fmaxf(__uint_as_float(rr[0]), __uint_as_float(rr[1])); }
    alpha = 1.f; m = pmax;
#pragma unroll
    for (int r = 0; r < 16; ++r) { p0[r] = __builtin_amdgcn_exp2f(p0[r] - pmax); p1[r] -= pmax; }
}
__device__ __forceinline__ void partialSM(f32x16& p0, f32x16& p1, float& m, float& alpha) {
    { const float nm = -m; p0 += nm; p1 += nm; }
    float x = fmaxf(p0[0], p0[1]), y = fmaxf(p1[0], p1[1]);
#pragma unroll
    for (int r = 2; r < 16; r += 2) { x = fmaxf(x, fmaxf(p0[r], p0[r + 1])); y = fmaxf(y, fmaxf(p1[r], p1[r + 1])); }
    float pmax = fmaxf(x, y);
    { const auto rr = __builtin_amdgcn_permlane32_swap(__float_as_uint(pmax), __float_as_uint(pmax), false, false); pmax = fmaxf(__uint_as_float(rr[0]), __uint_as_float(rr[1])); }
    if (__builtin_expect(__all(pmax <= THR2), 1)) alpha = 1.f;
    else { const float d = fmaxf(pmax, 0.f); alpha = __builtin_amdgcn_exp2f(-d); m += d; const float nd = -d; p0 += nd; p1 += nd; }
#pragma unroll
    for (int r = 0; r < 16; ++r) p0[r] = __builtin_amdgcn_exp2f(p0[r]);
}
__device__ __forceinline__ void finishExp(f32x16& p1) {
#pragma unroll
    for (int r = 0; r < 16; ++r) p1[r] = __builtin_amdgcn_exp2f(p1[r]);
}
__device__ __forceinline__ void finishRest(f32x16& p0, f32x16& p1, float alpha, float& l, bf16x8 (&pf)[4]) {
    f32x2 ps = ATT_PAIR(p0, 0) + ATT_PAIR(p1, 0);
#pragma unroll
    for (int i = 1; i < 8; ++i) { ps += ATT_PAIR(p0, i); ps += ATT_PAIR(p1, i); }
    l = l * alpha + (ps.x + ps.y);
    pf[0] = pack8(p0, 0); pf[1] = pack8(p0, 8); pf[2] = pack8(p1, 0); pf[3] = pack8(p1, 8);
}
__device__ __forceinline__ void finishSM(f32x16& p0, f32x16& p1, float alpha, float& l, bf16x8 (&pf)[4]) { finishExp(p1); finishRest(p0, p1, alpha, l, pf); }
__device__ __forceinline__ void pv(f32x16 (&o)[4], LAS const unsigned char* vs, const bf16x8 (&pf)[4], int r32, int hi) {
    LAS const unsigned char* vb = vs + hi * 2048 + r32 * 16;
    bf16x8 va[2][4];
#pragma unroll
    for (int s = 0; s < 4; ++s) va[0][s] = *(LAS const bf16x8*)(vb + s * 4096);
    __builtin_amdgcn_sched_group_barrier(0x100, 4, 0);
#pragma unroll
    for (int db = 0; db < 4; ++db) {
        if (db < 3) {
#pragma unroll
            for (int s = 0; s < 4; ++s) va[(db + 1) & 1][s] = *(LAS const bf16x8*)(vb + s * 4096 + (db + 1) * 512);
        }
#pragma unroll
        for (int s = 0; s < 4; ++s) o[db] = __builtin_amdgcn_mfma_f32_32x32x16_bf16(va[db & 1][s], pf[s], o[db], 0, 0, 0);
        if (db < 3) __builtin_amdgcn_sched_group_barrier(0x100, 4, 0);
        __builtin_amdgcn_sched_group_barrier(0x8, 4, 0);
    }
}
__device__ __forceinline__ void resc(f32x16 (&o)[4], float alpha) {
    if (__any(alpha < 1.f)) {
#pragma unroll
        for (int db = 0; db < 4; ++db)
#pragma unroll
            for (int r = 0; r < 16; ++r) o[db][r] *= alpha;
    }
}
#define ATT_SGB(mask, n) __builtin_amdgcn_sched_group_barrier(mask, n, 0)
__device__ __forceinline__ void v_load(bf16x8 (&va)[8], LAS const unsigned char* vs, int half, int r32, int hi) {
    LAS const unsigned char* vb = vs + hi * 2048 + r32 * 16 + half * 1024;
#pragma unroll
    for (int h2 = 0; h2 < 2; ++h2)
#pragma unroll
        for (int s = 0; s < 4; ++s) va[h2 * 4 + s] = *(LAS const bf16x8*)(vb + s * 4096 + h2 * 512);
}
__device__ __forceinline__ void firstSM(f32x16& p0, f32x16& p1, f32x16& nm, float& alpha, float& ps0) {
    float pmax = fmaxf(p0[0], p1[0]);
#pragma unroll
    for (int r = 1; r < 16; ++r) pmax = fmaxf(pmax, fmaxf(p0[r], p1[r]));
    { const auto rr = __builtin_amdgcn_permlane32_swap(__float_as_uint(pmax), __float_as_uint(pmax), false, false); pmax = fmaxf(__uint_as_float(rr[0]), __uint_as_float(rr[1])); }
    alpha = 1.f;
    const float nmm = -pmax;
#pragma unroll
    for (int r = 0; r < 16; ++r) nm[r] = nmm;
    float s = 0.f;
#pragma unroll
    for (int r = 0; r < 16; ++r) { p0[r] = __builtin_amdgcn_exp2f(p0[r] + nmm); s += p0[r]; p1[r] += nmm; }
    ps0 = s;
}
__device__ __forceinline__ void blk1(f32x16& q0, f32x16& q1, const f32x16& nm, LAS const unsigned char* ks, const bf16x8 (&qf)[4],
                                     f32x16& f0, f32x16& f1, float alf, float psf, float& l, bf16x8 (&pf)[4], int r32, int hi) {
    bf16x8 kf[8]; qkt_load(kf, ks, r32, hi);
    __builtin_amdgcn_sched_barrier(0);
    float s1 = psf;
#pragma unroll
    for (int r = 0; r < 4; ++r) { f1[r] = __builtin_amdgcn_exp2f(f1[r]); s1 += f1[r]; }
    pf[0] = pack8(f0, 0);
    asm volatile("" : "+v"(s1));
    __builtin_amdgcn_sched_barrier(0);
#pragma unroll
    for (int kk = 0; kk < 4; ++kk) {
        if (kk == 0) { q0 = __builtin_amdgcn_mfma_f32_32x32x16_bf16(kf[0], qf[0], nm, 0, 0, 0); q1 = __builtin_amdgcn_mfma_f32_32x32x16_bf16(kf[1], qf[0], nm, 0, 0, 0); }
        else { q0 = __builtin_amdgcn_mfma_f32_32x32x16_bf16(kf[2 * kk], qf[kk], q0, 0, 0, 0); q1 = __builtin_amdgcn_mfma_f32_32x32x16_bf16(kf[2 * kk + 1], qf[kk], q1, 0, 0, 0); }
#pragma unroll
        for (int r = 4 + 3 * kk; r < 7 + 3 * kk; ++r) { f1[r] = __builtin_amdgcn_exp2f(f1[r]); s1 += f1[r]; }
        if (kk == 0) pf[1] = pack8(f0, 8);
        if (kk == 1) pf[2] = pack8(f1, 0);
        if (kk == 3) { pf[3] = pack8(f1, 8); l = l * alf + s1; asm volatile("" : "+v"(l)); }
        else asm volatile("" : "+v"(s1));
        __builtin_amdgcn_sched_barrier(0);
    }
}
__device__ __forceinline__ float blk2a(f32x16& oa, f32x16& ob, bf16x8 (&vn)[8], LAS const unsigned char* vs, const bf16x8 (&pf)[4], const f32x16& q0, const f32x16& q1, int r32, int hi) {
    bf16x8 va[8]; v_load(va, vs, 0, r32, hi);
    int x = __float_as_int(q0[0]), y = __float_as_int(q1[0]);
#pragma unroll
    for (int r = 1; r < 15; r += 2) { x = max(max(x, __float_as_int(q0[r])), __float_as_int(q0[r + 1])); y = max(max(y, __float_as_int(q1[r])), __float_as_int(q1[r + 1])); }
    x = max(max(x, __float_as_int(q0[15])), max(y, __float_as_int(q1[15])));
    { const auto rr = __builtin_amdgcn_permlane32_swap((unsigned)x, (unsigned)x, false, false); x = max((int)rr[0], (int)rr[1]); }
#pragma unroll
    for (int s = 0; s < 4; ++s) { oa = __builtin_amdgcn_mfma_f32_32x32x16_bf16(va[s], pf[s], oa, 0, 0, 0); ob = __builtin_amdgcn_mfma_f32_32x32x16_bf16(va[4 + s], pf[s], ob, 0, 0, 0); }
    v_load(vn, vs, 1, r32, hi);
    ATT_SGB(0x100, 8); ATT_SGB(0x2, 4);
#pragma unroll
    for (int i = 0; i < 4; ++i) { ATT_SGB(0x8, 1); ATT_SGB(0x2, 2); }
    ATT_SGB(0x100, 8);
#pragma unroll
    for (int i = 0; i < 4; ++i) { ATT_SGB(0x8, 1); ATT_SGB(0x2, 3); }
    return __int_as_float(x);
}
__device__ __forceinline__ float blk2b(f32x16& oc, f32x16& od, const bf16x8 (&vn)[8], const bf16x8 (&pf)[4], f32x16& q0) {
    float s = 0.f;
#pragma unroll
    for (int r = 0; r < 16; ++r) { q0[r] = __builtin_amdgcn_exp2f(q0[r]); s += q0[r]; }
#pragma unroll
    for (int s_ = 0; s_ < 4; ++s_) { oc = __builtin_amdgcn_mfma_f32_32x32x16_bf16(vn[s_], pf[s_], oc, 0, 0, 0); od = __builtin_amdgcn_mfma_f32_32x32x16_bf16(vn[4 + s_], pf[s_], od, 0, 0, 0); }
#pragma unroll
    for (int i = 0; i < 8; ++i) { ATT_SGB(0x8, 1); ATT_SGB(0x402, 4); }
    asm volatile("" : "+v"(s));
    return s;
}
template <int VAR = 0>
__device__ __forceinline__ void unit(LAS unsigned char* lds, int b, int h, int qb, const bf16* QKP, const bf16* UVT, float lam, float lam_init, const float* subg, bf16* MIXB, float* stash, int wave, int lane, int c0 = 0, int c1 = 2) {
    lane = (int)mk_lane_id();
    const int r32 = lane & 31, hi = lane >> 5;
    if (wave >= 4) __builtin_amdgcn_s_setprio(1);
    const size_t tok0 = (size_t)b * S;
    constexpr int NT = S / 64;
#pragma unroll 1
    for (int cc = c0; cc < c1; ++cc) {
        const int c = cc & 1;
        bf16x8 qf[4];
        { const int lane_q = (int)mk_lane_id();
          const bf16* qp = QKP + (tok0 + qb * 256 + wave * 32 + (lane_q & 31)) * 1280 + h * 128 + c * 64 + (lane_q >> 5) * 8;
#pragma unroll
          for (int kk = 0; kk < 4; ++kk) qf[kk] = *(const GAS bf16x8*)(qp + kk * 16); }
        f32x16 o[4];
#pragma unroll
        for (int db = 0; db < 4; ++db)
#pragma unroll
            for (int r = 0; r < 16; ++r) o[db][r] = 0.f;
        float l = 0.f, alA, alB, psA, psB;
        f32x16 pA0, pA1, pB0, pB1, nm; bf16x8 pf[4];
        const char* kub = (const char*)(QKP + tok0 * 1280 + 512 + h * 128 + c * 64 + wave * 8);
        const char* vub = (const char*)(UVT + (size_t)(768 + h * 128) * M + tok0 + wave * 8);
        const unsigned kvo = (unsigned)lane * 2560u; unsigned vvo = (unsigned)lane * (unsigned)(M * 2);
#define ATT_DMA_K(t) __builtin_amdgcn_global_load_lds((const unsigned*)(kub + (size_t)(t) * (64 * 2560) + kvo), (LAS unsigned*)(lds + LDS_K + ((t) & 1) * KSLOT + wave * 1024), 16, 0, 0)
#define ATT_DMA_V(t) do { \
            __builtin_amdgcn_global_load_lds((const unsigned*)(vub + (size_t)(t) * 128 + vvo), (LAS unsigned*)(lds + LDS_V + ((t) & 1) * VSLOT + wave * 2048), 16, 0, 0); \
            __builtin_amdgcn_global_load_lds((const unsigned*)(vub + (size_t)64 * M * 2 + (size_t)(t) * 128 + vvo), (LAS unsigned*)(lds + LDS_V + ((t) & 1) * VSLOT + wave * 2048 + 1024), 16, 0, 0); } while (0)
#define SB() __builtin_amdgcn_sched_barrier(0)
#define ATT_SYNC() do { asm volatile("s_waitcnt vmcnt(0) lgkmcnt(0)" ::: "memory"); __builtin_amdgcn_s_barrier(); asm volatile("" ::: "memory"); } while (0)
#define ATT_DECIDE(pm_, al_, q0_, q1_) do { if (__builtin_expect(__all((pm_) <= THR2), 1)) al_ = 1.f; \
            else { const float d_ = fmaxf(pm_, 0.f); al_ = __builtin_amdgcn_exp2f(-d_); const float nd_ = -d_; nm += nd_; q0_ += nd_; q1_ += nd_; } } while (0)
#define ATT_STEP(q0_, q1_, alq_, psq_, ks_, f0_, f1_, alf_, psf_, vs_, LATE_DMA) do { \
            SB(); blk1(q0_, q1_, nm, ks_, qf, f0_, f1_, alf_, psf_, l, pf, r32, hi); SB(); \
            LATE_DMA; \
            { bf16x8 vn_[8]; const float pm_ = blk2a(o[0], o[1], vn_, vs_, pf, q0_, q1_, r32, hi); SB(); \
              ATT_DECIDE(pm_, alq_, q0_, q1_); SB(); \
              psq_ = blk2b(o[2], o[3], vn_, pf, q0_); SB(); } \
            resc(o, alq_); } while (0)
        const bool early = wave < 4;
        ATT_SYNC();
        ATT_DMA_K(0); ATT_DMA_V(0);
        ATT_SYNC();
        ATT_DMA_K(1);
        qkt(pA0, pA1, lds + LDS_K, qf, r32, hi); firstSM(pA0, pA1, nm, alA, psA);
#pragma unroll 1
        for (int j = 1; j < NT - 1; j += 2) {
            ATT_SYNC(); if (early) { ATT_DMA_K(j + 1); ATT_DMA_V(j); }
            ATT_STEP(pB0, pB1, alB, psB, lds + LDS_K + KSLOT, pA0, pA1, alA, psA, lds + LDS_V, if (!early) { ATT_DMA_K(j + 1); ATT_DMA_V(j); });
            ATT_SYNC(); if (early) { ATT_DMA_K(j + 2); ATT_DMA_V(j + 1); }
            ATT_STEP(pA0, pA1, alA, psA, lds + LDS_K, pB0, pB1, alB, psB, lds + LDS_V + VSLOT, if (!early) { ATT_DMA_K(j + 2); ATT_DMA_V(j + 1); });
        }
        asm volatile("" : "+v"(vvo));
        ATT_SYNC(); ATT_DMA_V(NT - 1);
        ATT_STEP(pB0, pB1, alB, psB, lds + LDS_K + KSLOT, pA0, pA1, alA, psA, lds + LDS_V, (void)0);
        ATT_SYNC();
        { float s1 = psB;
#pragma unroll
          for (int r = 0; r < 16; ++r) { pB1[r] = __builtin_amdgcn_exp2f(pB1[r]); s1 += pB1[r]; }
          l = l * alB + s1;
          pf[0] = pack8(pB0, 0); pf[1] = pack8(pB0, 8); pf[2] = pack8(pB1, 0); pf[3] = pack8(pB1, 8); }
        pv(o, lds + LDS_V + VSLOT, pf, r32, hi);
#undef ATT_DECIDE
#undef ATT_STEP
#undef ATT_DMA_K
#undef ATT_DMA_V
#undef ATT_SYNC
#undef SB
        const float lt = xsum32(l);
        const int lane_e = (int)mk_lane_id();
        const int hi_e = lane_e >> 5; const size_t qtok_e = tok0 + qb * 256 + wave * 32 + (lane_e & 31);
        if (cc >= 2) {
            if (lam == 123456.f) { for (int db = 0; db < 4; ++db) for (int r = 0; r < 16; ++r) stash[(db * 16 + r) * 64 + lane_e] = o[db][r] + lt; }
        } else if (c == 0) {
            const float i1 = 1.f / lt;
#pragma unroll
            for (int db = 0; db < 4; ++db)
#pragma unroll
                for (int g4 = 0; g4 < 4; ++g4) *(GAS f32x4*)(stash + ((db * 4 + g4) * 64 + lane_e) * 4) = (f32x4){o[db][4 * g4] * i1, o[db][4 * g4 + 1] * i1, o[db][4 * g4 + 2] * i1, o[db][4 * g4 + 3] * i1};
        } else {
            const float i2 = lam / lt;
            float ss = 0.f;
#pragma unroll
            for (int db = 0; db < 4; ++db)
#pragma unroll
                for (int g4 = 0; g4 < 4; ++g4) { const f32x4 s1 = *(const GAS f32x4*)(stash + ((db * 4 + g4) * 64 + lane_e) * 4);
#pragma unroll
                    for (int i = 0; i < 4; ++i) { const float v = s1[i] - o[db][4 * g4 + i] * i2; o[db][4 * g4 + i] = v; ss += v * v; } }
            ss = xsum32(ss);
            const float rs = (1.f - lam_init) / sqrtf(ss * (1.f / 128.f) + 1e-5f);
            bf16* orow = MIXB + qtok_e * D + 256 + h * 128;
#pragma unroll
            for (int db = 0; db < 4; ++db)
#pragma unroll
                for (int g4 = 0; g4 < 4; ++g4) { const int e = 32 * db + 8 * g4 + 4 * hi_e; const f32x4 gg = *(const GAS f32x4*)(subg + e);
                    const unsigned long long w = (unsigned long long)pg8::cvt_pk_bf16(o[db][4 * g4] * rs * gg.x, o[db][4 * g4 + 1] * rs * gg.y) | ((unsigned long long)pg8::cvt_pk_bf16(o[db][4 * g4 + 2] * rs * gg.z, o[db][4 * g4 + 3] * rs * gg.w) << 32);
                    *(GAS unsigned long long*)(orow + e) = w; }
        }
    }
    __builtin_amdgcn_s_setprio(0);
}
}
namespace hy {
typedef float f32x16 __attribute__((ext_vector_type(16)));
constexpr int CPY = 16456;
constexpr int VJ = 65, VK8 = VJ * 64;
constexpr int LDS_F = 0, LDS_VV = 4 * CPY, LDS_END = LDS_VV + 8 * VK8;
static_assert(LDS_VV % 16 == 0 && LDS_END <= 131072, "hyena LDS map");

__device__ __forceinline__ void filter_item(LAS unsigned char* lds, int pb, const float* fw1, const float* fb1, const float* fr1, const float* fw2, const float* fb2, const float* fr2,
                                            const float* fw3, bf16* KF, float* PS, int wave, int lane) {
    LAS bf16* tile = (LAS bf16*)lds;
    LAS float* za = (LAS float*)(lds + 65536) + wave * 512;
    LAS float* zb = (LAS float*)(lds + 81920) + wave * 512;
    LAS float* sqs = (LAS float*)(lds + 98304);
    const int p0 = pb * 64 + wave * 8;
    if (lane < 33) {
#pragma unroll 1
        for (int pi = 0; pi < 8; ++pi) { const int p = p0 + pi; float z;
            if (lane == 0) z = (float)p / (float)(S - 1);
            else { const int bi = (lane - 1) & 15; const float band = 1e-4f + (float)bi * ((15.0f - 1e-4f) / 15.0f), wpos = 2.0f * 3.14159265358979323846f * (float)p / (float)S;
                   z = lane <= 16 ? cosf(wpos * band) : -sinf(wpos * band); }
            za[pi * 64 + lane] = z; }
    }
    LDS_WAIT(); asm volatile("" ::: "memory");
    float acc8[8];
    { const float b1 = fb1[lane];
#pragma unroll
      for (int pi = 0; pi < 8; ++pi) acc8[pi] = b1;
#pragma unroll 1
      for (int i = 0; i < 33; ++i) { const float w = fw1[i * 64 + lane];
#pragma unroll
          for (int pi = 0; pi < 8; ++pi) acc8[pi] += za[pi * 64 + i] * w; }
      const float f1 = fr1[lane];
#pragma unroll
      for (int pi = 0; pi < 8; ++pi) zb[pi * 64 + lane] = sinf(f1 * acc8[pi]); }
    LDS_WAIT(); asm volatile("" ::: "memory");
    { const float b2 = fb2[lane];
#pragma unroll
      for (int pi = 0; pi < 8; ++pi) acc8[pi] = b2;
#pragma unroll 1
      for (int i = 0; i < 64; ++i) { const float w = fw2[i * 64 + lane];
#pragma unroll
          for (int pi = 0; pi < 8; ++pi) acc8[pi] += zb[pi * 64 + i] * w; }
      const float f2 = fr2[lane];
      LDS_WAIT(); asm volatile("" ::: "memory");
#pragma unroll
      for (int pi = 0; pi < 8; ++pi) za[pi * 64 + lane] = sinf(f2 * acc8[pi]); }
    LDS_WAIT(); asm volatile("" ::: "memory");
    const float mind = logf(1e-2f) / 1.5f, maxd = logf(1e-2f) / 0.3f;
#pragma unroll 1
    for (int qh = 0; qh < 2; ++qh) {
        float ac[8][4];
#pragma unroll
        for (int pi = 0; pi < 8; ++pi)
#pragma unroll
            for (int q = 0; q < 4; ++q) ac[pi][q] = 0.f;
#pragma unroll 1
        for (int i = 0; i < 64; ++i) { float w[4];
#pragma unroll
            for (int q = 0; q < 4; ++q) w[q] = fw3[i * 512 + lane + 64 * (qh * 4 + q)];
#pragma unroll
            for (int pi = 0; pi < 8; ++pi) { const float hv = za[pi * 64 + i];
#pragma unroll
                for (int q = 0; q < 4; ++q) ac[pi][q] += hv * w[q]; } }
#pragma unroll
        for (int q = 0; q < 4; ++q) { const int col = lane + 64 * (qh * 4 + q), ch = col & 255; const float delta = fabsf(mind + (float)ch * ((maxd - mind) / 255.0f)); float sq = 0.f;
#pragma unroll
            for (int pi = 0; pi < 8; ++pi) { const int p = p0 + pi; const float val = ac[pi][q] * expf(-((float)p / (float)(S - 1)) * delta);
                if (!(col >= 256 && p == 0)) sq += val * val;
                tile[col * 64 + wave * 8 + pi] = (bf16)f2bf(val); }
            sqs[wave * 512 + col] = sq; }
    }
    LDS_WAIT(); __syncthreads();
    { const int p = pb * 64 + lane;
#pragma unroll 1
      for (int cc = 0; cc < 64; ++cc) { const int col = wave * 64 + cc; const bf16 v = tile[col * 64 + lane];
          if (col < 256) KF[(size_t)col * 8192 + 4095 - p] = v; else if (p != 0) KF[(size_t)(col - 256) * 8192 + 4095 + p] = v; } }
    { const int t = wave * 64 + lane; float s = 0.f;
#pragma unroll
      for (int w = 0; w < 8; ++w) s += sqs[w * 512 + t];
      PS[(size_t)pb * 512 + t] = s;
      if (pb == 0 && t < 256) KF[(size_t)t * 8192 + 8191] = 0; }
    LDS_WAIT(); __syncthreads();
}

__device__ __forceinline__ float conv1(float um, float u0, float up, float w0, float w1, float w2, float cb) { return um * w0 + u0 * w1 + up * w2 + cb; }

__device__ __forceinline__ void unit(LAS unsigned char* lds, int c, const bf16* KF, const float* PS, const bf16* UVT, const float* cw, const float* cb, const float* bias_d, bf16* HT, int wave, int lane) {
    lane = (int)mk_lane_id(); asm volatile("" : "+s"(wave));
    const int tid = wave * 64 + lane;
    { const bf16* src = KF + (size_t)c * 8192;
#pragma unroll
      for (int i = 0; i < 2; ++i) { const int ch = tid + 512 * i; *(LAS v4u*)(lds + LDS_F + ch * 16) = *(const GAS v4u*)(src + ch * 8); } }
    { const float w0v = cw[512 + c], w1v = cw[768 + 512 + c], w2v = cw[1536 + 512 + c], cbv = cb[512 + c], w0x = cw[256 + c], w1x = cw[768 + 256 + c], w2x = cw[1536 + 256 + c], cbx = cb[256 + c];
      const bf16* rv = UVT + (size_t)(512 + c) * M; const bf16* rx = UVT + (size_t)(256 + c) * M;
#pragma unroll
      for (int i = 0; i < 4; ++i) { const int q = tid + 512 * i, b = q >> 9, sc = q & 511, s0 = sc * 8; const size_t g0 = (size_t)b * S + s0;
          const v4u av = *(const GAS v4u*)(rv + g0), ax = *(const GAS v4u*)(rx + g0);
          float uv[10], ux[10];
          uv[0] = s0 > 0 ? bf2f(rv[g0 - 1]) : 0.f; ux[0] = s0 > 0 ? bf2f(rx[g0 - 1]) : 0.f; uv[9] = s0 + 8 < S ? bf2f(rv[g0 + 8]) : 0.f; ux[9] = s0 + 8 < S ? bf2f(rx[g0 + 8]) : 0.f;
#pragma unroll
          for (int e = 0; e < 4; ++e) { uv[1 + 2 * e] = bf2f((bf16)av[e]); uv[2 + 2 * e] = bf2f((bf16)(av[e] >> 16)); ux[1 + 2 * e] = bf2f((bf16)ax[e]); ux[2 + 2 * e] = bf2f((bf16)(ax[e] >> 16)); }
          float o[8];
#pragma unroll
          for (int e = 0; e < 8; ++e) o[e] = conv1(uv[e], uv[e + 1], uv[e + 2], w0v, w1v, w2v, cbv) * conv1(ux[e], ux[e + 1], ux[e + 2], w0x, w1x, w2x, cbx);
          v4u w; w.x = pk2(o[0], o[1]); w.y = pk2(o[2], o[3]); w.z = pk2(o[4], o[5]); w.w = pk2(o[6], o[7]);
          *(LAS v4u*)(lds + LDS_VV + (((sc & 7) * VJ + (sc >> 3)) * 4 + b) * 16) = w; }
      if (tid < 32) { unsigned z_; asm volatile("v_mov_b32 %0, 0" : "=v"(z_)); *(LAS v4u*)(lds + LDS_VV + (((tid >> 2) * VJ + 64) * 4 + (tid & 3)) * 16) = (v4u){z_, z_, z_, z_}; } }
    LDS_WAIT(); __syncthreads();
    {
#pragma unroll 1
      for (int i = 0; i < 4; ++i) { const int y = tid + 512 * i;
          const unsigned long long w0 = *(LAS const unsigned long long*)(lds + LDS_F + y * 8), w1 = *(LAS const unsigned long long*)(lds + LDS_F + y * 8 + 8);
#pragma unroll
          for (int p = 1; p < 4; ++p) *(LAS unsigned long long*)(lds + LDS_F + p * CPY + y * 8) = (w0 >> (16 * p)) | (w1 << (64 - 16 * p)); } }
    const float nrm = 1.0f / sqrtf(wave_sum(PS[(size_t)lane * 512 + c] + PS[(size_t)lane * 512 + 256 + c]) + 1e-6f);
    LDS_WAIT(); __syncthreads();
    const int r32 = lane & 31, hi = lane >> 5, gp = wave & 3, half = wave >> 2, iloc = r32 >> 2, b = r32 & 3;
    f32x16 acc[2][2];
#pragma unroll
    for (int rho = 0; rho < 2; ++rho)
#pragma unroll
        for (int gg = 0; gg < 2; ++gg)
#pragma unroll
            for (int r = 0; r < 16; ++r) acc[rho][gg][r] = 0.f;
    const int dlo = 16 * gp - 63 + (half ? 40 : 0), dn = half ? 39 : 40;
    int pa = LDS_F + (3 - (r32 & 3)) * CPY + (4092 - 4 * (r32 >> 2) + 8 * hi) * 2 - 64 - 128 * dlo;
    int jb = 16 * gp + iloc - dlo;
    const int pbase = LDS_VV + hi * VK8 + b * 16;
    typedef unsigned long long u64;
    struct Frag { u64 a[4][4]; v4u b[4][2]; };
#define HY_LOAD(F) do { const int j0_ = jb, j1_ = jb + 8; LAS const unsigned char* ap_ = lds + pa; \
        LAS const unsigned char* bp0_ = lds + pbase + ((unsigned)j0_ < 64u ? j0_ : 64) * 64; LAS const unsigned char* bp1_ = lds + pbase + ((unsigned)j1_ < 64u ? j1_ : 64) * 64; \
        _Pragma("unroll") for (int k = 0; k < 4; ++k) { F.a[k][0] = *(LAS const u64*)(ap_ + 64 + 32 * k); F.a[k][1] = *(LAS const u64*)(ap_ + 64 + 32 * k + 8); F.a[k][2] = *(LAS const u64*)(ap_ + 32 * k); F.a[k][3] = *(LAS const u64*)(ap_ + 32 * k + 8); \
            F.b[k][0] = *(LAS const v4u*)(bp0_ + k * (2 * VK8)); F.b[k][1] = *(LAS const v4u*)(bp1_ + k * (2 * VK8)); } \
        pa -= 128; jb -= 1; } while (0)
#define HY_MMA(F) do { _Pragma("unroll") for (int k = 0; k < 4; ++k) { \
            const bf16x8 fa0 = __builtin_bit_cast(bf16x8, (v4u){(unsigned)F.a[k][0], (unsigned)(F.a[k][0] >> 32), (unsigned)F.a[k][1], (unsigned)(F.a[k][1] >> 32)}); \
            const bf16x8 fa1 = __builtin_bit_cast(bf16x8, (v4u){(unsigned)F.a[k][2], (unsigned)(F.a[k][2] >> 32), (unsigned)F.a[k][3], (unsigned)(F.a[k][3] >> 32)}); \
            const bf16x8 fb0 = __builtin_bit_cast(bf16x8, F.b[k][0]), fb1 = __builtin_bit_cast(bf16x8, F.b[k][1]); \
            acc[0][0] = __builtin_amdgcn_mfma_f32_32x32x16_bf16(fa0, fb0, acc[0][0], 0, 0, 0); acc[0][1] = __builtin_amdgcn_mfma_f32_32x32x16_bf16(fa0, fb1, acc[0][1], 0, 0, 0); \
            acc[1][0] = __builtin_amdgcn_mfma_f32_32x32x16_bf16(fa1, fb0, acc[1][0], 0, 0, 0); acc[1][1] = __builtin_amdgcn_mfma_f32_32x32x16_bf16(fa1, fb1, acc[1][1], 0, 0, 0); } } while (0)
#define HY_MIX() do { _Pragma("unroll") for (int i_ = 0; i_ < 8; ++i_) { __builtin_amdgcn_sched_group_barrier(0x100, 3, 0); __builtin_amdgcn_sched_group_barrier(0x8, 2, 0); } } while (0)
    Frag FA, FB;
    HY_LOAD(FA);
    int dd = 0;
#pragma unroll 1
    for (; dd + 2 <= dn; dd += 2) {
        HY_LOAD(FB); HY_MMA(FA); HY_MIX();
        if (dd + 2 < dn) { HY_LOAD(FA); HY_MMA(FB); HY_MIX(); } else { HY_MMA(FB); }
    }
    if (dd < dn) HY_MMA(FA);
#undef HY_MIX
#undef HY_LOAD
#undef HY_MMA
    const int lane_b = (int)mk_lane_id(), r32_b = lane_b & 31, hi_b = lane_b >> 5, iloc_b = r32_b >> 2, b_b = r32_b & 3;
    LDS_WAIT(); __syncthreads();
    { LAS float* xw = (LAS float*)(lds + LDS_F) + (gp * 2 + (half ? 0 : 1)) * 2048 + lane_b;
#pragma unroll
      for (int gg = 0; gg < 2; ++gg)
#pragma unroll
          for (int r = 0; r < 16; ++r) xw[(gg * 16 + r) * 64] = half ? acc[0][gg][r] : acc[1][gg][r]; }
    LDS_WAIT(); __syncthreads();
    f32x16 fin[2];
    { LAS const float* xr = (LAS const float*)(lds + LDS_F) + (gp * 2 + (half ? 1 : 0)) * 2048 + lane_b;
#pragma unroll
      for (int gg = 0; gg < 2; ++gg)
#pragma unroll
          for (int r = 0; r < 16; ++r) fin[gg][r] = (half ? acc[1][gg][r] : acc[0][gg][r]) + xr[(gg * 16 + r) * 64]; }
    { const float bd = bias_d[c], w0 = cw[c], w1 = cw[768 + c], w2 = cw[1536 + c], cb0 = cb[c]; const bf16* r0p = UVT + (size_t)c * M; bf16* hrow = HT + (size_t)c * M;
#pragma unroll
      for (int gg = 0; gg < 2; ++gg)
#pragma unroll
          for (int g4 = 0; g4 < 4; ++g4) { const int i = 16 * gp + 8 * gg + iloc_b, rr = 32 * half + 8 * g4 + 4 * hi_b, t0 = 64 * i + rr; const size_t tok = (size_t)b_b * S + t0;
              const unsigned long long vw = *(LAS const unsigned long long*)(lds + LDS_VV + (((rr >> 3) * VJ + i) * 4 + b_b) * 16 + (rr & 7) * 2);
              const unsigned long long uw = *(const GAS unsigned long long*)(r0p + tok);
              float u[6]; u[0] = t0 > 0 ? bf2f(r0p[tok - 1]) : 0.f; u[5] = t0 + 4 < S ? bf2f(r0p[tok + 4]) : 0.f;
              u[1] = bf2f((bf16)uw); u[2] = bf2f((bf16)(uw >> 16)); u[3] = bf2f((bf16)(uw >> 32)); u[4] = bf2f((bf16)(uw >> 48));
              float o[4];
#pragma unroll
              for (int e = 0; e < 4; ++e) { const float vv = bf2f((bf16)(vw >> (16 * e))); o[e] = (nrm * fin[gg][4 * g4 + e] + vv * bd) * conv1(u[e], u[e + 1], u[e + 2], w0, w1, w2, cb0); }
              *(GAS unsigned long long*)(hrow + tok) = (unsigned long long)pk2(o[0], o[1]) | ((unsigned long long)pk2(o[2], o[3]) << 32); } }
    LDS_WAIT(); __syncthreads();
}
__device__ __forceinline__ void transpose_slab(LAS unsigned char* lds, int slab, const bf16* HT, bf16* MIXB, int wave, int lane) {
    const int tid = wave * 64 + lane; LAS bf16* tile = (LAS bf16*)lds;
#pragma unroll 1
    for (int i = 0; i < 4; ++i) { const int q = tid + 512 * i, c = q >> 3, tc = q & 7; const v4u w = *(const GAS v4u*)(HT + (size_t)c * M + (size_t)slab * 64 + tc * 8);
#pragma unroll
        for (int e = 0; e < 4; ++e) { tile[(tc * 8 + 2 * e) * 264 + c] = (bf16)w[e]; tile[(tc * 8 + 2 * e + 1) * 264 + c] = (bf16)(w[e] >> 16); } }
    LDS_WAIT(); __syncthreads();
#pragma unroll 1
    for (int i = 0; i < 4; ++i) { const int q = tid + 512 * i, tk = q >> 5, cc = q & 31;
        *(GAS v4u*)(MIXB + ((size_t)slab * 64 + tk) * D + cc * 8) = *(LAS const v4u*)(lds + (tk * 264 + cc * 8) * 2); }
    LDS_WAIT(); __syncthreads();
}
}
#ifndef DUP_PRO
#define DUP_PRO 1
#endif
#ifndef DUP_IN
#define DUP_IN 1
#endif
#ifndef DUP_HY
#define DUP_HY 1
#endif
#ifndef DUP_POOL
#define DUP_POOL 1
#endif
#ifndef DUP_HYT
#define DUP_HYT 1
#endif
#ifndef DUP_ATT
#define DUP_ATT 1
#endif
#ifndef DUP_OUT
#define DUP_OUT 1
#endif
#ifndef DUP_LN1
#define DUP_LN1 1
#endif
#ifndef DUP_MOE1
#define DUP_MOE1 1
#endif
#ifndef DUP_MOE2
#define DUP_MOE2 1
#endif
#ifndef DUP_LN2
#define DUP_LN2 1
#endif
#ifndef EN_HY
#define EN_HY 1
#endif
#ifndef EN_HYT
#define EN_HYT 1
#endif
#ifndef EN_PRO
#define EN_PRO 1
#endif
#ifndef EN_IN
#define EN_IN 1
#endif
#ifndef EN_ATT
#define EN_ATT 1
#endif
#ifndef EN_POOL
#define EN_POOL 1
#endif
#ifndef EN_OUT
#define EN_OUT 1
#endif
#ifndef EN_LN1
#define EN_LN1 1
#endif
#ifndef EN_WCV
#define EN_WCV 1
#endif
#ifndef EN_MOE1
#define EN_MOE1 1
#endif
#ifndef EN_MOE2
#define EN_MOE2 1
#endif
#ifndef EN_LN2
#define EN_LN2 1
#endif
constexpr int RING_BYTES = 135168;
constexpr int LDSCTL_OFF = RING_BYTES, MISC_OFF = LDSCTL_OFF + 320, MOETAB_OFF = LDSCTL_OFF + 1024, ROUTE_OFF = LDSCTL_OFF + 2048;
constexpr int LDS_BYTES = 151552;

struct Args { const float* in[38]; float* out; unsigned char* ws; int* eid; float* wts; int ph_lo, ph_hi, l_lo, l_hi, single, pad; };
enum { PH_PRO = 0, PH_IN = 1, PH_ATT = 2, PH_POOL = 3, PH_OUT = 4, PH_LN1 = 5, PH_WCV = 6, PH_MOE1 = 7, PH_MOE2 = 8, PH_LN2 = 9, PH_HY = 10, PH_HYT = 11, PH_END = 12 };

__global__ void __launch_bounds__(NWAVES * 64, 2) mk_fwd(Args a) {
    extern __shared__ __attribute__((aligned(16))) unsigned char lds_raw[];
    LAS unsigned char* lds = (LAS unsigned char*)lds_raw;
    volatile LAS unsigned* MISC = (volatile LAS unsigned*)(lds + MISC_OFF);
    const int wave_s = __builtin_amdgcn_readfirstlane((int)threadIdx.x >> 6);
    const int G = gridDim.x, bx = blockIdx.x, vcu0 = (G % 8 == 0) ? (bx % 8) * (G / 8) + bx / 8 : bx;
    gu32* ctl0 = (gu32*)(a.ws + WS_CTL);
    for (int u = wave_s * 64 + (int)mk_lane_id(); u < (LDS_BYTES - LDSCTL_OFF) / 4; u += NWAVES * 64) ((LAS unsigned*)(lds + LDSCTL_OFF))[u] = 0u;
    __syncthreads();
    XcdBarrier bar; bar.bar = (unsigned*)(ctl0 + CW_BAR); bar.x = 0; bar.st = nullptr;
#if defined(MK_PER_PHASE)
    if (!a.single)
#endif
    bar = xcd_barrier_post((unsigned*)(ctl0 + CW_BAR), MISC + 8, wave_s);
#if defined(MK_PER_PHASE)
#define IN(k) (a.ph_lo <= (k) && (k) < a.ph_hi)
#define SEAM() do { if (!a.single) xcd_barrier(bar, wave_s); } while (0)
#else
#define IN(k) 1
#if defined(PROBE_BAR2)
#define SEAM() do { xcd_barrier(bar, wave_s); xcd_barrier(bar, wave_s); } while (0)
#else
#define SEAM() xcd_barrier(bar, wave_s)
#endif
#endif
    const int NGW = G * NWAVES;
#define PHASE_PTRS() int lane_ = (int)mk_lane_id(); asm volatile("" : "+v"(lane_)); const int lane = lane_, wave = wave_s; int vcu = vcu0; asm volatile("" : "+s"(vcu)); (void)wave; const int gw = vcu * NWAVES + wave; (void)gw; unsigned char* ws = a.ws; gu32* ctl = (gu32*)(ws + WS_CTL); (void)ctl; \
    bf16* XB = (bf16*)(ws + WS_XB); bf16* QKP = (bf16*)(ws + WS_QKP); bf16* UVT = (bf16*)(ws + WS_UVT); float* CS = (float*)(ws + WS_CS); bf16* MIXB = (bf16*)(ws + WS_MIXB); \
    (void)XB; (void)QKP; (void)UVT; (void)CS; (void)MIXB
#define INP(k) (a.in[k])
#define WCV_SPLIT_IT 3730
#define WCV_SPLIT_PB ((size_t)M * 256 / 16 * 9)
#define WCV_LAYER(LEXPR, GW_, NGW_, IT0_, IT1_, PB0_, PB1_) do { const int wl_ = (LEXPR), wg_ = (GW_), wn_ = (NGW_); const int l = wl_, gw = wg_, NGW = wn_; (void)NGW; const int it0_ = (IT0_), it1_ = (IT1_); const size_t pb0_ = (PB0_), pb1_ = (PB1_); \
            LAS float* scr = (LAS float*)(lds + wave * 16384); \
            unsigned char* wb_ = ws + WS_WBUF + (size_t)(l & 1) * WBUF_STRIDE; bf16* W13 = (bf16*)(wb_ + WB_W13); bf16* W2 = (bf16*)(wb_ + WB_W2); bf16* WG = (bf16*)(wb_ + WB_WG); bf16* WP = (bf16*)(wb_ + WB_WP); \
            for (int it = it0_ + gw; it < it1_; it += NGW) { \
                const float* src; int K, N, k0, n0, mode = 0; bf16* dst; \
                if (it < 4096) { const int which = it >> 11, r = it & 2047, e = r >> 7, kb = (r >> 3) & 15, nb = r & 7; \
                    src = INP(which ? 31 : 30) + ((size_t)l * 16 + e) * D * 256; K = D; N = 256; k0 = kb * 64; n0 = nb * 32; mode = 1 + which; dst = W13 + (size_t)e * 512 * D; \
                } else if (it < 6144) { const int r = it - 4096, e = r >> 7, kb = (r >> 5) & 3, nb = r & 31; \
                    src = INP(32) + ((size_t)l * 16 + e) * 256 * D; K = 256; N = D; k0 = kb * 64; n0 = nb * 32; dst = W2 + (size_t)e * D * 256 + (size_t)n0 * 256; \
                } else if (it < 6656) { const int r = it - 6144, kb = r >> 5, nb = r & 31; \
                    src = INP(33) + (size_t)l * D * D; K = D; N = D; k0 = kb * 64; n0 = nb * 32; dst = WG + (size_t)n0 * D; \
                } else { const int r = it - 6656, kb = r >> 5, nb = r & 31; \
                    src = INP(35) + (size_t)l * 256 * D; K = 256; N = D; k0 = kb * 64; n0 = nb * 32; dst = WP + (size_t)n0 * 256; } \
                p0_transpose_block(src, K, N, k0, n0, dst, mode, scr, lane); \
            } \
            const int ln = lane; \
            const float* ps = INP(1) + (size_t)l * M * 256; bf16* PB = (bf16*)(wb_ + WB_PB); \
            for (size_t i = pb0_ + ((size_t)gw * 64 + ln) * 8; i < pb1_; i += (size_t)NGW * 64 * 8) { const f32x4 x0 = *(const GAS f32x4*)(ps + i), x1 = *(const GAS f32x4*)(ps + i + 4); \
                v4u o; o.x = pk2(x0.x, x0.y); o.y = pk2(x0.z, x0.w); o.z = pk2(x1.x, x1.y); o.w = pk2(x1.z, x1.w); *(GAS v4u*)(PB + i) = o; } \
    } while (0)

    if (EN_PRO && IN(PH_PRO)) {
            PHASE_PTRS();
            for (int rep_ = 0; rep_ < DUP_PRO; ++rep_) {
        LAS float* scr = (LAS float*)(lds + wave * 16384);
        for (int it = gw; it < DEPTH * (16 * 72 + 16 * 32); it += NGW) {
            const int l = it / 1664, r = it % 1664; const float* src; int N, k0, n0; bf16* dst;
            if (r < 1152) { const int kb = r / 72, nb = r % 72; n0 = nb * 32; k0 = kb * 64; N = INW; src = INP(4) + (size_t)l * D * INW;
                bf16* wsw = (bf16*)(ws + WS_WIN + (size_t)l * WIN_LAYER); bf16* wnm = wsw + 1280 * 1024;
                dst = n0 < 768 ? wsw + (size_t)n0 * D : (n0 < 1792 ? wnm + (size_t)(n0 - 768) * D : wsw + (size_t)(768 + n0 - 1792) * D); }
            else { const int q = r - 1152, kb = q >> 5, nb = q & 31; n0 = nb * 32; k0 = kb * 64; N = D; src = INP(23) + (size_t)l * D * D; dst = (bf16*)(ws + WS_WOUT + (size_t)l * WOUT_LAYER) + (size_t)n0 * D; }
            p0_transpose_block(src, D, N, k0, n0, dst, 0, scr, lane);
            }
        }
        for (int it = gw; it < DEPTH * 4 * 16 * 2; it += NGW) {
            const int l = it >> 7, g = (it >> 5) & 3, dh = (it >> 4) & 1, k = (it & 15) * 64 + lane;
            const float* wrow = INP(4) + (size_t)l * D * INW + (size_t)k * INW + 2304 + g * 64;
            const float* pw = INP(20) + (size_t)(l * 4 + g) * 64 * 64 + dh * 32;
            float acc[32];
#pragma unroll
            for (int d = 0; d < 32; ++d) acc[d] = 0.f;
#pragma unroll 1
            for (int c = 0; c < 64; ++c) { const float x = wrow[c];
#pragma unroll
                for (int d = 0; d < 32; ++d) acc[d] += x * pw[c * 64 + d]; }
            bf16* dst = (bf16*)(ws + WS_WIN + (size_t)l * WIN_LAYER) + (size_t)(1280 + 1024 + g * 64 + dh * 32) * D + k;
#pragma unroll
            for (int d = 0; d < 32; ++d) dst[(size_t)d * D] = (bf16)f2bf(acc[d]);
        }
        for (int i = gw * 64 + lane; i < DEPTH * 32 * D; i += NGW * 64) { const int l2 = i / (32 * D), r = i % (32 * D), col = r / D, k = r % D;
            const float w = col < 4 ? INP(26)[((size_t)l2 * D + k) * 4 + col] : (col < 20 ? INP(28)[((size_t)l2 * D + k) * 16 + col - 4] : 0.f);
            const unsigned hb = f2bf(w); const float lo = w - __uint_as_float(hb << 16);
            bf16* dst = (bf16*)(ws + WS_WR) + (size_t)l2 * 64 * D; dst[(size_t)col * D + k] = (bf16)hb; dst[(size_t)(32 + col) * D + k] = (bf16)f2bf(lo); }
        int ln2 = lane; asm volatile("" : "+v"(ln2));
        for (int i = gw * 64 + ln2; i < S * 8; i += NGW * 64) { const int pos = i >> 3, j = i & 7; const float ang = (float)pos * powf(500000.0f, -(float)(2 * j) / 16.0f);
            CS[pos * 16 + j] = cosf(ang); CS[pos * 16 + 8 + j] = sinf(ang); }
        for (int m = 4 * gw; m < M; m += 4 * NGW) ln0_row4(INP(0) + (size_t)m * D, INP(2), INP(3), XB + (size_t)m * D, lane);
        WCV_LAYER(0, gw, NGW, 0, 6784, (size_t)0, (size_t)M * 256);
        LDS_WAIT(); __syncthreads();
        for (int it = vcu; it < DEPTH * 64; it += G) { const int fl = it >> 6, pb = it & 63;
            hy::filter_item(lds, pb, INP(7) + fl * 33 * 64, INP(8) + fl * 64, INP(9) + fl * 64, INP(10) + fl * 64 * 64, INP(11) + fl * 64, INP(12) + fl * 64, INP(13) + fl * 64 * 512,
                            (bf16*)(ws + WS_KF) + (size_t)fl * 256 * 8192, (float*)(ws + WS_PS) + (size_t)fl * 64 * 512, wave, lane); }
        SEAM();
    }
#if defined(MK_PER_PHASE)
    for (int l = a.l_lo; l < a.l_hi; ++l) {
#else
#pragma unroll 1
    for (int l = 0; l < DEPTH; ++l) {
#endif
        if (EN_IN && IN(PH_IN)) {
            PHASE_PTRS();
            for (int rep_ = 0; rep_ < DUP_IN; ++rep_) {
            const char* wsw = (const char*)(ws + WS_WIN + (size_t)l * WIN_LAYER);
            SchedIn Sc{vcu, G, (const char*)XB, wsw, wsw + (size_t)1280 * 1024 * 2};
            EpiIn E{QKP, UVT, CS};
            pg8::gemm_phase<EpiIn, SchedIn>(lds, D, Sc, E, wave);
            { SchedSq Sc2{vcu, G / 2, (const char*)(ws + WS_WBUF + (size_t)(l & 1) * WBUF_STRIDE + WB_PB), (const char*)(ws + WS_WBUF + (size_t)(l & 1) * WBUF_STRIDE + WB_WP), (size_t)256 * 256 * 2, (size_t)256 * 256 * 2, G / 2};
              EpiPle<0> E2{(bf16*)(ws + WS_YP), nullptr};
              pg8::gemm_phase<EpiPle<0>, SchedSq>(lds, 256, Sc2, E2, wave); }
            }
            SEAM();
        }
        if (EN_HY && IN(PH_HY)) {
            PHASE_PTRS();
            for (int rep_ = 0; rep_ < DUP_HY; ++rep_) {
            for (int c = vcu; c < 256; c += G)
                hy::unit(lds, c, (const bf16*)(ws + WS_KF) + (size_t)l * 256 * 8192, (const float*)(ws + WS_PS) + (size_t)l * 64 * 512, UVT, INP(5) + l * 3 * 768, INP(6) + l * 768, INP(14) + l * 256, (bf16*)(ws + WS_HT), wave, lane);
            }
        }
        if (EN_POOL && IN(PH_POOL)) {
            PHASE_PTRS();
            for (int rep_ = 0; rep_ < DUP_POOL; ++rep_) {
            int ln = lane; asm volatile("" : "+v"(ln));
            const int cc = (ln & 31) * 8, gq = cc >> 6, hw = 1 << gq;
            const float* pb = INP(21) + l * 256 + cc; const float* psc = INP(22) + l * 256 + cc;
            for (int it = gw; it < M / 2; it += NGW) {
                const int tok = it * 2 + (ln >> 5), pos = tok & (S - 1);
                int lo = pos - hw, hi2 = pos + hw - 1; lo = lo < 0 ? 0 : lo; hi2 = hi2 > S - 1 ? S - 1 : hi2;
                float sacc[8];
#pragma unroll
                for (int e = 0; e < 8; ++e) sacc[e] = 0.f;
                const bf16* zp = QKP + (size_t)(tok - pos) * 1280 + 1024 + cc;
                for (int r = lo; r <= hi2; ++r) { const v4u w = *(const GAS v4u*)(zp + (size_t)r * 1280);
                    sacc[0] += bf2f((bf16)w.x); sacc[1] += bf2f((bf16)(w.x >> 16)); sacc[2] += bf2f((bf16)w.y); sacc[3] += bf2f((bf16)(w.y >> 16));
                    sacc[4] += bf2f((bf16)w.z); sacc[5] += bf2f((bf16)(w.z >> 16)); sacc[6] += bf2f((bf16)w.w); sacc[7] += bf2f((bf16)(w.w >> 16)); }
                const float inv = 1.f / (float)(hi2 - lo + 1);
                const v4u w = *(const GAS v4u*)(zp + (size_t)pos * 1280);
                float z[8] = {bf2f((bf16)w.x), bf2f((bf16)(w.x >> 16)), bf2f((bf16)w.y), bf2f((bf16)(w.y >> 16)), bf2f((bf16)w.z), bf2f((bf16)(w.z >> 16)), bf2f((bf16)w.w), bf2f((bf16)(w.w >> 16))};
                float y[8];
#pragma unroll
                for (int e = 0; e < 8; ++e) y[e] = (sacc[e] * inv - z[e] + pb[e]) * psc[e];
                v4u o; o.x = pk2(y[0], y[1]); o.y = pk2(y[2], y[3]); o.z = pk2(y[4], y[5]); o.w = pk2(y[6], y[7]);
                *(GAS v4u*)(MIXB + (size_t)tok * D + 768 + cc) = o;
            }
            }
            SEAM();
        }
        if (EN_HYT && IN(PH_HYT)) {
            PHASE_PTRS();
            for (int rep_ = 0; rep_ < DUP_HYT; ++rep_) {
            for (int s = vcu; s < 256; s += G) hy::transpose_slab(lds, s, (const bf16*)(ws + WS_HT), MIXB, wave, lane);
            }
        }
        if (EN_ATT && IN(PH_ATT)) {
            PHASE_PTRS();
            for (int rep_ = 0; rep_ < DUP_ATT; ++rep_) {
            const float lam_init = 0.8f - 0.6f * expf(-0.3f * (float)l);
            int ln = lane; asm volatile("" : "+v"(ln));
            const float lam = expf(wave_sum(INP(15)[l * 64 + ln] * INP(16)[l * 64 + ln])) - expf(wave_sum(INP(17)[l * 64 + ln] * INP(18)[l * 64 + ln])) + lam_init;
            for (int u = vcu; u < 256; u += G) { att::unit(lds, (u >> 4) >> 2, (u >> 4) & 3, u & 15, QKP, UVT, lam, lam_init, INP(19) + l * 128, MIXB, (float*)(ws + WS_STASH) + ((size_t)u * 8 + wave) * 4096, wave, lane);
#ifdef ATT_PROBE_VAR
                att::unit<ATT_PROBE_VAR>(lds, (u >> 4) >> 2, (u >> 4) & 3, u & 15, QKP, UVT, lam, lam_init, INP(19) + l * 128, MIXB, (float*)(ws + WS_STASH) + ((size_t)u * 8 + wave) * 4096, wave, lane, 2, 3);
#endif
            }
            }
            SEAM();
        }
        if (EN_OUT && IN(PH_OUT)) {
            PHASE_PTRS();
            for (int rep_ = 0; rep_ < DUP_OUT; ++rep_) {
            SchedOut Sc{vcu, G, (const char*)MIXB, (const char*)(ws + WS_WOUT + (size_t)l * WOUT_LAYER)};
#if defined(PROBE_OUT)
            { EpiRes E0{(bf16*)(ws + WS_STASH)}; pg8::gemm_phase<EpiRes, SchedOut>(lds, D, Sc, E0, wave); }
#endif
            EpiRes E{XB};
            pg8::gemm_phase<EpiRes, SchedOut>(lds, D, Sc, E, wave);
            }
            SEAM();
        }
        if (EN_LN1 && IN(PH_LN1)) {
            PHASE_PTRS();
            for (int rep_ = 0; rep_ < DUP_LN1; ++rep_) {
            int ln = lane; asm volatile("" : "+v"(ln));
#if defined(PROBE_LN1)
            for (int ch = vcu; ch < M / 64; ch += G)
                ln1_router_chunk<PROBE_LN1>((LAS RouteLds*)(lds + ROUTE_OFF), lds, ch * 64, XB, (bf16*)(ws + WS_STASH), INP(24) + l * D, INP(25) + l * D, (const bf16*)(ws + WS_WR) + (size_t)l * 64 * D, INP(27) + l * 4, INP(29) + l * 16,
                                 ctl + CW_CNT + l * 16 * CNT_STRIDE, (int*)(ws + WS_TOKIDX), (float*)(ws + WS_GATE), wave, lane);
#endif
            for (int ch = vcu; ch < M / 64; ch += G)
                ln1_router_chunk((LAS RouteLds*)(lds + ROUTE_OFF), lds, ch * 64, XB, XB, INP(24) + l * D, INP(25) + l * D, (const bf16*)(ws + WS_WR) + (size_t)l * 64 * D, INP(27) + l * 4, INP(29) + l * 16,
                                 ctl + CW_CNT + l * 16 * CNT_STRIDE, (int*)(ws + WS_TOKIDX), (float*)(ws + WS_GATE), wave, lane);
            }
            SEAM();
        }
        if (EN_MOE1 && IN(PH_MOE1)) {
            PHASE_PTRS();
            for (int rep_ = 0; rep_ < DUP_MOE1; ++rep_) {
            moe_tab_build((LAS int*)(lds + MOETAB_OFF), ctl + CW_CNT + l * 16 * CNT_STRIDE, wave == 0 && lane == 0); const MoeTab T{(LAS const int*)(lds + MOETAB_OFF)};
            { SchedMoe<2> Sc{vcu, G, T, (const char*)XB, (const char*)(ws + WS_WBUF + (size_t)(l & 1) * WBUF_STRIDE + WB_W13), (size_t)512 * D * 2, (const int*)(ws + WS_TOKIDX), 0};
              EpiMoe1 E{(bf16*)(ws + WS_ACT), (const float*)(ws + WS_GATE), T};
              pg8::gemm_phase<EpiMoe1, SchedMoe<2>, true>(lds, D, Sc, E, wave);
#if defined(PROBE_MOE1A)
              pg8::gemm_phase<EpiMoe1, SchedMoe<2>, true>(lds, D, Sc, E, wave);
#endif
            }
            { SchedSq Sc{vcu, G, (const char*)XB, (const char*)(ws + WS_WBUF + (size_t)(l & 1) * WBUF_STRIDE + WB_WG), TILEB, TILEB, 0};
              EpiPle<1> E{(bf16*)(ws + WS_YP), INP(34) + l * D};
              pg8::gemm_phase<EpiPle<1>, SchedSq>(lds, D, Sc, E, wave); }
            if (l + 1 < DEPTH) {
                int x2 = 2 * T.pre(16) - G; x2 = x2 < 0 ? 0 : (x2 > G / 2 ? G / 2 : x2);
                if (vcu >= x2) WCV_LAYER(l + 1, (vcu - x2) * NWAVES + wave, (G - x2) * NWAVES, 0, WCV_SPLIT_IT, (size_t)0, WCV_SPLIT_PB);
            }
            }
            SEAM();
        }
        if (EN_MOE2 && IN(PH_MOE2)) {
            PHASE_PTRS();
            for (int rep_ = 0; rep_ < DUP_MOE2; ++rep_) {
            moe_tab_build((LAS int*)(lds + MOETAB_OFF), ctl + CW_CNT + l * 16 * CNT_STRIDE, wave == 0 && lane == 0); const MoeTab T{(LAS const int*)(lds + MOETAB_OFF)};
            SchedMoe<4> Sc{vcu, G, T, (const char*)(ws + WS_ACT), (const char*)(ws + WS_WBUF + (size_t)(l & 1) * WBUF_STRIDE + WB_W2), (size_t)D * 256 * 2, (const int*)(ws + WS_TOKIDX), (size_t)256 * 256 * 2};
            EpiMoe2 E{(bf16*)(ws + WS_YMOE), (const int*)(ws + WS_TOKIDX), T};
            pg8::gemm_phase<EpiMoe2, SchedMoe<4>>(lds, 256, Sc, E, wave);
            if (l + 1 < DEPTH) {
                int x3 = 4 * T.pre(16) - 2 * G; x3 = x3 < 0 ? 0 : (x3 > G / 2 ? G / 2 : x3);
                if (vcu >= x3) WCV_LAYER(l + 1, (vcu - x3) * NWAVES + wave, (G - x3) * NWAVES, WCV_SPLIT_IT, 6784, WCV_SPLIT_PB, (size_t)M * 256);
            }
            }
            SEAM();
        }
        if (EN_LN2 && IN(PH_LN2)) {
            PHASE_PTRS();
            for (int rep_ = 0; rep_ < DUP_LN2; ++rep_) {
            int ln = lane; asm volatile("" : "+v"(ln));
            const bf16* YM = (const bf16*)(ws + WS_YMOE); const bf16* YP = (const bf16*)(ws + WS_YP);
            const bool lastl = (l == DEPTH - 1);
#if defined(PROBE_LN2)
            for (int m = gw; m < M; m += NGW)
                ln_row(XB + (size_t)m * D, DN_ALPHA, YM + (size_t)(2 * m) * D, YM + (size_t)(2 * m + 1) * D, YP + (size_t)m * D, INP(36) + l * D, INP(37) + l * D, (float*)nullptr, (bf16*)(ws + WS_STASH) + (size_t)m * D, ln);
#endif
            for (int m = 4 * gw; m < M; m += 4 * NGW)
                ln2_row4(XB + (size_t)m * D, DN_ALPHA, YM + (size_t)(2 * m) * D, YP + (size_t)m * D, INP(36) + l * D, INP(37) + l * D,
                         lastl ? a.out + (size_t)m * D : (float*)nullptr, lastl ? (bf16*)nullptr : XB + (size_t)m * D, ln);
            }
            if (l != DEPTH - 1) SEAM();
        }
    }
#undef IN
#undef SEAM
}
static void mk_launch(const Args& base, int ph, int l, int grid, hipStream_t stream) {
    Args a = base; a.ph_lo = ph; a.ph_hi = ph + 1; a.l_lo = l; a.l_hi = l + 1; a.single = 1;
    hipLaunchKernelGGL(mk_fwd, dim3(grid), dim3(NWAVES * 64), LDS_BYTES, stream, a);
}
extern "C" void kernel_launch(void* const* d_in, const int* in_sizes, int n_in, void* d_out, int out_size, void* d_ws, size_t ws_size, hipStream_t stream) {
    (void)in_sizes; (void)n_in; (void)out_size; (void)ws_size;
    static int grid = 0;
    if (grid == 0) {
        int dev = 0, cus = 0;
        if (hipGetDevice(&dev) != hipSuccess || hipDeviceGetAttribute(&cus, hipDeviceAttributeMultiprocessorCount, dev) != hipSuccess) { grid = -1; return; }
        if (hipFuncSetAttribute((const void*)mk_fwd, hipFuncAttributeMaxDynamicSharedMemorySize, LDS_BYTES) != hipSuccess) { grid = -1; return; }
        (void)hipGetLastError();
        grid = cus;
    }
    if (grid < 0) return;
    (void)hipMemsetAsync((char*)d_ws + WS_CTL, 0, CTL_ZERO_BYTES, stream);
    Args base{};
    for (int i = 0; i < 38; ++i) base.in[i] = (const float*)d_in[i];
    base.out = (float*)d_out; base.ws = (unsigned char*)d_ws;
    base.eid = nullptr; base.wts = nullptr;
#if defined(MK_PER_PHASE)
    mk_launch(base, PH_PRO, 0, grid, stream);
    for (int l = 0; l < DEPTH; ++l) for (int ph : {PH_IN, PH_HY, PH_HYT, PH_ATT, PH_POOL, PH_OUT, PH_LN1, PH_WCV, PH_MOE1, PH_MOE2, PH_LN2}) mk_launch(base, ph, l, grid, stream);
#else
    Args a = base; a.ph_lo = 0; a.ph_hi = PH_END; a.l_lo = 0; a.l_hi = DEPTH; a.single = 0;
    hipLaunchKernelGGL(mk_fwd, dim3(grid), dim3(NWAVES * 64), LDS_BYTES, stream, a);
#endif
}
```

```cpp
#include <hip/hip_runtime.h>
#include <stdint.h>
#include <math.h>
namespace pg8 {
#define PG8_LAS __attribute__((address_space(3)))
typedef unsigned short bf16_t;
typedef short bf16x8 __attribute__((ext_vector_type(8)));
typedef float f32x4 __attribute__((ext_vector_type(4)));
typedef unsigned u32x4 __attribute__((ext_vector_type(4)));
constexpr int BM = 256, BK = 64, HALF = 128, HTB = HALF * BK * 2  , STAGE_BYTES = 8 * HTB;

__host__ __device__ __forceinline__ int lds_byte(int r, int c) { const int st = (r >> 4) * 2 + (c >> 5), rr = r & 15, cc = c & 31, ob = rr * 64 + cc * 2; return st * 1024 + (ob ^ (((ob >> 9) & 1) << 5)); }
__host__ __device__ __forceinline__ void stage_rc(int b, int& R, int& C) { const int st = b / 1024, sb = b % 1024, swz = sb ^ (((sb >> 9) & 1) << 5); R = (st >> 1) * 16 + swz / 64; C = (st & 1) * 32 + (swz % 64) / 2; }
__host__ __device__ __forceinline__ int perm32(int rho) { const int n = rho >> 4, i = rho & 15; return 8 * (i >> 2) + 4 * n + (i & 3); }

struct Unit { const char* A; const char* B; int kind, pm, pn, aux; };

__device__ __forceinline__ unsigned cvt_pk_bf16(float lo, float hi) { unsigned r; asm volatile("v_cvt_pk_bf16_f32 %0, %1, %2" : "=v"(r) : "v"(lo), "v"(hi)); return r; }

template <class Epi, class Sched, bool GATHER = false>
__device__ __forceinline__ void gemm_phase(PG8_LAS unsigned char* lds, const int K_, const Sched& S, const Epi& E, const int wave_) {
    int K = K_; asm volatile("" : "+s"(K));
    int tid_; asm volatile("v_mbcnt_lo_u32_b32 %0, -1, 0\n\tv_mbcnt_hi_u32_b32 %0, -1, %0" : "=v"(tid_)); tid_ += wave_ * 64;
    const int tid = tid_, wid = __builtin_amdgcn_readfirstlane(tid >> 6), lane = tid & 63, wr = wid >> 2, wc = wid & 3, fr = lane & 15, fq = lane >> 4;
    const int nt = K / BK;
    unsigned voffA[2][2], voffN[2][2] = {{0u, 0u}, {0u, 0u}}, voffB[2]; int RA[2], CA[2];
#pragma unroll
    for (int i = 0; i < 2; ++i) { int R, C; stage_rc(tid * 16 + i * 8192, R, C); const int Rb = Epi::PERM ? ((R & ~31) + perm32(R & 31)) : R; RA[i] = R; CA[i] = C;
        voffA[0][i] = (unsigned)(R * K + C) * 2u; voffA[1][i] = (unsigned)((R + HALF) * K + C) * 2u; voffB[i] = (unsigned)(Rb * K + C) * 2u; }
    const size_t kstep = (size_t)(BK * 2);
    const size_t hstep = (size_t)HALF * K * 2;
    const unsigned ldsw = (unsigned)wid * 1024u;
    const int aoff = lds_byte(wr * 64 + fr, fq * 8), boff = lds_byte(wc * 32 + fr, fq * 8);
#define PG8_SA(b, h) (((b) * 2 + (h)) * HTB)
#define PG8_SB(b, h) ((4 + (b) * 2 + (h)) * HTB)
#define PG8_STAGE(bufoff, gbase, voff) do { _Pragma("unroll") for (int _i = 0; _i < 2; ++_i) \
        __builtin_amdgcn_global_load_lds((const unsigned*)((const char*)(gbase) + (voff)[_i]), (PG8_LAS unsigned*)(lds + (bufoff) + ldsw + _i * 8192), 16, 0, 0); } while (0)
#define PG8_LDA(dst, b, h) do { _Pragma("unroll") for (int m = 0; m < 4; ++m) _Pragma("unroll") for (int k = 0; k < 2; ++k) dst[m][k] = *(const PG8_LAS bf16x8*)(lds + PG8_SA(b, h) + aoff + m * 2048 + k * 1024); } while (0)
#define PG8_LDB(dst, b, h) do { _Pragma("unroll") for (int n = 0; n < 2; ++n) _Pragma("unroll") for (int k = 0; k < 2; ++k) dst[n][k] = *(const PG8_LAS bf16x8*)(lds + PG8_SB(b, h) + boff + n * 2048 + k * 1024); } while (0)
#define PG8_MMA(ai, bj, At, Bt) do { __builtin_amdgcn_s_setprio(1); _Pragma("unroll") for (int m = 0; m < 4; ++m) _Pragma("unroll") for (int n = 0; n < 2; ++n) _Pragma("unroll") for (int k = 0; k < 2; ++k) \
        acc[ai][bj][m][n] = __builtin_amdgcn_mfma_f32_16x16x32_bf16(Bt[n][k], At[m][k], acc[ai][bj][m][n], 0, 0, 0); __builtin_amdgcn_s_setprio(0); } while (0)
#define PG8_WAIT_V(n) asm volatile("s_waitcnt vmcnt(" #n ")" ::: "memory")
#define PG8_WAIT_L(n) asm volatile("s_waitcnt lgkmcnt(" #n ")" ::: "memory")
#define PG8_BAR __builtin_amdgcn_s_barrier()
#define PG8_SCHED __builtin_amdgcn_sched_barrier(0)
    Unit cur, nxt; int ui = 0;
    if (!S.next(0, cur)) return;
    if constexpr (GATHER) {
#pragma unroll
        for (int h = 0; h < 2; ++h)
#pragma unroll
            for (int i = 0; i < 2; ++i) voffA[h][i] = (unsigned)(S.arow(cur, h * HALF + RA[i]) * K + CA[i]) * 2u;
    }
    f32x4 acc[2][2][4][2];
#pragma unroll
    for (int a = 0; a < 2; ++a)
#pragma unroll
        for (int b = 0; b < 2; ++b)
#pragma unroll
            for (int m = 0; m < 4; ++m)
#pragma unroll
                for (int n = 0; n < 2; ++n) acc[a][b][m][n] = (f32x4){0.f, 0.f, 0.f, 0.f};
    bf16x8 At[4][2], B0[2][2], B1[2][2];
    const char* cA = cur.A; const char* cB = cur.B;
    PG8_STAGE(PG8_SB(0, 0), cB, voffB); PG8_STAGE(PG8_SB(0, 1), cB + hstep, voffB); PG8_STAGE(PG8_SA(0, 0), cA, voffA[0]); PG8_STAGE(PG8_SA(0, 1), cA, voffA[1]);
    if (wr == 1) PG8_BAR;
    PG8_WAIT_V(2); PG8_BAR;
    PG8_STAGE(PG8_SB(1, 0), cB + kstep, voffB); PG8_STAGE(PG8_SA(1, 0), cA + kstep, voffA[0]); PG8_STAGE(PG8_SB(1, 1), cB + hstep + kstep, voffB);
    PG8_WAIT_V(6); PG8_BAR;
    for (;;) {
        const bool has_next = S.next(ui + 1, nxt);
        const char* nA = has_next ? nxt.A : cA; const char* nB = has_next ? nxt.B : cB;
        if constexpr (GATHER) {
#pragma unroll
            for (int h = 0; h < 2; ++h)
#pragma unroll
                for (int i = 0; i < 2; ++i) voffN[h][i] = has_next ? (unsigned)(S.arow(nxt, h * HALF + RA[i]) * K + CA[i]) * 2u : voffA[h][i];
        }
#pragma unroll 1
        for (int t = 0; t < nt; t += 2) {
            const bool last = (t == nt - 2);
            const char* a1 = cA + (size_t)(t + 1) * kstep;
            const char* a2 = last ? nA : cA + (size_t)(t + 2) * kstep; const char* b2 = last ? nB : cB + (size_t)(t + 2) * kstep;
            const char* a3 = a2 + kstep; const char* b3 = b2 + kstep;
            PG8_LDB(B0, 0, 0); PG8_LDB(B1, 0, 1); PG8_SCHED; PG8_LDA(At, 0, 0); PG8_STAGE(PG8_SA(1, 1), a1, voffA[1]);
            if constexpr (GATHER) { if (last) {
#pragma unroll
                for (int h = 0; h < 2; ++h)
#pragma unroll
                    for (int i = 0; i < 2; ++i) voffA[h][i] = voffN[h][i]; } }
            PG8_WAIT_V(8); PG8_WAIT_L(0); PG8_BAR; PG8_MMA(0, 0, At, B0); PG8_MMA(0, 1, At, B1); PG8_BAR; PG8_SCHED;
            PG8_LDA(At, 0, 1); PG8_STAGE(PG8_SB(0, 0), b2, voffB); PG8_STAGE(PG8_SB(0, 1), b2 + hstep, voffB); PG8_STAGE(PG8_SA(0, 0), a2, voffA[0]);
            PG8_WAIT_V(8); PG8_WAIT_L(0); PG8_BAR; PG8_MMA(1, 0, At, B0); PG8_MMA(1, 1, At, B1); PG8_BAR; PG8_SCHED;
            PG8_LDB(B0, 1, 0); PG8_LDB(B1, 1, 1); PG8_SCHED; PG8_LDA(At, 1, 0); PG8_STAGE(PG8_SA(0, 1), a2, voffA[1]);
            PG8_WAIT_V(8); PG8_WAIT_L(0); PG8_BAR; PG8_MMA(0, 0, At, B0); PG8_MMA(0, 1, At, B1); PG8_BAR; PG8_SCHED;
            PG8_LDA(At, 1, 1); PG8_STAGE(PG8_SB(1, 0), b3, voffB); PG8_STAGE(PG8_SB(1, 1), b3 + hstep, voffB); PG8_STAGE(PG8_SA(1, 0), a3, voffA[0]);
            PG8_WAIT_V(8); PG8_WAIT_L(0); PG8_BAR; PG8_MMA(1, 0, At, B0); PG8_MMA(1, 1, At, B1); PG8_BAR; PG8_SCHED;
        }
        if (wr == 0) PG8_BAR;
        { Unit ce = cur; ce.pm = __builtin_amdgcn_readfirstlane(cur.pm); ce.pn = __builtin_amdgcn_readfirstlane(cur.pn); ce.kind = __builtin_amdgcn_readfirstlane(cur.kind); ce.aux = __builtin_amdgcn_readfirstlane(cur.aux); int fr_ = fr, fq_ = fq;
          asm volatile("" : "+s"(ce.pm), "+s"(ce.pn), "+s"(ce.kind), "+s"(ce.aux), "+v"(fr_), "+v"(fq_));
          if constexpr (Epi::FUSED) E.fused(acc, ce, wr, wc, fr_, fq_, lds, wave_);
          else E(acc, ce, wr, wc, fr_, fq_); }
        if (!has_next) break;
#pragma unroll
        for (int a = 0; a < 2; ++a)
#pragma unroll
            for (int b = 0; b < 2; ++b)
#pragma unroll
                for (int m = 0; m < 4; ++m)
#pragma unroll
                    for (int n = 0; n < 2; ++n) acc[a][b][m][n] = (f32x4){0.f, 0.f, 0.f, 0.f};
        cur = nxt; cA = nA; cB = nB; ++ui;
        if (wr == 1) PG8_BAR;
    }
    PG8_WAIT_V(0);
    PG8_BAR;
#undef PG8_SA
#undef PG8_SB
#undef PG8_STAGE
#undef PG8_LDA
#undef PG8_LDB
#undef PG8_MMA
#undef PG8_WAIT_V
#undef PG8_WAIT_L
#undef PG8_BAR
#undef PG8_SCHED
}
}
constexpr int D = 1024, NB = 4, S = 4096, M = NB * S, DEPTH = 4, INW = 2560;
constexpr float DN_ALPHA = 1.681792830507429f;
constexpr float QSCALE = 0.125f * 1.4426950408889634f;
constexpr int NWAVES = 8;
constexpr size_t MiB = 1u << 20;
constexpr size_t TILEB = (size_t)256 * D * 2;
constexpr size_t WS_CTL = 0, CTL_ZERO_BYTES = 49152;
constexpr size_t WS_CS = 1 * MiB;
constexpr size_t WS_WIN = 2 * MiB, WIN_LAYER = 5 * MiB;
constexpr size_t WS_XB = 22 * MiB;
constexpr size_t WS_QKP = 118 * MiB;
constexpr size_t WS_UVT = 158 * MiB;
constexpr size_t WS_MIXB = 198 * MiB;
constexpr size_t WS_STASH = 54 * MiB;
constexpr size_t WS_WOUT = 383 * MiB, WOUT_LAYER = 2 * MiB;
constexpr size_t WS_TOKIDX = 391 * MiB, WS_GATE = 392 * MiB;
constexpr size_t WS_YMOE = WS_QKP;
constexpr size_t WS_YP = 86 * MiB;
constexpr size_t WS_ACT = 230 * MiB;
constexpr size_t WS_WBUF = 288 * MiB, WBUF_STRIDE = 35 * MiB, WB_W13 = 0, WB_W2 = 16 * MiB, WB_WG = 24 * MiB, WB_WP = 26 * MiB, WB_PB = 27 * MiB;
constexpr size_t WS_KF = 262 * MiB, WS_PS = 278 * MiB, WS_HT = 280 * MiB;
constexpr size_t WS_WR = 256 * MiB;
constexpr int CW_BAR = 4096, CW_CNT = 8192, CNT_STRIDE = 64;
static_assert((size_t)(CW_CNT + 4 * 16 * CNT_STRIDE) * 4 <= CTL_ZERO_BYTES && CTL_ZERO_BYTES % 16 == 0, "the per-call memset must cover every polled control word");

#define GAS __attribute__((address_space(1)))
#define LAS __attribute__((address_space(3)))
typedef unsigned short bf16;
typedef unsigned v4u __attribute__((ext_vector_type(4)));
typedef float f32x4 __attribute__((ext_vector_type(4)));
typedef short bf16x8 __attribute__((ext_vector_type(8)));
typedef GAS unsigned gu32;
typedef GAS unsigned long long gu64;
#define RLX_AGENT __ATOMIC_RELAXED, __HIP_MEMORY_SCOPE_AGENT
#define LDS_WAIT() asm volatile("s_waitcnt lgkmcnt(0)" ::: "memory")
#define VM_WAIT() asm volatile("s_waitcnt vmcnt(0)" ::: "memory")
__device__ __forceinline__ unsigned long long rt() { return __builtin_amdgcn_s_memrealtime(); }
__device__ __forceinline__ unsigned f2bf(float f) { unsigned u = __builtin_bit_cast(unsigned, f); return (u + 0x7fffu + ((u >> 16) & 1u)) >> 16; }
__device__ __forceinline__ unsigned pk2(float lo, float hi) { return f2bf(lo) | (f2bf(hi) << 16); }

#define XB_TMO      128
#define XB_XCNT(j)  (256  + 64 * (j))
#define XB_XSUB(j)  (1280 + 64 * (j))
#define XB_XGEN(j)  (2304 + 64 * (j))
#define XB_TOP      3328
#define XB_TOPGEN   3392
#define XCD_BAR_WORDS 3456
#define XB_SPIN_CAP (1u << 18)

__device__ __forceinline__ unsigned xb_ld(unsigned* p)              { return __hip_atomic_load(p, __ATOMIC_RELAXED, __HIP_MEMORY_SCOPE_AGENT); }
__device__ __forceinline__ unsigned xb_add(unsigned* p, unsigned v) { return __hip_atomic_fetch_add(p, v, __ATOMIC_RELAXED, __HIP_MEMORY_SCOPE_AGENT); }
__device__ __forceinline__ unsigned xb_xcc_id() { return (unsigned)__builtin_amdgcn_s_getreg((3 << 11) | 20) & 0xFu; }
#define XB_SPIN(cond, bar) do { unsigned _sp = 0; while (cond) { __builtin_amdgcn_s_sleep(1); \
    if ((++_sp & 255u) == 0u) { if (xb_ld(&(bar)[XB_TMO])) break; if (_sp > XB_SPIN_CAP) { atomicAdd(&(bar)[XB_TMO], 1u); break; } } } } while (0)

struct XcdBarrier {
    unsigned* bar; unsigned x;
    volatile LAS unsigned* st;
};

__device__ __forceinline__ unsigned mk_lane_id() { unsigned x; asm volatile("v_mbcnt_lo_u32_b32 %0, -1, 0\n\tv_mbcnt_hi_u32_b32 %0, -1, %0" : "=v"(x)); return x; }
__device__ __forceinline__ XcdBarrier xcd_barrier_post(unsigned* bar, volatile LAS unsigned* st, int wave) {
    XcdBarrier b; b.bar = bar; b.x = xb_xcc_id(); b.st = st;
    if (wave == 0 && mk_lane_id() == 0u) (void)xb_add(&bar[XB_XCNT(b.x)], 1u);
    return b;
}
__device__ __forceinline__ void xcd_barrier_complete(unsigned* bar, unsigned x, unsigned& nloc, unsigned& nx) {
    const unsigned G = gridDim.x * gridDim.y * gridDim.z;
    unsigned sum, cnt, mine, sp = 0u;
    for (;;) {
        sum = 0u; cnt = 0u; mine = 0u;
#pragma unroll
        for (unsigned j = 0; j < 16; ++j) { const unsigned c = xb_ld(&bar[XB_XCNT(j)]); sum += c; cnt += (c > 0u) ? 1u : 0u; mine = (j == x) ? c : mine; }
        if (sum == G) break;
        __builtin_amdgcn_s_sleep(1);
        if ((++sp & 255u) == 0u) { if (xb_ld(&bar[XB_TMO])) break; if (sp > XB_SPIN_CAP) { atomicAdd(&bar[XB_TMO], 1u); break; } }
    }
    nloc = mine > 0u ? mine : 1u; nx = cnt > 0u ? cnt : 1u;
}

__device__ __forceinline__ void xcd_barrier(const XcdBarrier& b, int wave) {
    asm volatile("" : "+s"(wave));
    const bool t0_ = (wave == 0) && (mk_lane_id() == 0u);
    asm volatile("s_waitcnt vmcnt(0)" ::: "memory");
    __syncthreads();
    if (t0_) {
        unsigned* bar = b.bar; unsigned bx_ = b.x; asm volatile("" : "+s"(bx_));
        __builtin_amdgcn_s_waitcnt(0);
        unsigned nloc = b.st[0], nx = b.st[1];
        if (nloc == 0u) { xcd_barrier_complete(bar, bx_, nloc, nx); b.st[0] = nloc; b.st[1] = nx; }
        const unsigned old = xb_add(&bar[XB_XSUB(bx_)], 1u);
        const unsigned gen = old / nloc;
        if (old + 1u == (gen + 1u) * nloc) {
            __builtin_amdgcn_fence(__ATOMIC_RELEASE, "agent");
            asm volatile("s_waitcnt vmcnt(0)" ::: "memory");
            const unsigned og = xb_add(&bar[XB_TOP], 1u);
            const unsigned tg = og / nx;
            if (og + 1u == (tg + 1u) * nx) xb_add(&bar[XB_TOPGEN], 1u);
            else XB_SPIN(xb_ld(&bar[XB_TOPGEN]) == tg, bar);
            __builtin_amdgcn_fence(__ATOMIC_ACQUIRE, "agent");
            xb_add(&bar[XB_XGEN(bx_)], 1u);
            asm volatile("s_waitcnt vmcnt(0)" ::: "memory");
        } else {
            XB_SPIN(xb_ld(&bar[XB_XGEN(bx_)]) == gen, bar);
            __builtin_amdgcn_fence(__ATOMIC_ACQUIRE, "agent");
            asm volatile("s_waitcnt vmcnt(0)" ::: "memory");
        }
    }
    __syncthreads();
}
__device__ __forceinline__ float bf2f(unsigned short b) { return __uint_as_float((unsigned)b << 16); }
#define MK_DPP(v, ctrl) __uint_as_float(__builtin_amdgcn_update_dpp(0, __float_as_uint(v), (ctrl), 0xF, 0xF, true))
__device__ __forceinline__ float xsum16(float v) { const auto r = __builtin_amdgcn_permlane16_swap(__float_as_uint(v), __float_as_uint(v), false, false); return __uint_as_float(r[0]) + __uint_as_float(r[1]); }
__device__ __forceinline__ float xsum32(float v) { const auto r = __builtin_amdgcn_permlane32_swap(__float_as_uint(v), __float_as_uint(v), false, false); return __uint_as_float(r[0]) + __uint_as_float(r[1]); }
__device__ __forceinline__ float wave_sum(float v) {
    v += MK_DPP(v, 0xB1); v += MK_DPP(v, 0x4E);
    v += MK_DPP(v, 0x141); v += MK_DPP(v, 0x140);
    return xsum32(xsum16(v));
}
__device__ __forceinline__ void p0_transpose_block(const float* W, int K, int N, int k0, int n0, bf16* WT, int mode, LAS float* scr, int lane) {
#pragma unroll
    for (int i = 0; i < 8; ++i) { const int kk = 8 * i + (lane >> 3), n4 = (lane & 7) * 4;
        const f32x4 w = __builtin_nontemporal_load((const GAS f32x4*)(W + (size_t)(k0 + kk) * N + n0 + n4));
        LAS float* d = scr + kk * 33 + n4; d[0] = w.x; d[1] = w.y; d[2] = w.z; d[3] = w.w; }
    LDS_WAIT(); asm volatile("" ::: "memory");
    const int c = lane & 7;
#pragma unroll 1
    for (int j = 0; j < 4; ++j) { const int n = (lane >> 3) + 8 * j; const LAS float* s = scr + (8 * c) * 33 + n;
        v4u o; o.x = pk2(s[0 * 33], s[1 * 33]); o.y = pk2(s[2 * 33], s[3 * 33]); o.z = pk2(s[4 * 33], s[5 * 33]); o.w = pk2(s[6 * 33], s[7 * 33]);
        const int f = n0 + n; const size_t drow = mode == 0 ? (size_t)n : (size_t)(8 * (f >> 2) + (f & 3) + (mode == 2 ? 4 : 0));
        __builtin_nontemporal_store(o, (GAS v4u*)(WT + drow * K + k0 + 8 * c)); }
    LDS_WAIT(); asm volatile("" ::: "memory");
}
template <class TX> __device__ __forceinline__ void ln_row(const TX* x0, float a, const bf16* y1, const bf16* y2, const bf16* y3, const float* g, const float* b, float* of, bf16* ob, int lane) {
    f32x4 v[4]; float s = 0.f;
#pragma unroll
    for (int j = 0; j < 4; ++j) { const int c = 4 * lane + 256 * j;
        if constexpr (sizeof(TX) == 4) v[j] = *(const GAS f32x4*)(x0 + c) * a;
        else { const unsigned long long w = *(const GAS unsigned long long*)(x0 + c); v[j] = (f32x4){bf2f((bf16)w), bf2f((bf16)(w >> 16)), bf2f((bf16)(w >> 32)), bf2f((bf16)(w >> 48))} * a; }
        if (y1) { const unsigned long long w = *(const GAS unsigned long long*)(y1 + c); v[j] += (f32x4){bf2f((bf16)w), bf2f((bf16)(w >> 16)), bf2f((bf16)(w >> 32)), bf2f((bf16)(w >> 48))}; }
        if (y2) { const unsigned long long w = *(const GAS unsigned long long*)(y2 + c); v[j] += (f32x4){bf2f((bf16)w), bf2f((bf16)(w >> 16)), bf2f((bf16)(w >> 32)), bf2f((bf16)(w >> 48))}; }
        if (y3) { const unsigned long long w = *(const GAS unsigned long long*)(y3 + c); v[j] += (f32x4){bf2f((bf16)w), bf2f((bf16)(w >> 16)), bf2f((bf16)(w >> 32)), bf2f((bf16)(w >> 48))}; }
        s += (v[j].x + v[j].y) + (v[j].z + v[j].w); }
    const float mean = wave_sum(s) * (1.f / D); float s2 = 0.f;
#pragma unroll
    for (int j = 0; j < 4; ++j) { v[j] = v[j] - mean; s2 += (v[j].x * v[j].x + v[j].y * v[j].y) + (v[j].z * v[j].z + v[j].w * v[j].w); }
    const float rstd = __builtin_amdgcn_rsqf(wave_sum(s2) * (1.f / D) + 1e-5f);
#pragma unroll
    for (int j = 0; j < 4; ++j) { const int c = 4 * lane + 256 * j; const f32x4 o = v[j] * rstd * *(const GAS f32x4*)(g + c) + *(const GAS f32x4*)(b + c);
        if (of) *(GAS f32x4*)(of + c) = o;
        if (ob) *(GAS unsigned long long*)(ob + c) = (unsigned long long)pk2(o.x, o.y) | ((unsigned long long)pk2(o.z, o.w) << 32); }
}

__device__ __forceinline__ void bf8_acc(f32x4& lo, f32x4& hi, const v4u w, float a) {
    lo += (f32x4){bf2f((bf16)w.x), bf2f((bf16)(w.x >> 16)), bf2f((bf16)w.y), bf2f((bf16)(w.y >> 16))} * a; hi += (f32x4){bf2f((bf16)w.z), bf2f((bf16)(w.z >> 16)), bf2f((bf16)w.w), bf2f((bf16)(w.w >> 16))} * a; }
__device__ __forceinline__ void ln2_row4(const bf16* x0, float a, const bf16* ym, const bf16* yp, const float* g, const float* b, float* of, bf16* ob, int lane) {
    f32x4 v[4][4]; float s[4];
    f32x4 gb[2][4];
#pragma unroll
    for (int p = 0; p < 2; ++p) { const int c = 8 * lane + 512 * p; gb[p][0] = *(const GAS f32x4*)(g + c); gb[p][1] = *(const GAS f32x4*)(g + c + 4); gb[p][2] = *(const GAS f32x4*)(b + c); gb[p][3] = *(const GAS f32x4*)(b + c + 4); }
#pragma unroll
    for (int r = 0; r < 4; ++r) {
#pragma unroll
        for (int p = 0; p < 2; ++p) { const int c = 8 * lane + 512 * p;
            const v4u w0 = *(const GAS v4u*)(x0 + (size_t)r * D + c), w1 = *(const GAS v4u*)(ym + (size_t)r * 2 * D + c), w2 = *(const GAS v4u*)(ym + (size_t)r * 2 * D + D + c), w3 = *(const GAS v4u*)(yp + (size_t)r * D + c);
            v[r][2 * p] = (f32x4){0.f, 0.f, 0.f, 0.f}; v[r][2 * p + 1] = (f32x4){0.f, 0.f, 0.f, 0.f};
            bf8_acc(v[r][2 * p], v[r][2 * p + 1], w0, a); bf8_acc(v[r][2 * p], v[r][2 * p + 1], w1, 1.f); bf8_acc(v[r][2 * p], v[r][2 * p + 1], w2, 1.f); bf8_acc(v[r][2 * p], v[r][2 * p + 1], w3, 1.f); }
        s[r] = 0.f;
#pragma unroll
        for (int j = 0; j < 4; ++j) s[r] += (v[r][j].x + v[r][j].y) + (v[r][j].z + v[r][j].w); }
    float rstd[4];
#pragma unroll
    for (int r = 0; r < 4; ++r) { const float mean = wave_sum(s[r]) * (1.f / D); float s2 = 0.f;
#pragma unroll
        for (int j = 0; j < 4; ++j) { v[r][j] = v[r][j] - mean; s2 += (v[r][j].x * v[r][j].x + v[r][j].y * v[r][j].y) + (v[r][j].z * v[r][j].z + v[r][j].w * v[r][j].w); }
        rstd[r] = __builtin_amdgcn_rsqf(wave_sum(s2) * (1.f / D) + 1e-5f); }
#pragma unroll
    for (int p = 0; p < 2; ++p) { const int c = 8 * lane + 512 * p; const f32x4 g0 = gb[p][0], g1 = gb[p][1], b0 = gb[p][2], b1 = gb[p][3];
#pragma unroll
        for (int r = 0; r < 4; ++r) { const f32x4 o0 = v[r][2 * p] * rstd[r] * g0 + b0, o1 = v[r][2 * p + 1] * rstd[r] * g1 + b1;
            if (of) { *(GAS f32x4*)(of + (size_t)r * D + c) = o0; *(GAS f32x4*)(of + (size_t)r * D + c + 4) = o1; }
            if (ob) { v4u w; w.x = pk2(o0.x, o0.y); w.y = pk2(o0.z, o0.w); w.z = pk2(o1.x, o1.y); w.w = pk2(o1.z, o1.w); *(GAS v4u*)(ob + (size_t)r * D + c) = w; } } }
}

__device__ __forceinline__ void ln0_row4(const float* x0, const float* g, const float* b, bf16* ob, int lane) {
    f32x4 v[4][4]; float s[4];
#pragma unroll
    for (int r = 0; r < 4; ++r) { s[r] = 0.f;
#pragma unroll
        for (int p = 0; p < 2; ++p) { const int c = 8 * lane + 512 * p; v[r][2 * p] = __builtin_nontemporal_load((const GAS f32x4*)(x0 + (size_t)r * D + c)); v[r][2 * p + 1] = __builtin_nontemporal_load((const GAS f32x4*)(x0 + (size_t)r * D + c + 4)); }
#pragma unroll
        for (int j = 0; j < 4; ++j) s[r] += (v[r][j].x + v[r][j].y) + (v[r][j].z + v[r][j].w); }
    float rstd[4];
#pragma unroll
    for (int r = 0; r < 4; ++r) { const float mean = wave_sum(s[r]) * (1.f / D); float s2 = 0.f;
#pragma unroll
        for (int j = 0; j < 4; ++j) { v[r][j] = v[r][j] - mean; s2 += (v[r][j].x * v[r][j].x + v[r][j].y * v[r][j].y) + (v[r][j].z * v[r][j].z + v[r][j].w * v[r][j].w); }
        rstd[r] = __builtin_amdgcn_rsqf(wave_sum(s2) * (1.f / D) + 1e-5f); }
#pragma unroll
    for (int p = 0; p < 2; ++p) { const int c = 8 * lane + 512 * p; const f32x4 g0 = *(const GAS f32x4*)(g + c), g1 = *(const GAS f32x4*)(g + c + 4), b0 = *(const GAS f32x4*)(b + c), b1 = *(const GAS f32x4*)(b + c + 4);
#pragma unroll
        for (int r = 0; r < 4; ++r) { const f32x4 o0 = v[r][2 * p] * rstd[r] * g0 + b0, o1 = v[r][2 * p + 1] * rstd[r] * g1 + b1;
            v4u w; w.x = pk2(o0.x, o0.y); w.y = pk2(o0.z, o0.w); w.z = pk2(o1.x, o1.y); w.w = pk2(o1.z, o1.w); *(GAS v4u*)(ob + (size_t)r * D + c) = w; } }
}

struct SchedIn {
    int vcu, G; const char* xb; const char* wsw; const char* wnm;
    __device__ __forceinline__ bool next(int i, pg8::Unit& u) const {
        const int L = i * G + vcu; if (L >= 640) return false;
        const int t = L / 10, j = L % 10;
        const int sw = __builtin_amdgcn_readfirstlane((unsigned)(j + 27) >> 5);
        const int jj = j - 5 * sw; const char* tp = xb + (size_t)t * TILEB; const char* wp = (sw ? wsw : wnm) + (size_t)jj * TILEB;
        u.kind = sw; u.pm = sw ? jj : t; u.pn = sw ? t : jj; u.A = sw ? wp : tp; u.B = sw ? tp : wp;
        u.aux = 0; return true;
    }
};
struct EpiIn {
    static constexpr bool PERM = true; static constexpr bool FUSED = false;
    bf16* qkp; bf16* uvt; const float* cs;
    __device__ __forceinline__ void operator()(const pg8::f32x4 (&acc)[2][2][4][2], const pg8::Unit& u, int wr, int wc, int fr, int fq) const {
        bf16* base = u.kind == 0 ? qkp : uvt; const int ldc = u.kind == 0 ? 1280 : M;
        const int row0 = u.pm * 256 + wr * 64 + fr, col0 = u.pn * 256 + wc * 32 + 8 * fq;
        const bool rope = (u.kind == 0) && (u.pn < 4) && ((wc & 1) == 0);
        const float sc = (u.kind == 0 && u.pn < 2) ? QSCALE : 1.f;
        const float sgn = fq == 0 ? -1.f : 1.f;
        const bool vperm = (u.kind == 1) && (u.pm >= 3);
#pragma unroll
        for (int ai = 0; ai < 2; ++ai)
#pragma unroll
            for (int m = 0; m < 4; ++m) { const int row = row0 + ai * 128 + m * 16; bf16* rowp = base + (size_t)row * ldc + col0;
                f32x4 cv0 = {1.f, 1.f, 1.f, 1.f}, cv1 = cv0, sv0 = {0.f, 0.f, 0.f, 0.f}, sv1 = sv0;
                if (rope && fq < 2) { const float* t = cs + (size_t)(row & (S - 1)) * 16; cv0 = *(const f32x4*)t; cv1 = *(const f32x4*)(t + 4); sv0 = *(const f32x4*)(t + 8) * sgn; sv1 = *(const f32x4*)(t + 12) * sgn; }
#pragma unroll
                for (int bj = 0; bj < 2; ++bj) { f32x4 v0 = acc[ai][bj][m][0], v1 = acc[ai][bj][m][1];
                    if (rope) { f32x4 p0, p1;
#pragma unroll
                        for (int e = 0; e < 4; ++e) { const auto r0 = __builtin_amdgcn_permlane16_swap(__float_as_uint(v0[e]), __float_as_uint(v0[e]), false, false), r1 = __builtin_amdgcn_permlane16_swap(__float_as_uint(v1[e]), __float_as_uint(v1[e]), false, false);
                            p0[e] = __uint_as_float((fq & 1) ? r0[0] : r0[1]); p1[e] = __uint_as_float((fq & 1) ? r1[0] : r1[1]); }
                        v0 = v0 * cv0 + p0 * sv0; v1 = v1 * cv1 + p1 * sv1; }
                    v0 = v0 * sc; v1 = v1 * sc;
                    pg8::u32x4 w; w.x = pg8::cvt_pk_bf16(v0[0], v0[1]); w.y = pg8::cvt_pk_bf16(v0[2], v0[3]); w.z = pg8::cvt_pk_bf16(v1[0], v1[1]); w.w = pg8::cvt_pk_bf16(v1[2], v1[3]);
                    if (vperm) {
                        const auto r0 = __builtin_amdgcn_permlane16_swap(w.x, w.z, false, false), r1 = __builtin_amdgcn_permlane16_swap(w.y, w.w, false, false);
                        if (fq & 1) { w.x = r0[0]; w.y = r1[0]; }
                        else { w.z = r0[1]; w.w = r1[1]; }
                    }
                    *(pg8::u32x4*)(rowp + bj * 128) = w; } }
    }
};

struct SchedOut {
    int vcu, G; const char* a; const char* w;
    __device__ __forceinline__ bool next(int i, pg8::Unit& u) const {
        const int L = i * G + vcu; if (L >= 256) return false;
        u.kind = 0; u.pm = L >> 2; u.pn = L & 3; u.aux = 0; u.A = a + (size_t)u.pm * TILEB; u.B = w + (size_t)u.pn * TILEB; return true;
    }
};
struct EpiRes {
    static constexpr bool PERM = true; static constexpr bool FUSED = false;
    bf16* XB;
    __device__ __forceinline__ void operator()(const pg8::f32x4 (&acc)[2][2][4][2], const pg8::Unit& u, int wr, int wc, int fr, int fq) const {
        const int row0 = u.pm * 256 + wr * 64 + fr, col0 = u.pn * 256 + wc * 32 + 8 * fq;
#pragma unroll
        for (int ai = 0; ai < 2; ++ai) {
            pg8::u32x4 xin[4][2];
#pragma unroll
            for (int m = 0; m < 4; ++m)
#pragma unroll
                for (int bj = 0; bj < 2; ++bj) xin[m][bj] = *(const pg8::u32x4*)(XB + (size_t)(row0 + ai * 128 + m * 16) * D + col0 + bj * 128);
#pragma unroll
            for (int m = 0; m < 4; ++m) { bf16* rowp = XB + (size_t)(row0 + ai * 128 + m * 16) * D + col0;
#pragma unroll
                for (int bj = 0; bj < 2; ++bj) { pg8::u32x4* p = (pg8::u32x4*)(rowp + bj * 128); const pg8::u32x4 x = xin[m][bj]; const pg8::f32x4 v0 = acc[ai][bj][m][0], v1 = acc[ai][bj][m][1];
                    pg8::u32x4 w; w.x = pg8::cvt_pk_bf16(bf2f((bf16)x.x) * DN_ALPHA + v0[0], bf2f((bf16)(x.x >> 16)) * DN_ALPHA + v0[1]); w.y = pg8::cvt_pk_bf16(bf2f((bf16)x.y) * DN_ALPHA + v0[2], bf2f((bf16)(x.y >> 16)) * DN_ALPHA + v0[3]);
                    w.z = pg8::cvt_pk_bf16(bf2f((bf16)x.z) * DN_ALPHA + v1[0], bf2f((bf16)(x.z >> 16)) * DN_ALPHA + v1[1]); w.w = pg8::cvt_pk_bf16(bf2f((bf16)x.w) * DN_ALPHA + v1[2], bf2f((bf16)(x.w >> 16)) * DN_ALPHA + v1[3]);
                    *p = w; } } }
    }
};
struct EpiResLn {
    static constexpr bool PERM = true, FUSED = true;
    bf16* XB; const float* g; const float* b; unsigned long long* xs; unsigned* cnt; unsigned* bar; unsigned want;
    __device__ __forceinline__ void operator()(const pg8::f32x4 (&)[2][2][4][2], const pg8::Unit&, int, int, int, int) const {}
    __device__ __forceinline__ void fused(pg8::f32x4 (&acc)[2][2][4][2], const pg8::Unit& u, int wr, int wc, int fr, int fq, LAS unsigned char* lds, int wave) const {
        typedef float f32x2v __attribute__((ext_vector_type(2)));
        LAS f32x2v* P = (LAS f32x2v*)lds;
        LAS f32x2v* S = (LAS f32x2v*)(lds + 8192);
        const int row0 = u.pm * 256 + wr * 64 + fr, col0 = u.pn * 256 + wc * 32 + 8 * fq;
        asm volatile("s_waitcnt vmcnt(0)" ::: "memory"); __builtin_amdgcn_s_barrier(); asm volatile("" ::: "memory");
#pragma unroll
        for (int ai = 0; ai < 2; ++ai) {
            pg8::u32x4 xin[4][2];
#pragma unroll
            for (int m = 0; m < 4; ++m)
#pragma unroll
                for (int bj = 0; bj < 2; ++bj) xin[m][bj] = *(const pg8::u32x4*)(XB + (size_t)(row0 + ai * 128 + m * 16) * D + col0 + bj * 128);
#pragma unroll
            for (int m = 0; m < 4; ++m)
#pragma unroll
                for (int bj = 0; bj < 2; ++bj) { const pg8::u32x4 x = xin[m][bj];
                    acc[ai][bj][m][0] += (pg8::f32x4){bf2f((bf16)x.x), bf2f((bf16)(x.x >> 16)), bf2f((bf16)x.y), bf2f((bf16)(x.y >> 16))} * DN_ALPHA;
                    acc[ai][bj][m][1] += (pg8::f32x4){bf2f((bf16)x.z), bf2f((bf16)(x.z >> 16)), bf2f((bf16)x.w), bf2f((bf16)(x.w >> 16))} * DN_ALPHA; } }
#pragma unroll
        for (int ai = 0; ai < 2; ++ai)
#pragma unroll
            for (int m = 0; m < 4; ++m) { float s = 0.f;
#pragma unroll
                for (int bj = 0; bj < 2; ++bj)
#pragma unroll
                    for (int n = 0; n < 2; ++n) { const pg8::f32x4 x = acc[ai][bj][m][n]; s += (x[0] + x[1]) + (x[2] + x[3]); }
                s = xsum32(xsum16(s));
                const float mw = s * (1.0f / 64.0f); float q = 0.f;
#pragma unroll
                for (int bj = 0; bj < 2; ++bj)
#pragma unroll
                    for (int n = 0; n < 2; ++n) { const pg8::f32x4 d = acc[ai][bj][m][n] - mw; q += (d[0] * d[0] + d[1] * d[1]) + (d[2] * d[2] + d[3] * d[3]); }
                q = xsum32(xsum16(q));
                if (fq == 0) P[(ai * 128 + wr * 64 + m * 16 + fr) * 4 + wc] = (f32x2v){mw, q}; }
        asm volatile("s_waitcnt lgkmcnt(0)" ::: "memory"); __builtin_amdgcn_s_barrier(); asm volatile("" ::: "memory");
        const int lane = (int)mk_lane_id(), row = wave * 32 + (lane & 31);
        if (lane < 32) { const f32x2v a = P[row * 4 + 0], bq = P[row * 4 + 1], c = P[row * 4 + 2], d = P[row * 4 + 3];
            const float mt = (a.x + bq.x + c.x + d.x) * 0.25f; const float da = a.x - mt, db = bq.x - mt, dc = c.x - mt, dd = d.x - mt;
            const float m2 = (a.y + bq.y) + (c.y + d.y) + 64.0f * ((da * da + db * db) + (dc * dc + dd * dd));
            __hip_atomic_store(xs + ((size_t)(u.pm * 256 + row) * 4 + u.pn), ((unsigned long long)__float_as_uint(m2) << 32) | __float_as_uint(mt), __ATOMIC_RELAXED, __HIP_MEMORY_SCOPE_AGENT); }
        asm volatile("s_waitcnt vmcnt(0)" ::: "memory");
        if (lane == 0) (void)xb_add(cnt + 64 * u.pm, 1u);
        f32x4 gv[2][2], bv[2][2];
#pragma unroll
        for (int bj = 0; bj < 2; ++bj) { gv[bj][0] = *(const GAS f32x4*)(g + col0 + bj * 128); gv[bj][1] = *(const GAS f32x4*)(g + col0 + bj * 128 + 4); bv[bj][0] = *(const GAS f32x4*)(b + col0 + bj * 128); bv[bj][1] = *(const GAS f32x4*)(b + col0 + bj * 128 + 4); }
        if (wave == 0) { XB_SPIN(xb_ld(cnt + 64 * u.pm) < want, bar); __builtin_amdgcn_fence(__ATOMIC_ACQUIRE, "agent"); }
        asm volatile("s_waitcnt vmcnt(0) lgkmcnt(0)" ::: "memory"); __builtin_amdgcn_s_barrier(); asm volatile("" ::: "memory");
        if (lane < 32) { const unsigned long long* sl = xs + (size_t)(u.pm * 256 + row) * 4; float mt[4], m2[4], ms = 0.f;
#pragma unroll
            for (int t = 0; t < 4; ++t) { const unsigned long long w = __hip_atomic_load(sl + t, __ATOMIC_RELAXED, __HIP_MEMORY_SCOPE_AGENT); mt[t] = __uint_as_float((unsigned)w); m2[t] = __uint_as_float((unsigned)(w >> 32)); ms += mt[t]; }
            const float mean = ms * 0.25f; float q = 0.f;
#pragma unroll
            for (int t = 0; t < 4; ++t) { const float dm = mt[t] - mean; q += m2[t] + 256.0f * dm * dm; }
            S[row] = (f32x2v){mean, __builtin_amdgcn_rsqf(q * (1.0f / 1024.0f) + 1e-5f)}; }
        asm volatile("s_waitcnt lgkmcnt(0)" ::: "memory"); __builtin_amdgcn_s_barrier(); asm volatile("" ::: "memory");
#pragma unroll
        for (int ai = 0; ai < 2; ++ai)
#pragma unroll
            for (int m = 0; m < 4; ++m) { const int r = ai * 128 + wr * 64 + m * 16 + fr; const f32x2v sr = S[r]; bf16* rowp = XB + (size_t)(u.pm * 256 + r) * D + col0;
#pragma unroll
                for (int bj = 0; bj < 2; ++bj) { const pg8::f32x4 o0 = (acc[ai][bj][m][0] - sr.x) * sr.y * gv[bj][0] + bv[bj][0], o1 = (acc[ai][bj][m][1] - sr.x) * sr.y * gv[bj][1] + bv[bj][1];
                    pg8::u32x4 w; w.x = pg8::cvt_pk_bf16(o0[0], o0[1]); w.y = pg8::cvt_pk_bf16(o0[2], o0[3]); w.z = pg8::cvt_pk_bf16(o1[0], o1[1]); w.w = pg8::cvt_pk_bf16(o1[2], o1[3]);
                    *(pg8::u32x4*)(rowp + bj * 128) = w; } }
    }
};
struct RouteLds { unsigned lcnt[16]; unsigned gbase[16]; int e0[64], e1[64]; unsigned r0[64], r1[64]; float g0[64], g1[64]; };
constexpr int RT_PITCH = 2064;
template <int DRY = 0> __device__ __forceinline__ void ln1_router_chunk(LAS RouteLds* R, LAS unsigned char* tile, int row0, bf16* XB, bf16* XOUT, const float* g, const float* b, const bf16* wrt, const float* bgc, const float* bgf,
                                                 gu32* cnt, int* tokidx, float* gate, int wave, int lane, bool pre = false) {
    const int tidl = wave * 64 + lane;
    if (tidl < 16) R->lcnt[tidl] = 0u;
    if (pre) {
        v4u wr_[8][2];
#pragma unroll
        for (int r = 0; r < 8; ++r)
#pragma unroll
            for (int p = 0; p < 2; ++p) wr_[r][p] = *(const GAS v4u*)(XB + (size_t)(row0 + wave * 8 + r) * D + 8 * lane + 512 * p);
#pragma unroll
        for (int r = 0; r < 8; ++r)
#pragma unroll
            for (int p = 0; p < 2; ++p) *(LAS v4u*)(tile + (wave * 8 + r) * RT_PITCH + (8 * lane + 512 * p) * 2) = wr_[r][p];
    } else {
    f32x4 gbv[2][4];
#pragma unroll
    for (int p = 0; p < 2; ++p) { const int c = 8 * lane + 512 * p; gbv[p][0] = *(const GAS f32x4*)(g + c); gbv[p][1] = *(const GAS f32x4*)(g + c + 4); gbv[p][2] = *(const GAS f32x4*)(b + c); gbv[p][3] = *(const GAS f32x4*)(b + c + 4); }
#pragma unroll 2
    for (int r = 0; r < 8; ++r) { const int rl = wave * 8 + r; bf16* xbrow = XB + (size_t)(row0 + rl) * D; f32x4 v[4]; float s = 0.f;
#pragma unroll
        for (int p = 0; p < 2; ++p) { const v4u w = *(const GAS v4u*)(xbrow + 8 * lane + 512 * p);
            v[2 * p] = (f32x4){bf2f((bf16)w.x), bf2f((bf16)(w.x >> 16)), bf2f((bf16)w.y), bf2f((bf16)(w.y >> 16))}; v[2 * p + 1] = (f32x4){bf2f((bf16)w.z), bf2f((bf16)(w.z >> 16)), bf2f((bf16)w.w), bf2f((bf16)(w.w >> 16))};
            s += ((v[2 * p].x + v[2 * p].y) + (v[2 * p].z + v[2 * p].w)) + ((v[2 * p + 1].x + v[2 * p + 1].y) + (v[2 * p + 1].z + v[2 * p + 1].w)); }
        const float mean = wave_sum(s) * (1.f / D); float s2 = 0.f;
#pragma unroll
        for (int j = 0; j < 4; ++j) { v[j] = v[j] - mean; s2 += (v[j].x * v[j].x + v[j].y * v[j].y) + (v[j].z * v[j].z + v[j].w * v[j].w); }
        const float rstd = __builtin_amdgcn_rsqf(wave_sum(s2) * (1.f / D) + 1e-5f);
#pragma unroll
        for (int p = 0; p < 2; ++p) { const int c = 8 * lane + 512 * p;
            const f32x4 o0 = v[2 * p] * rstd * gbv[p][0] + gbv[p][2], o1 = v[2 * p + 1] * rstd * gbv[p][1] + gbv[p][3];
            v4u w; w.x = pk2(o0.x, o0.y); w.y = pk2(o0.z, o0.w); w.z = pk2(o1.x, o1.y); w.w = pk2(o1.z, o1.w);
            *(GAS v4u*)(xbrow + c) = w;
            *(LAS v4u*)(tile + rl * RT_PITCH + c * 2) = w; } }
    }
    LDS_WAIT(); __syncthreads();
    if (DRY == 1) return;
    typedef float f32x16_t __attribute__((ext_vector_type(16)));
    f32x16_t pacc;
#pragma unroll
    for (int r = 0; r < 16; ++r) pacc[r] = 0.f;
    { const int rt = wave & 1, kq = wave >> 1, r32 = lane & 31, hi = lane >> 5;
      LAS const unsigned char* ap = tile + (32 * rt + r32) * RT_PITCH + (256 * kq + 8 * hi) * 2;
      const bf16* bh = wrt + (size_t)r32 * D + 256 * kq + 8 * hi; const bf16* bl = bh + 32 * D;
#pragma unroll 4
      for (int ks = 0; ks < 16; ++ks) { const bf16x8 af = *(LAS const bf16x8*)(ap + ks * 32), bhf = *(const GAS bf16x8*)(bh + ks * 16), blf = *(const GAS bf16x8*)(bl + ks * 16);
          pacc = __builtin_amdgcn_mfma_f32_32x32x16_bf16(af, bhf, pacc, 0, 0, 0); pacc = __builtin_amdgcn_mfma_f32_32x32x16_bf16(af, blf, pacc, 0, 0, 0); } }
    LDS_WAIT(); __syncthreads();
    if (DRY == 2) return;
    { const int rt = wave & 1, kq = wave >> 1, r32 = lane & 31, hi = lane >> 5;
      LAS float* P = (LAS float*)tile + (kq * 64 + rt * 32) * 33 + r32;
#pragma unroll
      for (int r = 0; r < 16; ++r) P[((r & 3) + 8 * (r >> 2) + 4 * hi) * 33] = pacc[r]; }
    LDS_WAIT(); __syncthreads();
    if (wave == 0) {
        float my[20];
#pragma unroll
        for (int i = 0; i < 20; ++i) { float t = 0.f;
#pragma unroll
            for (int q = 0; q < 4; ++q) t += ((LAS const float*)tile)[(q * 64 + lane) * 33 + i];
            my[i] = t; }
        const int rl = lane;
        float pg[4], mx = -INFINITY, sum = 0.f;
#pragma unroll
        for (int j = 0; j < 4; ++j) { pg[j] = my[j] + bgc[j]; mx = fmaxf(mx, pg[j]); }
#pragma unroll
        for (int j = 0; j < 4; ++j) { pg[j] = expf(pg[j] - mx); sum += pg[j]; }
        int gi = 0; float gw = pg[0];
#pragma unroll
        for (int j = 1; j < 4; ++j) if (pg[j] > gw) { gw = pg[j]; gi = j; }
        gw /= sum;
        float fs[4]; mx = -INFINITY;
#pragma unroll
        for (int j = 0; j < 4; ++j) { float t = 0.f;
#pragma unroll
            for (int q = 0; q < 4; ++q) if (q == gi) t = my[4 + q * 4 + j] + bgf[q * 4 + j];
            fs[j] = t; mx = fmaxf(mx, t); }
#pragma unroll
        for (int j = 0; j < 4; ++j) fs[j] = expf(fs[j] - mx);
        int t0 = 0; float v0 = fs[0];
#pragma unroll
        for (int j = 1; j < 4; ++j) if (fs[j] > v0) { v0 = fs[j]; t0 = j; }
        int t1 = -1; float v1 = -1.f;
#pragma unroll
        for (int j = 0; j < 4; ++j) if (j != t0 && fs[j] > v1) { v1 = fs[j]; t1 = j; }
        const float ts = v0 + v1; const int e0 = gi * 4 + t0, e1 = gi * 4 + t1;
        R->e0[rl] = e0; R->e1[rl] = e1; R->g0[rl] = gw * (v0 / ts); R->g1[rl] = gw * (v1 / ts);
        R->r0[rl] = __hip_atomic_fetch_add(&R->lcnt[e0], 1u, __ATOMIC_RELAXED, __HIP_MEMORY_SCOPE_WORKGROUP);
        R->r1[rl] = __hip_atomic_fetch_add(&R->lcnt[e1], 1u, __ATOMIC_RELAXED, __HIP_MEMORY_SCOPE_WORKGROUP);
    }
    LDS_WAIT(); __syncthreads();
    if (DRY == 3) return;
    if (tidl < 16) { const unsigned n = R->lcnt[tidl]; R->gbase[tidl] = n ? __hip_atomic_fetch_add(cnt + tidl * CNT_STRIDE, n, RLX_AGENT) : 0u; }
    LDS_WAIT(); __syncthreads();
    if (tidl < 64) { const int rl = tidl, tok = row0 + rl; const int e0 = R->e0[rl], e1 = R->e1[rl]; const unsigned p0 = R->gbase[e0] + R->r0[rl], p1 = R->gbase[e1] + R->r1[rl];
        tokidx[(size_t)e0 * M + p0] = tok * 2; gate[(size_t)e0 * M + p0] = R->g0[rl]; tokidx[(size_t)e1 * M + p1] = tok * 2 + 1; gate[(size_t)e1 * M + p1] = R->g1[rl]; }
    LDS_WAIT(); __syncthreads();
}

struct MoeTab { LAS const int* p;
    __device__ __forceinline__ int cnt(int e) const { return __builtin_amdgcn_readfirstlane(p[e]); }
    __device__ __forceinline__ int pre(int e) const { return __builtin_amdgcn_readfirstlane(p[16 + e]); } };
__device__ __forceinline__ void moe_tab_build(LAS int* p, const gu32* cnt, int tid) {
    if (tid < 64) {
        const int c = tid < 16 ? (int)__hip_atomic_load(cnt + (tid < 16 ? tid : 0) * CNT_STRIDE, RLX_AGENT) : 0;
        const int tl = (c + 255) >> 8; int t = tl;
        t += __builtin_amdgcn_update_dpp(0, t, 0x111, 0xF, 0xF, false); t += __builtin_amdgcn_update_dpp(0, t, 0x112, 0xF, 0xF, false);
        t += __builtin_amdgcn_update_dpp(0, t, 0x114, 0xF, 0xF, false); t += __builtin_amdgcn_update_dpp(0, t, 0x118, 0xF, 0xF, false);
        if (tid < 16) { p[tid] = c; p[16 + tid] = t - tl; if (tid == 15) p[32] = t; } }
    __syncthreads();
}
template <int NPN> struct SchedMoe {
    int vcu, G; MoeTab T; const char* a; const char* w; size_t wexp  ; const int* tokidx; size_t atile  ;
    __device__ __forceinline__ bool next(int i, pg8::Unit& u) const {
        const int L = i * G + vcu; if (L >= T.pre(16) * NPN) return false;
        const int tile = L / NPN; u.pn = L % NPN; int e = 0;
#pragma unroll
        for (int st = 8; st >= 1; st >>= 1) if (tile >= T.pre(e + st)) e += st;
        u.aux = e; u.pm = tile - T.pre(e); u.kind = tile;
        u.A = a + (size_t)tile * atile; u.B = w + (size_t)e * wexp + (size_t)u.pn * 256 * (wexp / (NPN * 256)); return true;
    }
    __device__ __forceinline__ int arow(const pg8::Unit& u, int r) const {
        const int rank = u.pm * 256 + r; const int c = T.cnt(u.aux);
        return rank < c ? (tokidx[(size_t)u.aux * M + rank] >> 1) : 0;
    }
};
struct EpiMoe1 {
    static constexpr bool PERM = true; static constexpr bool FUSED = false;
    bf16* act; const float* gate; MoeTab T;
    __device__ __forceinline__ void operator()(const pg8::f32x4 (&acc)[2][2][4][2], const pg8::Unit& u, int wr, int wc, int fr, int fq) const {
        const int cnt = T.cnt(u.aux);
        float gts[2][4];
#pragma unroll
        for (int ai = 0; ai < 2; ++ai)
#pragma unroll
            for (int m = 0; m < 4; ++m) { const int rank = u.pm * 256 + ai * 128 + wr * 64 + m * 16 + fr; gts[ai][m] = rank < cnt ? gate[(size_t)u.aux * M + rank] : 0.f; }
#pragma unroll
        for (int ai = 0; ai < 2; ++ai)
#pragma unroll
            for (int m = 0; m < 4; ++m) { const int r = ai * 128 + wr * 64 + m * 16 + fr;
                const float gt = gts[ai][m];
                bf16* rowp = act + ((size_t)u.kind * 256 + r) * 256 + u.pn * 128 + wc * 16 + 4 * fq;
                unsigned wq[2][2];
#pragma unroll
                for (int bj = 0; bj < 2; ++bj) { const pg8::f32x4 av = acc[ai][bj][m][0], cv = acc[ai][bj][m][1]; float y[4];
#pragma unroll
                    for (int e = 0; e < 4; ++e) y[e] = av[e] * __builtin_amdgcn_rcpf(1.f + __builtin_amdgcn_exp2f(av[e] * -1.4426950408889634f)) * cv[e] * gt;
                    wq[bj][0] = pg8::cvt_pk_bf16(y[0], y[1]); wq[bj][1] = pg8::cvt_pk_bf16(y[2], y[3]); }
                const auto r0 = __builtin_amdgcn_permlane16_swap(wq[0][0], wq[1][0], false, false), r1 = __builtin_amdgcn_permlane16_swap(wq[0][1], wq[1][1], false, false);
                pg8::u32x4 w;
                if (fq & 1) { w.x = r0[0]; w.y = r1[0]; w.z = wq[1][0]; w.w = wq[1][1]; }
                else { w.x = wq[0][0]; w.y = wq[0][1]; w.z = r0[1]; w.w = r1[1]; }
                *(pg8::u32x4*)(rowp + ((fq & 1) ? 60 : 0)) = w; }
    }
};
struct EpiMoe2 {
    static constexpr bool PERM = true; static constexpr bool FUSED = false;
    bf16* ymoe; const int* tokidx; MoeTab T;
    __device__ __forceinline__ void operator()(const pg8::f32x4 (&acc)[2][2][4][2], const pg8::Unit& u, int wr, int wc, int fr, int fq) const {
        const int cnt = T.cnt(u.aux);
        int tks[2][4];
#pragma unroll
        for (int ai = 0; ai < 2; ++ai)
#pragma unroll
            for (int m = 0; m < 4; ++m) { const int rank = u.pm * 256 + ai * 128 + wr * 64 + m * 16 + fr; tks[ai][m] = rank < cnt ? tokidx[(size_t)u.aux * M + rank] : 0; }
#pragma unroll
        for (int ai = 0; ai < 2; ++ai)
#pragma unroll
            for (int m = 0; m < 4; ++m) { const int r = ai * 128 + wr * 64 + m * 16 + fr, rank = u.pm * 256 + r;
                if (rank < cnt) { bf16* rowp = ymoe + (size_t)tks[ai][m] * D + u.pn * 256 + wc * 32 + 8 * fq;
#pragma unroll
                    for (int bj = 0; bj < 2; ++bj) { const pg8::f32x4 v0 = acc[ai][bj][m][0], v1 = acc[ai][bj][m][1];
                        pg8::u32x4 w; w.x = pg8::cvt_pk_bf16(v0[0], v0[1]); w.y = pg8::cvt_pk_bf16(v0[2], v0[3]); w.z = pg8::cvt_pk_bf16(v1[0], v1[1]); w.w = pg8::cvt_pk_bf16(v1[2], v1[3]);
                        *(pg8::u32x4*)(rowp + bj * 128) = w; } } }
    }
};
struct SchedSq {
    int vcu, G; const char* a; const char* w; size_t astep, wstep; int vfirst; int lo = 0, hi = 256;
    __device__ __forceinline__ bool next(int i, pg8::Unit& u) const {
        if (vcu < vfirst || vcu >= vfirst + G) return false;
        const int L = lo + i * G + (vcu - vfirst); if (L >= hi) return false;
        u.kind = 0; u.pm = L >> 2; u.pn = L & 3; u.aux = 0; u.A = a + (size_t)u.pm * astep; u.B = w + (size_t)u.pn * wstep; return true;
    }
};
template <int GATED> struct EpiPle {
    static constexpr bool PERM = true; static constexpr bool FUSED = false;
    bf16* yp; const float* bg;
    __device__ __forceinline__ void operator()(const pg8::f32x4 (&acc)[2][2][4][2], const pg8::Unit& u, int wr, int wc, int fr, int fq) const {
        const int row0 = u.pm * 256 + wr * 64 + fr, col0 = u.pn * 256 + wc * 32 + 8 * fq;
        pg8::f32x4 bb[2][2];
        if (GATED) {
#pragma unroll
            for (int bj = 0; bj < 2; ++bj) { bb[bj][0] = *(const pg8::f32x4*)(bg + col0 + bj * 128); bb[bj][1] = *(const pg8::f32x4*)(bg + col0 + bj * 128 + 4); } }
#pragma unroll
        for (int ai = 0; ai < 2; ++ai) {
            pg8::u32x4 yin[4][2];
            if (GATED) {
#pragma unroll
                for (int m = 0; m < 4; ++m)
#pragma unroll
                    for (int bj = 0; bj < 2; ++bj) yin[m][bj] = *(const pg8::u32x4*)(yp + (size_t)(row0 + ai * 128 + m * 16) * D + col0 + bj * 128); }
#pragma unroll
            for (int m = 0; m < 4; ++m) { bf16* rowp = yp + (size_t)(row0 + ai * 128 + m * 16) * D + col0;
#pragma unroll
                for (int bj = 0; bj < 2; ++bj) { pg8::f32x4 v0 = acc[ai][bj][m][0], v1 = acc[ai][bj][m][1];
                    if (GATED) { const pg8::f32x4 b0 = bb[bj][0], b1 = bb[bj][1]; const pg8::u32x4 y = yin[m][bj];
                        const float yf[8] = {bf2f((bf16)y.x), bf2f((bf16)(y.x >> 16)), bf2f((bf16)y.y), bf2f((bf16)(y.y >> 16)), bf2f((bf16)y.z), bf2f((bf16)(y.z >> 16)), bf2f((bf16)y.w), bf2f((bf16)(y.w >> 16))};
#pragma unroll
                        for (int e = 0; e < 4; ++e) { v0[e] = yf[e] * __builtin_amdgcn_rcpf(1.f + __builtin_amdgcn_exp2f((v0[e] + b0[e]) * -1.4426950408889634f)); v1[e] = yf[4 + e] * __builtin_amdgcn_rcpf(1.f + __builtin_amdgcn_exp2f((v1[e] + b1[e]) * -1.4426950408889634f)); } }
                    pg8::u32x4 w; w.x = pg8::cvt_pk_bf16(v0[0], v0[1]); w.y = pg8::cvt_pk_bf16(v0[2], v0[3]); w.z = pg8::cvt_pk_bf16(v1[0], v1[1]); w.w = pg8::cvt_pk_bf16(v1[2], v1[3]);
                    *(pg8::u32x4*)(rowp + bj * 128) = w; } } }
    }
};
namespace att {
typedef float f32x16 __attribute__((ext_vector_type(16)));
constexpr int KSLOT = 8192, VSLOT = 16384, LDS_K = 0, LDS_V = 2 * KSLOT, ATT_LDS = 2 * KSLOT + 2 * VSLOT;
__device__ __forceinline__ bf16x8 pack8(const f32x16& p, int b) {
    v4u w; w.x = pg8::cvt_pk_bf16(p[b], p[b + 1]); w.y = pg8::cvt_pk_bf16(p[b + 2], p[b + 3]); w.z = pg8::cvt_pk_bf16(p[b + 4], p[b + 5]); w.w = pg8::cvt_pk_bf16(p[b + 6], p[b + 7]);
    return __builtin_bit_cast(bf16x8, w);
}
#define ATT_PARK2(w) ((w) < 5 ? ATT_LDS + 65536 + (w) * 4096 : 137216 + ((w) - 5) * 4096)
constexpr int ATT_SUBG = 149504;
constexpr float THR2 = 8.f;
__device__ __forceinline__ void qkt_load(bf16x8 (&kf)[8], LAS const unsigned char* ks, int r32, int hi) {
    LAS const unsigned char* kb = ks + hi * 1024 + r32 * 16;
#pragma unroll
    for (int kk = 0; kk < 4; ++kk) { kf[2 * kk] = *(LAS const bf16x8*)(kb + kk * 2048); kf[2 * kk + 1] = *(LAS const bf16x8*)(kb + kk * 2048 + 512); }
}
__device__ __forceinline__ void qkt_mma(f32x16& p0, f32x16& p1, const bf16x8 (&kf)[8], const bf16x8 (&qf)[4]) {
#pragma unroll
    for (int r = 0; r < 16; ++r) { p0[r] = 0.f; p1[r] = 0.f; }
#pragma unroll
    for (int kk = 0; kk < 4; ++kk) {
        p0 = __builtin_amdgcn_mfma_f32_32x32x16_bf16(kf[2 * kk], qf[kk], p0, 0, 0, 0);
        p1 = __builtin_amdgcn_mfma_f32_32x32x16_bf16(kf[2 * kk + 1], qf[kk], p1, 0, 0, 0);
    }
}
__device__ __forceinline__ void qkt(f32x16& p0, f32x16& p1, LAS const unsigned char* ks, const bf16x8 (&qf)[4], int r32, int hi) {
    bf16x8 kf[8]; qkt_load(kf, ks, r32, hi); qkt_mma(p0, p1, kf, qf);
}
typedef float f32x2 __attribute__((ext_vector_type(2)));
#define ATT_PAIR(p, i) ((f32x2){p[2 * (i)], p[2 * (i) + 1]})
__device__ __forceinline__ void partialSM0(f32x16& p0, f32x16& p1, float& m, float& alpha) {
    float pmax = fmaxf(p0[0], p1[0]);
#pragma unroll
    for (int r = 1; r < 16; ++r) pmax = fmaxf(pmax, fmaxf(p0[r], p1[r]));
    { const auto rr = __builtin_amdgcn_permlane32_swap(__float_as_uint(pmax), __float_as_uint(pmax), false, false); pmax = fmaxf(__uint_as_float(rr[0]), __uint_as_float(rr[1])); }
    alpha = 1.f; m = pmax;
#pragma unroll
    for (int r = 0; r < 16; ++r) { p0[r] = __builtin_amdgcn_exp2f(p0[r] - pmax); p1[r] -= pmax; }
}
__device__ __forceinline__ void partialSM(f32x16& p0, f32x16& p1, float& m, float& alpha) {
    { const float nm = -m; p0 += nm; p1 += nm; }
    float x = fmaxf(p0[0], p0[1]), y = fmaxf(p1[0], p1[1]);
#pragma unroll
    for (int r = 2; r < 16; r += 2) { x = fmaxf(x, fmaxf(p0[r], p0[r + 1])); y = fmaxf(y, fmaxf(p1[r], p1[r + 1])); }
    float pmax = fmaxf(x, y);
    { const auto rr = __builtin_amdgcn_permlane32_swap(__float_as_uint(pmax), __float_as_uint(pmax), false, false); pmax = fmaxf(__uint_as_float(rr[0]), __uint_as_float(rr[1])); }
    if (__builtin_expect(__all(pmax <= THR2), 1)) alpha = 1.f;
    else { const float d = fmaxf(pmax, 0.f); alpha = __builtin_amdgcn_exp2f(-d); m += d; const float nd = -d; p0 += nd; p1 += nd; }
#pragma unroll
    for (int r = 0; r < 16; ++r) p0[r] = __builtin_amdgcn_exp2f(p0[r]);
}
__device__ __forceinline__ void finishExp(f32x16& p1) {
#pragma unroll
    for (int r = 0; r < 16; ++r) p1[r] = __builtin_amdgcn_exp2f(p1[r]);
}
__device__ __forceinline__ void finishRest(f32x16& p0, f32x16& p1, float alpha, float& l, bf16x8 (&pf)[4]) {
    f32x2 ps = ATT_PAIR(p0, 0) + ATT_PAIR(p1, 0);
#pragma unroll
    for (int i = 1; i < 8; ++i) { ps += ATT_PAIR(p0, i); ps += ATT_PAIR(p1, i); }
    l = l * alpha + (ps.x + ps.y);
    pf[0] = pack8(p0, 0); pf[1] = pack8(p0, 8); pf[2] = pack8(p1, 0); pf[3] = pack8(p1, 8);
}
__device__ __forceinline__ void finishSM(f32x16& p0, f32x16& p1, float alpha, float& l, bf16x8 (&pf)[4]) { finishExp(p1); finishRest(p0, p1, alpha, l, pf); }
__device__ __forceinline__ void pv(f32x16 (&o)[4], LAS const unsigned char* vs, const bf16x8 (&pf)[4], int r32, int hi) {
    LAS const unsigned char* vb = vs + hi * 2048 + r32 * 16;
    bf16x8 va[2][4];
#pragma unroll
    for (int s = 0; s < 4; ++s) va[0][s] = *(LAS const bf16x8*)(vb + s * 4096);
    __builtin_amdgcn_sched_group_barrier(0x100, 4, 0);
#pragma unroll
    for (int db = 0; db < 4; ++db) {
        if (db < 3) {
#pragma unroll
            for (int s = 0; s < 4; ++s) va[(db + 1) & 1][s] = *(LAS const bf16x8*)(vb + s * 4096 + (db + 1) * 512);
        }
#pragma unroll
        for (int s = 0; s < 4; ++s) o[db] = __builtin_amdgcn_mfma_f32_32x32x16_bf16(va[db & 1][s], pf[s], o[db], 0, 0, 0);
        if (db < 3) __builtin_amdgcn_sched_group_barrier(0x100, 4, 0);
        __builtin_amdgcn_sched_group_barrier(0x8, 4, 0);
    }
}
__device__ __forceinline__ void resc(f32x16 (&o)[4], float alpha) {
    if (__any(alpha < 1.f)) {
#pragma unroll
        for (int db = 0; db < 4; ++db)
#pragma unroll
            for (int r = 0; r < 16; ++r) o[db][r] *= alpha;
    }
}
#define ATT_SGB(mask, n) __builtin_amdgcn_sched_group_barrier(mask, n, 0)
__device__ __forceinline__ void v_load(bf16x8 (&va)[8], LAS const unsigned char* vs, int half, int r32, int hi) {
    LAS const unsigned char* vb = vs + hi * 2048 + r32 * 16 + half * 1024;
#pragma unroll
    for (int h2 = 0; h2 < 2; ++h2)
#pragma unroll
        for (int s = 0; s < 4; ++s) va[h2 * 4 + s] = *(LAS const bf16x8*)(vb + s * 4096 + h2 * 512);
}
__device__ __forceinline__ void firstSM(f32x16& p0, f32x16& p1, f32x16& nm, float& alpha, float& ps0) {
    float pmax = fmaxf(p0[0], p1[0]);
#pragma unroll
    for (int r = 1; r < 16; ++r) pmax = fmaxf(pmax, fmaxf(p0[r], p1[r]));
    { const auto rr = __builtin_amdgcn_permlane32_swap(__float_as_uint(pmax), __float_as_uint(pmax), false, false); pmax = fmaxf(__uint_as_float(rr[0]), __uint_as_float(rr[1])); }
    alpha = 1.f;
    const float nmm = -pmax;
#pragma unroll
    for (int r = 0; r < 16; ++r) nm[r] = nmm;
    float s = 0.f;
#pragma unroll
    for (int r = 0; r < 16; ++r) { p0[r] = __builtin_amdgcn_exp2f(p0[r] + nmm); s += p0[r]; p1[r] += nmm; }
    ps0 = s;
}
__device__ __forceinline__ void blk1(f32x16& q0, f32x16& q1, const f32x16& nm, LAS const unsigned char* ks, const bf16x8 (&qf)[4],
                                     f32x16& f0, f32x16& f1, float alf, float psf, float& l, bf16x8 (&pf)[4], int r32, int hi) {
    bf16x8 kf[8]; qkt_load(kf, ks, r32, hi);
    __builtin_amdgcn_sched_barrier(0);
    float s1 = psf;
#pragma unroll
    for (int r = 0; r < 4; ++r) { f1[r] = __builtin_amdgcn_exp2f(f1[r]); s1 += f1[r]; }
    pf[0] = pack8(f0, 0);
    asm volatile("" : "+v"(s1));
    __builtin_amdgcn_sched_barrier(0);
#pragma unroll
    for (int kk = 0; kk < 4; ++kk) {
        if (kk == 0) { q0 = __builtin_amdgcn_mfma_f32_32x32x16_bf16(kf[0], qf[0], nm, 0, 0, 0); q1 = __builtin_amdgcn_mfma_f32_32x32x16_bf16(kf[1], qf[0], nm, 0, 0, 0); }
        else { q0 = __builtin_amdgcn_mfma_f32_32x32x16_bf16(kf[2 * kk], qf[kk], q0, 0, 0, 0); q1 = __builtin_amdgcn_mfma_f32_32x32x16_bf16(kf[2 * kk + 1], qf[kk], q1, 0, 0, 0); }
#pragma unroll
        for (int r = 4 + 3 * kk; r < 7 + 3 * kk; ++r) { f1[r] = __builtin_amdgcn_exp2f(f1[r]); s1 += f1[r]; }
        if (kk == 0) pf[1] = pack8(f0, 8);
        if (kk == 1) pf[2] = pack8(f1, 0);
        if (kk == 3) { pf[3] = pack8(f1, 8); l = l * alf + s1; asm volatile("" : "+v"(l)); }
        else asm volatile("" : "+v"(s1));
        __builtin_amdgcn_sched_barrier(0);
    }
}
__device__ __forceinline__ float blk2a(f32x16& oa, f32x16& ob, bf16x8 (&vn)[8], LAS const unsigned char* vs, const bf16x8 (&pf)[4], const f32x16& q0, const f32x16& q1, int r32, int hi) {
    bf16x8 va[8]; v_load(va, vs, 0, r32, hi);
    int x = __float_as_int(q0[0]), y = __float_as_int(q1[0]);
#pragma unroll
    for (int r = 1; r < 15; r += 2) { x = max(max(x, __float_as_int(q0[r])), __float_as_int(q0[r + 1])); y = max(max(y, __float_as_int(q1[r])), __float_as_int(q1[r + 1])); }
    x = max(max(x, __float_as_int(q0[15])), max(y, __float_as_int(q1[15])));
    { const auto rr = __builtin_amdgcn_permlane32_swap((unsigned)x, (unsigned)x, false, false); x = max((int)rr[0], (int)rr[1]); }
#pragma unroll
    for (int s = 0; s < 4; ++s) { oa = __builtin_amdgcn_mfma_f32_32x32x16_bf16(va[s], pf[s], oa, 0, 0, 0); ob = __builtin_amdgcn_mfma_f32_32x32x16_bf16(va[4 + s], pf[s], ob, 0, 0, 0); }
    v_load(vn, vs, 1, r32, hi);
    ATT_SGB(0x100, 8); ATT_SGB(0x2, 4);
#pragma unroll
    for (int i = 0; i < 4; ++i) { ATT_SGB(0x8, 1); ATT_SGB(0x2, 2); }
    ATT_SGB(0x100, 8);
#pragma unroll
    for (int i = 0; i < 4; ++i) { ATT_SGB(0x8, 1); ATT_SGB(0x2, 3); }
    return __int_as_float(x);
}
__device__ __forceinline__ float blk2b(f32x16& oc, f32x16& od, const bf16x8 (&vn)[8], const bf16x8 (&pf)[4], f32x16& q0) {
    float s = 0.f;
#pragma unroll
    for (int r = 0; r < 16; ++r) { q0[r] = __builtin_amdgcn_exp2f(q0[r]); s += q0[r]; }
#pragma unroll
    for (int s_ = 0; s_ < 4; ++s_) { oc = __builtin_amdgcn_mfma_f32_32x32x16_bf16(vn[s_], pf[s_], oc, 0, 0, 0); od = __builtin_amdgcn_mfma_f32_32x32x16_bf16(vn[4 + s_], pf[s_], od, 0, 0, 0); }
#pragma unroll
    for (int i = 0; i < 8; ++i) { ATT_SGB(0x8, 1); ATT_SGB(0x402, 4); }
    asm volatile("" : "+v"(s));
    return s;
}
template <int VAR = 0>
__device__ __forceinline__ void unit(LAS unsigned char* lds, int b, int h, int qb, const bf16* QKP, const bf16* UVT, float lam, float lam_init, const float* subg, bf16* MIXB, float* stash, int wave, int lane, int c0 = 0, int c1 = 2) {
    lane = (int)mk_lane_id();
    const int r32 = lane & 31, hi = lane >> 5;
    if (wave == 0 && lane < 32) *(LAS f32x4*)(lds + ATT_SUBG + lane * 16) = *(const GAS f32x4*)(subg + lane * 4);
    if (wave >= 4) __builtin_amdgcn_s_setprio(1);
    const size_t tok0 = (size_t)b * S;
    constexpr int NT = S / 64;
#pragma unroll 1
    for (int cc = c0; cc < c1; ++cc) {
        const int c = cc & 1;
        bf16x8 qf[4];
        { const int lane_q = (int)mk_lane_id();
          const bf16* qp = QKP + (tok0 + qb * 256 + wave * 32 + (lane_q & 31)) * 1280 + h * 128 + c * 64 + (lane_q >> 5) * 8;
#pragma unroll
          for (int kk = 0; kk < 4; ++kk) qf[kk] = *(const GAS bf16x8*)(qp + kk * 16); }
        f32x16 o[4];
#pragma unroll
        for (int db = 0; db < 4; ++db)
#pragma unroll
            for (int r = 0; r < 16; ++r) o[db][r] = 0.f;
        float l = 0.f, alA, alB, psA, psB;
        f32x16 pA0, pA1, pB0, pB1, nm; bf16x8 pf[4];
        const char* kub = (const char*)(QKP + tok0 * 1280 + 512 + h * 128 + c * 64 + wave * 8);
        const char* vub = (const char*)(UVT + (size_t)(768 + h * 128) * M + tok0 + wave * 8);
        const unsigned kvo = (unsigned)lane * 2560u; unsigned vvo = (unsigned)lane * (unsigned)(M * 2);
#define ATT_DMA_K(t) __builtin_amdgcn_global_load_lds((const unsigned*)(kub + (size_t)(t) * (64 * 2560) + kvo), (LAS unsigned*)(lds + LDS_K + ((t) & 1) * KSLOT + wave * 1024), 16, 0, 0)
#define ATT_DMA_V(t) do { \
            __builtin_amdgcn_global_load_lds((const unsigned*)(vub + (size_t)(t) * 128 + vvo), (LAS unsigned*)(lds + LDS_V + ((t) & 1) * VSLOT + wave * 2048), 16, 0, 0); \
            __builtin_amdgcn_global_load_lds((const unsigned*)(vub + (size_t)64 * M * 2 + (size_t)(t) * 128 + vvo), (LAS unsigned*)(lds + LDS_V + ((t) & 1) * VSLOT + wave * 2048 + 1024), 16, 0, 0); } while (0)
#define SB() __builtin_amdgcn_sched_barrier(0)
#define ATT_SYNC() do { asm volatile("s_waitcnt vmcnt(0) lgkmcnt(0)" ::: "memory"); __builtin_amdgcn_s_barrier(); asm volatile("" ::: "memory"); } while (0)
#define ATT_DECIDE(pm_, al_, q0_, q1_) do { if (__builtin_expect(__all((pm_) <= THR2), 1)) al_ = 1.f; \
            else { const float d_ = fmaxf(pm_, 0.f); al_ = __builtin_amdgcn_exp2f(-d_); const float nd_ = -d_; nm += nd_; q0_ += nd_; q1_ += nd_; } } while (0)
#define ATT_STEP(q0_, q1_, alq_, psq_, ks_, f0_, f1_, alf_, psf_, vs_, LATE_DMA) do { \
            SB(); blk1(q0_, q1_, nm, ks_, qf, f0_, f1_, alf_, psf_, l, pf, r32, hi); SB(); \
            LATE_DMA; \
            { bf16x8 vn_[8]; const float pm_ = blk2a(o[0], o[1], vn_, vs_, pf, q0_, q1_, r32, hi); SB(); \
              ATT_DECIDE(pm_, alq_, q0_, q1_); SB(); \
              psq_ = blk2b(o[2], o[3], vn_, pf, q0_); SB(); } \
            resc(o, alq_); } while (0)
        const bool early = wave < 4;
        if (cc == c0) { ATT_SYNC();
                        ATT_DMA_K(0); ATT_DMA_V(0); }
        ATT_SYNC();
        ATT_DMA_K(1);
        qkt(pA0, pA1, lds + LDS_K, qf, r32, hi); firstSM(pA0, pA1, nm, alA, psA);
#pragma unroll 1
        for (int j = 1; j < NT - 1; j += 2) {
            ATT_SYNC(); if (early) { ATT_DMA_K(j + 1); ATT_DMA_V(j); }
            ATT_STEP(pB0, pB1, alB, psB, lds + LDS_K + KSLOT, pA0, pA1, alA, psA, lds + LDS_V, if (!early) { ATT_DMA_K(j + 1); ATT_DMA_V(j); });
            ATT_SYNC(); if (early) { ATT_DMA_K(j + 2); ATT_DMA_V(j + 1); }
            ATT_STEP(pA0, pA1, alA, psA, lds + LDS_K, pB0, pB1, alB, psB, lds + LDS_V + VSLOT, if (!early) { ATT_DMA_K(j + 2); ATT_DMA_V(j + 1); });
        }
        asm volatile("" : "+v"(vvo));
        ATT_SYNC(); ATT_DMA_V(NT - 1);
        ATT_STEP(pB0, pB1, alB, psB, lds + LDS_K + KSLOT, pA0, pA1, alA, psA, lds + LDS_V, (void)0);
        ATT_SYNC();
        { float s1 = psB;
#pragma unroll
          for (int r = 0; r < 16; ++r) { pB1[r] = __builtin_amdgcn_exp2f(pB1[r]); s1 += pB1[r]; }
          l = l * alB + s1;
          pf[0] = pack8(pB0, 0); pf[1] = pack8(pB0, 8); pf[2] = pack8(pB1, 0); pf[3] = pack8(pB1, 8); }
        pv(o, lds + LDS_V + VSLOT, pf, r32, hi);
        if (cc + 1 < c1) {
            ATT_SYNC();
            __builtin_amdgcn_global_load_lds((const unsigned*)(kub + 128 + kvo), (LAS unsigned*)(lds + LDS_K + wave * 1024), 16, 0, 0);
            ATT_DMA_V(0); }
#undef ATT_DECIDE
#undef ATT_STEP
#undef ATT_DMA_K
#undef ATT_DMA_V
#undef ATT_SYNC
#undef SB
        const float lt = xsum32(l);
        const int lane_e = (int)mk_lane_id();
        const int hi_e = lane_e >> 5; const size_t qtok_e = tok0 + qb * 256 + wave * 32 + (lane_e & 31);
        if (cc >= 2) {
            if (lam == 123456.f) { for (int db = 0; db < 4; ++db) for (int r = 0; r < 16; ++r) stash[(db * 16 + r) * 64 + lane_e] = o[db][r] + lt; }
        } else if (c == 0) {
            const float i1 = 1.f / lt;
#pragma unroll
            for (int db = 0; db < 4; ++db)
#pragma unroll
                for (int g4 = 0; g4 < 4; ++g4) { const f32x4 v4 = (f32x4){o[db][4 * g4] * i1, o[db][4 * g4 + 1] * i1, o[db][4 * g4 + 2] * i1, o[db][4 * g4 + 3] * i1};
                    if (db < 2) *(LAS f32x4*)(lds + ATT_LDS + wave * 8192 + ((db * 4 + g4) * 64 + lane_e) * 16) = v4;
                    else if (db == 2) *(LAS f32x4*)(lds + ATT_PARK2(wave) + (g4 * 64 + lane_e) * 16) = v4;
                    else *(GAS f32x4*)(stash + ((db * 4 + g4) * 64 + lane_e) * 4) = v4; }
        } else {
            const float i2 = lam / lt;
            float ss = 0.f;
#pragma unroll
            for (int db = 0; db < 4; ++db)
#pragma unroll
                for (int g4 = 0; g4 < 4; ++g4) { const f32x4 s1 = db < 2 ? *(LAS const f32x4*)(lds + ATT_LDS + wave * 8192 + ((db * 4 + g4) * 64 + lane_e) * 16) : (db == 2 ? *(LAS const f32x4*)(lds + ATT_PARK2(wave) + (g4 * 64 + lane_e) * 16) : *(const GAS f32x4*)(stash + ((db * 4 + g4) * 64 + lane_e) * 4));
#pragma unroll
                    for (int i = 0; i < 4; ++i) { const float v = s1[i] - o[db][4 * g4 + i] * i2; o[db][4 * g4 + i] = v; ss += v * v; } }
            ss = xsum32(ss);
            const float rs = (1.f - lam_init) / sqrtf(ss * (1.f / 128.f) + 1e-5f);
            bf16* orow = MIXB + qtok_e * D + 256 + h * 128;
#pragma unroll
            for (int db = 0; db < 4; ++db)
#pragma unroll
                for (int k2 = 0; k2 < 2; ++k2) {
                    unsigned wq[2][2];
#pragma unroll
                    for (int q = 0; q < 2; ++q) { const int g4 = 2 * k2 + q, e = 32 * db + 8 * g4 + 4 * hi_e; const f32x4 gg = *(LAS const f32x4*)(lds + ATT_SUBG + e * 4);
                        wq[q][0] = pg8::cvt_pk_bf16(o[db][4 * g4] * rs * gg.x, o[db][4 * g4 + 1] * rs * gg.y); wq[q][1] = pg8::cvt_pk_bf16(o[db][4 * g4 + 2] * rs * gg.z, o[db][4 * g4 + 3] * rs * gg.w); }
                    const auto r0 = __builtin_amdgcn_permlane32_swap(wq[0][0], wq[1][0], false, false), r1 = __builtin_amdgcn_permlane32_swap(wq[0][1], wq[1][1], false, false);
                    v4u w; w.x = r0[0]; w.y = r1[0]; w.z = r0[1]; w.w = r1[1];
                    *(GAS v4u*)(orow + 32 * db + 8 * (2 * k2 + hi_e)) = w; }
        }
    }
    __builtin_amdgcn_s_setprio(0);
}
}
namespace hy {
typedef float f32x16 __attribute__((ext_vector_type(16)));
constexpr int CPY = 16456;
constexpr int VJ = 65, VK8 = VJ * 64;
constexpr int LDS_F = 0, LDS_VV = 4 * CPY, LDS_END = LDS_VV + 8 * VK8;
static_assert(LDS_VV % 16 == 0 && LDS_END <= 131072, "hyena LDS map");

__device__ __forceinline__ void filter_item(LAS unsigned char* lds, int pb, const float* fw1, const float* fb1, const float* fr1, const float* fw2, const float* fb2, const float* fr2,
                                            const float* fw3, bf16* KF, float* PS, int wave, int lane) {
    LAS bf16* tile = (LAS bf16*)lds;
    LAS float* za = (LAS float*)(lds + 65536) + wave * 512;
    LAS float* zb = (LAS float*)(lds + 81920) + wave * 512;
    LAS float* sqs = (LAS float*)(lds + 98304);
    const int p0 = pb * 64 + wave * 8;
    if (lane < 33) {
#pragma unroll 1
        for (int pi = 0; pi < 8; ++pi) { const int p = p0 + pi; float z;
            if (lane == 0) z = (float)p / (float)(S - 1);
            else { const int bi = (lane - 1) & 15; const float band = 1e-4f + (float)bi * ((15.0f - 1e-4f) / 15.0f), wpos = 2.0f * 3.14159265358979323846f * (float)p / (float)S;
                   z = lane <= 16 ? cosf(wpos * band) : -sinf(wpos * band); }
            za[pi * 64 + lane] = z; }
    }
    LDS_WAIT(); asm volatile("" ::: "memory");
    float acc8[8];
    { const float b1 = fb1[lane];
#pragma unroll
      for (int pi = 0; pi < 8; ++pi) acc8[pi] = b1;
#pragma unroll 1
      for (int i0 = 0; i0 < 33; i0 += 11) { float w[11];
#pragma unroll
          for (int k = 0; k < 11; ++k) w[k] = fw1[(i0 + k) * 64 + lane];
#pragma unroll
          for (int k = 0; k < 11; ++k)
#pragma unroll
              for (int pi = 0; pi < 8; ++pi) acc8[pi] += za[pi * 64 + i0 + k] * w[k]; }
      const float f1 = fr1[lane];
#pragma unroll
      for (int pi = 0; pi < 8; ++pi) zb[pi * 64 + lane] = sinf(f1 * acc8[pi]); }
    LDS_WAIT(); asm volatile("" ::: "memory");
    { const float b2 = fb2[lane];
#pragma unroll
      for (int pi = 0; pi < 8; ++pi) acc8[pi] = b2;
#pragma unroll 1
      for (int i0 = 0; i0 < 64; i0 += 16) { float w[16];
#pragma unroll
          for (int k = 0; k < 16; ++k) w[k] = fw2[(i0 + k) * 64 + lane];
#pragma unroll
          for (int k = 0; k < 16; ++k)
#pragma unroll
              for (int pi = 0; pi < 8; ++pi) acc8[pi] += zb[pi * 64 + i0 + k] * w[k]; }
      const float f2 = fr2[lane];
      LDS_WAIT(); asm volatile("" ::: "memory");
#pragma unroll
      for (int pi = 0; pi < 8; ++pi) za[pi * 64 + lane] = sinf(f2 * acc8[pi]); }
    LDS_WAIT(); asm volatile("" ::: "memory");
    const float mind = logf(1e-2f) / 1.5f, maxd = logf(1e-2f) / 0.3f;
#pragma unroll 1
    for (int qh = 0; qh < 2; ++qh) {
        float ac[8][4];
#pragma unroll
        for (int pi = 0; pi < 8; ++pi)
#pragma unroll
            for (int q = 0; q < 4; ++q) ac[pi][q] = 0.f;
#pragma unroll 1
        for (int i0 = 0; i0 < 64; i0 += 8) { float w[8][4];
#pragma unroll
            for (int k = 0; k < 8; ++k)
#pragma unroll
                for (int q = 0; q < 4; ++q) w[k][q] = fw3[(i0 + k) * 512 + lane + 64 * (qh * 4 + q)];
#pragma unroll
            for (int k = 0; k < 8; ++k)
#pragma unroll
                for (int pi = 0; pi < 8; ++pi) { const float hv = za[pi * 64 + i0 + k];
#pragma unroll
                    for (int q = 0; q < 4; ++q) ac[pi][q] += hv * w[k][q]; } }
#pragma unroll
        for (int q = 0; q < 4; ++q) { const int col = lane + 64 * (qh * 4 + q), ch = col & 255; const float delta = fabsf(mind + (float)ch * ((maxd - mind) / 255.0f)); float sq = 0.f;
#pragma unroll
            for (int pi = 0; pi < 8; ++pi) { const int p = p0 + pi; const float val = ac[pi][q] * expf(-((float)p / (float)(S - 1)) * delta);
                if (!(col >= 256 && p == 0)) sq += val * val;
                tile[col * 64 + wave * 8 + pi] = (bf16)f2bf(val); }
            sqs[wave * 512 + col] = sq; }
    }
    LDS_WAIT(); __syncthreads();
    { const int p = pb * 64 + lane;
#pragma unroll 1
      for (int cc = 0; cc < 64; ++cc) { const int col = wave * 64 + cc; const bf16 v = tile[col * 64 + lane];
          if (col < 256) KF[(size_t)col * 8192 + 4095 - p] = v; else if (p != 0) KF[(size_t)(col - 256) * 8192 + 4095 + p] = v; } }
    { const int t = wave * 64 + lane; float s = 0.f;
#pragma unroll
      for (int w = 0; w < 8; ++w) s += sqs[w * 512 + t];
      PS[(size_t)pb * 512 + t] = s;
      if (pb == 0 && t < 256) KF[(size_t)t * 8192 + 8191] = 0; }
    LDS_WAIT(); __syncthreads();
}

__device__ __forceinline__ float conv1(float um, float u0, float up, float w0, float w1, float w2, float cb) { return um * w0 + u0 * w1 + up * w2 + cb; }

__device__ __forceinline__ void unit(LAS unsigned char* lds, int c, const bf16* KF, const float* PS, const bf16* UVT, const float* cw, const float* cb, const float* bias_d, bf16* HT, int wave, int lane) {
    lane = (int)mk_lane_id(); asm volatile("" : "+s"(wave));
    const int tid = wave * 64 + lane;
    { const bf16* src = KF + (size_t)c * 8192;
#pragma unroll
      for (int i = 0; i < 2; ++i) { const int ch = tid + 512 * i; *(LAS v4u*)(lds + LDS_F + ch * 16) = *(const GAS v4u*)(src + ch * 8); } }
    { const float w0v = cw[512 + c], w1v = cw[768 + 512 + c], w2v = cw[1536 + 512 + c], cbv = cb[512 + c], w0x = cw[256 + c], w1x = cw[768 + 256 + c], w2x = cw[1536 + 256 + c], cbx = cb[256 + c];
      const bf16* rv = UVT + (size_t)(512 + c) * M; const bf16* rx = UVT + (size_t)(256 + c) * M;
#pragma unroll
      for (int i = 0; i < 4; ++i) { const int q = tid + 512 * i, b = q >> 9, sc = q & 511, s0 = sc * 8; const size_t g0 = (size_t)b * S + s0;
          const v4u av = *(const GAS v4u*)(rv + g0), ax = *(const GAS v4u*)(rx + g0);
          float uv[10], ux[10];
          uv[0] = s0 > 0 ? bf2f(rv[g0 - 1]) : 0.f; ux[0] = s0 > 0 ? bf2f(rx[g0 - 1]) : 0.f; uv[9] = s0 + 8 < S ? bf2f(rv[g0 + 8]) : 0.f; ux[9] = s0 + 8 < S ? bf2f(rx[g0 + 8]) : 0.f;
#pragma unroll
          for (int e = 0; e < 4; ++e) { uv[1 + 2 * e] = bf2f((bf16)av[e]); uv[2 + 2 * e] = bf2f((bf16)(av[e] >> 16)); ux[1 + 2 * e] = bf2f((bf16)ax[e]); ux[2 + 2 * e] = bf2f((bf16)(ax[e] >> 16)); }
          float o[8];
#pragma unroll
          for (int e = 0; e < 8; ++e) o[e] = conv1(uv[e], uv[e + 1], uv[e + 2], w0v, w1v, w2v, cbv) * conv1(ux[e], ux[e + 1], ux[e + 2], w0x, w1x, w2x, cbx);
          v4u w; w.x = pk2(o[0], o[1]); w.y = pk2(o[2], o[3]); w.z = pk2(o[4], o[5]); w.w = pk2(o[6], o[7]);
          *(LAS v4u*)(lds + LDS_VV + (((sc & 7) * VJ + (sc >> 3)) * 4 + b) * 16) = w; }
      if (tid < 32) { unsigned z_; asm volatile("v_mov_b32 %0, 0" : "=v"(z_)); *(LAS v4u*)(lds + LDS_VV + (((tid >> 2) * VJ + 64) * 4 + (tid & 3)) * 16) = (v4u){z_, z_, z_, z_}; } }
    LDS_WAIT(); __syncthreads();
    {
#pragma unroll 1
      for (int i = 0; i < 4; ++i) { const int y = tid + 512 * i;
          const unsigned long long w0 = *(LAS const unsigned long long*)(lds + LDS_F + y * 8), w1 = *(LAS const unsigned long long*)(lds + LDS_F + y * 8 + 8);
#pragma unroll
          for (int p = 1; p < 4; ++p) *(LAS unsigned long long*)(lds + LDS_F + p * CPY + y * 8) = (w0 >> (16 * p)) | (w1 << (64 - 16 * p)); } }
    const float nrm = 1.0f / sqrtf(wave_sum(PS[(size_t)lane * 512 + c] + PS[(size_t)lane * 512 + 256 + c]) + 1e-6f);
    LDS_WAIT(); __syncthreads();
    const int r32 = lane & 31, hi = lane >> 5, gp = wave & 3, half = wave >> 2, iloc = r32 >> 2, b = r32 & 3;
    f32x16 acc[2][2];
#pragma unroll
    for (int rho = 0; rho < 2; ++rho)
#pragma unroll
        for (int gg = 0; gg < 2; ++gg)
#pragma unroll
            for (int r = 0; r < 16; ++r) acc[rho][gg][r] = 0.f;
    const int dlo = 16 * gp - 63 + (half ? 40 : 0), dn = half ? 39 : 40;
    int pa = LDS_F + (3 - (r32 & 3)) * CPY + (4092 - 4 * (r32 >> 2) + 8 * hi) * 2 - 64 - 128 * dlo;
    int jb = 16 * gp + iloc - dlo;
    const int pbase = LDS_VV + hi * VK8 + b * 16;
    typedef unsigned long long u64;
    struct Frag { u64 a[4][4]; v4u b[4][2]; };
#define HY_LOAD(F) do { const int j0_ = jb, j1_ = jb + 8; LAS const unsigned char* ap_ = lds + pa; \
        LAS const unsigned char* bp0_ = lds + pbase + ((unsigned)j0_ < 64u ? j0_ : 64) * 64; LAS const unsigned char* bp1_ = lds + pbase + ((unsigned)j1_ < 64u ? j1_ : 64) * 64; \
        _Pragma("unroll") for (int k = 0; k < 4; ++k) { F.a[k][0] = *(LAS const u64*)(ap_ + 64 + 32 * k); F.a[k][1] = *(LAS const u64*)(ap_ + 64 + 32 * k + 8); F.a[k][2] = *(LAS const u64*)(ap_ + 32 * k); F.a[k][3] = *(LAS const u64*)(ap_ + 32 * k + 8); \
            F.b[k][0] = *(LAS const v4u*)(bp0_ + k * (2 * VK8)); F.b[k][1] = *(LAS const v4u*)(bp1_ + k * (2 * VK8)); } \
        pa -= 128; jb -= 1; } while (0)
#define HY_MMA(F) do { _Pragma("unroll") for (int k = 0; k < 4; ++k) { \
            const bf16x8 fa0 = __builtin_bit_cast(bf16x8, (v4u){(unsigned)F.a[k][0], (unsigned)(F.a[k][0] >> 32), (unsigned)F.a[k][1], (unsigned)(F.a[k][1] >> 32)}); \
            const bf16x8 fa1 = __builtin_bit_cast(bf16x8, (v4u){(unsigned)F.a[k][2], (unsigned)(F.a[k][2] >> 32), (unsigned)F.a[k][3], (unsigned)(F.a[k][3] >> 32)}); \
            const bf16x8 fb0 = __builtin_bit_cast(bf16x8, F.b[k][0]), fb1 = __builtin_bit_cast(bf16x8, F.b[k][1]); \
            acc[0][0] = __builtin_amdgcn_mfma_f32_32x32x16_bf16(fa0, fb0, acc[0][0], 0, 0, 0); acc[0][1] = __builtin_amdgcn_mfma_f32_32x32x16_bf16(fa0, fb1, acc[0][1], 0, 0, 0); \
            acc[1][0] = __builtin_amdgcn_mfma_f32_32x32x16_bf16(fa1, fb0, acc[1][0], 0, 0, 0); acc[1][1] = __builtin_amdgcn_mfma_f32_32x32x16_bf16(fa1, fb1, acc[1][1], 0, 0, 0); } } while (0)
#define HY_MIX() do { _Pragma("unroll") for (int i_ = 0; i_ < 8; ++i_) { __builtin_amdgcn_sched_group_barrier(0x100, 3, 0); __builtin_amdgcn_sched_group_barrier(0x8, 2, 0); } } while (0)
    Frag FA, FB;
    HY_LOAD(FA);
    int dd = 0;
#pragma unroll 1
    for (; dd + 2 <= dn; dd += 2) {
        HY_LOAD(FB); HY_MMA(FA); HY_MIX();
        if (dd + 2 < dn) { HY_LOAD(FA); HY_MMA(FB); HY_MIX(); } else { HY_MMA(FB); }
    }
    if (dd < dn) HY_MMA(FA);
#undef HY_MIX
#undef HY_LOAD
#undef HY_MMA
    const int lane_b = (int)mk_lane_id(), r32_b = lane_b & 31, hi_b = lane_b >> 5, iloc_b = r32_b >> 2, b_b = r32_b & 3;
    LDS_WAIT(); __syncthreads();
    { LAS float* xw = (LAS float*)(lds + LDS_F) + (gp * 2 + (half ? 0 : 1)) * 2048 + lane_b;
#pragma unroll
      for (int gg = 0; gg < 2; ++gg)
#pragma unroll
          for (int r = 0; r < 16; ++r) xw[(gg * 16 + r) * 64] = half ? acc[0][gg][r] : acc[1][gg][r]; }
    LDS_WAIT(); __syncthreads();
    f32x16 fin[2];
    { LAS const float* xr = (LAS const float*)(lds + LDS_F) + (gp * 2 + (half ? 1 : 0)) * 2048 + lane_b;
#pragma unroll
      for (int gg = 0; gg < 2; ++gg)
#pragma unroll
          for (int r = 0; r < 16; ++r) fin[gg][r] = (half ? acc[1][gg][r] : acc[0][gg][r]) + xr[(gg * 16 + r) * 64]; }
    { const float bd = bias_d[c], w0 = cw[c], w1 = cw[768 + c], w2 = cw[1536 + c], cb0 = cb[c]; const bf16* r0p = UVT + (size_t)c * M; bf16* hrow = HT + (size_t)c * M;
#pragma unroll
      for (int gg = 0; gg < 2; ++gg) { const int i = 16 * gp + 8 * gg + iloc_b, tf = 64 * i + 32 * half; const size_t tb = (size_t)b_b * S + tf;
          v4u xw[4];
#pragma unroll
          for (int g4 = 0; g4 < 4; ++g4) xw[g4] = *(const GAS v4u*)(r0p + tb + 8 * g4);
          const float hl = tf > 0 ? bf2f(r0p[tb - 1]) : 0.f, hr = tf + 32 < S ? bf2f(r0p[tb + 32]) : 0.f;
          unsigned wq[4][2];
#pragma unroll
          for (int g4 = 0; g4 < 4; ++g4) { const int rr = 32 * half + 8 * g4 + 4 * hi_b;
              const unsigned long long vw = *(LAS const unsigned long long*)(lds + LDS_VV + (((rr >> 3) * VJ + i) * 4 + b_b) * 16 + (rr & 7) * 2);
              const v4u x = xw[g4];
              float u[6];
              if (hi_b) { u[0] = bf2f((bf16)(x.y >> 16)); u[1] = bf2f((bf16)x.z); u[2] = bf2f((bf16)(x.z >> 16)); u[3] = bf2f((bf16)x.w); u[4] = bf2f((bf16)(x.w >> 16));
                          u[5] = g4 < 3 ? bf2f((bf16)xw[g4 < 3 ? g4 + 1 : 3].x) : hr; }
              else { u[0] = g4 > 0 ? bf2f((bf16)(xw[g4 > 0 ? g4 - 1 : 0].w >> 16)) : hl; u[1] = bf2f((bf16)x.x); u[2] = bf2f((bf16)(x.x >> 16)); u[3] = bf2f((bf16)x.y); u[4] = bf2f((bf16)(x.y >> 16));
                     u[5] = bf2f((bf16)x.z); }
              float o[4];
#pragma unroll
              for (int e = 0; e < 4; ++e) { const float vv = bf2f((bf16)(vw >> (16 * e))); o[e] = (nrm * fin[gg][4 * g4 + e] + vv * bd) * conv1(u[e], u[e + 1], u[e + 2], w0, w1, w2, cb0); }
              wq[g4][0] = pk2(o[0], o[1]); wq[g4][1] = pk2(o[2], o[3]); }
#pragma unroll
          for (int k2 = 0; k2 < 2; ++k2) {
              const auto r0 = __builtin_amdgcn_permlane32_swap(wq[2 * k2][0], wq[2 * k2 + 1][0], false, false), r1 = __builtin_amdgcn_permlane32_swap(wq[2 * k2][1], wq[2 * k2 + 1][1], false, false);
              v4u w; w.x = r0[0]; w.y = r1[0]; w.z = r0[1]; w.w = r1[1];
              *(GAS v4u*)(hrow + tb + 8 * (2 * k2 + hi_b)) = w; } } }
    LDS_WAIT(); __syncthreads();
}
__device__ __forceinline__ void transpose_slab(LAS unsigned char* lds, int slab, const bf16* HT, bf16* MIXB, int wave, int lane) {
    const int tid = wave * 64 + lane; LAS bf16* tile = (LAS bf16*)lds;
    v4u win[4];
#pragma unroll
    for (int i = 0; i < 4; ++i) { const int q = tid + 512 * i, c = q >> 3, tc = q & 7; win[i] = *(const GAS v4u*)(HT + (size_t)c * M + (size_t)slab * 64 + tc * 8); }
#pragma unroll
    for (int i = 0; i < 4; ++i) { const int q = tid + 512 * i, c = q >> 3, tc = q & 7; const v4u w = win[i];
#pragma unroll
        for (int e = 0; e < 4; ++e) { tile[(tc * 8 + 2 * e) * 264 + c] = (bf16)w[e]; tile[(tc * 8 + 2 * e + 1) * 264 + c] = (bf16)(w[e] >> 16); } }
    LDS_WAIT(); __syncthreads();
#pragma unroll 1
    for (int i = 0; i < 4; ++i) { const int q = tid + 512 * i, tk = q >> 5, cc = q & 31;
        *(GAS v4u*)(MIXB + ((size_t)slab * 64 + tk) * D + cc * 8) = *(LAS const v4u*)(lds + (tk * 264 + cc * 8) * 2); }
    LDS_WAIT(); __syncthreads();
}
}
#ifndef DUP_PRO
#define DUP_PRO 1
#endif
#ifndef DUP_IN
#define DUP_IN 1
#endif
#ifndef DUP_HY
#define DUP_HY 1
#endif
#ifndef DUP_POOL
#define DUP_POOL 1
#endif
#ifndef DUP_HYT
#define DUP_HYT 1
#endif
#ifndef DUP_ATT
#define DUP_ATT 1
#endif
#ifndef DUP_OUT
#define DUP_OUT 1
#endif
#ifndef DUP_LN1
#define DUP_LN1 1
#endif
#ifndef DUP_MOE1
#define DUP_MOE1 1
#endif
#ifndef DUP_MOE2
#define DUP_MOE2 1
#endif
#ifndef DUP_LN2
#define DUP_LN2 1
#endif
#ifndef EN_HY
#define EN_HY 1
#endif
#ifndef EN_HYT
#define EN_HYT 1
#endif
#ifndef EN_PRO
#define EN_PRO 1
#endif
#ifndef EN_IN
#define EN_IN 1
#endif
#ifndef EN_ATT
#define EN_ATT 1
#endif
#ifndef EN_POOL
#define EN_POOL 1
#endif
#ifndef EN_OUT
#define EN_OUT 1
#endif
#ifndef EN_LN1
#define EN_LN1 1
#endif
#ifndef EN_WCV
#define EN_WCV 1
#endif
#ifndef EN_MOE1
#define EN_MOE1 1
#endif
#ifndef EN_MOE2
#define EN_MOE2 1
#endif
#ifndef EN_LN2
#define EN_LN2 1
#endif
constexpr int RING_BYTES = 135168;
static_assert(att::ATT_SUBG == 137216 + 3 * 4096 && att::ATT_SUBG + 512 <= 151552, "attention gain table no longer fits the LDS map");
static_assert(att::ATT_LDS + 65536 + 5 * 4096 == RING_BYTES && RING_BYTES + 2048 == 137216, "attention parking regions (ATT_PARK2) no longer match the LDS map");
constexpr int LDSCTL_OFF = RING_BYTES, MISC_OFF = LDSCTL_OFF + 320, MOETAB_OFF = LDSCTL_OFF + 1024, ROUTE_OFF = LDSCTL_OFF + 2048;
constexpr int LDS_BYTES = 151552;

struct Args { const float* in[38]; float* out; unsigned char* ws; int* eid; float* wts; int ph_lo, ph_hi, l_lo, l_hi, single, pad; };
enum { PH_PRO = 0, PH_IN = 1, PH_ATT = 2, PH_POOL = 3, PH_OUT = 4, PH_LN1 = 5, PH_WCV = 6, PH_MOE1 = 7, PH_MOE2 = 8, PH_LN2 = 9, PH_HY = 10, PH_HYT = 11, PH_END = 12 };

__global__ void __launch_bounds__(NWAVES * 64, 2) mk_fwd(Args a) {
    extern __shared__ __attribute__((aligned(16))) unsigned char lds_raw[];
    LAS unsigned char* lds = (LAS unsigned char*)lds_raw;
    volatile LAS unsigned* MISC = (volatile LAS unsigned*)(lds + MISC_OFF);
    const int wave_s = __builtin_amdgcn_readfirstlane((int)threadIdx.x >> 6);
    const int G = gridDim.x, bx = blockIdx.x, vcu0 = (G % 8 == 0) ? (bx % 8) * (G / 8) + bx / 8 : bx;
    gu32* ctl0 = (gu32*)(a.ws + WS_CTL);
    for (int u = wave_s * 64 + (int)mk_lane_id(); u < (LDS_BYTES - LDSCTL_OFF) / 4; u += NWAVES * 64) ((LAS unsigned*)(lds + LDSCTL_OFF))[u] = 0u;
    __syncthreads();
    XcdBarrier bar; bar.bar = (unsigned*)(ctl0 + CW_BAR); bar.x = 0; bar.st = nullptr;
#if defined(MK_PER_PHASE)
    if (!a.single)
#endif
    bar = xcd_barrier_post((unsigned*)(ctl0 + CW_BAR), MISC + 8, wave_s);
#if defined(MK_PER_PHASE)
#define IN(k) (a.ph_lo <= (k) && (k) < a.ph_hi)
#define SEAM() do { if (!a.single) xcd_barrier(bar, wave_s); } while (0)
#else
#define IN(k) 1
#if defined(PROBE_BAR2)
#define SEAM() do { xcd_barrier(bar, wave_s); xcd_barrier(bar, wave_s); } while (0)
#else
#define SEAM() xcd_barrier(bar, wave_s)
#endif
#endif
    const int NGW = G * NWAVES;
#define PHASE_PTRS() int lane_ = (int)mk_lane_id(); asm volatile("" : "+v"(lane_)); const int lane = lane_, wave = wave_s; int vcu = vcu0; asm volatile("" : "+s"(vcu)); (void)wave; const int gw = vcu * NWAVES + wave; (void)gw; unsigned char* ws = a.ws; gu32* ctl = (gu32*)(ws + WS_CTL); (void)ctl; \
    bf16* XB = (bf16*)(ws + WS_XB); bf16* QKP = (bf16*)(ws + WS_QKP); bf16* UVT = (bf16*)(ws + WS_UVT); float* CS = (float*)(ws + WS_CS); bf16* MIXB = (bf16*)(ws + WS_MIXB); \
    (void)XB; (void)QKP; (void)UVT; (void)CS; (void)MIXB
#define INP(k) (a.in[k])
#define WCV_SPLIT_IT 3730
#define WCV_SPLIT_PB ((size_t)M * 256 / 16 * 9)
#define WCV_LAYER(LEXPR, GW_, NGW_, IT0_, IT1_, PB0_, PB1_) do { const int wl_ = (LEXPR), wg_ = (GW_), wn_ = (NGW_); const int l = wl_, gw = wg_, NGW = wn_; (void)NGW; const int it0_ = (IT0_), it1_ = (IT1_); const size_t pb0_ = (PB0_), pb1_ = (PB1_); \
            LAS float* scr = (LAS float*)(lds + wave * 16384); \
            unsigned char* wb_ = ws + WS_WBUF + (size_t)(l & 1) * WBUF_STRIDE; bf16* W13 = (bf16*)(wb_ + WB_W13); bf16* W2 = (bf16*)(wb_ + WB_W2); bf16* WG = (bf16*)(wb_ + WB_WG); bf16* WP = (bf16*)(wb_ + WB_WP); \
            for (int it = it0_ + gw; it < it1_; it += NGW) { \
                const float* src; int K, N, k0, n0, mode = 0; bf16* dst; \
                if (it < 4096) { const int which = it >> 11, r = it & 2047, e = r >> 7, kb = (r >> 3) & 15, nb = r & 7; \
                    src = INP(which ? 31 : 30) + ((size_t)l * 16 + e) * D * 256; K = D; N = 256; k0 = kb * 64; n0 = nb * 32; mode = 1 + which; dst = W13 + (size_t)e * 512 * D; \
                } else if (it < 6144) { const int r = it - 4096, e = r >> 7, kb = (r >> 5) & 3, nb = r & 31; \
                    src = INP(32) + ((size_t)l * 16 + e) * 256 * D; K = 256; N = D; k0 = kb * 64; n0 = nb * 32; dst = W2 + (size_t)e * D * 256 + (size_t)n0 * 256; \
                } else if (it < 6656) { const int r = it - 6144, kb = r >> 5, nb = r & 31; \
                    src = INP(33) + (size_t)l * D * D; K = D; N = D; k0 = kb * 64; n0 = nb * 32; dst = WG + (size_t)n0 * D; \
                } else { const int r = it - 6656, kb = r >> 5, nb = r & 31; \
                    src = INP(35) + (size_t)l * 256 * D; K = 256; N = D; k0 = kb * 64; n0 = nb * 32; dst = WP + (size_t)n0 * 256; } \
                p0_transpose_block(src, K, N, k0, n0, dst, mode, scr, lane); \
            } \
            const int ln = lane; \
            const float* ps = INP(1) + (size_t)l * M * 256; bf16* PB = (bf16*)(wb_ + WB_PB); \
            const size_t pst_ = (size_t)NGW * 64 * 8; \
            for (size_t i = pb0_ + ((size_t)gw * 64 + ln) * 8; i < pb1_; i += 4 * pst_) {        \
                const size_t i1 = i + pst_, i2 = i + 2 * pst_, i3 = i + 3 * pst_; const bool k1 = i1 < pb1_, k2 = i2 < pb1_, k3 = i3 < pb1_; \
                const f32x4 z4_ = {0.f, 0.f, 0.f, 0.f}; \
                const f32x4 a0 = __builtin_nontemporal_load((const GAS f32x4*)(ps + i)), a1 = __builtin_nontemporal_load((const GAS f32x4*)(ps + i + 4)); \
                const f32x4 b0 = k1 ? __builtin_nontemporal_load((const GAS f32x4*)(ps + i1)) : z4_, b1 = k1 ? __builtin_nontemporal_load((const GAS f32x4*)(ps + i1 + 4)) : z4_; \
                const f32x4 c0 = k2 ? __builtin_nontemporal_load((const GAS f32x4*)(ps + i2)) : z4_, c1 = k2 ? __builtin_nontemporal_load((const GAS f32x4*)(ps + i2 + 4)) : z4_; \
                const f32x4 d0 = k3 ? __builtin_nontemporal_load((const GAS f32x4*)(ps + i3)) : z4_, d1 = k3 ? __builtin_nontemporal_load((const GAS f32x4*)(ps + i3 + 4)) : z4_; \
                { v4u o; o.x = pk2(a0.x, a0.y); o.y = pk2(a0.z, a0.w); o.z = pk2(a1.x, a1.y); o.w = pk2(a1.z, a1.w); __builtin_nontemporal_store(o, (GAS v4u*)(PB + i)); } \
                if (k1) { v4u o; o.x = pk2(b0.x, b0.y); o.y = pk2(b0.z, b0.w); o.z = pk2(b1.x, b1.y); o.w = pk2(b1.z, b1.w); __builtin_nontemporal_store(o, (GAS v4u*)(PB + i1)); } \
                if (k2) { v4u o; o.x = pk2(c0.x, c0.y); o.y = pk2(c0.z, c0.w); o.z = pk2(c1.x, c1.y); o.w = pk2(c1.z, c1.w); __builtin_nontemporal_store(o, (GAS v4u*)(PB + i2)); } \
                if (k3) { v4u o; o.x = pk2(d0.x, d0.y); o.y = pk2(d0.z, d0.w); o.z = pk2(d1.x, d1.y); o.w = pk2(d1.z, d1.w); __builtin_nontemporal_store(o, (GAS v4u*)(PB + i3)); } } \
    } while (0)

    if (EN_PRO && IN(PH_PRO)) {
            PHASE_PTRS();
            for (int rep_ = 0; rep_ < DUP_PRO; ++rep_) {
        LAS float* scr = (LAS float*)(lds + wave * 16384);
        for (int it = gw; it < DEPTH * (16 * 72 + 16 * 32); it += NGW) {
            const int l = it / 1664, r = it % 1664; const float* src; int N, k0, n0; bf16* dst;
            if (r < 1152) { const int kb = r / 72, nb = r % 72; n0 = nb * 32; k0 = kb * 64; N = INW; src = INP(4) + (size_t)l * D * INW;
                bf16* wsw = (bf16*)(ws + WS_WIN + (size_t)l * WIN_LAYER); bf16* wnm = wsw + 1280 * 1024;
                dst = n0 < 768 ? wsw + (size_t)n0 * D : (n0 < 1792 ? wnm + (size_t)(n0 - 768) * D : wsw + (size_t)(768 + n0 - 1792) * D); }
            else { const int q = r - 1152, kb = q >> 5, nb = q & 31; n0 = nb * 32; k0 = kb * 64; N = D; src = INP(23) + (size_t)l * D * D; dst = (bf16*)(ws + WS_WOUT + (size_t)l * WOUT_LAYER) + (size_t)n0 * D; }
            p0_transpose_block(src, D, N, k0, n0, dst, 0, scr, lane);
            }
        }
        for (int it = gw; it < DEPTH * 4 * 16 * 2; it += NGW) {
            const int l = it >> 7, g = (it >> 5) & 3, dh = (it >> 4) & 1, k = (it & 15) * 64 + lane;
            const float* wrow = INP(4) + (size_t)l * D * INW + (size_t)k * INW + 2304 + g * 64;
            const float* pw = INP(20) + (size_t)(l * 4 + g) * 64 * 64 + dh * 32;
            float acc[32];
#pragma unroll
            for (int d = 0; d < 32; ++d) acc[d] = 0.f;
#pragma unroll 1
            for (int c16 = 0; c16 < 64; c16 += 16) {
                f32x4 xr[4];
#pragma unroll
                for (int q = 0; q < 4; ++q) xr[q] = *(const GAS f32x4*)(wrow + c16 + 4 * q);
#pragma unroll
                for (int q = 0; q < 4; ++q)
#pragma unroll
                    for (int e = 0; e < 4; ++e) { const float x = xr[q][e]; const int c = c16 + 4 * q + e;
#pragma unroll
                        for (int d = 0; d < 32; ++d) acc[d] += x * pw[c * 64 + d]; } }
            bf16* dst = (bf16*)(ws + WS_WIN + (size_t)l * WIN_LAYER) + (size_t)(1280 + 1024 + g * 64 + dh * 32) * D + k;
#pragma unroll
            for (int d = 0; d < 32; ++d) dst[(size_t)d * D] = (bf16)f2bf(acc[d]);
        }
        for (int i = gw * 64 + lane; i < DEPTH * 32 * D; i += NGW * 64) { const int l2 = i / (32 * D), r = i % (32 * D), col = r / D, k = r % D;
            const float w = col < 4 ? INP(26)[((size_t)l2 * D + k) * 4 + col] : (col < 20 ? INP(28)[((size_t)l2 * D + k) * 16 + col - 4] : 0.f);
            const unsigned hb = f2bf(w); const float lo = w - __uint_as_float(hb << 16);
            bf16* dst = (bf16*)(ws + WS_WR) + (size_t)l2 * 64 * D; dst[(size_t)col * D + k] = (bf16)hb; dst[(size_t)(32 + col) * D + k] = (bf16)f2bf(lo); }
        int ln2 = lane; asm volatile("" : "+v"(ln2));
        for (int i = gw * 64 + ln2; i < S * 8; i += NGW * 64) { const int pos = i >> 3, j = i & 7; const float ang = (float)pos * powf(500000.0f, -(float)(2 * j) / 16.0f);
            CS[pos * 16 + j] = cosf(ang); CS[pos * 16 + 8 + j] = sinf(ang); }
        for (int m = 4 * gw; m < M; m += 4 * NGW) ln0_row4(INP(0) + (size_t)m * D, INP(2), INP(3), XB + (size_t)m * D, lane);
        WCV_LAYER(0, gw, NGW, 0, 6784, (size_t)0, (size_t)M * 256);
        LDS_WAIT(); __syncthreads();
        for (int it = vcu; it < DEPTH * 64; it += G) { const int fl = it >> 6, pb = it & 63;
            hy::filter_item(lds, pb, INP(7) + fl * 33 * 64, INP(8) + fl * 64, INP(9) + fl * 64, INP(10) + fl * 64 * 64, INP(11) + fl * 64, INP(12) + fl * 64, INP(13) + fl * 64 * 512,
                            (bf16*)(ws + WS_KF) + (size_t)fl * 256 * 8192, (float*)(ws + WS_PS) + (size_t)fl * 64 * 512, wave, lane); }
        SEAM();
    }
#if defined(MK_PER_PHASE)
    for (int l = a.l_lo; l < a.l_hi; ++l) {
#else
#pragma unroll 1
    for (int l = 0; l < DEPTH; ++l) {
#endif
        if (EN_IN && IN(PH_IN)) {
            PHASE_PTRS();
            for (int rep_ = 0; rep_ < DUP_IN; ++rep_) {
            const char* wsw = (const char*)(ws + WS_WIN + (size_t)l * WIN_LAYER);
            SchedIn Sc{vcu, G, (const char*)XB, wsw, wsw + (size_t)1280 * 1024 * 2};
            EpiIn E{QKP, UVT, CS};
            pg8::gemm_phase<EpiIn, SchedIn>(lds, D, Sc, E, wave);
            { SchedSq Sc2{vcu, G / 2, (const char*)(ws + WS_WBUF + (size_t)(l & 1) * WBUF_STRIDE + WB_PB), (const char*)(ws + WS_WBUF + (size_t)(l & 1) * WBUF_STRIDE + WB_WP), (size_t)256 * 256 * 2, (size_t)256 * 256 * 2, G / 2};
              EpiPle<0> E2{(bf16*)(ws + WS_YP), nullptr};
              pg8::gemm_phase<EpiPle<0>, SchedSq>(lds, 256, Sc2, E2, wave); }
            }
            SEAM();
        }
        if (EN_HY && IN(PH_HY)) {
            PHASE_PTRS();
            for (int rep_ = 0; rep_ < DUP_HY; ++rep_) {
            for (int c = vcu; c < 256; c += G)
                hy::unit(lds, c, (const bf16*)(ws + WS_KF) + (size_t)l * 256 * 8192, (const float*)(ws + WS_PS) + (size_t)l * 64 * 512, UVT, INP(5) + l * 3 * 768, INP(6) + l * 768, INP(14) + l * 256, (bf16*)(ws + WS_HT), wave, lane);
            }
        }
        if (EN_POOL && IN(PH_POOL)) {
            PHASE_PTRS();
            for (int rep_ = 0; rep_ < DUP_POOL; ++rep_) {
            int ln = lane; asm volatile("" : "+v"(ln));
            const int cc = (ln & 31) * 8, gq = cc >> 6, hw = 1 << gq;
            const float* pb = INP(21) + l * 256 + cc; const float* psc = INP(22) + l * 256 + cc;
#define POOL_LOAD(IT_, tok_, pos_, lo_, hi_, zp_, wv_, w_) \
                const int tok_ = (IT_) * 2 + (ln >> 5), pos_ = tok_ & (S - 1); \
                int lo_ = pos_ - hw, hi_ = pos_ + hw - 1; lo_ = lo_ < 0 ? 0 : lo_; hi_ = hi_ > S - 1 ? S - 1 : hi_; \
                const bf16* zp_ = QKP + (size_t)(tok_ - pos_) * 1280 + 1024 + cc; \
                v4u wv_[16]; \
                _Pragma("unroll") for (int k = 0; k < 16; ++k) { const int r = pos_ - hw + k; const bool ok = (k < 2 * hw) && (r >= lo_) && (r <= hi_); \
                    wv_[k] = ok ? *(const GAS v4u*)(zp_ + (size_t)(ok ? r : pos_) * 1280) : (v4u){0u, 0u, 0u, 0u}; }        \
                const v4u w_ = *(const GAS v4u*)(zp_ + (size_t)pos_ * 1280)
#define POOL_FINISH(tok_, lo_, hi_, wv_, w_) do { float sacc[8]; \
                _Pragma("unroll") for (int e = 0; e < 8; ++e) sacc[e] = 0.f; \
                _Pragma("unroll") for (int k = 0; k < 16; ++k) { const v4u wk = wv_[k]; \
                    sacc[0] += bf2f((bf16)wk.x); sacc[1] += bf2f((bf16)(wk.x >> 16)); sacc[2] += bf2f((bf16)wk.y); sacc[3] += bf2f((bf16)(wk.y >> 16)); \
                    sacc[4] += bf2f((bf16)wk.z); sacc[5] += bf2f((bf16)(wk.z >> 16)); sacc[6] += bf2f((bf16)wk.w); sacc[7] += bf2f((bf16)(wk.w >> 16)); } \
                const float inv = 1.f / (float)(hi_ - lo_ + 1); \
                const float z[8] = {bf2f((bf16)w_.x), bf2f((bf16)(w_.x >> 16)), bf2f((bf16)w_.y), bf2f((bf16)(w_.y >> 16)), bf2f((bf16)w_.z), bf2f((bf16)(w_.z >> 16)), bf2f((bf16)w_.w), bf2f((bf16)(w_.w >> 16))}; \
                float y[8]; \
                _Pragma("unroll") for (int e = 0; e < 8; ++e) y[e] = (sacc[e] * inv - z[e] + pb[e]) * psc[e]; \
                v4u o; o.x = pk2(y[0], y[1]); o.y = pk2(y[2], y[3]); o.z = pk2(y[4], y[5]); o.w = pk2(y[6], y[7]); \
                *(GAS v4u*)(MIXB + (size_t)tok_ * D + 768 + cc) = o; } while (0)
            for (int it = gw; it < M / 2; it += 2 * NGW) {
                const int itb = it + NGW < M / 2 ? it + NGW : it;
                POOL_LOAD(it, tokA, posA, loA, hiA, zpA, wvA, wA);
                POOL_LOAD(itb, tokB, posB, loB, hiB, zpB, wvB, wB);
                POOL_FINISH(tokA, loA, hiA, wvA, wA);
                POOL_FINISH(tokB, loB, hiB, wvB, wB);
            }
#undef POOL_LOAD
#undef POOL_FINISH
            }
            SEAM();
        }
        if (EN_HYT && IN(PH_HYT)) {
            PHASE_PTRS();
            for (int rep_ = 0; rep_ < DUP_HYT; ++rep_) {
            for (int s = vcu; s < 256; s += G) hy::transpose_slab(lds, s, (const bf16*)(ws + WS_HT), MIXB, wave, lane);
            }
        }
        if (EN_ATT && IN(PH_ATT)) {
            PHASE_PTRS();
            for (int rep_ = 0; rep_ < DUP_ATT; ++rep_) {
            const float lam_init = 0.8f - 0.6f * expf(-0.3f * (float)l);
            int ln = lane; asm volatile("" : "+v"(ln));
            const float lam = expf(wave_sum(INP(15)[l * 64 + ln] * INP(16)[l * 64 + ln])) - expf(wave_sum(INP(17)[l * 64 + ln] * INP(18)[l * 64 + ln])) + lam_init;
            for (int u = vcu; u < 256; u += G) { att::unit(lds, (u >> 4) >> 2, (u >> 4) & 3, u & 15, QKP, UVT, lam, lam_init, INP(19) + l * 128, MIXB, (float*)(ws + WS_STASH) + ((size_t)u * 8 + wave) * 4096, wave, lane);
#ifdef ATT_PROBE_VAR
                att::unit<ATT_PROBE_VAR>(lds, (u >> 4) >> 2, (u >> 4) & 3, u & 15, QKP, UVT, lam, lam_init, INP(19) + l * 128, MIXB, (float*)(ws + WS_STASH) + ((size_t)u * 8 + wave) * 4096, wave, lane, 2, 3);
#endif
            }
            }
            SEAM();
        }
        if (EN_OUT && IN(PH_OUT)) {
            PHASE_PTRS();
            for (int rep_ = 0; rep_ < DUP_OUT; ++rep_) {
            SchedOut Sc{vcu, G, (const char*)MIXB, (const char*)(ws + WS_WOUT + (size_t)l * WOUT_LAYER)};
#if defined(PROBE_OUT)
            { EpiRes E0{(bf16*)(ws + WS_STASH)}; pg8::gemm_phase<EpiRes, SchedOut>(lds, D, Sc, E0, wave); }
#endif
            if (G == 256) {
                EpiResLn E{XB, INP(24) + l * D, INP(25) + l * D, (unsigned long long*)(ws + WS_CTL + 262144), (unsigned*)ctl, (unsigned*)(ctl + CW_BAR), 32u * (unsigned)(l + 1)};
                pg8::gemm_phase<EpiResLn, SchedOut>(lds, D, Sc, E, wave);
            } else {
            EpiRes E{XB};
            pg8::gemm_phase<EpiRes, SchedOut>(lds, D, Sc, E, wave);
            }
            }
            SEAM();
        }
        if (EN_LN1 && IN(PH_LN1)) {
            PHASE_PTRS();
            for (int rep_ = 0; rep_ < DUP_LN1; ++rep_) {
            int ln = lane; asm volatile("" : "+v"(ln));
#if defined(PROBE_LN1)
            for (int ch = vcu; ch < M / 64; ch += G)
                ln1_router_chunk<PROBE_LN1>((LAS RouteLds*)(lds + ROUTE_OFF), lds, ch * 64, XB, (bf16*)(ws + WS_STASH), INP(24) + l * D, INP(25) + l * D, (const bf16*)(ws + WS_WR) + (size_t)l * 64 * D, INP(27) + l * 4, INP(29) + l * 16,
                                 ctl + CW_CNT + l * 16 * CNT_STRIDE, (int*)(ws + WS_TOKIDX), (float*)(ws + WS_GATE), wave, lane);
#endif
            for (int ch = vcu; ch < M / 64; ch += G)
                ln1_router_chunk((LAS RouteLds*)(lds + ROUTE_OFF), lds, ch * 64, XB, XB, INP(24) + l * D, INP(25) + l * D, (const bf16*)(ws + WS_WR) + (size_t)l * 64 * D, INP(27) + l * 4, INP(29) + l * 16,
                                 ctl + CW_CNT + l * 16 * CNT_STRIDE, (int*)(ws + WS_TOKIDX), (float*)(ws + WS_GATE), wave, lane, G == 256);
            }
            SEAM();
        }
        if (EN_MOE1 && IN(PH_MOE1)) {
            PHASE_PTRS();
            for (int rep_ = 0; rep_ < DUP_MOE1; ++rep_) {
            moe_tab_build((LAS int*)(lds + MOETAB_OFF), ctl + CW_CNT + l * 16 * CNT_STRIDE, wave * 64 + lane); const MoeTab T{(LAS const int*)(lds + MOETAB_OFF)};
            { SchedMoe<2> Sc{vcu, G, T, (const char*)XB, (const char*)(ws + WS_WBUF + (size_t)(l & 1) * WBUF_STRIDE + WB_W13), (size_t)512 * D * 2, (const int*)(ws + WS_TOKIDX), 0};
              EpiMoe1 E{(bf16*)(ws + WS_ACT), (const float*)(ws + WS_GATE), T};
              pg8::gemm_phase<EpiMoe1, SchedMoe<2>, true>(lds, D, Sc, E, wave);
#if defined(PROBE_MOE1A)
              pg8::gemm_phase<EpiMoe1, SchedMoe<2>, true>(lds, D, Sc, E, wave);
#endif
            }
            int dfr = 2 * T.pre(16) - G; dfr = (G != 256 || dfr < 0) ? 0 : (dfr > 64 ? 64 : dfr);
            { SchedSq Sc{vcu, G - dfr, (const char*)XB, (const char*)(ws + WS_WBUF + (size_t)(l & 1) * WBUF_STRIDE + WB_WG), TILEB, TILEB, dfr, dfr, 256};
              EpiPle<1> E{(bf16*)(ws + WS_YP), INP(34) + l * D};
              pg8::gemm_phase<EpiPle<1>, SchedSq>(lds, D, Sc, E, wave); }
            if (l + 1 < DEPTH && G != 256) {
                int x2 = 2 * T.pre(16) - G; x2 = x2 < 0 ? 0 : (x2 > G / 2 ? G / 2 : x2);
                if (vcu >= x2) WCV_LAYER(l + 1, (vcu - x2) * NWAVES + wave, (G - x2) * NWAVES, 0, WCV_SPLIT_IT, (size_t)0, WCV_SPLIT_PB);
            }
            }
            SEAM();
        }
        if (EN_MOE2 && IN(PH_MOE2)) {
            PHASE_PTRS();
            for (int rep_ = 0; rep_ < DUP_MOE2; ++rep_) {
            const MoeTab T{(LAS const int*)(lds + MOETAB_OFF)};
            SchedMoe<4> Sc{vcu, G, T, (const char*)(ws + WS_ACT), (const char*)(ws + WS_WBUF + (size_t)(l & 1) * WBUF_STRIDE + WB_W2), (size_t)D * 256 * 2, (const int*)(ws + WS_TOKIDX), (size_t)256 * 256 * 2};
            EpiMoe2 E{(bf16*)(ws + WS_YMOE), (const int*)(ws + WS_TOKIDX), T};
            pg8::gemm_phase<EpiMoe2, SchedMoe<4>>(lds, 256, Sc, E, wave);
            int dfr = 2 * T.pre(16) - G; dfr = (G != 256 || dfr < 0) ? 0 : (dfr > 64 ? 64 : dfr);
            { SchedSq Sc2{vcu, dfr, (const char*)XB, (const char*)(ws + WS_WBUF + (size_t)(l & 1) * WBUF_STRIDE + WB_WG), TILEB, TILEB, G - dfr, 0, dfr};
              EpiPle<1> E2{(bf16*)(ws + WS_YP), INP(34) + l * D};
              pg8::gemm_phase<EpiPle<1>, SchedSq>(lds, D, Sc2, E2, wave); }
            if (l + 1 < DEPTH) {
                int x3 = 4 * T.pre(16) - 2 * G; x3 = x3 < 0 ? 0 : (x3 > G / 2 ? G / 2 : x3);
                if (G != 256) { if (vcu >= x3) WCV_LAYER(l + 1, (vcu - x3) * NWAVES + wave, (G - x3) * NWAVES, WCV_SPLIT_IT, 6784, WCV_SPLIT_PB, (size_t)M * 256); }
                else if (vcu >= x3 && vcu < G - dfr) WCV_LAYER(l + 1, (vcu - x3) * NWAVES + wave, (G - dfr - x3) * NWAVES, 0, 6784, (size_t)0, (size_t)M * 256);
            }
            }
            SEAM();
        }
        if (EN_LN2 && IN(PH_LN2)) {
            PHASE_PTRS();
            for (int rep_ = 0; rep_ < DUP_LN2; ++rep_) {
            int ln = lane; asm volatile("" : "+v"(ln));
            const bf16* YM = (const bf16*)(ws + WS_YMOE); const bf16* YP = (const bf16*)(ws + WS_YP);
            const bool lastl = (l == DEPTH - 1);
#if defined(PROBE_LN2)
            for (int m = gw; m < M; m += NGW)
                ln_row(XB + (size_t)m * D, DN_ALPHA, YM + (size_t)(2 * m) * D, YM + (size_t)(2 * m + 1) * D, YP + (size_t)m * D, INP(36) + l * D, INP(37) + l * D, (float*)nullptr, (bf16*)(ws + WS_STASH) + (size_t)m * D, ln);
#endif
            for (int m = 4 * gw; m < M; m += 4 * NGW)
                ln2_row4(XB + (size_t)m * D, DN_ALPHA, YM + (size_t)(2 * m) * D, YP + (size_t)m * D, INP(36) + l * D, INP(37) + l * D,
                         lastl ? a.out + (size_t)m * D : (float*)nullptr, lastl ? (bf16*)nullptr : XB + (size_t)m * D, ln);
            }
            if (l != DEPTH - 1) SEAM();
        }
    }
#undef IN
#undef SEAM
}
static void mk_launch(const Args& base, int ph, int l, int grid, hipStream_t stream) {
    Args a = base; a.ph_lo = ph; a.ph_hi = ph + 1; a.l_lo = l; a.l_hi = l + 1; a.single = 1;
    hipLaunchKernelGGL(mk_fwd, dim3(grid), dim3(NWAVES * 64), LDS_BYTES, stream, a);
}
extern "C" void kernel_launch(void* const* d_in, const int* in_sizes, int n_in, void* d_out, int out_size, void* d_ws, size_t ws_size, hipStream_t stream) {
    (void)in_sizes; (void)n_in; (void)out_size; (void)ws_size;
    static int grid = 0;
    if (grid == 0) {
        int dev = 0, cus = 0;
        if (hipGetDevice(&dev) != hipSuccess || hipDeviceGetAttribute(&cus, hipDeviceAttributeMultiprocessorCount, dev) != hipSuccess) { grid = -1; return; }
        if (hipFuncSetAttribute((const void*)mk_fwd, hipFuncAttributeMaxDynamicSharedMemorySize, LDS_BYTES) != hipSuccess) { grid = -1; return; }
        (void)hipGetLastError();
        grid = cus;
    }
    if (grid < 0) return;
    (void)hipMemsetAsync((char*)d_ws + WS_CTL, 0, CTL_ZERO_BYTES, stream);
    Args base{};
    for (int i = 0; i < 38; ++i) base.in[i] = (const float*)d_in[i];
    base.out = (float*)d_out; base.ws = (unsigned char*)d_ws;
    base.eid = nullptr; base.wts = nullptr;
#if defined(MK_PER_PHASE)
    mk_launch(base, PH_PRO, 0, grid, stream);
    for (int l = 0; l < DEPTH; ++l) for (int ph : {PH_IN, PH_HY, PH_HYT, PH_ATT, PH_POOL, PH_OUT, PH_LN1, PH_WCV, PH_MOE1, PH_MOE2, PH_LN2}) mk_launch(base, ph, l, grid, stream);
#else
    Args a = base; a.ph_lo = 0; a.ph_hi = PH_END; a.l_lo = 0; a.l_hi = DEPTH; a.single = 0;
    hipLaunchKernelGGL(mk_fwd, dim3(grid), dim3(NWAVES * 64), LDS_BYTES, stream, a);
#endif
}
```
